# Optimizing an MI355X kernel written in HIP

```python
import math
import jax, jax.numpy as jnp
from jax import lax
import numpy as np

D_MODEL = 1024
BATCH = 4
SEQ = 8192
DEPTH = 1

S5_WIDTH = D_MODEL // 2
S5_GROUP = 16
S5_GROUPS = S5_WIDTH // S5_GROUP
S5_STATE = 64
DT_MIN = 0.001
DT_MAX = 0.1

N_Q_HEADS = 8
N_KV_GROUPS = 2
HEADS_PER_GROUP = N_Q_HEADS // N_KV_GROUPS
HEAD_DIM = 64
NSA_WIDTH = N_Q_HEADS * HEAD_DIM
KV_WIDTH = N_KV_GROUPS * HEAD_DIM
CMP_BLOCK = 32
CMP_STRIDE = 16
CMP_HIDDEN = 2 * HEAD_DIM
SEL_BLOCK = 64
SEL_TOPK = 16
WINDOW = 512
Q_BLK = 128
ATTN_SCALE = HEAD_DIM ** -0.5
SEL_FORCE = 1e9

N_BUCKETS = 32
REL_MAX_DIST = 1024

N_EXPERTS = 32
TOP_K = 4
D_FF = D_MODEL
SWIGLU_LIMIT = 7.0
SWIGLU_ALPHA = 1.702
MOE_BLK = 128

DEEPNORM_ALPHA = (2 * DEPTH) ** 0.25
DEEPNORM_BETA = (8 * DEPTH) ** -0.25
LN_EPS = 1e-5

IN_WIDTHS = (S5_WIDTH, NSA_WIDTH, KV_WIDTH, KV_WIDTH, KV_WIDTH, KV_WIDTH, KV_WIDTH, KV_WIDTH, 3 * N_Q_HEADS, D_MODEL, D_MODEL)
IN_SPLITS = tuple(int(v) for v in np.cumsum(IN_WIDTHS)[:-1])
D_IN = int(sum(IN_WIDTHS))

kernel_name = "hybrid_s5_nsa_moe_block"


def layer_norm(x, g, b):
    xf = x.astype(jnp.float32)
    mu = xf.mean(-1, keepdims=True)
    var = jnp.square(xf - mu).mean(-1, keepdims=True)
    return ((xf - mu) * lax.rsqrt(var + LN_EPS) * g.astype(jnp.float32) + b.astype(jnp.float32)).astype(x.dtype)


def masked_softmax(logits, mask):
    z = jnp.where(mask, logits.astype(jnp.float32), -jnp.inf)
    m = jnp.max(z, axis=-1, keepdims=True)
    m = jnp.where(jnp.isfinite(m), m, 0.0)
    p = jnp.exp(z - m)
    return p / jnp.maximum(p.sum(-1, keepdims=True), 1e-30)


def rel_bucket(dist):
    n = jnp.maximum(dist, 0)
    max_exact = N_BUCKETS // 2
    nf = jnp.maximum(n, 1).astype(jnp.float32)
    large = max_exact + (jnp.log(nf / max_exact) / math.log(REL_MAX_DIST / max_exact) * (N_BUCKETS - max_exact)).astype(jnp.int32)
    large = jnp.minimum(large, N_BUCKETS - 1)
    return jnp.where(n < max_exact, n, large)


def s5_mixer(u, lam_re, lam_im, log_dt, b_re, b_im, c_re, c_im, d_skip, w_glu, b_glu):
    B, S, _ = u.shape
    f32 = jnp.float32
    uf = u.astype(f32).reshape(B, S, S5_GROUPS, S5_GROUP)
    lam = lax.complex(lam_re.astype(f32), lam_im.astype(f32))
    dt = jnp.exp(log_dt.astype(f32))[:, None]
    lam_bar = jnp.exp(lam * dt)
    b_mat = lax.complex(b_re.astype(f32), b_im.astype(f32))
    b_bar = ((lam_bar - 1.0) / lam)[..., None] * b_mat
    c_mat = lax.complex(c_re.astype(f32), c_im.astype(f32))
    bu = jnp.einsum('gnp,bsgp->bsgn', b_bar, uf.astype(jnp.complex64))
    a = jnp.broadcast_to(lam_bar[None, None], (1, S, S5_GROUPS, S5_STATE))

    def combine(e1, e2):
        a1, b1 = e1
        a2, b2 = e2
        return a1 * a2, a2 * b1 + b2

    _, states = lax.associative_scan(combine, (a, bu), axis=1)
    y = jnp.einsum('gpn,bsgn->bsgp', c_mat, states).real + d_skip.astype(f32).reshape(S5_GROUPS, S5_GROUP) * uf
    y = jax.nn.gelu(y.reshape(B, S, S5_WIDTH)).astype(u.dtype)
    val, gate = jnp.split(y @ w_glu + b_glu, 2, axis=-1)
    return val * jax.nn.sigmoid(gate)


def compress_blocks(k, pos, w1, w2):
    S = k.shape[2]
    n_cmp = (S - CMP_BLOCK) // CMP_STRIDE + 1
    idx = jnp.arange(n_cmp)[:, None] * CMP_STRIDE + jnp.arange(CMP_BLOCK)[None, :]
    kb = k[:, :, idx, :] + pos
    kb = kb.reshape(kb.shape[0], kb.shape[1], n_cmp, CMP_BLOCK * HEAD_DIM)
    return jax.nn.gelu(kb @ w1) @ w2


def nsa_mixer(q, k_c, v_c, k_s, v_s, k_w, v_w, g_br, rel_bias, pos_k, w1_k, w2_k, pos_v, w1_v, w2_v):
    B, G, hpg, S, dk = q.shape
    n_cmp = (S - CMP_BLOCK) // CMP_STRIDE + 1
    n_sel = S // SEL_BLOCK
    n_top = min(SEL_TOPK, n_sel)
    n_qb = S // Q_BLK

    kc = compress_blocks(k_c, pos_k, w1_k, w2_k)
    vc = compress_blocks(v_c, pos_v, w1_v, w2_v)
    cmp_start = jnp.arange(n_cmp) * CMP_STRIDE
    cmp_end = cmp_start + CMP_BLOCK - 1
    sel_start = jnp.arange(n_sel) * SEL_BLOCK
    sel_end = sel_start + SEL_BLOCK - 1
    overlap = ((cmp_start[:, None] <= sel_end[None, :]) & (cmp_end[:, None] >= sel_start[None, :])).astype(jnp.float32)

    ks_blocks = k_s.reshape(B, G, n_sel, SEL_BLOCK, dk)
    vs_blocks = v_s.reshape(B, G, n_sel, SEL_BLOCK, dk)
    kw_pad = jnp.pad(k_w, ((0, 0), (0, 0), (WINDOW, 0), (0, 0)))
    vw_pad = jnp.pad(v_w, ((0, 0), (0, 0), (WINDOW, 0), (0, 0)))
    tbl = rel_bias.astype(jnp.float32).T.reshape(G, hpg, N_BUCKETS)
    g_ix = jnp.arange(G)[None, :, None, None, None]
    h_ix = jnp.arange(hpg)[None, None, :, None, None]
    gather_sel = jax.vmap(jax.vmap(lambda blk, ix: blk[ix]))

    def qblock(i):
        q0 = i * Q_BLK
        t = q0 + jnp.arange(Q_BLK)
        qb = lax.dynamic_slice_in_dim(q, q0, Q_BLK, axis=3)
        gb = lax.dynamic_slice_in_dim(g_br, q0, Q_BLK, axis=3)

        lc = jnp.einsum('bghqd,bgnd->bghqn', qb, kc).astype(jnp.float32) * ATTN_SCALE
        lc = lc + tbl[:, :, rel_bucket(t[:, None] - cmp_end[None, :])]
        p_c = masked_softmax(lc, cmp_end[None, :] <= t[:, None])
        o_c = jnp.einsum('bghqn,bgnd->bghqd', p_c.astype(vc.dtype), vc)

        imp = jnp.einsum('bghqn,nj->bgqj', p_c, overlap)
        cur = t // SEL_BLOCK
        j = jnp.arange(n_sel)[None, :]
        forced = (j == 0) | (j == cur[:, None]) | (j == cur[:, None] - 1)
        causal_blk = sel_start[None, :] <= t[:, None]
        score = jnp.where(forced, SEL_FORCE, jnp.where(causal_blk, imp, -SEL_FORCE))
        _, sel_idx = lax.top_k(score, n_top)

        kg = gather_sel(ks_blocks, sel_idx).reshape(B, G, Q_BLK, n_top * SEL_BLOCK, dk)
        vg = gather_sel(vs_blocks, sel_idx).reshape(B, G, Q_BLK, n_top * SEL_BLOCK, dk)
        pos_s = (sel_idx[..., None] * SEL_BLOCK + jnp.arange(SEL_BLOCK)).reshape(B, G, Q_BLK, n_top * SEL_BLOCK)
        dist_s = t[None, None, :, None] - pos_s
        ls = jnp.einsum('bghqd,bgqkd->bghqk', qb, kg).astype(jnp.float32) * ATTN_SCALE
        ls = ls + tbl[g_ix, h_ix, rel_bucket(dist_s)[:, :, None]]
        p_s = masked_softmax(ls, (dist_s >= 0)[:, :, None])
        o_s = jnp.einsum('bghqk,bgqkd->bghqd', p_s.astype(vg.dtype), vg)

        kwb = lax.dynamic_slice_in_dim(kw_pad, q0, Q_BLK + WINDOW, axis=2)
        vwb = lax.dynamic_slice_in_dim(vw_pad, q0, Q_BLK + WINDOW, axis=2)
        pos_w = q0 - WINDOW + jnp.arange(Q_BLK + WINDOW)
        dist_w = t[:, None] - pos_w[None, :]
        mask_w = (dist_w >= 0) & (dist_w < WINDOW) & (pos_w[None, :] >= 0)
        lw = jnp.einsum('bghqd,bgkd->bghqk', qb, kwb).astype(jnp.float32) * ATTN_SCALE
        lw = lw + tbl[:, :, rel_bucket(dist_w)]
        p_w = masked_softmax(lw, mask_w)
        o_w = jnp.einsum('bghqk,bgkd->bghqd', p_w.astype(vwb.dtype), vwb)

        return gb[..., 0:1] * o_c + gb[..., 1:2] * o_s + gb[..., 2:3] * o_w

    out = lax.map(qblock, jnp.arange(n_qb))
    return out.transpose(1, 0, 4, 2, 3, 5).reshape(B, S, G * hpg * dk)


def token_mixer(h, rel_bias, w_in, lam_re, lam_im, log_dt, b_re, b_im, c_re, c_im, d_skip, w_glu, b_glu,
                pos_k, w1_k, w2_k, pos_v, w1_v, w2_v, w_nsa_up, w_out):
    B, S, _ = h.shape
    u, q, k_c, v_c, k_s, v_s, k_w, v_w, g_nsa, gm_s5, gm_nsa = jnp.split(h @ w_in, IN_SPLITS, axis=-1)
    y_s5 = s5_mixer(u, lam_re, lam_im, log_dt, b_re, b_im, c_re, c_im, d_skip, w_glu, b_glu)

    def heads_q(z, last):
        return z.reshape(B, S, N_KV_GROUPS, HEADS_PER_GROUP, last).transpose(0, 2, 3, 1, 4)

    def heads_kv(z):
        return z.reshape(B, S, N_KV_GROUPS, HEAD_DIM).transpose(0, 2, 1, 3)

    o_nsa = nsa_mixer(heads_q(q, HEAD_DIM), heads_kv(k_c), heads_kv(v_c), heads_kv(k_s), heads_kv(v_s),
                      heads_kv(k_w), heads_kv(v_w), jax.nn.sigmoid(heads_q(g_nsa, 3)), rel_bias,
                      pos_k, w1_k, w2_k, pos_v, w1_v, w2_v)
    y_nsa = o_nsa @ w_nsa_up
    merged = jax.nn.sigmoid(gm_s5) * y_s5 + jax.nn.sigmoid(gm_nsa) * y_nsa
    return merged @ w_out


def moe_ffn(h, w_router, b_router, w_gate_up, b_gate_up, w_down, b_down):
    B, S, D = h.shape
    T = B * S
    TK = T * TOP_K
    xt = h.reshape(T, D)
    logits = (xt @ w_router + b_router).astype(jnp.float32)
    top_val, top_idx = lax.top_k(logits, TOP_K)
    gates = jax.nn.softmax(top_val, axis=-1)
    flat_e = top_idx.reshape(-1)
    flat_tok = jnp.repeat(jnp.arange(T, dtype=jnp.int32), TOP_K)
    flat_g = gates.reshape(-1)
    order = jnp.argsort(flat_e)
    se, stok, sg = flat_e[order], flat_tok[order], flat_g[order]
    counts = jnp.zeros((N_EXPERTS,), jnp.int32).at[flat_e].add(1)
    starts = jnp.cumsum(counts) - counts
    pcounts = (counts + MOE_BLK - 1) // MOE_BLK * MOE_BLK
    pends = jnp.cumsum(pcounts)
    pstarts = pends - pcounts
    dest = pstarts[se] + jnp.arange(TK, dtype=jnp.int32) - starts[se]
    n_rows = ((TK + MOE_BLK - 1) // MOE_BLK + N_EXPERTS) * MOE_BLK
    n_blk = n_rows // MOE_BLK
    row_tok = jnp.full((n_rows,), T, jnp.int32).at[dest].set(stok)
    row_g = jnp.zeros((n_rows,), flat_g.dtype).at[dest].set(sg)
    blk_e = jnp.clip(jnp.searchsorted(pends, jnp.arange(n_blk) * MOE_BLK, side='right'), 0, N_EXPERTS - 1)
    x_pad = jnp.concatenate([xt, jnp.zeros((1, D), xt.dtype)], axis=0)
    rows = x_pad[row_tok].reshape(n_blk, MOE_BLK, D)

    def expert_block(args):
        xb, e = args
        gate, up = jnp.split(xb @ w_gate_up[e] + b_gate_up[e], 2, axis=-1)
        gate = jnp.minimum(gate, SWIGLU_LIMIT)
        up = jnp.clip(up, -SWIGLU_LIMIT, SWIGLU_LIMIT)
        act = (up + 1.0) * gate * jax.nn.sigmoid(SWIGLU_ALPHA * gate)
        return act @ w_down[e] + b_down[e]

    y_rows = lax.map(expert_block, (rows, blk_e)).reshape(n_rows, D)
    out = jax.ops.segment_sum(y_rows * row_g[:, None], row_tok, num_segments=T + 1)[:T]
    return out.astype(h.dtype).reshape(B, S, D)


def setup_inputs(seed: int = 0) -> dict:
    key = jax.random.key(seed)
    keys = iter(jax.random.split(key, 48))
    L = DEPTH

    def nrm(shape, s):
        return s * jax.random.normal(next(keys), shape, jnp.float32)

    lam_im = jnp.broadcast_to(jnp.pi * jnp.arange(S5_STATE, dtype=jnp.float32), (L, S5_GROUPS, S5_STATE))
    return {
        "x": nrm((BATCH, SEQ, D_MODEL), 1.0),
        "c": nrm((BATCH, D_MODEL), 1.0),
        "rel_bias": nrm((N_BUCKETS, N_Q_HEADS), 0.5),
        "w_ada": nrm((L, D_MODEL, 6 * D_MODEL), 0.5 * D_MODEL ** -0.5),
        "b_ada": nrm((L, 6 * D_MODEL), 0.02),
        "w_in": nrm((L, D_MODEL, D_IN), D_MODEL ** -0.5),
        "ssm_lam_re": -0.5 + nrm((L, S5_GROUPS, S5_STATE), 0.01),
        "ssm_lam_im": lam_im + nrm((L, S5_GROUPS, S5_STATE), 0.01),
        "ssm_log_dt": jax.random.uniform(next(keys), (L, S5_GROUPS), jnp.float32, math.log(DT_MIN), math.log(DT_MAX)),
        "ssm_b_re": nrm((L, S5_GROUPS, S5_STATE, S5_GROUP), (2 * S5_GROUP) ** -0.5),
        "ssm_b_im": nrm((L, S5_GROUPS, S5_STATE, S5_GROUP), (2 * S5_GROUP) ** -0.5),
        "ssm_c_re": nrm((L, S5_GROUPS, S5_GROUP, S5_STATE), (2 * S5_STATE) ** -0.5),
        "ssm_c_im": nrm((L, S5_GROUPS, S5_GROUP, S5_STATE), (2 * S5_STATE) ** -0.5),
        "ssm_d": nrm((L, S5_WIDTH), 1.0),
        "w_glu": nrm((L, S5_WIDTH, 2 * D_MODEL), S5_WIDTH ** -0.5),
        "b_glu": nrm((L, 2 * D_MODEL), 0.02),
        "cmp_pos_k": nrm((L, CMP_BLOCK, HEAD_DIM), 0.02),
        "cmp_w1_k": nrm((L, CMP_BLOCK * HEAD_DIM, CMP_HIDDEN), (CMP_BLOCK * HEAD_DIM) ** -0.5),
        "cmp_w2_k": nrm((L, CMP_HIDDEN, HEAD_DIM), CMP_HIDDEN ** -0.5),
        "cmp_pos_v": nrm((L, CMP_BLOCK, HEAD_DIM), 0.02),
        "cmp_w1_v": nrm((L, CMP_BLOCK * HEAD_DIM, CMP_HIDDEN), (CMP_BLOCK * HEAD_DIM) ** -0.5),
        "cmp_w2_v": nrm((L, CMP_HIDDEN, HEAD_DIM), CMP_HIDDEN ** -0.5),
        "w_nsa_up": nrm((L, NSA_WIDTH, D_MODEL), NSA_WIDTH ** -0.5),
        "w_out": nrm((L, D_MODEL, D_MODEL), DEEPNORM_BETA * D_MODEL ** -0.5),
        "ln1_g": 1.0 + nrm((L, D_MODEL), 0.01),
        "ln1_b": nrm((L, D_MODEL), 0.01),
        "w_router": nrm((L, D_MODEL, N_EXPERTS), D_MODEL ** -0.5),
        "b_router": nrm((L, N_EXPERTS), 0.01),
        "w_gate_up": nrm((L, N_EXPERTS, D_MODEL, 2 * D_FF), D_MODEL ** -0.5),
        "b_gate_up": nrm((L, N_EXPERTS, 2 * D_FF), 0.02),
        "w_down": nrm((L, N_EXPERTS, D_FF, D_MODEL), DEEPNORM_BETA * D_FF ** -0.5),
        "b_down": nrm((L, N_EXPERTS, D_MODEL), 0.02),
        "ln2_g": 1.0 + nrm((L, D_MODEL), 0.01),
        "ln2_b": nrm((L, D_MODEL), 0.01),
    }


def reference(x, c, rel_bias, w_ada, b_ada, w_in, ssm_lam_re, ssm_lam_im, ssm_log_dt, ssm_b_re, ssm_b_im,
              ssm_c_re, ssm_c_im, ssm_d, w_glu, b_glu, cmp_pos_k, cmp_w1_k, cmp_w2_k, cmp_pos_v, cmp_w1_v,
              cmp_w2_v, w_nsa_up, w_out, ln1_g, ln1_b, w_router, b_router, w_gate_up, b_gate_up, w_down,
              b_down, ln2_g, ln2_b):
    cond = jax.nn.silu(c)
    for l in range(DEPTH):
        ada = (cond @ w_ada[l] + b_ada[l])[:, None, :]
        sh_a, sc_a, g_a, sh_f, sc_f, g_f = jnp.split(ada, 6, axis=-1)
        h = x * (1.0 + sc_a) + sh_a
        y = token_mixer(h, rel_bias, w_in[l], ssm_lam_re[l], ssm_lam_im[l], ssm_log_dt[l], ssm_b_re[l],
                        ssm_b_im[l], ssm_c_re[l], ssm_c_im[l], ssm_d[l], w_glu[l], b_glu[l],
                        cmp_pos_k[l], cmp_w1_k[l], cmp_w2_k[l], cmp_pos_v[l], cmp_w1_v[l], cmp_w2_v[l],
                        w_nsa_up[l], w_out[l])
        x = layer_norm(DEEPNORM_ALPHA * x + g_a * y, ln1_g[l], ln1_b[l])
        h = x * (1.0 + sc_f) + sh_f
        y = moe_ffn(h, w_router[l], b_router[l], w_gate_up[l], b_gate_up[l], w_down[l], b_down[l])
        x = layer_norm(DEEPNORM_ALPHA * x + g_f * y, ln2_g[l], ln2_b[l])
    return x
```

```cpp
#include <hip/hip_runtime.h>
#include <hip/hip_cooperative_groups.h>
#include <cstdio>
#include <cstdint>
namespace cg = cooperative_groups;

#ifndef PH_MASK
#define PH_MASK 0xFFFF
#endif
#ifndef ONE_LAUNCH
#define ONE_LAUNCH 0
#endif

typedef unsigned short bf16_t;
typedef short bf16x8 __attribute__((ext_vector_type(8)));
typedef float f32x4 __attribute__((ext_vector_type(4)));
typedef float f32x2 __attribute__((ext_vector_type(2)));
typedef unsigned u32x4 __attribute__((ext_vector_type(4)));
typedef unsigned u32x2 __attribute__((ext_vector_type(2)));
typedef __bf16 bf16x2_t __attribute__((ext_vector_type(2)));

constexpr int NB = 4, SEQ = 8192, NTOK = NB * SEQ, DM = 1024;
constexpr int NIN_PAD = 3968;
constexpr int NEXP = 32, TOPK = 4, NROWS = NTOK * TOPK;
constexpr int S5L = 32;
constexpr int NCHUNK = SEQ / S5L;
constexpr int UROW = 640;
constexpr float DN_ALPHA = 1.189207115002721f;
constexpr float LN_EPS = 1e-5f;
constexpr int NT = 256;

constexpr size_t al256(size_t x) { return (x + 255) & ~(size_t)255; }
constexpr size_t O_ADA = 0;
constexpr size_t O_CNT = O_ADA + al256(4 * 6144 * 4);
constexpr size_t O_LAML = O_CNT + 1024;
constexpr size_t O_BIAS1 = O_LAML + al256(32 * 64 * 2 * 4);
constexpr size_t O_WT_IN = O_BIAS1 + al256(2 * 8 * 128 * 4);
constexpr size_t O_WT_GLU = O_WT_IN + al256((size_t)NIN_PAD * 1024 * 2);
constexpr size_t O_WT_NSA = O_WT_GLU + al256((size_t)2048 * 512 * 2);
constexpr size_t O_WT_OUT = O_WT_NSA + al256((size_t)1024 * 512 * 2);
constexpr size_t O_WT_C1 = O_WT_OUT + al256((size_t)1024 * 1024 * 2);
constexpr size_t O_W1T = O_WT_C1 + al256((size_t)2 * 128 * 2048 * 2);
constexpr size_t O_TW2 = O_W1T + al256((size_t)32 * 128 * 512 * 2);
constexpr size_t O_WT_GU = O_TW2 + al256((size_t)32 * 512 * 640 * 2);
constexpr size_t O_WT_DN = O_WT_GU + al256((size_t)32 * 2048 * 1024 * 2);
constexpr size_t O_H2 = O_WT_DN + al256((size_t)32 * 1024 * 1024 * 2);
constexpr size_t O_Z1 = O_H2 + al256((size_t)NTOK * 1024 * 2);
constexpr size_t O_TOPE = O_Z1 + al256((size_t)NTOK * 1024 * 4);
constexpr size_t O_TOPP = O_TOPE + al256((size_t)NROWS * 4);
constexpr size_t O_TOPG = O_TOPP + al256((size_t)NROWS * 4);
constexpr size_t O_ROWTOK = O_TOPG + al256((size_t)NROWS * 4);
constexpr size_t O_ROWGATE = O_ROWTOK + al256((size_t)(NROWS + 256) * 4);
constexpr size_t O_TOKROW = O_ROWGATE + al256((size_t)(NROWS + 256) * 4);
constexpr size_t O_OVL = O_TOKROW + al256((size_t)NROWS * 4);
constexpr size_t O_U = O_OVL;
constexpr size_t O_E = O_U + al256((size_t)32 * 1024 * UROW * 2);
constexpr size_t O_YS = O_E + al256((size_t)32 * 1024 * 128 * 4);
constexpr size_t O_Q = O_YS + al256((size_t)NTOK * 512 * 2);
constexpr size_t O_KV = O_Q + al256((size_t)NTOK * 512 * 2);
constexpr size_t KV_SLAB = (size_t)SEQ * 64;
constexpr size_t O_SG5 = O_KV + al256((size_t)6 * 8 * KV_SLAB * 2 + 8192);
constexpr size_t O_SGN = O_SG5 + al256((size_t)NTOK * 1024 * 2);
constexpr size_t O_GN = O_SGN + al256((size_t)NTOK * 1024 * 2);
constexpr size_t O_MS5 = O_GN + al256((size_t)NTOK * 24 * 4);
constexpr size_t O_ONSA = O_MS5 + al256((size_t)NTOK * 1024 * 2);
constexpr size_t O_HC = O_ONSA + al256((size_t)NTOK * 512 * 2);
constexpr size_t O_KC = O_HC + al256((size_t)2 * 4096 * 128 * 2);
constexpr size_t O_END1 = O_KC + al256((size_t)2 * 4096 * 64 * 2);
constexpr size_t O_ACT = O_OVL;
constexpr size_t O_YK = O_ACT + al256((size_t)(NROWS + 128) * 1024 * 2);
constexpr size_t O_END2 = O_YK + al256((size_t)(NROWS + 128) * 1024 * 2);
constexpr size_t WS_NEED = O_END1 > O_END2 ? O_END1 : O_END2;

constexpr int SMEM_BYTES = 43008;
constexpr int NPHASE = 16;

struct Params {
    const float* in[34];
    float* out;
    unsigned char* ws;
    int ph_lo, ph_hi;
};

__device__ __forceinline__ unsigned pk2(float lo, float hi) { f32x2 v = {lo, hi}; bf16x2_t b = __builtin_convertvector(v, bf16x2_t); return __builtin_bit_cast(unsigned, b); }
__device__ __forceinline__ bf16_t f2bf(float f) { return (bf16_t)(pk2(f, 0.f) & 0xffffu); }
__device__ __forceinline__ float bf2f(bf16_t h) { return __uint_as_float(((unsigned)h) << 16); }
__device__ __forceinline__ float bflo(unsigned w) { return __uint_as_float(w << 16); }
__device__ __forceinline__ float bfhi(unsigned w) { return __uint_as_float(w & 0xffff0000u); }
__device__ __forceinline__ float sigmoidf_(float x) { return 1.f / (1.f + __expf(-x)); }
__device__ __forceinline__ float gelu_tanh(float x) { const float u = 0.7978845608028654f * (x + 0.044715f * x * x * x); const float e = __expf(2.f * u); return 0.5f * x * (2.f - 2.f / (e + 1.f)); }
__device__ __forceinline__ float wave_sum(float v) {
#pragma unroll
    for (int o = 1; o < 64; o <<= 1) v += __shfl_xor(v, o);
    return v;
}
__device__ __forceinline__ float wave_max(float v) {
#pragma unroll
    for (int o = 1; o < 64; o <<= 1) v = fmaxf(v, __shfl_xor(v, o));
    return v;
}
#define WAVE_SYNC() do { __builtin_amdgcn_fence(__ATOMIC_RELEASE, "wavefront"); __builtin_amdgcn_wave_barrier(); __builtin_amdgcn_fence(__ATOMIC_ACQUIRE, "wavefront"); } while (0)

constexpr int LROW = 72;
template <class AL, class BL, class EP>
__device__ __forceinline__ void gemm_tile(int nk, const AL& al, const BL& bl, const EP& ep, unsigned char* smem) {
    const int tid = threadIdx.x, lane = tid & 63, wid = tid >> 6, wr = wid >> 1, wc = wid & 1, fr = lane & 15, fq = lane >> 4;
    bf16_t* sA = (bf16_t*)smem; bf16_t* sB = sA + 128 * LROW;
    f32x4 acc[4][4];
#pragma unroll
    for (int m = 0; m < 4; ++m)
#pragma unroll
        for (int n = 0; n < 4; ++n) acc[m][n] = (f32x4){0.f, 0.f, 0.f, 0.f};
    u32x4 ra[4], rb[4];
    const int prow = tid >> 3, pk = (tid & 7) * 8;
#pragma unroll
    for (int i = 0; i < 4; ++i) { ra[i] = al(i, prow + i * 32, pk); rb[i] = bl(i, prow + i * 32, pk); }
    for (int kt = 0; kt < nk; ++kt) {
        __syncthreads();
#pragma unroll
        for (int i = 0; i < 4; ++i) {
            *(u32x4*)(sA + (prow + i * 32) * LROW + pk) = ra[i];
            *(u32x4*)(sB + (prow + i * 32) * LROW + pk) = rb[i];
        }
        __syncthreads();
        if (kt + 1 < nk) {
            const int k0 = (kt + 1) * 64 + pk;
#pragma unroll
            for (int i = 0; i < 4; ++i) { ra[i] = al(i, prow + i * 32, k0); rb[i] = bl(i, prow + i * 32, k0); }
        }
#pragma unroll
        for (int kk = 0; kk < 2; ++kk) {
            bf16x8 af[4], bfr[4];
#pragma unroll
            for (int m = 0; m < 4; ++m) af[m] = *(const bf16x8*)(sA + (wr * 64 + m * 16 + fr) * LROW + kk * 32 + fq * 8);
#pragma unroll
            for (int n = 0; n < 4; ++n) bfr[n] = *(const bf16x8*)(sB + (wc * 64 + n * 16 + fr) * LROW + kk * 32 + fq * 8);
#pragma unroll
            for (int m = 0; m < 4; ++m)
#pragma unroll
                for (int n = 0; n < 4; ++n) acc[m][n] = __builtin_amdgcn_mfma_f32_16x16x32_bf16(bfr[n], af[m], acc[m][n], 0, 0, 0);
        }
    }
    ep(acc, wr, wc, fr, fq);
    __syncthreads();
}

struct LoadBf16 {
    const bf16_t* base; long ld;
    __device__ __forceinline__ u32x4 operator()(int, int row, int k) const { return *(const u32x4*)(base + (long)row * ld + k); }
};

__device__ __forceinline__ int map_in(int n) { return n < 1792 ? n : (n < 3840 ? n + 24 : (n < 3864 ? 1792 + (n - 3840) : -1)); }
__device__ __forceinline__ int map_il32(int n) { const int b = n >> 5; return (b & 1) * 1024 + (b >> 1) * 32 + (n & 31); }

template <int MAP>
__device__ __forceinline__ void transpose_tile(const float* W, int K, int Nsrc, bf16_t* Wt, int kt, int ntile, unsigned char* smem) {
    float* t = (float*)smem;
    const int tid = threadIdx.x, k0 = kt * 64, n0 = ntile * 64;
    {
        const int n = tid & 63;
        const int nd = n0 + n;
        const int src = MAP == 0 ? nd : (MAP == 1 ? map_in(nd) : map_il32(nd));
#pragma unroll 4
        for (int i = 0; i < 16; ++i) { const int k = i * 4 + (tid >> 6); t[k * 65 + n] = (src >= 0) ? W[(size_t)(k0 + k) * Nsrc + src] : 0.f; }
    }
    __syncthreads();
    {
        const int n = tid >> 2, ks = (tid & 3) * 16;
        u32x4 o0, o1;
        o0.x = pk2(t[(ks + 0) * 65 + n], t[(ks + 1) * 65 + n]); o0.y = pk2(t[(ks + 2) * 65 + n], t[(ks + 3) * 65 + n]);
        o0.z = pk2(t[(ks + 4) * 65 + n], t[(ks + 5) * 65 + n]); o0.w = pk2(t[(ks + 6) * 65 + n], t[(ks + 7) * 65 + n]);
        o1.x = pk2(t[(ks + 8) * 65 + n], t[(ks + 9) * 65 + n]); o1.y = pk2(t[(ks + 10) * 65 + n], t[(ks + 11) * 65 + n]);
        o1.z = pk2(t[(ks + 12) * 65 + n], t[(ks + 13) * 65 + n]); o1.w = pk2(t[(ks + 14) * 65 + n], t[(ks + 15) * 65 + n]);
        bf16_t* d = Wt + (size_t)(n0 + n) * K + k0 + ks;
        *(u32x4*)d = o0; *(u32x4*)(d + 8) = o1;
    }
    __syncthreads();
}

__device__ __forceinline__ void phase0(const Params& p, unsigned char* smem) {
    unsigned char* ws = p.ws;
    const int tid = threadIdx.x;
    constexpr int I_ADA = 96;
    constexpr int T_IN = 16 * (NIN_PAD / 64), T_GLU = 8 * 32, T_NSA = 8 * 16, T_OUT = 16 * 16, T_C1 = 2 * 32 * 2, T_GU = 32 * 16 * 32, T_DN = 32 * 16 * 16;
    constexpr int I_TR = T_IN + T_GLU + T_NSA + T_OUT + T_C1 + T_GU + T_DN;
    constexpr int I_S5 = 32 * 33;
    constexpr int I_MISC = 17;
    constexpr int NITEM = I_ADA + I_TR + I_S5 + I_MISC;
    for (int item = blockIdx.x; item < NITEM; item += gridDim.x) {
        int r = item;
        if (r < I_ADA) {
            const float* c = p.in[1]; const float* w = p.in[3]; const float* bb = p.in[4];
            const int wid = tid >> 6, lane = tid & 63, j = r * 64 + lane;
            float a0 = 0.f, a1 = 0.f, a2 = 0.f, a3 = 0.f;
            for (int k = wid * 256; k < wid * 256 + 256; ++k) {
                const float wv = w[(size_t)k * 6144 + j];
                const float c0 = c[k], c1 = c[1024 + k], c2 = c[2048 + k], c3 = c[3072 + k];
                a0 += c0 * sigmoidf_(c0) * wv; a1 += c1 * sigmoidf_(c1) * wv; a2 += c2 * sigmoidf_(c2) * wv; a3 += c3 * sigmoidf_(c3) * wv;
            }
            float* red = (float*)smem;
            red[(wid * 4 + 0) * 64 + lane] = a0; red[(wid * 4 + 1) * 64 + lane] = a1; red[(wid * 4 + 2) * 64 + lane] = a2; red[(wid * 4 + 3) * 64 + lane] = a3;
            __syncthreads();
            { const int b = tid >> 6; const float s = red[(0 * 4 + b) * 64 + lane] + red[(1 * 4 + b) * 64 + lane] + red[(2 * 4 + b) * 64 + lane] + red[(3 * 4 + b) * 64 + lane];
              ((float*)(ws + O_ADA))[b * 6144 + j] = s + bb[j]; }
            __syncthreads();
            continue;
        }
        r -= I_ADA;
        if (r < I_TR) {
            if (r < T_IN) { transpose_tile<1>(p.in[5], 1024, 3864, (bf16_t*)(ws + O_WT_IN), r / (NIN_PAD / 64), r % (NIN_PAD / 64), smem); continue; } r -= T_IN;
            if (r < T_GLU) { transpose_tile<2>(p.in[14], 512, 2048, (bf16_t*)(ws + O_WT_GLU), r / 32, r % 32, smem); continue; } r -= T_GLU;
            if (r < T_NSA) { transpose_tile<0>(p.in[22], 512, 1024, (bf16_t*)(ws + O_WT_NSA), r / 16, r % 16, smem); continue; } r -= T_NSA;
            if (r < T_OUT) { transpose_tile<0>(p.in[23], 1024, 1024, (bf16_t*)(ws + O_WT_OUT), r / 16, r % 16, smem); continue; } r -= T_OUT;
            if (r < T_C1) { const int kv = r / 64, q = r % 64; transpose_tile<0>(p.in[kv ? 20 : 17], 2048, 128, (bf16_t*)(ws + O_WT_C1) + (size_t)kv * 128 * 2048, q / 2, q % 2, smem); continue; } r -= T_C1;
            if (r < T_GU) { const int e = r / 512, q = r % 512; transpose_tile<2>(p.in[28] + (size_t)e * 1024 * 2048, 1024, 2048, (bf16_t*)(ws + O_WT_GU) + (size_t)e * 2048 * 1024, q / 32, q % 32, smem); continue; } r -= T_GU;
            { const int e = r / 256, q = r % 256; transpose_tile<0>(p.in[30] + (size_t)e * 1024 * 1024, 1024, 1024, (bf16_t*)(ws + O_WT_DN) + (size_t)e * 1024 * 1024, q / 16, q % 16, smem); continue; }
        }
        r -= I_TR;
        if (r < I_S5) {
            const int g = r / 33, dl = r % 33;
            f32x2* pw = (f32x2*)smem;
            f32x2* bbv = pw + 64;
            f32x2* ccv = bbv + 1024;
            const float dt = expf(p.in[8][g]);
            if (tid < 64) {
                const int n = tid; const double re = p.in[6][g * 64 + n], im = p.in[7][g * 64 + n];
                const double mag = exp(re * (double)dt * dl), ang = im * (double)dt * dl;
                double sn, cs; sincos(ang, &sn, &cs);
                pw[n] = (f32x2){(float)(mag * cs), (float)(mag * sn)};
                if (dl == 32) { ((f32x2*)(ws + O_LAML))[g * 64 + n] = pw[n]; }
            }
            for (int e = tid; e < 1024; e += NT) {
                const int n = e >> 4, q = e & 15;
                const double re = p.in[6][g * 64 + n], im = p.in[7][g * 64 + n];
                const double mag = exp(re * (double)dt), ang = im * (double)dt;
                double sn, cs; sincos(ang, &sn, &cs);
                const double lr = mag * cs - 1.0, li = mag * sn;
                const double den = re * re + im * im;
                const double fr_ = (lr * re + li * im) / den, fi_ = (li * re - lr * im) / den;
                const double br = p.in[9][(g * 64 + n) * 16 + q], bi = p.in[10][(g * 64 + n) * 16 + q];
                bbv[e] = (f32x2){(float)(fr_ * br - fi_ * bi), (float)(fr_ * bi + fi_ * br)};
            }
            for (int e = tid; e < 1024; e += NT) { ccv[e] = (f32x2){p.in[11][g * 1024 + e], p.in[12][g * 1024 + e]}; }
            __syncthreads();
            bf16_t* TW2 = (bf16_t*)(ws + O_TW2) + (size_t)g * 512 * UROW;
            bf16_t* W1T = (bf16_t*)(ws + O_W1T) + (size_t)g * 128 * 512;
            if (dl < 32) {
                const int pp = tid >> 4, q = tid & 15;
                float acc = 0.f;
                for (int n = 0; n < 64; ++n) {
                    const f32x2 cv = ccv[pp * 64 + n], pv = pw[n], bv = bbv[n * 16 + q];
                    const float xr = cv.x * pv.x - cv.y * pv.y, xi = cv.x * pv.y + cv.y * pv.x;
                    acc += xr * bv.x - xi * bv.y;
                }
                if (dl == 0 && pp == q) acc += p.in[13][g * 16 + pp];
                const bf16_t kb = f2bf(acc);
                for (int tau = dl; tau < 32; ++tau) { const int s = tau - dl; TW2[(size_t)(tau * 16 + pp) * UROW + s * 16 + q] = kb; }
                if (dl >= 1) for (int s = dl; s < 32; ++s) { const int tau = s - dl; TW2[(size_t)(tau * 16 + pp) * UROW + s * 16 + q] = 0; }
                const int s = 31 - dl;
                for (int e = tid; e < 2048; e += NT) {
                    const int c = e >> 4, qq = e & 15, n = c & 63, ri = c >> 6;
                    const f32x2 pv = pw[n], bv = bbv[n * 16 + qq];
                    const float zr = pv.x * bv.x - pv.y * bv.y, zi = pv.x * bv.y + pv.y * bv.x;
                    W1T[(size_t)c * 512 + s * 16 + qq] = f2bf(ri ? zi : zr);
                }
            }
            if (dl >= 1) {
                const int tau = dl - 1;
                for (int e = tid; e < 2048; e += NT) {
                    const int pp = e >> 7, c = e & 127, n = c & 63, ri = c >> 6;
                    const f32x2 cv = ccv[pp * 64 + n], pv = pw[n];
                    const float xr = cv.x * pv.x - cv.y * pv.y, xi = cv.x * pv.y + cv.y * pv.x;
                    TW2[(size_t)(tau * 16 + pp) * UROW + 512 + c] = f2bf(ri ? -xi : xr);
                }
            }
            __syncthreads();
            continue;
        }
        r -= I_S5;
        if (r < 16) {
            const int kv = r >> 3, part = r & 7, j = tid & 127, half = tid >> 7;
            const float* pos = p.in[kv ? 19 : 16]; const float* w1 = p.in[kv ? 20 : 17];
            float a = 0.f;
            const int i0 = part * 256 + half * 128;
            for (int i = i0; i < i0 + 128; ++i) a += pos[i] * w1[(size_t)i * 128 + j];
            float* red = (float*)smem;
            red[tid] = a;
            __syncthreads();
            if (tid < 128) ((float*)(ws + O_BIAS1))[(kv * 8 + part) * 128 + tid] = red[tid] + red[tid + 128];
            __syncthreads();
            continue;
        }
        if (tid < 64) ((unsigned*)(ws + O_CNT))[tid] = 0u;
    }
}

struct LoadXMod {
    const float* x; const float* ada;
    __device__ __forceinline__ u32x4 operator()(int, int row, int k) const {
        const f32x4 x0 = *(const f32x4*)(x + (size_t)row * 1024 + k), x1 = *(const f32x4*)(x + (size_t)row * 1024 + k + 4);
        const f32x4 s0 = *(const f32x4*)(ada + 1024 + k), s1 = *(const f32x4*)(ada + 1024 + k + 4);
        const f32x4 h0 = *(const f32x4*)(ada + k), h1 = *(const f32x4*)(ada + k + 4);
        u32x4 o;
        o.x = pk2(x0[0] * (1.f + s0[0]) + h0[0], x0[1] * (1.f + s0[1]) + h0[1]); o.y = pk2(x0[2] * (1.f + s0[2]) + h0[2], x0[3] * (1.f + s0[3]) + h0[3]);
        o.z = pk2(x1[0] * (1.f + s1[0]) + h1[0], x1[1] * (1.f + s1[1]) + h1[1]); o.w = pk2(x1[2] * (1.f + s1[2]) + h1[2], x1[3] * (1.f + s1[3]) + h1[3]);
        return o;
    }
};
struct EpiIn {
    unsigned char* ws; int pm, pn;
    __device__ __forceinline__ void operator()(f32x4 (&acc)[4][4], int wr, int wc, int fr, int fq) const {
#pragma unroll
        for (int m = 0; m < 4; ++m) {
            const int token = pm * 128 + wr * 64 + m * 16 + fr;
#pragma unroll
            for (int n = 0; n < 4; ++n) {
                const int col = pn * 128 + wc * 64 + n * 16 + fq * 4;
                const f32x4 v = acc[m][n];
                if (pn < 4) {
                    const int g = col >> 4, q = col & 15;
                    bf16_t* d = (bf16_t*)(ws + O_U) + ((size_t)(g * 1024 + (token >> 5)) * UROW + (token & 31) * 16 + q);
                    *(u32x2*)d = (u32x2){pk2(v[0], v[1]), pk2(v[2], v[3])};
                } else if (pn < 8) {
                    bf16_t* d = (bf16_t*)(ws + O_Q) + (size_t)token * 512 + (col - 512);
                    *(u32x2*)d = (u32x2){pk2(v[0], v[1]), pk2(v[2], v[3])};
                } else if (pn < 14) {
                    const int c = col - 1024, j6 = c >> 7, g = (c >> 6) & 1, dd = c & 63, b = token >> 13, s = token & 8191;
                    bf16_t* d = (bf16_t*)(ws + O_KV) + ((size_t)((j6 * 4 + b) * 2 + g) * KV_SLAB + (size_t)s * 64 + dd);
                    *(u32x2*)d = (u32x2){pk2(v[0], v[1]), pk2(v[2], v[3])};
                } else if (pn < 22) {
                    bf16_t* d = (bf16_t*)(ws + O_SG5) + (size_t)token * 1024 + (col - 1792);
                    *(u32x2*)d = (u32x2){pk2(sigmoidf_(v[0]), sigmoidf_(v[1])), pk2(sigmoidf_(v[2]), sigmoidf_(v[3]))};
                } else if (pn < 30) {
                    bf16_t* d = (bf16_t*)(ws + O_SGN) + (size_t)token * 1024 + (col - 2816);
                    *(u32x2*)d = (u32x2){pk2(sigmoidf_(v[0]), sigmoidf_(v[1])), pk2(sigmoidf_(v[2]), sigmoidf_(v[3]))};
                } else {
                    const int c = col - 3840;
                    if (c < 24) { float* d = (float*)(ws + O_GN) + (size_t)token * 24 + c; *(f32x4*)d = (f32x4){sigmoidf_(v[0]), sigmoidf_(v[1]), sigmoidf_(v[2]), sigmoidf_(v[3])}; }
                }
            }
        }
    }
};
__device__ __forceinline__ void phase1(const Params& p, unsigned char* smem) {
    constexpr int NPN = NIN_PAD / 128;
    for (int item = blockIdx.x; item < 256 * NPN; item += gridDim.x) {
        const int pm = item / NPN, pn = item % NPN, b = pm >> 6;
        LoadXMod al{p.in[0] + (size_t)pm * 128 * 1024, (const float*)(p.ws + O_ADA) + b * 6144};
        LoadBf16 bl{(const bf16_t*)(p.ws + O_WT_IN) + (size_t)pn * 128 * 1024, 1024};
        EpiIn ep{p.ws, pm, pn};
        gemm_tile(16, al, bl, ep, smem);
    }
}

struct EpiE { float* E; __device__ __forceinline__ void operator()(f32x4 (&acc)[4][4], int wr, int wc, int fr, int fq) const {
#pragma unroll
    for (int m = 0; m < 4; ++m)
#pragma unroll
        for (int n = 0; n < 4; ++n) *(f32x4*)(E + (size_t)(wr * 64 + m * 16 + fr) * 128 + wc * 64 + n * 16 + fq * 4) = acc[m][n]; } };
__device__ __forceinline__ void phase2(const Params& p, unsigned char* smem) {
    for (int item = blockIdx.x; item < 32 * 8; item += gridDim.x) {
        const int g = item >> 3, pm = item & 7;
        LoadBf16 al{(const bf16_t*)(p.ws + O_U) + (size_t)(g * 1024 + pm * 128) * UROW, UROW};
        LoadBf16 bl{(const bf16_t*)(p.ws + O_W1T) + (size_t)g * 128 * 512, 512};
        EpiE ep{(float*)(p.ws + O_E) + (size_t)(g * 1024 + pm * 128) * 128};
        gemm_tile(8, al, bl, ep, smem);
    }
}
__device__ __forceinline__ void phase3(const Params& p, unsigned char*) {
    for (int item = blockIdx.x; item < 32; item += gridDim.x) {
        const int tid = threadIdx.x, n = tid & 63, bg = item * 4 + (tid >> 6), b = bg >> 5, g = bg & 31;
        const f32x2 lm = ((const f32x2*)(p.ws + O_LAML))[g * 64 + n];
        const float* E = (const float*)(p.ws + O_E) + (size_t)(g * 1024 + b * 256) * 128;
        bf16_t* U = (bf16_t*)(p.ws + O_U) + (size_t)(g * 1024 + b * 256) * UROW + 512;
        float hr = 0.f, hi = 0.f;
#pragma unroll 8
        for (int c = 0; c < NCHUNK; ++c) {
            const float er = E[(size_t)c * 128 + n], ei = E[(size_t)c * 128 + 64 + n];
            U[(size_t)c * UROW + n] = f2bf(hr); U[(size_t)c * UROW + 64 + n] = f2bf(hi);
            const float nr = lm.x * hr - lm.y * hi + er, ni = lm.x * hi + lm.y * hr + ei;
            hr = nr; hi = ni;
        }
    }
}
struct EpiY { bf16_t* YS; int g, pm, pn;
    __device__ __forceinline__ void operator()(f32x4 (&acc)[4][4], int wr, int wc, int fr, int fq) const {
#pragma unroll
        for (int m = 0; m < 4; ++m) {
            const int r = pm * 128 + wr * 64 + m * 16 + fr;
            const int tok0 = (r >> 8) * SEQ + (r & 255) * S5L;
#pragma unroll
            for (int n = 0; n < 4; ++n) {
                const int col = pn * 128 + wc * 64 + n * 16 + fq * 4, tau = col >> 4, pp = col & 15;
                const f32x4 v = acc[m][n];
                bf16_t* d = YS + (size_t)(tok0 + tau) * 512 + g * 16 + pp;
                *(u32x2*)d = (u32x2){pk2(gelu_tanh(v[0]), gelu_tanh(v[1])), pk2(gelu_tanh(v[2]), gelu_tanh(v[3]))};
            }
        }
    } };
__device__ __forceinline__ void phase4(const Params& p, unsigned char* smem) {
    for (int item = blockIdx.x; item < 32 * 8 * 4; item += gridDim.x) {
        const int g = item >> 5, pm = (item >> 2) & 7, pn = item & 3;
        LoadBf16 al{(const bf16_t*)(p.ws + O_U) + (size_t)(g * 1024 + pm * 128) * UROW, UROW};
        LoadBf16 bl{(const bf16_t*)(p.ws + O_TW2) + (size_t)(g * 512 + pn * 128) * UROW, UROW};
        EpiY ep{(bf16_t*)(p.ws + O_YS), g, pm, pn};
        gemm_tile(10, al, bl, ep, smem);
    }
}
struct EpiGlu { const float* bglu; const bf16_t* SG5; bf16_t* MS5; int pm, pn;
    __device__ __forceinline__ void operator()(f32x4 (&acc)[4][4], int wr, int wc, int fr, int fq) const {
#pragma unroll
        for (int m = 0; m < 4; ++m) {
            const int token = pm * 128 + wr * 64 + m * 16 + fr;
#pragma unroll
            for (int n = 0; n < 2; ++n) {
                const int cv = pn * 64 + wc * 32 + n * 16 + fq * 4;
                const f32x4 bv = *(const f32x4*)(bglu + cv), bg = *(const f32x4*)(bglu + 1024 + cv);
                const u32x2 sg = *(const u32x2*)(SG5 + (size_t)token * 1024 + cv);
                const f32x4 va = acc[m][n] + bv, ga = acc[m][n + 2] + bg;
                const float y0 = va[0] * sigmoidf_(ga[0]) * bflo(sg.x), y1 = va[1] * sigmoidf_(ga[1]) * bfhi(sg.x);
                const float y2 = va[2] * sigmoidf_(ga[2]) * bflo(sg.y), y3 = va[3] * sigmoidf_(ga[3]) * bfhi(sg.y);
                *(u32x2*)(MS5 + (size_t)token * 1024 + cv) = (u32x2){pk2(y0, y1), pk2(y2, y3)};
            }
        }
    } };
__device__ __forceinline__ void phase5(const Params& p, unsigned char* smem) {
    for (int item = blockIdx.x; item < 256 * 16; item += gridDim.x) {
        const int pm = item >> 4, pn = item & 15;
        LoadBf16 al{(const bf16_t*)(p.ws + O_YS) + (size_t)pm * 128 * 512, 512};
        LoadBf16 bl{(const bf16_t*)(p.ws + O_WT_GLU) + (size_t)pn * 128 * 512, 512};
        EpiGlu ep{p.in[15], (const bf16_t*)(p.ws + O_SG5), (bf16_t*)(p.ws + O_MS5), pm, pn};
        gemm_tile(8, al, bl, ep, smem);
    }
}

struct LoadCmp {
    const bf16_t* slab0; int R0;
    __device__ __forceinline__ u32x4 operator()(int, int row, int k) const { const int R = R0 + row; return *(const u32x4*)(slab0 + (size_t)(R >> 9) * KV_SLAB + (size_t)(R & 511) * 1024 + k); }
};
struct EpiCmp { const float* b1p; bf16_t* HC; int R0;
    __device__ __forceinline__ void operator()(f32x4 (&acc)[4][4], int wr, int wc, int fr, int fq) const {
#pragma unroll
        for (int n = 0; n < 4; ++n) {
            const int col = wc * 64 + n * 16 + fq * 4;
            f32x4 bs = (f32x4){0.f, 0.f, 0.f, 0.f};
#pragma unroll
            for (int part = 0; part < 8; ++part) bs += *(const f32x4*)(b1p + part * 128 + col);
#pragma unroll
            for (int m = 0; m < 4; ++m) {
                const int R = R0 + wr * 64 + m * 16 + fr;
                const f32x4 v = acc[m][n] + bs;
                *(u32x2*)(HC + (size_t)R * 128 + col) = (u32x2){pk2(gelu_tanh(v[0]), gelu_tanh(v[1])), pk2(gelu_tanh(v[2]), gelu_tanh(v[3]))};
            }
        }
    } };
__device__ __forceinline__ void phase6(const Params& p, unsigned char* smem) {
    for (int item = blockIdx.x; item < 64; item += gridDim.x) {
        const int kv = item >> 5, pm = item & 31;
        LoadCmp al{(const bf16_t*)(p.ws + O_KV) + (size_t)kv * 8 * KV_SLAB, pm * 128};
        LoadBf16 bl{(const bf16_t*)(p.ws + O_WT_C1) + (size_t)kv * 128 * 2048, 2048};
        EpiCmp ep{(const float*)(p.ws + O_BIAS1) + kv * 8 * 128, (bf16_t*)(p.ws + O_HC) + (size_t)kv * 4096 * 128, pm * 128};
        gemm_tile(32, al, bl, ep, smem);
    }
}
__device__ __forceinline__ void phase7(const Params& p, unsigned char*) {
    for (int item = blockIdx.x; item < 2048; item += gridDim.x) {
        const int o = item * NT + threadIdx.x, d = o & 63, R = (o >> 6) & 4095, kv = o >> 18;
        const bf16_t* h = (const bf16_t*)(p.ws + O_HC) + ((size_t)kv * 4096 + R) * 128;
        const float* w2 = p.in[kv ? 21 : 18];
        float a = 0.f;
#pragma unroll 8
        for (int j = 0; j < 128; ++j) a += bf2f(h[j]) * w2[j * 64 + d];
        ((bf16_t*)(p.ws + O_KC))[((size_t)kv * 4096 + R) * 64 + d] = f2bf(a);
    }
}

__device__ __forceinline__ int rel_bucket_dev(int dist) {
    const int n = dist > 0 ? dist : 0;
    if (n < 16) return n;
    const int l = (int)(__log2f((float)n * 0.0625f) * 2.6666667f);
    const int v = 16 + l;
    return v < 31 ? v : 31;
}
struct AttState { float m[4], l[4], o[4]; };
__device__ __forceinline__ void attn_block(AttState& st, bool cmp, int row0, int t, int ncnt, int maxrow, const bf16_t* Kb, const bf16_t* Vb,
                                           const float* qs, float* sc, float* pb, const unsigned char* blut, const float* tbl, int lane) {
    const int r = row0 + lane;
    bool valid; int dist;
    if (cmp) { valid = r < ncnt; dist = t - (16 * r + 31); }
    else { valid = (r >= 0) && (r <= t); dist = t - r; }
    if (!__any(valid)) return;
    const int rc = r < 0 ? 0 : (r > maxrow ? maxrow : r);
    const bf16_t* kp = Kb + (size_t)rc * 64;
    float s0 = 0.f, s1 = 0.f, s2 = 0.f, s3 = 0.f;
#pragma unroll 2
    for (int c = 0; c < 8; ++c) {
        const u32x4 kk = *(const u32x4*)(kp + c * 8);
        const float k0 = bflo(kk.x), k1 = bfhi(kk.x), k2 = bflo(kk.y), k3 = bfhi(kk.y), k4 = bflo(kk.z), k5 = bfhi(kk.z), k6 = bflo(kk.w), k7 = bfhi(kk.w);
#pragma unroll
        for (int h = 0; h < 4; ++h) {
            const f32x4 qa = *(const f32x4*)(qs + h * 64 + c * 8), qb = *(const f32x4*)(qs + h * 64 + c * 8 + 4);
            const float d = qa[0] * k0 + qa[1] * k1 + qa[2] * k2 + qa[3] * k3 + qb[0] * k4 + qb[1] * k5 + qb[2] * k6 + qb[3] * k7;
            if (h == 0) s0 += d; else if (h == 1) s1 += d; else if (h == 2) s2 += d; else s3 += d;
        }
    }
    const int dcl = dist < 0 ? 0 : dist;
    const int bk = dcl < 1024 ? (int)blut[dcl] : 31;
    float s[4] = {s0 + tbl[0 * 32 + bk], s1 + tbl[1 * 32 + bk], s2 + tbl[2 * 32 + bk], s3 + tbl[3 * 32 + bk]};
    float pv[4];
#pragma unroll
    for (int h = 0; h < 4; ++h) {
        if (!valid) s[h] = -INFINITY;
        if (cmp) sc[h * 512 + (r & 511)] = s[h];
        const float mb = wave_max(s[h]);
        const float mn = fmaxf(st.m[h], mb);
        const float corr = __expf(st.m[h] - mn);
        const float pe = valid ? __expf(s[h] - mn) : 0.f;
        st.l[h] = st.l[h] * corr + wave_sum(pe);
        st.o[h] *= corr; st.m[h] = mn; pv[h] = pe;
    }
    *(f32x4*)(pb + lane * 4) = (f32x4){pv[0], pv[1], pv[2], pv[3]};
    WAVE_SYNC();
#pragma unroll 4
    for (int k = 0; k < 64; ++k) {
        int rk = row0 + k; rk = rk < 0 ? 0 : (rk > maxrow ? maxrow : rk);
        const float vv = bf2f(Vb[(size_t)rk * 64 + lane]);
        const f32x4 pk = *(const f32x4*)(pb + k * 4);
        st.o[0] += pk[0] * vv; st.o[1] += pk[1] * vv; st.o[2] += pk[2] * vv; st.o[3] += pk[3] * vv;
    }
    WAVE_SYNC();
}
__device__ __forceinline__ void phase8(const Params& p, unsigned char* smem) {
    const int tid = threadIdx.x, lane = tid & 63, wid = tid >> 6;
    unsigned char* blut = smem;
    float* tblall = (float*)(smem + 1024);
    float* wbase = (float*)(smem + 2048 + wid * 10240);
    float* qs = wbase;
    float* sc = wbase + 256;
    float* pb = wbase + 256 + 2048;
    for (int i = tid; i < 1024; i += NT) blut[i] = (unsigned char)rel_bucket_dev(i);
    { const int hq = tid >> 5, bk = tid & 31; tblall[hq * 32 + bk] = p.in[2][bk * 8 + hq]; }
    __syncthreads();
    const bf16_t* KVb = (const bf16_t*)(p.ws + O_KV);
#pragma unroll 1
    for (int item = blockIdx.x; item < 8 * 2048; item += gridDim.x) {
        const int bg = item >> 11, t = ((item & 2047) << 2) + wid, b = bg >> 1, g = bg & 1, token = b * SEQ + t;
        const float* tbl = tblall + g * 4 * 32;
        { const bf16_t* qp = (const bf16_t*)(p.ws + O_Q) + (size_t)token * 512 + g * 256;
#pragma unroll
          for (int h = 0; h < 4; ++h) qs[h * 64 + lane] = bf2f(qp[h * 64 + lane]) * 0.125f; }
        WAVE_SYNC();
        const int ncnt = t >= 31 ? ((t - 31) >> 4) + 1 : 0;
        const int cur = t >> 6;
        const float* gn = (const float*)(p.ws + O_GN) + (size_t)token * 24 + g * 12;
        float of[4] = {0.f, 0.f, 0.f, 0.f};
        unsigned long long mlo = 0ull, mhi = 0ull;
        AttState st;
#pragma unroll 1
        for (int stage = 0; stage < 3; ++stage) {
            const bf16_t *Kb, *Vb; int nb, maxrow;
            if (stage == 0) {
                Kb = (const bf16_t*)(p.ws + O_KC) + (size_t)(0 * 4096 + bg * 512) * 64;
                Vb = (const bf16_t*)(p.ws + O_KC) + (size_t)(1 * 4096 + bg * 512) * 64;
                nb = (ncnt + 63) >> 6; maxrow = 510;
            } else {
                if (stage == 1) {
                    if (cur < 16) { mlo = (1ull << (cur + 1)) - 1ull; mhi = 0ull; }
                    else {
                        float il[4];
#pragma unroll
                        for (int h = 0; h < 4; ++h) il[h] = 1.f / st.l[h];
                        float imp[2];
#pragma unroll
                        for (int w = 0; w < 2; ++w) {
                            const int j = lane + 64 * w;
                            float a = -1.f;
                            if (j >= 1 && j <= cur - 2) {
                                a = 0.f;
#pragma unroll
                                for (int dn = -1; dn <= 3; ++dn) { const int n = 4 * j + dn;
                                    if (n < ncnt) {
#pragma unroll
                                        for (int h = 0; h < 4; ++h) a += __expf(sc[h * 512 + n] - st.m[h]) * il[h]; } }
                            }
                            imp[w] = a;
                        }
                        mlo = 1ull; mhi = 0ull;
                        { const int j1 = cur, j2 = cur - 1;
                          if (j1 < 64) mlo |= 1ull << j1; else mhi |= 1ull << (j1 - 64);
                          if (j2 < 64) mlo |= 1ull << j2; else mhi |= 1ull << (j2 - 64); }
#pragma unroll 1
                        for (int round = 0; round < 13; ++round) {
                            float bs; int bj;
                            if (imp[0] >= imp[1]) { bs = imp[0]; bj = lane; } else { bs = imp[1]; bj = lane + 64; }
#pragma unroll
                            for (int o = 1; o < 64; o <<= 1) { const float os = __shfl_xor(bs, o); const int oj = __shfl_xor(bj, o); if (os > bs || (os == bs && oj < bj)) { bs = os; bj = oj; } }
                            if (bj < 64) mlo |= 1ull << bj; else mhi |= 1ull << (bj - 64);
                            if (bj == lane) imp[0] = -2.f;
                            if (bj == lane + 64) imp[1] = -2.f;
                        }
                    }
                }
                const int j6 = stage == 1 ? 2 : 4;
                Kb = KVb + (size_t)((j6 * 4 + b) * 2 + g) * KV_SLAB;
                Vb = KVb + (size_t)(((j6 + 1) * 4 + b) * 2 + g) * KV_SLAB;
                nb = stage == 1 ? cur + 1 : 8; maxrow = SEQ - 1;
            }
            if (stage > 0) {
#pragma unroll
                for (int h = 0; h < 4; ++h) of[h] += gn[h * 3 + stage - 1] * (st.l[h] > 0.f ? st.o[h] / st.l[h] : 0.f);
            }
#pragma unroll
            for (int h = 0; h < 4; ++h) { st.m[h] = -INFINITY; st.l[h] = 0.f; st.o[h] = 0.f; }
#pragma unroll 1
            for (int blk = 0; blk < nb; ++blk) {
                if (stage == 1) { const bool on = blk < 64 ? ((mlo >> blk) & 1ull) : ((mhi >> (blk - 64)) & 1ull); if (!on) continue; }
                const int row0 = stage == 2 ? t - 511 + blk * 64 : blk * 64;
                attn_block(st, stage == 0, row0, t, ncnt, maxrow, Kb, Vb, qs, sc, pb, blut, tbl, lane);
            }
        }
        { bf16_t* op = (bf16_t*)(p.ws + O_ONSA) + (size_t)token * 512 + g * 256;
#pragma unroll
          for (int h = 0; h < 4; ++h) {
              const float o = of[h] + gn[h * 3 + 2] * (st.l[h] > 0.f ? st.o[h] / st.l[h] : 0.f);
              op[h * 64 + lane] = f2bf(o);
          } }
        WAVE_SYNC();
    }
    __syncthreads();
}

struct EpiNsa { const bf16_t* SGN; bf16_t* MS5; int pm, pn;
    __device__ __forceinline__ void operator()(f32x4 (&acc)[4][4], int wr, int wc, int fr, int fq) const {
#pragma unroll
        for (int m = 0; m < 4; ++m) {
            const int token = pm * 128 + wr * 64 + m * 16 + fr;
#pragma unroll
            for (int n = 0; n < 4; ++n) {
                const int col = pn * 128 + wc * 64 + n * 16 + fq * 4;
                const u32x2 sg = *(const u32x2*)(SGN + (size_t)token * 1024 + col);
                const u32x2 ms = *(const u32x2*)(MS5 + (size_t)token * 1024 + col);
                const f32x4 v = acc[m][n];
                *(u32x2*)(MS5 + (size_t)token * 1024 + col) = (u32x2){pk2(bflo(ms.x) + bflo(sg.x) * v[0], bfhi(ms.x) + bfhi(sg.x) * v[1]), pk2(bflo(ms.y) + bflo(sg.y) * v[2], bfhi(ms.y) + bfhi(sg.y) * v[3])};
            }
        }
    } };
__device__ __forceinline__ void phase9(const Params& p, unsigned char* smem) {
    for (int item = blockIdx.x; item < 256 * 8; item += gridDim.x) {
        const int pm = item >> 3, pn = item & 7;
        LoadBf16 al{(const bf16_t*)(p.ws + O_ONSA) + (size_t)pm * 128 * 512, 512};
        LoadBf16 bl{(const bf16_t*)(p.ws + O_WT_NSA) + (size_t)pn * 128 * 512, 512};
        EpiNsa ep{(const bf16_t*)(p.ws + O_SGN), (bf16_t*)(p.ws + O_MS5), pm, pn};
        gemm_tile(8, al, bl, ep, smem);
    }
}
struct EpiOut { const float* x; const float* ga; float* Z1; int pm, pn;
    __device__ __forceinline__ void operator()(f32x4 (&acc)[4][4], int wr, int wc, int fr, int fq) const {
#pragma unroll
        for (int m = 0; m < 4; ++m) {
            const int token = pm * 128 + wr * 64 + m * 16 + fr;
#pragma unroll
            for (int n = 0; n < 4; ++n) {
                const int col = pn * 128 + wc * 64 + n * 16 + fq * 4;
                const f32x4 xv = *(const f32x4*)(x + (size_t)token * 1024 + col), gv = *(const f32x4*)(ga + col);
                *(f32x4*)(Z1 + (size_t)token * 1024 + col) = xv * DN_ALPHA + gv * acc[m][n];
            }
        }
    } };
__device__ __forceinline__ void phase10(const Params& p, unsigned char* smem) {
    for (int item = blockIdx.x; item < 256 * 8; item += gridDim.x) {
        const int pm = item >> 3, pn = item & 7, b = pm >> 6;
        LoadBf16 al{(const bf16_t*)(p.ws + O_MS5) + (size_t)pm * 128 * 1024, 1024};
        LoadBf16 bl{(const bf16_t*)(p.ws + O_WT_OUT) + (size_t)pn * 128 * 1024, 1024};
        EpiOut ep{p.in[0], (const float*)(p.ws + O_ADA) + b * 6144 + 2048, (float*)(p.ws + O_Z1), pm, pn};
        gemm_tile(16, al, bl, ep, smem);
    }
}

__device__ __forceinline__ void phase11(const Params& p, unsigned char* smem) {
    const int tid = threadIdx.x, lane = tid & 63, wid = tid >> 6;
    float* hs = (float*)smem + wid * 1024;
    const float* lg = p.in[24]; const float* lb = p.in[25]; const float* wr_ = p.in[26]; const float* br_ = p.in[27];
    unsigned* cnt = (unsigned*)(p.ws + O_CNT);
    for (int item = blockIdx.x; item < NTOK / 4; item += gridDim.x) {
        const int token = item * 4 + wid, b = token >> 13;
        float* zr = (float*)(p.ws + O_Z1) + (size_t)token * 1024;
        const float* ada = (const float*)(p.ws + O_ADA) + b * 6144;
        f32x4 v[4]; float s = 0.f;
#pragma unroll
        for (int j = 0; j < 4; ++j) { v[j] = *(const f32x4*)(zr + j * 256 + lane * 4); s += (v[j][0] + v[j][1]) + (v[j][2] + v[j][3]); }
        const float mean = wave_sum(s) * (1.f / 1024.f); float q = 0.f;
#pragma unroll
        for (int j = 0; j < 4; ++j) { v[j] = v[j] - mean; q += (v[j][0] * v[j][0] + v[j][1] * v[j][1]) + (v[j][2] * v[j][2] + v[j][3] * v[j][3]); }
        const float rstd = rsqrtf(wave_sum(q) * (1.f / 1024.f) + LN_EPS);
        bf16_t* h2 = (bf16_t*)(p.ws + O_H2) + (size_t)token * 1024;
#pragma unroll
        for (int j = 0; j < 4; ++j) {
            const int c = j * 256 + lane * 4;
            const f32x4 x1 = v[j] * rstd * *(const f32x4*)(lg + c) + *(const f32x4*)(lb + c);
            *(f32x4*)(zr + c) = x1;
            const f32x4 hv = x1 * (*(const f32x4*)(ada + 4096 + c) + 1.f) + *(const f32x4*)(ada + 3072 + c);
            *(f32x4*)(hs + c) = hv;
            *(u32x2*)(h2 + c) = (u32x2){pk2(hv[0], hv[1]), pk2(hv[2], hv[3])};
        }
        WAVE_SYNC();
        const int e = lane & 31, kh = lane >> 5;
        float a = 0.f;
#pragma unroll 8
        for (int k = kh * 512; k < kh * 512 + 512; ++k) a += hs[k] * wr_[k * 32 + e];
        a += __shfl_xor(a, 32);
        a += br_[e];
        float val = a; int te[4]; float tv[4];
#pragma unroll
        for (int r = 0; r < 4; ++r) {
            float bs = val; int bj = e;
#pragma unroll
            for (int o = 1; o < 32; o <<= 1) { const float os = __shfl_xor(bs, o); const int oj = __shfl_xor(bj, o); if (os > bs || (os == bs && oj < bj)) { bs = os; bj = oj; } }
            te[r] = bj; tv[r] = bs;
            if (e == bj) val = -INFINITY;
        }
        const float e0 = 1.f, e1 = __expf(tv[1] - tv[0]), e2 = __expf(tv[2] - tv[0]), e3 = __expf(tv[3] - tv[0]);
        const float inv = 1.f / (e0 + e1 + e2 + e3);
        if (lane < 4) {
            const int ee = lane == 0 ? te[0] : (lane == 1 ? te[1] : (lane == 2 ? te[2] : te[3]));
            const float gg = (lane == 0 ? e0 : (lane == 1 ? e1 : (lane == 2 ? e2 : e3))) * inv;
            const unsigned pos = atomicAdd(cnt + ee, 1u);
            ((int*)(p.ws + O_TOPE))[token * 4 + lane] = ee;
            ((unsigned*)(p.ws + O_TOPP))[token * 4 + lane] = pos;
            ((float*)(p.ws + O_TOPG))[token * 4 + lane] = gg;
        }
        WAVE_SYNC();
    }
}

__device__ __forceinline__ void load_offsets(const Params& p, int* offs  , int* toff  ) {
    if (threadIdx.x == 0) {
        const unsigned* cnt = (const unsigned*)(p.ws + O_CNT);
        int a = 0, t = 0;
        for (int e = 0; e < 32; ++e) { offs[e] = a; toff[e] = t; const int c = (int)cnt[e]; a += c; t += (c + 127) >> 7; }
        offs[32] = a; toff[32] = t;
    }
    __syncthreads();
}
__device__ __forceinline__ void phase12(const Params& p, unsigned char* smem) {
    int* offs = (int*)smem; int* toff = offs + 40;
    load_offsets(p, offs, toff);
    const int* tope = (const int*)(p.ws + O_TOPE); const unsigned* topp = (const unsigned*)(p.ws + O_TOPP); const float* topg = (const float*)(p.ws + O_TOPG);
    int* rowtok = (int*)(p.ws + O_ROWTOK); float* rowgate = (float*)(p.ws + O_ROWGATE); int* tokrow = (int*)(p.ws + O_TOKROW);
    for (int i = blockIdx.x * NT + threadIdx.x; i < NROWS; i += gridDim.x * NT) {
        const int R = offs[tope[i]] + (int)topp[i];
        rowtok[R] = i >> 2; rowgate[R] = topg[i]; tokrow[i] = R;
    }
    __syncthreads();
}

struct LoadGather { const bf16_t* rp[4]; __device__ __forceinline__ u32x4 operator()(int i, int, int k) const { return *(const u32x4*)(rp[i] + k); } };
struct EpiGU { const float* bgu; bf16_t* ACT; int R0, nvalid, pn;
    __device__ __forceinline__ void operator()(f32x4 (&acc)[4][4], int wr, int wc, int fr, int fq) const {
#pragma unroll
        for (int m = 0; m < 4; ++m) {
            const int lr = wr * 64 + m * 16 + fr;
            if (lr < nvalid) {
#pragma unroll
                for (int n = 0; n < 2; ++n) {
                    const int cv = pn * 64 + wc * 32 + n * 16 + fq * 4;
                    const f32x4 ga = acc[m][n] + *(const f32x4*)(bgu + cv), ua = acc[m][n + 2] + *(const f32x4*)(bgu + 1024 + cv);
                    float o[4];
#pragma unroll
                    for (int j = 0; j < 4; ++j) { const float gt = fminf(ga[j], 7.f), up = fminf(fmaxf(ua[j], -7.f), 7.f); o[j] = (up + 1.f) * gt * sigmoidf_(1.702f * gt); }
                    *(u32x2*)(ACT + (size_t)(R0 + lr) * 1024 + cv) = (u32x2){pk2(o[0], o[1]), pk2(o[2], o[3])};
                }
            }
        }
    } };
__device__ __forceinline__ void phase13(const Params& p, unsigned char* smem) {
    int* offs = (int*)(smem + 40960); int* toff = offs + 40;
    load_offsets(p, offs, toff);
    const int ntile = toff[32];
    const int* rowtok = (const int*)(p.ws + O_ROWTOK);
    const int tid = threadIdx.x, prow = tid >> 3;
    for (int item = blockIdx.x; item < ntile * 16; item += gridDim.x) {
        const int tile = item >> 4, pn = item & 15;
        int e = 0;
#pragma unroll 1
        while (toff[e + 1] <= tile) ++e;
        const int mt = tile - toff[e], R0 = offs[e] + mt * 128, nvalid = offs[e + 1] - R0;
        LoadGather al;
#pragma unroll
        for (int i = 0; i < 4; ++i) { int R = R0 + prow + i * 32; R = R < NROWS ? R : NROWS - 1; al.rp[i] = (const bf16_t*)(p.ws + O_H2) + (size_t)rowtok[R] * 1024; }
        LoadBf16 bl{(const bf16_t*)(p.ws + O_WT_GU) + ((size_t)e * 2048 + pn * 128) * 1024, 1024};
        EpiGU ep{p.in[29] + (size_t)e * 2048, (bf16_t*)(p.ws + O_ACT), R0, nvalid, pn};
        gemm_tile(16, al, bl, ep, smem);
    }
    __syncthreads();
}
struct EpiDn { const float* bd; const float* rowgate; bf16_t* YK; int R0, nvalid, pn;
    __device__ __forceinline__ void operator()(f32x4 (&acc)[4][4], int wr, int wc, int fr, int fq) const {
#pragma unroll
        for (int m = 0; m < 4; ++m) {
            const int lr = wr * 64 + m * 16 + fr;
            if (lr < nvalid) {
                const float gw = rowgate[R0 + lr];
#pragma unroll
                for (int n = 0; n < 4; ++n) {
                    const int col = pn * 128 + wc * 64 + n * 16 + fq * 4;
                    const f32x4 v = (acc[m][n] + *(const f32x4*)(bd + col)) * gw;
                    *(u32x2*)(YK + (size_t)(R0 + lr) * 1024 + col) = (u32x2){pk2(v[0], v[1]), pk2(v[2], v[3])};
                }
            }
        }
    } };
__device__ __forceinline__ void phase14(const Params& p, unsigned char* smem) {
    int* offs = (int*)(smem + 40960); int* toff = offs + 40;
    load_offsets(p, offs, toff);
    const int ntile = toff[32];
    for (int item = blockIdx.x; item < ntile * 8; item += gridDim.x) {
        const int tile = item >> 3, pn = item & 7;
        int e = 0;
#pragma unroll 1
        while (toff[e + 1] <= tile) ++e;
        const int mt = tile - toff[e], R0 = offs[e] + mt * 128, nvalid = offs[e + 1] - R0;
        LoadBf16 al{(const bf16_t*)(p.ws + O_ACT) + (size_t)R0 * 1024, 1024};
        LoadBf16 bl{(const bf16_t*)(p.ws + O_WT_DN) + ((size_t)e * 1024 + pn * 128) * 1024, 1024};
        EpiDn ep{p.in[31] + (size_t)e * 1024, (const float*)(p.ws + O_ROWGATE), (bf16_t*)(p.ws + O_YK), R0, nvalid, pn};
        gemm_tile(16, al, bl, ep, smem);
    }
    __syncthreads();
}

__device__ __forceinline__ void phase15(const Params& p, unsigned char*) {
    const int tid = threadIdx.x, lane = tid & 63, wid = tid >> 6;
    const float* lg = p.in[32]; const float* lb = p.in[33];
    const int* tokrow = (const int*)(p.ws + O_TOKROW);
    const bf16_t* YK = (const bf16_t*)(p.ws + O_YK);
    for (int item = blockIdx.x; item < NTOK / 4; item += gridDim.x) {
        const int token = item * 4 + wid, b = token >> 13;
        const float* x1 = (const float*)(p.ws + O_Z1) + (size_t)token * 1024;
        const float* gf = (const float*)(p.ws + O_ADA) + b * 6144 + 5120;
        const int r0 = tokrow[token * 4 + 0], r1 = tokrow[token * 4 + 1], r2 = tokrow[token * 4 + 2], r3 = tokrow[token * 4 + 3];
        f32x4 v[4]; float s = 0.f;
#pragma unroll
        for (int j = 0; j < 4; ++j) {
            const int c = j * 256 + lane * 4;
            const u32x2 a0 = *(const u32x2*)(YK + (size_t)r0 * 1024 + c), a1 = *(const u32x2*)(YK + (size_t)r1 * 1024 + c), a2 = *(const u32x2*)(YK + (size_t)r2 * 1024 + c), a3 = *(const u32x2*)(YK + (size_t)r3 * 1024 + c);
            f32x4 y;
            y[0] = (bflo(a0.x) + bflo(a1.x)) + (bflo(a2.x) + bflo(a3.x)); y[1] = (bfhi(a0.x) + bfhi(a1.x)) + (bfhi(a2.x) + bfhi(a3.x));
            y[2] = (bflo(a0.y) + bflo(a1.y)) + (bflo(a2.y) + bflo(a3.y)); y[3] = (bfhi(a0.y) + bfhi(a1.y)) + (bfhi(a2.y) + bfhi(a3.y));
            v[j] = *(const f32x4*)(x1 + c) * DN_ALPHA + *(const f32x4*)(gf + c) * y;
            s += (v[j][0] + v[j][1]) + (v[j][2] + v[j][3]);
        }
        const float mean = wave_sum(s) * (1.f / 1024.f); float q = 0.f;
#pragma unroll
        for (int j = 0; j < 4; ++j) { v[j] = v[j] - mean; q += (v[j][0] * v[j][0] + v[j][1] * v[j][1]) + (v[j][2] * v[j][2] + v[j][3] * v[j][3]); }
        const float rstd = rsqrtf(wave_sum(q) * (1.f / 1024.f) + LN_EPS);
#pragma unroll
        for (int j = 0; j < 4; ++j) { const int c = j * 256 + lane * 4; *(f32x4*)(p.out + (size_t)token * 1024 + c) = v[j] * rstd * *(const f32x4*)(lg + c) + *(const f32x4*)(lb + c); }
    }
}

template <bool COOP>
__global__ void __launch_bounds__(NT, 2) fwd_kernel(Params p) {
    __shared__ __attribute__((aligned(16))) unsigned char smem[SMEM_BYTES];
    const int lo = p.ph_lo, hi = p.ph_hi;
#define RUN_PHASE(k) if (((PH_MASK >> (k)) & 1) && lo <= (k) && (k) < hi) { phase##k(p, smem); } if (COOP) { if (lo <= (k) && (k) + 1 < hi) cg::this_grid().sync(); }
    RUN_PHASE(0)
    RUN_PHASE(1)
    RUN_PHASE(2)
    RUN_PHASE(3)
    RUN_PHASE(4)
    RUN_PHASE(5)
    RUN_PHASE(6)
    RUN_PHASE(7)
    RUN_PHASE(8)
    RUN_PHASE(9)
    RUN_PHASE(10)
    RUN_PHASE(11)
    RUN_PHASE(12)
    RUN_PHASE(13)
    RUN_PHASE(14)
    RUN_PHASE(15)
#undef RUN_PHASE
}

extern "C" void kernel_launch(void* const* d_in, const int* in_sizes, int n_in, void* d_out, int out_size, void* d_ws, size_t ws_size, hipStream_t stream) {
    static int grid = 0;
    if (grid == 0) {
        if (n_in != 34 || out_size != NTOK * DM || ws_size < WS_NEED) { fprintf(stderr, "kernel_launch: unexpected problem (n_in %d, out %d, ws %zu need %zu)\n", n_in, out_size, ws_size, (size_t)WS_NEED); grid = -1; return; }
        int dev = 0, cus = 0, per_cu = 0;
        hipGetDevice(&dev);
        hipDeviceGetAttribute(&cus, hipDeviceAttributeMultiprocessorCount, dev);
#if ONE_LAUNCH
        hipOccupancyMaxActiveBlocksPerMultiprocessor(&per_cu, fwd_kernel<true>, NT, 0);
#else
        hipOccupancyMaxActiveBlocksPerMultiprocessor(&per_cu, fwd_kernel<false>, NT, 0);
#endif
        if (per_cu < 1) per_cu = 1;
        grid = cus * per_cu;
        fprintf(stderr, "kernel_launch: grid %d (%d CUs x %d)\n", grid, cus, per_cu);
    }
    if (grid < 0) return;
    Params p{};
    for (int i = 0; i < 34; ++i) p.in[i] = (const float*)d_in[i];
    p.out = (float*)d_out; p.ws = (unsigned char*)d_ws;
#if ONE_LAUNCH
    p.ph_lo = 0; p.ph_hi = NPHASE;
    void* args[] = {&p};
    hipError_t e = hipLaunchCooperativeKernel((void*)fwd_kernel<true>, dim3(grid), dim3(NT), args, 0, stream);
    if (e != hipSuccess) fprintf(stderr, "cooperative launch failed: %s (grid %d)\n", hipGetErrorString(e), grid);
#else
    for (int ph = 0; ph < NPHASE; ++ph) {
        p.ph_lo = ph; p.ph_hi = ph + 1;
        hipLaunchKernelGGL(fwd_kernel<false>, dim3(grid), dim3(NT), 0, stream, p);
    }
#endif
}
static_assert(WS_NEED <= (size_t)1073741824, "workspace map exceeds 1 GiB");
```

```cpp
#include <hip/hip_runtime.h>
#include <hip/hip_cooperative_groups.h>
#include <cstdio>
#include <cstdint>
namespace cg = cooperative_groups;

#ifndef PH_MASK
#define PH_MASK 0xFFFF
#endif
#ifndef ONE_LAUNCH
#define ONE_LAUNCH 1
#endif

typedef unsigned short bf16_t;
typedef short bf16x8 __attribute__((ext_vector_type(8)));
typedef float f32x4 __attribute__((ext_vector_type(4)));
typedef float f32x2 __attribute__((ext_vector_type(2)));
typedef unsigned u32x4 __attribute__((ext_vector_type(4)));
typedef unsigned u32x2 __attribute__((ext_vector_type(2)));
typedef __bf16 bf16x2_t __attribute__((ext_vector_type(2)));

constexpr int NB = 4, SEQ = 8192, NTOK = NB * SEQ, DM = 1024;
constexpr int NIN_PAD = 3968;
constexpr int NEXP = 32, TOPK = 4, NROWS = NTOK * TOPK;
constexpr int S5L = 32;
constexpr int NCHUNK = SEQ / S5L;
constexpr int UROW = 640;
constexpr float DN_ALPHA = 1.189207115002721f;
constexpr float LN_EPS = 1e-5f;
constexpr int NT = 256;

constexpr size_t al256(size_t x) { return (x + 255) & ~(size_t)255; }
constexpr size_t O_ADA = 0;
constexpr size_t O_CNT = O_ADA + al256(4 * 6144 * 4);
constexpr size_t O_LAML = O_CNT + 1024;
constexpr size_t O_BIAS1 = O_LAML + al256(32 * 64 * 2 * 4);
constexpr size_t O_WT_IN = O_BIAS1 + al256(2 * 8 * 128 * 4);
constexpr size_t O_WT_GLU = O_WT_IN + al256((size_t)NIN_PAD * 1024 * 2);
constexpr size_t O_WT_NSA = O_WT_GLU + al256((size_t)2048 * 512 * 2);
constexpr size_t O_WT_OUT = O_WT_NSA + al256((size_t)1024 * 512 * 2);
constexpr size_t O_WT_C1 = O_WT_OUT + al256((size_t)1024 * 1024 * 2);
constexpr size_t O_W1T = O_WT_C1 + al256((size_t)2 * 128 * 2048 * 2);
constexpr size_t O_TW2 = O_W1T + al256((size_t)32 * 128 * 512 * 2);
constexpr size_t O_WT_GU = O_TW2 + al256((size_t)32 * 512 * 640 * 2);
constexpr size_t O_WT_DN = O_WT_GU + al256((size_t)32 * 2048 * 1024 * 2);
constexpr size_t O_H2 = O_WT_DN + al256((size_t)32 * 1024 * 1024 * 2);
constexpr size_t O_Z1 = O_H2 + al256((size_t)NTOK * 1024 * 2);
constexpr size_t O_TOPE = O_Z1 + al256((size_t)NTOK * 1024 * 4);
constexpr size_t O_TOPP = O_TOPE + al256((size_t)NROWS * 4);
constexpr size_t O_TOPG = O_TOPP + al256((size_t)NROWS * 4);
constexpr size_t O_ROWTOK = O_TOPG + al256((size_t)NROWS * 4);
constexpr size_t O_ROWGATE = O_ROWTOK + al256((size_t)(NROWS + 256) * 4);
constexpr size_t O_TOKROW = O_ROWGATE + al256((size_t)(NROWS + 256) * 4);
constexpr size_t O_OVL = O_TOKROW + al256((size_t)NROWS * 4);
constexpr size_t O_U = O_OVL;
constexpr size_t O_E = O_U + al256((size_t)32 * 1024 * UROW * 2);
constexpr size_t O_YS = O_E + al256((size_t)32 * 1024 * 128 * 4);
constexpr size_t O_Q = O_YS + al256((size_t)NTOK * 512 * 2);
constexpr size_t O_KV = O_Q + al256((size_t)NTOK * 512 * 2);
constexpr size_t KV_SLAB = (size_t)SEQ * 64;
constexpr size_t O_SG5 = O_KV + al256((size_t)6 * 8 * KV_SLAB * 2 + 8192);
constexpr size_t O_SGN = O_SG5 + al256((size_t)NTOK * 1024 * 2);
constexpr size_t O_GN = O_SGN + al256((size_t)NTOK * 1024 * 2);
constexpr size_t O_MS5 = O_GN + al256((size_t)NTOK * 24 * 4);
constexpr size_t O_ONSA = O_MS5 + al256((size_t)NTOK * 1024 * 2);
constexpr size_t O_HC = O_ONSA + al256((size_t)NTOK * 512 * 2);
constexpr size_t O_KC = O_HC + al256((size_t)2 * 4096 * 128 * 2);
constexpr size_t O_END1 = O_KC + al256((size_t)2 * 4096 * 64 * 2);
constexpr size_t O_ACT = O_OVL;
constexpr size_t O_YK = O_ACT + al256((size_t)(NROWS + 128) * 1024 * 2);
constexpr size_t O_END2 = O_YK + al256((size_t)(NROWS + 128) * 1024 * 2);
constexpr size_t WS_NEED = O_END1 > O_END2 ? O_END1 : O_END2;

constexpr int SMEM_BYTES = 43008;
constexpr int NPHASE = 16;

struct Params {
    const float* in[34];
    float* out;
    unsigned char* ws;
    int ph_lo, ph_hi;
};

__device__ __forceinline__ unsigned pk2(float lo, float hi) { f32x2 v = {lo, hi}; bf16x2_t b = __builtin_convertvector(v, bf16x2_t); return __builtin_bit_cast(unsigned, b); }
__device__ __forceinline__ bf16_t f2bf(float f) { return (bf16_t)(pk2(f, 0.f) & 0xffffu); }
__device__ __forceinline__ float bf2f(bf16_t h) { return __uint_as_float(((unsigned)h) << 16); }
__device__ __forceinline__ float bflo(unsigned w) { return __uint_as_float(w << 16); }
__device__ __forceinline__ float bfhi(unsigned w) { return __uint_as_float(w & 0xffff0000u); }
__device__ __forceinline__ float sigmoidf_(float x) { return 1.f / (1.f + __expf(-x)); }
__device__ __forceinline__ float gelu_tanh(float x) { const float u = 0.7978845608028654f * (x + 0.044715f * x * x * x); const float e = __expf(2.f * u); return 0.5f * x * (2.f - 2.f / (e + 1.f)); }
__device__ __forceinline__ float wave_sum(float v) {
#pragma unroll
    for (int o = 1; o < 64; o <<= 1) v += __shfl_xor(v, o);
    return v;
}
__device__ __forceinline__ float wave_max(float v) {
#pragma unroll
    for (int o = 1; o < 64; o <<= 1) v = fmaxf(v, __shfl_xor(v, o));
    return v;
}
#define WAVE_SYNC() do { __builtin_amdgcn_fence(__ATOMIC_RELEASE, "wavefront"); __builtin_amdgcn_wave_barrier(); __builtin_amdgcn_fence(__ATOMIC_ACQUIRE, "wavefront"); } while (0)

constexpr int LROW = 72;
template <class AL, class BL, class EP>
__device__ __forceinline__ void gemm_tile(int nk, const AL& al, const BL& bl, const EP& ep, unsigned char* smem) {
    const int tid = threadIdx.x, lane = tid & 63, wid = tid >> 6, wr = wid >> 1, wc = wid & 1, fr = lane & 15, fq = lane >> 4;
    bf16_t* sA = (bf16_t*)smem; bf16_t* sB = sA + 128 * LROW;
    f32x4 acc[4][4];
#pragma unroll
    for (int m = 0; m < 4; ++m)
#pragma unroll
        for (int n = 0; n < 4; ++n) acc[m][n] = (f32x4){0.f, 0.f, 0.f, 0.f};
    u32x4 ra[4], rb[4];
    const int prow = tid >> 3, pk = (tid & 7) * 8;
#pragma unroll
    for (int i = 0; i < 4; ++i) { ra[i] = al(i, prow + i * 32, pk); rb[i] = bl(i, prow + i * 32, pk); }
    for (int kt = 0; kt < nk; ++kt) {
        __syncthreads();
#pragma unroll
        for (int i = 0; i < 4; ++i) {
            *(u32x4*)(sA + (prow + i * 32) * LROW + pk) = ra[i];
            *(u32x4*)(sB + (prow + i * 32) * LROW + pk) = rb[i];
        }
        __syncthreads();
        if (kt + 1 < nk) {
            const int k0 = (kt + 1) * 64 + pk;
#pragma unroll
            for (int i = 0; i < 4; ++i) { ra[i] = al(i, prow + i * 32, k0); rb[i] = bl(i, prow + i * 32, k0); }
        }
#pragma unroll
        for (int kk = 0; kk < 2; ++kk) {
            bf16x8 af[4], bfr[4];
#pragma unroll
            for (int m = 0; m < 4; ++m) af[m] = *(const bf16x8*)(sA + (wr * 64 + m * 16 + fr) * LROW + kk * 32 + fq * 8);
#pragma unroll
            for (int n = 0; n < 4; ++n) bfr[n] = *(const bf16x8*)(sB + (wc * 64 + n * 16 + fr) * LROW + kk * 32 + fq * 8);
#pragma unroll
            for (int m = 0; m < 4; ++m)
#pragma unroll
                for (int n = 0; n < 4; ++n) acc[m][n] = __builtin_amdgcn_mfma_f32_16x16x32_bf16(bfr[n], af[m], acc[m][n], 0, 0, 0);
        }
    }
    ep(acc, wr, wc, fr, fq);
    __syncthreads();
}

struct LoadBf16 {
    const bf16_t* base; long ld;
    __device__ __forceinline__ u32x4 operator()(int, int row, int k) const { return *(const u32x4*)(base + (long)row * ld + k); }
};

__device__ __forceinline__ int map_in(int n) { return n < 1792 ? n : (n < 3840 ? n + 24 : (n < 3864 ? 1792 + (n - 3840) : -1)); }
__device__ __forceinline__ int map_il32(int n) { const int b = n >> 5; return (b & 1) * 1024 + (b >> 1) * 32 + (n & 31); }

template <int MAP>
__device__ __forceinline__ void transpose_tile(const float* W, int K, int Nsrc, bf16_t* Wt, int kt, int ntile, unsigned char* smem) {
    float* t = (float*)smem;
    const int tid = threadIdx.x, k0 = kt * 64, n0 = ntile * 64;
    {
        const int n = tid & 63;
        const int nd = n0 + n;
        const int src = MAP == 0 ? nd : (MAP == 1 ? map_in(nd) : map_il32(nd));
#pragma unroll 4
        for (int i = 0; i < 16; ++i) { const int k = i * 4 + (tid >> 6); t[k * 65 + n] = (src >= 0) ? W[(size_t)(k0 + k) * Nsrc + src] : 0.f; }
    }
    __syncthreads();
    {
        const int n = tid >> 2, ks = (tid & 3) * 16;
        u32x4 o0, o1;
        o0.x = pk2(t[(ks + 0) * 65 + n], t[(ks + 1) * 65 + n]); o0.y = pk2(t[(ks + 2) * 65 + n], t[(ks + 3) * 65 + n]);
        o0.z = pk2(t[(ks + 4) * 65 + n], t[(ks + 5) * 65 + n]); o0.w = pk2(t[(ks + 6) * 65 + n], t[(ks + 7) * 65 + n]);
        o1.x = pk2(t[(ks + 8) * 65 + n], t[(ks + 9) * 65 + n]); o1.y = pk2(t[(ks + 10) * 65 + n], t[(ks + 11) * 65 + n]);
        o1.z = pk2(t[(ks + 12) * 65 + n], t[(ks + 13) * 65 + n]); o1.w = pk2(t[(ks + 14) * 65 + n], t[(ks + 15) * 65 + n]);
        bf16_t* d = Wt + (size_t)(n0 + n) * K + k0 + ks;
        *(u32x4*)d = o0; *(u32x4*)(d + 8) = o1;
    }
    __syncthreads();
}

__device__ __forceinline__ void phase0(const Params& p, unsigned char* smem) {
    unsigned char* ws = p.ws;
    const int tid = threadIdx.x;
    constexpr int I_ADA = 96;
    constexpr int T_IN = 16 * (NIN_PAD / 64), T_GLU = 8 * 32, T_NSA = 8 * 16, T_OUT = 16 * 16, T_C1 = 2 * 32 * 2, T_GU = 32 * 16 * 32, T_DN = 32 * 16 * 16;
    constexpr int I_TR = T_IN + T_GLU + T_NSA + T_OUT + T_C1 + T_GU + T_DN;
    constexpr int I_S5 = 32 * 33;
    constexpr int I_MISC = 17;
    constexpr int NITEM = I_ADA + I_TR + I_S5 + I_MISC;
    for (int item = blockIdx.x; item < NITEM; item += gridDim.x) {
        int r = item;
        if (r < I_ADA) {
            const float* c = p.in[1]; const float* w = p.in[3]; const float* bb = p.in[4];
            const int wid = tid >> 6, lane = tid & 63, j = r * 64 + lane;
            float a0 = 0.f, a1 = 0.f, a2 = 0.f, a3 = 0.f;
            for (int k = wid * 256; k < wid * 256 + 256; ++k) {
                const float wv = w[(size_t)k * 6144 + j];
                const float c0 = c[k], c1 = c[1024 + k], c2 = c[2048 + k], c3 = c[3072 + k];
                a0 += c0 * sigmoidf_(c0) * wv; a1 += c1 * sigmoidf_(c1) * wv; a2 += c2 * sigmoidf_(c2) * wv; a3 += c3 * sigmoidf_(c3) * wv;
            }
            float* red = (float*)smem;
            red[(wid * 4 + 0) * 64 + lane] = a0; red[(wid * 4 + 1) * 64 + lane] = a1; red[(wid * 4 + 2) * 64 + lane] = a2; red[(wid * 4 + 3) * 64 + lane] = a3;
            __syncthreads();
            { const int b = tid >> 6; const float s = red[(0 * 4 + b) * 64 + lane] + red[(1 * 4 + b) * 64 + lane] + red[(2 * 4 + b) * 64 + lane] + red[(3 * 4 + b) * 64 + lane];
              ((float*)(ws + O_ADA))[b * 6144 + j] = s + bb[j]; }
            __syncthreads();
            continue;
        }
        r -= I_ADA;
        if (r < I_TR) {
            if (r < T_IN) { transpose_tile<1>(p.in[5], 1024, 3864, (bf16_t*)(ws + O_WT_IN), r / (NIN_PAD / 64), r % (NIN_PAD / 64), smem); continue; } r -= T_IN;
            if (r < T_GLU) { transpose_tile<2>(p.in[14], 512, 2048, (bf16_t*)(ws + O_WT_GLU), r / 32, r % 32, smem); continue; } r -= T_GLU;
            if (r < T_NSA) { transpose_tile<0>(p.in[22], 512, 1024, (bf16_t*)(ws + O_WT_NSA), r / 16, r % 16, smem); continue; } r -= T_NSA;
            if (r < T_OUT) { transpose_tile<0>(p.in[23], 1024, 1024, (bf16_t*)(ws + O_WT_OUT), r / 16, r % 16, smem); continue; } r -= T_OUT;
            if (r < T_C1) { const int kv = r / 64, q = r % 64; transpose_tile<0>(p.in[kv ? 20 : 17], 2048, 128, (bf16_t*)(ws + O_WT_C1) + (size_t)kv * 128 * 2048, q / 2, q % 2, smem); continue; } r -= T_C1;
            if (r < T_GU) { const int e = r / 512, q = r % 512; transpose_tile<2>(p.in[28] + (size_t)e * 1024 * 2048, 1024, 2048, (bf16_t*)(ws + O_WT_GU) + (size_t)e * 2048 * 1024, q / 32, q % 32, smem); continue; } r -= T_GU;
            { const int e = r / 256, q = r % 256; transpose_tile<0>(p.in[30] + (size_t)e * 1024 * 1024, 1024, 1024, (bf16_t*)(ws + O_WT_DN) + (size_t)e * 1024 * 1024, q / 16, q % 16, smem); continue; }
        }
        r -= I_TR;
        if (r < I_S5) {
            const int g = r / 33, dl = r % 33;
            f32x2* pw = (f32x2*)smem;
            f32x2* bbv = pw + 64;
            f32x2* ccv = bbv + 1024;
            const float dt = expf(p.in[8][g]);
            if (tid < 64) {
                const int n = tid; const double re = p.in[6][g * 64 + n], im = p.in[7][g * 64 + n];
                const double mag = exp(re * (double)dt * dl), ang = im * (double)dt * dl;
                double sn, cs; sincos(ang, &sn, &cs);
                pw[n] = (f32x2){(float)(mag * cs), (float)(mag * sn)};
                if (dl == 32) { ((f32x2*)(ws + O_LAML))[g * 64 + n] = pw[n]; }
            }
            for (int e = tid; e < 1024; e += NT) {
                const int n = e >> 4, q = e & 15;
                const double re = p.in[6][g * 64 + n], im = p.in[7][g * 64 + n];
                const double mag = exp(re * (double)dt), ang = im * (double)dt;
                double sn, cs; sincos(ang, &sn, &cs);
                const double lr = mag * cs - 1.0, li = mag * sn;
                const double den = re * re + im * im;
                const double fr_ = (lr * re + li * im) / den, fi_ = (li * re - lr * im) / den;
                const double br = p.in[9][(g * 64 + n) * 16 + q], bi = p.in[10][(g * 64 + n) * 16 + q];
                bbv[e] = (f32x2){(float)(fr_ * br - fi_ * bi), (float)(fr_ * bi + fi_ * br)};
            }
            for (int e = tid; e < 1024; e += NT) { ccv[e] = (f32x2){p.in[11][g * 1024 + e], p.in[12][g * 1024 + e]}; }
            __syncthreads();
            bf16_t* TW2 = (bf16_t*)(ws + O_TW2) + (size_t)g * 512 * UROW;
            bf16_t* W1T = (bf16_t*)(ws + O_W1T) + (size_t)g * 128 * 512;
            if (dl < 32) {
                const int pp = tid >> 4, q = tid & 15;
                float acc = 0.f;
                for (int n = 0; n < 64; ++n) {
                    const f32x2 cv = ccv[pp * 64 + n], pv = pw[n], bv = bbv[n * 16 + q];
                    const float xr = cv.x * pv.x - cv.y * pv.y, xi = cv.x * pv.y + cv.y * pv.x;
                    acc += xr * bv.x - xi * bv.y;
                }
                if (dl == 0 && pp == q) acc += p.in[13][g * 16 + pp];
                const bf16_t kb = f2bf(acc);
                for (int tau = dl; tau < 32; ++tau) { const int s = tau - dl; TW2[(size_t)(tau * 16 + pp) * UROW + s * 16 + q] = kb; }
                if (dl >= 1) for (int s = dl; s < 32; ++s) { const int tau = s - dl; TW2[(size_t)(tau * 16 + pp) * UROW + s * 16 + q] = 0; }
                const int s = 31 - dl;
                for (int e = tid; e < 2048; e += NT) {
                    const int c = e >> 4, qq = e & 15, n = c & 63, ri = c >> 6;
                    const f32x2 pv = pw[n], bv = bbv[n * 16 + qq];
                    const float zr = pv.x * bv.x - pv.y * bv.y, zi = pv.x * bv.y + pv.y * bv.x;
                    W1T[(size_t)c * 512 + s * 16 + qq] = f2bf(ri ? zi : zr);
                }
            }
            if (dl >= 1) {
                const int tau = dl - 1;
                for (int e = tid; e < 2048; e += NT) {
                    const int pp = e >> 7, c = e & 127, n = c & 63, ri = c >> 6;
                    const f32x2 cv = ccv[pp * 64 + n], pv = pw[n];
                    const float xr = cv.x * pv.x - cv.y * pv.y, xi = cv.x * pv.y + cv.y * pv.x;
                    TW2[(size_t)(tau * 16 + pp) * UROW + 512 + c] = f2bf(ri ? -xi : xr);
                }
            }
            __syncthreads();
            continue;
        }
        r -= I_S5;
        if (r < 16) {
            const int kv = r >> 3, part = r & 7, j = tid & 127, half = tid >> 7;
            const float* pos = p.in[kv ? 19 : 16]; const float* w1 = p.in[kv ? 20 : 17];
            float a = 0.f;
            const int i0 = part * 256 + half * 128;
            for (int i = i0; i < i0 + 128; ++i) a += pos[i] * w1[(size_t)i * 128 + j];
            float* red = (float*)smem;
            red[tid] = a;
            __syncthreads();
            if (tid < 128) ((float*)(ws + O_BIAS1))[(kv * 8 + part) * 128 + tid] = red[tid] + red[tid + 128];
            __syncthreads();
            continue;
        }
        if (tid < 64) ((unsigned*)(ws + O_CNT))[tid] = 0u;
    }
}

struct LoadXMod {
    const float* x; const float* ada;
    __device__ __forceinline__ u32x4 operator()(int, int row, int k) const {
        const f32x4 x0 = *(const f32x4*)(x + (size_t)row * 1024 + k), x1 = *(const f32x4*)(x + (size_t)row * 1024 + k + 4);
        const f32x4 s0 = *(const f32x4*)(ada + 1024 + k), s1 = *(const f32x4*)(ada + 1024 + k + 4);
        const f32x4 h0 = *(const f32x4*)(ada + k), h1 = *(const f32x4*)(ada + k + 4);
        u32x4 o;
        o.x = pk2(x0[0] * (1.f + s0[0]) + h0[0], x0[1] * (1.f + s0[1]) + h0[1]); o.y = pk2(x0[2] * (1.f + s0[2]) + h0[2], x0[3] * (1.f + s0[3]) + h0[3]);
        o.z = pk2(x1[0] * (1.f + s1[0]) + h1[0], x1[1] * (1.f + s1[1]) + h1[1]); o.w = pk2(x1[2] * (1.f + s1[2]) + h1[2], x1[3] * (1.f + s1[3]) + h1[3]);
        return o;
    }
};
struct EpiIn {
    unsigned char* ws; int pm, pn;
    __device__ __forceinline__ void operator()(f32x4 (&acc)[4][4], int wr, int wc, int fr, int fq) const {
#pragma unroll
        for (int m = 0; m < 4; ++m) {
            const int token = pm * 128 + wr * 64 + m * 16 + fr;
#pragma unroll
            for (int n = 0; n < 4; ++n) {
                const int col = pn * 128 + wc * 64 + n * 16 + fq * 4;
                const f32x4 v = acc[m][n];
                if (pn < 4) {
                    const int g = col >> 4, q = col & 15;
                    bf16_t* d = (bf16_t*)(ws + O_U) + ((size_t)(g * 1024 + (token >> 5)) * UROW + (token & 31) * 16 + q);
                    *(u32x2*)d = (u32x2){pk2(v[0], v[1]), pk2(v[2], v[3])};
                } else if (pn < 8) {
                    bf16_t* d = (bf16_t*)(ws + O_Q) + (size_t)token * 512 + (col - 512);
                    *(u32x2*)d = (u32x2){pk2(v[0], v[1]), pk2(v[2], v[3])};
                } else if (pn < 14) {
                    const int c = col - 1024, j6 = c >> 7, g = (c >> 6) & 1, dd = c & 63, b = token >> 13, s = token & 8191;
                    bf16_t* d = (bf16_t*)(ws + O_KV) + ((size_t)((j6 * 4 + b) * 2 + g) * KV_SLAB + (size_t)s * 64 + dd);
                    *(u32x2*)d = (u32x2){pk2(v[0], v[1]), pk2(v[2], v[3])};
                } else if (pn < 22) {
                    bf16_t* d = (bf16_t*)(ws + O_SG5) + (size_t)token * 1024 + (col - 1792);
                    *(u32x2*)d = (u32x2){pk2(sigmoidf_(v[0]), sigmoidf_(v[1])), pk2(sigmoidf_(v[2]), sigmoidf_(v[3]))};
                } else if (pn < 30) {
                    bf16_t* d = (bf16_t*)(ws + O_SGN) + (size_t)token * 1024 + (col - 2816);
                    *(u32x2*)d = (u32x2){pk2(sigmoidf_(v[0]), sigmoidf_(v[1])), pk2(sigmoidf_(v[2]), sigmoidf_(v[3]))};
                } else {
                    const int c = col - 3840;
                    if (c < 24) { float* d = (float*)(ws + O_GN) + (size_t)token * 24 + c; *(f32x4*)d = (f32x4){sigmoidf_(v[0]), sigmoidf_(v[1]), sigmoidf_(v[2]), sigmoidf_(v[3])}; }
                }
            }
        }
    }
};
__device__ __forceinline__ void phase1(const Params& p, unsigned char* smem) {
    constexpr int NPN = NIN_PAD / 128;
    for (int item = blockIdx.x; item < 256 * NPN; item += gridDim.x) {
        const int pm = item / NPN, pn = item % NPN, b = pm >> 6;
        LoadXMod al{p.in[0] + (size_t)pm * 128 * 1024, (const float*)(p.ws + O_ADA) + b * 6144};
        LoadBf16 bl{(const bf16_t*)(p.ws + O_WT_IN) + (size_t)pn * 128 * 1024, 1024};
        EpiIn ep{p.ws, pm, pn};
        gemm_tile(16, al, bl, ep, smem);
    }
}

struct EpiE { float* E; __device__ __forceinline__ void operator()(f32x4 (&acc)[4][4], int wr, int wc, int fr, int fq) const {
#pragma unroll
    for (int m = 0; m < 4; ++m)
#pragma unroll
        for (int n = 0; n < 4; ++n) *(f32x4*)(E + (size_t)(wr * 64 + m * 16 + fr) * 128 + wc * 64 + n * 16 + fq * 4) = acc[m][n]; } };
__device__ __forceinline__ void phase2(const Params& p, unsigned char* smem) {
    for (int item = blockIdx.x; item < 32 * 8; item += gridDim.x) {
        const int g = item >> 3, pm = item & 7;
        LoadBf16 al{(const bf16_t*)(p.ws + O_U) + (size_t)(g * 1024 + pm * 128) * UROW, UROW};
        LoadBf16 bl{(const bf16_t*)(p.ws + O_W1T) + (size_t)g * 128 * 512, 512};
        EpiE ep{(float*)(p.ws + O_E) + (size_t)(g * 1024 + pm * 128) * 128};
        gemm_tile(8, al, bl, ep, smem);
    }
}
__device__ __forceinline__ void phase3(const Params& p, unsigned char*) {
    for (int item = blockIdx.x; item < 32; item += gridDim.x) {
        const int tid = threadIdx.x, n = tid & 63, bg = item * 4 + (tid >> 6), b = bg >> 5, g = bg & 31;
        const f32x2 lm = ((const f32x2*)(p.ws + O_LAML))[g * 64 + n];
        const float* E = (const float*)(p.ws + O_E) + (size_t)(g * 1024 + b * 256) * 128;
        bf16_t* U = (bf16_t*)(p.ws + O_U) + (size_t)(g * 1024 + b * 256) * UROW + 512;
        float hr = 0.f, hi = 0.f;
#pragma unroll 8
        for (int c = 0; c < NCHUNK; ++c) {
            const float er = E[(size_t)c * 128 + n], ei = E[(size_t)c * 128 + 64 + n];
            U[(size_t)c * UROW + n] = f2bf(hr); U[(size_t)c * UROW + 64 + n] = f2bf(hi);
            const float nr = lm.x * hr - lm.y * hi + er, ni = lm.x * hi + lm.y * hr + ei;
            hr = nr; hi = ni;
        }
    }
}
struct EpiY { bf16_t* YS; int g, pm, pn;
    __device__ __forceinline__ void operator()(f32x4 (&acc)[4][4], int wr, int wc, int fr, int fq) const {
#pragma unroll
        for (int m = 0; m < 4; ++m) {
            const int r = pm * 128 + wr * 64 + m * 16 + fr;
            const int tok0 = (r >> 8) * SEQ + (r & 255) * S5L;
#pragma unroll
            for (int n = 0; n < 4; ++n) {
                const int col = pn * 128 + wc * 64 + n * 16 + fq * 4, tau = col >> 4, pp = col & 15;
                const f32x4 v = acc[m][n];
                bf16_t* d = YS + (size_t)(tok0 + tau) * 512 + g * 16 + pp;
                *(u32x2*)d = (u32x2){pk2(gelu_tanh(v[0]), gelu_tanh(v[1])), pk2(gelu_tanh(v[2]), gelu_tanh(v[3]))};
            }
        }
    } };
__device__ __forceinline__ void phase4(const Params& p, unsigned char* smem) {
    for (int item = blockIdx.x; item < 32 * 8 * 4; item += gridDim.x) {
        const int g = item >> 5, pm = (item >> 2) & 7, pn = item & 3;
        LoadBf16 al{(const bf16_t*)(p.ws + O_U) + (size_t)(g * 1024 + pm * 128) * UROW, UROW};
        LoadBf16 bl{(const bf16_t*)(p.ws + O_TW2) + (size_t)(g * 512 + pn * 128) * UROW, UROW};
        EpiY ep{(bf16_t*)(p.ws + O_YS), g, pm, pn};
        gemm_tile(10, al, bl, ep, smem);
    }
}
struct EpiGlu { const float* bglu; const bf16_t* SG5; bf16_t* MS5; int pm, pn;
    __device__ __forceinline__ void operator()(f32x4 (&acc)[4][4], int wr, int wc, int fr, int fq) const {
#pragma unroll
        for (int m = 0; m < 4; ++m) {
            const int token = pm * 128 + wr * 64 + m * 16 + fr;
#pragma unroll
            for (int n = 0; n < 2; ++n) {
                const int cv = pn * 64 + wc * 32 + n * 16 + fq * 4;
                const f32x4 bv = *(const f32x4*)(bglu + cv), bg = *(const f32x4*)(bglu + 1024 + cv);
                const u32x2 sg = *(const u32x2*)(SG5 + (size_t)token * 1024 + cv);
                const f32x4 va = acc[m][n] + bv, ga = acc[m][n + 2] + bg;
                const float y0 = va[0] * sigmoidf_(ga[0]) * bflo(sg.x), y1 = va[1] * sigmoidf_(ga[1]) * bfhi(sg.x);
                const float y2 = va[2] * sigmoidf_(ga[2]) * bflo(sg.y), y3 = va[3] * sigmoidf_(ga[3]) * bfhi(sg.y);
                *(u32x2*)(MS5 + (size_t)token * 1024 + cv) = (u32x2){pk2(y0, y1), pk2(y2, y3)};
            }
        }
    } };
__device__ __forceinline__ void phase5(const Params& p, unsigned char* smem) {
    for (int item = blockIdx.x; item < 256 * 16; item += gridDim.x) {
        const int pm = item >> 4, pn = item & 15;
        LoadBf16 al{(const bf16_t*)(p.ws + O_YS) + (size_t)pm * 128 * 512, 512};
        LoadBf16 bl{(const bf16_t*)(p.ws + O_WT_GLU) + (size_t)pn * 128 * 512, 512};
        EpiGlu ep{p.in[15], (const bf16_t*)(p.ws + O_SG5), (bf16_t*)(p.ws + O_MS5), pm, pn};
        gemm_tile(8, al, bl, ep, smem);
    }
}

struct LoadCmp {
    const bf16_t* slab0; int R0;
    __device__ __forceinline__ u32x4 operator()(int, int row, int k) const { const int R = R0 + row; return *(const u32x4*)(slab0 + (size_t)(R >> 9) * KV_SLAB + (size_t)(R & 511) * 1024 + k); }
};
struct EpiCmp { const float* b1p; bf16_t* HC; int R0;
    __device__ __forceinline__ void operator()(f32x4 (&acc)[4][4], int wr, int wc, int fr, int fq) const {
#pragma unroll
        for (int n = 0; n < 4; ++n) {
            const int col = wc * 64 + n * 16 + fq * 4;
            f32x4 bs = (f32x4){0.f, 0.f, 0.f, 0.f};
#pragma unroll
            for (int part = 0; part < 8; ++part) bs += *(const f32x4*)(b1p + part * 128 + col);
#pragma unroll
            for (int m = 0; m < 4; ++m) {
                const int R = R0 + wr * 64 + m * 16 + fr;
                const f32x4 v = acc[m][n] + bs;
                *(u32x2*)(HC + (size_t)R * 128 + col) = (u32x2){pk2(gelu_tanh(v[0]), gelu_tanh(v[1])), pk2(gelu_tanh(v[2]), gelu_tanh(v[3]))};
            }
        }
    } };
__device__ __forceinline__ void phase6(const Params& p, unsigned char* smem) {
    for (int item = blockIdx.x; item < 64; item += gridDim.x) {
        const int kv = item >> 5, pm = item & 31;
        LoadCmp al{(const bf16_t*)(p.ws + O_KV) + (size_t)kv * 8 * KV_SLAB, pm * 128};
        LoadBf16 bl{(const bf16_t*)(p.ws + O_WT_C1) + (size_t)kv * 128 * 2048, 2048};
        EpiCmp ep{(const float*)(p.ws + O_BIAS1) + kv * 8 * 128, (bf16_t*)(p.ws + O_HC) + (size_t)kv * 4096 * 128, pm * 128};
        gemm_tile(32, al, bl, ep, smem);
    }
}
__device__ __forceinline__ void phase7(const Params& p, unsigned char*) {
    for (int item = blockIdx.x; item < 2048; item += gridDim.x) {
        const int o = item * NT + threadIdx.x, d = o & 63, R = (o >> 6) & 4095, kv = o >> 18;
        const bf16_t* h = (const bf16_t*)(p.ws + O_HC) + ((size_t)kv * 4096 + R) * 128;
        const float* w2 = p.in[kv ? 21 : 18];
        float a = 0.f;
#pragma unroll 8
        for (int j = 0; j < 128; ++j) a += bf2f(h[j]) * w2[j * 64 + d];
        ((bf16_t*)(p.ws + O_KC))[((size_t)kv * 4096 + R) * 64 + d] = f2bf(a);
    }
}

__device__ __forceinline__ int rel_bucket_dev(int dist) {
    const int n = dist > 0 ? dist : 0;
    if (n < 16) return n;
    const int l = (int)(__log2f((float)n * 0.0625f) * 2.6666667f);
    const int v = 16 + l;
    return v < 31 ? v : 31;
}
struct AttState { float m[4], l[4], o[4]; };
__device__ __forceinline__ void attn_block(AttState& st, bool cmp, int row0, int t, int ncnt, int maxrow, const bf16_t* Kb, const bf16_t* Vb,
                                           const float* qs, float* sc, float* pb, const unsigned char* blut, const float* tbl, int lane) {
    const int r = row0 + lane;
    bool valid; int dist;
    if (cmp) { valid = r < ncnt; dist = t - (16 * r + 31); }
    else { valid = (r >= 0) && (r <= t); dist = t - r; }
    if (!__any(valid)) return;
    const int rc = r < 0 ? 0 : (r > maxrow ? maxrow : r);
    const bf16_t* kp = Kb + (size_t)rc * 64;
    float s0 = 0.f, s1 = 0.f, s2 = 0.f, s3 = 0.f;
#pragma unroll 2
    for (int c = 0; c < 8; ++c) {
        const u32x4 kk = *(const u32x4*)(kp + c * 8);
        const float k0 = bflo(kk.x), k1 = bfhi(kk.x), k2 = bflo(kk.y), k3 = bfhi(kk.y), k4 = bflo(kk.z), k5 = bfhi(kk.z), k6 = bflo(kk.w), k7 = bfhi(kk.w);
#pragma unroll
        for (int h = 0; h < 4; ++h) {
            const f32x4 qa = *(const f32x4*)(qs + h * 64 + c * 8), qb = *(const f32x4*)(qs + h * 64 + c * 8 + 4);
            const float d = qa[0] * k0 + qa[1] * k1 + qa[2] * k2 + qa[3] * k3 + qb[0] * k4 + qb[1] * k5 + qb[2] * k6 + qb[3] * k7;
            if (h == 0) s0 += d; else if (h == 1) s1 += d; else if (h == 2) s2 += d; else s3 += d;
        }
    }
    const int dcl = dist < 0 ? 0 : dist;
    const int bk = dcl < 1024 ? (int)blut[dcl] : 31;
    float s[4] = {s0 + tbl[0 * 32 + bk], s1 + tbl[1 * 32 + bk], s2 + tbl[2 * 32 + bk], s3 + tbl[3 * 32 + bk]};
    float pv[4];
#pragma unroll
    for (int h = 0; h < 4; ++h) {
        if (!valid) s[h] = -INFINITY;
        if (cmp) sc[h * 512 + (r & 511)] = s[h];
        const float mb = wave_max(s[h]);
        const float mn = fmaxf(st.m[h], mb);
        const float corr = __expf(st.m[h] - mn);
        const float pe = valid ? __expf(s[h] - mn) : 0.f;
        st.l[h] = st.l[h] * corr + wave_sum(pe);
        st.o[h] *= corr; st.m[h] = mn; pv[h] = pe;
    }
    *(f32x4*)(pb + lane * 4) = (f32x4){pv[0], pv[1], pv[2], pv[3]};
    WAVE_SYNC();
#pragma unroll 4
    for (int k = 0; k < 64; ++k) {
        int rk = row0 + k; rk = rk < 0 ? 0 : (rk > maxrow ? maxrow : rk);
        const float vv = bf2f(Vb[(size_t)rk * 64 + lane]);
        const f32x4 pk = *(const f32x4*)(pb + k * 4);
        st.o[0] += pk[0] * vv; st.o[1] += pk[1] * vv; st.o[2] += pk[2] * vv; st.o[3] += pk[3] * vv;
    }
    WAVE_SYNC();
}
__device__ __forceinline__ void phase8(const Params& p, unsigned char* smem) {
    const int tid = threadIdx.x, lane = tid & 63, wid = tid >> 6;
    unsigned char* blut = smem;
    float* tblall = (float*)(smem + 1024);
    float* wbase = (float*)(smem + 2048 + wid * 10240);
    float* qs = wbase;
    float* sc = wbase + 256;
    float* pb = wbase + 256 + 2048;
    for (int i = tid; i < 1024; i += NT) blut[i] = (unsigned char)rel_bucket_dev(i);
    { const int hq = tid >> 5, bk = tid & 31; tblall[hq * 32 + bk] = p.in[2][bk * 8 + hq]; }
    __syncthreads();
    const bf16_t* KVb = (const bf16_t*)(p.ws + O_KV);
#pragma unroll 1
    for (int item = blockIdx.x; item < 8 * 2048; item += gridDim.x) {
        const int bg = item >> 11, t = ((item & 2047) << 2) + wid, b = bg >> 1, g = bg & 1, token = b * SEQ + t;
        const float* tbl = tblall + g * 4 * 32;
        { const bf16_t* qp = (const bf16_t*)(p.ws + O_Q) + (size_t)token * 512 + g * 256;
#pragma unroll
          for (int h = 0; h < 4; ++h) qs[h * 64 + lane] = bf2f(qp[h * 64 + lane]) * 0.125f; }
        WAVE_SYNC();
        const int ncnt = t >= 31 ? ((t - 31) >> 4) + 1 : 0;
        const int cur = t >> 6;
        const float* gn = (const float*)(p.ws + O_GN) + (size_t)token * 24 + g * 12;
        float of[4] = {0.f, 0.f, 0.f, 0.f};
        unsigned long long mlo = 0ull, mhi = 0ull;
        AttState st;
#pragma unroll 1
        for (int stage = 0; stage < 3; ++stage) {
            const bf16_t *Kb, *Vb; int nb, maxrow;
            if (stage == 0) {
                Kb = (const bf16_t*)(p.ws + O_KC) + (size_t)(0 * 4096 + bg * 512) * 64;
                Vb = (const bf16_t*)(p.ws + O_KC) + (size_t)(1 * 4096 + bg * 512) * 64;
                nb = (ncnt + 63) >> 6; maxrow = 510;
            } else {
                if (stage == 1) {
                    if (cur < 16) { mlo = (1ull << (cur + 1)) - 1ull; mhi = 0ull; }
                    else {
                        float il[4];
#pragma unroll
                        for (int h = 0; h < 4; ++h) il[h] = 1.f / st.l[h];
                        float imp[2];
#pragma unroll
                        for (int w = 0; w < 2; ++w) {
                            const int j = lane + 64 * w;
                            float a = -1.f;
                            if (j >= 1 && j <= cur - 2) {
                                a = 0.f;
#pragma unroll
                                for (int dn = -1; dn <= 3; ++dn) { const int n = 4 * j + dn;
                                    if (n < ncnt) {
#pragma unroll
                                        for (int h = 0; h < 4; ++h) a += __expf(sc[h * 512 + n] - st.m[h]) * il[h]; } }
                            }
                            imp[w] = a;
                        }
                        mlo = 1ull; mhi = 0ull;
                        { const int j1 = cur, j2 = cur - 1;
                          if (j1 < 64) mlo |= 1ull << j1; else mhi |= 1ull << (j1 - 64);
                          if (j2 < 64) mlo |= 1ull << j2; else mhi |= 1ull << (j2 - 64); }
#pragma unroll 1
                        for (int round = 0; round < 13; ++round) {
                            float bs; int bj;
                            if (imp[0] >= imp[1]) { bs = imp[0]; bj = lane; } else { bs = imp[1]; bj = lane + 64; }
#pragma unroll
                            for (int o = 1; o < 64; o <<= 1) { const float os = __shfl_xor(bs, o); const int oj = __shfl_xor(bj, o); if (os > bs || (os == bs && oj < bj)) { bs = os; bj = oj; } }
                            if (bj < 64) mlo |= 1ull << bj; else mhi |= 1ull << (bj - 64);
                            if (bj == lane) imp[0] = -2.f;
                            if (bj == lane + 64) imp[1] = -2.f;
                        }
                    }
                }
                const int j6 = stage == 1 ? 2 : 4;
                Kb = KVb + (size_t)((j6 * 4 + b) * 2 + g) * KV_SLAB;
                Vb = KVb + (size_t)(((j6 + 1) * 4 + b) * 2 + g) * KV_SLAB;
                nb = stage == 1 ? cur + 1 : 8; maxrow = SEQ - 1;
            }
            if (stage > 0) {
#pragma unroll
                for (int h = 0; h < 4; ++h) of[h] += gn[h * 3 + stage - 1] * (st.l[h] > 0.f ? st.o[h] / st.l[h] : 0.f);
            }
#pragma unroll
            for (int h = 0; h < 4; ++h) { st.m[h] = -INFINITY; st.l[h] = 0.f; st.o[h] = 0.f; }
#pragma unroll 1
            for (int blk = 0; blk < nb; ++blk) {
                if (stage == 1) { const bool on = blk < 64 ? ((mlo >> blk) & 1ull) : ((mhi >> (blk - 64)) & 1ull); if (!on) continue; }
                const int row0 = stage == 2 ? t - 511 + blk * 64 : blk * 64;
                attn_block(st, stage == 0, row0, t, ncnt, maxrow, Kb, Vb, qs, sc, pb, blut, tbl, lane);
            }
        }
        { bf16_t* op = (bf16_t*)(p.ws + O_ONSA) + (size_t)token * 512 + g * 256;
#pragma unroll
          for (int h = 0; h < 4; ++h) {
              const float o = of[h] + gn[h * 3 + 2] * (st.l[h] > 0.f ? st.o[h] / st.l[h] : 0.f);
              op[h * 64 + lane] = f2bf(o);
          } }
        WAVE_SYNC();
    }
    __syncthreads();
}

struct EpiNsa { const bf16_t* SGN; bf16_t* MS5; int pm, pn;
    __device__ __forceinline__ void operator()(f32x4 (&acc)[4][4], int wr, int wc, int fr, int fq) const {
#pragma unroll
        for (int m = 0; m < 4; ++m) {
            const int token = pm * 128 + wr * 64 + m * 16 + fr;
#pragma unroll
            for (int n = 0; n < 4; ++n) {
                const int col = pn * 128 + wc * 64 + n * 16 + fq * 4;
                const u32x2 sg = *(const u32x2*)(SGN + (size_t)token * 1024 + col);
                const u32x2 ms = *(const u32x2*)(MS5 + (size_t)token * 1024 + col);
                const f32x4 v = acc[m][n];
                *(u32x2*)(MS5 + (size_t)token * 1024 + col) = (u32x2){pk2(bflo(ms.x) + bflo(sg.x) * v[0], bfhi(ms.x) + bfhi(sg.x) * v[1]), pk2(bflo(ms.y) + bflo(sg.y) * v[2], bfhi(ms.y) + bfhi(sg.y) * v[3])};
            }
        }
    } };
__device__ __forceinline__ void phase9(const Params& p, unsigned char* smem) {
    for (int item = blockIdx.x; item < 256 * 8; item += gridDim.x) {
        const int pm = item >> 3, pn = item & 7;
        LoadBf16 al{(const bf16_t*)(p.ws + O_ONSA) + (size_t)pm * 128 * 512, 512};
        LoadBf16 bl{(const bf16_t*)(p.ws + O_WT_NSA) + (size_t)pn * 128 * 512, 512};
        EpiNsa ep{(const bf16_t*)(p.ws + O_SGN), (bf16_t*)(p.ws + O_MS5), pm, pn};
        gemm_tile(8, al, bl, ep, smem);
    }
}
struct EpiOut { const float* x; const float* ga; float* Z1; int pm, pn;
    __device__ __forceinline__ void operator()(f32x4 (&acc)[4][4], int wr, int wc, int fr, int fq) const {
#pragma unroll
        for (int m = 0; m < 4; ++m) {
            const int token = pm * 128 + wr * 64 + m * 16 + fr;
#pragma unroll
            for (int n = 0; n < 4; ++n) {
                const int col = pn * 128 + wc * 64 + n * 16 + fq * 4;
                const f32x4 xv = *(const f32x4*)(x + (size_t)token * 1024 + col), gv = *(const f32x4*)(ga + col);
                *(f32x4*)(Z1 + (size_t)token * 1024 + col) = xv * DN_ALPHA + gv * acc[m][n];
            }
        }
    } };
__device__ __forceinline__ void phase10(const Params& p, unsigned char* smem) {
    for (int item = blockIdx.x; item < 256 * 8; item += gridDim.x) {
        const int pm = item >> 3, pn = item & 7, b = pm >> 6;
        LoadBf16 al{(const bf16_t*)(p.ws + O_MS5) + (size_t)pm * 128 * 1024, 1024};
        LoadBf16 bl{(const bf16_t*)(p.ws + O_WT_OUT) + (size_t)pn * 128 * 1024, 1024};
        EpiOut ep{p.in[0], (const float*)(p.ws + O_ADA) + b * 6144 + 2048, (float*)(p.ws + O_Z1), pm, pn};
        gemm_tile(16, al, bl, ep, smem);
    }
}

__device__ __forceinline__ void phase11(const Params& p, unsigned char* smem) {
    const int tid = threadIdx.x, lane = tid & 63, wid = tid >> 6;
    float* hs = (float*)smem + wid * 1024;
    const float* lg = p.in[24]; const float* lb = p.in[25]; const float* wr_ = p.in[26]; const float* br_ = p.in[27];
    unsigned* cnt = (unsigned*)(p.ws + O_CNT);
    for (int item = blockIdx.x; item < NTOK / 4; item += gridDim.x) {
        const int token = item * 4 + wid, b = token >> 13;
        float* zr = (float*)(p.ws + O_Z1) + (size_t)token * 1024;
        const float* ada = (const float*)(p.ws + O_ADA) + b * 6144;
        f32x4 v[4]; float s = 0.f;
#pragma unroll
        for (int j = 0; j < 4; ++j) { v[j] = *(const f32x4*)(zr + j * 256 + lane * 4); s += (v[j][0] + v[j][1]) + (v[j][2] + v[j][3]); }
        const float mean = wave_sum(s) * (1.f / 1024.f); float q = 0.f;
#pragma unroll
        for (int j = 0; j < 4; ++j) { v[j] = v[j] - mean; q += (v[j][0] * v[j][0] + v[j][1] * v[j][1]) + (v[j][2] * v[j][2] + v[j][3] * v[j][3]); }
        const float rstd = rsqrtf(wave_sum(q) * (1.f / 1024.f) + LN_EPS);
        bf16_t* h2 = (bf16_t*)(p.ws + O_H2) + (size_t)token * 1024;
#pragma unroll
        for (int j = 0; j < 4; ++j) {
            const int c = j * 256 + lane * 4;
            const f32x4 x1 = v[j] * rstd * *(const f32x4*)(lg + c) + *(const f32x4*)(lb + c);
            *(f32x4*)(zr + c) = x1;
            const f32x4 hv = x1 * (*(const f32x4*)(ada + 4096 + c) + 1.f) + *(const f32x4*)(ada + 3072 + c);
            *(f32x4*)(hs + c) = hv;
            *(u32x2*)(h2 + c) = (u32x2){pk2(hv[0], hv[1]), pk2(hv[2], hv[3])};
        }
        WAVE_SYNC();
        const int e = lane & 31, kh = lane >> 5;
        float a = 0.f;
#pragma unroll 8
        for (int k = kh * 512; k < kh * 512 + 512; ++k) a += hs[k] * wr_[k * 32 + e];
        a += __shfl_xor(a, 32);
        a += br_[e];
        float val = a; int te[4]; float tv[4];
#pragma unroll
        for (int r = 0; r < 4; ++r) {
            float bs = val; int bj = e;
#pragma unroll
            for (int o = 1; o < 32; o <<= 1) { const float os = __shfl_xor(bs, o); const int oj = __shfl_xor(bj, o); if (os > bs || (os == bs && oj < bj)) { bs = os; bj = oj; } }
            te[r] = bj; tv[r] = bs;
            if (e == bj) val = -INFINITY;
        }
        const float e0 = 1.f, e1 = __expf(tv[1] - tv[0]), e2 = __expf(tv[2] - tv[0]), e3 = __expf(tv[3] - tv[0]);
        const float inv = 1.f / (e0 + e1 + e2 + e3);
        if (lane < 4) {
            const int ee = lane == 0 ? te[0] : (lane == 1 ? te[1] : (lane == 2 ? te[2] : te[3]));
            const float gg = (lane == 0 ? e0 : (lane == 1 ? e1 : (lane == 2 ? e2 : e3))) * inv;
            const unsigned pos = atomicAdd(cnt + ee, 1u);
            ((int*)(p.ws + O_TOPE))[token * 4 + lane] = ee;
            ((unsigned*)(p.ws + O_TOPP))[token * 4 + lane] = pos;
            ((float*)(p.ws + O_TOPG))[token * 4 + lane] = gg;
        }
        WAVE_SYNC();
    }
}

__device__ __forceinline__ void load_offsets(const Params& p, int* offs  , int* toff  ) {
    if (threadIdx.x == 0) {
        const unsigned* cnt = (const unsigned*)(p.ws + O_CNT);
        int a = 0, t = 0;
        for (int e = 0; e < 32; ++e) { offs[e] = a; toff[e] = t; const int c = (int)cnt[e]; a += c; t += (c + 127) >> 7; }
        offs[32] = a; toff[32] = t;
    }
    __syncthreads();
}
__device__ __forceinline__ void phase12(const Params& p, unsigned char* smem) {
    int* offs = (int*)smem; int* toff = offs + 40;
    load_offsets(p, offs, toff);
    const int* tope = (const int*)(p.ws + O_TOPE); const unsigned* topp = (const unsigned*)(p.ws + O_TOPP); const float* topg = (const float*)(p.ws + O_TOPG);
    int* rowtok = (int*)(p.ws + O_ROWTOK); float* rowgate = (float*)(p.ws + O_ROWGATE); int* tokrow = (int*)(p.ws + O_TOKROW);
    for (int i = blockIdx.x * NT + threadIdx.x; i < NROWS; i += gridDim.x * NT) {
        const int R = offs[tope[i]] + (int)topp[i];
        rowtok[R] = i >> 2; rowgate[R] = topg[i]; tokrow[i] = R;
    }
    __syncthreads();
}

struct LoadGather { const bf16_t* rp[4]; __device__ __forceinline__ u32x4 operator()(int i, int, int k) const { return *(const u32x4*)(rp[i] + k); } };
struct EpiGU { const float* bgu; bf16_t* ACT; int R0, nvalid, pn;
    __device__ __forceinline__ void operator()(f32x4 (&acc)[4][4], int wr, int wc, int fr, int fq) const {
#pragma unroll
        for (int m = 0; m < 4; ++m) {
            const int lr = wr * 64 + m * 16 + fr;
            if (lr < nvalid) {
#pragma unroll
                for (int n = 0; n < 2; ++n) {
                    const int cv = pn * 64 + wc * 32 + n * 16 + fq * 4;
                    const f32x4 ga = acc[m][n] + *(const f32x4*)(bgu + cv), ua = acc[m][n + 2] + *(const f32x4*)(bgu + 1024 + cv);
                    float o[4];
#pragma unroll
                    for (int j = 0; j < 4; ++j) { const float gt = fminf(ga[j], 7.f), up = fminf(fmaxf(ua[j], -7.f), 7.f); o[j] = (up + 1.f) * gt * sigmoidf_(1.702f * gt); }
                    *(u32x2*)(ACT + (size_t)(R0 + lr) * 1024 + cv) = (u32x2){pk2(o[0], o[1]), pk2(o[2], o[3])};
                }
            }
        }
    } };
__device__ __forceinline__ void phase13(const Params& p, unsigned char* smem) {
    int* offs = (int*)(smem + 40960); int* toff = offs + 40;
    load_offsets(p, offs, toff);
    const int ntile = toff[32];
    const int* rowtok = (const int*)(p.ws + O_ROWTOK);
    const int tid = threadIdx.x, prow = tid >> 3;
    for (int item = blockIdx.x; item < ntile * 16; item += gridDim.x) {
        const int tile = item >> 4, pn = item & 15;
        int e = 0;
#pragma unroll 1
        while (toff[e + 1] <= tile) ++e;
        const int mt = tile - toff[e], R0 = offs[e] + mt * 128, nvalid = offs[e + 1] - R0;
        LoadGather al;
#pragma unroll
        for (int i = 0; i < 4; ++i) { int R = R0 + prow + i * 32; R = R < NROWS ? R : NROWS - 1; al.rp[i] = (const bf16_t*)(p.ws + O_H2) + (size_t)rowtok[R] * 1024; }
        LoadBf16 bl{(const bf16_t*)(p.ws + O_WT_GU) + ((size_t)e * 2048 + pn * 128) * 1024, 1024};
        EpiGU ep{p.in[29] + (size_t)e * 2048, (bf16_t*)(p.ws + O_ACT), R0, nvalid, pn};
        gemm_tile(16, al, bl, ep, smem);
    }
    __syncthreads();
}
struct EpiDn { const float* bd; const float* rowgate; bf16_t* YK; int R0, nvalid, pn;
    __device__ __forceinline__ void operator()(f32x4 (&acc)[4][4], int wr, int wc, int fr, int fq) const {
#pragma unroll
        for (int m = 0; m < 4; ++m) {
            const int lr = wr * 64 + m * 16 + fr;
            if (lr < nvalid) {
                const float gw = rowgate[R0 + lr];
#pragma unroll
                for (int n = 0; n < 4; ++n) {
                    const int col = pn * 128 + wc * 64 + n * 16 + fq * 4;
                    const f32x4 v = (acc[m][n] + *(const f32x4*)(bd + col)) * gw;
                    *(u32x2*)(YK + (size_t)(R0 + lr) * 1024 + col) = (u32x2){pk2(v[0], v[1]), pk2(v[2], v[3])};
                }
            }
        }
    } };
__device__ __forceinline__ void phase14(const Params& p, unsigned char* smem) {
    int* offs = (int*)(smem + 40960); int* toff = offs + 40;
    load_offsets(p, offs, toff);
    const int ntile = toff[32];
    for (int item = blockIdx.x; item < ntile * 8; item += gridDim.x) {
        const int tile = item >> 3, pn = item & 7;
        int e = 0;
#pragma unroll 1
        while (toff[e + 1] <= tile) ++e;
        const int mt = tile - toff[e], R0 = offs[e] + mt * 128, nvalid = offs[e + 1] - R0;
        LoadBf16 al{(const bf16_t*)(p.ws + O_ACT) + (size_t)R0 * 1024, 1024};
        LoadBf16 bl{(const bf16_t*)(p.ws + O_WT_DN) + ((size_t)e * 1024 + pn * 128) * 1024, 1024};
        EpiDn ep{p.in[31] + (size_t)e * 1024, (const float*)(p.ws + O_ROWGATE), (bf16_t*)(p.ws + O_YK), R0, nvalid, pn};
        gemm_tile(16, al, bl, ep, smem);
    }
    __syncthreads();
}

__device__ __forceinline__ void phase15(const Params& p, unsigned char*) {
    const int tid = threadIdx.x, lane = tid & 63, wid = tid >> 6;
    const float* lg = p.in[32]; const float* lb = p.in[33];
    const int* tokrow = (const int*)(p.ws + O_TOKROW);
    const bf16_t* YK = (const bf16_t*)(p.ws + O_YK);
    for (int item = blockIdx.x; item < NTOK / 4; item += gridDim.x) {
        const int token = item * 4 + wid, b = token >> 13;
        const float* x1 = (const float*)(p.ws + O_Z1) + (size_t)token * 1024;
        const float* gf = (const float*)(p.ws + O_ADA) + b * 6144 + 5120;
        const int r0 = tokrow[token * 4 + 0], r1 = tokrow[token * 4 + 1], r2 = tokrow[token * 4 + 2], r3 = tokrow[token * 4 + 3];
        f32x4 v[4]; float s = 0.f;
#pragma unroll
        for (int j = 0; j < 4; ++j) {
            const int c = j * 256 + lane * 4;
            const u32x2 a0 = *(const u32x2*)(YK + (size_t)r0 * 1024 + c), a1 = *(const u32x2*)(YK + (size_t)r1 * 1024 + c), a2 = *(const u32x2*)(YK + (size_t)r2 * 1024 + c), a3 = *(const u32x2*)(YK + (size_t)r3 * 1024 + c);
            f32x4 y;
            y[0] = (bflo(a0.x) + bflo(a1.x)) + (bflo(a2.x) + bflo(a3.x)); y[1] = (bfhi(a0.x) + bfhi(a1.x)) + (bfhi(a2.x) + bfhi(a3.x));
            y[2] = (bflo(a0.y) + bflo(a1.y)) + (bflo(a2.y) + bflo(a3.y)); y[3] = (bfhi(a0.y) + bfhi(a1.y)) + (bfhi(a2.y) + bfhi(a3.y));
            v[j] = *(const f32x4*)(x1 + c) * DN_ALPHA + *(const f32x4*)(gf + c) * y;
            s += (v[j][0] + v[j][1]) + (v[j][2] + v[j][3]);
        }
        const float mean = wave_sum(s) * (1.f / 1024.f); float q = 0.f;
#pragma unroll
        for (int j = 0; j < 4; ++j) { v[j] = v[j] - mean; q += (v[j][0] * v[j][0] + v[j][1] * v[j][1]) + (v[j][2] * v[j][2] + v[j][3] * v[j][3]); }
        const float rstd = rsqrtf(wave_sum(q) * (1.f / 1024.f) + LN_EPS);
#pragma unroll
        for (int j = 0; j < 4; ++j) { const int c = j * 256 + lane * 4; *(f32x4*)(p.out + (size_t)token * 1024 + c) = v[j] * rstd * *(const f32x4*)(lg + c) + *(const f32x4*)(lb + c); }
    }
}

template <bool COOP>
__global__ void __launch_bounds__(NT, 2) fwd_kernel(Params p) {
    __shared__ __attribute__((aligned(16))) unsigned char smem[SMEM_BYTES];
    const int lo = p.ph_lo, hi = p.ph_hi;
#define RUN_PHASE(k) if (((PH_MASK >> (k)) & 1) && lo <= (k) && (k) < hi) { phase##k(p, smem); } if (COOP) { if (lo <= (k) && (k) + 1 < hi) cg::this_grid().sync(); }
    RUN_PHASE(0)
    RUN_PHASE(1)
    RUN_PHASE(2)
    RUN_PHASE(3)
    RUN_PHASE(4)
    RUN_PHASE(5)
    RUN_PHASE(6)
    RUN_PHASE(7)
    RUN_PHASE(8)
    RUN_PHASE(9)
    RUN_PHASE(10)
    RUN_PHASE(11)
    RUN_PHASE(12)
    RUN_PHASE(13)
    RUN_PHASE(14)
    RUN_PHASE(15)
#undef RUN_PHASE
}

extern "C" void kernel_launch(void* const* d_in, const int* in_sizes, int n_in, void* d_out, int out_size, void* d_ws, size_t ws_size, hipStream_t stream) {
    static int grid = 0;
    if (grid == 0) {
        if (n_in != 34 || out_size != NTOK * DM || ws_size < WS_NEED) { fprintf(stderr, "kernel_launch: unexpected problem (n_in %d, out %d, ws %zu need %zu)\n", n_in, out_size, ws_size, (size_t)WS_NEED); grid = -1; return; }
        int dev = 0, cus = 0, per_cu = 0;
        hipGetDevice(&dev);
        hipDeviceGetAttribute(&cus, hipDeviceAttributeMultiprocessorCount, dev);
#if ONE_LAUNCH
        hipOccupancyMaxActiveBlocksPerMultiprocessor(&per_cu, fwd_kernel<true>, NT, 0);
#else
        hipOccupancyMaxActiveBlocksPerMultiprocessor(&per_cu, fwd_kernel<false>, NT, 0);
#endif
        if (per_cu < 1) per_cu = 1;
        grid = cus * per_cu;
        fprintf(stderr, "kernel_launch: grid %d (%d CUs x %d)\n", grid, cus, per_cu);
    }
    if (grid < 0) return;
    Params p{};
    for (int i = 0; i < 34; ++i) p.in[i] = (const float*)d_in[i];
    p.out = (float*)d_out; p.ws = (unsigned char*)d_ws;
#if ONE_LAUNCH
    p.ph_lo = 0; p.ph_hi = NPHASE;
    void* args[] = {&p};
    hipError_t e = hipLaunchCooperativeKernel((void*)fwd_kernel<true>, dim3(grid), dim3(NT), args, 0, stream);
    if (e != hipSuccess) fprintf(stderr, "cooperative launch failed: %s (grid %d)\n", hipGetErrorString(e), grid);
#else
    for (int ph = 0; ph < NPHASE; ++ph) {
        p.ph_lo = ph; p.ph_hi = ph + 1;
        hipLaunchKernelGGL(fwd_kernel<false>, dim3(grid), dim3(NT), 0, stream, p);
    }
#endif
}
static_assert(WS_NEED <= (size_t)1073741824, "workspace map exceeds 1 GiB");
```

```cpp
#include <hip/hip_runtime.h>
#include <hip/hip_cooperative_groups.h>
#include <cstdio>
#include <cstdint>
namespace cg = cooperative_groups;

#ifndef PH_MASK
#define PH_MASK 0xFFFF
#endif
#ifndef REPEAT_MASK
#define REPEAT_MASK 0
#endif
#ifndef ONE_LAUNCH
#define ONE_LAUNCH 1
#endif

typedef unsigned short bf16_t;
typedef short bf16x8 __attribute__((ext_vector_type(8)));
typedef float f32x4 __attribute__((ext_vector_type(4)));
typedef float f32x2 __attribute__((ext_vector_type(2)));
typedef unsigned u32x4 __attribute__((ext_vector_type(4)));
typedef unsigned u32x2 __attribute__((ext_vector_type(2)));
typedef __bf16 bf16x2_t __attribute__((ext_vector_type(2)));

constexpr int NB = 4, SEQ = 8192, NTOK = NB * SEQ, DM = 1024;
constexpr int NIN_PAD = 3968;
constexpr int NEXP = 32, TOPK = 4, NROWS = NTOK * TOPK;
constexpr int S5L = 32;
constexpr int NCHUNK = SEQ / S5L;
constexpr int UROW = 640;
constexpr float DN_ALPHA = 1.189207115002721f;
constexpr float LN_EPS = 1e-5f;
constexpr float LOG2E = 1.4426950408889634f;
constexpr float QSCALE = 0.125f * 1.4426950408889634f;
constexpr int NT = 256;

constexpr size_t al256(size_t x) { return (x + 255) & ~(size_t)255; }
constexpr size_t O_ADA = 0;
constexpr size_t O_CNT = O_ADA + al256(4 * 6144 * 4);
constexpr size_t O_LAML = O_CNT + 1024;
constexpr size_t O_BIAS1 = O_LAML + al256(32 * 64 * 2 * 4);
constexpr size_t O_WT_IN = O_BIAS1 + al256(2 * 8 * 128 * 4);
constexpr size_t O_WT_GLU = O_WT_IN + al256((size_t)NIN_PAD * 1024 * 2);
constexpr size_t O_WT_NSA = O_WT_GLU + al256((size_t)2048 * 512 * 2);
constexpr size_t O_WT_OUT = O_WT_NSA + al256((size_t)1024 * 512 * 2);
constexpr size_t O_WT_C1 = O_WT_OUT + al256((size_t)1024 * 1024 * 2);
constexpr size_t O_W1T = O_WT_C1 + al256((size_t)2 * 128 * 2048 * 2);
constexpr size_t O_TW2 = O_W1T + al256((size_t)32 * 128 * 512 * 2);
constexpr size_t O_WT_GU = O_TW2 + al256((size_t)32 * 512 * 640 * 2);
constexpr size_t O_WT_DN = O_WT_GU + al256((size_t)32 * 2048 * 1024 * 2);
constexpr size_t O_H2 = O_WT_DN + al256((size_t)32 * 1024 * 1024 * 2);
constexpr size_t O_Z1 = O_H2 + al256((size_t)NTOK * 1024 * 2);
constexpr size_t O_TOPE = O_Z1 + al256((size_t)NTOK * 1024 * 4);
constexpr size_t O_TOPP = O_TOPE + al256((size_t)NROWS * 4);
constexpr size_t O_TOPG = O_TOPP + al256((size_t)NROWS * 4);
constexpr size_t O_ROWTOK = O_TOPG + al256((size_t)NROWS * 4);
constexpr size_t O_ROWGATE = O_ROWTOK + al256((size_t)(NROWS + 256) * 4);
constexpr size_t O_TOKROW = O_ROWGATE + al256((size_t)(NROWS + 256) * 4);
constexpr size_t O_OVL = O_TOKROW + al256((size_t)NROWS * 4);
constexpr size_t O_U = O_OVL;
constexpr size_t O_E = O_U + al256((size_t)32 * 1024 * UROW * 2);
constexpr size_t O_YS = O_E + al256((size_t)32 * 1024 * 128 * 4);
constexpr size_t O_Q = O_YS + al256((size_t)NTOK * 512 * 2);
constexpr size_t O_KV = O_Q + al256((size_t)NTOK * 512 * 2);
constexpr size_t KV_SLAB = (size_t)SEQ * 64;
constexpr size_t O_SG5 = O_KV + al256((size_t)6 * 8 * KV_SLAB * 2 + 8192);
constexpr size_t O_SGN = O_SG5 + al256((size_t)NTOK * 1024 * 2);
constexpr size_t O_GN = O_SGN + al256((size_t)NTOK * 1024 * 2);
constexpr size_t O_MS5 = O_GN + al256((size_t)NTOK * 24 * 4);
constexpr size_t O_ONSA = O_MS5 + al256((size_t)NTOK * 1024 * 2);
constexpr size_t O_HC = O_ONSA + al256((size_t)NTOK * 512 * 2);
constexpr size_t O_KC = O_HC + al256((size_t)2 * 4096 * 128 * 2);
constexpr size_t O_END1 = O_KC + al256((size_t)2 * 4096 * 64 * 2);
constexpr size_t O_ACT = O_OVL;
constexpr size_t O_YK = O_ACT + al256((size_t)(NROWS + 128) * 1024 * 2);
constexpr size_t O_END2 = O_YK + al256((size_t)(NROWS + 128) * 1024 * 2);
constexpr size_t WS_NEED = O_END1 > O_END2 ? O_END1 : O_END2;

constexpr int SMEM_BYTES = 43008;
constexpr int NPHASE = 16;

struct Params {
    const float* in[34];
    float* out;
    unsigned char* ws;
    int ph_lo, ph_hi;
};

__device__ __forceinline__ unsigned pk2(float lo, float hi) { f32x2 v = {lo, hi}; bf16x2_t b = __builtin_convertvector(v, bf16x2_t); return __builtin_bit_cast(unsigned, b); }
__device__ __forceinline__ bf16_t f2bf(float f) { return (bf16_t)(pk2(f, 0.f) & 0xffffu); }
__device__ __forceinline__ float bf2f(bf16_t h) { return __uint_as_float(((unsigned)h) << 16); }
__device__ __forceinline__ float bflo(unsigned w) { return __uint_as_float(w << 16); }
__device__ __forceinline__ float bfhi(unsigned w) { return __uint_as_float(w & 0xffff0000u); }
__device__ __forceinline__ float sigmoidf_(float x) { return 1.f / (1.f + __expf(-x)); }
__device__ __forceinline__ float gelu_tanh(float x) { const float u = 0.7978845608028654f * (x + 0.044715f * x * x * x); const float e = __expf(2.f * u); return 0.5f * x * (2.f - 2.f / (e + 1.f)); }
__device__ __forceinline__ float wave_sum(float v) {
#pragma unroll
    for (int o = 1; o < 64; o <<= 1) v += __shfl_xor(v, o);
    return v;
}
__device__ __forceinline__ float wave_max(float v) {
#pragma unroll
    for (int o = 1; o < 64; o <<= 1) v = fmaxf(v, __shfl_xor(v, o));
    return v;
}
#define WAVE_SYNC() do { __builtin_amdgcn_fence(__ATOMIC_RELEASE, "wavefront"); __builtin_amdgcn_wave_barrier(); __builtin_amdgcn_fence(__ATOMIC_ACQUIRE, "wavefront"); } while (0)

constexpr int LROW = 72;
template <class AL, class BL, class EP>
__device__ __forceinline__ void gemm_tile(int nk, const AL& al, const BL& bl, const EP& ep, unsigned char* smem) {
    const int tid = threadIdx.x, lane = tid & 63, wid = tid >> 6, wr = wid >> 1, wc = wid & 1, fr = lane & 15, fq = lane >> 4;
    bf16_t* sA = (bf16_t*)smem; bf16_t* sB = sA + 128 * LROW;
    f32x4 acc[4][4];
#pragma unroll
    for (int m = 0; m < 4; ++m)
#pragma unroll
        for (int n = 0; n < 4; ++n) acc[m][n] = (f32x4){0.f, 0.f, 0.f, 0.f};
    u32x4 ra[4], rb[4];
    const int prow = tid >> 3, pk = (tid & 7) * 8;
#pragma unroll
    for (int i = 0; i < 4; ++i) { ra[i] = al(i, prow + i * 32, pk); rb[i] = bl(i, prow + i * 32, pk); }
    for (int kt = 0; kt < nk; ++kt) {
        __syncthreads();
#pragma unroll
        for (int i = 0; i < 4; ++i) {
            *(u32x4*)(sA + (prow + i * 32) * LROW + pk) = ra[i];
            *(u32x4*)(sB + (prow + i * 32) * LROW + pk) = rb[i];
        }
        __syncthreads();
        if (kt + 1 < nk) {
            const int k0 = (kt + 1) * 64 + pk;
#pragma unroll
            for (int i = 0; i < 4; ++i) { ra[i] = al(i, prow + i * 32, k0); rb[i] = bl(i, prow + i * 32, k0); }
        }
#pragma unroll
        for (int kk = 0; kk < 2; ++kk) {
            bf16x8 af[4], bfr[4];
#pragma unroll
            for (int m = 0; m < 4; ++m) af[m] = *(const bf16x8*)(sA + (wr * 64 + m * 16 + fr) * LROW + kk * 32 + fq * 8);
#pragma unroll
            for (int n = 0; n < 4; ++n) bfr[n] = *(const bf16x8*)(sB + (wc * 64 + n * 16 + fr) * LROW + kk * 32 + fq * 8);
#pragma unroll
            for (int m = 0; m < 4; ++m)
#pragma unroll
                for (int n = 0; n < 4; ++n) acc[m][n] = __builtin_amdgcn_mfma_f32_16x16x32_bf16(bfr[n], af[m], acc[m][n], 0, 0, 0);
        }
    }
    ep(acc, wr, wc, fr, fq);
    __syncthreads();
}

struct LoadBf16 {
    const bf16_t* base; long ld;
    __device__ __forceinline__ u32x4 operator()(int, int row, int k) const { return *(const u32x4*)(base + (long)row * ld + k); }
};

__device__ __forceinline__ int map_in(int n) { return n < 1792 ? n : (n < 3840 ? n + 24 : (n < 3864 ? 1792 + (n - 3840) : -1)); }
__device__ __forceinline__ int map_il32(int n) { const int b = n >> 5; return (b & 1) * 1024 + (b >> 1) * 32 + (n & 31); }

template <int MAP>
__device__ __forceinline__ void transpose_tile(const float* W, int K, int Nsrc, bf16_t* Wt, int kt, int ntile, unsigned char* smem) {
    float* t = (float*)smem;
    const int tid = threadIdx.x, k0 = kt * 64, n0 = ntile * 64;
    {
        const int n = tid & 63;
        const int nd = n0 + n;
        const int src = MAP == 0 ? nd : (MAP == 1 ? map_in(nd) : map_il32(nd));
#pragma unroll 4
        for (int i = 0; i < 16; ++i) { const int k = i * 4 + (tid >> 6); t[k * 65 + n] = (src >= 0) ? W[(size_t)(k0 + k) * Nsrc + src] : 0.f; }
    }
    __syncthreads();
    {
        const int n = tid >> 2, ks = (tid & 3) * 16;
        u32x4 o0, o1;
        o0.x = pk2(t[(ks + 0) * 65 + n], t[(ks + 1) * 65 + n]); o0.y = pk2(t[(ks + 2) * 65 + n], t[(ks + 3) * 65 + n]);
        o0.z = pk2(t[(ks + 4) * 65 + n], t[(ks + 5) * 65 + n]); o0.w = pk2(t[(ks + 6) * 65 + n], t[(ks + 7) * 65 + n]);
        o1.x = pk2(t[(ks + 8) * 65 + n], t[(ks + 9) * 65 + n]); o1.y = pk2(t[(ks + 10) * 65 + n], t[(ks + 11) * 65 + n]);
        o1.z = pk2(t[(ks + 12) * 65 + n], t[(ks + 13) * 65 + n]); o1.w = pk2(t[(ks + 14) * 65 + n], t[(ks + 15) * 65 + n]);
        bf16_t* d = Wt + (size_t)(n0 + n) * K + k0 + ks;
        *(u32x4*)d = o0; *(u32x4*)(d + 8) = o1;
    }
    __syncthreads();
}

__device__ __forceinline__ void phase0(const Params& p, unsigned char* smem) {
    unsigned char* ws = p.ws;
    const int tid = threadIdx.x;
    constexpr int I_ADA = 96;
    constexpr int T_IN = 16 * (NIN_PAD / 64), T_GLU = 8 * 32, T_NSA = 8 * 16, T_OUT = 16 * 16, T_C1 = 2 * 32 * 2, T_GU = 32 * 16 * 32, T_DN = 32 * 16 * 16;
    constexpr int I_TR = T_IN + T_GLU + T_NSA + T_OUT + T_C1 + T_GU + T_DN;
    constexpr int I_S5 = 32 * 33;
    constexpr int I_MISC = 17;
    constexpr int NITEM = I_ADA + I_TR + I_S5 + I_MISC;
    for (int item = blockIdx.x; item < NITEM; item += gridDim.x) {
        int r = item;
        if (r < I_ADA) {
            const float* c = p.in[1]; const float* w = p.in[3]; const float* bb = p.in[4];
            const int wid = tid >> 6, lane = tid & 63, j = r * 64 + lane;
            float a0 = 0.f, a1 = 0.f, a2 = 0.f, a3 = 0.f;
            for (int k = wid * 256; k < wid * 256 + 256; ++k) {
                const float wv = w[(size_t)k * 6144 + j];
                const float c0 = c[k], c1 = c[1024 + k], c2 = c[2048 + k], c3 = c[3072 + k];
                a0 += c0 * sigmoidf_(c0) * wv; a1 += c1 * sigmoidf_(c1) * wv; a2 += c2 * sigmoidf_(c2) * wv; a3 += c3 * sigmoidf_(c3) * wv;
            }
            float* red = (float*)smem;
            red[(wid * 4 + 0) * 64 + lane] = a0; red[(wid * 4 + 1) * 64 + lane] = a1; red[(wid * 4 + 2) * 64 + lane] = a2; red[(wid * 4 + 3) * 64 + lane] = a3;
            __syncthreads();
            { const int b = tid >> 6; const float s = red[(0 * 4 + b) * 64 + lane] + red[(1 * 4 + b) * 64 + lane] + red[(2 * 4 + b) * 64 + lane] + red[(3 * 4 + b) * 64 + lane];
              ((float*)(ws + O_ADA))[b * 6144 + j] = s + bb[j]; }
            __syncthreads();
            continue;
        }
        r -= I_ADA;
        if (r < I_TR) {
            if (r < T_IN) { transpose_tile<1>(p.in[5], 1024, 3864, (bf16_t*)(ws + O_WT_IN), r / (NIN_PAD / 64), r % (NIN_PAD / 64), smem); continue; } r -= T_IN;
            if (r < T_GLU) { transpose_tile<2>(p.in[14], 512, 2048, (bf16_t*)(ws + O_WT_GLU), r / 32, r % 32, smem); continue; } r -= T_GLU;
            if (r < T_NSA) { transpose_tile<0>(p.in[22], 512, 1024, (bf16_t*)(ws + O_WT_NSA), r / 16, r % 16, smem); continue; } r -= T_NSA;
            if (r < T_OUT) { transpose_tile<0>(p.in[23], 1024, 1024, (bf16_t*)(ws + O_WT_OUT), r / 16, r % 16, smem); continue; } r -= T_OUT;
            if (r < T_C1) { const int kv = r / 64, q = r % 64; transpose_tile<0>(p.in[kv ? 20 : 17], 2048, 128, (bf16_t*)(ws + O_WT_C1) + (size_t)kv * 128 * 2048, q / 2, q % 2, smem); continue; } r -= T_C1;
            if (r < T_GU) { const int e = r / 512, q = r % 512; transpose_tile<2>(p.in[28] + (size_t)e * 1024 * 2048, 1024, 2048, (bf16_t*)(ws + O_WT_GU) + (size_t)e * 2048 * 1024, q / 32, q % 32, smem); continue; } r -= T_GU;
            { const int e = r / 256, q = r % 256; transpose_tile<0>(p.in[30] + (size_t)e * 1024 * 1024, 1024, 1024, (bf16_t*)(ws + O_WT_DN) + (size_t)e * 1024 * 1024, q / 16, q % 16, smem); continue; }
        }
        r -= I_TR;
        if (r < I_S5) {
            const int g = r / 33, dl = r % 33;
            f32x2* pw = (f32x2*)smem;
            f32x2* bbv = pw + 64;
            f32x2* ccv = bbv + 1024;
            const float dt = expf(p.in[8][g]);
            if (tid < 64) {
                const int n = tid; const double re = p.in[6][g * 64 + n], im = p.in[7][g * 64 + n];
                const double mag = exp(re * (double)dt * dl), ang = im * (double)dt * dl;
                double sn, cs; sincos(ang, &sn, &cs);
                pw[n] = (f32x2){(float)(mag * cs), (float)(mag * sn)};
                if (dl == 32) { ((f32x2*)(ws + O_LAML))[g * 64 + n] = pw[n]; }
            }
            for (int e = tid; e < 1024; e += NT) {
                const int n = e >> 4, q = e & 15;
                const double re = p.in[6][g * 64 + n], im = p.in[7][g * 64 + n];
                const double mag = exp(re * (double)dt), ang = im * (double)dt;
                double sn, cs; sincos(ang, &sn, &cs);
                const double lr = mag * cs - 1.0, li = mag * sn;
                const double den = re * re + im * im;
                const double fr_ = (lr * re + li * im) / den, fi_ = (li * re - lr * im) / den;
                const double br = p.in[9][(g * 64 + n) * 16 + q], bi = p.in[10][(g * 64 + n) * 16 + q];
                bbv[e] = (f32x2){(float)(fr_ * br - fi_ * bi), (float)(fr_ * bi + fi_ * br)};
            }
            for (int e = tid; e < 1024; e += NT) { ccv[e] = (f32x2){p.in[11][g * 1024 + e], p.in[12][g * 1024 + e]}; }
            __syncthreads();
            bf16_t* TW2 = (bf16_t*)(ws + O_TW2) + (size_t)g * 512 * UROW;
            bf16_t* W1T = (bf16_t*)(ws + O_W1T) + (size_t)g * 128 * 512;
            if (dl < 32) {
                const int pp = tid >> 4, q = tid & 15;
                float acc = 0.f;
                for (int n = 0; n < 64; ++n) {
                    const f32x2 cv = ccv[pp * 64 + n], pv = pw[n], bv = bbv[n * 16 + q];
                    const float xr = cv.x * pv.x - cv.y * pv.y, xi = cv.x * pv.y + cv.y * pv.x;
                    acc += xr * bv.x - xi * bv.y;
                }
                if (dl == 0 && pp == q) acc += p.in[13][g * 16 + pp];
                const bf16_t kb = f2bf(acc);
                for (int tau = dl; tau < 32; ++tau) { const int s = tau - dl; TW2[(size_t)(tau * 16 + pp) * UROW + s * 16 + q] = kb; }
                if (dl >= 1) for (int s = dl; s < 32; ++s) { const int tau = s - dl; TW2[(size_t)(tau * 16 + pp) * UROW + s * 16 + q] = 0; }
                const int s = 31 - dl;
                for (int e = tid; e < 2048; e += NT) {
                    const int c = e >> 4, qq = e & 15, n = c & 63, ri = c >> 6;
                    const f32x2 pv = pw[n], bv = bbv[n * 16 + qq];
                    const float zr = pv.x * bv.x - pv.y * bv.y, zi = pv.x * bv.y + pv.y * bv.x;
                    W1T[(size_t)c * 512 + s * 16 + qq] = f2bf(ri ? zi : zr);
                }
            }
            if (dl >= 1) {
                const int tau = dl - 1;
                for (int e = tid; e < 2048; e += NT) {
                    const int pp = e >> 7, c = e & 127, n = c & 63, ri = c >> 6;
                    const f32x2 cv = ccv[pp * 64 + n], pv = pw[n];
                    const float xr = cv.x * pv.x - cv.y * pv.y, xi = cv.x * pv.y + cv.y * pv.x;
                    TW2[(size_t)(tau * 16 + pp) * UROW + 512 + c] = f2bf(ri ? -xi : xr);
                }
            }
            __syncthreads();
            continue;
        }
        r -= I_S5;
        if (r < 16) {
            const int kv = r >> 3, part = r & 7, j = tid & 127, half = tid >> 7;
            const float* pos = p.in[kv ? 19 : 16]; const float* w1 = p.in[kv ? 20 : 17];
            float a = 0.f;
            const int i0 = part * 256 + half * 128;
            for (int i = i0; i < i0 + 128; ++i) a += pos[i] * w1[(size_t)i * 128 + j];
            float* red = (float*)smem;
            red[tid] = a;
            __syncthreads();
            if (tid < 128) ((float*)(ws + O_BIAS1))[(kv * 8 + part) * 128 + tid] = red[tid] + red[tid + 128];
            __syncthreads();
            continue;
        }
        if (tid < 64) ((unsigned*)(ws + O_CNT))[tid] = 0u;
    }
}

struct LoadXMod {
    const float* x; const float* ada;
    __device__ __forceinline__ u32x4 operator()(int, int row, int k) const {
        const f32x4 x0 = *(const f32x4*)(x + (size_t)row * 1024 + k), x1 = *(const f32x4*)(x + (size_t)row * 1024 + k + 4);
        const f32x4 s0 = *(const f32x4*)(ada + 1024 + k), s1 = *(const f32x4*)(ada + 1024 + k + 4);
        const f32x4 h0 = *(const f32x4*)(ada + k), h1 = *(const f32x4*)(ada + k + 4);
        u32x4 o;
        o.x = pk2(x0[0] * (1.f + s0[0]) + h0[0], x0[1] * (1.f + s0[1]) + h0[1]); o.y = pk2(x0[2] * (1.f + s0[2]) + h0[2], x0[3] * (1.f + s0[3]) + h0[3]);
        o.z = pk2(x1[0] * (1.f + s1[0]) + h1[0], x1[1] * (1.f + s1[1]) + h1[1]); o.w = pk2(x1[2] * (1.f + s1[2]) + h1[2], x1[3] * (1.f + s1[3]) + h1[3]);
        return o;
    }
};
struct EpiIn {
    unsigned char* ws; int pm, pn;
    __device__ __forceinline__ void operator()(f32x4 (&acc)[4][4], int wr, int wc, int fr, int fq) const {
#pragma unroll
        for (int m = 0; m < 4; ++m) {
            const int token = pm * 128 + wr * 64 + m * 16 + fr;
#pragma unroll
            for (int n = 0; n < 4; ++n) {
                const int col = pn * 128 + wc * 64 + n * 16 + fq * 4;
                const f32x4 v = acc[m][n];
                if (pn < 4) {
                    const int g = col >> 4, q = col & 15;
                    bf16_t* d = (bf16_t*)(ws + O_U) + ((size_t)(g * 1024 + (token >> 5)) * UROW + (token & 31) * 16 + q);
                    *(u32x2*)d = (u32x2){pk2(v[0], v[1]), pk2(v[2], v[3])};
                } else if (pn < 8) {
                    bf16_t* d = (bf16_t*)(ws + O_Q) + (size_t)token * 512 + (col - 512);
                    *(u32x2*)d = (u32x2){pk2(v[0] * QSCALE, v[1] * QSCALE), pk2(v[2] * QSCALE, v[3] * QSCALE)};
                } else if (pn < 14) {
                    const int c = col - 1024, j6 = c >> 7, g = (c >> 6) & 1, dd = c & 63, b = token >> 13, s = token & 8191;
                    bf16_t* slab = (bf16_t*)(ws + O_KV) + (size_t)((j6 * 4 + b) * 2 + g) * KV_SLAB;
                    if (j6 == 3 || j6 == 5) {
                        const int sp = (s & ~15) | (s & 3) | ((s & 4) << 1) | ((s & 8) >> 1);
#pragma unroll
                        for (int j = 0; j < 4; ++j) slab[(size_t)(dd + j) * SEQ + sp] = f2bf(v[j]);
                    } else {
                        *(u32x2*)(slab + (size_t)s * 64 + dd) = (u32x2){pk2(v[0], v[1]), pk2(v[2], v[3])};
                    }
                } else if (pn < 22) {
                    bf16_t* d = (bf16_t*)(ws + O_SG5) + (size_t)token * 1024 + (col - 1792);
                    *(u32x2*)d = (u32x2){pk2(sigmoidf_(v[0]), sigmoidf_(v[1])), pk2(sigmoidf_(v[2]), sigmoidf_(v[3]))};
                } else if (pn < 30) {
                    bf16_t* d = (bf16_t*)(ws + O_SGN) + (size_t)token * 1024 + (col - 2816);
                    *(u32x2*)d = (u32x2){pk2(sigmoidf_(v[0]), sigmoidf_(v[1])), pk2(sigmoidf_(v[2]), sigmoidf_(v[3]))};
                } else {
                    const int c = col - 3840;
                    if (c < 24) { float* d = (float*)(ws + O_GN) + (size_t)token * 24 + c; *(f32x4*)d = (f32x4){sigmoidf_(v[0]), sigmoidf_(v[1]), sigmoidf_(v[2]), sigmoidf_(v[3])}; }
                }
            }
        }
    }
};
__device__ __forceinline__ void phase1(const Params& p, unsigned char* smem) {
    constexpr int NPN = NIN_PAD / 128;
    for (int item = blockIdx.x; item < 256 * NPN; item += gridDim.x) {
        const int pm = item / NPN, pn = item % NPN, b = pm >> 6;
        LoadXMod al{p.in[0] + (size_t)pm * 128 * 1024, (const float*)(p.ws + O_ADA) + b * 6144};
        LoadBf16 bl{(const bf16_t*)(p.ws + O_WT_IN) + (size_t)pn * 128 * 1024, 1024};
        EpiIn ep{p.ws, pm, pn};
        gemm_tile(16, al, bl, ep, smem);
    }
}

struct EpiE { float* E; __device__ __forceinline__ void operator()(f32x4 (&acc)[4][4], int wr, int wc, int fr, int fq) const {
#pragma unroll
    for (int m = 0; m < 4; ++m)
#pragma unroll
        for (int n = 0; n < 4; ++n) *(f32x4*)(E + (size_t)(wr * 64 + m * 16 + fr) * 128 + wc * 64 + n * 16 + fq * 4) = acc[m][n]; } };
__device__ __forceinline__ void phase2(const Params& p, unsigned char* smem) {
    for (int item = blockIdx.x; item < 32 * 8; item += gridDim.x) {
        const int g = item >> 3, pm = item & 7;
        LoadBf16 al{(const bf16_t*)(p.ws + O_U) + (size_t)(g * 1024 + pm * 128) * UROW, UROW};
        LoadBf16 bl{(const bf16_t*)(p.ws + O_W1T) + (size_t)g * 128 * 512, 512};
        EpiE ep{(float*)(p.ws + O_E) + (size_t)(g * 1024 + pm * 128) * 128};
        gemm_tile(8, al, bl, ep, smem);
    }
}
__device__ __forceinline__ void phase3(const Params& p, unsigned char*) {
    for (int item = blockIdx.x; item < 32; item += gridDim.x) {
        const int tid = threadIdx.x, n = tid & 63, bg = item * 4 + (tid >> 6), b = bg >> 5, g = bg & 31;
        const f32x2 lm = ((const f32x2*)(p.ws + O_LAML))[g * 64 + n];
        const float* E = (const float*)(p.ws + O_E) + (size_t)(g * 1024 + b * 256) * 128;
        bf16_t* U = (bf16_t*)(p.ws + O_U) + (size_t)(g * 1024 + b * 256) * UROW + 512;
        float hr = 0.f, hi = 0.f;
#pragma unroll 8
        for (int c = 0; c < NCHUNK; ++c) {
            const float er = E[(size_t)c * 128 + n], ei = E[(size_t)c * 128 + 64 + n];
            U[(size_t)c * UROW + n] = f2bf(hr); U[(size_t)c * UROW + 64 + n] = f2bf(hi);
            const float nr = lm.x * hr - lm.y * hi + er, ni = lm.x * hi + lm.y * hr + ei;
            hr = nr; hi = ni;
        }
    }
}
struct EpiY { bf16_t* YS; int g, pm, pn;
    __device__ __forceinline__ void operator()(f32x4 (&acc)[4][4], int wr, int wc, int fr, int fq) const {
#pragma unroll
        for (int m = 0; m < 4; ++m) {
            const int r = pm * 128 + wr * 64 + m * 16 + fr;
            const int tok0 = (r >> 8) * SEQ + (r & 255) * S5L;
#pragma unroll
            for (int n = 0; n < 4; ++n) {
                const int col = pn * 128 + wc * 64 + n * 16 + fq * 4, tau = col >> 4, pp = col & 15;
                const f32x4 v = acc[m][n];
                bf16_t* d = YS + (size_t)(tok0 + tau) * 512 + g * 16 + pp;
                *(u32x2*)d = (u32x2){pk2(gelu_tanh(v[0]), gelu_tanh(v[1])), pk2(gelu_tanh(v[2]), gelu_tanh(v[3]))};
            }
        }
    } };
__device__ __forceinline__ void phase4(const Params& p, unsigned char* smem) {
    for (int item = blockIdx.x; item < 32 * 8 * 4; item += gridDim.x) {
        const int g = item >> 5, pm = (item >> 2) & 7, pn = item & 3;
        LoadBf16 al{(const bf16_t*)(p.ws + O_U) + (size_t)(g * 1024 + pm * 128) * UROW, UROW};
        LoadBf16 bl{(const bf16_t*)(p.ws + O_TW2) + (size_t)(g * 512 + pn * 128) * UROW, UROW};
        EpiY ep{(bf16_t*)(p.ws + O_YS), g, pm, pn};
        gemm_tile(10, al, bl, ep, smem);
    }
}
struct EpiGlu { const float* bglu; const bf16_t* SG5; bf16_t* MS5; int pm, pn;
    __device__ __forceinline__ void operator()(f32x4 (&acc)[4][4], int wr, int wc, int fr, int fq) const {
#pragma unroll
        for (int m = 0; m < 4; ++m) {
            const int token = pm * 128 + wr * 64 + m * 16 + fr;
#pragma unroll
            for (int n = 0; n < 2; ++n) {
                const int cv = pn * 64 + wc * 32 + n * 16 + fq * 4;
                const f32x4 bv = *(const f32x4*)(bglu + cv), bg = *(const f32x4*)(bglu + 1024 + cv);
                const u32x2 sg = *(const u32x2*)(SG5 + (size_t)token * 1024 + cv);
                const f32x4 va = acc[m][n] + bv, ga = acc[m][n + 2] + bg;
                const float y0 = va[0] * sigmoidf_(ga[0]) * bflo(sg.x), y1 = va[1] * sigmoidf_(ga[1]) * bfhi(sg.x);
                const float y2 = va[2] * sigmoidf_(ga[2]) * bflo(sg.y), y3 = va[3] * sigmoidf_(ga[3]) * bfhi(sg.y);
                *(u32x2*)(MS5 + (size_t)token * 1024 + cv) = (u32x2){pk2(y0, y1), pk2(y2, y3)};
            }
        }
    } };
__device__ __forceinline__ void phase5(const Params& p, unsigned char* smem) {
    for (int item = blockIdx.x; item < 256 * 16; item += gridDim.x) {
        const int pm = item >> 4, pn = item & 15;
        LoadBf16 al{(const bf16_t*)(p.ws + O_YS) + (size_t)pm * 128 * 512, 512};
        LoadBf16 bl{(const bf16_t*)(p.ws + O_WT_GLU) + (size_t)pn * 128 * 512, 512};
        EpiGlu ep{p.in[15], (const bf16_t*)(p.ws + O_SG5), (bf16_t*)(p.ws + O_MS5), pm, pn};
        gemm_tile(8, al, bl, ep, smem);
    }
}

struct LoadCmp {
    const bf16_t* slab0; int R0;
    __device__ __forceinline__ u32x4 operator()(int, int row, int k) const { const int R = R0 + row; return *(const u32x4*)(slab0 + (size_t)(R >> 9) * KV_SLAB + (size_t)(R & 511) * 1024 + k); }
};
struct EpiCmp { const float* b1p; bf16_t* HC; int R0;
    __device__ __forceinline__ void operator()(f32x4 (&acc)[4][4], int wr, int wc, int fr, int fq) const {
#pragma unroll
        for (int n = 0; n < 4; ++n) {
            const int col = wc * 64 + n * 16 + fq * 4;
            f32x4 bs = (f32x4){0.f, 0.f, 0.f, 0.f};
#pragma unroll
            for (int part = 0; part < 8; ++part) bs += *(const f32x4*)(b1p + part * 128 + col);
#pragma unroll
            for (int m = 0; m < 4; ++m) {
                const int R = R0 + wr * 64 + m * 16 + fr;
                const f32x4 v = acc[m][n] + bs;
                *(u32x2*)(HC + (size_t)R * 128 + col) = (u32x2){pk2(gelu_tanh(v[0]), gelu_tanh(v[1])), pk2(gelu_tanh(v[2]), gelu_tanh(v[3]))};
            }
        }
    } };
__device__ __forceinline__ void phase6(const Params& p, unsigned char* smem) {
    for (int item = blockIdx.x; item < 64; item += gridDim.x) {
        const int kv = item >> 5, pm = item & 31;
        LoadCmp al{(const bf16_t*)(p.ws + O_KV) + (size_t)kv * 8 * KV_SLAB, pm * 128};
        LoadBf16 bl{(const bf16_t*)(p.ws + O_WT_C1) + (size_t)kv * 128 * 2048, 2048};
        EpiCmp ep{(const float*)(p.ws + O_BIAS1) + kv * 8 * 128, (bf16_t*)(p.ws + O_HC) + (size_t)kv * 4096 * 128, pm * 128};
        gemm_tile(32, al, bl, ep, smem);
    }
}
__device__ __forceinline__ void phase7(const Params& p, unsigned char*) {
    for (int item = blockIdx.x; item < 2048; item += gridDim.x) {
        const int o = item * NT + threadIdx.x, d = o & 63, R = (o >> 6) & 4095, kv = o >> 18;
        const bf16_t* h = (const bf16_t*)(p.ws + O_HC) + ((size_t)kv * 4096 + R) * 128;
        const float* w2 = p.in[kv ? 21 : 18];
        float a = 0.f;
#pragma unroll 8
        for (int j = 0; j < 128; ++j) a += bf2f(h[j]) * w2[j * 64 + d];
        if (kv == 0) ((bf16_t*)(p.ws + O_KC))[(size_t)R * 64 + d] = f2bf(a);
        else { const int bgi = R >> 9, n = R & 511, np = (n & ~15) | (n & 3) | ((n & 4) << 1) | ((n & 8) >> 1);
               ((bf16_t*)(p.ws + O_KC))[(size_t)4096 * 64 + ((size_t)bgi * 64 + d) * 512 + np] = f2bf(a); }
    }
}

typedef float f32x16 __attribute__((ext_vector_type(16)));
__device__ __forceinline__ int rel_bucket_dev(int dist) {
    const int n = dist > 0 ? dist : 0;
    if (n < 16) return n;
    const int l = (int)(__log2f((float)n * 0.0625f) * 2.6666667f);
    const int v = 16 + l;
    return v < 31 ? v : 31;
}
__device__ __forceinline__ float xhalf_max(float v) { auto rr = __builtin_amdgcn_permlane32_swap(__float_as_uint(v), __float_as_uint(v), false, false); return fmaxf(__uint_as_float(rr[0]), __uint_as_float(rr[1])); }
__device__ __forceinline__ float xhalf_sum(float v) { auto rr = __builtin_amdgcn_permlane32_swap(__float_as_uint(v), __float_as_uint(v), false, false); return __uint_as_float(rr[0]) + __uint_as_float(rr[1]); }
__device__ __forceinline__ float quad_sum(float v) {
    v += __uint_as_float(__builtin_amdgcn_update_dpp(0u, __float_as_uint(v), 0xB1, 0xF, 0xF, true));
    v += __uint_as_float(__builtin_amdgcn_update_dpp(0u, __float_as_uint(v), 0x4E, 0xF, 0xF, true));
    return v;
}
constexpr int LUTW = 1028;
constexpr int IMPW = 132;
constexpr float NEG_BIG = -1e30f;

__device__ __forceinline__ void qk_block(f32x16 (&st)[2], const bf16x8 (&qf)[4], const bf16_t* kp  , float cinit) {
#pragma unroll
    for (int sub = 0; sub < 2; ++sub) {
        f32x16 acc;
#pragma unroll
        for (int r = 0; r < 16; ++r) acc[r] = cinit;
#pragma unroll
        for (int s = 0; s < 4; ++s) {
            const bf16x8 kf = *(const bf16x8*)(kp + sub * 32 * 64 + s * 16);
            acc = __builtin_amdgcn_mfma_f32_32x32x16_bf16(kf, qf[s], acc, 0, 0, 0);
        }
        st[sub] = acc;
    }
}
template <int MODE>
__device__ __forceinline__ void bias_mask(f32x16 (&st)[2], int dist0, bool selme, const float* lut) {
    constexpr int STEP = MODE == 0 ? 16 : 1;
#pragma unroll
    for (int sub = 0; sub < 2; ++sub)
#pragma unroll
        for (int r = 0; r < 16; ++r) {
            const int dist = dist0 - STEP * (32 * sub + (r & 3) + 8 * (r >> 2));
            int idx = dist < 0 ? 0 : dist; idx = idx > 1024 ? 1024 : idx;
            bool valid = dist >= 0;
            if (MODE == 1) valid = valid && selme;
            if (MODE == 2) valid = valid && (dist < 512);
            st[sub][r] = valid ? st[sub][r] + lut[idx] : -INFINITY;
        }
}
__device__ __forceinline__ float tile_max(const f32x16 (&st)[2]) {
    float a = fmaxf(st[0][0], st[1][0]);
#pragma unroll
    for (int r = 1; r < 16; ++r) a = fmaxf(a, fmaxf(st[0][r], st[1][r]));
    return xhalf_max(a);
}
__device__ __forceinline__ void pv_block(f32x16 (&O)[2], const f32x16 (&st)[2], const bf16_t* vt, int rs) {
    bf16x8 pf[2][2];
#pragma unroll
    for (int sub = 0; sub < 2; ++sub)
#pragma unroll
        for (int s2 = 0; s2 < 2; ++s2) {
            u32x4 w;
            w.x = pk2(st[sub][8 * s2 + 0], st[sub][8 * s2 + 1]); w.y = pk2(st[sub][8 * s2 + 2], st[sub][8 * s2 + 3]);
            w.z = pk2(st[sub][8 * s2 + 4], st[sub][8 * s2 + 5]); w.w = pk2(st[sub][8 * s2 + 6], st[sub][8 * s2 + 7]);
            pf[sub][s2] = __builtin_bit_cast(bf16x8, w);
        }
#pragma unroll
    for (int dt = 0; dt < 2; ++dt)
#pragma unroll
        for (int sub = 0; sub < 2; ++sub)
#pragma unroll
            for (int s2 = 0; s2 < 2; ++s2) {
                const bf16x8 vf = *(const bf16x8*)(vt + (size_t)dt * 32 * rs + sub * 32 + s2 * 16);
                O[dt] = __builtin_amdgcn_mfma_f32_32x32x16_bf16(vf, pf[sub][s2], O[dt], 0, 0, 0);
            }
}
__device__ __forceinline__ void softmax_step(f32x16 (&st)[2], f32x16 (&O)[2], float& m, float& l) {
    const float mn = fmaxf(m, tile_max(st));
    const float corr = __builtin_amdgcn_exp2f(m - mn);
    float sum = 0.f;
#pragma unroll
    for (int sub = 0; sub < 2; ++sub)
#pragma unroll
        for (int r = 0; r < 16; ++r) { const float pe = __builtin_amdgcn_exp2f(st[sub][r] - mn); st[sub][r] = pe; sum += pe; }
    l = l * corr + sum;
    if (__any(corr != 1.f)) {
#pragma unroll
        for (int dt = 0; dt < 2; ++dt)
#pragma unroll
            for (int r = 0; r < 16; ++r) O[dt][r] *= corr;
    }
    m = mn;
}

__device__ __forceinline__ void nsa_tile(const Params& p, int bg, int tg, const float* lutall, float* impw, int lane) {
    const int q = lane & 31, h2 = lane >> 5, tok = q >> 2, head = q & 3;
    const int b = bg >> 1, g = bg & 1, t0 = tg * 8, t = t0 + tok, token = b * SEQ + t;
    const float* lut = lutall + head * LUTW;
    const float b31 = lut[1024];
    bf16x8 qf[4];
    { const bf16_t* qp = (const bf16_t*)(p.ws + O_Q) + (size_t)token * 512 + (g * 4 + head) * 64 + 8 * h2;
#pragma unroll
      for (int s = 0; s < 4; ++s) qf[s] = *(const bf16x8*)(qp + 16 * s); }
    const float* gn = (const float*)(p.ws + O_GN) + (size_t)token * 24 + (g * 4 + head) * 3;
    f32x16 F[2], O[2], st[2];
#pragma unroll
    for (int dt = 0; dt < 2; ++dt)
#pragma unroll
        for (int r = 0; r < 16; ++r) { F[dt][r] = 0.f; O[dt][r] = 0.f; }
    const int cur = t0 >> 6;
    { const int u = head + 4 * h2;
#pragma unroll
      for (int i = 0; i < 16; ++i) impw[tok * IMPW + i * 8 + u] = 0.f; }
    WAVE_SYNC();

    {
        const bf16_t* Kc = (const bf16_t*)(p.ws + O_KC) + (size_t)bg * 512 * 64;
        const bf16_t* VcT = (const bf16_t*)(p.ws + O_KC) + (size_t)4096 * 64 + (size_t)bg * 64 * 512;
        const int tl = t0 + 7;
        const int ncmax = tl >= 31 ? ((tl - 31) >> 4) + 1 : 0;
        const int nblk = (ncmax + 63) >> 6;
        float m = NEG_BIG, l = 0.f;
#pragma unroll 1
        for (int blk = 0; blk < nblk; ++blk) {
            qk_block(st, qf, Kc + (size_t)(blk * 64 + q) * 64 + 8 * h2, 0.f);
            bias_mask<0>(st, t - 31 - 16 * (blk * 64 + 4 * h2), true, lut);
            const float mn = fmaxf(m, tile_max(st));
            float sum = 0.f;
#pragma unroll
            for (int sub = 0; sub < 2; ++sub)
#pragma unroll
                for (int r = 0; r < 16; ++r) sum += __builtin_amdgcn_exp2f(st[sub][r] - mn);
            l = l * __builtin_amdgcn_exp2f(m - mn) + sum; m = mn;
        }
        l = xhalf_sum(l);
        const float invl = l > 0.f ? 1.f / l : 0.f;
#pragma unroll 1
        for (int blk = 0; blk < nblk; ++blk) {
            qk_block(st, qf, Kc + (size_t)(blk * 64 + q) * 64 + 8 * h2, 0.f);
            bias_mask<0>(st, t - 31 - 16 * (blk * 64 + 4 * h2), true, lut);
#pragma unroll
            for (int sub = 0; sub < 2; ++sub)
#pragma unroll
                for (int r = 0; r < 16; ++r) st[sub][r] = __builtin_amdgcn_exp2f(st[sub][r] - m) * invl;
#pragma unroll
            for (int sub = 0; sub < 2; ++sub)
#pragma unroll
                for (int a = 0; a < 4; ++a) {
                    const float L = quad_sum(st[sub][4 * a + 3]);
                    const float G = quad_sum((st[sub][4 * a] + st[sub][4 * a + 1]) + (st[sub][4 * a + 2] + st[sub][4 * a + 3]));
                    const int j = blk * 16 + 8 * sub + 2 * a + h2;
                    if (head == 0) { atomicAdd(&impw[tok * IMPW + j], G); if (j + 1 < 128) atomicAdd(&impw[tok * IMPW + j + 1], L); }
                }
            pv_block(O, st, VcT + (size_t)q * 512 + blk * 64 + 8 * h2, 512);
        }
#pragma unroll
        for (int dt = 0; dt < 2; ++dt)
#pragma unroll
            for (int r = 0; r < 16; ++r) { F[dt][r] = gn[0] * O[dt][r]; O[dt][r] = 0.f; }
    }
    WAVE_SYNC();

    unsigned long long mlo, mhi;
    if (cur < 16) { mlo = (1ull << (cur + 1)) - 1ull; mhi = 0ull; }
    else {
        const int u = head + 4 * h2;
        float val[16];
#pragma unroll
        for (int i = 0; i < 16; ++i) { const int j = i * 8 + u; val[i] = (j >= 1 && j <= cur - 2) ? impw[tok * IMPW + j] : -1.f; }
        mlo = 1ull; mhi = 0ull;
        if (cur < 64) mlo |= 1ull << cur; else mhi |= 1ull << (cur - 64);
        if (cur - 1 < 64) mlo |= 1ull << (cur - 1); else mhi |= 1ull << (cur - 1 - 64);
#pragma unroll 1
        for (int round = 0; round < 13; ++round) {
            float bs = val[0]; int bj = u;
#pragma unroll
            for (int i = 1; i < 16; ++i) { if (val[i] > bs) { bs = val[i]; bj = i * 8 + u; } }
            { const float os = __uint_as_float(__builtin_amdgcn_update_dpp(0u, __float_as_uint(bs), 0xB1, 0xF, 0xF, true)); const int oj = __builtin_amdgcn_update_dpp(0, bj, 0xB1, 0xF, 0xF, true);
              if (os > bs || (os == bs && oj < bj)) { bs = os; bj = oj; } }
            { const float os = __uint_as_float(__builtin_amdgcn_update_dpp(0u, __float_as_uint(bs), 0x4E, 0xF, 0xF, true)); const int oj = __builtin_amdgcn_update_dpp(0, bj, 0x4E, 0xF, 0xF, true);
              if (os > bs || (os == bs && oj < bj)) { bs = os; bj = oj; } }
            { const float os = __shfl_xor(bs, 32); const int oj = __shfl_xor(bj, 32);
              if (os > bs || (os == bs && oj < bj)) { bs = os; bj = oj; } }
            if (bj < 64) mlo |= 1ull << bj; else mhi |= 1ull << (bj - 64);
#pragma unroll
            for (int i = 0; i < 16; ++i) if (i * 8 + u == bj) val[i] = -2.f;
        }
    }
    unsigned long long ulo = mlo, uhi = mhi;
#pragma unroll
    for (int o = 4; o < 32; o <<= 1) { ulo |= __shfl_xor(ulo, o); uhi |= __shfl_xor(uhi, o); }
    ulo = ((unsigned long long)__builtin_amdgcn_readfirstlane((unsigned)(ulo >> 32)) << 32) | (unsigned)__builtin_amdgcn_readfirstlane((unsigned)ulo);
    uhi = ((unsigned long long)__builtin_amdgcn_readfirstlane((unsigned)(uhi >> 32)) << 32) | (unsigned)__builtin_amdgcn_readfirstlane((unsigned)uhi);

    {
        const bf16_t* Ks = (const bf16_t*)(p.ws + O_KV) + (size_t)((2 * 4 + b) * 2 + g) * KV_SLAB;
        const bf16_t* VsT = (const bf16_t*)(p.ws + O_KV) + (size_t)((3 * 4 + b) * 2 + g) * KV_SLAB;
        float m = NEG_BIG, l = 0.f;
#pragma unroll 1
        for (int j = 0; j <= cur; ++j) {
            const bool inu = j < 64 ? ((ulo >> j) & 1ull) : ((uhi >> (j - 64)) & 1ull);
            if (!inu) continue;
            const bool selme = j < 64 ? ((mlo >> j) & 1ull) : ((mhi >> (j - 64)) & 1ull);
            const bool nearb = (64 * j + 63 + 1024 > t0);
            const bf16_t* kp = Ks + (size_t)(j * 64 + q) * 64 + 8 * h2;
            if (nearb) { qk_block(st, qf, kp, 0.f); bias_mask<1>(st, t - 64 * j - 4 * h2, selme, lut); }
            else qk_block(st, qf, kp, selme ? b31 : -INFINITY);
            softmax_step(st, O, m, l);
            pv_block(O, st, VsT + (size_t)q * SEQ + j * 64 + 8 * h2, SEQ);
        }
        l = xhalf_sum(l);
        const float sc = l > 0.f ? gn[1] / l : 0.f;
#pragma unroll
        for (int dt = 0; dt < 2; ++dt)
#pragma unroll
            for (int r = 0; r < 16; ++r) { F[dt][r] += sc * O[dt][r]; O[dt][r] = 0.f; }
    }
    {
        const bf16_t* Kw = (const bf16_t*)(p.ws + O_KV) + (size_t)((4 * 4 + b) * 2 + g) * KV_SLAB;
        const bf16_t* VwT = (const bf16_t*)(p.ws + O_KV) + (size_t)((5 * 4 + b) * 2 + g) * KV_SLAB;
        float m = NEG_BIG, l = 0.f;
        const int wlo = t0 - 511;
        const int r_begin = (wlo > 0 ? wlo : 0) & ~63;
#pragma unroll 1
        for (int row0 = r_begin; row0 <= t0 + 7; row0 += 64) {
            qk_block(st, qf, Kw + (size_t)(row0 + q) * 64 + 8 * h2, 0.f);
            bias_mask<2>(st, t - row0 - 4 * h2, true, lut);
            softmax_step(st, O, m, l);
            pv_block(O, st, VwT + (size_t)q * SEQ + row0 + 8 * h2, SEQ);
        }
        l = xhalf_sum(l);
        const float sc = l > 0.f ? gn[2] / l : 0.f;
#pragma unroll
        for (int dt = 0; dt < 2; ++dt)
#pragma unroll
            for (int r = 0; r < 16; ++r) F[dt][r] += sc * O[dt][r];
    }
    { bf16_t* op = (bf16_t*)(p.ws + O_ONSA) + (size_t)token * 512 + (g * 4 + head) * 64 + 4 * h2;
#pragma unroll
      for (int dt = 0; dt < 2; ++dt)
#pragma unroll
          for (int a = 0; a < 4; ++a)
              *(u32x2*)(op + dt * 32 + a * 8) = (u32x2){pk2(F[dt][4 * a], F[dt][4 * a + 1]), pk2(F[dt][4 * a + 2], F[dt][4 * a + 3])}; }
    WAVE_SYNC();
}

__device__ __forceinline__ void phase8(const Params& p, unsigned char* smem) {
    const int tid = threadIdx.x, lane = tid & 63, wid = tid >> 6;
    float* lutall = (float*)smem;
    float* impw = (float*)(smem + 4 * LUTW * 4) + wid * 8 * IMPW;
    const int bg = blockIdx.x & 7, g = bg & 1;
    for (int i = tid; i < 4 * 1025; i += NT) { const int head = i / 1025, idx = i % 1025; lutall[head * LUTW + idx] = p.in[2][rel_bucket_dev(idx) * 8 + g * 4 + head] * LOG2E; }
    __syncthreads();
    const int nblk_bg = (gridDim.x - bg + 7) >> 3;
    const int W = nblk_bg * 4, w = (blockIdx.x >> 3) * 4 + wid;
#pragma unroll 1
    for (int round = 0; ; ++round) {
        const int idx = round * W + ((round & 1) ? (W - 1 - w) : w);
        if (idx >= 1024) break;
        nsa_tile(p, bg, 1023 - idx, lutall, impw, lane);
    }
    __syncthreads();
}

struct EpiNsa { const bf16_t* SGN; bf16_t* MS5; int pm, pn;
    __device__ __forceinline__ void operator()(f32x4 (&acc)[4][4], int wr, int wc, int fr, int fq) const {
#pragma unroll
        for (int m = 0; m < 4; ++m) {
            const int token = pm * 128 + wr * 64 + m * 16 + fr;
#pragma unroll
            for (int n = 0; n < 4; ++n) {
                const int col = pn * 128 + wc * 64 + n * 16 + fq * 4;
                const u32x2 sg = *(const u32x2*)(SGN + (size_t)token * 1024 + col);
                const u32x2 ms = *(const u32x2*)(MS5 + (size_t)token * 1024 + col);
                const f32x4 v = acc[m][n];
                *(u32x2*)(MS5 + (size_t)token * 1024 + col) = (u32x2){pk2(bflo(ms.x) + bflo(sg.x) * v[0], bfhi(ms.x) + bfhi(sg.x) * v[1]), pk2(bflo(ms.y) + bflo(sg.y) * v[2], bfhi(ms.y) + bfhi(sg.y) * v[3])};
            }
        }
    } };
__device__ __forceinline__ void phase9(const Params& p, unsigned char* smem) {
    for (int item = blockIdx.x; item < 256 * 8; item += gridDim.x) {
        const int pm = item >> 3, pn = item & 7;
        LoadBf16 al{(const bf16_t*)(p.ws + O_ONSA) + (size_t)pm * 128 * 512, 512};
        LoadBf16 bl{(const bf16_t*)(p.ws + O_WT_NSA) + (size_t)pn * 128 * 512, 512};
        EpiNsa ep{(const bf16_t*)(p.ws + O_SGN), (bf16_t*)(p.ws + O_MS5), pm, pn};
        gemm_tile(8, al, bl, ep, smem);
    }
}
struct EpiOut { const float* x; const float* ga; float* Z1; int pm, pn;
    __device__ __forceinline__ void operator()(f32x4 (&acc)[4][4], int wr, int wc, int fr, int fq) const {
#pragma unroll
        for (int m = 0; m < 4; ++m) {
            const int token = pm * 128 + wr * 64 + m * 16 + fr;
#pragma unroll
            for (int n = 0; n < 4; ++n) {
                const int col = pn * 128 + wc * 64 + n * 16 + fq * 4;
                const f32x4 xv = *(const f32x4*)(x + (size_t)token * 1024 + col), gv = *(const f32x4*)(ga + col);
                *(f32x4*)(Z1 + (size_t)token * 1024 + col) = xv * DN_ALPHA + gv * acc[m][n];
            }
        }
    } };
__device__ __forceinline__ void phase10(const Params& p, unsigned char* smem) {
    for (int item = blockIdx.x; item < 256 * 8; item += gridDim.x) {
        const int pm = item >> 3, pn = item & 7, b = pm >> 6;
        LoadBf16 al{(const bf16_t*)(p.ws + O_MS5) + (size_t)pm * 128 * 1024, 1024};
        LoadBf16 bl{(const bf16_t*)(p.ws + O_WT_OUT) + (size_t)pn * 128 * 1024, 1024};
        EpiOut ep{p.in[0], (const float*)(p.ws + O_ADA) + b * 6144 + 2048, (float*)(p.ws + O_Z1), pm, pn};
        gemm_tile(16, al, bl, ep, smem);
    }
}

__device__ __forceinline__ void phase11(const Params& p, unsigned char* smem) {
    const int tid = threadIdx.x, lane = tid & 63, wid = tid >> 6;
    float* hs = (float*)smem + wid * 1024;
    const float* lg = p.in[24]; const float* lb = p.in[25]; const float* wr_ = p.in[26]; const float* br_ = p.in[27];
    unsigned* cnt = (unsigned*)(p.ws + O_CNT);
    for (int item = blockIdx.x; item < NTOK / 4; item += gridDim.x) {
        const int token = item * 4 + wid, b = token >> 13;
        float* zr = (float*)(p.ws + O_Z1) + (size_t)token * 1024;
        const float* ada = (const float*)(p.ws + O_ADA) + b * 6144;
        f32x4 v[4]; float s = 0.f;
#pragma unroll
        for (int j = 0; j < 4; ++j) { v[j] = *(const f32x4*)(zr + j * 256 + lane * 4); s += (v[j][0] + v[j][1]) + (v[j][2] + v[j][3]); }
        const float mean = wave_sum(s) * (1.f / 1024.f); float q = 0.f;
#pragma unroll
        for (int j = 0; j < 4; ++j) { v[j] = v[j] - mean; q += (v[j][0] * v[j][0] + v[j][1] * v[j][1]) + (v[j][2] * v[j][2] + v[j][3] * v[j][3]); }
        const float rstd = rsqrtf(wave_sum(q) * (1.f / 1024.f) + LN_EPS);
        bf16_t* h2 = (bf16_t*)(p.ws + O_H2) + (size_t)token * 1024;
#pragma unroll
        for (int j = 0; j < 4; ++j) {
            const int c = j * 256 + lane * 4;
            const f32x4 x1 = v[j] * rstd * *(const f32x4*)(lg + c) + *(const f32x4*)(lb + c);
            *(f32x4*)(zr + c) = x1;
            const f32x4 hv = x1 * (*(const f32x4*)(ada + 4096 + c) + 1.f) + *(const f32x4*)(ada + 3072 + c);
            *(f32x4*)(hs + c) = hv;
            *(u32x2*)(h2 + c) = (u32x2){pk2(hv[0], hv[1]), pk2(hv[2], hv[3])};
        }
        WAVE_SYNC();
        const int e = lane & 31, kh = lane >> 5;
        float a = 0.f;
#pragma unroll 8
        for (int k = kh * 512; k < kh * 512 + 512; ++k) a += hs[k] * wr_[k * 32 + e];
        a += __shfl_xor(a, 32);
        a += br_[e];
        float val = a; int te[4]; float tv[4];
#pragma unroll
        for (int r = 0; r < 4; ++r) {
            float bs = val; int bj = e;
#pragma unroll
            for (int o = 1; o < 32; o <<= 1) { const float os = __shfl_xor(bs, o); const int oj = __shfl_xor(bj, o); if (os > bs || (os == bs && oj < bj)) { bs = os; bj = oj; } }
            te[r] = bj; tv[r] = bs;
            if (e == bj) val = -INFINITY;
        }
        const float e0 = 1.f, e1 = __expf(tv[1] - tv[0]), e2 = __expf(tv[2] - tv[0]), e3 = __expf(tv[3] - tv[0]);
        const float inv = 1.f / (e0 + e1 + e2 + e3);
        if (lane < 4) {
            const int ee = lane == 0 ? te[0] : (lane == 1 ? te[1] : (lane == 2 ? te[2] : te[3]));
            const float gg = (lane == 0 ? e0 : (lane == 1 ? e1 : (lane == 2 ? e2 : e3))) * inv;
            const unsigned pos = atomicAdd(cnt + ee, 1u);
            ((int*)(p.ws + O_TOPE))[token * 4 + lane] = ee;
            ((unsigned*)(p.ws + O_TOPP))[token * 4 + lane] = pos;
            ((float*)(p.ws + O_TOPG))[token * 4 + lane] = gg;
        }
        WAVE_SYNC();
    }
}

__device__ __forceinline__ void load_offsets(const Params& p, int* offs  , int* toff  ) {
    if (threadIdx.x == 0) {
        const unsigned* cnt = (const unsigned*)(p.ws + O_CNT);
        int a = 0, t = 0;
        for (int e = 0; e < 32; ++e) { offs[e] = a; toff[e] = t; const int c = (int)cnt[e]; a += c; t += (c + 127) >> 7; }
        offs[32] = a; toff[32] = t;
    }
    __syncthreads();
}
__device__ __forceinline__ void phase12(const Params& p, unsigned char* smem) {
    int* offs = (int*)smem; int* toff = offs + 40;
    load_offsets(p, offs, toff);
    const int* tope = (const int*)(p.ws + O_TOPE); const unsigned* topp = (const unsigned*)(p.ws + O_TOPP); const float* topg = (const float*)(p.ws + O_TOPG);
    int* rowtok = (int*)(p.ws + O_ROWTOK); float* rowgate = (float*)(p.ws + O_ROWGATE); int* tokrow = (int*)(p.ws + O_TOKROW);
    for (int i = blockIdx.x * NT + threadIdx.x; i < NROWS; i += gridDim.x * NT) {
        const int R = offs[tope[i]] + (int)topp[i];
        rowtok[R] = i >> 2; rowgate[R] = topg[i]; tokrow[i] = R;
    }
    __syncthreads();
}

struct LoadGather { const bf16_t* rp[4]; __device__ __forceinline__ u32x4 operator()(int i, int, int k) const { return *(const u32x4*)(rp[i] + k); } };
struct EpiGU { const float* bgu; bf16_t* ACT; int R0, nvalid, pn;
    __device__ __forceinline__ void operator()(f32x4 (&acc)[4][4], int wr, int wc, int fr, int fq) const {
#pragma unroll
        for (int m = 0; m < 4; ++m) {
            const int lr = wr * 64 + m * 16 + fr;
            if (lr < nvalid) {
#pragma unroll
                for (int n = 0; n < 2; ++n) {
                    const int cv = pn * 64 + wc * 32 + n * 16 + fq * 4;
                    const f32x4 ga = acc[m][n] + *(const f32x4*)(bgu + cv), ua = acc[m][n + 2] + *(const f32x4*)(bgu + 1024 + cv);
                    float o[4];
#pragma unroll
                    for (int j = 0; j < 4; ++j) { const float gt = fminf(ga[j], 7.f), up = fminf(fmaxf(ua[j], -7.f), 7.f); o[j] = (up + 1.f) * gt * sigmoidf_(1.702f * gt); }
                    *(u32x2*)(ACT + (size_t)(R0 + lr) * 1024 + cv) = (u32x2){pk2(o[0], o[1]), pk2(o[2], o[3])};
                }
            }
        }
    } };
__device__ __forceinline__ void phase13(const Params& p, unsigned char* smem) {
    int* offs = (int*)(smem + 40960); int* toff = offs + 40;
    load_offsets(p, offs, toff);
    const int ntile = toff[32];
    const int* rowtok = (const int*)(p.ws + O_ROWTOK);
    const int tid = threadIdx.x, prow = tid >> 3;
    for (int item = blockIdx.x; item < ntile * 16; item += gridDim.x) {
        const int tile = item >> 4, pn = item & 15;
        int e = 0;
#pragma unroll 1
        while (toff[e + 1] <= tile) ++e;
        const int mt = tile - toff[e], R0 = offs[e] + mt * 128, nvalid = offs[e + 1] - R0;
        LoadGather al;
#pragma unroll
        for (int i = 0; i < 4; ++i) { int R = R0 + prow + i * 32; R = R < NROWS ? R : NROWS - 1; al.rp[i] = (const bf16_t*)(p.ws + O_H2) + (size_t)rowtok[R] * 1024; }
        LoadBf16 bl{(const bf16_t*)(p.ws + O_WT_GU) + ((size_t)e * 2048 + pn * 128) * 1024, 1024};
        EpiGU ep{p.in[29] + (size_t)e * 2048, (bf16_t*)(p.ws + O_ACT), R0, nvalid, pn};
        gemm_tile(16, al, bl, ep, smem);
    }
    __syncthreads();
}
struct EpiDn { const float* bd; const float* rowgate; bf16_t* YK; int R0, nvalid, pn;
    __device__ __forceinline__ void operator()(f32x4 (&acc)[4][4], int wr, int wc, int fr, int fq) const {
#pragma unroll
        for (int m = 0; m < 4; ++m) {
            const int lr = wr * 64 + m * 16 + fr;
            if (lr < nvalid) {
                const float gw = rowgate[R0 + lr];
#pragma unroll
                for (int n = 0; n < 4; ++n) {
                    const int col = pn * 128 + wc * 64 + n * 16 + fq * 4;
                    const f32x4 v = (acc[m][n] + *(const f32x4*)(bd + col)) * gw;
                    *(u32x2*)(YK + (size_t)(R0 + lr) * 1024 + col) = (u32x2){pk2(v[0], v[1]), pk2(v[2], v[3])};
                }
            }
        }
    } };
__device__ __forceinline__ void phase14(const Params& p, unsigned char* smem) {
    int* offs = (int*)(smem + 40960); int* toff = offs + 40;
    load_offsets(p, offs, toff);
    const int ntile = toff[32];
    for (int item = blockIdx.x; item < ntile * 8; item += gridDim.x) {
        const int tile = item >> 3, pn = item & 7;
        int e = 0;
#pragma unroll 1
        while (toff[e + 1] <= tile) ++e;
        const int mt = tile - toff[e], R0 = offs[e] + mt * 128, nvalid = offs[e + 1] - R0;
        LoadBf16 al{(const bf16_t*)(p.ws + O_ACT) + (size_t)R0 * 1024, 1024};
        LoadBf16 bl{(const bf16_t*)(p.ws + O_WT_DN) + ((size_t)e * 1024 + pn * 128) * 1024, 1024};
        EpiDn ep{p.in[31] + (size_t)e * 1024, (const float*)(p.ws + O_ROWGATE), (bf16_t*)(p.ws + O_YK), R0, nvalid, pn};
        gemm_tile(16, al, bl, ep, smem);
    }
    __syncthreads();
}

__device__ __forceinline__ void phase15(const Params& p, unsigned char*) {
    const int tid = threadIdx.x, lane = tid & 63, wid = tid >> 6;
    const float* lg = p.in[32]; const float* lb = p.in[33];
    const int* tokrow = (const int*)(p.ws + O_TOKROW);
    const bf16_t* YK = (const bf16_t*)(p.ws + O_YK);
    for (int item = blockIdx.x; item < NTOK / 4; item += gridDim.x) {
        const int token = item * 4 + wid, b = token >> 13;
        const float* x1 = (const float*)(p.ws + O_Z1) + (size_t)token * 1024;
        const float* gf = (const float*)(p.ws + O_ADA) + b * 6144 + 5120;
        const int r0 = tokrow[token * 4 + 0], r1 = tokrow[token * 4 + 1], r2 = tokrow[token * 4 + 2], r3 = tokrow[token * 4 + 3];
        f32x4 v[4]; float s = 0.f;
#pragma unroll
        for (int j = 0; j < 4; ++j) {
            const int c = j * 256 + lane * 4;
            const u32x2 a0 = *(const u32x2*)(YK + (size_t)r0 * 1024 + c), a1 = *(const u32x2*)(YK + (size_t)r1 * 1024 + c), a2 = *(const u32x2*)(YK + (size_t)r2 * 1024 + c), a3 = *(const u32x2*)(YK + (size_t)r3 * 1024 + c);
            f32x4 y;
            y[0] = (bflo(a0.x) + bflo(a1.x)) + (bflo(a2.x) + bflo(a3.x)); y[1] = (bfhi(a0.x) + bfhi(a1.x)) + (bfhi(a2.x) + bfhi(a3.x));
            y[2] = (bflo(a0.y) + bflo(a1.y)) + (bflo(a2.y) + bflo(a3.y)); y[3] = (bfhi(a0.y) + bfhi(a1.y)) + (bfhi(a2.y) + bfhi(a3.y));
            v[j] = *(const f32x4*)(x1 + c) * DN_ALPHA + *(const f32x4*)(gf + c) * y;
            s += (v[j][0] + v[j][1]) + (v[j][2] + v[j][3]);
        }
        const float mean = wave_sum(s) * (1.f / 1024.f); float q = 0.f;
#pragma unroll
        for (int j = 0; j < 4; ++j) { v[j] = v[j] - mean; q += (v[j][0] * v[j][0] + v[j][1] * v[j][1]) + (v[j][2] * v[j][2] + v[j][3] * v[j][3]); }
        const float rstd = rsqrtf(wave_sum(q) * (1.f / 1024.f) + LN_EPS);
#pragma unroll
        for (int j = 0; j < 4; ++j) { const int c = j * 256 + lane * 4; *(f32x4*)(p.out + (size_t)token * 1024 + c) = v[j] * rstd * *(const f32x4*)(lg + c) + *(const f32x4*)(lb + c); }
    }
}

template <bool COOP>
__global__ void __launch_bounds__(NT, 2) fwd_kernel(Params p) {
    __shared__ __attribute__((aligned(16))) unsigned char smem[SMEM_BYTES];
    const int lo = p.ph_lo, hi = p.ph_hi;
#define RUN_PHASE(k) if (((PH_MASK >> (k)) & 1) && lo <= (k) && (k) < hi) { phase##k(p, smem); if ((REPEAT_MASK >> (k)) & 1) { if (COOP) cg::this_grid().sync(); phase##k(p, smem); } } if (COOP) { if (lo <= (k) && (k) + 1 < hi) cg::this_grid().sync(); }
    RUN_PHASE(0)
    RUN_PHASE(1)
    RUN_PHASE(2)
    RUN_PHASE(3)
    RUN_PHASE(4)
    RUN_PHASE(5)
    RUN_PHASE(6)
    RUN_PHASE(7)
    RUN_PHASE(8)
    RUN_PHASE(9)
    RUN_PHASE(10)
    RUN_PHASE(11)
    RUN_PHASE(12)
    RUN_PHASE(13)
    RUN_PHASE(14)
    RUN_PHASE(15)
#undef RUN_PHASE
}

extern "C" void kernel_launch(void* const* d_in, const int* in_sizes, int n_in, void* d_out, int out_size, void* d_ws, size_t ws_size, hipStream_t stream) {
    static int grid = 0;
    if (grid == 0) {
        if (n_in != 34 || out_size != NTOK * DM || ws_size < WS_NEED) { fprintf(stderr, "kernel_launch: unexpected problem (n_in %d, out %d, ws %zu need %zu)\n", n_in, out_size, ws_size, (size_t)WS_NEED); grid = -1; return; }
        int dev = 0, cus = 0, per_cu = 0;
        hipGetDevice(&dev);
        hipDeviceGetAttribute(&cus, hipDeviceAttributeMultiprocessorCount, dev);
#if ONE_LAUNCH
        hipOccupancyMaxActiveBlocksPerMultiprocessor(&per_cu, fwd_kernel<true>, NT, 0);
#else
        hipOccupancyMaxActiveBlocksPerMultiprocessor(&per_cu, fwd_kernel<false>, NT, 0);
#endif
        if (per_cu < 1) per_cu = 1;
        grid = cus * per_cu;
        fprintf(stderr, "kernel_launch: grid %d (%d CUs x %d)\n", grid, cus, per_cu);
    }
    if (grid < 0) return;
    Params p{};
    for (int i = 0; i < 34; ++i) p.in[i] = (const float*)d_in[i];
    p.out = (float*)d_out; p.ws = (unsigned char*)d_ws;
#if ONE_LAUNCH
    p.ph_lo = 0; p.ph_hi = NPHASE;
    void* args[] = {&p};
    hipError_t e = hipLaunchCooperativeKernel((void*)fwd_kernel<true>, dim3(grid), dim3(NT), args, 0, stream);
    if (e != hipSuccess) fprintf(stderr, "cooperative launch failed: %s (grid %d)\n", hipGetErrorString(e), grid);
#else
    for (int ph = 0; ph < NPHASE; ++ph) {
        p.ph_lo = ph; p.ph_hi = ph + 1;
        hipLaunchKernelGGL(fwd_kernel<false>, dim3(grid), dim3(NT), 0, stream, p);
    }
#endif
}
static_assert(WS_NEED <= (size_t)1073741824, "workspace map exceeds 1 GiB");
```

```cpp
#include <hip/hip_runtime.h>
#include <hip/hip_cooperative_groups.h>
#include <cstdio>
#include <cstdint>
namespace cg = cooperative_groups;

#ifndef PH_MASK
#define PH_MASK 0xFFFFF
#endif
#ifndef REPEAT_MASK
#define REPEAT_MASK 0
#endif
#ifndef ONE_LAUNCH
#define ONE_LAUNCH 1
#endif

#define LAS __attribute__((address_space(3)))
typedef unsigned short bf16_t;
typedef short bf16x8 __attribute__((ext_vector_type(8)));
typedef float f32x4 __attribute__((ext_vector_type(4)));
typedef float f32x2 __attribute__((ext_vector_type(2)));
typedef unsigned u32x4 __attribute__((ext_vector_type(4)));
typedef unsigned u32x2 __attribute__((ext_vector_type(2)));
typedef __bf16 bf16x2_t __attribute__((ext_vector_type(2)));

constexpr int NB = 4, SEQ = 8192, NTOK = NB * SEQ, DM = 1024;
constexpr int NIN_PAD = 4096;
constexpr int NEXP = 32, TOPK = 4, NROWS = NTOK * TOPK;
constexpr int S5L = 32;
constexpr int NCHUNK = SEQ / S5L;
constexpr int UROW = 640;
constexpr float DN_ALPHA = 1.189207115002721f;
constexpr float LN_EPS = 1e-5f;
constexpr float LOG2E = 1.4426950408889634f;
constexpr float QSCALE = 0.125f * 1.4426950408889634f;
constexpr int NT = 512;
constexpr int NWV = NT / 64;

constexpr size_t al256(size_t x) { return (x + 255) & ~(size_t)255; }
constexpr size_t O_ADA = 0;
constexpr size_t O_CNT = O_ADA + al256(4 * 6144 * 4);
constexpr size_t O_LAML = O_CNT + 1024;
constexpr size_t O_BIAS1 = O_LAML + al256(32 * 64 * 2 * 4);
constexpr size_t O_WT_IN = O_BIAS1 + al256(2 * 8 * 128 * 4);
constexpr size_t O_WT_GLU = O_WT_IN + al256((size_t)NIN_PAD * 1024 * 2);
constexpr size_t O_WT_NSA = O_WT_GLU + al256((size_t)2048 * 512 * 2);
constexpr size_t O_WT_OUT = O_WT_NSA + al256((size_t)1024 * 512 * 2);
constexpr size_t O_WT_C1 = O_WT_OUT + al256((size_t)1024 * 1024 * 2);
constexpr size_t O_W1T = O_WT_C1 + al256((size_t)2 * 256 * 2048 * 2);
constexpr size_t O_TW2 = O_W1T + al256((size_t)32 * 256 * 512 * 2);
constexpr size_t O_WT_GU = O_TW2 + al256((size_t)32 * 512 * 640 * 2);
constexpr size_t O_WT_DN = O_WT_GU + al256((size_t)32 * 2048 * 1024 * 2);
constexpr size_t O_H2 = O_WT_DN + al256((size_t)32 * 1024 * 1024 * 2);
constexpr size_t O_Z1 = O_H2 + al256((size_t)NTOK * 1024 * 2);
constexpr size_t O_TOPE = O_Z1 + al256((size_t)NTOK * 1024 * 4);
constexpr size_t O_TOPP = O_TOPE + al256((size_t)NROWS * 4);
constexpr size_t O_TOPG = O_TOPP + al256((size_t)NROWS * 4);
constexpr size_t O_ROWGATE = O_TOPG + al256((size_t)NROWS * 4);
constexpr size_t O_TOKROW = O_ROWGATE + al256((size_t)(NROWS + 256) * 4);
constexpr size_t O_OVL = O_TOKROW + al256((size_t)NROWS * 4);
constexpr size_t O_U = O_OVL;
constexpr size_t O_E = O_U + al256((size_t)32 * 1024 * UROW * 2);
constexpr size_t O_YS = O_E + al256((size_t)32 * 1024 * 128 * 4);
constexpr size_t O_Q = O_YS + al256((size_t)NTOK * 512 * 2);
constexpr size_t O_KV = O_Q + al256((size_t)NTOK * 512 * 2);
constexpr size_t KV_SLAB = (size_t)SEQ * 64;
constexpr size_t O_SG5 = O_KV + al256((size_t)6 * 8 * KV_SLAB * 2 + 8192);
constexpr size_t O_SGN = O_SG5 + al256((size_t)NTOK * 1024 * 2);
constexpr size_t O_GN = O_SGN + al256((size_t)NTOK * 1024 * 2);
constexpr size_t O_MS5 = O_GN + al256((size_t)NTOK * 24 * 4);
constexpr size_t O_ONSA = O_MS5 + al256((size_t)NTOK * 1024 * 2);
constexpr size_t O_HC = O_ONSA + al256((size_t)NTOK * 512 * 2);
constexpr size_t O_KC = O_HC + al256((size_t)2 * 4096 * 128 * 2);
constexpr size_t O_XN = O_KC + al256((size_t)2 * 4096 * 64 * 2);
constexpr size_t O_END1 = O_XN + al256((size_t)NTOK * 1024 * 2);
constexpr size_t O_HS = O_OVL;
constexpr size_t O_YK = O_HS;
constexpr size_t O_ACT = O_HS + al256((size_t)(NROWS + 256) * 1024 * 2);
constexpr size_t O_END2 = O_ACT + al256((size_t)(NROWS + 256) * 1024 * 2);
constexpr size_t WS_NEED = O_END1 > O_END2 ? O_END1 : O_END2;
static_assert(WS_NEED <= (size_t)1073741824, "workspace map exceeds 1 GiB");

constexpr int LDS_BYTES = 147456;
constexpr int LDS_TAB = 131072;
constexpr int NPHASE = 15;

struct Params {
    const float* in[34];
    float* out;
    unsigned char* ws;
    int ph_lo, ph_hi;
};

__device__ __forceinline__ unsigned pk2(float lo, float hi) { f32x2 v = {lo, hi}; bf16x2_t b = __builtin_convertvector(v, bf16x2_t); return __builtin_bit_cast(unsigned, b); }
__device__ __forceinline__ bf16_t f2bf(float f) { return (bf16_t)(pk2(f, 0.f) & 0xffffu); }
__device__ __forceinline__ float bf2f(bf16_t h) { return __uint_as_float(((unsigned)h) << 16); }
__device__ __forceinline__ float bflo(unsigned w) { return __uint_as_float(w << 16); }
__device__ __forceinline__ float bfhi(unsigned w) { return __uint_as_float(w & 0xffff0000u); }
__device__ __forceinline__ float sigmoidf_(float x) { return 1.f / (1.f + __expf(-x)); }
__device__ __forceinline__ float gelu_tanh(float x) { const float u = 0.7978845608028654f * (x + 0.044715f * x * x * x); const float e = __expf(2.f * u); return 0.5f * x * (2.f - 2.f / (e + 1.f)); }
__device__ __forceinline__ float wave_sum(float v) {
#pragma unroll
    for (int o = 1; o < 64; o <<= 1) v += __shfl_xor(v, o);
    return v;
}
#define WAVE_SYNC() do { __builtin_amdgcn_fence(__ATOMIC_RELEASE, "wavefront"); __builtin_amdgcn_wave_barrier(); __builtin_amdgcn_fence(__ATOMIC_ACQUIRE, "wavefront"); } while (0)

namespace pg8 {
constexpr int BM = 256, BK = 64, HALF = 128, HTB = HALF * BK * 2, STAGE_BYTES = 8 * HTB;
__device__ __forceinline__ int lds_byte(int r, int c) { const int st = (r >> 4) * 2 + (c >> 5), rr = r & 15, cc = c & 31, ob = rr * 64 + cc * 2; return st * 1024 + (ob ^ (((ob >> 9) & 1) << 5)); }
__device__ __forceinline__ void stage_rc(int b, int& R, int& C) { const int st = b / 1024, sb = b % 1024, swz = sb ^ (((sb >> 9) & 1) << 5); R = (st >> 1) * 16 + swz / 64; C = (st & 1) * 32 + (swz % 64) / 2; }
__device__ __forceinline__ int perm32(int rho) { const int n = rho >> 4, i = rho & 15; return 8 * (i >> 2) + 4 * n + (i & 3); }
struct Unit { const char* A; const char* B; int pm, pn, e, nvalid; };

template <class Epi, class Sched, bool ALIGN_EPI>
__device__ __forceinline__ void gemm_phase(LAS unsigned char* lds, const int K, const int lda, const int ldb, const Sched& S, const Epi& E) {
    const int tid = threadIdx.x, wid = __builtin_amdgcn_readfirstlane(tid >> 6), lane = tid & 63, wr = wid >> 2, wc = wid & 3, fr = lane & 15, fq = lane >> 4;
    const int nt = K / BK;
    unsigned voffA[2], voffB[2];
#pragma unroll
    for (int i = 0; i < 2; ++i) { int R, C; stage_rc(tid * 16 + i * 8192, R, C); const int Rb = Epi::PERM ? ((R & ~31) + perm32(R & 31)) : R;
        voffA[i] = (unsigned)(R * lda + C) * 2u; voffB[i] = (unsigned)(Rb * ldb + C) * 2u; }
    const size_t kstep = (size_t)(BK * 2);
    const size_t hstepA = (size_t)HALF * lda * 2, hstepB = (size_t)HALF * ldb * 2;
    const unsigned ldsw = (unsigned)wid * 1024u;
    const int aoff = lds_byte(wr * 64 + fr, fq * 8), boff = lds_byte(wc * 32 + fr, fq * 8);
#define PG8_SA(b, h) (((b) * 2 + (h)) * HTB)
#define PG8_SB(b, h) ((4 + (b) * 2 + (h)) * HTB)
#define PG8_STAGE(bufoff, gbase, voff) do { _Pragma("unroll") for (int _i = 0; _i < 2; ++_i) \
        __builtin_amdgcn_global_load_lds((const unsigned*)((const char*)(gbase) + (voff)[_i]), (LAS unsigned*)(lds + (bufoff) + ldsw + _i * 8192), 16, 0, 0); } while (0)
#define PG8_LDA(dst, b, h) do { _Pragma("unroll") for (int m = 0; m < 4; ++m) _Pragma("unroll") for (int k = 0; k < 2; ++k) dst[m][k] = *(const LAS bf16x8*)(lds + PG8_SA(b, h) + aoff + m * 2048 + k * 1024); } while (0)
#define PG8_LDB(dst, b, h) do { _Pragma("unroll") for (int n = 0; n < 2; ++n) _Pragma("unroll") for (int k = 0; k < 2; ++k) dst[n][k] = *(const LAS bf16x8*)(lds + PG8_SB(b, h) + boff + n * 2048 + k * 1024); } while (0)
#define PG8_MMA(ai, bj, At, Bt) do { __builtin_amdgcn_s_setprio(1); _Pragma("unroll") for (int m = 0; m < 4; ++m) _Pragma("unroll") for (int n = 0; n < 2; ++n) _Pragma("unroll") for (int k = 0; k < 2; ++k) \
        acc[ai][bj][m][n] = __builtin_amdgcn_mfma_f32_16x16x32_bf16(Bt[n][k], At[m][k], acc[ai][bj][m][n], 0, 0, 0); __builtin_amdgcn_s_setprio(0); } while (0)
#define PG8_WAIT_V(n) asm volatile("s_waitcnt vmcnt(" #n ")" ::: "memory")
#define PG8_WAIT_L(n) asm volatile("s_waitcnt lgkmcnt(" #n ")" ::: "memory")
#define PG8_BAR __builtin_amdgcn_s_barrier()
#define PG8_SCHED __builtin_amdgcn_sched_barrier(0)
    Unit cur, nxt; int ui = 0;
    if (!S.next(0, cur)) return;
    f32x4 acc[2][2][4][2];
#pragma unroll
    for (int a = 0; a < 2; ++a)
#pragma unroll
        for (int b = 0; b < 2; ++b)
#pragma unroll
            for (int m = 0; m < 4; ++m)
#pragma unroll
                for (int n = 0; n < 2; ++n) acc[a][b][m][n] = (f32x4){0.f, 0.f, 0.f, 0.f};
    bf16x8 At[4][2], B0[2][2], B1[2][2];
    const char* cA = cur.A; const char* cB = cur.B;
    PG8_STAGE(PG8_SB(0, 0), cB, voffB); PG8_STAGE(PG8_SB(0, 1), cB + hstepB, voffB); PG8_STAGE(PG8_SA(0, 0), cA, voffA); PG8_STAGE(PG8_SA(0, 1), cA + hstepA, voffA);
    if (wr == 1) PG8_BAR;
    PG8_WAIT_V(2); PG8_BAR;
    PG8_STAGE(PG8_SB(1, 0), cB + kstep, voffB); PG8_STAGE(PG8_SA(1, 0), cA + kstep, voffA); PG8_STAGE(PG8_SB(1, 1), cB + hstepB + kstep, voffB);
    PG8_WAIT_V(6); PG8_BAR;
    for (;;) {
        const bool has_next = S.next(ui + 1, nxt);
        const char* nA = has_next ? nxt.A : cA; const char* nB = has_next ? nxt.B : cB;
        for (int t = 0; t < nt; t += 2) {
            const bool last = (t == nt - 2);
            const char* a1 = cA + (size_t)(t + 1) * kstep;
            const char* a2 = last ? nA : cA + (size_t)(t + 2) * kstep; const char* b2 = last ? nB : cB + (size_t)(t + 2) * kstep;
            const char* a3 = a2 + kstep; const char* b3 = b2 + kstep;
            PG8_LDB(B0, 0, 0); PG8_LDB(B1, 0, 1); PG8_SCHED; PG8_LDA(At, 0, 0); PG8_STAGE(PG8_SA(1, 1), a1 + hstepA, voffA);
            PG8_WAIT_V(8); PG8_WAIT_L(0); PG8_BAR; PG8_MMA(0, 0, At, B0); PG8_MMA(0, 1, At, B1); PG8_BAR; PG8_SCHED;
            PG8_LDA(At, 0, 1); PG8_STAGE(PG8_SB(0, 0), b2, voffB); PG8_STAGE(PG8_SB(0, 1), b2 + hstepB, voffB); PG8_STAGE(PG8_SA(0, 0), a2, voffA);
            PG8_WAIT_V(8); PG8_WAIT_L(0); PG8_BAR; PG8_MMA(1, 0, At, B0); PG8_MMA(1, 1, At, B1); PG8_BAR; PG8_SCHED;
            PG8_LDB(B0, 1, 0); PG8_LDB(B1, 1, 1); PG8_SCHED; PG8_LDA(At, 1, 0); PG8_STAGE(PG8_SA(0, 1), a2 + hstepA, voffA);
            PG8_WAIT_V(8); PG8_WAIT_L(0); PG8_BAR; PG8_MMA(0, 0, At, B0); PG8_MMA(0, 1, At, B1); PG8_BAR; PG8_SCHED;
            PG8_LDA(At, 1, 1); PG8_STAGE(PG8_SB(1, 0), b3, voffB); PG8_STAGE(PG8_SB(1, 1), b3 + hstepB, voffB); PG8_STAGE(PG8_SA(1, 0), a3, voffA);
            PG8_WAIT_V(8); PG8_WAIT_L(0); PG8_BAR; PG8_MMA(1, 0, At, B0); PG8_MMA(1, 1, At, B1); PG8_BAR; PG8_SCHED;
        }
        if constexpr (ALIGN_EPI) { if (wr == 0) PG8_BAR; }
        E(acc, cur, wr, wc, fr, fq);
        if (!has_next) break;
#pragma unroll
        for (int a = 0; a < 2; ++a)
#pragma unroll
            for (int b = 0; b < 2; ++b)
#pragma unroll
                for (int m = 0; m < 4; ++m)
#pragma unroll
                    for (int n = 0; n < 2; ++n) acc[a][b][m][n] = (f32x4){0.f, 0.f, 0.f, 0.f};
        cur = nxt; cA = nA; cB = nB; ++ui;
        if constexpr (ALIGN_EPI) { if (wr == 1) PG8_BAR; }
    }
    PG8_WAIT_V(0);
    if constexpr (!ALIGN_EPI) { if (wr == 0) PG8_BAR; }
    PG8_BAR;
#undef PG8_SA
#undef PG8_SB
#undef PG8_STAGE
#undef PG8_LDA
#undef PG8_LDB
#undef PG8_MMA
#undef PG8_WAIT_V
#undef PG8_WAIT_L
#undef PG8_BAR
#undef PG8_SCHED
}

struct DenseOrder {
    const char* A; const char* B; size_t tstepA, tstepB; int nM, nN, nwg, G, c;
    __device__ __forceinline__ void init(const void* A_, const void* B_, int M, int N, int lda, int ldb, int G_, int c_) {
        A = (const char*)A_; B = (const char*)B_; tstepA = (size_t)BM * lda * 2; tstepB = (size_t)BM * ldb * 2; nM = M / BM; nN = N / BM; nwg = nM * nN; G = G_; c = c_; }
    __device__ __forceinline__ bool next(int i, Unit& u) const {
        const long L = (long)i * G + c; if (L >= nwg) return false;
        int wgid = (int)L; { const int q = nwg / 8, r = nwg % 8, xcd = wgid % 8, off = wgid / 8; wgid = (xcd < r ? xcd * (q + 1) : r * (q + 1) + (xcd - r) * q) + off; }
        const int nig = 8 * nN, gid = wgid / nig, fm = gid * 8, gsz = (nM - fm) < 8 ? (nM - fm) : 8;
        u.pm = fm + ((wgid % nig) % gsz); u.pn = (wgid % nig) / gsz; u.e = 0; u.nvalid = 256;
        u.A = A + (size_t)u.pm * tstepA; u.B = B + (size_t)u.pn * tstepB; return true;
    }
};
}

__device__ __forceinline__ int map_in(int n) { return n < 1792 ? n : (n < 3840 ? n + 24 : (n < 3864 ? 1792 + (n - 3840) : -1)); }
__device__ __forceinline__ int map_il128(int n) { const int b = n >> 7; return (b & 1) * 1024 + (b >> 1) * 128 + (n & 127); }

template <int MAP>
__device__ __forceinline__ void transpose_tile(const float* W, int K, int Nsrc, bf16_t* Wt, int kt, int ntile, unsigned char* smem) {
    float* t = (float*)smem;
    const int tid = threadIdx.x, k0 = kt * 64, n0 = ntile * 64;
    {
        const int n = tid & 63, nd = n0 + n;
        const int src = MAP == 0 ? nd : (MAP == 1 ? map_in(nd) : (MAP == 2 ? map_il128(nd) : (nd < 128 ? nd : -1)));
#pragma unroll 4
        for (int i = 0; i < 8; ++i) { const int k = i * 8 + (tid >> 6); t[k * 65 + n] = (src >= 0) ? W[(size_t)(k0 + k) * Nsrc + src] : 0.f; }
    }
    __syncthreads();
    {
        const int n = tid >> 3, ks = (tid & 7) * 8;
        u32x4 o;
        o.x = pk2(t[(ks + 0) * 65 + n], t[(ks + 1) * 65 + n]); o.y = pk2(t[(ks + 2) * 65 + n], t[(ks + 3) * 65 + n]);
        o.z = pk2(t[(ks + 4) * 65 + n], t[(ks + 5) * 65 + n]); o.w = pk2(t[(ks + 6) * 65 + n], t[(ks + 7) * 65 + n]);
        *(u32x4*)(Wt + (size_t)(n0 + n) * K + k0 + ks) = o;
    }
    __syncthreads();
}

__device__ __forceinline__ void phase0(const Params& p, unsigned char* smem) {
    unsigned char* ws = p.ws;
    const int tid = threadIdx.x;
    constexpr int I_ADA = 96;
    constexpr int T_IN = 16 * (NIN_PAD / 64), T_GLU = 8 * 32, T_NSA = 8 * 16, T_OUT = 16 * 16, T_C1 = 2 * 32 * 4, T_GU = 32 * 16 * 32, T_DN = 32 * 16 * 16;
    constexpr int I_TR = T_IN + T_GLU + T_NSA + T_OUT + T_C1 + T_GU + T_DN;
    constexpr int I_S5 = 32 * 33;
    constexpr int I_MISC = 17;
    constexpr int NITEM = I_ADA + I_TR + I_S5 + I_MISC;
    for (int item = blockIdx.x; item < NITEM; item += gridDim.x) {
        int r = item;
        if (r < I_ADA) {
            const float* c = p.in[1]; const float* w = p.in[3]; const float* bb = p.in[4];
            const int wid = tid >> 6, lane = tid & 63, j = r * 64 + lane;
            float a0 = 0.f, a1 = 0.f, a2 = 0.f, a3 = 0.f;
#pragma unroll 4
            for (int k = wid * 128; k < wid * 128 + 128; ++k) {
                const float wv = w[(size_t)k * 6144 + j];
                const float c0 = c[k], c1 = c[1024 + k], c2 = c[2048 + k], c3 = c[3072 + k];
                a0 += c0 * sigmoidf_(c0) * wv; a1 += c1 * sigmoidf_(c1) * wv; a2 += c2 * sigmoidf_(c2) * wv; a3 += c3 * sigmoidf_(c3) * wv;
            }
            float* red = (float*)smem;
            red[(wid * 4 + 0) * 64 + lane] = a0; red[(wid * 4 + 1) * 64 + lane] = a1; red[(wid * 4 + 2) * 64 + lane] = a2; red[(wid * 4 + 3) * 64 + lane] = a3;
            __syncthreads();
            if (tid < 256) { const int b = tid >> 6; float s = 0.f;
#pragma unroll
              for (int w8 = 0; w8 < 8; ++w8) s += red[(w8 * 4 + b) * 64 + lane];
              ((float*)(ws + O_ADA))[b * 6144 + j] = s + bb[j]; }
            __syncthreads();
            continue;
        }
        r -= I_ADA;
        if (r < I_TR) {
            if (r < T_IN) { transpose_tile<1>(p.in[5], 1024, 3864, (bf16_t*)(ws + O_WT_IN), r / (NIN_PAD / 64), r % (NIN_PAD / 64), smem); continue; } r -= T_IN;
            if (r < T_GLU) { transpose_tile<2>(p.in[14], 512, 2048, (bf16_t*)(ws + O_WT_GLU), r / 32, r % 32, smem); continue; } r -= T_GLU;
            if (r < T_NSA) { transpose_tile<0>(p.in[22], 512, 1024, (bf16_t*)(ws + O_WT_NSA), r / 16, r % 16, smem); continue; } r -= T_NSA;
            if (r < T_OUT) { transpose_tile<0>(p.in[23], 1024, 1024, (bf16_t*)(ws + O_WT_OUT), r / 16, r % 16, smem); continue; } r -= T_OUT;
            if (r < T_C1) { const int kv = r / 128, q = r % 128; transpose_tile<3>(p.in[kv ? 20 : 17], 2048, 128, (bf16_t*)(ws + O_WT_C1) + (size_t)kv * 256 * 2048, q / 4, q % 4, smem); continue; } r -= T_C1;
            if (r < T_GU) { const int e = r / 512, q = r % 512; transpose_tile<2>(p.in[28] + (size_t)e * 1024 * 2048, 1024, 2048, (bf16_t*)(ws + O_WT_GU) + (size_t)e * 2048 * 1024, q / 32, q % 32, smem); continue; } r -= T_GU;
            { const int e = r / 256, q = r % 256; transpose_tile<0>(p.in[30] + (size_t)e * 1024 * 1024, 1024, 1024, (bf16_t*)(ws + O_WT_DN) + (size_t)e * 1024 * 1024, q / 16, q % 16, smem); continue; }
        }
        r -= I_TR;
        if (r < I_S5) {
            const int g = r / 33, dl = r % 33;
            f32x2* pw = (f32x2*)smem;
            f32x2* bbv = pw + 64;
            f32x2* ccv = bbv + 1024;
            const float dt = expf(p.in[8][g]);
            if (tid < 64) {
                const int n = tid; const double re = p.in[6][g * 64 + n], im = p.in[7][g * 64 + n];
                const double mag = exp(re * (double)dt * dl), ang = im * (double)dt * dl;
                double sn, cs; sincos(ang, &sn, &cs);
                pw[n] = (f32x2){(float)(mag * cs), (float)(mag * sn)};
                if (dl == 32) { ((f32x2*)(ws + O_LAML))[g * 64 + n] = pw[n]; }
            }
            for (int e = tid; e < 1024; e += NT) {
                const int n = e >> 4, q = e & 15;
                const double re = p.in[6][g * 64 + n], im = p.in[7][g * 64 + n];
                const double mag = exp(re * (double)dt), ang = im * (double)dt;
                double sn, cs; sincos(ang, &sn, &cs);
                const double lr = mag * cs - 1.0, li = mag * sn;
                const double den = re * re + im * im;
                const double fr_ = (lr * re + li * im) / den, fi_ = (li * re - lr * im) / den;
                const double br = p.in[9][(g * 64 + n) * 16 + q], bi = p.in[10][(g * 64 + n) * 16 + q];
                bbv[e] = (f32x2){(float)(fr_ * br - fi_ * bi), (float)(fr_ * bi + fi_ * br)};
            }
            for (int e = tid; e < 1024; e += NT) { ccv[e] = (f32x2){p.in[11][g * 1024 + e], p.in[12][g * 1024 + e]}; }
            __syncthreads();
            bf16_t* TW2 = (bf16_t*)(ws + O_TW2) + (size_t)g * 512 * UROW;
            bf16_t* W1T = (bf16_t*)(ws + O_W1T) + (size_t)g * 256 * 512;
            if (dl < 32) {
                if (tid < 256) {
                    const int pp = tid >> 4, q = tid & 15;
                    float acc = 0.f;
                    for (int n = 0; n < 64; ++n) {
                        const f32x2 cv = ccv[pp * 64 + n], pv = pw[n], bv = bbv[n * 16 + q];
                        const float xr = cv.x * pv.x - cv.y * pv.y, xi = cv.x * pv.y + cv.y * pv.x;
                        acc += xr * bv.x - xi * bv.y;
                    }
                    if (dl == 0 && pp == q) acc += p.in[13][g * 16 + pp];
                    const bf16_t kb = f2bf(acc);
                    for (int tau = dl; tau < 32; ++tau) { const int s = tau - dl; TW2[(size_t)(tau * 16 + pp) * UROW + s * 16 + q] = kb; }
                    if (dl >= 1) for (int s = dl; s < 32; ++s) { const int tau = s - dl; TW2[(size_t)(tau * 16 + pp) * UROW + s * 16 + q] = 0; }
                }
                const int s = 31 - dl;
                for (int e = tid; e < 2048; e += NT) {
                    const int c = e >> 4, qq = e & 15, n = c & 63, ri = c >> 6;
                    const f32x2 pv = pw[n], bv = bbv[n * 16 + qq];
                    const float zr = pv.x * bv.x - pv.y * bv.y, zi = pv.x * bv.y + pv.y * bv.x;
                    W1T[(size_t)c * 512 + s * 16 + qq] = f2bf(ri ? zi : zr);
                }
            } else {
                u32x4* z = (u32x4*)(W1T + (size_t)128 * 512);
                for (int e = tid; e < 128 * 512 / 8; e += NT) z[e] = (u32x4){0u, 0u, 0u, 0u};
            }
            if (dl >= 1) {
                const int tau = dl - 1;
                for (int e = tid; e < 2048; e += NT) {
                    const int pp = e >> 7, c = e & 127, n = c & 63, ri = c >> 6;
                    const f32x2 cv = ccv[pp * 64 + n], pv = pw[n];
                    const float xr = cv.x * pv.x - cv.y * pv.y, xi = cv.x * pv.y + cv.y * pv.x;
                    TW2[(size_t)(tau * 16 + pp) * UROW + 512 + c] = f2bf(ri ? -xi : xr);
                }
            }
            __syncthreads();
            continue;
        }
        r -= I_S5;
        if (r < 16) {
            const int kv = r >> 3, part = r & 7, j = tid & 127, qtr = tid >> 7;
            const float* pos = p.in[kv ? 19 : 16]; const float* w1 = p.in[kv ? 20 : 17];
            float a = 0.f;
            const int i0 = part * 256 + qtr * 64;
            for (int i = i0; i < i0 + 64; ++i) a += pos[i] * w1[(size_t)i * 128 + j];
            float* red = (float*)smem;
            red[tid] = a;
            __syncthreads();
            if (tid < 128) ((float*)(ws + O_BIAS1))[(kv * 8 + part) * 128 + tid] = (red[tid] + red[tid + 128]) + (red[tid + 256] + red[tid + 384]);
            __syncthreads();
            continue;
        }
        if (tid < 64) ((unsigned*)(ws + O_CNT))[tid] = 0u;
    }
}

__device__ __forceinline__ void phase1(const Params& p, unsigned char*) {
    const float* x = p.in[0];
    bf16_t* xn = (bf16_t*)(p.ws + O_XN);
    for (size_t i = (size_t)blockIdx.x * NT + threadIdx.x; i < (size_t)NTOK * 128; i += (size_t)gridDim.x * NT) {
        const int token = (int)(i >> 7), k = (int)(i & 127) * 8, b = token >> 13;
        const float* ada = (const float*)(p.ws + O_ADA) + b * 6144;
        const f32x4 x0 = *(const f32x4*)(x + (size_t)token * 1024 + k), x1 = *(const f32x4*)(x + (size_t)token * 1024 + k + 4);
        const f32x4 s0 = *(const f32x4*)(ada + 1024 + k), s1 = *(const f32x4*)(ada + 1024 + k + 4);
        const f32x4 h0 = *(const f32x4*)(ada + k), h1 = *(const f32x4*)(ada + k + 4);
        u32x4 o;
        o.x = pk2(x0[0] * (1.f + s0[0]) + h0[0], x0[1] * (1.f + s0[1]) + h0[1]); o.y = pk2(x0[2] * (1.f + s0[2]) + h0[2], x0[3] * (1.f + s0[3]) + h0[3]);
        o.z = pk2(x1[0] * (1.f + s1[0]) + h1[0], x1[1] * (1.f + s1[1]) + h1[1]); o.w = pk2(x1[2] * (1.f + s1[2]) + h1[2], x1[3] * (1.f + s1[3]) + h1[3]);
        *(u32x4*)(xn + (size_t)token * 1024 + k) = o;
    }
}

typedef const f32x4 (&AccRef)[2][2][4][2];
struct EpiIn {
    static constexpr bool PERM = true;
    unsigned char* ws;
    __device__ __forceinline__ void operator()(AccRef acc, const pg8::Unit& u, int wr, int wc, int fr, int fq) const {
        const int pn = u.pn;
#pragma unroll
        for (int ai = 0; ai < 2; ++ai)
#pragma unroll
            for (int m = 0; m < 4; ++m) {
                const int token = u.pm * 256 + ai * 128 + wr * 64 + m * 16 + fr;
#pragma unroll
                for (int bj = 0; bj < 2; ++bj) {
                    const int col = pn * 256 + bj * 128 + wc * 32 + 8 * fq;
                    const f32x4 v0 = acc[ai][bj][m][0], v1 = acc[ai][bj][m][1];
                    if (pn < 2) {
                        const int g = col >> 4, q = col & 15;
                        bf16_t* d = (bf16_t*)(ws + O_U) + ((size_t)(g * 1024 + (token >> 5)) * UROW + (token & 31) * 16 + q);
                        *(u32x4*)d = (u32x4){pk2(v0[0], v0[1]), pk2(v0[2], v0[3]), pk2(v1[0], v1[1]), pk2(v1[2], v1[3])};
                    } else if (pn < 4) {
                        bf16_t* d = (bf16_t*)(ws + O_Q) + (size_t)token * 512 + (col - 512);
                        *(u32x4*)d = (u32x4){pk2(v0[0] * QSCALE, v0[1] * QSCALE), pk2(v0[2] * QSCALE, v0[3] * QSCALE), pk2(v1[0] * QSCALE, v1[1] * QSCALE), pk2(v1[2] * QSCALE, v1[3] * QSCALE)};
                    } else if (pn < 7) {
                        const int c = col - 1024, j6 = c >> 7, g = (c >> 6) & 1, dd = c & 63, b = token >> 13, s = token & 8191;
                        bf16_t* slab = (bf16_t*)(ws + O_KV) + (size_t)((j6 * 4 + b) * 2 + g) * KV_SLAB;
                        if (j6 == 3 || j6 == 5) {
                            const int sp = (s & ~15) | (s & 3) | ((s & 4) << 1) | ((s & 8) >> 1);
#pragma unroll
                            for (int j = 0; j < 4; ++j) { slab[(size_t)(dd + j) * SEQ + sp] = f2bf(v0[j]); slab[(size_t)(dd + 4 + j) * SEQ + sp] = f2bf(v1[j]); }
                        } else {
                            *(u32x4*)(slab + (size_t)s * 64 + dd) = (u32x4){pk2(v0[0], v0[1]), pk2(v0[2], v0[3]), pk2(v1[0], v1[1]), pk2(v1[2], v1[3])};
                        }
                    } else if (pn < 15) {
                        bf16_t* d = (pn < 11 ? (bf16_t*)(ws + O_SG5) + (size_t)token * 1024 + (col - 1792) : (bf16_t*)(ws + O_SGN) + (size_t)token * 1024 + (col - 2816));
                        *(u32x4*)d = (u32x4){pk2(sigmoidf_(v0[0]), sigmoidf_(v0[1])), pk2(sigmoidf_(v0[2]), sigmoidf_(v0[3])), pk2(sigmoidf_(v1[0]), sigmoidf_(v1[1])), pk2(sigmoidf_(v1[2]), sigmoidf_(v1[3]))};
                    } else {
                        const int c = col - 3840;
                        if (c < 24) { float* d = (float*)(ws + O_GN) + (size_t)token * 24 + c;
                            *(f32x4*)d = (f32x4){sigmoidf_(v0[0]), sigmoidf_(v0[1]), sigmoidf_(v0[2]), sigmoidf_(v0[3])};
                            *(f32x4*)(d + 4) = (f32x4){sigmoidf_(v1[0]), sigmoidf_(v1[1]), sigmoidf_(v1[2]), sigmoidf_(v1[3])}; }
                    }
                }
            }
    }
};
__device__ __forceinline__ void phase2(const Params& p, LAS unsigned char* lds) {
    pg8::DenseOrder S; S.init(p.ws + O_XN, p.ws + O_WT_IN, NTOK, NIN_PAD, 1024, 1024, gridDim.x, blockIdx.x);
    EpiIn E{p.ws};
    pg8::gemm_phase<EpiIn, pg8::DenseOrder, true>(lds, 1024, 1024, 1024, S, E);
}

struct BatchOrder {
    const char* A; const char* B; size_t bsA, bsB, tstepA, tstepB; int nM, nN, nunits, G, c;
    __device__ __forceinline__ bool next(int i, pg8::Unit& u) const {
        const long L = (long)i * G + c; if (L >= nunits) return false;
        const int per = nM * nN, bt = (int)L / per, rem = (int)L % per;
        u.pm = rem / nN; u.pn = rem % nN; u.e = bt; u.nvalid = 256;
        u.A = A + (size_t)bt * bsA + (size_t)u.pm * tstepA; u.B = B + (size_t)bt * bsB + (size_t)u.pn * tstepB; return true;
    }
};
struct EpiE { static constexpr bool PERM = false; float* E;
    __device__ __forceinline__ void operator()(AccRef acc, const pg8::Unit& u, int wr, int wc, int fr, int fq) const {
#pragma unroll
        for (int ai = 0; ai < 2; ++ai)
#pragma unroll
            for (int m = 0; m < 4; ++m) {
                const int r = u.pm * 256 + ai * 128 + wr * 64 + m * 16 + fr;
#pragma unroll
                for (int n = 0; n < 2; ++n) *(f32x4*)(E + ((size_t)u.e * 1024 + r) * 128 + wc * 32 + n * 16 + fq * 4) = acc[ai][0][m][n];
            }
    } };
struct EpiCmp { static constexpr bool PERM = true; const float* b1p; bf16_t* HC;
    __device__ __forceinline__ void operator()(AccRef acc, const pg8::Unit& u, int wr, int wc, int fr, int fq) const {
        const int col = wc * 32 + 8 * fq;
        f32x4 b0 = (f32x4){0.f, 0.f, 0.f, 0.f}, b1 = b0;
#pragma unroll
        for (int part = 0; part < 8; ++part) { b0 += *(const f32x4*)(b1p + (u.e * 8 + part) * 128 + col); b1 += *(const f32x4*)(b1p + (u.e * 8 + part) * 128 + col + 4); }
#pragma unroll
        for (int ai = 0; ai < 2; ++ai)
#pragma unroll
            for (int m = 0; m < 4; ++m) {
                const int R = u.pm * 256 + ai * 128 + wr * 64 + m * 16 + fr;
                const f32x4 v0 = acc[ai][0][m][0] + b0, v1 = acc[ai][0][m][1] + b1;
                *(u32x4*)(HC + ((size_t)u.e * 4096 + R) * 128 + col) = (u32x4){pk2(gelu_tanh(v0[0]), gelu_tanh(v0[1])), pk2(gelu_tanh(v0[2]), gelu_tanh(v0[3])), pk2(gelu_tanh(v1[0]), gelu_tanh(v1[1])), pk2(gelu_tanh(v1[2]), gelu_tanh(v1[3]))};
            }
    } };
__device__ __forceinline__ void phase3(const Params& p, LAS unsigned char* lds) {
    const int G = gridDim.x;
    {
        BatchOrder S{(const char*)(p.ws + O_U), (const char*)(p.ws + O_W1T), (size_t)1024 * UROW * 2, (size_t)256 * 512 * 2, (size_t)256 * UROW * 2, 0, 4, 1, 128, G, (int)blockIdx.x};
        EpiE E{(float*)(p.ws + O_E)};
        pg8::gemm_phase<EpiE, BatchOrder, false>(lds, 512, UROW, 512, S, E);
    }
    {
        BatchOrder S{(const char*)(p.ws + O_KV), (const char*)(p.ws + O_WT_C1), (size_t)8 * KV_SLAB * 2, (size_t)256 * 2048 * 2, (size_t)256 * 1024 * 2, 0, 16, 1, 32, G, (int)((blockIdx.x + G - 128 % G) % G)};
        EpiCmp E{(const float*)(p.ws + O_BIAS1), (bf16_t*)(p.ws + O_HC)};
        pg8::gemm_phase<EpiCmp, BatchOrder, false>(lds, 2048, 1024, 2048, S, E);
    }
}
__device__ __forceinline__ void phase4(const Params& p, unsigned char*) {
    const int tid = threadIdx.x;
    for (int item = blockIdx.x; item < 16 + 1024; item += gridDim.x) {
        if (item < 16) {
            const int n = tid & 63, bg = item * 8 + (tid >> 6), b = bg >> 5, g = bg & 31;
            const f32x2 lm = ((const f32x2*)(p.ws + O_LAML))[g * 64 + n];
            const float* E = (const float*)(p.ws + O_E) + (size_t)(g * 1024 + b * 256) * 128;
            bf16_t* U = (bf16_t*)(p.ws + O_U) + (size_t)(g * 1024 + b * 256) * UROW + 512;
            float hr = 0.f, hi = 0.f;
#pragma unroll 8
            for (int c = 0; c < NCHUNK; ++c) {
                const float er = E[(size_t)c * 128 + n], ei = E[(size_t)c * 128 + 64 + n];
                U[(size_t)c * UROW + n] = f2bf(hr); U[(size_t)c * UROW + 64 + n] = f2bf(hi);
                const float nr = lm.x * hr - lm.y * hi + er, ni = lm.x * hi + lm.y * hr + ei;
                hr = nr; hi = ni;
            }
        } else {
            const int o = (item - 16) * NT + tid, d = o & 63, R = (o >> 6) & 4095, kv = o >> 18;
            const bf16_t* h = (const bf16_t*)(p.ws + O_HC) + ((size_t)kv * 4096 + R) * 128;
            const float* w2 = p.in[kv ? 21 : 18];
            float a = 0.f;
#pragma unroll 8
            for (int j = 0; j < 128; ++j) a += bf2f(h[j]) * w2[j * 64 + d];
            if (kv == 0) ((bf16_t*)(p.ws + O_KC))[(size_t)R * 64 + d] = f2bf(a);
            else { const int bgi = R >> 9, n = R & 511, np = (n & ~15) | (n & 3) | ((n & 4) << 1) | ((n & 8) >> 1);
                   ((bf16_t*)(p.ws + O_KC))[(size_t)4096 * 64 + ((size_t)bgi * 64 + d) * 512 + np] = f2bf(a); }
        }
    }
}
struct EpiY { static constexpr bool PERM = true; bf16_t* YS;
    __device__ __forceinline__ void operator()(AccRef acc, const pg8::Unit& u, int wr, int wc, int fr, int fq) const {
#pragma unroll
        for (int ai = 0; ai < 2; ++ai)
#pragma unroll
            for (int m = 0; m < 4; ++m) {
                const int r = u.pm * 256 + ai * 128 + wr * 64 + m * 16 + fr;
                const int tok0 = (r >> 8) * SEQ + (r & 255) * S5L;
#pragma unroll
                for (int bj = 0; bj < 2; ++bj) {
                    const int col = u.pn * 256 + bj * 128 + wc * 32 + 8 * fq, tau = col >> 4, pp = col & 15;
                    const f32x4 v0 = acc[ai][bj][m][0], v1 = acc[ai][bj][m][1];
                    *(u32x4*)(YS + (size_t)(tok0 + tau) * 512 + u.e * 16 + pp) = (u32x4){pk2(gelu_tanh(v0[0]), gelu_tanh(v0[1])), pk2(gelu_tanh(v0[2]), gelu_tanh(v0[3])), pk2(gelu_tanh(v1[0]), gelu_tanh(v1[1])), pk2(gelu_tanh(v1[2]), gelu_tanh(v1[3]))};
                }
            }
    } };
__device__ __forceinline__ void phase5(const Params& p, LAS unsigned char* lds) {
    BatchOrder S{(const char*)(p.ws + O_U), (const char*)(p.ws + O_TW2), (size_t)1024 * UROW * 2, (size_t)512 * UROW * 2, (size_t)256 * UROW * 2, (size_t)256 * UROW * 2, 4, 2, 256, (int)gridDim.x, (int)blockIdx.x};
    EpiY E{(bf16_t*)(p.ws + O_YS)};
    pg8::gemm_phase<EpiY, BatchOrder, false>(lds, UROW, UROW, UROW, S, E);
}
struct EpiGlu { static constexpr bool PERM = true; const float* bglu; const bf16_t* SG5; bf16_t* MS5;
    __device__ __forceinline__ void operator()(AccRef acc, const pg8::Unit& u, int wr, int wc, int fr, int fq) const {
        const int cv = u.pn * 128 + wc * 32 + 8 * fq;
        const f32x4 bv0 = *(const f32x4*)(bglu + cv), bv1 = *(const f32x4*)(bglu + cv + 4), bg0 = *(const f32x4*)(bglu + 1024 + cv), bg1 = *(const f32x4*)(bglu + 1024 + cv + 4);
#pragma unroll
        for (int ai = 0; ai < 2; ++ai)
#pragma unroll
            for (int m = 0; m < 4; ++m) {
                const int token = u.pm * 256 + ai * 128 + wr * 64 + m * 16 + fr;
                const u32x4 sg = *(const u32x4*)(SG5 + (size_t)token * 1024 + cv);
                const f32x4 va0 = acc[ai][0][m][0] + bv0, va1 = acc[ai][0][m][1] + bv1, ga0 = acc[ai][1][m][0] + bg0, ga1 = acc[ai][1][m][1] + bg1;
                u32x4 o;
                o.x = pk2(va0[0] * sigmoidf_(ga0[0]) * bflo(sg.x), va0[1] * sigmoidf_(ga0[1]) * bfhi(sg.x)); o.y = pk2(va0[2] * sigmoidf_(ga0[2]) * bflo(sg.y), va0[3] * sigmoidf_(ga0[3]) * bfhi(sg.y));
                o.z = pk2(va1[0] * sigmoidf_(ga1[0]) * bflo(sg.z), va1[1] * sigmoidf_(ga1[1]) * bfhi(sg.z)); o.w = pk2(va1[2] * sigmoidf_(ga1[2]) * bflo(sg.w), va1[3] * sigmoidf_(ga1[3]) * bfhi(sg.w));
                *(u32x4*)(MS5 + (size_t)token * 1024 + cv) = o;
            }
    } };
__device__ __forceinline__ void phase6(const Params& p, LAS unsigned char* lds) {
    pg8::DenseOrder S; S.init(p.ws + O_YS, p.ws + O_WT_GLU, NTOK, 2048, 512, 512, gridDim.x, blockIdx.x);
    EpiGlu E{p.in[15], (const bf16_t*)(p.ws + O_SG5), (bf16_t*)(p.ws + O_MS5)};
    pg8::gemm_phase<EpiGlu, pg8::DenseOrder, true>(lds, 512, 512, 512, S, E);
}
typedef float f32x16 __attribute__((ext_vector_type(16)));
__device__ __forceinline__ int rel_bucket_dev(int dist) {
    const int n = dist > 0 ? dist : 0;
    if (n < 16) return n;
    const int l = (int)(__log2f((float)n * 0.0625f) * 2.6666667f);
    const int v = 16 + l;
    return v < 31 ? v : 31;
}
__device__ __forceinline__ float xhalf_max(float v) { auto rr = __builtin_amdgcn_permlane32_swap(__float_as_uint(v), __float_as_uint(v), false, false); return fmaxf(__uint_as_float(rr[0]), __uint_as_float(rr[1])); }
__device__ __forceinline__ float xhalf_sum(float v) { auto rr = __builtin_amdgcn_permlane32_swap(__float_as_uint(v), __float_as_uint(v), false, false); return __uint_as_float(rr[0]) + __uint_as_float(rr[1]); }
__device__ __forceinline__ float quad_sum(float v) {
    v += __uint_as_float(__builtin_amdgcn_update_dpp(0u, __float_as_uint(v), 0xB1, 0xF, 0xF, true));
    v += __uint_as_float(__builtin_amdgcn_update_dpp(0u, __float_as_uint(v), 0x4E, 0xF, 0xF, true));
    return v;
}
constexpr int LUTW = 1028;
constexpr int IMPW = 132;
constexpr float NEG_BIG = -1e30f;

__device__ __forceinline__ void qk_block(f32x16 (&st)[2], const bf16x8 (&qf)[4], const bf16_t* kp  , float cinit) {
#pragma unroll
    for (int sub = 0; sub < 2; ++sub) {
        f32x16 acc;
#pragma unroll
        for (int r = 0; r < 16; ++r) acc[r] = cinit;
#pragma unroll
        for (int s = 0; s < 4; ++s) {
            const bf16x8 kf = *(const bf16x8*)(kp + sub * 32 * 64 + s * 16);
            acc = __builtin_amdgcn_mfma_f32_32x32x16_bf16(kf, qf[s], acc, 0, 0, 0);
        }
        st[sub] = acc;
    }
}
template <int MODE>
__device__ __forceinline__ void bias_mask(f32x16 (&st)[2], int dist0, bool selme, const float* lut) {
    constexpr int STEP = MODE == 0 ? 16 : 1;
#pragma unroll
    for (int sub = 0; sub < 2; ++sub)
#pragma unroll
        for (int r = 0; r < 16; ++r) {
            const int dist = dist0 - STEP * (32 * sub + (r & 3) + 8 * (r >> 2));
            int idx = dist < 0 ? 0 : dist; idx = idx > 1024 ? 1024 : idx;
            bool valid = dist >= 0;
            if (MODE == 1) valid = valid && selme;
            if (MODE == 2) valid = valid && (dist < 512);
            st[sub][r] = valid ? st[sub][r] + lut[idx] : -INFINITY;
        }
}
__device__ __forceinline__ float tile_max(const f32x16 (&st)[2]) {
    float a = fmaxf(st[0][0], st[1][0]);
#pragma unroll
    for (int r = 1; r < 16; ++r) a = fmaxf(a, fmaxf(st[0][r], st[1][r]));
    return xhalf_max(a);
}
__device__ __forceinline__ void pv_block(f32x16 (&O)[2], const f32x16 (&st)[2], const bf16_t* vt, int rs) {
    bf16x8 pf[2][2];
#pragma unroll
    for (int sub = 0; sub < 2; ++sub)
#pragma unroll
        for (int s2 = 0; s2 < 2; ++s2) {
            u32x4 w;
            w.x = pk2(st[sub][8 * s2 + 0], st[sub][8 * s2 + 1]); w.y = pk2(st[sub][8 * s2 + 2], st[sub][8 * s2 + 3]);
            w.z = pk2(st[sub][8 * s2 + 4], st[sub][8 * s2 + 5]); w.w = pk2(st[sub][8 * s2 + 6], st[sub][8 * s2 + 7]);
            pf[sub][s2] = __builtin_bit_cast(bf16x8, w);
        }
#pragma unroll
    for (int dt = 0; dt < 2; ++dt)
#pragma unroll
        for (int sub = 0; sub < 2; ++sub)
#pragma unroll
            for (int s2 = 0; s2 < 2; ++s2) {
                const bf16x8 vf = *(const bf16x8*)(vt + (size_t)dt * 32 * rs + sub * 32 + s2 * 16);
                O[dt] = __builtin_amdgcn_mfma_f32_32x32x16_bf16(vf, pf[sub][s2], O[dt], 0, 0, 0);
            }
}
__device__ __forceinline__ void softmax_step(f32x16 (&st)[2], f32x16 (&O)[2], float& m, float& l) {
    const float mn = fmaxf(m, tile_max(st));
    const float corr = __builtin_amdgcn_exp2f(m - mn);
    float sum = 0.f;
#pragma unroll
    for (int sub = 0; sub < 2; ++sub)
#pragma unroll
        for (int r = 0; r < 16; ++r) { const float pe = __builtin_amdgcn_exp2f(st[sub][r] - mn); st[sub][r] = pe; sum += pe; }
    l = l * corr + sum;
    if (__any(corr != 1.f)) {
#pragma unroll
        for (int dt = 0; dt < 2; ++dt)
#pragma unroll
            for (int r = 0; r < 16; ++r) O[dt][r] *= corr;
    }
    m = mn;
}

__device__ __forceinline__ void nsa_tile(const Params& p, int bg, int tg, const float* lutall, float* impw, int lane) {
    const int q = lane & 31, h2 = lane >> 5, tok = q >> 2, head = q & 3;
    const int b = bg >> 1, g = bg & 1, t0 = tg * 8, t = t0 + tok, token = b * SEQ + t;
    const float* lut = lutall + head * LUTW;
    const float b31 = lut[1024];
    bf16x8 qf[4];
    { const bf16_t* qp = (const bf16_t*)(p.ws + O_Q) + (size_t)token * 512 + (g * 4 + head) * 64 + 8 * h2;
#pragma unroll
      for (int s = 0; s < 4; ++s) qf[s] = *(const bf16x8*)(qp + 16 * s); }
    const float* gn = (const float*)(p.ws + O_GN) + (size_t)token * 24 + (g * 4 + head) * 3;
    f32x16 F[2], O[2], st[2];
#pragma unroll
    for (int dt = 0; dt < 2; ++dt)
#pragma unroll
        for (int r = 0; r < 16; ++r) { F[dt][r] = 0.f; O[dt][r] = 0.f; }
    const int cur = t0 >> 6;
    { const int u = head + 4 * h2;
#pragma unroll
      for (int i = 0; i < 16; ++i) impw[tok * IMPW + i * 8 + u] = 0.f; }
    WAVE_SYNC();

    {
        const bf16_t* Kc = (const bf16_t*)(p.ws + O_KC) + (size_t)bg * 512 * 64;
        const bf16_t* VcT = (const bf16_t*)(p.ws + O_KC) + (size_t)4096 * 64 + (size_t)bg * 64 * 512;
        const int tl = t0 + 7;
        const int ncmax = tl >= 31 ? ((tl - 31) >> 4) + 1 : 0;
        const int nblk = (ncmax + 63) >> 6;
        float m = NEG_BIG, l = 0.f;
#pragma unroll 1
        for (int blk = 0; blk < nblk; ++blk) {
            qk_block(st, qf, Kc + (size_t)(blk * 64 + q) * 64 + 8 * h2, 0.f);
            bias_mask<0>(st, t - 31 - 16 * (blk * 64 + 4 * h2), true, lut);
            const float mn = fmaxf(m, tile_max(st));
            float sum = 0.f;
#pragma unroll
            for (int sub = 0; sub < 2; ++sub)
#pragma unroll
                for (int r = 0; r < 16; ++r) sum += __builtin_amdgcn_exp2f(st[sub][r] - mn);
            l = l * __builtin_amdgcn_exp2f(m - mn) + sum; m = mn;
        }
        l = xhalf_sum(l);
        const float invl = l > 0.f ? 1.f / l : 0.f;
#pragma unroll 1
        for (int blk = 0; blk < nblk; ++blk) {
            qk_block(st, qf, Kc + (size_t)(blk * 64 + q) * 64 + 8 * h2, 0.f);
            bias_mask<0>(st, t - 31 - 16 * (blk * 64 + 4 * h2), true, lut);
#pragma unroll
            for (int sub = 0; sub < 2; ++sub)
#pragma unroll
                for (int r = 0; r < 16; ++r) st[sub][r] = __builtin_amdgcn_exp2f(st[sub][r] - m) * invl;
#pragma unroll
            for (int sub = 0; sub < 2; ++sub)
#pragma unroll
                for (int a = 0; a < 4; ++a) {
                    const float L = quad_sum(st[sub][4 * a + 3]);
                    const float G = quad_sum((st[sub][4 * a] + st[sub][4 * a + 1]) + (st[sub][4 * a + 2] + st[sub][4 * a + 3]));
                    const int j = blk * 16 + 8 * sub + 2 * a + h2;
                    if (head == 0) { atomicAdd(&impw[tok * IMPW + j], G); if (j + 1 < 128) atomicAdd(&impw[tok * IMPW + j + 1], L); }
                }
            pv_block(O, st, VcT + (size_t)q * 512 + blk * 64 + 8 * h2, 512);
        }
#pragma unroll
        for (int dt = 0; dt < 2; ++dt)
#pragma unroll
            for (int r = 0; r < 16; ++r) { F[dt][r] = gn[0] * O[dt][r]; O[dt][r] = 0.f; }
    }
    WAVE_SYNC();

    unsigned long long mlo, mhi;
    if (cur < 16) { mlo = (1ull << (cur + 1)) - 1ull; mhi = 0ull; }
    else {
        const int u = head + 4 * h2;
        float val[16];
#pragma unroll
        for (int i = 0; i < 16; ++i) { const int j = i * 8 + u; val[i] = (j >= 1 && j <= cur - 2) ? impw[tok * IMPW + j] : -1.f; }
        mlo = 1ull; mhi = 0ull;
        if (cur < 64) mlo |= 1ull << cur; else mhi |= 1ull << (cur - 64);
        if (cur - 1 < 64) mlo |= 1ull << (cur - 1); else mhi |= 1ull << (cur - 1 - 64);
#pragma unroll 1
        for (int round = 0; round < 13; ++round) {
            float bs = val[0]; int bj = u;
#pragma unroll
            for (int i = 1; i < 16; ++i) { if (val[i] > bs) { bs = val[i]; bj = i * 8 + u; } }
            { const float os = __uint_as_float(__builtin_amdgcn_update_dpp(0u, __float_as_uint(bs), 0xB1, 0xF, 0xF, true)); const int oj = __builtin_amdgcn_update_dpp(0, bj, 0xB1, 0xF, 0xF, true);
              if (os > bs || (os == bs && oj < bj)) { bs = os; bj = oj; } }
            { const float os = __uint_as_float(__builtin_amdgcn_update_dpp(0u, __float_as_uint(bs), 0x4E, 0xF, 0xF, true)); const int oj = __builtin_amdgcn_update_dpp(0, bj, 0x4E, 0xF, 0xF, true);
              if (os > bs || (os == bs && oj < bj)) { bs = os; bj = oj; } }
            { const float os = __shfl_xor(bs, 32); const int oj = __shfl_xor(bj, 32);
              if (os > bs || (os == bs && oj < bj)) { bs = os; bj = oj; } }
            if (bj < 64) mlo |= 1ull << bj; else mhi |= 1ull << (bj - 64);
#pragma unroll
            for (int i = 0; i < 16; ++i) if (i * 8 + u == bj) val[i] = -2.f;
        }
    }
    unsigned long long ulo = mlo, uhi = mhi;
#pragma unroll
    for (int o = 4; o < 32; o <<= 1) { ulo |= __shfl_xor(ulo, o); uhi |= __shfl_xor(uhi, o); }
    ulo = ((unsigned long long)__builtin_amdgcn_readfirstlane((unsigned)(ulo >> 32)) << 32) | (unsigned)__builtin_amdgcn_readfirstlane((unsigned)ulo);
    uhi = ((unsigned long long)__builtin_amdgcn_readfirstlane((unsigned)(uhi >> 32)) << 32) | (unsigned)__builtin_amdgcn_readfirstlane((unsigned)uhi);

    {
        const bf16_t* Ks = (const bf16_t*)(p.ws + O_KV) + (size_t)((2 * 4 + b) * 2 + g) * KV_SLAB;
        const bf16_t* VsT = (const bf16_t*)(p.ws + O_KV) + (size_t)((3 * 4 + b) * 2 + g) * KV_SLAB;
        float m = NEG_BIG, l = 0.f;
#pragma unroll 1
        for (int j = 0; j <= cur; ++j) {
            const bool inu = j < 64 ? ((ulo >> j) & 1ull) : ((uhi >> (j - 64)) & 1ull);
            if (!inu) continue;
            const bool selme = j < 64 ? ((mlo >> j) & 1ull) : ((mhi >> (j - 64)) & 1ull);
            const bool nearb = (64 * j + 63 + 1024 > t0);
            const bf16_t* kp = Ks + (size_t)(j * 64 + q) * 64 + 8 * h2;
            if (nearb) { qk_block(st, qf, kp, 0.f); bias_mask<1>(st, t - 64 * j - 4 * h2, selme, lut); }
            else qk_block(st, qf, kp, selme ? b31 : -INFINITY);
            softmax_step(st, O, m, l);
            pv_block(O, st, VsT + (size_t)q * SEQ + j * 64 + 8 * h2, SEQ);
        }
        l = xhalf_sum(l);
        const float sc = l > 0.f ? gn[1] / l : 0.f;
#pragma unroll
        for (int dt = 0; dt < 2; ++dt)
#pragma unroll
            for (int r = 0; r < 16; ++r) { F[dt][r] += sc * O[dt][r]; O[dt][r] = 0.f; }
    }
    {
        const bf16_t* Kw = (const bf16_t*)(p.ws + O_KV) + (size_t)((4 * 4 + b) * 2 + g) * KV_SLAB;
        const bf16_t* VwT = (const bf16_t*)(p.ws + O_KV) + (size_t)((5 * 4 + b) * 2 + g) * KV_SLAB;
        float m = NEG_BIG, l = 0.f;
        const int wlo = t0 - 511;
        const int r_begin = (wlo > 0 ? wlo : 0) & ~63;
#pragma unroll 1
        for (int row0 = r_begin; row0 <= t0 + 7; row0 += 64) {
            qk_block(st, qf, Kw + (size_t)(row0 + q) * 64 + 8 * h2, 0.f);
            bias_mask<2>(st, t - row0 - 4 * h2, true, lut);
            softmax_step(st, O, m, l);
            pv_block(O, st, VwT + (size_t)q * SEQ + row0 + 8 * h2, SEQ);
        }
        l = xhalf_sum(l);
        const float sc = l > 0.f ? gn[2] / l : 0.f;
#pragma unroll
        for (int dt = 0; dt < 2; ++dt)
#pragma unroll
            for (int r = 0; r < 16; ++r) F[dt][r] += sc * O[dt][r];
    }
    { bf16_t* op = (bf16_t*)(p.ws + O_ONSA) + (size_t)token * 512 + (g * 4 + head) * 64 + 4 * h2;
#pragma unroll
      for (int dt = 0; dt < 2; ++dt)
#pragma unroll
          for (int a = 0; a < 4; ++a)
              *(u32x2*)(op + dt * 32 + a * 8) = (u32x2){pk2(F[dt][4 * a], F[dt][4 * a + 1]), pk2(F[dt][4 * a + 2], F[dt][4 * a + 3])}; }
    WAVE_SYNC();
}

__device__ __forceinline__ void phase7(const Params& p, unsigned char* smem) {
    const int tid = threadIdx.x, lane = tid & 63, wid = tid >> 6;
    float* lutall = (float*)smem;
    float* impw = (float*)(smem + 4 * LUTW * 4) + wid * 8 * IMPW;
    const int bg = blockIdx.x & 7, g = bg & 1;
    for (int i = tid; i < 4 * 1025; i += NT) { const int head = i / 1025, idx = i % 1025; lutall[head * LUTW + idx] = p.in[2][rel_bucket_dev(idx) * 8 + g * 4 + head] * LOG2E; }
    __syncthreads();
    const int nblk_bg = (gridDim.x - bg + 7) >> 3;
    const int W = nblk_bg * NWV, w = (blockIdx.x >> 3) * NWV + wid;
#pragma unroll 1
    for (int round = 0; ; ++round) {
        const int idx = round * W + ((round & 1) ? (W - 1 - w) : w);
        if (idx >= 1024) break;
        nsa_tile(p, bg, 1023 - idx, lutall, impw, lane);
    }
    __syncthreads();
}

struct EpiNsa { static constexpr bool PERM = true; const bf16_t* SGN; bf16_t* MS5;
    __device__ __forceinline__ void operator()(AccRef acc, const pg8::Unit& u, int wr, int wc, int fr, int fq) const {
#pragma unroll
        for (int ai = 0; ai < 2; ++ai)
#pragma unroll
            for (int m = 0; m < 4; ++m) {
                const int token = u.pm * 256 + ai * 128 + wr * 64 + m * 16 + fr;
#pragma unroll
                for (int bj = 0; bj < 2; ++bj) {
                    const int col = u.pn * 256 + bj * 128 + wc * 32 + 8 * fq;
                    const u32x4 sg = *(const u32x4*)(SGN + (size_t)token * 1024 + col);
                    const u32x4 ms = *(const u32x4*)(MS5 + (size_t)token * 1024 + col);
                    const f32x4 v0 = acc[ai][bj][m][0], v1 = acc[ai][bj][m][1];
                    u32x4 o;
                    o.x = pk2(bflo(ms.x) + bflo(sg.x) * v0[0], bfhi(ms.x) + bfhi(sg.x) * v0[1]); o.y = pk2(bflo(ms.y) + bflo(sg.y) * v0[2], bfhi(ms.y) + bfhi(sg.y) * v0[3]);
                    o.z = pk2(bflo(ms.z) + bflo(sg.z) * v1[0], bfhi(ms.z) + bfhi(sg.z) * v1[1]); o.w = pk2(bflo(ms.w) + bflo(sg.w) * v1[2], bfhi(ms.w) + bfhi(sg.w) * v1[3]);
                    *(u32x4*)(MS5 + (size_t)token * 1024 + col) = o;
                }
            }
    } };
__device__ __forceinline__ void phase8(const Params& p, LAS unsigned char* lds) {
    pg8::DenseOrder S; S.init(p.ws + O_ONSA, p.ws + O_WT_NSA, NTOK, 1024, 512, 512, gridDim.x, blockIdx.x);
    EpiNsa E{(const bf16_t*)(p.ws + O_SGN), (bf16_t*)(p.ws + O_MS5)};
    pg8::gemm_phase<EpiNsa, pg8::DenseOrder, true>(lds, 512, 512, 512, S, E);
}
struct EpiOut { static constexpr bool PERM = false; const float* x; const float* ada; float* Z1;
    __device__ __forceinline__ void operator()(AccRef acc, const pg8::Unit& u, int wr, int wc, int fr, int fq) const {
        const float* ga = ada + (u.pm >> 5) * 6144 + 2048;
#pragma unroll
        for (int ai = 0; ai < 2; ++ai)
#pragma unroll
            for (int m = 0; m < 4; ++m) {
                const int token = u.pm * 256 + ai * 128 + wr * 64 + m * 16 + fr;
#pragma unroll
                for (int bj = 0; bj < 2; ++bj)
#pragma unroll
                    for (int n = 0; n < 2; ++n) {
                        const int col = u.pn * 256 + bj * 128 + wc * 32 + n * 16 + fq * 4;
                        const f32x4 xv = *(const f32x4*)(x + (size_t)token * 1024 + col), gv = *(const f32x4*)(ga + col);
                        *(f32x4*)(Z1 + (size_t)token * 1024 + col) = xv * DN_ALPHA + gv * acc[ai][bj][m][n];
                    }
            }
    } };
__device__ __forceinline__ void phase9(const Params& p, LAS unsigned char* lds) {
    pg8::DenseOrder S; S.init(p.ws + O_MS5, p.ws + O_WT_OUT, NTOK, 1024, 1024, 1024, gridDim.x, blockIdx.x);
    EpiOut E{p.in[0], (const float*)(p.ws + O_ADA), (float*)(p.ws + O_Z1)};
    pg8::gemm_phase<EpiOut, pg8::DenseOrder, true>(lds, 1024, 1024, 1024, S, E);
}

__device__ __forceinline__ void phase10(const Params& p, unsigned char* smem) {
    const int tid = threadIdx.x, lane = tid & 63, wid = tid >> 6;
    float* hs = (float*)smem + wid * 1024;
    const float* lg = p.in[24]; const float* lb = p.in[25]; const float* wr_ = p.in[26]; const float* br_ = p.in[27];
    unsigned* cnt = (unsigned*)(p.ws + O_CNT);
    for (int item = blockIdx.x; item < NTOK / NWV; item += gridDim.x) {
        const int token = item * NWV + wid, b = token >> 13;
        float* zr = (float*)(p.ws + O_Z1) + (size_t)token * 1024;
        const float* ada = (const float*)(p.ws + O_ADA) + b * 6144;
        f32x4 v[4]; float s = 0.f;
#pragma unroll
        for (int j = 0; j < 4; ++j) { v[j] = *(const f32x4*)(zr + j * 256 + lane * 4); s += (v[j][0] + v[j][1]) + (v[j][2] + v[j][3]); }
        const float mean = wave_sum(s) * (1.f / 1024.f); float q = 0.f;
#pragma unroll
        for (int j = 0; j < 4; ++j) { v[j] = v[j] - mean; q += (v[j][0] * v[j][0] + v[j][1] * v[j][1]) + (v[j][2] * v[j][2] + v[j][3] * v[j][3]); }
        const float rstd = rsqrtf(wave_sum(q) * (1.f / 1024.f) + LN_EPS);
        bf16_t* h2 = (bf16_t*)(p.ws + O_H2) + (size_t)token * 1024;
#pragma unroll
        for (int j = 0; j < 4; ++j) {
            const int c = j * 256 + lane * 4;
            const f32x4 x1 = v[j] * rstd * *(const f32x4*)(lg + c) + *(const f32x4*)(lb + c);
            *(f32x4*)(zr + c) = x1;
            const f32x4 hv = x1 * (*(const f32x4*)(ada + 4096 + c) + 1.f) + *(const f32x4*)(ada + 3072 + c);
            *(f32x4*)(hs + c) = hv;
            *(u32x2*)(h2 + c) = (u32x2){pk2(hv[0], hv[1]), pk2(hv[2], hv[3])};
        }
        WAVE_SYNC();
        const int e = lane & 31, kh = lane >> 5;
        float a = 0.f;
#pragma unroll 8
        for (int k = kh * 512; k < kh * 512 + 512; ++k) a += hs[k] * wr_[k * 32 + e];
        a += __shfl_xor(a, 32);
        a += br_[e];
        float val = a; int te[4]; float tv[4];
#pragma unroll
        for (int r = 0; r < 4; ++r) {
            float bs = val; int bj = e;
#pragma unroll
            for (int o = 1; o < 32; o <<= 1) { const float os = __shfl_xor(bs, o); const int oj = __shfl_xor(bj, o); if (os > bs || (os == bs && oj < bj)) { bs = os; bj = oj; } }
            te[r] = bj; tv[r] = bs;
            if (e == bj) val = -INFINITY;
        }
        const float e0 = 1.f, e1 = __expf(tv[1] - tv[0]), e2 = __expf(tv[2] - tv[0]), e3 = __expf(tv[3] - tv[0]);
        const float inv = 1.f / (e0 + e1 + e2 + e3);
        if (lane < 4) {
            const int ee = lane == 0 ? te[0] : (lane == 1 ? te[1] : (lane == 2 ? te[2] : te[3]));
            const float gg = (lane == 0 ? e0 : (lane == 1 ? e1 : (lane == 2 ? e2 : e3))) * inv;
            const unsigned pos = atomicAdd(cnt + ee, 1u);
            ((int*)(p.ws + O_TOPE))[token * 4 + lane] = ee;
            ((unsigned*)(p.ws + O_TOPP))[token * 4 + lane] = pos;
            ((float*)(p.ws + O_TOPG))[token * 4 + lane] = gg;
        }
        WAVE_SYNC();
    }
}

__device__ __forceinline__ void load_offsets(const Params& p, int* offs  , int* toff  ) {
    if (threadIdx.x == 0) {
        const unsigned* cnt = (const unsigned*)(p.ws + O_CNT);
        int a = 0, t = 0;
        for (int e = 0; e < 32; ++e) { offs[e] = a; toff[e] = t; const int c = (int)cnt[e]; a += c; t += (c + 255) >> 8; }
        offs[32] = a; toff[32] = t;
    }
    __syncthreads();
}
__device__ __forceinline__ void phase11(const Params& p, unsigned char* smem) {
    int* offs = (int*)(smem + LDS_TAB); int* toff = offs + 40;
    load_offsets(p, offs, toff);
    const int lane = threadIdx.x & 63, wid = threadIdx.x >> 6;
    const int* tope = (const int*)(p.ws + O_TOPE); const unsigned* topp = (const unsigned*)(p.ws + O_TOPP); const float* topg = (const float*)(p.ws + O_TOPG);
    float* rowgate = (float*)(p.ws + O_ROWGATE); int* tokrow = (int*)(p.ws + O_TOKROW);
    const bf16_t* H2 = (const bf16_t*)(p.ws + O_H2); bf16_t* HS = (bf16_t*)(p.ws + O_HS);
    for (int i = blockIdx.x * NWV + wid; i < NROWS; i += gridDim.x * NWV) {
        const int R = offs[tope[i]] + (int)topp[i];
        if (lane == 0) { rowgate[R] = topg[i]; tokrow[i] = R; }
        const u32x4* src = (const u32x4*)(H2 + (size_t)(i >> 2) * 1024);
        u32x4* dst = (u32x4*)(HS + (size_t)R * 1024);
        dst[lane] = src[lane]; dst[lane + 64] = src[lane + 64];
    }
    __syncthreads();
}

struct MoeOrder {
    const int* offs; const int* toff; const char* A; const char* B; size_t bsB; int nN, G, c;
    __device__ __forceinline__ bool next(int i, pg8::Unit& u) const {
        const long L = (long)i * G + c; if (L >= (long)toff[32] * nN) return false;
        const int tile = (int)L / nN, pn = (int)L % nN;
        int e = 0;
#pragma unroll 1
        while (toff[e + 1] <= tile) ++e;
        const int r0 = offs[e] + (tile - toff[e]) * 256;
        u.pm = r0; u.pn = pn; u.e = e; u.nvalid = offs[e + 1] - r0;
        u.A = A + (size_t)r0 * 2048; u.B = B + (size_t)e * bsB + (size_t)pn * 256 * 2048; return true;
    }
};
struct EpiGU { static constexpr bool PERM = true; const float* bgu; bf16_t* ACT;
    __device__ __forceinline__ void operator()(AccRef acc, const pg8::Unit& u, int wr, int wc, int fr, int fq) const {
        const int cv = u.pn * 128 + wc * 32 + 8 * fq;
        const float* bb = bgu + (size_t)u.e * 2048;
        const f32x4 bg0 = *(const f32x4*)(bb + cv), bg1 = *(const f32x4*)(bb + cv + 4), bu0 = *(const f32x4*)(bb + 1024 + cv), bu1 = *(const f32x4*)(bb + 1024 + cv + 4);
#pragma unroll
        for (int ai = 0; ai < 2; ++ai)
#pragma unroll
            for (int m = 0; m < 4; ++m) {
                const int lr = ai * 128 + wr * 64 + m * 16 + fr;
                if (lr < u.nvalid) {
                    const f32x4 ga0 = acc[ai][0][m][0] + bg0, ga1 = acc[ai][0][m][1] + bg1, ua0 = acc[ai][1][m][0] + bu0, ua1 = acc[ai][1][m][1] + bu1;
                    float o[8];
#pragma unroll
                    for (int j = 0; j < 4; ++j) {
                        const float gt0 = fminf(ga0[j], 7.f), up0 = fminf(fmaxf(ua0[j], -7.f), 7.f); o[j] = (up0 + 1.f) * gt0 * sigmoidf_(1.702f * gt0);
                        const float gt1 = fminf(ga1[j], 7.f), up1 = fminf(fmaxf(ua1[j], -7.f), 7.f); o[4 + j] = (up1 + 1.f) * gt1 * sigmoidf_(1.702f * gt1);
                    }
                    *(u32x4*)(ACT + (size_t)(u.pm + lr) * 1024 + cv) = (u32x4){pk2(o[0], o[1]), pk2(o[2], o[3]), pk2(o[4], o[5]), pk2(o[6], o[7])};
                }
            }
    } };
__device__ __forceinline__ void phase12(const Params& p, unsigned char* smem, LAS unsigned char* lds) {
    int* offs = (int*)(smem + LDS_TAB); int* toff = offs + 40;
    load_offsets(p, offs, toff);
    MoeOrder S{offs, toff, (const char*)(p.ws + O_HS), (const char*)(p.ws + O_WT_GU), (size_t)2048 * 2048, 8, (int)gridDim.x, (int)blockIdx.x};
    EpiGU E{p.in[29], (bf16_t*)(p.ws + O_ACT)};
    pg8::gemm_phase<EpiGU, MoeOrder, true>(lds, 1024, 1024, 1024, S, E);
    __syncthreads();
}
struct EpiDn { static constexpr bool PERM = true; const float* bd; const float* rowgate; bf16_t* YK;
    __device__ __forceinline__ void operator()(AccRef acc, const pg8::Unit& u, int wr, int wc, int fr, int fq) const {
        const float* bb = bd + (size_t)u.e * 1024;
#pragma unroll
        for (int ai = 0; ai < 2; ++ai)
#pragma unroll
            for (int m = 0; m < 4; ++m) {
                const int lr = ai * 128 + wr * 64 + m * 16 + fr;
                if (lr < u.nvalid) {
                    const float gw = rowgate[u.pm + lr];
#pragma unroll
                    for (int bj = 0; bj < 2; ++bj) {
                        const int col = u.pn * 256 + bj * 128 + wc * 32 + 8 * fq;
                        const f32x4 v0 = (acc[ai][bj][m][0] + *(const f32x4*)(bb + col)) * gw, v1 = (acc[ai][bj][m][1] + *(const f32x4*)(bb + col + 4)) * gw;
                        *(u32x4*)(YK + (size_t)(u.pm + lr) * 1024 + col) = (u32x4){pk2(v0[0], v0[1]), pk2(v0[2], v0[3]), pk2(v1[0], v1[1]), pk2(v1[2], v1[3])};
                    }
                }
            }
    } };
__device__ __forceinline__ void phase13(const Params& p, unsigned char* smem, LAS unsigned char* lds) {
    int* offs = (int*)(smem + LDS_TAB); int* toff = offs + 40;
    load_offsets(p, offs, toff);
    MoeOrder S{offs, toff, (const char*)(p.ws + O_ACT), (const char*)(p.ws + O_WT_DN), (size_t)1024 * 2048, 4, (int)gridDim.x, (int)blockIdx.x};
    EpiDn E{p.in[31], (const float*)(p.ws + O_ROWGATE), (bf16_t*)(p.ws + O_YK)};
    pg8::gemm_phase<EpiDn, MoeOrder, true>(lds, 1024, 1024, 1024, S, E);
    __syncthreads();
}

__device__ __forceinline__ void phase14(const Params& p, unsigned char*) {
    const int tid = threadIdx.x, lane = tid & 63, wid = tid >> 6;
    const float* lg = p.in[32]; const float* lb = p.in[33];
    const int* tokrow = (const int*)(p.ws + O_TOKROW);
    const bf16_t* YK = (const bf16_t*)(p.ws + O_YK);
    for (int item = blockIdx.x; item < NTOK / NWV; item += gridDim.x) {
        const int token = item * NWV + wid, b = token >> 13;
        const float* x1 = (const float*)(p.ws + O_Z1) + (size_t)token * 1024;
        const float* gf = (const float*)(p.ws + O_ADA) + b * 6144 + 5120;
        const int r0 = tokrow[token * 4 + 0], r1 = tokrow[token * 4 + 1], r2 = tokrow[token * 4 + 2], r3 = tokrow[token * 4 + 3];
        f32x4 v[4]; float s = 0.f;
#pragma unroll
        for (int j = 0; j < 4; ++j) {
            const int c = j * 256 + lane * 4;
            const u32x2 a0 = *(const u32x2*)(YK + (size_t)r0 * 1024 + c), a1 = *(const u32x2*)(YK + (size_t)r1 * 1024 + c), a2 = *(const u32x2*)(YK + (size_t)r2 * 1024 + c), a3 = *(const u32x2*)(YK + (size_t)r3 * 1024 + c);
            f32x4 y;
            y[0] = (bflo(a0.x) + bflo(a1.x)) + (bflo(a2.x) + bflo(a3.x)); y[1] = (bfhi(a0.x) + bfhi(a1.x)) + (bfhi(a2.x) + bfhi(a3.x));
            y[2] = (bflo(a0.y) + bflo(a1.y)) + (bflo(a2.y) + bflo(a3.y)); y[3] = (bfhi(a0.y) + bfhi(a1.y)) + (bfhi(a2.y) + bfhi(a3.y));
            v[j] = *(const f32x4*)(x1 + c) * DN_ALPHA + *(const f32x4*)(gf + c) * y;
            s += (v[j][0] + v[j][1]) + (v[j][2] + v[j][3]);
        }
        const float mean = wave_sum(s) * (1.f / 1024.f); float q = 0.f;
#pragma unroll
        for (int j = 0; j < 4; ++j) { v[j] = v[j] - mean; q += (v[j][0] * v[j][0] + v[j][1] * v[j][1]) + (v[j][2] * v[j][2] + v[j][3] * v[j][3]); }
        const float rstd = rsqrtf(wave_sum(q) * (1.f / 1024.f) + LN_EPS);
#pragma unroll
        for (int j = 0; j < 4; ++j) { const int c = j * 256 + lane * 4; *(f32x4*)(p.out + (size_t)token * 1024 + c) = v[j] * rstd * *(const f32x4*)(lg + c) + *(const f32x4*)(lb + c); }
    }
}

template <bool COOP>
__global__ void __launch_bounds__(NT, 2) fwd_kernel(Params p) {
    extern __shared__ __attribute__((aligned(16))) unsigned char smem[];
    LAS unsigned char* lds = (LAS unsigned char*)smem;
    const int lo = p.ph_lo, hi = p.ph_hi;
#define RUN_PHASE(k, call) if (((PH_MASK >> (k)) & 1) && lo <= (k) && (k) < hi) { call; if ((REPEAT_MASK >> (k)) & 1) { if (COOP) cg::this_grid().sync(); call; } } if (COOP) { if (lo <= (k) && (k) + 1 < hi) cg::this_grid().sync(); }
    RUN_PHASE(0, phase0(p, smem))
    RUN_PHASE(1, phase1(p, smem))
    RUN_PHASE(2, phase2(p, lds))
    RUN_PHASE(3, phase3(p, lds))
    RUN_PHASE(4, phase4(p, smem))
    RUN_PHASE(5, phase5(p, lds))
    RUN_PHASE(6, phase6(p, lds))
    RUN_PHASE(7, phase7(p, smem))
    RUN_PHASE(8, phase8(p, lds))
    RUN_PHASE(9, phase9(p, lds))
    RUN_PHASE(10, phase10(p, smem))
    RUN_PHASE(11, phase11(p, smem))
    RUN_PHASE(12, phase12(p, smem, lds))
    RUN_PHASE(13, phase13(p, smem, lds))
    RUN_PHASE(14, phase14(p, smem))
#undef RUN_PHASE
}

extern "C" void kernel_launch(void* const* d_in, const int* in_sizes, int n_in, void* d_out, int out_size, void* d_ws, size_t ws_size, hipStream_t stream) {
    static int grid = 0;
    if (grid == 0) {
        if (n_in != 34 || out_size != NTOK * DM || ws_size < WS_NEED) { fprintf(stderr, "kernel_launch: unexpected problem (n_in %d, out %d, ws %zu need %zu)\n", n_in, out_size, ws_size, (size_t)WS_NEED); grid = -1; return; }
        int dev = 0, cus = 0, per_cu = 0;
        (void)hipGetDevice(&dev);
        (void)hipDeviceGetAttribute(&cus, hipDeviceAttributeMultiprocessorCount, dev);
#if ONE_LAUNCH
        (void)hipFuncSetAttribute((const void*)fwd_kernel<true>, hipFuncAttributeMaxDynamicSharedMemorySize, LDS_BYTES);
        (void)hipOccupancyMaxActiveBlocksPerMultiprocessor(&per_cu, fwd_kernel<true>, NT, LDS_BYTES);
#else
        (void)hipFuncSetAttribute((const void*)fwd_kernel<false>, hipFuncAttributeMaxDynamicSharedMemorySize, LDS_BYTES);
        (void)hipOccupancyMaxActiveBlocksPerMultiprocessor(&per_cu, fwd_kernel<false>, NT, LDS_BYTES);
#endif
        if (per_cu < 1) { fprintf(stderr, "kernel_launch: occupancy query reports %d blocks per CU\n", per_cu); per_cu = 1; }
        grid = cus * per_cu;
        fprintf(stderr, "kernel_launch: grid %d (%d CUs x %d)\n", grid, cus, per_cu);
    }
    if (grid < 0) return;
    Params p{};
    for (int i = 0; i < 34; ++i) p.in[i] = (const float*)d_in[i];
    p.out = (float*)d_out; p.ws = (unsigned char*)d_ws;
#if ONE_LAUNCH
    p.ph_lo = 0; p.ph_hi = NPHASE;
    void* args[] = {&p};
    hipError_t e = hipLaunchCooperativeKernel((void*)fwd_kernel<true>, dim3(grid), dim3(NT), args, LDS_BYTES, stream);
    if (e != hipSuccess) fprintf(stderr, "cooperative launch failed: %s (grid %d)\n", hipGetErrorString(e), grid);
#else
    for (int ph = 0; ph < NPHASE; ++ph) {
        p.ph_lo = ph; p.ph_hi = ph + 1;
        hipLaunchKernelGGL(fwd_kernel<false>, dim3(grid), dim3(NT), LDS_BYTES, stream, p);
    }
#endif
}
```

```cpp
#include <hip/hip_runtime.h>
#include <hip/hip_cooperative_groups.h>
#include <cstdio>
#include <cstdint>
namespace cg = cooperative_groups;

#ifndef PH_MASK
#define PH_MASK 0xFFFFF
#endif
#ifndef REPEAT_MASK
#define REPEAT_MASK 0
#endif
#ifndef ONE_LAUNCH
#define ONE_LAUNCH 1
#endif

#define LAS __attribute__((address_space(3)))
typedef unsigned short bf16_t;
typedef short bf16x8 __attribute__((ext_vector_type(8)));
typedef float f32x4 __attribute__((ext_vector_type(4)));
typedef float f32x2 __attribute__((ext_vector_type(2)));
typedef unsigned u32x4 __attribute__((ext_vector_type(4)));
typedef unsigned u32x2 __attribute__((ext_vector_type(2)));
typedef __bf16 bf16x2_t __attribute__((ext_vector_type(2)));

constexpr int NB = 4, SEQ = 8192, NTOK = NB * SEQ, DM = 1024;
constexpr int NIN_PAD = 4096;
constexpr int NEXP = 32, TOPK = 4, NROWS = NTOK * TOPK;
constexpr int S5L = 32;
constexpr int NCHUNK = SEQ / S5L;
constexpr int UROW = 640;
constexpr float DN_ALPHA = 1.189207115002721f;
constexpr float LN_EPS = 1e-5f;
constexpr float LOG2E = 1.4426950408889634f;
constexpr float QSCALE = 0.125f * 1.4426950408889634f;
constexpr int NT = 512;
constexpr int NWV = NT / 64;

constexpr size_t al256(size_t x) { return (x + 255) & ~(size_t)255; }
constexpr size_t O_ADA = 0;
constexpr size_t O_CNT = O_ADA + al256(4 * 6144 * 4);
constexpr size_t O_LAML = O_CNT + 1024;
constexpr size_t O_BIAS1 = O_LAML + al256(32 * 64 * 2 * 4);
constexpr size_t O_WT_IN = O_BIAS1 + al256(2 * 8 * 128 * 4);
constexpr size_t O_WT_GLU = O_WT_IN + al256((size_t)NIN_PAD * 1024 * 2);
constexpr size_t O_WT_NSA = O_WT_GLU + al256((size_t)2048 * 512 * 2);
constexpr size_t O_WT_OUT = O_WT_NSA + al256((size_t)1024 * 512 * 2);
constexpr size_t O_WT_C1 = O_WT_OUT + al256((size_t)1024 * 1024 * 2);
constexpr size_t O_W1T = O_WT_C1 + al256((size_t)2 * 256 * 2048 * 2);
constexpr size_t O_TW2 = O_W1T + al256((size_t)32 * 256 * 512 * 2);
constexpr size_t O_WT_GU = O_TW2 + al256((size_t)32 * 512 * 640 * 2);
constexpr size_t O_WT_DN = O_WT_GU + al256((size_t)32 * 2048 * 1024 * 2);
constexpr size_t O_H2 = O_WT_DN + al256((size_t)32 * 1024 * 1024 * 2);
constexpr size_t O_Z1 = O_H2 + al256((size_t)NTOK * 1024 * 2);
constexpr size_t O_TOPE = O_Z1 + al256((size_t)NTOK * 1024 * 4);
constexpr size_t O_TOPP = O_TOPE + al256((size_t)NROWS * 4);
constexpr size_t O_TOPG = O_TOPP + al256((size_t)NROWS * 4);
constexpr size_t O_ROWTOK = O_TOPG + al256((size_t)NROWS * 4);
constexpr size_t O_ROWGATE = O_ROWTOK + al256((size_t)(NROWS + 256) * 4);
constexpr size_t O_TOKROW = O_ROWGATE + al256((size_t)(NROWS + 256) * 4);
constexpr size_t O_OVL = O_TOKROW + al256((size_t)NROWS * 4);
constexpr size_t O_U = O_OVL;
constexpr size_t O_E = O_U + al256((size_t)32 * 1024 * UROW * 2);
constexpr size_t O_YS = O_E + al256((size_t)32 * 1024 * 128 * 4);
constexpr size_t O_Q = O_YS + al256((size_t)NTOK * 512 * 2);
constexpr size_t O_KV = O_Q + al256((size_t)NTOK * 512 * 2);
constexpr size_t KV_SLAB = (size_t)SEQ * 64;
constexpr size_t O_SG5 = O_KV + al256((size_t)6 * 8 * KV_SLAB * 2 + 8192);
constexpr size_t O_SGN = O_SG5 + al256((size_t)NTOK * 1024 * 2);
constexpr size_t O_GN = O_SGN + al256((size_t)NTOK * 1024 * 2);
constexpr size_t O_MS5 = O_GN + al256((size_t)NTOK * 24 * 4);
constexpr size_t O_ONSA = O_MS5 + al256((size_t)NTOK * 1024 * 2);
constexpr size_t O_HC = O_ONSA + al256((size_t)NTOK * 512 * 2);
constexpr size_t O_KC = O_HC + al256((size_t)2 * 4096 * 128 * 2);
constexpr size_t O_XN = O_KC + al256((size_t)2 * 4096 * 64 * 2);
constexpr size_t O_END1 = O_XN + al256((size_t)NTOK * 1024 * 2);
constexpr size_t O_ACT = O_OVL;
constexpr size_t O_YK = O_ACT + al256((size_t)(NROWS + 256) * 1024 * 2);
constexpr size_t O_END2 = O_YK + al256((size_t)(NROWS + 256) * 1024 * 2);
constexpr size_t WS_NEED = O_END1 > O_END2 ? O_END1 : O_END2;
static_assert(WS_NEED <= (size_t)1073741824, "workspace map exceeds 1 GiB");

constexpr int LDS_BYTES = 147456;
constexpr int LDS_TAB = 131072;
constexpr int NPHASE = 15;

struct Params {
    const float* in[34];
    float* out;
    unsigned char* ws;
    int ph_lo, ph_hi;
};

__device__ __forceinline__ unsigned pk2(float lo, float hi) { f32x2 v = {lo, hi}; bf16x2_t b = __builtin_convertvector(v, bf16x2_t); return __builtin_bit_cast(unsigned, b); }
__device__ __forceinline__ bf16_t f2bf(float f) { return (bf16_t)(pk2(f, 0.f) & 0xffffu); }
__device__ __forceinline__ float bf2f(bf16_t h) { return __uint_as_float(((unsigned)h) << 16); }
__device__ __forceinline__ float bflo(unsigned w) { return __uint_as_float(w << 16); }
__device__ __forceinline__ float bfhi(unsigned w) { return __uint_as_float(w & 0xffff0000u); }
__device__ __forceinline__ float sigmoidf_(float x) { return 1.f / (1.f + __expf(-x)); }
__device__ __forceinline__ float gelu_tanh(float x) { const float u = 0.7978845608028654f * (x + 0.044715f * x * x * x); const float e = __expf(2.f * u); return 0.5f * x * (2.f - 2.f / (e + 1.f)); }
__device__ __forceinline__ float wave_sum(float v) {
#pragma unroll
    for (int o = 1; o < 64; o <<= 1) v += __shfl_xor(v, o);
    return v;
}
#define WAVE_SYNC() do { __builtin_amdgcn_fence(__ATOMIC_RELEASE, "wavefront"); __builtin_amdgcn_wave_barrier(); __builtin_amdgcn_fence(__ATOMIC_ACQUIRE, "wavefront"); } while (0)

namespace pg8 {
constexpr int BM = 256, BK = 64, HALF = 128, HTB = HALF * BK * 2, STAGE_BYTES = 8 * HTB;
__device__ __forceinline__ int lds_byte(int r, int c) { const int st = (r >> 4) * 2 + (c >> 5), rr = r & 15, cc = c & 31, ob = rr * 64 + cc * 2; return st * 1024 + (ob ^ (((ob >> 9) & 1) << 5)); }
__device__ __forceinline__ void stage_rc(int b, int& R, int& C) { const int st = b / 1024, sb = b % 1024, swz = sb ^ (((sb >> 9) & 1) << 5); R = (st >> 1) * 16 + swz / 64; C = (st & 1) * 32 + (swz % 64) / 2; }
__device__ __forceinline__ int perm32(int rho) { const int n = rho >> 4, i = rho & 15; return 8 * (i >> 2) + 4 * n + (i & 3); }
struct Unit { const char* A; const char* B; const int* rows; int pm, pn, e, nvalid, rmax; };

template <class Epi, class Sched, bool ALIGN_EPI>
__device__ __forceinline__ void gemm_phase(LAS unsigned char* lds, const int K, const int lda, const int ldb, const Sched& S, const Epi& E) {
    const int tid = threadIdx.x, wid = __builtin_amdgcn_readfirstlane(tid >> 6), lane = tid & 63, wr = wid >> 2, wc = wid & 3, fr = lane & 15, fq = lane >> 4;
    const int nt = K / BK;
    unsigned voffB[2]; int Ra[2], Ca[2];
#pragma unroll
    for (int i = 0; i < 2; ++i) { int R, C; stage_rc(tid * 16 + i * 8192, R, C); const int Rb = Epi::PERM ? ((R & ~31) + perm32(R & 31)) : R;
        Ra[i] = R; Ca[i] = C; voffB[i] = (unsigned)(Rb * ldb + C) * 2u; }
    unsigned offC[2][2], offN[2][2];
#define PG8_SETOFF(o, u) do { _Pragma("unroll") for (int h_ = 0; h_ < 2; ++h_) _Pragma("unroll") for (int i_ = 0; i_ < 2; ++i_) { \
        if ((u).rows) { int ix_ = h_ * HALF + Ra[i_]; ix_ = ix_ < (u).rmax ? ix_ : (u).rmax; o[h_][i_] = (unsigned)(u).rows[ix_] * (unsigned)(lda * 2) + (unsigned)Ca[i_] * 2u; } \
        else o[h_][i_] = (unsigned)((h_ * HALF + Ra[i_]) * lda + Ca[i_]) * 2u; } } while (0)
    const size_t kstep = (size_t)(BK * 2);
    const size_t hstepB = (size_t)HALF * ldb * 2;
    const unsigned ldsw = (unsigned)wid * 1024u;
    const int aoff = lds_byte(wr * 64 + fr, fq * 8), boff = lds_byte(wc * 32 + fr, fq * 8);
#define PG8_SA(b, h) (((b) * 2 + (h)) * HTB)
#define PG8_SB(b, h) ((4 + (b) * 2 + (h)) * HTB)
#define PG8_STAGE(bufoff, gbase, voff) do { _Pragma("unroll") for (int _i = 0; _i < 2; ++_i) \
        __builtin_amdgcn_global_load_lds((const unsigned*)((const char*)(gbase) + (voff)[_i]), (LAS unsigned*)(lds + (bufoff) + ldsw + _i * 8192), 16, 0, 0); } while (0)
#define PG8_LDA(dst, b, h) do { _Pragma("unroll") for (int m = 0; m < 4; ++m) _Pragma("unroll") for (int k = 0; k < 2; ++k) dst[m][k] = *(const LAS bf16x8*)(lds + PG8_SA(b, h) + aoff + m * 2048 + k * 1024); } while (0)
#define PG8_LDB(dst, b, h) do { _Pragma("unroll") for (int n = 0; n < 2; ++n) _Pragma("unroll") for (int k = 0; k < 2; ++k) dst[n][k] = *(const LAS bf16x8*)(lds + PG8_SB(b, h) + boff + n * 2048 + k * 1024); } while (0)
#define PG8_MMA(ai, bj, At, Bt) do { __builtin_amdgcn_s_setprio(1); _Pragma("unroll") for (int m = 0; m < 4; ++m) _Pragma("unroll") for (int n = 0; n < 2; ++n) _Pragma("unroll") for (int k = 0; k < 2; ++k) \
        acc[ai][bj][m][n] = __builtin_amdgcn_mfma_f32_16x16x32_bf16(Bt[n][k], At[m][k], acc[ai][bj][m][n], 0, 0, 0); __builtin_amdgcn_s_setprio(0); } while (0)
#define PG8_WAIT_V(n) asm volatile("s_waitcnt vmcnt(" #n ")" ::: "memory")
#define PG8_WAIT_L(n) asm volatile("s_waitcnt lgkmcnt(" #n ")" ::: "memory")
#define PG8_BAR __builtin_amdgcn_s_barrier()
#define PG8_SCHED __builtin_amdgcn_sched_barrier(0)
    Unit cur, nxt; int ui = 0;
    if (!S.next(0, cur)) return;
    f32x4 acc[2][2][4][2];
#pragma unroll
    for (int a = 0; a < 2; ++a)
#pragma unroll
        for (int b = 0; b < 2; ++b)
#pragma unroll
            for (int m = 0; m < 4; ++m)
#pragma unroll
                for (int n = 0; n < 2; ++n) acc[a][b][m][n] = (f32x4){0.f, 0.f, 0.f, 0.f};
    bf16x8 At[4][2], B0[2][2], B1[2][2];
    const char* cA = cur.A; const char* cB = cur.B;
    PG8_SETOFF(offC, cur);
    PG8_STAGE(PG8_SB(0, 0), cB, voffB); PG8_STAGE(PG8_SB(0, 1), cB + hstepB, voffB); PG8_STAGE(PG8_SA(0, 0), cA, offC[0]); PG8_STAGE(PG8_SA(0, 1), cA, offC[1]);
    if (wr == 1) PG8_BAR;
    PG8_WAIT_V(2); PG8_BAR;
    PG8_STAGE(PG8_SB(1, 0), cB + kstep, voffB); PG8_STAGE(PG8_SA(1, 0), cA + kstep, offC[0]); PG8_STAGE(PG8_SB(1, 1), cB + hstepB + kstep, voffB);
    PG8_WAIT_V(6); PG8_BAR;
    for (;;) {
        const bool has_next = S.next(ui + 1, nxt);
        const char* nA = has_next ? nxt.A : cA; const char* nB = has_next ? nxt.B : cB;
        if (has_next) { PG8_SETOFF(offN, nxt); } else { offN[0][0] = offC[0][0]; offN[0][1] = offC[0][1]; offN[1][0] = offC[1][0]; offN[1][1] = offC[1][1]; }
        for (int t = 0; t < nt; t += 2) {
            const bool last = (t == nt - 2);
            const char* a1 = cA + (size_t)(t + 1) * kstep;
            const char* a2 = last ? nA : cA + (size_t)(t + 2) * kstep; const char* b2 = last ? nB : cB + (size_t)(t + 2) * kstep;
            const char* a3 = a2 + kstep; const char* b3 = b2 + kstep;
            unsigned o2[2][2];
            o2[0][0] = last ? offN[0][0] : offC[0][0]; o2[0][1] = last ? offN[0][1] : offC[0][1]; o2[1][0] = last ? offN[1][0] : offC[1][0]; o2[1][1] = last ? offN[1][1] : offC[1][1];
            PG8_LDB(B0, 0, 0); PG8_LDB(B1, 0, 1); PG8_SCHED; PG8_LDA(At, 0, 0); PG8_STAGE(PG8_SA(1, 1), a1, offC[1]);
            PG8_WAIT_V(8); PG8_WAIT_L(0); PG8_BAR; PG8_MMA(0, 0, At, B0); PG8_MMA(0, 1, At, B1); PG8_BAR; PG8_SCHED;
            PG8_LDA(At, 0, 1); PG8_STAGE(PG8_SB(0, 0), b2, voffB); PG8_STAGE(PG8_SB(0, 1), b2 + hstepB, voffB); PG8_STAGE(PG8_SA(0, 0), a2, o2[0]);
            PG8_WAIT_V(8); PG8_WAIT_L(0); PG8_BAR; PG8_MMA(1, 0, At, B0); PG8_MMA(1, 1, At, B1); PG8_BAR; PG8_SCHED;
            PG8_LDB(B0, 1, 0); PG8_LDB(B1, 1, 1); PG8_SCHED; PG8_LDA(At, 1, 0); PG8_STAGE(PG8_SA(0, 1), a2, o2[1]);
            PG8_WAIT_V(8); PG8_WAIT_L(0); PG8_BAR; PG8_MMA(0, 0, At, B0); PG8_MMA(0, 1, At, B1); PG8_BAR; PG8_SCHED;
            PG8_LDA(At, 1, 1); PG8_STAGE(PG8_SB(1, 0), b3, voffB); PG8_STAGE(PG8_SB(1, 1), b3 + hstepB, voffB); PG8_STAGE(PG8_SA(1, 0), a3, o2[0]);
            PG8_WAIT_V(8); PG8_WAIT_L(0); PG8_BAR; PG8_MMA(1, 0, At, B0); PG8_MMA(1, 1, At, B1); PG8_BAR; PG8_SCHED;
        }
        if constexpr (ALIGN_EPI) { if (wr == 0) PG8_BAR; }
        E(acc, cur, wr, wc, fr, fq);
        if (!has_next) break;
#pragma unroll
        for (int a = 0; a < 2; ++a)
#pragma unroll
            for (int b = 0; b < 2; ++b)
#pragma unroll
                for (int m = 0; m < 4; ++m)
#pragma unroll
                    for (int n = 0; n < 2; ++n) acc[a][b][m][n] = (f32x4){0.f, 0.f, 0.f, 0.f};
        cur = nxt; cA = nA; cB = nB; ++ui;
        offC[0][0] = offN[0][0]; offC[0][1] = offN[0][1]; offC[1][0] = offN[1][0]; offC[1][1] = offN[1][1];
        if constexpr (ALIGN_EPI) { if (wr == 1) PG8_BAR; }
    }
    PG8_WAIT_V(0);
    if constexpr (!ALIGN_EPI) { if (wr == 0) PG8_BAR; }
    PG8_BAR;
#undef PG8_SETOFF
#undef PG8_SA
#undef PG8_SB
#undef PG8_STAGE
#undef PG8_LDA
#undef PG8_LDB
#undef PG8_MMA
#undef PG8_WAIT_V
#undef PG8_WAIT_L
#undef PG8_BAR
#undef PG8_SCHED
}

struct DenseOrder {
    const char* A; const char* B; size_t tstepA, tstepB; int nM, nN, nwg, G, c;
    __device__ __forceinline__ void init(const void* A_, const void* B_, int M, int N, int lda, int ldb, int G_, int c_) {
        A = (const char*)A_; B = (const char*)B_; tstepA = (size_t)BM * lda * 2; tstepB = (size_t)BM * ldb * 2; nM = M / BM; nN = N / BM; nwg = nM * nN; G = G_; c = c_; }
    __device__ __forceinline__ bool next(int i, Unit& u) const {
        const long L = (long)i * G + c; if (L >= nwg) return false;
        int wgid = (int)L; { const int q = nwg / 8, r = nwg % 8, xcd = wgid % 8, off = wgid / 8; wgid = (xcd < r ? xcd * (q + 1) : r * (q + 1) + (xcd - r) * q) + off; }
        const int nig = 8 * nN, gid = wgid / nig, fm = gid * 8, gsz = (nM - fm) < 8 ? (nM - fm) : 8;
        u.pm = fm + ((wgid % nig) % gsz); u.pn = (wgid % nig) / gsz; u.e = 0; u.nvalid = 256; u.rows = nullptr; u.rmax = 255;
        u.A = A + (size_t)u.pm * tstepA; u.B = B + (size_t)u.pn * tstepB; return true;
    }
};
}

__device__ __forceinline__ int map_in(int n) { return n < 1792 ? n : (n < 3840 ? n + 24 : (n < 3864 ? 1792 + (n - 3840) : -1)); }
__device__ __forceinline__ int map_il128(int n) { const int b = n >> 7; return (b & 1) * 1024 + (b >> 1) * 128 + (n & 127); }

struct TrJob { const float* W; bf16_t* Wt; int K, Nsrc, map, kt, nt; };
constexpr int TR_IN = 16 * 16, TR_GLU = 8 * 8, TR_NSA = 8 * 4, TR_OUT = 16 * 4, TR_C1 = 2 * 32, TR_GU = 32 * 16 * 8, TR_DN = 32 * 16 * 4;
constexpr int TR_ITEMS = TR_IN + TR_GLU + TR_NSA + TR_OUT + TR_C1 + TR_GU + TR_DN;
__device__ __forceinline__ void tr_job(const Params& p, int r, TrJob& j) {
    unsigned char* ws = p.ws;
    if (r < TR_IN) { j = TrJob{p.in[5], (bf16_t*)(ws + O_WT_IN), 1024, 3864, 1, r / 16, r % 16}; return; } r -= TR_IN;
    if (r < TR_GLU) { j = TrJob{p.in[14], (bf16_t*)(ws + O_WT_GLU), 512, 2048, 2, r / 8, r % 8}; return; } r -= TR_GLU;
    if (r < TR_NSA) { j = TrJob{p.in[22], (bf16_t*)(ws + O_WT_NSA), 512, 1024, 0, r / 4, r % 4}; return; } r -= TR_NSA;
    if (r < TR_OUT) { j = TrJob{p.in[23], (bf16_t*)(ws + O_WT_OUT), 1024, 1024, 0, r / 4, r % 4}; return; } r -= TR_OUT;
    if (r < TR_C1) { const int kv = r / 32; j = TrJob{p.in[kv ? 20 : 17], (bf16_t*)(ws + O_WT_C1) + (size_t)kv * 256 * 2048, 2048, 128, 3, r % 32, 0}; return; } r -= TR_C1;
    if (r < TR_GU) { const int e = r / 128, q = r % 128; j = TrJob{p.in[28] + (size_t)e * 1024 * 2048, (bf16_t*)(ws + O_WT_GU) + (size_t)e * 2048 * 1024, 1024, 2048, 2, q / 8, q % 8}; return; } r -= TR_GU;
    { const int e = r / 64, q = r % 64; j = TrJob{p.in[30] + (size_t)e * 1024 * 1024, (bf16_t*)(ws + O_WT_DN) + (size_t)e * 1024 * 1024, 1024, 1024, 0, q / 4, q % 4}; }
}
__device__ __forceinline__ void tr_load(const TrJob& j, f32x4 (&v)[8], int tid) {
    const int n4 = tid & 63, kq = tid >> 6, nd = j.nt * 256 + 4 * n4;
    const int src = j.map == 0 ? nd : (j.map == 1 ? map_in(nd) : (j.map == 2 ? map_il128(nd) : (nd < 128 ? nd : -1)));
    const float* base = j.W + (size_t)(j.kt * 64 + kq) * j.Nsrc + (src >= 0 ? src : 0);
#pragma unroll
    for (int i = 0; i < 8; ++i) v[i] = (src >= 0) ? *(const f32x4*)(base + (size_t)i * 8 * j.Nsrc) : (f32x4){0.f, 0.f, 0.f, 0.f};
}
__device__ __forceinline__ void convert_weights(const Params& p, unsigned char* smem) {
    float* t = (float*)smem;
    const int tid = threadIdx.x;
    int it = blockIdx.x;
    if (it >= TR_ITEMS) return;
    TrJob j; tr_job(p, it, j);
    f32x4 v[8];
    tr_load(j, v, tid);
    for (;;) {
        { const int n4 = tid & 63, kq = tid >> 6;
#pragma unroll
          for (int i = 0; i < 8; ++i) *(f32x4*)(t + (i * 8 + kq) * 260 + 4 * n4) = v[i]; }
        __syncthreads();
        const TrJob cj = j;
        const int nit = it + gridDim.x;
        const bool more = nit < TR_ITEMS;
        if (more) { tr_job(p, nit, j); tr_load(j, v, tid); }
        { const int n = tid & 255, kh = (tid >> 8) * 32;
          bf16_t* d = cj.Wt + (size_t)(cj.nt * 256 + n) * cj.K + cj.kt * 64 + kh;
#pragma unroll
          for (int q = 0; q < 4; ++q) {
              const float* c = t + (kh + 8 * q) * 260 + n;
              u32x4 o;
              o.x = pk2(c[0], c[260]); o.y = pk2(c[2 * 260], c[3 * 260]); o.z = pk2(c[4 * 260], c[5 * 260]); o.w = pk2(c[6 * 260], c[7 * 260]);
              *(u32x4*)(d + 8 * q) = o;
          } }
        __syncthreads();
        if (!more) break;
        it = nit;
    }
}

__device__ __forceinline__ void phase0(const Params& p, unsigned char* smem) {
    unsigned char* ws = p.ws;
    const int tid = threadIdx.x;
    convert_weights(p, smem);
    constexpr int I_ADA = 96;
    constexpr int I_S5 = 32 * 33;
    constexpr int I_MISC = 17;
    constexpr int NITEM = I_ADA + I_S5 + I_MISC;
    for (int item = blockIdx.x; item < NITEM; item += gridDim.x) {
        int r = item;
        if (r < I_ADA) {
            const float* c = p.in[1]; const float* w = p.in[3]; const float* bb = p.in[4];
            const int wid = tid >> 6, lane = tid & 63, j = r * 64 + lane;
            float a0 = 0.f, a1 = 0.f, a2 = 0.f, a3 = 0.f;
#pragma unroll 4
            for (int k = wid * 128; k < wid * 128 + 128; ++k) {
                const float wv = w[(size_t)k * 6144 + j];
                const float c0 = c[k], c1 = c[1024 + k], c2 = c[2048 + k], c3 = c[3072 + k];
                a0 += c0 * sigmoidf_(c0) * wv; a1 += c1 * sigmoidf_(c1) * wv; a2 += c2 * sigmoidf_(c2) * wv; a3 += c3 * sigmoidf_(c3) * wv;
            }
            float* red = (float*)smem;
            red[(wid * 4 + 0) * 64 + lane] = a0; red[(wid * 4 + 1) * 64 + lane] = a1; red[(wid * 4 + 2) * 64 + lane] = a2; red[(wid * 4 + 3) * 64 + lane] = a3;
            __syncthreads();
            if (tid < 256) { const int b = tid >> 6; float s = 0.f;
#pragma unroll
              for (int w8 = 0; w8 < 8; ++w8) s += red[(w8 * 4 + b) * 64 + lane];
              ((float*)(ws + O_ADA))[b * 6144 + j] = s + bb[j]; }
            __syncthreads();
            continue;
        }
        r -= I_ADA;
        if (r < I_S5) {
            const int g = r / 33, dl = r % 33;
            f32x2* pw = (f32x2*)smem;
            f32x2* bbv = pw + 64;
            f32x2* ccv = bbv + 1024;
            const float dt = expf(p.in[8][g]);
            if (tid < 64) {
                const int n = tid; const double re = p.in[6][g * 64 + n], im = p.in[7][g * 64 + n];
                const double mag = exp(re * (double)dt * dl), ang = im * (double)dt * dl;
                double sn, cs; sincos(ang, &sn, &cs);
                pw[n] = (f32x2){(float)(mag * cs), (float)(mag * sn)};
                if (dl == 32) { ((f32x2*)(ws + O_LAML))[g * 64 + n] = pw[n]; }
            }
            for (int e = tid; e < 1024; e += NT) {
                const int n = e >> 4, q = e & 15;
                const double re = p.in[6][g * 64 + n], im = p.in[7][g * 64 + n];
                const double mag = exp(re * (double)dt), ang = im * (double)dt;
                double sn, cs; sincos(ang, &sn, &cs);
                const double lr = mag * cs - 1.0, li = mag * sn;
                const double den = re * re + im * im;
                const double fr_ = (lr * re + li * im) / den, fi_ = (li * re - lr * im) / den;
                const double br = p.in[9][(g * 64 + n) * 16 + q], bi = p.in[10][(g * 64 + n) * 16 + q];
                bbv[e] = (f32x2){(float)(fr_ * br - fi_ * bi), (float)(fr_ * bi + fi_ * br)};
            }
            for (int e = tid; e < 1024; e += NT) { ccv[e] = (f32x2){p.in[11][g * 1024 + e], p.in[12][g * 1024 + e]}; }
            __syncthreads();
            bf16_t* TW2 = (bf16_t*)(ws + O_TW2) + (size_t)g * 512 * UROW;
            bf16_t* W1T = (bf16_t*)(ws + O_W1T) + (size_t)g * 256 * 512;
            if (dl < 32) {
                if (tid < 256) {
                    const int pp = tid >> 4, q = tid & 15;
                    float acc = 0.f;
                    for (int n = 0; n < 64; ++n) {
                        const f32x2 cv = ccv[pp * 64 + n], pv = pw[n], bv = bbv[n * 16 + q];
                        const float xr = cv.x * pv.x - cv.y * pv.y, xi = cv.x * pv.y + cv.y * pv.x;
                        acc += xr * bv.x - xi * bv.y;
                    }
                    if (dl == 0 && pp == q) acc += p.in[13][g * 16 + pp];
                    const bf16_t kb = f2bf(acc);
                    for (int tau = dl; tau < 32; ++tau) { const int s = tau - dl; TW2[(size_t)(tau * 16 + pp) * UROW + s * 16 + q] = kb; }
                    if (dl >= 1) for (int s = dl; s < 32; ++s) { const int tau = s - dl; TW2[(size_t)(tau * 16 + pp) * UROW + s * 16 + q] = 0; }
                }
                const int s = 31 - dl;
                for (int e = tid; e < 2048; e += NT) {
                    const int c = e >> 4, qq = e & 15, n = c & 63, ri = c >> 6;
                    const f32x2 pv = pw[n], bv = bbv[n * 16 + qq];
                    const float zr = pv.x * bv.x - pv.y * bv.y, zi = pv.x * bv.y + pv.y * bv.x;
                    W1T[(size_t)c * 512 + s * 16 + qq] = f2bf(ri ? zi : zr);
                }
            } else {
                u32x4* z = (u32x4*)(W1T + (size_t)128 * 512);
                for (int e = tid; e < 128 * 512 / 8; e += NT) z[e] = (u32x4){0u, 0u, 0u, 0u};
            }
            if (dl >= 1) {
                const int tau = dl - 1;
                for (int e = tid; e < 2048; e += NT) {
                    const int pp = e >> 7, c = e & 127, n = c & 63, ri = c >> 6;
                    const f32x2 cv = ccv[pp * 64 + n], pv = pw[n];
                    const float xr = cv.x * pv.x - cv.y * pv.y, xi = cv.x * pv.y + cv.y * pv.x;
                    TW2[(size_t)(tau * 16 + pp) * UROW + 512 + c] = f2bf(ri ? -xi : xr);
                }
            }
            __syncthreads();
            continue;
        }
        r -= I_S5;
        if (r < 16) {
            const int kv = r >> 3, part = r & 7, j = tid & 127, qtr = tid >> 7;
            const float* pos = p.in[kv ? 19 : 16]; const float* w1 = p.in[kv ? 20 : 17];
            float a = 0.f;
            const int i0 = part * 256 + qtr * 64;
            for (int i = i0; i < i0 + 64; ++i) a += pos[i] * w1[(size_t)i * 128 + j];
            float* red = (float*)smem;
            red[tid] = a;
            __syncthreads();
            if (tid < 128) ((float*)(ws + O_BIAS1))[(kv * 8 + part) * 128 + tid] = (red[tid] + red[tid + 128]) + (red[tid + 256] + red[tid + 384]);
            __syncthreads();
            continue;
        }
        if (tid < 64) ((unsigned*)(ws + O_CNT))[tid] = 0u;
    }
}

__device__ __forceinline__ void phase1(const Params& p, unsigned char*) {
    const float* x = p.in[0];
    bf16_t* xn = (bf16_t*)(p.ws + O_XN);
    for (size_t i = (size_t)blockIdx.x * NT + threadIdx.x; i < (size_t)NTOK * 128; i += (size_t)gridDim.x * NT) {
        const int token = (int)(i >> 7), k = (int)(i & 127) * 8, b = token >> 13;
        const float* ada = (const float*)(p.ws + O_ADA) + b * 6144;
        const f32x4 x0 = *(const f32x4*)(x + (size_t)token * 1024 + k), x1 = *(const f32x4*)(x + (size_t)token * 1024 + k + 4);
        const f32x4 s0 = *(const f32x4*)(ada + 1024 + k), s1 = *(const f32x4*)(ada + 1024 + k + 4);
        const f32x4 h0 = *(const f32x4*)(ada + k), h1 = *(const f32x4*)(ada + k + 4);
        u32x4 o;
        o.x = pk2(x0[0] * (1.f + s0[0]) + h0[0], x0[1] * (1.f + s0[1]) + h0[1]); o.y = pk2(x0[2] * (1.f + s0[2]) + h0[2], x0[3] * (1.f + s0[3]) + h0[3]);
        o.z = pk2(x1[0] * (1.f + s1[0]) + h1[0], x1[1] * (1.f + s1[1]) + h1[1]); o.w = pk2(x1[2] * (1.f + s1[2]) + h1[2], x1[3] * (1.f + s1[3]) + h1[3]);
        *(u32x4*)(xn + (size_t)token * 1024 + k) = o;
    }
}

typedef const f32x4 (&AccRef)[2][2][4][2];
struct EpiIn {
    static constexpr bool PERM = true;
    unsigned char* ws;
    __device__ __forceinline__ void operator()(AccRef acc, const pg8::Unit& u, int wr, int wc, int fr, int fq) const {
        const int pn = u.pn;
#pragma unroll
        for (int ai = 0; ai < 2; ++ai)
#pragma unroll
            for (int m = 0; m < 4; ++m) {
                const int token = u.pm * 256 + ai * 128 + wr * 64 + m * 16 + fr;
#pragma unroll
                for (int bj = 0; bj < 2; ++bj) {
                    const int col = pn * 256 + bj * 128 + wc * 32 + 8 * fq;
                    const f32x4 v0 = acc[ai][bj][m][0], v1 = acc[ai][bj][m][1];
                    if (pn < 2) {
                        const int g = col >> 4, q = col & 15;
                        bf16_t* d = (bf16_t*)(ws + O_U) + ((size_t)(g * 1024 + (token >> 5)) * UROW + (token & 31) * 16 + q);
                        *(u32x4*)d = (u32x4){pk2(v0[0], v0[1]), pk2(v0[2], v0[3]), pk2(v1[0], v1[1]), pk2(v1[2], v1[3])};
                    } else if (pn < 4) {
                        bf16_t* d = (bf16_t*)(ws + O_Q) + (size_t)token * 512 + (col - 512);
                        *(u32x4*)d = (u32x4){pk2(v0[0] * QSCALE, v0[1] * QSCALE), pk2(v0[2] * QSCALE, v0[3] * QSCALE), pk2(v1[0] * QSCALE, v1[1] * QSCALE), pk2(v1[2] * QSCALE, v1[3] * QSCALE)};
                    } else if (pn < 7) {
                        const int c = col - 1024, j6 = c >> 7, g = (c >> 6) & 1, dd = c & 63, b = token >> 13, s = token & 8191;
                        bf16_t* slab = (bf16_t*)(ws + O_KV) + (size_t)((j6 * 4 + b) * 2 + g) * KV_SLAB;
                        if (j6 == 3 || j6 == 5) {
                            const int sp = (s & ~15) | (s & 3) | ((s & 4) << 1) | ((s & 8) >> 1);
#pragma unroll
                            for (int j = 0; j < 4; ++j) { slab[(size_t)(dd + j) * SEQ + sp] = f2bf(v0[j]); slab[(size_t)(dd + 4 + j) * SEQ + sp] = f2bf(v1[j]); }
                        } else {
                            *(u32x4*)(slab + (size_t)s * 64 + dd) = (u32x4){pk2(v0[0], v0[1]), pk2(v0[2], v0[3]), pk2(v1[0], v1[1]), pk2(v1[2], v1[3])};
                        }
                    } else if (pn < 15) {
                        bf16_t* d = (pn < 11 ? (bf16_t*)(ws + O_SG5) + (size_t)token * 1024 + (col - 1792) : (bf16_t*)(ws + O_SGN) + (size_t)token * 1024 + (col - 2816));
                        *(u32x4*)d = (u32x4){pk2(sigmoidf_(v0[0]), sigmoidf_(v0[1])), pk2(sigmoidf_(v0[2]), sigmoidf_(v0[3])), pk2(sigmoidf_(v1[0]), sigmoidf_(v1[1])), pk2(sigmoidf_(v1[2]), sigmoidf_(v1[3]))};
                    } else {
                        const int c = col - 3840;
                        if (c < 24) { float* d = (float*)(ws + O_GN) + (size_t)token * 24 + c;
                            *(f32x4*)d = (f32x4){sigmoidf_(v0[0]), sigmoidf_(v0[1]), sigmoidf_(v0[2]), sigmoidf_(v0[3])};
                            *(f32x4*)(d + 4) = (f32x4){sigmoidf_(v1[0]), sigmoidf_(v1[1]), sigmoidf_(v1[2]), sigmoidf_(v1[3])}; }
                    }
                }
            }
    }
};
__device__ __forceinline__ void phase2(const Params& p, LAS unsigned char* lds) {
    pg8::DenseOrder S; S.init(p.ws + O_XN, p.ws + O_WT_IN, NTOK, NIN_PAD, 1024, 1024, gridDim.x, blockIdx.x);
    EpiIn E{p.ws};
    pg8::gemm_phase<EpiIn, pg8::DenseOrder, true>(lds, 1024, 1024, 1024, S, E);
}

struct BatchOrder {
    const char* A; const char* B; size_t bsA, bsB, tstepA, tstepB; int nM, nN, nunits, G, c;
    __device__ __forceinline__ bool next(int i, pg8::Unit& u) const {
        const long L = (long)i * G + c; if (L >= nunits) return false;
        const int per = nM * nN, bt = (int)L / per, rem = (int)L % per;
        u.pm = rem / nN; u.pn = rem % nN; u.e = bt; u.nvalid = 256; u.rows = nullptr; u.rmax = 255;
        u.A = A + (size_t)bt * bsA + (size_t)u.pm * tstepA; u.B = B + (size_t)bt * bsB + (size_t)u.pn * tstepB; return true;
    }
};
struct EpiE { static constexpr bool PERM = false; float* E;
    __device__ __forceinline__ void operator()(AccRef acc, const pg8::Unit& u, int wr, int wc, int fr, int fq) const {
#pragma unroll
        for (int ai = 0; ai < 2; ++ai)
#pragma unroll
            for (int m = 0; m < 4; ++m) {
                const int r = u.pm * 256 + ai * 128 + wr * 64 + m * 16 + fr;
#pragma unroll
                for (int n = 0; n < 2; ++n) *(f32x4*)(E + ((size_t)u.e * 1024 + r) * 128 + wc * 32 + n * 16 + fq * 4) = acc[ai][0][m][n];
            }
    } };
struct EpiCmp { static constexpr bool PERM = true; const float* b1p; bf16_t* HC;
    __device__ __forceinline__ void operator()(AccRef acc, const pg8::Unit& u, int wr, int wc, int fr, int fq) const {
        const int col = wc * 32 + 8 * fq;
        f32x4 b0 = (f32x4){0.f, 0.f, 0.f, 0.f}, b1 = b0;
#pragma unroll
        for (int part = 0; part < 8; ++part) { b0 += *(const f32x4*)(b1p + (u.e * 8 + part) * 128 + col); b1 += *(const f32x4*)(b1p + (u.e * 8 + part) * 128 + col + 4); }
#pragma unroll
        for (int ai = 0; ai < 2; ++ai)
#pragma unroll
            for (int m = 0; m < 4; ++m) {
                const int R = u.pm * 256 + ai * 128 + wr * 64 + m * 16 + fr;
                const f32x4 v0 = acc[ai][0][m][0] + b0, v1 = acc[ai][0][m][1] + b1;
                *(u32x4*)(HC + ((size_t)u.e * 4096 + R) * 128 + col) = (u32x4){pk2(gelu_tanh(v0[0]), gelu_tanh(v0[1])), pk2(gelu_tanh(v0[2]), gelu_tanh(v0[3])), pk2(gelu_tanh(v1[0]), gelu_tanh(v1[1])), pk2(gelu_tanh(v1[2]), gelu_tanh(v1[3]))};
            }
    } };
__device__ __forceinline__ void phase3(const Params& p, LAS unsigned char* lds) {
    const int G = gridDim.x;
    {
        BatchOrder S{(const char*)(p.ws + O_U), (const char*)(p.ws + O_W1T), (size_t)1024 * UROW * 2, (size_t)256 * 512 * 2, (size_t)256 * UROW * 2, 0, 4, 1, 128, G, (int)blockIdx.x};
        EpiE E{(float*)(p.ws + O_E)};
        pg8::gemm_phase<EpiE, BatchOrder, false>(lds, 512, UROW, 512, S, E);
    }
    {
        BatchOrder S{(const char*)(p.ws + O_KV), (const char*)(p.ws + O_WT_C1), (size_t)8 * KV_SLAB * 2, (size_t)256 * 2048 * 2, (size_t)256 * 1024 * 2, 0, 16, 1, 32, G, (int)((blockIdx.x + G - 128 % G) % G)};
        EpiCmp E{(const float*)(p.ws + O_BIAS1), (bf16_t*)(p.ws + O_HC)};
        pg8::gemm_phase<EpiCmp, BatchOrder, false>(lds, 2048, 1024, 2048, S, E);
    }
}
__device__ __forceinline__ void phase4(const Params& p, unsigned char*) {
    const int tid = threadIdx.x;
    for (int item = blockIdx.x; item < 16 + 1024; item += gridDim.x) {
        if (item < 16) {
            const int n = tid & 63, bg = item * 8 + (tid >> 6), b = bg >> 5, g = bg & 31;
            const f32x2 lm = ((const f32x2*)(p.ws + O_LAML))[g * 64 + n];
            const float* E = (const float*)(p.ws + O_E) + (size_t)(g * 1024 + b * 256) * 128;
            bf16_t* U = (bf16_t*)(p.ws + O_U) + (size_t)(g * 1024 + b * 256) * UROW + 512;
            float hr = 0.f, hi = 0.f;
#pragma unroll 8
            for (int c = 0; c < NCHUNK; ++c) {
                const float er = E[(size_t)c * 128 + n], ei = E[(size_t)c * 128 + 64 + n];
                U[(size_t)c * UROW + n] = f2bf(hr); U[(size_t)c * UROW + 64 + n] = f2bf(hi);
                const float nr = lm.x * hr - lm.y * hi + er, ni = lm.x * hi + lm.y * hr + ei;
                hr = nr; hi = ni;
            }
        } else {
            const int o = (item - 16) * NT + tid, d = o & 63, R = (o >> 6) & 4095, kv = o >> 18;
            const bf16_t* h = (const bf16_t*)(p.ws + O_HC) + ((size_t)kv * 4096 + R) * 128;
            const float* w2 = p.in[kv ? 21 : 18];
            float a = 0.f;
#pragma unroll 8
            for (int j = 0; j < 128; ++j) a += bf2f(h[j]) * w2[j * 64 + d];
            if (kv == 0) ((bf16_t*)(p.ws + O_KC))[(size_t)R * 64 + d] = f2bf(a);
            else { const int bgi = R >> 9, n = R & 511, np = (n & ~15) | (n & 3) | ((n & 4) << 1) | ((n & 8) >> 1);
                   ((bf16_t*)(p.ws + O_KC))[(size_t)4096 * 64 + ((size_t)bgi * 64 + d) * 512 + np] = f2bf(a); }
        }
    }
}
struct EpiY { static constexpr bool PERM = true; bf16_t* YS;
    __device__ __forceinline__ void operator()(AccRef acc, const pg8::Unit& u, int wr, int wc, int fr, int fq) const {
#pragma unroll
        for (int ai = 0; ai < 2; ++ai)
#pragma unroll
            for (int m = 0; m < 4; ++m) {
                const int r = u.pm * 256 + ai * 128 + wr * 64 + m * 16 + fr;
                const int tok0 = (r >> 8) * SEQ + (r & 255) * S5L;
#pragma unroll
                for (int bj = 0; bj < 2; ++bj) {
                    const int col = u.pn * 256 + bj * 128 + wc * 32 + 8 * fq, tau = col >> 4, pp = col & 15;
                    const f32x4 v0 = acc[ai][bj][m][0], v1 = acc[ai][bj][m][1];
                    *(u32x4*)(YS + (size_t)(tok0 + tau) * 512 + u.e * 16 + pp) = (u32x4){pk2(gelu_tanh(v0[0]), gelu_tanh(v0[1])), pk2(gelu_tanh(v0[2]), gelu_tanh(v0[3])), pk2(gelu_tanh(v1[0]), gelu_tanh(v1[1])), pk2(gelu_tanh(v1[2]), gelu_tanh(v1[3]))};
                }
            }
    } };
__device__ __forceinline__ void phase5(const Params& p, LAS unsigned char* lds) {
    BatchOrder S{(const char*)(p.ws + O_U), (const char*)(p.ws + O_TW2), (size_t)1024 * UROW * 2, (size_t)512 * UROW * 2, (size_t)256 * UROW * 2, (size_t)256 * UROW * 2, 4, 2, 256, (int)gridDim.x, (int)blockIdx.x};
    EpiY E{(bf16_t*)(p.ws + O_YS)};
    pg8::gemm_phase<EpiY, BatchOrder, false>(lds, UROW, UROW, UROW, S, E);
}
struct EpiGlu { static constexpr bool PERM = true; const float* bglu; const bf16_t* SG5; bf16_t* MS5;
    __device__ __forceinline__ void operator()(AccRef acc, const pg8::Unit& u, int wr, int wc, int fr, int fq) const {
        const int cv = u.pn * 128 + wc * 32 + 8 * fq;
        const f32x4 bv0 = *(const f32x4*)(bglu + cv), bv1 = *(const f32x4*)(bglu + cv + 4), bg0 = *(const f32x4*)(bglu + 1024 + cv), bg1 = *(const f32x4*)(bglu + 1024 + cv + 4);
#pragma unroll
        for (int ai = 0; ai < 2; ++ai)
#pragma unroll
            for (int m = 0; m < 4; ++m) {
                const int token = u.pm * 256 + ai * 128 + wr * 64 + m * 16 + fr;
                const u32x4 sg = *(const u32x4*)(SG5 + (size_t)token * 1024 + cv);
                const f32x4 va0 = acc[ai][0][m][0] + bv0, va1 = acc[ai][0][m][1] + bv1, ga0 = acc[ai][1][m][0] + bg0, ga1 = acc[ai][1][m][1] + bg1;
                u32x4 o;
                o.x = pk2(va0[0] * sigmoidf_(ga0[0]) * bflo(sg.x), va0[1] * sigmoidf_(ga0[1]) * bfhi(sg.x)); o.y = pk2(va0[2] * sigmoidf_(ga0[2]) * bflo(sg.y), va0[3] * sigmoidf_(ga0[3]) * bfhi(sg.y));
                o.z = pk2(va1[0] * sigmoidf_(ga1[0]) * bflo(sg.z), va1[1] * sigmoidf_(ga1[1]) * bfhi(sg.z)); o.w = pk2(va1[2] * sigmoidf_(ga1[2]) * bflo(sg.w), va1[3] * sigmoidf_(ga1[3]) * bfhi(sg.w));
                *(u32x4*)(MS5 + (size_t)token * 1024 + cv) = o;
            }
    } };
__device__ __forceinline__ void phase6(const Params& p, LAS unsigned char* lds) {
    pg8::DenseOrder S; S.init(p.ws + O_YS, p.ws + O_WT_GLU, NTOK, 2048, 512, 512, gridDim.x, blockIdx.x);
    EpiGlu E{p.in[15], (const bf16_t*)(p.ws + O_SG5), (bf16_t*)(p.ws + O_MS5)};
    pg8::gemm_phase<EpiGlu, pg8::DenseOrder, true>(lds, 512, 512, 512, S, E);
}
typedef float f32x16 __attribute__((ext_vector_type(16)));
__device__ __forceinline__ int rel_bucket_dev(int dist) {
    const int n = dist > 0 ? dist : 0;
    if (n < 16) return n;
    const int l = (int)(__log2f((float)n * 0.0625f) * 2.6666667f);
    const int v = 16 + l;
    return v < 31 ? v : 31;
}
__device__ __forceinline__ float xhalf_max(float v) { auto rr = __builtin_amdgcn_permlane32_swap(__float_as_uint(v), __float_as_uint(v), false, false); return fmaxf(__uint_as_float(rr[0]), __uint_as_float(rr[1])); }
__device__ __forceinline__ float xhalf_sum(float v) { auto rr = __builtin_amdgcn_permlane32_swap(__float_as_uint(v), __float_as_uint(v), false, false); return __uint_as_float(rr[0]) + __uint_as_float(rr[1]); }
__device__ __forceinline__ float quad_sum(float v) {
    v += __uint_as_float(__builtin_amdgcn_update_dpp(0u, __float_as_uint(v), 0xB1, 0xF, 0xF, true));
    v += __uint_as_float(__builtin_amdgcn_update_dpp(0u, __float_as_uint(v), 0x4E, 0xF, 0xF, true));
    return v;
}
constexpr int LUTW = 1028;
constexpr int IMPW = 132;
constexpr float NEG_BIG = -1e30f;

typedef int v4i_t __attribute__((ext_vector_type(4)));
typedef __amdgpu_buffer_rsrc_t rsrc_t;
__device__ __forceinline__ bf16x8 bload16(rsrc_t r, unsigned voff, unsigned soff) { return __builtin_bit_cast(bf16x8, __builtin_amdgcn_raw_buffer_load_b128(r, (int)voff, (int)soff, 0)); }
__device__ __forceinline__ void load_k(bf16x8 (&kf)[8], rsrc_t r, unsigned soff, unsigned voff) {
#pragma unroll
    for (int sub = 0; sub < 2; ++sub)
#pragma unroll
        for (int s = 0; s < 4; ++s) kf[sub * 4 + s] = bload16(r, voff + s * 32, soff + sub * 4096);
}
__device__ __forceinline__ void load_v(bf16x8 (&vf)[8], rsrc_t r, unsigned soff, unsigned voff, int rs) {
#pragma unroll
    for (int dt = 0; dt < 2; ++dt)
#pragma unroll
        for (int sub = 0; sub < 2; ++sub)
#pragma unroll
            for (int s2 = 0; s2 < 2; ++s2) vf[dt * 4 + sub * 2 + s2] = bload16(r, voff + sub * 64 + s2 * 32, soff + dt * 64 * rs);
}
__device__ __forceinline__ void qk_block(f32x16 (&st)[2], const bf16x8 (&qf)[4], const bf16x8 (&kf)[8], float cinit) {
#pragma unroll
    for (int sub = 0; sub < 2; ++sub) {
        f32x16 acc;
#pragma unroll
        for (int r = 0; r < 16; ++r) acc[r] = cinit;
#pragma unroll
        for (int s = 0; s < 4; ++s) acc = __builtin_amdgcn_mfma_f32_32x32x16_bf16(kf[sub * 4 + s], qf[s], acc, 0, 0, 0);
        st[sub] = acc;
    }
}
template <int MODE>
__device__ __forceinline__ void bias_mask(f32x16 (&st)[2], int dist0, bool selme, const float* lut) {
    constexpr int STEP = MODE == 0 ? 16 : 1;
#pragma unroll
    for (int sub = 0; sub < 2; ++sub) {
        float bias[16];
#pragma unroll
        for (int r = 0; r < 16; ++r) {
            const int dist = dist0 - STEP * (32 * sub + (r & 3) + 8 * (r >> 2));
            const int idx = dist < 0 ? 0 : (dist > 1024 ? 1024 : dist);
            bias[r] = lut[idx];
        }
#pragma unroll
        for (int r = 0; r < 16; ++r) {
            const int dist = dist0 - STEP * (32 * sub + (r & 3) + 8 * (r >> 2));
            bool valid = dist >= 0;
            if (MODE == 1) valid = valid && selme;
            if (MODE == 2) valid = valid && (dist < 512);
            const float v = st[sub][r] + bias[r];
            st[sub][r] = valid ? v : -INFINITY;
        }
    }
}
__device__ __forceinline__ float tile_max(const f32x16 (&st)[2]) {
    float a = fmaxf(st[0][0], st[1][0]);
#pragma unroll
    for (int r = 1; r < 16; ++r) a = fmaxf(a, fmaxf(st[0][r], st[1][r]));
    return xhalf_max(a);
}
__device__ __forceinline__ void pv_block(f32x16 (&O)[2], const f32x16 (&st)[2], const bf16x8 (&vf)[8]) {
    bf16x8 pf[2][2];
#pragma unroll
    for (int sub = 0; sub < 2; ++sub)
#pragma unroll
        for (int s2 = 0; s2 < 2; ++s2) {
            u32x4 w;
            w.x = pk2(st[sub][8 * s2 + 0], st[sub][8 * s2 + 1]); w.y = pk2(st[sub][8 * s2 + 2], st[sub][8 * s2 + 3]);
            w.z = pk2(st[sub][8 * s2 + 4], st[sub][8 * s2 + 5]); w.w = pk2(st[sub][8 * s2 + 6], st[sub][8 * s2 + 7]);
            pf[sub][s2] = __builtin_bit_cast(bf16x8, w);
        }
#pragma unroll
    for (int dt = 0; dt < 2; ++dt)
#pragma unroll
        for (int sub = 0; sub < 2; ++sub)
#pragma unroll
            for (int s2 = 0; s2 < 2; ++s2) O[dt] = __builtin_amdgcn_mfma_f32_32x32x16_bf16(vf[dt * 4 + sub * 2 + s2], pf[sub][s2], O[dt], 0, 0, 0);
}
__device__ __forceinline__ void softmax_step(f32x16 (&st)[2], f32x16 (&O)[2], float& m, float& l) {
    const float mn = fmaxf(m, tile_max(st));
    const float corr = __builtin_amdgcn_exp2f(m - mn);
    float sum = 0.f;
#pragma unroll
    for (int sub = 0; sub < 2; ++sub)
#pragma unroll
        for (int r = 0; r < 16; ++r) { const float pe = __builtin_amdgcn_exp2f(st[sub][r] - mn); st[sub][r] = pe; sum += pe; }
    l = l * corr + sum;
    if (__any(corr != 1.f)) {
#pragma unroll
        for (int dt = 0; dt < 2; ++dt)
#pragma unroll
            for (int r = 0; r < 16; ++r) O[dt][r] *= corr;
    }
    m = mn;
}

constexpr int FLW = 68;
template <int MODE>
__device__ __forceinline__ void kv_step(f32x16 (&O)[2], float& m, float& l, const bf16x8 (&qf)[4], const bf16x8 (&kf)[8], bf16x8 (&kn)[8], rsrc_t rv, unsigned ksoff_next, unsigned koff,
                                        unsigned vsoff_blk, unsigned vvoff, bool nearb, int dist0, bool selme, float b31, const float* lut) {
    bf16x8 vf[8];
    load_v(vf, rv, vsoff_blk, vvoff, SEQ);
    f32x16 st[2];
    qk_block(st, qf, kf, nearb ? 0.f : (selme ? b31 : -INFINITY));
    __builtin_amdgcn_sched_barrier(0);
    load_k(kn, rv, ksoff_next, koff);
    if (nearb) bias_mask<MODE>(st, dist0, selme, lut);
    softmax_step(st, O, m, l);
    pv_block(O, st, vf);
}

__device__ __forceinline__ void nsa_tile(const Params& p, int bg, int tg, const float* lutall, float* impw, float* fl, int lane) {
    asm volatile("" : "+v"(lane));
    const int q = lane & 31, h2 = lane >> 5, tok = q >> 2, head = q & 3;
    const int b = bg >> 1, g = bg & 1, t0 = tg * 8, t = t0 + tok, token = b * SEQ + t;
    const float* lut = lutall + head * LUTW;
    const float b31 = lut[1024];
    bf16x8 qf[4];
    { const bf16_t* qp = (const bf16_t*)(p.ws + O_Q) + (size_t)token * 512 + (g * 4 + head) * 64 + 8 * h2;
#pragma unroll
      for (int s = 0; s < 4; ++s) qf[s] = *(const bf16x8*)(qp + 16 * s); }
    const float* gn = (const float*)(p.ws + O_GN) + (size_t)token * 24 + (g * 4 + head) * 3;
    float* flp = fl + q * FLW + 4 * h2;
    f32x16 O[2];
#pragma unroll
    for (int dt = 0; dt < 2; ++dt)
#pragma unroll
        for (int r = 0; r < 16; ++r) O[dt][r] = 0.f;
    const int cur = t0 >> 6;
    { const int u = head + 4 * h2;
#pragma unroll
      for (int i = 0; i < 16; ++i) impw[tok * IMPW + i * 8 + u] = 0.f; }
    WAVE_SYNC();
    bf16x8 kfA[8], kfB[8];
    const rsrc_t rKV = __builtin_amdgcn_make_buffer_rsrc((void*)(p.ws + O_KV), 0, (int)(6 * 8 * KV_SLAB * 2 + 8192), 0x00020000);
    const rsrc_t rKC = __builtin_amdgcn_make_buffer_rsrc((void*)(p.ws + O_KC), 0, (int)(2 * 4096 * 64 * 2), 0x00020000);
    const unsigned koff = (unsigned)(q * 64 + 8 * h2) * 2u, vsoff = (unsigned)(q * SEQ + 8 * h2) * 2u;

    {
        const unsigned Kc = (unsigned)bg * 512u * 64u * 2u;
        const unsigned VcT = (4096u * 64u + (unsigned)bg * 64u * 512u) * 2u;
        const unsigned vcoff = (unsigned)(q * 512 + 8 * h2) * 2u;
        const int tl = t0 + 7;
        const int ncmax = tl >= 31 ? ((tl - 31) >> 4) + 1 : 0;
        const int nblk = (ncmax + 63) >> 6;
        float m = NEG_BIG, l = 0.f;
        f32x16 st[2];
#define CMP_P1(KF, KN, BLK, BN) do { qk_block(st, qf, KF, 0.f); __builtin_amdgcn_sched_barrier(0); load_k(KN, rKC, Kc + (BN) * 8192, koff); \
            bias_mask<0>(st, t - 31 - 16 * ((BLK) * 64 + 4 * h2), true, lut); \
            const float mn = fmaxf(m, tile_max(st)); float sum = 0.f; \
            _Pragma("unroll") for (int sub = 0; sub < 2; ++sub) _Pragma("unroll") for (int r = 0; r < 16; ++r) sum += __builtin_amdgcn_exp2f(st[sub][r] - mn); \
            l = l * __builtin_amdgcn_exp2f(m - mn) + sum; m = mn; } while (0)
        if (nblk > 0) load_k(kfA, rKC, Kc, koff);
#pragma unroll 1
        for (int blk = 0; blk < nblk; blk += 2) {
            const int b1 = blk + 1 < nblk ? blk + 1 : blk;
            CMP_P1(kfA, kfB, blk, b1);
            if (blk + 1 >= nblk) break;
            const int b2 = blk + 2 < nblk ? blk + 2 : blk + 1;
            CMP_P1(kfB, kfA, blk + 1, b2);
        }
#undef CMP_P1
        l = xhalf_sum(l);
        const float invl = l > 0.f ? 1.f / l : 0.f;
#define CMP_P2(KF, KN, BLK, BN) do { bf16x8 vf[8]; load_v(vf, rKC, VcT + (BLK) * 128, vcoff, 512); \
            qk_block(st, qf, KF, 0.f); __builtin_amdgcn_sched_barrier(0); load_k(KN, rKC, Kc + (BN) * 8192, koff); \
            bias_mask<0>(st, t - 31 - 16 * ((BLK) * 64 + 4 * h2), true, lut); \
            _Pragma("unroll") for (int sub = 0; sub < 2; ++sub) _Pragma("unroll") for (int r = 0; r < 16; ++r) st[sub][r] = __builtin_amdgcn_exp2f(st[sub][r] - m) * invl; \
            _Pragma("unroll") for (int sub = 0; sub < 2; ++sub) _Pragma("unroll") for (int a = 0; a < 4; ++a) { \
                const float L_ = quad_sum(st[sub][4 * a + 3]); \
                const float G_ = quad_sum((st[sub][4 * a] + st[sub][4 * a + 1]) + (st[sub][4 * a + 2] + st[sub][4 * a + 3])); \
                const int j_ = (BLK) * 16 + 8 * sub + 2 * a + h2; \
                if (head == 0) { atomicAdd(&impw[tok * IMPW + j_], G_); if (j_ + 1 < 128) atomicAdd(&impw[tok * IMPW + j_ + 1], L_); } } \
            pv_block(O, st, vf); } while (0)
        if (nblk > 0) load_k(kfA, rKC, Kc, koff);
#pragma unroll 1
        for (int blk = 0; blk < nblk; blk += 2) {
            const int b1 = blk + 1 < nblk ? blk + 1 : blk;
            CMP_P2(kfA, kfB, blk, b1);
            if (blk + 1 >= nblk) break;
            const int b2 = blk + 2 < nblk ? blk + 2 : blk + 1;
            CMP_P2(kfB, kfA, blk + 1, b2);
        }
#undef CMP_P2
        const float g0 = gn[0];
#pragma unroll
        for (int dt = 0; dt < 2; ++dt)
#pragma unroll
            for (int a = 0; a < 4; ++a) {
                *(f32x4*)(flp + dt * 32 + a * 8) = (f32x4){g0 * O[dt][4 * a], g0 * O[dt][4 * a + 1], g0 * O[dt][4 * a + 2], g0 * O[dt][4 * a + 3]};
                O[dt][4 * a] = 0.f; O[dt][4 * a + 1] = 0.f; O[dt][4 * a + 2] = 0.f; O[dt][4 * a + 3] = 0.f;
            }
    }
    WAVE_SYNC();

    unsigned long long mlo, mhi;
    if (cur < 16) { mlo = (1ull << (cur + 1)) - 1ull; mhi = 0ull; }
    else {
        const int u = head + 4 * h2;
        float val[16];
#pragma unroll
        for (int i = 0; i < 16; ++i) { const int j = i * 8 + u; val[i] = (j >= 1 && j <= cur - 2) ? impw[tok * IMPW + j] : -1.f; }
        mlo = 1ull; mhi = 0ull;
        if (cur < 64) mlo |= 1ull << cur; else mhi |= 1ull << (cur - 64);
        if (cur - 1 < 64) mlo |= 1ull << (cur - 1); else mhi |= 1ull << (cur - 1 - 64);
#pragma unroll 1
        for (int round = 0; round < 13; ++round) {
            float bs = val[0]; int bj = u;
#pragma unroll
            for (int i = 1; i < 16; ++i) { if (val[i] > bs) { bs = val[i]; bj = i * 8 + u; } }
            { const float os = __uint_as_float(__builtin_amdgcn_update_dpp(0u, __float_as_uint(bs), 0xB1, 0xF, 0xF, true)); const int oj = __builtin_amdgcn_update_dpp(0, bj, 0xB1, 0xF, 0xF, true);
              if (os > bs || (os == bs && oj < bj)) { bs = os; bj = oj; } }
            { const float os = __uint_as_float(__builtin_amdgcn_update_dpp(0u, __float_as_uint(bs), 0x4E, 0xF, 0xF, true)); const int oj = __builtin_amdgcn_update_dpp(0, bj, 0x4E, 0xF, 0xF, true);
              if (os > bs || (os == bs && oj < bj)) { bs = os; bj = oj; } }
            { const float os = __shfl_xor(bs, 32); const int oj = __shfl_xor(bj, 32);
              if (os > bs || (os == bs && oj < bj)) { bs = os; bj = oj; } }
            if (bj < 64) mlo |= 1ull << bj; else mhi |= 1ull << (bj - 64);
#pragma unroll
            for (int i = 0; i < 16; ++i) if (i * 8 + u == bj) val[i] = -2.f;
        }
    }
    unsigned long long ulo = mlo, uhi = mhi;
#pragma unroll
    for (int o = 4; o < 32; o <<= 1) { ulo |= __shfl_xor(ulo, o); uhi |= __shfl_xor(uhi, o); }
    ulo = ((unsigned long long)__builtin_amdgcn_readfirstlane((unsigned)(ulo >> 32)) << 32) | (unsigned)__builtin_amdgcn_readfirstlane((unsigned)ulo);
    uhi = ((unsigned long long)__builtin_amdgcn_readfirstlane((unsigned)(uhi >> 32)) << 32) | (unsigned)__builtin_amdgcn_readfirstlane((unsigned)uhi);

    {
        const unsigned Ks = (unsigned)((2 * 4 + b) * 2 + g) * (unsigned)(KV_SLAB * 2);
        const unsigned VsT = (unsigned)((3 * 4 + b) * 2 + g) * (unsigned)(KV_SLAB * 2);
        float m = NEG_BIG, l = 0.f;
#define POPJ(J) do { if (ulo) { J = __builtin_ctzll(ulo); ulo &= ulo - 1ull; } else if (uhi) { J = 64 + __builtin_ctzll(uhi); uhi &= uhi - 1ull; } else J = -1; } while (0)
#define SEL_STEP(KF, KN, J, JN) do { const bool selme_ = (J) < 64 ? ((mlo >> (J)) & 1ull) : ((mhi >> ((J) - 64)) & 1ull); \
            kv_step<1>(O, m, l, qf, KF, KN, rKV, Ks + (JN) * 8192, koff, VsT + (J) * 128, vsoff, (64 * (J) + 63 + 1024 > t0), t - 64 * (J) - 4 * h2, selme_, b31, lut); } while (0)
        int ja, jb;
        POPJ(ja);
        load_k(kfA, rKV, Ks + ja * 8192, koff);
#pragma unroll 1
        for (;;) {
            POPJ(jb);
            { const int jn = jb >= 0 ? jb : ja; SEL_STEP(kfA, kfB, ja, jn); }
            if (jb < 0) break;
            POPJ(ja);
            { const int jn = ja >= 0 ? ja : jb; SEL_STEP(kfB, kfA, jb, jn); }
            if (ja < 0) break;
        }
#undef SEL_STEP
#undef POPJ
        l = xhalf_sum(l);
        const float sc = l > 0.f ? gn[1] / l : 0.f;
#pragma unroll
        for (int dt = 0; dt < 2; ++dt)
#pragma unroll
            for (int a = 0; a < 4; ++a) {
                f32x4 f = *(const f32x4*)(flp + dt * 32 + a * 8);
                f[0] += sc * O[dt][4 * a]; f[1] += sc * O[dt][4 * a + 1]; f[2] += sc * O[dt][4 * a + 2]; f[3] += sc * O[dt][4 * a + 3];
                *(f32x4*)(flp + dt * 32 + a * 8) = f;
                O[dt][4 * a] = 0.f; O[dt][4 * a + 1] = 0.f; O[dt][4 * a + 2] = 0.f; O[dt][4 * a + 3] = 0.f;
            }
    }
    {
        const unsigned Kw = (unsigned)((4 * 4 + b) * 2 + g) * (unsigned)(KV_SLAB * 2);
        const unsigned VwT = (unsigned)((5 * 4 + b) * 2 + g) * (unsigned)(KV_SLAB * 2);
        float m = NEG_BIG, l = 0.f;
        const int wlo = t0 - 511;
        const int r_begin = (wlo > 0 ? wlo : 0) & ~63;
        const int r_last = t0 + 7;
#define WIN_STEP(KF, KN, R0, RN) kv_step<2>(O, m, l, qf, KF, KN, rKV, Kw + (RN) * 128, koff, VwT + (R0) * 2, vsoff, true, t - (R0) - 4 * h2, true, b31, lut)
        load_k(kfA, rKV, Kw + r_begin * 128, koff);
#pragma unroll 1
        for (int row0 = r_begin; row0 <= r_last; row0 += 128) {
            { const int rn = row0 + 64 <= r_last ? row0 + 64 : row0; WIN_STEP(kfA, kfB, row0, rn); }
            if (row0 + 64 > r_last) break;
            { const int rn = row0 + 128 <= r_last ? row0 + 128 : row0 + 64; WIN_STEP(kfB, kfA, row0 + 64, rn); }
        }
#undef WIN_STEP
        l = xhalf_sum(l);
        const float sc = l > 0.f ? gn[2] / l : 0.f;
        bf16_t* op = (bf16_t*)(p.ws + O_ONSA) + (size_t)token * 512 + (g * 4 + head) * 64 + 4 * h2;
#pragma unroll
        for (int dt = 0; dt < 2; ++dt)
#pragma unroll
            for (int a = 0; a < 4; ++a) {
                const f32x4 f = *(const f32x4*)(flp + dt * 32 + a * 8);
                *(u32x2*)(op + dt * 32 + a * 8) = (u32x2){pk2(f[0] + sc * O[dt][4 * a], f[1] + sc * O[dt][4 * a + 1]), pk2(f[2] + sc * O[dt][4 * a + 2], f[3] + sc * O[dt][4 * a + 3])};
            }
    }
    WAVE_SYNC();
}

__device__ __forceinline__ void phase7(const Params& p, unsigned char* smem) {
    const int tid = threadIdx.x, lane = tid & 63, wid = __builtin_amdgcn_readfirstlane(tid >> 6);
    float* lutall = (float*)smem;
    float* impw = (float*)(smem + 4 * LUTW * 4) + wid * 8 * IMPW;
    float* fl = (float*)(smem + 4 * LUTW * 4 + NWV * 8 * IMPW * 4) + wid * 32 * FLW;
    const int bg = blockIdx.x & 7, g = bg & 1;
    for (int i = tid; i < 4 * 1025; i += NT) { const int head = i / 1025, idx = i % 1025; lutall[head * LUTW + idx] = p.in[2][rel_bucket_dev(idx) * 8 + g * 4 + head] * LOG2E; }
    __syncthreads();
    const int nblk_bg = (gridDim.x - bg + 7) >> 3;
    const int W = nblk_bg * NWV, w = (blockIdx.x >> 3) * NWV + wid;
#pragma unroll 1
    for (int round = 0; ; ++round) {
        const int idx = round * W + ((round & 1) ? (W - 1 - w) : w);
        if (idx >= 1024) break;
        nsa_tile(p, bg, 1023 - idx, lutall, impw, fl, lane);
    }
    __syncthreads();
}

struct EpiNsa { static constexpr bool PERM = true; const bf16_t* SGN; bf16_t* MS5;
    __device__ __forceinline__ void operator()(AccRef acc, const pg8::Unit& u, int wr, int wc, int fr, int fq) const {
#pragma unroll
        for (int ai = 0; ai < 2; ++ai)
#pragma unroll
            for (int m = 0; m < 4; ++m) {
                const int token = u.pm * 256 + ai * 128 + wr * 64 + m * 16 + fr;
#pragma unroll
                for (int bj = 0; bj < 2; ++bj) {
                    const int col = u.pn * 256 + bj * 128 + wc * 32 + 8 * fq;
                    const u32x4 sg = *(const u32x4*)(SGN + (size_t)token * 1024 + col);
                    const u32x4 ms = *(const u32x4*)(MS5 + (size_t)token * 1024 + col);
                    const f32x4 v0 = acc[ai][bj][m][0], v1 = acc[ai][bj][m][1];
                    u32x4 o;
                    o.x = pk2(bflo(ms.x) + bflo(sg.x) * v0[0], bfhi(ms.x) + bfhi(sg.x) * v0[1]); o.y = pk2(bflo(ms.y) + bflo(sg.y) * v0[2], bfhi(ms.y) + bfhi(sg.y) * v0[3]);
                    o.z = pk2(bflo(ms.z) + bflo(sg.z) * v1[0], bfhi(ms.z) + bfhi(sg.z) * v1[1]); o.w = pk2(bflo(ms.w) + bflo(sg.w) * v1[2], bfhi(ms.w) + bfhi(sg.w) * v1[3]);
                    *(u32x4*)(MS5 + (size_t)token * 1024 + col) = o;
                }
            }
    } };
__device__ __forceinline__ void phase8(const Params& p, LAS unsigned char* lds) {
    pg8::DenseOrder S; S.init(p.ws + O_ONSA, p.ws + O_WT_NSA, NTOK, 1024, 512, 512, gridDim.x, blockIdx.x);
    EpiNsa E{(const bf16_t*)(p.ws + O_SGN), (bf16_t*)(p.ws + O_MS5)};
    pg8::gemm_phase<EpiNsa, pg8::DenseOrder, true>(lds, 512, 512, 512, S, E);
}
struct EpiOut { static constexpr bool PERM = false; const float* x; const float* ada; float* Z1;
    __device__ __forceinline__ void operator()(AccRef acc, const pg8::Unit& u, int wr, int wc, int fr, int fq) const {
        const float* ga = ada + (u.pm >> 5) * 6144 + 2048;
#pragma unroll
        for (int ai = 0; ai < 2; ++ai)
#pragma unroll
            for (int m = 0; m < 4; ++m) {
                const int token = u.pm * 256 + ai * 128 + wr * 64 + m * 16 + fr;
#pragma unroll
                for (int bj = 0; bj < 2; ++bj)
#pragma unroll
                    for (int n = 0; n < 2; ++n) {
                        const int col = u.pn * 256 + bj * 128 + wc * 32 + n * 16 + fq * 4;
                        const f32x4 xv = *(const f32x4*)(x + (size_t)token * 1024 + col), gv = *(const f32x4*)(ga + col);
                        *(f32x4*)(Z1 + (size_t)token * 1024 + col) = xv * DN_ALPHA + gv * acc[ai][bj][m][n];
                    }
            }
    } };
__device__ __forceinline__ void phase9(const Params& p, LAS unsigned char* lds) {
    pg8::DenseOrder S; S.init(p.ws + O_MS5, p.ws + O_WT_OUT, NTOK, 1024, 1024, 1024, gridDim.x, blockIdx.x);
    EpiOut E{p.in[0], (const float*)(p.ws + O_ADA), (float*)(p.ws + O_Z1)};
    pg8::gemm_phase<EpiOut, pg8::DenseOrder, true>(lds, 1024, 1024, 1024, S, E);
}

__device__ __forceinline__ void phase10(const Params& p, unsigned char* smem) {
    const int tid = threadIdx.x, lane = tid & 63, wid = tid >> 6;
    float* hs = (float*)smem + wid * 1024;
    const float* lg = p.in[24]; const float* lb = p.in[25]; const float* wr_ = p.in[26]; const float* br_ = p.in[27];
    unsigned* cnt = (unsigned*)(p.ws + O_CNT);
    for (int item = blockIdx.x; item < NTOK / NWV; item += gridDim.x) {
        const int token = item * NWV + wid, b = token >> 13;
        float* zr = (float*)(p.ws + O_Z1) + (size_t)token * 1024;
        const float* ada = (const float*)(p.ws + O_ADA) + b * 6144;
        f32x4 v[4]; float s = 0.f;
#pragma unroll
        for (int j = 0; j < 4; ++j) { v[j] = *(const f32x4*)(zr + j * 256 + lane * 4); s += (v[j][0] + v[j][1]) + (v[j][2] + v[j][3]); }
        const float mean = wave_sum(s) * (1.f / 1024.f); float q = 0.f;
#pragma unroll
        for (int j = 0; j < 4; ++j) { v[j] = v[j] - mean; q += (v[j][0] * v[j][0] + v[j][1] * v[j][1]) + (v[j][2] * v[j][2] + v[j][3] * v[j][3]); }
        const float rstd = rsqrtf(wave_sum(q) * (1.f / 1024.f) + LN_EPS);
        bf16_t* h2 = (bf16_t*)(p.ws + O_H2) + (size_t)token * 1024;
#pragma unroll
        for (int j = 0; j < 4; ++j) {
            const int c = j * 256 + lane * 4;
            const f32x4 x1 = v[j] * rstd * *(const f32x4*)(lg + c) + *(const f32x4*)(lb + c);
            *(f32x4*)(zr + c) = x1;
            const f32x4 hv = x1 * (*(const f32x4*)(ada + 4096 + c) + 1.f) + *(const f32x4*)(ada + 3072 + c);
            *(f32x4*)(hs + c) = hv;
            *(u32x2*)(h2 + c) = (u32x2){pk2(hv[0], hv[1]), pk2(hv[2], hv[3])};
        }
        WAVE_SYNC();
        const int e = lane & 31, kh = lane >> 5;
        float a = 0.f;
#pragma unroll 8
        for (int k = kh * 512; k < kh * 512 + 512; ++k) a += hs[k] * wr_[k * 32 + e];
        a += __shfl_xor(a, 32);
        a += br_[e];
        float val = a; int te[4]; float tv[4];
#pragma unroll
        for (int r = 0; r < 4; ++r) {
            float bs = val; int bj = e;
#pragma unroll
            for (int o = 1; o < 32; o <<= 1) { const float os = __shfl_xor(bs, o); const int oj = __shfl_xor(bj, o); if (os > bs || (os == bs && oj < bj)) { bs = os; bj = oj; } }
            te[r] = bj; tv[r] = bs;
            if (e == bj) val = -INFINITY;
        }
        const float e0 = 1.f, e1 = __expf(tv[1] - tv[0]), e2 = __expf(tv[2] - tv[0]), e3 = __expf(tv[3] - tv[0]);
        const float inv = 1.f / (e0 + e1 + e2 + e3);
        if (lane < 4) {
            const int ee = lane == 0 ? te[0] : (lane == 1 ? te[1] : (lane == 2 ? te[2] : te[3]));
            const float gg = (lane == 0 ? e0 : (lane == 1 ? e1 : (lane == 2 ? e2 : e3))) * inv;
            const unsigned pos = atomicAdd(cnt + ee, 1u);
            ((int*)(p.ws + O_TOPE))[token * 4 + lane] = ee;
            ((unsigned*)(p.ws + O_TOPP))[token * 4 + lane] = pos;
            ((float*)(p.ws + O_TOPG))[token * 4 + lane] = gg;
        }
        WAVE_SYNC();
    }
}

__device__ __forceinline__ void load_offsets(const Params& p, int* offs  , int* toff  ) {
    if (threadIdx.x == 0) {
        const unsigned* cnt = (const unsigned*)(p.ws + O_CNT);
        int a = 0, t = 0;
        for (int e = 0; e < 32; ++e) { offs[e] = a; toff[e] = t; const int c = (int)cnt[e]; a += c; t += (c + 255) >> 8; }
        offs[32] = a; toff[32] = t;
    }
    __syncthreads();
}
__device__ __forceinline__ void phase11(const Params& p, unsigned char* smem) {
    int* offs = (int*)(smem + LDS_TAB); int* toff = offs + 40;
    load_offsets(p, offs, toff);
    const int* tope = (const int*)(p.ws + O_TOPE); const unsigned* topp = (const unsigned*)(p.ws + O_TOPP); const float* topg = (const float*)(p.ws + O_TOPG);
    float* rowgate = (float*)(p.ws + O_ROWGATE); int* tokrow = (int*)(p.ws + O_TOKROW); int* rowtok = (int*)(p.ws + O_ROWTOK);
    for (int i = blockIdx.x * NT + threadIdx.x; i < NROWS; i += gridDim.x * NT) {
        const int R = offs[tope[i]] + (int)topp[i];
        rowgate[R] = topg[i]; tokrow[i] = R; rowtok[R] = i >> 2;
    }
    __syncthreads();
}

struct MoeOrder {
    const int* offs; const int* toff; const char* A; const char* B; const int* rowtok; size_t bsB; int nN, G, c;
    __device__ __forceinline__ bool next(int i, pg8::Unit& u) const {
        const long L = (long)i * G + c; if (L >= (long)toff[32] * nN) return false;
        const int tile = (int)L / nN, pn = (int)L % nN;
        int e = 0;
#pragma unroll 1
        while (toff[e + 1] <= tile) ++e;
        const int r0 = offs[e] + (tile - toff[e]) * 256;
        u.pm = r0; u.pn = pn; u.e = e; u.nvalid = offs[e + 1] - r0;
        if (rowtok) { u.A = A; u.rows = rowtok + r0; const int rm = NROWS - 1 - r0; u.rmax = rm < 255 ? rm : 255; }
        else { u.A = A + (size_t)r0 * 2048; u.rows = nullptr; u.rmax = 255; }
        u.B = B + (size_t)e * bsB + (size_t)pn * 256 * 2048; return true;
    }
};
struct EpiGU { static constexpr bool PERM = true; const float* bgu; bf16_t* ACT;
    __device__ __forceinline__ void operator()(AccRef acc, const pg8::Unit& u, int wr, int wc, int fr, int fq) const {
        const int cv = u.pn * 128 + wc * 32 + 8 * fq;
        const float* bb = bgu + (size_t)u.e * 2048;
        const f32x4 bg0 = *(const f32x4*)(bb + cv), bg1 = *(const f32x4*)(bb + cv + 4), bu0 = *(const f32x4*)(bb + 1024 + cv), bu1 = *(const f32x4*)(bb + 1024 + cv + 4);
#pragma unroll
        for (int ai = 0; ai < 2; ++ai)
#pragma unroll
            for (int m = 0; m < 4; ++m) {
                const int lr = ai * 128 + wr * 64 + m * 16 + fr;
                if (lr < u.nvalid) {
                    const f32x4 ga0 = acc[ai][0][m][0] + bg0, ga1 = acc[ai][0][m][1] + bg1, ua0 = acc[ai][1][m][0] + bu0, ua1 = acc[ai][1][m][1] + bu1;
                    float o[8];
#pragma unroll
                    for (int j = 0; j < 4; ++j) {
                        const float gt0 = fminf(ga0[j], 7.f), up0 = fminf(fmaxf(ua0[j], -7.f), 7.f); o[j] = (up0 + 1.f) * gt0 * sigmoidf_(1.702f * gt0);
                        const float gt1 = fminf(ga1[j], 7.f), up1 = fminf(fmaxf(ua1[j], -7.f), 7.f); o[4 + j] = (up1 + 1.f) * gt1 * sigmoidf_(1.702f * gt1);
                    }
                    *(u32x4*)(ACT + (size_t)(u.pm + lr) * 1024 + cv) = (u32x4){pk2(o[0], o[1]), pk2(o[2], o[3]), pk2(o[4], o[5]), pk2(o[6], o[7])};
                }
            }
    } };
__device__ __forceinline__ void phase12(const Params& p, unsigned char* smem, LAS unsigned char* lds) {
    int* offs = (int*)(smem + LDS_TAB); int* toff = offs + 40;
    load_offsets(p, offs, toff);
    MoeOrder S{offs, toff, (const char*)(p.ws + O_H2), (const char*)(p.ws + O_WT_GU), (const int*)(p.ws + O_ROWTOK), (size_t)2048 * 2048, 8, (int)gridDim.x, (int)blockIdx.x};
    EpiGU E{p.in[29], (bf16_t*)(p.ws + O_ACT)};
    pg8::gemm_phase<EpiGU, MoeOrder, true>(lds, 1024, 1024, 1024, S, E);
    __syncthreads();
}
struct EpiDn { static constexpr bool PERM = true; const float* bd; const float* rowgate; bf16_t* YK;
    __device__ __forceinline__ void operator()(AccRef acc, const pg8::Unit& u, int wr, int wc, int fr, int fq) const {
        const float* bb = bd + (size_t)u.e * 1024;
#pragma unroll
        for (int ai = 0; ai < 2; ++ai)
#pragma unroll
            for (int m = 0; m < 4; ++m) {
                const int lr = ai * 128 + wr * 64 + m * 16 + fr;
                if (lr < u.nvalid) {
                    const float gw = rowgate[u.pm + lr];
#pragma unroll
                    for (int bj = 0; bj < 2; ++bj) {
                        const int col = u.pn * 256 + bj * 128 + wc * 32 + 8 * fq;
                        const f32x4 v0 = (acc[ai][bj][m][0] + *(const f32x4*)(bb + col)) * gw, v1 = (acc[ai][bj][m][1] + *(const f32x4*)(bb + col + 4)) * gw;
                        *(u32x4*)(YK + (size_t)(u.pm + lr) * 1024 + col) = (u32x4){pk2(v0[0], v0[1]), pk2(v0[2], v0[3]), pk2(v1[0], v1[1]), pk2(v1[2], v1[3])};
                    }
                }
            }
    } };
__device__ __forceinline__ void phase13(const Params& p, unsigned char* smem, LAS unsigned char* lds) {
    int* offs = (int*)(smem + LDS_TAB); int* toff = offs + 40;
    load_offsets(p, offs, toff);
    MoeOrder S{offs, toff, (const char*)(p.ws + O_ACT), (const char*)(p.ws + O_WT_DN), nullptr, (size_t)1024 * 2048, 4, (int)gridDim.x, (int)blockIdx.x};
    EpiDn E{p.in[31], (const float*)(p.ws + O_ROWGATE), (bf16_t*)(p.ws + O_YK)};
    pg8::gemm_phase<EpiDn, MoeOrder, true>(lds, 1024, 1024, 1024, S, E);
    __syncthreads();
}

__device__ __forceinline__ void phase14(const Params& p, unsigned char*) {
    const int tid = threadIdx.x, lane = tid & 63, wid = tid >> 6;
    const float* lg = p.in[32]; const float* lb = p.in[33];
    const int* tokrow = (const int*)(p.ws + O_TOKROW);
    const bf16_t* YK = (const bf16_t*)(p.ws + O_YK);
    for (int item = blockIdx.x; item < NTOK / NWV; item += gridDim.x) {
        const int token = item * NWV + wid, b = token >> 13;
        const float* x1 = (const float*)(p.ws + O_Z1) + (size_t)token * 1024;
        const float* gf = (const float*)(p.ws + O_ADA) + b * 6144 + 5120;
        const int r0 = tokrow[token * 4 + 0], r1 = tokrow[token * 4 + 1], r2 = tokrow[token * 4 + 2], r3 = tokrow[token * 4 + 3];
        f32x4 v[4]; float s = 0.f;
#pragma unroll
        for (int j = 0; j < 4; ++j) {
            const int c = j * 256 + lane * 4;
            const u32x2 a0 = *(const u32x2*)(YK + (size_t)r0 * 1024 + c), a1 = *(const u32x2*)(YK + (size_t)r1 * 1024 + c), a2 = *(const u32x2*)(YK + (size_t)r2 * 1024 + c), a3 = *(const u32x2*)(YK + (size_t)r3 * 1024 + c);
            f32x4 y;
            y[0] = (bflo(a0.x) + bflo(a1.x)) + (bflo(a2.x) + bflo(a3.x)); y[1] = (bfhi(a0.x) + bfhi(a1.x)) + (bfhi(a2.x) + bfhi(a3.x));
            y[2] = (bflo(a0.y) + bflo(a1.y)) + (bflo(a2.y) + bflo(a3.y)); y[3] = (bfhi(a0.y) + bfhi(a1.y)) + (bfhi(a2.y) + bfhi(a3.y));
            v[j] = *(const f32x4*)(x1 + c) * DN_ALPHA + *(const f32x4*)(gf + c) * y;
            s += (v[j][0] + v[j][1]) + (v[j][2] + v[j][3]);
        }
        const float mean = wave_sum(s) * (1.f / 1024.f); float q = 0.f;
#pragma unroll
        for (int j = 0; j < 4; ++j) { v[j] = v[j] - mean; q += (v[j][0] * v[j][0] + v[j][1] * v[j][1]) + (v[j][2] * v[j][2] + v[j][3] * v[j][3]); }
        const float rstd = rsqrtf(wave_sum(q) * (1.f / 1024.f) + LN_EPS);
#pragma unroll
        for (int j = 0; j < 4; ++j) { const int c = j * 256 + lane * 4; *(f32x4*)(p.out + (size_t)token * 1024 + c) = v[j] * rstd * *(const f32x4*)(lg + c) + *(const f32x4*)(lb + c); }
    }
}

template <bool COOP>
__global__ void __launch_bounds__(NT, 2) fwd_kernel(Params p) {
    extern __shared__ __attribute__((aligned(16))) unsigned char smem[];
    LAS unsigned char* lds = (LAS unsigned char*)smem;
    const int lo = p.ph_lo, hi = p.ph_hi;
#define RUN_PHASE(k, call) if (((PH_MASK >> (k)) & 1) && lo <= (k) && (k) < hi) { _Pragma("unroll 1") for (int rep_ = 0; rep_ < 1 + ((REPEAT_MASK >> (k)) & 1); ++rep_) { if (rep_) { if (COOP) cg::this_grid().sync(); } call; } } if (COOP) { if (lo <= (k) && (k) + 1 < hi) cg::this_grid().sync(); }
    RUN_PHASE(0, phase0(p, smem))
    RUN_PHASE(1, phase1(p, smem))
    RUN_PHASE(2, phase2(p, lds))
    RUN_PHASE(3, phase3(p, lds))
    RUN_PHASE(4, phase4(p, smem))
    RUN_PHASE(5, phase5(p, lds))
    RUN_PHASE(6, phase6(p, lds))
    RUN_PHASE(7, phase7(p, smem))
    RUN_PHASE(8, phase8(p, lds))
    RUN_PHASE(9, phase9(p, lds))
    RUN_PHASE(10, phase10(p, smem))
    RUN_PHASE(11, phase11(p, smem))
    RUN_PHASE(12, phase12(p, smem, lds))
    RUN_PHASE(13, phase13(p, smem, lds))
    RUN_PHASE(14, phase14(p, smem))
#undef RUN_PHASE
}

extern "C" void kernel_launch(void* const* d_in, const int* in_sizes, int n_in, void* d_out, int out_size, void* d_ws, size_t ws_size, hipStream_t stream) {
    static int grid = 0;
    if (grid == 0) {
        if (n_in != 34 || out_size != NTOK * DM || ws_size < WS_NEED) { fprintf(stderr, "kernel_launch: unexpected problem (n_in %d, out %d, ws %zu need %zu)\n", n_in, out_size, ws_size, (size_t)WS_NEED); grid = -1; return; }
        int dev = 0, cus = 0, per_cu = 0;
        (void)hipGetDevice(&dev);
        (void)hipDeviceGetAttribute(&cus, hipDeviceAttributeMultiprocessorCount, dev);
#if ONE_LAUNCH
        (void)hipFuncSetAttribute((const void*)fwd_kernel<true>, hipFuncAttributeMaxDynamicSharedMemorySize, LDS_BYTES);
        (void)hipOccupancyMaxActiveBlocksPerMultiprocessor(&per_cu, fwd_kernel<true>, NT, LDS_BYTES);
#else
        (void)hipFuncSetAttribute((const void*)fwd_kernel<false>, hipFuncAttributeMaxDynamicSharedMemorySize, LDS_BYTES);
        (void)hipOccupancyMaxActiveBlocksPerMultiprocessor(&per_cu, fwd_kernel<false>, NT, LDS_BYTES);
#endif
        if (per_cu < 1) { fprintf(stderr, "kernel_launch: occupancy query reports %d blocks per CU\n", per_cu); per_cu = 1; }
        grid = cus * per_cu;
        fprintf(stderr, "kernel_launch: grid %d (%d CUs x %d)\n", grid, cus, per_cu);
    }
    if (grid < 0) return;
    Params p{};
    for (int i = 0; i < 34; ++i) p.in[i] = (const float*)d_in[i];
    p.out = (float*)d_out; p.ws = (unsigned char*)d_ws;
#if ONE_LAUNCH
    p.ph_lo = 0; p.ph_hi = NPHASE;
    void* args[] = {&p};
    hipError_t e = hipLaunchCooperativeKernel((void*)fwd_kernel<true>, dim3(grid), dim3(NT), args, LDS_BYTES, stream);
    if (e != hipSuccess) fprintf(stderr, "cooperative launch failed: %s (grid %d)\n", hipGetErrorString(e), grid);
#else
    for (int ph = 0; ph < NPHASE; ++ph) {
        p.ph_lo = ph; p.ph_hi = ph + 1;
        hipLaunchKernelGGL(fwd_kernel<false>, dim3(grid), dim3(NT), LDS_BYTES, stream, p);
    }
#endif
}
```

```cpp
#include <hip/hip_runtime.h>
#include <hip/hip_cooperative_groups.h>
#include <cstdio>
#include <cstdint>
namespace cg = cooperative_groups;

#ifndef PH_MASK
#define PH_MASK 0xFFFFF
#endif
#ifndef REPEAT_MASK
#define REPEAT_MASK 0
#endif
#ifndef ONE_LAUNCH
#define ONE_LAUNCH 1
#endif

#define LAS __attribute__((address_space(3)))
typedef unsigned short bf16_t;
typedef short bf16x8 __attribute__((ext_vector_type(8)));
typedef float f32x4 __attribute__((ext_vector_type(4)));
typedef float f32x2 __attribute__((ext_vector_type(2)));
typedef unsigned u32x4 __attribute__((ext_vector_type(4)));
typedef unsigned u32x2 __attribute__((ext_vector_type(2)));
typedef __bf16 bf16x2_t __attribute__((ext_vector_type(2)));

constexpr int NB = 4, SEQ = 8192, NTOK = NB * SEQ, DM = 1024;
constexpr int NIN_PAD = 4096;
constexpr int NEXP = 32, TOPK = 4, NROWS = NTOK * TOPK;
constexpr int S5L = 32;
constexpr int NCHUNK = SEQ / S5L;
constexpr int UROW = 640;
constexpr float DN_ALPHA = 1.189207115002721f;
constexpr float LN_EPS = 1e-5f;
constexpr float LOG2E = 1.4426950408889634f;
constexpr float QSCALE = 0.125f * 1.4426950408889634f;
constexpr int NT = 512;
constexpr int NWV = NT / 64;

constexpr size_t al256(size_t x) { return (x + 255) & ~(size_t)255; }
constexpr size_t O_ADA = 0;
constexpr size_t O_CNT = O_ADA + al256(4 * 6144 * 4);
constexpr size_t O_LAML = O_CNT + 1024;
constexpr size_t O_BIAS1 = O_LAML + al256(32 * 64 * 2 * 4);
constexpr size_t O_WT_IN = O_BIAS1 + al256(2 * 8 * 128 * 4);
constexpr size_t O_WT_GLU = O_WT_IN + al256((size_t)NIN_PAD * 1024 * 2);
constexpr size_t O_WT_NSA = O_WT_GLU + al256((size_t)2048 * 512 * 2);
constexpr size_t O_WT_OUT = O_WT_NSA + al256((size_t)1024 * 512 * 2);
constexpr size_t O_WT_C1 = O_WT_OUT + al256((size_t)1024 * 1024 * 2);
constexpr size_t O_W1T = O_WT_C1 + al256((size_t)2 * 256 * 2048 * 2);
constexpr size_t O_TW2 = O_W1T + al256((size_t)32 * 256 * 512 * 2);
constexpr size_t O_WT_GU = O_TW2 + al256((size_t)32 * 512 * 640 * 2);
constexpr size_t O_WT_DN = O_WT_GU + al256((size_t)32 * 2048 * 1024 * 2);
constexpr size_t O_H2 = O_WT_DN + al256((size_t)32 * 1024 * 1024 * 2);
constexpr size_t O_Z1 = O_H2 + al256((size_t)NTOK * 1024 * 2);
constexpr size_t O_TOPE = O_Z1 + al256((size_t)NTOK * 1024 * 4);
constexpr size_t O_TOPP = O_TOPE + al256((size_t)NROWS * 4);
constexpr size_t O_TOPG = O_TOPP + al256((size_t)NROWS * 4);
constexpr size_t O_ROWTOK = O_TOPG + al256((size_t)NROWS * 4);
constexpr size_t O_ROWGATE = O_ROWTOK + al256((size_t)(NROWS + 256) * 4);
constexpr size_t O_TOKROW = O_ROWGATE + al256((size_t)(NROWS + 256) * 4);
constexpr size_t O_OVL = O_TOKROW + al256((size_t)NROWS * 4);
constexpr size_t O_U = O_OVL;
constexpr size_t O_E = O_U + al256((size_t)32 * 1024 * UROW * 2);
constexpr size_t O_YS = O_E + al256((size_t)32 * 1024 * 128 * 4);
constexpr size_t O_Q = O_YS + al256((size_t)NTOK * 512 * 2);
constexpr size_t O_KV = O_Q + al256((size_t)NTOK * 512 * 2);
constexpr size_t KV_SLAB = (size_t)SEQ * 64;
constexpr size_t O_SG5 = O_KV + al256((size_t)6 * 8 * KV_SLAB * 2 + 8192);
constexpr size_t O_SGN = O_SG5 + al256((size_t)NTOK * 1024 * 2);
constexpr size_t O_GN = O_SGN + al256((size_t)NTOK * 1024 * 2);
constexpr size_t O_MS5 = O_GN + al256((size_t)NTOK * 24 * 4);
constexpr size_t O_ONSA = O_MS5 + al256((size_t)NTOK * 1024 * 2);
constexpr size_t O_HC = O_ONSA + al256((size_t)NTOK * 512 * 2);
constexpr size_t O_KC = O_HC + al256((size_t)2 * 4096 * 128 * 2);
constexpr size_t O_XN = O_KC + al256((size_t)2 * 4096 * 64 * 2);
constexpr size_t O_END1 = O_XN + al256((size_t)NTOK * 1024 * 2);
constexpr size_t O_ACT = O_OVL;
constexpr size_t O_YK = O_ACT + al256((size_t)(NROWS + 256) * 1024 * 2);
constexpr size_t O_END2 = O_YK + al256((size_t)(NROWS + 256) * 1024 * 2);
constexpr size_t WS_NEED = O_END1 > O_END2 ? O_END1 : O_END2;
static_assert(WS_NEED <= (size_t)1073741824, "workspace map exceeds 1 GiB");

constexpr int LDS_BYTES = 147456;
constexpr int LDS_TAB = 131072;
constexpr int NPHASE = 15;

struct Params {
    const float* in[34];
    float* out;
    unsigned char* ws;
    int ph_lo, ph_hi;
};

__device__ __forceinline__ unsigned pk2(float lo, float hi) { f32x2 v = {lo, hi}; bf16x2_t b = __builtin_convertvector(v, bf16x2_t); return __builtin_bit_cast(unsigned, b); }
__device__ __forceinline__ bf16_t f2bf(float f) { return (bf16_t)(pk2(f, 0.f) & 0xffffu); }
__device__ __forceinline__ float bf2f(bf16_t h) { return __uint_as_float(((unsigned)h) << 16); }
__device__ __forceinline__ float bflo(unsigned w) { return __uint_as_float(w << 16); }
__device__ __forceinline__ float bfhi(unsigned w) { return __uint_as_float(w & 0xffff0000u); }
__device__ __forceinline__ float sigmoidf_(float x) { return 1.f / (1.f + __expf(-x)); }
__device__ __forceinline__ float gelu_tanh(float x) { const float u = 0.7978845608028654f * (x + 0.044715f * x * x * x); const float e = __expf(2.f * u); return 0.5f * x * (2.f - 2.f / (e + 1.f)); }
__device__ __forceinline__ float wave_sum(float v) {
#pragma unroll
    for (int o = 1; o < 64; o <<= 1) v += __shfl_xor(v, o);
    return v;
}
#define WAVE_SYNC() do { __builtin_amdgcn_fence(__ATOMIC_RELEASE, "wavefront"); __builtin_amdgcn_wave_barrier(); __builtin_amdgcn_fence(__ATOMIC_ACQUIRE, "wavefront"); } while (0)

namespace pg8 {
constexpr int BM = 256, BK = 64, HALF = 128, HTB = HALF * BK * 2, STAGE_BYTES = 8 * HTB;
__device__ __forceinline__ int lds_byte(int r, int c) { const int st = (r >> 4) * 2 + (c >> 5), rr = r & 15, cc = c & 31, ob = rr * 64 + cc * 2; return st * 1024 + (ob ^ (((ob >> 9) & 1) << 5)); }
__device__ __forceinline__ void stage_rc(int b, int& R, int& C) { const int st = b / 1024, sb = b % 1024, swz = sb ^ (((sb >> 9) & 1) << 5); R = (st >> 1) * 16 + swz / 64; C = (st & 1) * 32 + (swz % 64) / 2; }
__device__ __forceinline__ int perm32(int rho) { const int n = rho >> 4, i = rho & 15; return 8 * (i >> 2) + 4 * n + (i & 3); }
struct Unit { const char* A; const char* B; const int* rows; int pm, pn, e, nvalid, rmax; };

template <class Epi, class Sched, bool ALIGN_EPI>
__device__ __forceinline__ void gemm_phase(LAS unsigned char* lds, const int K, const int lda, const int ldb, const Sched& S, const Epi& E) {
    const int tid = threadIdx.x, wid = __builtin_amdgcn_readfirstlane(tid >> 6), lane = tid & 63, wr = wid >> 2, wc = wid & 3, fr = lane & 15, fq = lane >> 4;
    const int nt = K / BK;
    unsigned voffB[2]; int Ra[2], Ca[2];
#pragma unroll
    for (int i = 0; i < 2; ++i) { int R, C; stage_rc(tid * 16 + i * 8192, R, C); const int Rb = Epi::PERM ? ((R & ~31) + perm32(R & 31)) : R;
        Ra[i] = R; Ca[i] = C; voffB[i] = (unsigned)(Rb * ldb + C) * 2u; }
    unsigned offC[2][2], offN[2][2];
#define PG8_SETOFF(o, u) do { _Pragma("unroll") for (int h_ = 0; h_ < 2; ++h_) _Pragma("unroll") for (int i_ = 0; i_ < 2; ++i_) { \
        if ((u).rows) { int ix_ = h_ * HALF + Ra[i_]; ix_ = ix_ < (u).rmax ? ix_ : (u).rmax; o[h_][i_] = (unsigned)(u).rows[ix_] * (unsigned)(lda * 2) + (unsigned)Ca[i_] * 2u; } \
        else o[h_][i_] = (unsigned)((h_ * HALF + Ra[i_]) * lda + Ca[i_]) * 2u; } } while (0)
    const size_t kstep = (size_t)(BK * 2);
    const size_t hstepB = (size_t)HALF * ldb * 2;
    const unsigned ldsw = (unsigned)wid * 1024u;
    const int aoff = lds_byte(wr * 64 + fr, fq * 8), boff = lds_byte(wc * 32 + fr, fq * 8);
#define PG8_SA(b, h) (((b) * 2 + (h)) * HTB)
#define PG8_SB(b, h) ((4 + (b) * 2 + (h)) * HTB)
#define PG8_STAGE(bufoff, gbase, voff) do { _Pragma("unroll") for (int _i = 0; _i < 2; ++_i) \
        __builtin_amdgcn_global_load_lds((const unsigned*)((const char*)(gbase) + (voff)[_i]), (LAS unsigned*)(lds + (bufoff) + ldsw + _i * 8192), 16, 0, 0); } while (0)
#define PG8_LDA(dst, b, h) do { _Pragma("unroll") for (int m = 0; m < 4; ++m) _Pragma("unroll") for (int k = 0; k < 2; ++k) dst[m][k] = *(const LAS bf16x8*)(lds + PG8_SA(b, h) + aoff + m * 2048 + k * 1024); } while (0)
#define PG8_LDB(dst, b, h) do { _Pragma("unroll") for (int n = 0; n < 2; ++n) _Pragma("unroll") for (int k = 0; k < 2; ++k) dst[n][k] = *(const LAS bf16x8*)(lds + PG8_SB(b, h) + boff + n * 2048 + k * 1024); } while (0)
#define PG8_MMA(ai, bj, At, Bt) do { __builtin_amdgcn_s_setprio(1); _Pragma("unroll") for (int m = 0; m < 4; ++m) _Pragma("unroll") for (int n = 0; n < 2; ++n) _Pragma("unroll") for (int k = 0; k < 2; ++k) \
        acc[ai][bj][m][n] = __builtin_amdgcn_mfma_f32_16x16x32_bf16(Bt[n][k], At[m][k], acc[ai][bj][m][n], 0, 0, 0); __builtin_amdgcn_s_setprio(0); } while (0)
#define PG8_WAIT_V(n) asm volatile("s_waitcnt vmcnt(" #n ")" ::: "memory")
#define PG8_WAIT_L(n) asm volatile("s_waitcnt lgkmcnt(" #n ")" ::: "memory")
#define PG8_BAR __builtin_amdgcn_s_barrier()
#define PG8_SCHED __builtin_amdgcn_sched_barrier(0)
    Unit cur, nxt; int ui = 0;
    if (!S.next(0, cur)) return;
    f32x4 acc[2][2][4][2];
#pragma unroll
    for (int a = 0; a < 2; ++a)
#pragma unroll
        for (int b = 0; b < 2; ++b)
#pragma unroll
            for (int m = 0; m < 4; ++m)
#pragma unroll
                for (int n = 0; n < 2; ++n) acc[a][b][m][n] = (f32x4){0.f, 0.f, 0.f, 0.f};
    bf16x8 At[4][2], B0[2][2], B1[2][2];
    const char* cA = cur.A; const char* cB = cur.B;
    PG8_SETOFF(offC, cur);
    PG8_STAGE(PG8_SB(0, 0), cB, voffB); PG8_STAGE(PG8_SB(0, 1), cB + hstepB, voffB); PG8_STAGE(PG8_SA(0, 0), cA, offC[0]); PG8_STAGE(PG8_SA(0, 1), cA, offC[1]);
    if (wr == 1) PG8_BAR;
    PG8_WAIT_V(2); PG8_BAR;
    PG8_STAGE(PG8_SB(1, 0), cB + kstep, voffB); PG8_STAGE(PG8_SA(1, 0), cA + kstep, offC[0]); PG8_STAGE(PG8_SB(1, 1), cB + hstepB + kstep, voffB);
    PG8_WAIT_V(6); PG8_BAR;
    for (;;) {
        const bool has_next = S.next(ui + 1, nxt);
        const char* nA = has_next ? nxt.A : cA; const char* nB = has_next ? nxt.B : cB;
        if (has_next) { PG8_SETOFF(offN, nxt); } else { offN[0][0] = offC[0][0]; offN[0][1] = offC[0][1]; offN[1][0] = offC[1][0]; offN[1][1] = offC[1][1]; }
        for (int t = 0; t < nt; t += 2) {
            const bool last = (t == nt - 2);
            const char* a1 = cA + (size_t)(t + 1) * kstep;
            const char* a2 = last ? nA : cA + (size_t)(t + 2) * kstep; const char* b2 = last ? nB : cB + (size_t)(t + 2) * kstep;
            const char* a3 = a2 + kstep; const char* b3 = b2 + kstep;
            unsigned o2[2][2];
            o2[0][0] = last ? offN[0][0] : offC[0][0]; o2[0][1] = last ? offN[0][1] : offC[0][1]; o2[1][0] = last ? offN[1][0] : offC[1][0]; o2[1][1] = last ? offN[1][1] : offC[1][1];
            PG8_LDB(B0, 0, 0); PG8_LDB(B1, 0, 1); PG8_SCHED; PG8_LDA(At, 0, 0); PG8_STAGE(PG8_SA(1, 1), a1, offC[1]);
            PG8_WAIT_V(8); PG8_WAIT_L(0); PG8_BAR; PG8_MMA(0, 0, At, B0); PG8_MMA(0, 1, At, B1); PG8_BAR; PG8_SCHED;
            PG8_LDA(At, 0, 1); PG8_STAGE(PG8_SB(0, 0), b2, voffB); PG8_STAGE(PG8_SB(0, 1), b2 + hstepB, voffB); PG8_STAGE(PG8_SA(0, 0), a2, o2[0]);
            PG8_WAIT_V(8); PG8_WAIT_L(0); PG8_BAR; PG8_MMA(1, 0, At, B0); PG8_MMA(1, 1, At, B1); PG8_BAR; PG8_SCHED;
            PG8_LDB(B0, 1, 0); PG8_LDB(B1, 1, 1); PG8_SCHED; PG8_LDA(At, 1, 0); PG8_STAGE(PG8_SA(0, 1), a2, o2[1]);
            PG8_WAIT_V(8); PG8_WAIT_L(0); PG8_BAR; PG8_MMA(0, 0, At, B0); PG8_MMA(0, 1, At, B1); PG8_BAR; PG8_SCHED;
            PG8_LDA(At, 1, 1); PG8_STAGE(PG8_SB(1, 0), b3, voffB); PG8_STAGE(PG8_SB(1, 1), b3 + hstepB, voffB); PG8_STAGE(PG8_SA(1, 0), a3, o2[0]);
            PG8_WAIT_V(8); PG8_WAIT_L(0); PG8_BAR; PG8_MMA(1, 0, At, B0); PG8_MMA(1, 1, At, B1); PG8_BAR; PG8_SCHED;
        }
        if constexpr (ALIGN_EPI) { if (wr == 0) PG8_BAR; }
        E(acc, cur, wr, wc, fr, fq);
        if (!has_next) break;
#pragma unroll
        for (int a = 0; a < 2; ++a)
#pragma unroll
            for (int b = 0; b < 2; ++b)
#pragma unroll
                for (int m = 0; m < 4; ++m)
#pragma unroll
                    for (int n = 0; n < 2; ++n) acc[a][b][m][n] = (f32x4){0.f, 0.f, 0.f, 0.f};
        cur = nxt; cA = nA; cB = nB; ++ui;
        offC[0][0] = offN[0][0]; offC[0][1] = offN[0][1]; offC[1][0] = offN[1][0]; offC[1][1] = offN[1][1];
        if constexpr (ALIGN_EPI) { if (wr == 1) PG8_BAR; }
    }
    PG8_WAIT_V(0);
    if constexpr (!ALIGN_EPI) { if (wr == 0) PG8_BAR; }
    PG8_BAR;
#undef PG8_SETOFF
#undef PG8_SA
#undef PG8_SB
#undef PG8_STAGE
#undef PG8_LDA
#undef PG8_LDB
#undef PG8_MMA
#undef PG8_WAIT_V
#undef PG8_WAIT_L
#undef PG8_BAR
#undef PG8_SCHED
}

struct DenseOrder {
    const char* A; const char* B; size_t tstepA, tstepB; int nM, nN, nwg, G, c;
    __device__ __forceinline__ void init(const void* A_, const void* B_, int M, int N, int lda, int ldb, int G_, int c_) {
        A = (const char*)A_; B = (const char*)B_; tstepA = (size_t)BM * lda * 2; tstepB = (size_t)BM * ldb * 2; nM = M / BM; nN = N / BM; nwg = nM * nN; G = G_; c = c_; }
    __device__ __forceinline__ bool next(int i, Unit& u) const {
        const long L = (long)i * G + c; if (L >= nwg) return false;
        int wgid = (int)L; { const int q = nwg / 8, r = nwg % 8, xcd = wgid % 8, off = wgid / 8; wgid = (xcd < r ? xcd * (q + 1) : r * (q + 1) + (xcd - r) * q) + off; }
        const int nig = 8 * nN, gid = wgid / nig, fm = gid * 8, gsz = (nM - fm) < 8 ? (nM - fm) : 8;
        u.pm = fm + ((wgid % nig) % gsz); u.pn = (wgid % nig) / gsz; u.e = 0; u.nvalid = 256; u.rows = nullptr; u.rmax = 255;
        u.A = A + (size_t)u.pm * tstepA; u.B = B + (size_t)u.pn * tstepB; return true;
    }
};
}

__device__ __forceinline__ int map_in(int n) { return n < 1792 ? n : (n < 3840 ? n + 24 : (n < 3864 ? 1792 + (n - 3840) : -1)); }
__device__ __forceinline__ int map_il128(int n) { const int b = n >> 7; return (b & 1) * 1024 + (b >> 1) * 128 + (n & 127); }

struct TrJob { const float* W; bf16_t* Wt; int K, Nsrc, map, kt, nt; };
constexpr int TR_IN = 16 * 16, TR_GLU = 8 * 8, TR_NSA = 8 * 4, TR_OUT = 16 * 4, TR_C1 = 2 * 32, TR_GU = 32 * 16 * 8, TR_DN = 32 * 16 * 4;
constexpr int TR_ITEMS = TR_IN + TR_GLU + TR_NSA + TR_OUT + TR_C1 + TR_GU + TR_DN;
__device__ __forceinline__ void tr_job(const Params& p, int r, TrJob& j) {
    unsigned char* ws = p.ws;
    if (r < TR_IN) { j = TrJob{p.in[5], (bf16_t*)(ws + O_WT_IN), 1024, 3864, 1, r / 16, r % 16}; return; } r -= TR_IN;
    if (r < TR_GLU) { j = TrJob{p.in[14], (bf16_t*)(ws + O_WT_GLU), 512, 2048, 2, r / 8, r % 8}; return; } r -= TR_GLU;
    if (r < TR_NSA) { j = TrJob{p.in[22], (bf16_t*)(ws + O_WT_NSA), 512, 1024, 0, r / 4, r % 4}; return; } r -= TR_NSA;
    if (r < TR_OUT) { j = TrJob{p.in[23], (bf16_t*)(ws + O_WT_OUT), 1024, 1024, 0, r / 4, r % 4}; return; } r -= TR_OUT;
    if (r < TR_C1) { const int kv = r / 32; j = TrJob{p.in[kv ? 20 : 17], (bf16_t*)(ws + O_WT_C1) + (size_t)kv * 256 * 2048, 2048, 128, 3, r % 32, 0}; return; } r -= TR_C1;
    if (r < TR_GU) { const int e = r / 128, q = r % 128; j = TrJob{p.in[28] + (size_t)e * 1024 * 2048, (bf16_t*)(ws + O_WT_GU) + (size_t)e * 2048 * 1024, 1024, 2048, 2, q / 8, q % 8}; return; } r -= TR_GU;
    { const int e = r / 64, q = r % 64; j = TrJob{p.in[30] + (size_t)e * 1024 * 1024, (bf16_t*)(ws + O_WT_DN) + (size_t)e * 1024 * 1024, 1024, 1024, 0, q / 4, q % 4}; }
}
__device__ __forceinline__ void tr_load(const TrJob& j, f32x4 (&v)[8], int tid) {
    const int n4 = tid & 63, kq = tid >> 6, nd = j.nt * 256 + 4 * n4;
    const int src = j.map == 0 ? nd : (j.map == 1 ? map_in(nd) : (j.map == 2 ? map_il128(nd) : (nd < 128 ? nd : -1)));
    const float* base = j.W + (size_t)(j.kt * 64 + kq) * j.Nsrc + (src >= 0 ? src : 0);
#pragma unroll
    for (int i = 0; i < 8; ++i) v[i] = (src >= 0) ? *(const f32x4*)(base + (size_t)i * 8 * j.Nsrc) : (f32x4){0.f, 0.f, 0.f, 0.f};
}
__device__ __forceinline__ void convert_weights(const Params& p, unsigned char* smem, int lo, int hi, unsigned* queue) {
    float* t = (float*)smem;
    int* nxt_slot = (int*)(smem + 64 * 260 * 4);
    const int tid = threadIdx.x;
    int it;
    if (queue) { if (tid == 0) *nxt_slot = lo + (int)atomicAdd(queue, 1u); __syncthreads(); it = *nxt_slot; __syncthreads(); }
    else it = lo + blockIdx.x;
    if (it >= hi) return;
    TrJob j; tr_job(p, it, j);
    f32x4 v[8];
    tr_load(j, v, tid);
    for (;;) {
        { const int n4 = tid & 63, kq = tid >> 6;
#pragma unroll
          for (int i = 0; i < 8; ++i) *(f32x4*)(t + (i * 8 + kq) * 260 + 4 * n4) = v[i]; }
        if (queue && tid == 0) *nxt_slot = lo + (int)atomicAdd(queue, 1u);
        __syncthreads();
        const TrJob cj = j;
        const int nit = queue ? *nxt_slot : it + (int)gridDim.x;
        const bool more = nit < hi;
        if (more) { tr_job(p, nit, j); tr_load(j, v, tid); }
        { const int n = tid & 255, kh = (tid >> 8) * 32;
          bf16_t* d = cj.Wt + (size_t)(cj.nt * 256 + n) * cj.K + cj.kt * 64 + kh;
#pragma unroll
          for (int q = 0; q < 4; ++q) {
              const float* c = t + (kh + 8 * q) * 260 + n;
              u32x4 o;
              o.x = pk2(c[0], c[260]); o.y = pk2(c[2 * 260], c[3 * 260]); o.z = pk2(c[4 * 260], c[5 * 260]); o.w = pk2(c[6 * 260], c[7 * 260]);
              *(u32x4*)(d + 8 * q) = o;
          } }
        __syncthreads();
        if (!more) break;
        it = nit;
    }
}

__device__ __forceinline__ void phase0(const Params& p, unsigned char* smem) {
    unsigned char* ws = p.ws;
    const int tid = threadIdx.x;
    convert_weights(p, smem, 0, TR_ITEMS - TR_GU - TR_DN, nullptr);
    constexpr int I_ADA = 96;
    constexpr int I_S5 = 32 * 33;
    constexpr int I_MISC = 17;
    constexpr int NITEM = I_ADA + I_S5 + I_MISC;
    for (int item = blockIdx.x; item < NITEM; item += gridDim.x) {
        int r = item;
        if (r < I_ADA) {
            const float* c = p.in[1]; const float* w = p.in[3]; const float* bb = p.in[4];
            const int wid = tid >> 6, lane = tid & 63, j = r * 64 + lane;
            float a0 = 0.f, a1 = 0.f, a2 = 0.f, a3 = 0.f;
#pragma unroll 4
            for (int k = wid * 128; k < wid * 128 + 128; ++k) {
                const float wv = w[(size_t)k * 6144 + j];
                const float c0 = c[k], c1 = c[1024 + k], c2 = c[2048 + k], c3 = c[3072 + k];
                a0 += c0 * sigmoidf_(c0) * wv; a1 += c1 * sigmoidf_(c1) * wv; a2 += c2 * sigmoidf_(c2) * wv; a3 += c3 * sigmoidf_(c3) * wv;
            }
            float* red = (float*)smem;
            red[(wid * 4 + 0) * 64 + lane] = a0; red[(wid * 4 + 1) * 64 + lane] = a1; red[(wid * 4 + 2) * 64 + lane] = a2; red[(wid * 4 + 3) * 64 + lane] = a3;
            __syncthreads();
            if (tid < 256) { const int b = tid >> 6; float s = 0.f;
#pragma unroll
              for (int w8 = 0; w8 < 8; ++w8) s += red[(w8 * 4 + b) * 64 + lane];
              ((float*)(ws + O_ADA))[b * 6144 + j] = s + bb[j]; }
            __syncthreads();
            continue;
        }
        r -= I_ADA;
        if (r < I_S5) {
            const int g = r / 33, dl = r % 33;
            f32x2* pw = (f32x2*)smem;
            f32x2* bbv = pw + 64;
            f32x2* ccv = bbv + 1024;
            const float dt = expf(p.in[8][g]);
            if (tid < 64) {
                const int n = tid; const double re = p.in[6][g * 64 + n], im = p.in[7][g * 64 + n];
                const double mag = exp(re * (double)dt * dl), ang = im * (double)dt * dl;
                double sn, cs; sincos(ang, &sn, &cs);
                pw[n] = (f32x2){(float)(mag * cs), (float)(mag * sn)};
                if (dl == 32) { ((f32x2*)(ws + O_LAML))[g * 64 + n] = pw[n]; }
            }
            for (int e = tid; e < 1024; e += NT) {
                const int n = e >> 4, q = e & 15;
                const double re = p.in[6][g * 64 + n], im = p.in[7][g * 64 + n];
                const double mag = exp(re * (double)dt), ang = im * (double)dt;
                double sn, cs; sincos(ang, &sn, &cs);
                const double lr = mag * cs - 1.0, li = mag * sn;
                const double den = re * re + im * im;
                const double fr_ = (lr * re + li * im) / den, fi_ = (li * re - lr * im) / den;
                const double br = p.in[9][(g * 64 + n) * 16 + q], bi = p.in[10][(g * 64 + n) * 16 + q];
                bbv[e] = (f32x2){(float)(fr_ * br - fi_ * bi), (float)(fr_ * bi + fi_ * br)};
            }
            for (int e = tid; e < 1024; e += NT) { ccv[e] = (f32x2){p.in[11][g * 1024 + e], p.in[12][g * 1024 + e]}; }
            __syncthreads();
            bf16_t* TW2 = (bf16_t*)(ws + O_TW2) + (size_t)g * 512 * UROW;
            bf16_t* W1T = (bf16_t*)(ws + O_W1T) + (size_t)g * 256 * 512;
            if (dl < 32) {
                if (tid < 256) {
                    const int pp = tid >> 4, q = tid & 15;
                    float acc = 0.f;
                    for (int n = 0; n < 64; ++n) {
                        const f32x2 cv = ccv[pp * 64 + n], pv = pw[n], bv = bbv[n * 16 + q];
                        const float xr = cv.x * pv.x - cv.y * pv.y, xi = cv.x * pv.y + cv.y * pv.x;
                        acc += xr * bv.x - xi * bv.y;
                    }
                    if (dl == 0 && pp == q) acc += p.in[13][g * 16 + pp];
                    const bf16_t kb = f2bf(acc);
                    for (int tau = dl; tau < 32; ++tau) { const int s = tau - dl; TW2[(size_t)(tau * 16 + pp) * UROW + s * 16 + q] = kb; }
                    if (dl >= 1) for (int s = dl; s < 32; ++s) { const int tau = s - dl; TW2[(size_t)(tau * 16 + pp) * UROW + s * 16 + q] = 0; }
                }
                const int s = 31 - dl;
                for (int e = tid; e < 2048; e += NT) {
                    const int c = e >> 4, qq = e & 15, n = c & 63, ri = c >> 6;
                    const f32x2 pv = pw[n], bv = bbv[n * 16 + qq];
                    const float zr = pv.x * bv.x - pv.y * bv.y, zi = pv.x * bv.y + pv.y * bv.x;
                    W1T[(size_t)c * 512 + s * 16 + qq] = f2bf(ri ? zi : zr);
                }
            } else {
                u32x4* z = (u32x4*)(W1T + (size_t)128 * 512);
                for (int e = tid; e < 128 * 512 / 8; e += NT) z[e] = (u32x4){0u, 0u, 0u, 0u};
            }
            if (dl >= 1) {
                const int tau = dl - 1;
                for (int e = tid; e < 2048; e += NT) {
                    const int pp = e >> 7, c = e & 127, n = c & 63, ri = c >> 6;
                    const f32x2 cv = ccv[pp * 64 + n], pv = pw[n];
                    const float xr = cv.x * pv.x - cv.y * pv.y, xi = cv.x * pv.y + cv.y * pv.x;
                    TW2[(size_t)(tau * 16 + pp) * UROW + 512 + c] = f2bf(ri ? -xi : xr);
                }
            }
            __syncthreads();
            continue;
        }
        r -= I_S5;
        if (r < 16) {
            const int kv = r >> 3, part = r & 7, j = tid & 127, qtr = tid >> 7;
            const float* pos = p.in[kv ? 19 : 16]; const float* w1 = p.in[kv ? 20 : 17];
            float a = 0.f;
            const int i0 = part * 256 + qtr * 64;
            for (int i = i0; i < i0 + 64; ++i) a += pos[i] * w1[(size_t)i * 128 + j];
            float* red = (float*)smem;
            red[tid] = a;
            __syncthreads();
            if (tid < 128) ((float*)(ws + O_BIAS1))[(kv * 8 + part) * 128 + tid] = (red[tid] + red[tid + 128]) + (red[tid + 256] + red[tid + 384]);
            __syncthreads();
            continue;
        }
        if (tid < 64) ((unsigned*)(ws + O_CNT))[tid] = 0u;
    }
}

__device__ __forceinline__ void phase1(const Params& p, unsigned char*) {
    const float* x = p.in[0];
    bf16_t* xn = (bf16_t*)(p.ws + O_XN);
    for (size_t i = (size_t)blockIdx.x * NT + threadIdx.x; i < (size_t)NTOK * 128; i += (size_t)gridDim.x * NT) {
        const int token = (int)(i >> 7), k = (int)(i & 127) * 8, b = token >> 13;
        const float* ada = (const float*)(p.ws + O_ADA) + b * 6144;
        const f32x4 x0 = *(const f32x4*)(x + (size_t)token * 1024 + k), x1 = *(const f32x4*)(x + (size_t)token * 1024 + k + 4);
        const f32x4 s0 = *(const f32x4*)(ada + 1024 + k), s1 = *(const f32x4*)(ada + 1024 + k + 4);
        const f32x4 h0 = *(const f32x4*)(ada + k), h1 = *(const f32x4*)(ada + k + 4);
        u32x4 o;
        o.x = pk2(x0[0] * (1.f + s0[0]) + h0[0], x0[1] * (1.f + s0[1]) + h0[1]); o.y = pk2(x0[2] * (1.f + s0[2]) + h0[2], x0[3] * (1.f + s0[3]) + h0[3]);
        o.z = pk2(x1[0] * (1.f + s1[0]) + h1[0], x1[1] * (1.f + s1[1]) + h1[1]); o.w = pk2(x1[2] * (1.f + s1[2]) + h1[2], x1[3] * (1.f + s1[3]) + h1[3]);
        *(u32x4*)(xn + (size_t)token * 1024 + k) = o;
    }
}

typedef const f32x4 (&AccRef)[2][2][4][2];
struct EpiIn {
    static constexpr bool PERM = true;
    unsigned char* ws;
    __device__ __forceinline__ void operator()(AccRef acc, const pg8::Unit& u, int wr, int wc, int fr, int fq) const {
        const int pn = u.pn;
#pragma unroll
        for (int ai = 0; ai < 2; ++ai)
#pragma unroll
            for (int m = 0; m < 4; ++m) {
                const int token = u.pm * 256 + ai * 128 + wr * 64 + m * 16 + fr;
#pragma unroll
                for (int bj = 0; bj < 2; ++bj) {
                    const int col = pn * 256 + bj * 128 + wc * 32 + 8 * fq;
                    const f32x4 v0 = acc[ai][bj][m][0], v1 = acc[ai][bj][m][1];
                    if (pn < 2) {
                        const int g = col >> 4, q = col & 15;
                        bf16_t* d = (bf16_t*)(ws + O_U) + ((size_t)(g * 1024 + (token >> 5)) * UROW + (token & 31) * 16 + q);
                        *(u32x4*)d = (u32x4){pk2(v0[0], v0[1]), pk2(v0[2], v0[3]), pk2(v1[0], v1[1]), pk2(v1[2], v1[3])};
                    } else if (pn < 4) {
                        bf16_t* d = (bf16_t*)(ws + O_Q) + (size_t)token * 512 + (col - 512);
                        *(u32x4*)d = (u32x4){pk2(v0[0] * QSCALE, v0[1] * QSCALE), pk2(v0[2] * QSCALE, v0[3] * QSCALE), pk2(v1[0] * QSCALE, v1[1] * QSCALE), pk2(v1[2] * QSCALE, v1[3] * QSCALE)};
                    } else if (pn < 7) {
                        const int c = col - 1024, j6 = c >> 7, g = (c >> 6) & 1, dd = c & 63, b = token >> 13, s = token & 8191;
                        bf16_t* slab = (bf16_t*)(ws + O_KV) + (size_t)((j6 * 4 + b) * 2 + g) * KV_SLAB;
                        if (j6 == 3 || j6 == 5) {
                            const int p64 = s & 63, p16 = p64 & 15, slot = (p16 & 3) | ((p16 & 4) << 1) | ((p16 & 8) >> 1);
                            bf16_t* blkp = slab + (size_t)(s >> 6) * 4096 + (((p64 >> 5) * 2 + ((p64 >> 4) & 1)) * 64 + (slot >> 3) * 32) * 8 + (slot & 7);
#pragma unroll
                            for (int j = 0; j < 4; ++j) { const int d0 = dd + j, d1 = dd + 4 + j;
                                blkp[((d0 >> 5) * 4 * 64 + (d0 & 31)) * 8] = f2bf(v0[j]); blkp[((d1 >> 5) * 4 * 64 + (d1 & 31)) * 8] = f2bf(v1[j]); }
                        } else if (j6 == 2 || j6 == 4) {
                            bf16_t* d = slab + (size_t)((s >> 5) * 4 + (dd >> 4)) * 512 + (((dd >> 3) & 1) * 32 + (s & 31)) * 8;
                            *(u32x4*)d = (u32x4){pk2(v0[0], v0[1]), pk2(v0[2], v0[3]), pk2(v1[0], v1[1]), pk2(v1[2], v1[3])};
                        } else {
                            *(u32x4*)(slab + (size_t)s * 64 + dd) = (u32x4){pk2(v0[0], v0[1]), pk2(v0[2], v0[3]), pk2(v1[0], v1[1]), pk2(v1[2], v1[3])};
                        }
                    } else if (pn < 15) {
                        bf16_t* d = (pn < 11 ? (bf16_t*)(ws + O_SG5) + (size_t)token * 1024 + (col - 1792) : (bf16_t*)(ws + O_SGN) + (size_t)token * 1024 + (col - 2816));
                        *(u32x4*)d = (u32x4){pk2(sigmoidf_(v0[0]), sigmoidf_(v0[1])), pk2(sigmoidf_(v0[2]), sigmoidf_(v0[3])), pk2(sigmoidf_(v1[0]), sigmoidf_(v1[1])), pk2(sigmoidf_(v1[2]), sigmoidf_(v1[3]))};
                    } else {
                        const int c = col - 3840;
                        if (c < 24) { float* d = (float*)(ws + O_GN) + (size_t)token * 24 + c;
                            *(f32x4*)d = (f32x4){sigmoidf_(v0[0]), sigmoidf_(v0[1]), sigmoidf_(v0[2]), sigmoidf_(v0[3])};
                            *(f32x4*)(d + 4) = (f32x4){sigmoidf_(v1[0]), sigmoidf_(v1[1]), sigmoidf_(v1[2]), sigmoidf_(v1[3])}; }
                    }
                }
            }
    }
};
__device__ __forceinline__ void phase2(const Params& p, LAS unsigned char* lds) {
    pg8::DenseOrder S; S.init(p.ws + O_XN, p.ws + O_WT_IN, NTOK, NIN_PAD, 1024, 1024, gridDim.x, blockIdx.x);
    EpiIn E{p.ws};
    pg8::gemm_phase<EpiIn, pg8::DenseOrder, true>(lds, 1024, 1024, 1024, S, E);
}

struct BatchOrder {
    const char* A; const char* B; size_t bsA, bsB, tstepA, tstepB; int nM, nN, nunits, G, c;
    __device__ __forceinline__ bool next(int i, pg8::Unit& u) const {
        const long L = (long)i * G + c; if (L >= nunits) return false;
        const int per = nM * nN, bt = (int)L / per, rem = (int)L % per;
        u.pm = rem / nN; u.pn = rem % nN; u.e = bt; u.nvalid = 256; u.rows = nullptr; u.rmax = 255;
        u.A = A + (size_t)bt * bsA + (size_t)u.pm * tstepA; u.B = B + (size_t)bt * bsB + (size_t)u.pn * tstepB; return true;
    }
};
struct EpiE { static constexpr bool PERM = false; float* E;
    __device__ __forceinline__ void operator()(AccRef acc, const pg8::Unit& u, int wr, int wc, int fr, int fq) const {
#pragma unroll
        for (int ai = 0; ai < 2; ++ai)
#pragma unroll
            for (int m = 0; m < 4; ++m) {
                const int r = u.pm * 256 + ai * 128 + wr * 64 + m * 16 + fr;
#pragma unroll
                for (int n = 0; n < 2; ++n) *(f32x4*)(E + ((size_t)u.e * 1024 + r) * 128 + wc * 32 + n * 16 + fq * 4) = acc[ai][0][m][n];
            }
    } };
struct EpiCmp { static constexpr bool PERM = true; const float* b1p; bf16_t* HC;
    __device__ __forceinline__ void operator()(AccRef acc, const pg8::Unit& u, int wr, int wc, int fr, int fq) const {
        const int col = wc * 32 + 8 * fq;
        f32x4 b0 = (f32x4){0.f, 0.f, 0.f, 0.f}, b1 = b0;
#pragma unroll
        for (int part = 0; part < 8; ++part) { b0 += *(const f32x4*)(b1p + (u.e * 8 + part) * 128 + col); b1 += *(const f32x4*)(b1p + (u.e * 8 + part) * 128 + col + 4); }
#pragma unroll
        for (int ai = 0; ai < 2; ++ai)
#pragma unroll
            for (int m = 0; m < 4; ++m) {
                const int R = u.pm * 256 + ai * 128 + wr * 64 + m * 16 + fr;
                const f32x4 v0 = acc[ai][0][m][0] + b0, v1 = acc[ai][0][m][1] + b1;
                *(u32x4*)(HC + ((size_t)u.e * 4096 + R) * 128 + col) = (u32x4){pk2(gelu_tanh(v0[0]), gelu_tanh(v0[1])), pk2(gelu_tanh(v0[2]), gelu_tanh(v0[3])), pk2(gelu_tanh(v1[0]), gelu_tanh(v1[1])), pk2(gelu_tanh(v1[2]), gelu_tanh(v1[3]))};
            }
    } };
__device__ __forceinline__ void phase3(const Params& p, LAS unsigned char* lds) {
    const int G = gridDim.x;
    {
        BatchOrder S{(const char*)(p.ws + O_U), (const char*)(p.ws + O_W1T), (size_t)1024 * UROW * 2, (size_t)256 * 512 * 2, (size_t)256 * UROW * 2, 0, 4, 1, 128, G, (int)blockIdx.x};
        EpiE E{(float*)(p.ws + O_E)};
        pg8::gemm_phase<EpiE, BatchOrder, false>(lds, 512, UROW, 512, S, E);
    }
    {
        BatchOrder S{(const char*)(p.ws + O_KV), (const char*)(p.ws + O_WT_C1), (size_t)8 * KV_SLAB * 2, (size_t)256 * 2048 * 2, (size_t)256 * 1024 * 2, 0, 16, 1, 32, G, (int)((blockIdx.x + G - 128 % G) % G)};
        EpiCmp E{(const float*)(p.ws + O_BIAS1), (bf16_t*)(p.ws + O_HC)};
        pg8::gemm_phase<EpiCmp, BatchOrder, false>(lds, 2048, 1024, 2048, S, E);
    }
}
__device__ __forceinline__ void phase4(const Params& p, unsigned char* smem) {
    const int tid = threadIdx.x;
    for (int item = blockIdx.x; item < 16 + 512; item += gridDim.x) {
        if (item < 16) {
            f32x2* seg = (f32x2*)smem;
#pragma unroll 1
            for (int half = 0; half < 8; ++half) {
                const int n = tid & 63, sg = tid >> 6, bg = item * 8 + half, b = bg >> 5, g = bg & 31;
                const f32x2 lm = ((const f32x2*)(p.ws + O_LAML))[g * 64 + n];
                const float* E = (const float*)(p.ws + O_E) + (size_t)(g * 1024 + b * 256 + sg * 32) * 128;
                bf16_t* U = (bf16_t*)(p.ws + O_U) + (size_t)(g * 1024 + b * 256 + sg * 32) * UROW + 512;
                float er[32], ei[32];
#pragma unroll
                for (int c = 0; c < 32; ++c) { er[c] = E[(size_t)c * 128 + n]; ei[c] = E[(size_t)c * 128 + 64 + n]; }
                float hr = 0.f, hi = 0.f;
#pragma unroll
                for (int c = 0; c < 32; ++c) { const float nr = lm.x * hr - lm.y * hi + er[c], ni = lm.x * hi + lm.y * hr + ei[c]; hr = nr; hi = ni; }
                seg[sg * 64 + n] = (f32x2){hr, hi};
                float pr = lm.x, pi = lm.y;
#pragma unroll
                for (int q = 0; q < 5; ++q) { const float nr = pr * pr - pi * pi, ni = 2.f * pr * pi; pr = nr; pi = ni; }
                __syncthreads();
                float sr = 0.f, si = 0.f;
                for (int k = 0; k < sg; ++k) { const f32x2 a = seg[k * 64 + n]; const float nr = pr * sr - pi * si + a.x, ni = pr * si + pi * sr + a.y; sr = nr; si = ni; }
                hr = sr; hi = si;
#pragma unroll
                for (int c = 0; c < 32; ++c) {
                    U[(size_t)c * UROW + n] = f2bf(hr); U[(size_t)c * UROW + 64 + n] = f2bf(hi);
                    const float nr = lm.x * hr - lm.y * hi + er[c], ni = lm.x * hi + lm.y * hr + ei[c]; hr = nr; hi = ni;
                }
                __syncthreads();
            }
        } else {
#pragma unroll 1
            for (int rep = 0; rep < 2; ++rep) {
                const int o = ((item - 16) * 2 + rep) * NT + tid, d = o & 63, R = (o >> 6) & 4095, kv = o >> 18;
                const bf16_t* h = (const bf16_t*)(p.ws + O_HC) + ((size_t)kv * 4096 + R) * 128;
                const float* w2 = p.in[kv ? 21 : 18];
                float a = 0.f;
#pragma unroll 8
                for (int j = 0; j < 128; ++j) a += bf2f(h[j]) * w2[j * 64 + d];
                const int bgi = R >> 9, n = R & 511;
                if (kv == 0) ((bf16_t*)(p.ws + O_KC))[(size_t)bgi * 512 * 64 + (size_t)((n >> 5) * 4 + (d >> 4)) * 512 + (((d >> 3) & 1) * 32 + (n & 31)) * 8 + (d & 7)] = f2bf(a);
                else { const int p64 = n & 63, p16 = p64 & 15, slot = (p16 & 3) | ((p16 & 4) << 1) | ((p16 & 8) >> 1);
                       ((bf16_t*)(p.ws + O_KC))[(size_t)4096 * 64 + (size_t)bgi * 64 * 512 + (size_t)(n >> 6) * 4096 + ((((d >> 5) * 2 + (p64 >> 5)) * 2 + ((p64 >> 4) & 1)) * 64 + (slot >> 3) * 32 + (d & 31)) * 8 + (slot & 7)] = f2bf(a); }
            }
        }
    }
    __syncthreads();
    convert_weights(p, smem, TR_ITEMS - TR_GU - TR_DN, TR_ITEMS, (unsigned*)(p.ws + O_CNT) + 40);
}
struct EpiY { static constexpr bool PERM = true; bf16_t* YS;
    __device__ __forceinline__ void operator()(AccRef acc, const pg8::Unit& u, int wr, int wc, int fr, int fq) const {
#pragma unroll
        for (int ai = 0; ai < 2; ++ai)
#pragma unroll
            for (int m = 0; m < 4; ++m) {
                const int r = u.pm * 256 + ai * 128 + wr * 64 + m * 16 + fr;
                const int tok0 = (r >> 8) * SEQ + (r & 255) * S5L;
#pragma unroll
                for (int bj = 0; bj < 2; ++bj) {
                    const int col = u.pn * 256 + bj * 128 + wc * 32 + 8 * fq, tau = col >> 4, pp = col & 15;
                    const f32x4 v0 = acc[ai][bj][m][0], v1 = acc[ai][bj][m][1];
                    *(u32x4*)(YS + (size_t)(tok0 + tau) * 512 + u.e * 16 + pp) = (u32x4){pk2(gelu_tanh(v0[0]), gelu_tanh(v0[1])), pk2(gelu_tanh(v0[2]), gelu_tanh(v0[3])), pk2(gelu_tanh(v1[0]), gelu_tanh(v1[1])), pk2(gelu_tanh(v1[2]), gelu_tanh(v1[3]))};
                }
            }
    } };
__device__ __forceinline__ void phase5(const Params& p, LAS unsigned char* lds) {
    BatchOrder S{(const char*)(p.ws + O_U), (const char*)(p.ws + O_TW2), (size_t)1024 * UROW * 2, (size_t)512 * UROW * 2, (size_t)256 * UROW * 2, (size_t)256 * UROW * 2, 4, 2, 256, (int)gridDim.x, (int)blockIdx.x};
    EpiY E{(bf16_t*)(p.ws + O_YS)};
    pg8::gemm_phase<EpiY, BatchOrder, false>(lds, UROW, UROW, UROW, S, E);
}
struct EpiGlu { static constexpr bool PERM = true; const float* bglu; const bf16_t* SG5; bf16_t* MS5;
    __device__ __forceinline__ void operator()(AccRef acc, const pg8::Unit& u, int wr, int wc, int fr, int fq) const {
        const int cv = u.pn * 128 + wc * 32 + 8 * fq;
        const f32x4 bv0 = *(const f32x4*)(bglu + cv), bv1 = *(const f32x4*)(bglu + cv + 4), bg0 = *(const f32x4*)(bglu + 1024 + cv), bg1 = *(const f32x4*)(bglu + 1024 + cv + 4);
#pragma unroll
        for (int ai = 0; ai < 2; ++ai)
#pragma unroll
            for (int m = 0; m < 4; ++m) {
                const int token = u.pm * 256 + ai * 128 + wr * 64 + m * 16 + fr;
                const u32x4 sg = *(const u32x4*)(SG5 + (size_t)token * 1024 + cv);
                const f32x4 va0 = acc[ai][0][m][0] + bv0, va1 = acc[ai][0][m][1] + bv1, ga0 = acc[ai][1][m][0] + bg0, ga1 = acc[ai][1][m][1] + bg1;
                u32x4 o;
                o.x = pk2(va0[0] * sigmoidf_(ga0[0]) * bflo(sg.x), va0[1] * sigmoidf_(ga0[1]) * bfhi(sg.x)); o.y = pk2(va0[2] * sigmoidf_(ga0[2]) * bflo(sg.y), va0[3] * sigmoidf_(ga0[3]) * bfhi(sg.y));
                o.z = pk2(va1[0] * sigmoidf_(ga1[0]) * bflo(sg.z), va1[1] * sigmoidf_(ga1[1]) * bfhi(sg.z)); o.w = pk2(va1[2] * sigmoidf_(ga1[2]) * bflo(sg.w), va1[3] * sigmoidf_(ga1[3]) * bfhi(sg.w));
                *(u32x4*)(MS5 + (size_t)token * 1024 + cv) = o;
            }
    } };
__device__ __forceinline__ void phase6(const Params& p, LAS unsigned char* lds) {
    pg8::DenseOrder S; S.init(p.ws + O_YS, p.ws + O_WT_GLU, NTOK, 2048, 512, 512, gridDim.x, blockIdx.x);
    EpiGlu E{p.in[15], (const bf16_t*)(p.ws + O_SG5), (bf16_t*)(p.ws + O_MS5)};
    pg8::gemm_phase<EpiGlu, pg8::DenseOrder, true>(lds, 512, 512, 512, S, E);
}
typedef float f32x16 __attribute__((ext_vector_type(16)));
__device__ __forceinline__ int rel_bucket_dev(int dist) {
    const int n = dist > 0 ? dist : 0;
    if (n < 16) return n;
    const int l = (int)(__log2f((float)n * 0.0625f) * 2.6666667f);
    const int v = 16 + l;
    return v < 31 ? v : 31;
}
__device__ __forceinline__ float xhalf_max(float v) { auto rr = __builtin_amdgcn_permlane32_swap(__float_as_uint(v), __float_as_uint(v), false, false); return fmaxf(__uint_as_float(rr[0]), __uint_as_float(rr[1])); }
__device__ __forceinline__ float xhalf_sum(float v) { auto rr = __builtin_amdgcn_permlane32_swap(__float_as_uint(v), __float_as_uint(v), false, false); return __uint_as_float(rr[0]) + __uint_as_float(rr[1]); }
__device__ __forceinline__ float quad_sum(float v) {
    v += __uint_as_float(__builtin_amdgcn_update_dpp(0u, __float_as_uint(v), 0xB1, 0xF, 0xF, true));
    v += __uint_as_float(__builtin_amdgcn_update_dpp(0u, __float_as_uint(v), 0x4E, 0xF, 0xF, true));
    return v;
}
constexpr int LSW = 1168;
constexpr int LWW = 656;
constexpr float RESC_THR = 6.f;
constexpr int IMPW = 132;
constexpr float NEG_BIG = -1e30f;

typedef int v4i_t __attribute__((ext_vector_type(4)));
typedef __amdgpu_buffer_rsrc_t rsrc_t;
__device__ __forceinline__ bf16x8 bload16(rsrc_t r, unsigned voff, unsigned soff) { return __builtin_bit_cast(bf16x8, __builtin_amdgcn_raw_buffer_load_b128(r, (int)voff, (int)soff, 0)); }
__device__ __forceinline__ void load_k(bf16x8 (&kf)[8], rsrc_t r, unsigned soff, unsigned voff) {
#pragma unroll
    for (int i = 0; i < 8; ++i) kf[i] = bload16(r, voff, soff + i * 1024);
}
__device__ __forceinline__ void load_v(bf16x8 (&vf)[8], rsrc_t r, unsigned soff, unsigned voff) {
#pragma unroll
    for (int i = 0; i < 8; ++i) vf[i] = bload16(r, voff, soff + i * 1024);
}
__device__ __forceinline__ void qk_block(f32x16 (&st)[2], const bf16x8 (&qf)[4], const bf16x8 (&kf)[8], float cinit) {
#pragma unroll
    for (int sub = 0; sub < 2; ++sub) {
        f32x16 acc;
#pragma unroll
        for (int r = 0; r < 16; ++r) acc[r] = cinit;
#pragma unroll
        for (int s = 0; s < 4; ++s) acc = __builtin_amdgcn_mfma_f32_32x32x16_bf16(kf[sub * 4 + s], qf[s], acc, 0, 0, 0);
        st[sub] = acc;
    }
}
__device__ __forceinline__ void bias_lut(f32x16 (&st)[2], const float* p) {
#pragma unroll
    for (int sub = 0; sub < 2; ++sub)
#pragma unroll
        for (int r = 0; r < 16; ++r) st[sub][r] += p[59 - (32 * sub + (r & 3) + 8 * (r >> 2))];
}
__device__ __forceinline__ void bias_mask_cmp(f32x16 (&st)[2], int dist0, const float* lutS) {
#pragma unroll
    for (int sub = 0; sub < 2; ++sub) {
        float bias[16];
#pragma unroll
        for (int r = 0; r < 16; ++r) {
            const int dist = dist0 - 16 * (32 * sub + (r & 3) + 8 * (r >> 2));
            const int idx = dist < 0 ? 0 : (dist > 1024 ? 1024 : dist);
            bias[r] = lutS[64 + idx];
        }
#pragma unroll
        for (int r = 0; r < 16; ++r) {
            const int dist = dist0 - 16 * (32 * sub + (r & 3) + 8 * (r >> 2));
            const float v = st[sub][r] + bias[r];
            st[sub][r] = dist >= 0 ? v : -INFINITY;
        }
    }
}
__device__ __forceinline__ float tile_max(const f32x16 (&st)[2]) {
    float a = __builtin_fmaxf(__builtin_fmaxf(st[0][0], st[0][1]), st[1][0]), b2 = __builtin_fmaxf(__builtin_fmaxf(st[0][2], st[0][3]), st[1][1]);
    a = __builtin_fmaxf(__builtin_fmaxf(a, st[1][2]), st[1][3]);
#pragma unroll
    for (int r = 4; r < 16; r += 4) {
        a = __builtin_fmaxf(__builtin_fmaxf(a, st[0][r]), st[0][r + 1]); b2 = __builtin_fmaxf(__builtin_fmaxf(b2, st[0][r + 2]), st[0][r + 3]);
        a = __builtin_fmaxf(__builtin_fmaxf(a, st[1][r]), st[1][r + 1]); b2 = __builtin_fmaxf(__builtin_fmaxf(b2, st[1][r + 2]), st[1][r + 3]);
    }
    return xhalf_max(__builtin_fmaxf(a, b2));
}
__device__ __forceinline__ void pv_block(f32x16 (&O)[2], const f32x16 (&st)[2], const bf16x8 (&vf)[8]) {
    bf16x8 pf[2][2];
#pragma unroll
    for (int sub = 0; sub < 2; ++sub)
#pragma unroll
        for (int s2 = 0; s2 < 2; ++s2) {
            u32x4 w;
            w.x = pk2(st[sub][8 * s2 + 0], st[sub][8 * s2 + 1]); w.y = pk2(st[sub][8 * s2 + 2], st[sub][8 * s2 + 3]);
            w.z = pk2(st[sub][8 * s2 + 4], st[sub][8 * s2 + 5]); w.w = pk2(st[sub][8 * s2 + 6], st[sub][8 * s2 + 7]);
            pf[sub][s2] = __builtin_bit_cast(bf16x8, w);
        }
#pragma unroll
    for (int dt = 0; dt < 2; ++dt)
#pragma unroll
        for (int sub = 0; sub < 2; ++sub)
#pragma unroll
            for (int s2 = 0; s2 < 2; ++s2) O[dt] = __builtin_amdgcn_mfma_f32_32x32x16_bf16(vf[dt * 4 + sub * 2 + s2], pf[sub][s2], O[dt], 0, 0, 0);
}
__device__ __forceinline__ void softmax_step(f32x16 (&st)[2], f32x16 (&O)[2], float& m, float& l) {
    const float mx = tile_max(st);
    if (__any(mx > RESC_THR)) {
        const float dl = mx > 0.f ? mx : 0.f;
        const float corr = __builtin_amdgcn_exp2f(-dl);
        m += dl; l *= corr;
#pragma unroll
        for (int sub = 0; sub < 2; ++sub)
#pragma unroll
            for (int r = 0; r < 16; ++r) st[sub][r] -= dl;
#pragma unroll
        for (int dt = 0; dt < 2; ++dt)
#pragma unroll
            for (int r = 0; r < 16; ++r) O[dt][r] *= corr;
    }
    float sum = 0.f;
#pragma unroll
    for (int sub = 0; sub < 2; ++sub)
#pragma unroll
        for (int r = 0; r < 16; ++r) { const float pe = __builtin_amdgcn_exp2f(st[sub][r]); st[sub][r] = pe; sum += pe; }
    l += sum;
}

constexpr int FLW = 68;
__device__ __forceinline__ void kv_step(f32x16 (&O)[2], float& m, float& l, const bf16x8 (&qf)[4], const bf16x8 (&kf)[8], bf16x8 (&kn)[8], rsrc_t rv, unsigned ksoff_next, unsigned koff,
                                        unsigned vsoff_blk, unsigned vvoff, const float* lutp, bool selme, float b31) {
    bf16x8 vf[8];
    load_v(vf, rv, vsoff_blk, vvoff);
    f32x16 st[2];
    qk_block(st, qf, kf, selme ? (lutp ? -m : b31 - m) : -INFINITY);
    __builtin_amdgcn_sched_barrier(0);
    load_k(kn, rv, ksoff_next, koff);
    if (lutp) bias_lut(st, lutp);
    softmax_step(st, O, m, l);
    pv_block(O, st, vf);
}

__device__ __forceinline__ void nsa_tile(const Params& p, int bg, int tg, const float* lutSall, const float* lutWall, float* impw, float* fl, int lane) {
    asm volatile("" : "+v"(lane));
    const int q = lane & 31, h2 = lane >> 5, tok = q >> 2, head = q & 3;
    const int b = bg >> 1, g = bg & 1, t0 = tg * 8, t = t0 + tok, token = b * SEQ + t;
    const float* lutS = lutSall + head * LSW;
    const float* lutW = lutWall + head * LWW;
    const float b31 = lutS[64 + 1024];
    bf16x8 qf[4];
    { const bf16_t* qp = (const bf16_t*)(p.ws + O_Q) + (size_t)token * 512 + (g * 4 + head) * 64 + 8 * h2;
#pragma unroll
      for (int s = 0; s < 4; ++s) qf[s] = *(const bf16x8*)(qp + 16 * s); }
    const float* gn = (const float*)(p.ws + O_GN) + (size_t)token * 24 + (g * 4 + head) * 3;
    float* flp = fl + q * FLW + 4 * h2;
    f32x16 O[2];
#pragma unroll
    for (int dt = 0; dt < 2; ++dt)
#pragma unroll
        for (int r = 0; r < 16; ++r) O[dt][r] = 0.f;
    const int cur = t0 >> 6;
    { const int u = head + 4 * h2;
#pragma unroll
      for (int i = 0; i < 16; ++i) impw[tok * IMPW + i * 8 + u] = 0.f; }
    WAVE_SYNC();
    bf16x8 kfA[8], kfB[8];
    const rsrc_t rKV = __builtin_amdgcn_make_buffer_rsrc((void*)(p.ws + O_KV), 0, (int)(6 * 8 * KV_SLAB * 2 + 8192), 0x00020000);
    const rsrc_t rKC = __builtin_amdgcn_make_buffer_rsrc((void*)(p.ws + O_KC), 0, (int)(2 * 4096 * 64 * 2), 0x00020000);
    const unsigned koff = (unsigned)lane * 16u, vsoff = koff;

    {
        const unsigned Kc = (unsigned)bg * 512u * 64u * 2u;
        const unsigned VcT = (4096u * 64u + (unsigned)bg * 64u * 512u) * 2u;
        const int tl = t0 + 7;
        const int ncmax = tl >= 31 ? ((tl - 31) >> 4) + 1 : 0;
        const int nblk = (ncmax + 63) >> 6;
        float m = NEG_BIG, l = 0.f;
        f32x16 st[2];
#define CMP_FAR(BLK) (16 * (64 * (BLK) + 63) + 31 + 1024 <= t0)
#define CMP_P1(KF, KN, BLK, BN) do { const bool far_ = CMP_FAR(BLK); qk_block(st, qf, KF, far_ ? b31 : 0.f); __builtin_amdgcn_sched_barrier(0); load_k(KN, rKC, Kc + (BN) * 8192, koff); \
            if (!far_) bias_mask_cmp(st, t - 31 - 16 * ((BLK) * 64 + 4 * h2), lutS); \
            const float mn = fmaxf(m, tile_max(st)); float sum = 0.f; \
            _Pragma("unroll") for (int sub = 0; sub < 2; ++sub) _Pragma("unroll") for (int r = 0; r < 16; ++r) sum += __builtin_amdgcn_exp2f(st[sub][r] - mn); \
            l = l * __builtin_amdgcn_exp2f(m - mn) + sum; m = mn; } while (0)
        if (nblk > 0) load_k(kfA, rKC, Kc, koff);
#pragma unroll 1
        for (int blk = 0; blk < nblk; blk += 2) {
            const int b1 = blk + 1 < nblk ? blk + 1 : blk;
            CMP_P1(kfA, kfB, blk, b1);
            if (blk + 1 >= nblk) break;
            const int b2 = blk + 2 < nblk ? blk + 2 : blk + 1;
            CMP_P1(kfB, kfA, blk + 1, b2);
        }
#undef CMP_P1
        l = xhalf_sum(l);
        const float invl = l > 0.f ? 1.f / l : 0.f;
#define CMP_P2(KF, KN, BLK, BN) do { const bool far_ = CMP_FAR(BLK); bf16x8 vf[8]; load_v(vf, rKC, VcT + (BLK) * 8192, koff); \
            qk_block(st, qf, KF, (far_ ? b31 : 0.f) - m); __builtin_amdgcn_sched_barrier(0); load_k(KN, rKC, Kc + (BN) * 8192, koff); \
            if (!far_) bias_mask_cmp(st, t - 31 - 16 * ((BLK) * 64 + 4 * h2), lutS); \
            _Pragma("unroll") for (int sub = 0; sub < 2; ++sub) _Pragma("unroll") for (int r = 0; r < 16; ++r) st[sub][r] = __builtin_amdgcn_exp2f(st[sub][r]) * invl; \
            _Pragma("unroll") for (int sub = 0; sub < 2; ++sub) _Pragma("unroll") for (int a = 0; a < 4; ++a) { \
                const float L_ = quad_sum(st[sub][4 * a + 3]); \
                const float G_ = quad_sum((st[sub][4 * a] + st[sub][4 * a + 1]) + (st[sub][4 * a + 2] + st[sub][4 * a + 3])); \
                const int j_ = (BLK) * 16 + 8 * sub + 2 * a + h2; \
                if (head == 0) { atomicAdd(&impw[tok * IMPW + j_], G_); if (j_ + 1 < 128) atomicAdd(&impw[tok * IMPW + j_ + 1], L_); } } \
            pv_block(O, st, vf); } while (0)
        if (nblk > 0) load_k(kfA, rKC, Kc, koff);
#pragma unroll 1
        for (int blk = 0; blk < nblk; blk += 2) {
            const int b1 = blk + 1 < nblk ? blk + 1 : blk;
            CMP_P2(kfA, kfB, blk, b1);
            if (blk + 1 >= nblk) break;
            const int b2 = blk + 2 < nblk ? blk + 2 : blk + 1;
            CMP_P2(kfB, kfA, blk + 1, b2);
        }
#undef CMP_P2
#undef CMP_FAR
        const float g0 = gn[0];
#pragma unroll
        for (int dt = 0; dt < 2; ++dt)
#pragma unroll
            for (int a = 0; a < 4; ++a) {
                *(f32x4*)(flp + dt * 32 + a * 8) = (f32x4){g0 * O[dt][4 * a], g0 * O[dt][4 * a + 1], g0 * O[dt][4 * a + 2], g0 * O[dt][4 * a + 3]};
                O[dt][4 * a] = 0.f; O[dt][4 * a + 1] = 0.f; O[dt][4 * a + 2] = 0.f; O[dt][4 * a + 3] = 0.f;
            }
    }
    WAVE_SYNC();

    unsigned long long mlo, mhi;
    if (cur < 16) { mlo = (1ull << (cur + 1)) - 1ull; mhi = 0ull; }
    else {
        const int u = head + 4 * h2;
        float val[16];
#pragma unroll
        for (int i = 0; i < 16; ++i) { const int j = i * 8 + u; val[i] = (j >= 1 && j <= cur - 2) ? impw[tok * IMPW + j] : -1.f; }
        mlo = 1ull; mhi = 0ull;
        if (cur < 64) mlo |= 1ull << cur; else mhi |= 1ull << (cur - 64);
        if (cur - 1 < 64) mlo |= 1ull << (cur - 1); else mhi |= 1ull << (cur - 1 - 64);
#pragma unroll 1
        for (int round = 0; round < 13; ++round) {
            float bs = val[0]; int bj = u;
#pragma unroll
            for (int i = 1; i < 16; ++i) { if (val[i] > bs) { bs = val[i]; bj = i * 8 + u; } }
            { const float os = __uint_as_float(__builtin_amdgcn_update_dpp(0u, __float_as_uint(bs), 0xB1, 0xF, 0xF, true)); const int oj = __builtin_amdgcn_update_dpp(0, bj, 0xB1, 0xF, 0xF, true);
              if (os > bs || (os == bs && oj < bj)) { bs = os; bj = oj; } }
            { const float os = __uint_as_float(__builtin_amdgcn_update_dpp(0u, __float_as_uint(bs), 0x4E, 0xF, 0xF, true)); const int oj = __builtin_amdgcn_update_dpp(0, bj, 0x4E, 0xF, 0xF, true);
              if (os > bs || (os == bs && oj < bj)) { bs = os; bj = oj; } }
            { const float os = __shfl_xor(bs, 32); const int oj = __shfl_xor(bj, 32);
              if (os > bs || (os == bs && oj < bj)) { bs = os; bj = oj; } }
            if (bj < 64) mlo |= 1ull << bj; else mhi |= 1ull << (bj - 64);
#pragma unroll
            for (int i = 0; i < 16; ++i) if (i * 8 + u == bj) val[i] = -2.f;
        }
    }
    unsigned long long ulo = mlo, uhi = mhi;
#pragma unroll
    for (int o = 4; o < 32; o <<= 1) { ulo |= __shfl_xor(ulo, o); uhi |= __shfl_xor(uhi, o); }
    ulo = ((unsigned long long)__builtin_amdgcn_readfirstlane((unsigned)(ulo >> 32)) << 32) | (unsigned)__builtin_amdgcn_readfirstlane((unsigned)ulo);
    uhi = ((unsigned long long)__builtin_amdgcn_readfirstlane((unsigned)(uhi >> 32)) << 32) | (unsigned)__builtin_amdgcn_readfirstlane((unsigned)uhi);

    {
        const unsigned Ks = (unsigned)((2 * 4 + b) * 2 + g) * (unsigned)(KV_SLAB * 2);
        const unsigned VsT = (unsigned)((3 * 4 + b) * 2 + g) * (unsigned)(KV_SLAB * 2);
        float m = 0.f, l = 0.f;
#define POPJ(J) do { if (ulo) { J = __builtin_ctzll(ulo); ulo &= ulo - 1ull; } else if (uhi) { J = 64 + __builtin_ctzll(uhi); uhi &= uhi - 1ull; } else J = -1; } while (0)
#define SEL_STEP(KF, KN, J, JN) do { const bool selme_ = (J) < 64 ? ((mlo >> (J)) & 1ull) : ((mhi >> ((J) - 64)) & 1ull); \
            const bool near_ = (64 * (J) + 63 + 1024 > t0); \
            kv_step(O, m, l, qf, KF, KN, rKV, Ks + (JN) * 8192, koff, VsT + (J) * 8192, vsoff, near_ ? lutS + (t - 64 * (J) - 4 * h2 + 64 - 59) : nullptr, selme_, b31); } while (0)
        int ja, jb;
        POPJ(ja);
        load_k(kfA, rKV, Ks + ja * 8192, koff);
#pragma unroll 1
        for (;;) {
            POPJ(jb);
            { const int jn = jb >= 0 ? jb : ja; SEL_STEP(kfA, kfB, ja, jn); }
            if (jb < 0) break;
            POPJ(ja);
            { const int jn = ja >= 0 ? ja : jb; SEL_STEP(kfB, kfA, jb, jn); }
            if (ja < 0) break;
        }
#undef SEL_STEP
#undef POPJ
        l = xhalf_sum(l);
        const float sc = l > 0.f ? gn[1] / l : 0.f;
#pragma unroll
        for (int dt = 0; dt < 2; ++dt)
#pragma unroll
            for (int a = 0; a < 4; ++a) {
                f32x4 f = *(const f32x4*)(flp + dt * 32 + a * 8);
                f[0] += sc * O[dt][4 * a]; f[1] += sc * O[dt][4 * a + 1]; f[2] += sc * O[dt][4 * a + 2]; f[3] += sc * O[dt][4 * a + 3];
                *(f32x4*)(flp + dt * 32 + a * 8) = f;
                O[dt][4 * a] = 0.f; O[dt][4 * a + 1] = 0.f; O[dt][4 * a + 2] = 0.f; O[dt][4 * a + 3] = 0.f;
            }
    }
    {
        const unsigned Kw = (unsigned)((4 * 4 + b) * 2 + g) * (unsigned)(KV_SLAB * 2);
        const unsigned VwT = (unsigned)((5 * 4 + b) * 2 + g) * (unsigned)(KV_SLAB * 2);
        float m = 0.f, l = 0.f;
        const int wlo = t0 - 511;
        const int r_begin = (wlo > 0 ? wlo : 0) & ~63;
        const int r_last = t0 + 7;
#define WIN_STEP(KF, KN, R0, RN) kv_step(O, m, l, qf, KF, KN, rKV, Kw + (RN) * 128, koff, VwT + (R0) * 128, vsoff, lutW + (t - (R0) - 4 * h2 + 72 - 59), true, b31)
        load_k(kfA, rKV, Kw + r_begin * 128, koff);
#pragma unroll 1
        for (int row0 = r_begin; row0 <= r_last; row0 += 128) {
            { const int rn = row0 + 64 <= r_last ? row0 + 64 : row0; WIN_STEP(kfA, kfB, row0, rn); }
            if (row0 + 64 > r_last) break;
            { const int rn = row0 + 128 <= r_last ? row0 + 128 : row0 + 64; WIN_STEP(kfB, kfA, row0 + 64, rn); }
        }
#undef WIN_STEP
        l = xhalf_sum(l);
        const float sc = l > 0.f ? gn[2] / l : 0.f;
        bf16_t* op = (bf16_t*)(p.ws + O_ONSA) + (size_t)token * 512 + (g * 4 + head) * 64 + 4 * h2;
#pragma unroll
        for (int dt = 0; dt < 2; ++dt)
#pragma unroll
            for (int a = 0; a < 4; ++a) {
                const f32x4 f = *(const f32x4*)(flp + dt * 32 + a * 8);
                *(u32x2*)(op + dt * 32 + a * 8) = (u32x2){pk2(f[0] + sc * O[dt][4 * a], f[1] + sc * O[dt][4 * a + 1]), pk2(f[2] + sc * O[dt][4 * a + 2], f[3] + sc * O[dt][4 * a + 3])};
            }
    }
    WAVE_SYNC();
}

__device__ __forceinline__ void phase7(const Params& p, unsigned char* smem) {
    const int tid = threadIdx.x, lane = tid & 63, wid = __builtin_amdgcn_readfirstlane(tid >> 6);
    float* lutS = (float*)smem;
    float* lutW = lutS + 4 * LSW;
    float* impw = lutW + 4 * LWW + wid * 8 * IMPW;
    float* fl = lutW + 4 * LWW + NWV * 8 * IMPW + wid * 32 * FLW;
    const int bg = blockIdx.x & 7, g = bg & 1;
    for (int i = tid; i < 4 * LSW; i += NT) { const int head = i / LSW, dist = i % LSW - 64;
        lutS[i] = dist < 0 ? -INFINITY : p.in[2][rel_bucket_dev(dist) * 8 + g * 4 + head] * LOG2E; }
    for (int i = tid; i < 4 * LWW; i += NT) { const int head = i / LWW, dist = i % LWW - 72;
        lutW[i] = (dist < 0 || dist >= 512) ? -INFINITY : p.in[2][rel_bucket_dev(dist) * 8 + g * 4 + head] * LOG2E; }
    __syncthreads();
    const int nblk_bg = (gridDim.x - bg + 7) >> 3;
    const int W = nblk_bg * NWV, w = (blockIdx.x >> 3) * NWV + wid;
#pragma unroll 1
    for (int round = 0; ; ++round) {
        const int idx = round * W + ((round & 1) ? (W - 1 - w) : w);
        if (idx >= 1024) break;
        nsa_tile(p, bg, 1023 - idx, lutS, lutW, impw, fl, lane);
    }
    __syncthreads();
}

struct EpiNsa { static constexpr bool PERM = true; const bf16_t* SGN; bf16_t* MS5;
    __device__ __forceinline__ void operator()(AccRef acc, const pg8::Unit& u, int wr, int wc, int fr, int fq) const {
#pragma unroll
        for (int ai = 0; ai < 2; ++ai)
#pragma unroll
            for (int m = 0; m < 4; ++m) {
                const int token = u.pm * 256 + ai * 128 + wr * 64 + m * 16 + fr;
#pragma unroll
                for (int bj = 0; bj < 2; ++bj) {
                    const int col = u.pn * 256 + bj * 128 + wc * 32 + 8 * fq;
                    const u32x4 sg = *(const u32x4*)(SGN + (size_t)token * 1024 + col);
                    const u32x4 ms = *(const u32x4*)(MS5 + (size_t)token * 1024 + col);
                    const f32x4 v0 = acc[ai][bj][m][0], v1 = acc[ai][bj][m][1];
                    u32x4 o;
                    o.x = pk2(bflo(ms.x) + bflo(sg.x) * v0[0], bfhi(ms.x) + bfhi(sg.x) * v0[1]); o.y = pk2(bflo(ms.y) + bflo(sg.y) * v0[2], bfhi(ms.y) + bfhi(sg.y) * v0[3]);
                    o.z = pk2(bflo(ms.z) + bflo(sg.z) * v1[0], bfhi(ms.z) + bfhi(sg.z) * v1[1]); o.w = pk2(bflo(ms.w) + bflo(sg.w) * v1[2], bfhi(ms.w) + bfhi(sg.w) * v1[3]);
                    *(u32x4*)(MS5 + (size_t)token * 1024 + col) = o;
                }
            }
    } };
__device__ __forceinline__ void phase8(const Params& p, LAS unsigned char* lds) {
    pg8::DenseOrder S; S.init(p.ws + O_ONSA, p.ws + O_WT_NSA, NTOK, 1024, 512, 512, gridDim.x, blockIdx.x);
    EpiNsa E{(const bf16_t*)(p.ws + O_SGN), (bf16_t*)(p.ws + O_MS5)};
    pg8::gemm_phase<EpiNsa, pg8::DenseOrder, true>(lds, 512, 512, 512, S, E);
}
struct EpiOut { static constexpr bool PERM = false; const float* x; const float* ada; float* Z1;
    __device__ __forceinline__ void operator()(AccRef acc, const pg8::Unit& u, int wr, int wc, int fr, int fq) const {
        const float* ga = ada + (u.pm >> 5) * 6144 + 2048;
#pragma unroll
        for (int ai = 0; ai < 2; ++ai)
#pragma unroll
            for (int m = 0; m < 4; ++m) {
                const int token = u.pm * 256 + ai * 128 + wr * 64 + m * 16 + fr;
#pragma unroll
                for (int bj = 0; bj < 2; ++bj)
#pragma unroll
                    for (int n = 0; n < 2; ++n) {
                        const int col = u.pn * 256 + bj * 128 + wc * 32 + n * 16 + fq * 4;
                        const f32x4 xv = *(const f32x4*)(x + (size_t)token * 1024 + col), gv = *(const f32x4*)(ga + col);
                        *(f32x4*)(Z1 + (size_t)token * 1024 + col) = xv * DN_ALPHA + gv * acc[ai][bj][m][n];
                    }
            }
    } };
__device__ __forceinline__ void phase9(const Params& p, LAS unsigned char* lds) {
    pg8::DenseOrder S; S.init(p.ws + O_MS5, p.ws + O_WT_OUT, NTOK, 1024, 1024, 1024, gridDim.x, blockIdx.x);
    EpiOut E{p.in[0], (const float*)(p.ws + O_ADA), (float*)(p.ws + O_Z1)};
    pg8::gemm_phase<EpiOut, pg8::DenseOrder, true>(lds, 1024, 1024, 1024, S, E);
}

__device__ __forceinline__ void phase10(const Params& p, unsigned char* smem) {
    const int tid = threadIdx.x, lane = tid & 63, wid = tid >> 6;
    float* hs = (float*)smem + wid * 1024;
    const float* lg = p.in[24]; const float* lb = p.in[25]; const float* wr_ = p.in[26]; const float* br_ = p.in[27];
    unsigned* cnt = (unsigned*)(p.ws + O_CNT);
    for (int item = blockIdx.x; item < NTOK / NWV; item += gridDim.x) {
        const int token = item * NWV + wid, b = token >> 13;
        float* zr = (float*)(p.ws + O_Z1) + (size_t)token * 1024;
        const float* ada = (const float*)(p.ws + O_ADA) + b * 6144;
        f32x4 v[4]; float s = 0.f;
#pragma unroll
        for (int j = 0; j < 4; ++j) { v[j] = *(const f32x4*)(zr + j * 256 + lane * 4); s += (v[j][0] + v[j][1]) + (v[j][2] + v[j][3]); }
        const float mean = wave_sum(s) * (1.f / 1024.f); float q = 0.f;
#pragma unroll
        for (int j = 0; j < 4; ++j) { v[j] = v[j] - mean; q += (v[j][0] * v[j][0] + v[j][1] * v[j][1]) + (v[j][2] * v[j][2] + v[j][3] * v[j][3]); }
        const float rstd = rsqrtf(wave_sum(q) * (1.f / 1024.f) + LN_EPS);
        bf16_t* h2 = (bf16_t*)(p.ws + O_H2) + (size_t)token * 1024;
#pragma unroll
        for (int j = 0; j < 4; ++j) {
            const int c = j * 256 + lane * 4;
            const f32x4 x1 = v[j] * rstd * *(const f32x4*)(lg + c) + *(const f32x4*)(lb + c);
            *(f32x4*)(zr + c) = x1;
            const f32x4 hv = x1 * (*(const f32x4*)(ada + 4096 + c) + 1.f) + *(const f32x4*)(ada + 3072 + c);
            *(f32x4*)(hs + c) = hv;
            *(u32x2*)(h2 + c) = (u32x2){pk2(hv[0], hv[1]), pk2(hv[2], hv[3])};
        }
        WAVE_SYNC();
        const int e = lane & 31, kh = lane >> 5;
        float a = 0.f;
#pragma unroll 8
        for (int k = kh * 512; k < kh * 512 + 512; ++k) a += hs[k] * wr_[k * 32 + e];
        a += __shfl_xor(a, 32);
        a += br_[e];
        float val = a; int te[4]; float tv[4];
#pragma unroll
        for (int r = 0; r < 4; ++r) {
            float bs = val; int bj = e;
#pragma unroll
            for (int o = 1; o < 32; o <<= 1) { const float os = __shfl_xor(bs, o); const int oj = __shfl_xor(bj, o); if (os > bs || (os == bs && oj < bj)) { bs = os; bj = oj; } }
            te[r] = bj; tv[r] = bs;
            if (e == bj) val = -INFINITY;
        }
        const float e0 = 1.f, e1 = __expf(tv[1] - tv[0]), e2 = __expf(tv[2] - tv[0]), e3 = __expf(tv[3] - tv[0]);
        const float inv = 1.f / (e0 + e1 + e2 + e3);
        if (lane < 4) {
            const int ee = lane == 0 ? te[0] : (lane == 1 ? te[1] : (lane == 2 ? te[2] : te[3]));
            const float gg = (lane == 0 ? e0 : (lane == 1 ? e1 : (lane == 2 ? e2 : e3))) * inv;
            const unsigned pos = atomicAdd(cnt + ee, 1u);
            ((int*)(p.ws + O_TOPE))[token * 4 + lane] = ee;
            ((unsigned*)(p.ws + O_TOPP))[token * 4 + lane] = pos;
            ((float*)(p.ws + O_TOPG))[token * 4 + lane] = gg;
        }
        WAVE_SYNC();
    }
}

__device__ __forceinline__ void load_offsets(const Params& p, int* offs  , int* toff  ) {
    if (threadIdx.x == 0) {
        const unsigned* cnt = (const unsigned*)(p.ws + O_CNT);
        int a = 0, t = 0;
        for (int e = 0; e < 32; ++e) { offs[e] = a; toff[e] = t; const int c = (int)cnt[e]; a += c; t += (c + 255) >> 8; }
        offs[32] = a; toff[32] = t;
    }
    __syncthreads();
}
__device__ __forceinline__ void phase11(const Params& p, unsigned char* smem) {
    int* offs = (int*)(smem + LDS_TAB); int* toff = offs + 40;
    load_offsets(p, offs, toff);
    const int* tope = (const int*)(p.ws + O_TOPE); const unsigned* topp = (const unsigned*)(p.ws + O_TOPP); const float* topg = (const float*)(p.ws + O_TOPG);
    float* rowgate = (float*)(p.ws + O_ROWGATE); int* tokrow = (int*)(p.ws + O_TOKROW); int* rowtok = (int*)(p.ws + O_ROWTOK);
    for (int i = blockIdx.x * NT + threadIdx.x; i < NROWS; i += gridDim.x * NT) {
        const int R = offs[tope[i]] + (int)topp[i];
        rowgate[R] = topg[i]; tokrow[i] = R; rowtok[R] = i >> 2;
    }
    __syncthreads();
}

struct MoeOrder {
    const int* offs; const int* toff; const char* A; const char* B; const int* rowtok; size_t bsB; int nN, G, c;
    __device__ __forceinline__ bool next(int i, pg8::Unit& u) const {
        const long L = (long)i * G + c; if (L >= (long)toff[32] * nN) return false;
        const int tile = (int)L / nN, pn = (int)L % nN;
        int e = 0;
#pragma unroll 1
        while (toff[e + 1] <= tile) ++e;
        const int r0 = offs[e] + (tile - toff[e]) * 256;
        u.pm = r0; u.pn = pn; u.e = e; u.nvalid = offs[e + 1] - r0;
        if (rowtok) { u.A = A; u.rows = rowtok + r0; const int rm = NROWS - 1 - r0; u.rmax = rm < 255 ? rm : 255; }
        else { u.A = A + (size_t)r0 * 2048; u.rows = nullptr; u.rmax = 255; }
        u.B = B + (size_t)e * bsB + (size_t)pn * 256 * 2048; return true;
    }
};
struct EpiGU { static constexpr bool PERM = true; const float* bgu; bf16_t* ACT;
    __device__ __forceinline__ void operator()(AccRef acc, const pg8::Unit& u, int wr, int wc, int fr, int fq) const {
        const int cv = u.pn * 128 + wc * 32 + 8 * fq;
        const float* bb = bgu + (size_t)u.e * 2048;
        const f32x4 bg0 = *(const f32x4*)(bb + cv), bg1 = *(const f32x4*)(bb + cv + 4), bu0 = *(const f32x4*)(bb + 1024 + cv), bu1 = *(const f32x4*)(bb + 1024 + cv + 4);
#pragma unroll
        for (int ai = 0; ai < 2; ++ai)
#pragma unroll
            for (int m = 0; m < 4; ++m) {
                const int lr = ai * 128 + wr * 64 + m * 16 + fr;
                if (lr < u.nvalid) {
                    const f32x4 ga0 = acc[ai][0][m][0] + bg0, ga1 = acc[ai][0][m][1] + bg1, ua0 = acc[ai][1][m][0] + bu0, ua1 = acc[ai][1][m][1] + bu1;
                    float o[8];
#pragma unroll
                    for (int j = 0; j < 4; ++j) {
                        const float gt0 = fminf(ga0[j], 7.f), up0 = fminf(fmaxf(ua0[j], -7.f), 7.f); o[j] = (up0 + 1.f) * gt0 * sigmoidf_(1.702f * gt0);
                        const float gt1 = fminf(ga1[j], 7.f), up1 = fminf(fmaxf(ua1[j], -7.f), 7.f); o[4 + j] = (up1 + 1.f) * gt1 * sigmoidf_(1.702f * gt1);
                    }
                    *(u32x4*)(ACT + (size_t)(u.pm + lr) * 1024 + cv) = (u32x4){pk2(o[0], o[1]), pk2(o[2], o[3]), pk2(o[4], o[5]), pk2(o[6], o[7])};
                }
            }
    } };
__device__ __forceinline__ void phase12(const Params& p, unsigned char* smem, LAS unsigned char* lds) {
    int* offs = (int*)(smem + LDS_TAB); int* toff = offs + 40;
    load_offsets(p, offs, toff);
    MoeOrder S{offs, toff, (const char*)(p.ws + O_H2), (const char*)(p.ws + O_WT_GU), (const int*)(p.ws + O_ROWTOK), (size_t)2048 * 2048, 8, (int)gridDim.x, (int)blockIdx.x};
    EpiGU E{p.in[29], (bf16_t*)(p.ws + O_ACT)};
    pg8::gemm_phase<EpiGU, MoeOrder, true>(lds, 1024, 1024, 1024, S, E);
    __syncthreads();
}
struct EpiDn { static constexpr bool PERM = true; const float* bd; const float* rowgate; bf16_t* YK;
    __device__ __forceinline__ void operator()(AccRef acc, const pg8::Unit& u, int wr, int wc, int fr, int fq) const {
        const float* bb = bd + (size_t)u.e * 1024;
#pragma unroll
        for (int ai = 0; ai < 2; ++ai)
#pragma unroll
            for (int m = 0; m < 4; ++m) {
                const int lr = ai * 128 + wr * 64 + m * 16 + fr;
                if (lr < u.nvalid) {
                    const float gw = rowgate[u.pm + lr];
#pragma unroll
                    for (int bj = 0; bj < 2; ++bj) {
                        const int col = u.pn * 256 + bj * 128 + wc * 32 + 8 * fq;
                        const f32x4 v0 = (acc[ai][bj][m][0] + *(const f32x4*)(bb + col)) * gw, v1 = (acc[ai][bj][m][1] + *(const f32x4*)(bb + col + 4)) * gw;
                        *(u32x4*)(YK + (size_t)(u.pm + lr) * 1024 + col) = (u32x4){pk2(v0[0], v0[1]), pk2(v0[2], v0[3]), pk2(v1[0], v1[1]), pk2(v1[2], v1[3])};
                    }
                }
            }
    } };
__device__ __forceinline__ void phase13(const Params& p, unsigned char* smem, LAS unsigned char* lds) {
    int* offs = (int*)(smem + LDS_TAB); int* toff = offs + 40;
    load_offsets(p, offs, toff);
    MoeOrder S{offs, toff, (const char*)(p.ws + O_ACT), (const char*)(p.ws + O_WT_DN), nullptr, (size_t)1024 * 2048, 4, (int)gridDim.x, (int)blockIdx.x};
    EpiDn E{p.in[31], (const float*)(p.ws + O_ROWGATE), (bf16_t*)(p.ws + O_YK)};
    pg8::gemm_phase<EpiDn, MoeOrder, true>(lds, 1024, 1024, 1024, S, E);
    __syncthreads();
}

__device__ __forceinline__ void phase14(const Params& p, unsigned char*) {
    const int tid = threadIdx.x, lane = tid & 63, wid = tid >> 6;
    const float* lg = p.in[32]; const float* lb = p.in[33];
    const int* tokrow = (const int*)(p.ws + O_TOKROW);
    const bf16_t* YK = (const bf16_t*)(p.ws + O_YK);
    for (int item = blockIdx.x; item < NTOK / NWV; item += gridDim.x) {
        const int token = item * NWV + wid, b = token >> 13;
        const float* x1 = (const float*)(p.ws + O_Z1) + (size_t)token * 1024;
        const float* gf = (const float*)(p.ws + O_ADA) + b * 6144 + 5120;
        const int r0 = tokrow[token * 4 + 0], r1 = tokrow[token * 4 + 1], r2 = tokrow[token * 4 + 2], r3 = tokrow[token * 4 + 3];
        f32x4 v[4]; float s = 0.f;
#pragma unroll
        for (int j = 0; j < 4; ++j) {
            const int c = j * 256 + lane * 4;
            const u32x2 a0 = *(const u32x2*)(YK + (size_t)r0 * 1024 + c), a1 = *(const u32x2*)(YK + (size_t)r1 * 1024 + c), a2 = *(const u32x2*)(YK + (size_t)r2 * 1024 + c), a3 = *(const u32x2*)(YK + (size_t)r3 * 1024 + c);
            f32x4 y;
            y[0] = (bflo(a0.x) + bflo(a1.x)) + (bflo(a2.x) + bflo(a3.x)); y[1] = (bfhi(a0.x) + bfhi(a1.x)) + (bfhi(a2.x) + bfhi(a3.x));
            y[2] = (bflo(a0.y) + bflo(a1.y)) + (bflo(a2.y) + bflo(a3.y)); y[3] = (bfhi(a0.y) + bfhi(a1.y)) + (bfhi(a2.y) + bfhi(a3.y));
            v[j] = *(const f32x4*)(x1 + c) * DN_ALPHA + *(const f32x4*)(gf + c) * y;
            s += (v[j][0] + v[j][1]) + (v[j][2] + v[j][3]);
        }
        const float mean = wave_sum(s) * (1.f / 1024.f); float q = 0.f;
#pragma unroll
        for (int j = 0; j < 4; ++j) { v[j] = v[j] - mean; q += (v[j][0] * v[j][0] + v[j][1] * v[j][1]) + (v[j][2] * v[j][2] + v[j][3] * v[j][3]); }
        const float rstd = rsqrtf(wave_sum(q) * (1.f / 1024.f) + LN_EPS);
#pragma unroll
        for (int j = 0; j < 4; ++j) { const int c = j * 256 + lane * 4; *(f32x4*)(p.out + (size_t)token * 1024 + c) = v[j] * rstd * *(const f32x4*)(lg + c) + *(const f32x4*)(lb + c); }
    }
}

template <bool COOP>
__global__ void __launch_bounds__(NT, 2) fwd_kernel(Params p) {
    extern __shared__ __attribute__((aligned(16))) unsigned char smem[];
    LAS unsigned char* lds = (LAS unsigned char*)smem;
    const int lo = p.ph_lo, hi = p.ph_hi;
#define RUN_PHASE(k, call) if (((PH_MASK >> (k)) & 1) && lo <= (k) && (k) < hi) { _Pragma("unroll 1") for (int rep_ = 0; rep_ < 1 + ((REPEAT_MASK >> (k)) & 1); ++rep_) { if (rep_) { if (COOP) cg::this_grid().sync(); } call; } } if (COOP) { if (lo <= (k) && (k) + 1 < hi) cg::this_grid().sync(); }
    RUN_PHASE(0, phase0(p, smem))
    RUN_PHASE(1, phase1(p, smem))
    RUN_PHASE(2, phase2(p, lds))
    RUN_PHASE(3, phase3(p, lds))
    RUN_PHASE(4, phase4(p, smem))
    RUN_PHASE(5, phase5(p, lds))
    RUN_PHASE(6, phase6(p, lds))
    RUN_PHASE(7, phase7(p, smem))
    RUN_PHASE(8, phase8(p, lds))
    RUN_PHASE(9, phase9(p, lds))
    RUN_PHASE(10, phase10(p, smem))
    RUN_PHASE(11, phase11(p, smem))
    RUN_PHASE(12, phase12(p, smem, lds))
    RUN_PHASE(13, phase13(p, smem, lds))
    RUN_PHASE(14, phase14(p, smem))
#undef RUN_PHASE
}

extern "C" void kernel_launch(void* const* d_in, const int* in_sizes, int n_in, void* d_out, int out_size, void* d_ws, size_t ws_size, hipStream_t stream) {
    static int grid = 0;
    if (grid == 0) {
        if (n_in != 34 || out_size != NTOK * DM || ws_size < WS_NEED) { fprintf(stderr, "kernel_launch: unexpected problem (n_in %d, out %d, ws %zu need %zu)\n", n_in, out_size, ws_size, (size_t)WS_NEED); grid = -1; return; }
        int dev = 0, cus = 0, per_cu = 0;
        (void)hipGetDevice(&dev);
        (void)hipDeviceGetAttribute(&cus, hipDeviceAttributeMultiprocessorCount, dev);
#if ONE_LAUNCH
        (void)hipFuncSetAttribute((const void*)fwd_kernel<true>, hipFuncAttributeMaxDynamicSharedMemorySize, LDS_BYTES);
        (void)hipOccupancyMaxActiveBlocksPerMultiprocessor(&per_cu, fwd_kernel<true>, NT, LDS_BYTES);
#else
        (void)hipFuncSetAttribute((const void*)fwd_kernel<false>, hipFuncAttributeMaxDynamicSharedMemorySize, LDS_BYTES);
        (void)hipOccupancyMaxActiveBlocksPerMultiprocessor(&per_cu, fwd_kernel<false>, NT, LDS_BYTES);
#endif
        if (per_cu < 1) { fprintf(stderr, "kernel_launch: occupancy query reports %d blocks per CU\n", per_cu); per_cu = 1; }
        grid = cus * per_cu;
        fprintf(stderr, "kernel_launch: grid %d (%d CUs x %d)\n", grid, cus, per_cu);
    }
    if (grid < 0) return;
    Params p{};
    for (int i = 0; i < 34; ++i) p.in[i] = (const float*)d_in[i];
    p.out = (float*)d_out; p.ws = (unsigned char*)d_ws;
#if ONE_LAUNCH
    p.ph_lo = 0; p.ph_hi = NPHASE;
    void* args[] = {&p};
    hipError_t e = hipLaunchCooperativeKernel((void*)fwd_kernel<true>, dim3(grid), dim3(NT), args, LDS_BYTES, stream);
    if (e != hipSuccess) fprintf(stderr, "cooperative launch failed: %s (grid %d)\n", hipGetErrorString(e), grid);
#else
    for (int ph = 0; ph < NPHASE; ++ph) {
        p.ph_lo = ph; p.ph_hi = ph + 1;
        hipLaunchKernelGGL(fwd_kernel<false>, dim3(grid), dim3(NT), LDS_BYTES, stream, p);
    }
#endif
}
```

```cpp
#include <hip/hip_runtime.h>
#include <hip/hip_cooperative_groups.h>
#include <cstdio>
#include <cstdint>
namespace cg = cooperative_groups;

#ifndef PH_MASK
#define PH_MASK 0xFFFFF
#endif
#ifndef REPEAT_MASK
#define REPEAT_MASK 0
#endif
#ifndef ONE_LAUNCH
#define ONE_LAUNCH 1
#endif

#define LAS __attribute__((address_space(3)))
typedef unsigned short bf16_t;
typedef short bf16x8 __attribute__((ext_vector_type(8)));
typedef float f32x4 __attribute__((ext_vector_type(4)));
typedef float f32x2 __attribute__((ext_vector_type(2)));
typedef unsigned u32x4 __attribute__((ext_vector_type(4)));
typedef unsigned u32x2 __attribute__((ext_vector_type(2)));
typedef __bf16 bf16x2_t __attribute__((ext_vector_type(2)));

constexpr int NB = 4, SEQ = 8192, NTOK = NB * SEQ, DM = 1024;
constexpr int NIN_PAD = 4096;
constexpr int NEXP = 32, TOPK = 4, NROWS = NTOK * TOPK;
constexpr int S5L = 32;
constexpr int NCHUNK = SEQ / S5L;
constexpr int UROW = 640;
constexpr float DN_ALPHA = 1.189207115002721f;
constexpr float LN_EPS = 1e-5f;
constexpr float LOG2E = 1.4426950408889634f;
constexpr float QSCALE = 0.125f * 1.4426950408889634f;
constexpr float WGU_SCALE = 32.f, WDN_SCALE = 64.f;
constexpr int NT = 512;
constexpr int NWV = NT / 64;

constexpr size_t al256(size_t x) { return (x + 255) & ~(size_t)255; }
constexpr size_t O_ADA = 0;
constexpr size_t O_CNT = O_ADA + al256(4 * 6144 * 4);
constexpr size_t O_LAML = O_CNT + 1024;
constexpr size_t O_BIAS1 = O_LAML + al256(32 * 64 * 2 * 4);
constexpr size_t O_WT_IN = O_BIAS1 + al256(2 * 8 * 128 * 4);
constexpr size_t O_WT_GLU = O_WT_IN + al256((size_t)NIN_PAD * 1024 * 2);
constexpr size_t O_WT_NSA = O_WT_GLU + al256((size_t)2048 * 512 * 2);
constexpr size_t O_WT_OUT = O_WT_NSA + al256((size_t)1024 * 512 * 2);
constexpr size_t O_WT_C1 = O_WT_OUT + al256((size_t)1024 * 1024 * 2);
constexpr size_t O_W1T = O_WT_C1 + al256((size_t)2 * 256 * 2048 * 2);
constexpr size_t O_TW2 = O_W1T + al256((size_t)32 * 256 * 512 * 2);
constexpr size_t O_WT_GU = O_TW2 + al256((size_t)32 * 512 * 640 * 2);
constexpr size_t O_WT_DN = O_WT_GU + al256((size_t)32 * 2048 * 1024);
constexpr size_t O_H2 = O_WT_DN + al256((size_t)32 * 1024 * 1024);
constexpr size_t O_Z1 = O_H2 + al256((size_t)NTOK * 1024);
constexpr size_t O_TOPE = O_Z1 + al256((size_t)NTOK * 1024 * 4);
constexpr size_t O_TOPP = O_TOPE + al256((size_t)NROWS * 4);
constexpr size_t O_TOPG = O_TOPP + al256((size_t)NROWS * 4);
constexpr size_t O_ROWTOK = O_TOPG + al256((size_t)NROWS * 4);
constexpr size_t O_ROWGATE = O_ROWTOK + al256((size_t)(NROWS + 256) * 4);
constexpr size_t O_TOKROW = O_ROWGATE + al256((size_t)(NROWS + 256) * 4);
constexpr size_t O_OVL = O_TOKROW + al256((size_t)NROWS * 4);
constexpr size_t O_U = O_OVL;
constexpr size_t O_E = O_U + al256((size_t)32 * 1024 * UROW * 2);
constexpr size_t O_YS = O_E + al256((size_t)32 * 1024 * 128 * 4);
constexpr size_t O_Q = O_YS + al256((size_t)NTOK * 512 * 2);
constexpr size_t O_KV = O_Q + al256((size_t)NTOK * 512 * 2);
constexpr size_t KV_SLAB = (size_t)SEQ * 64;
constexpr size_t O_SG5 = O_KV + al256((size_t)6 * 8 * KV_SLAB * 2 + 8192);
constexpr size_t O_SGN = O_SG5 + al256((size_t)NTOK * 1024 * 2);
constexpr size_t O_GN = O_SGN + al256((size_t)NTOK * 1024 * 2);
constexpr size_t O_MS5 = O_GN + al256((size_t)NTOK * 24 * 4);
constexpr size_t O_ONSA = O_MS5 + al256((size_t)NTOK * 1024 * 2);
constexpr size_t O_HC = O_ONSA + al256((size_t)NTOK * 512 * 2);
constexpr size_t O_KC = O_HC + al256((size_t)2 * 4096 * 128 * 2);
constexpr size_t O_XN = O_KC + al256((size_t)2 * 4096 * 64 * 2);
constexpr size_t O_END1 = O_XN + al256((size_t)NTOK * 1024 * 2);
constexpr size_t O_ACT = O_OVL;
constexpr size_t O_YK = O_ACT + al256((size_t)(NROWS + 256) * 1024);
constexpr size_t O_END2 = O_YK + al256((size_t)(NROWS + 256) * 1024 * 2);
constexpr size_t WS_NEED = O_END1 > O_END2 ? O_END1 : O_END2;
static_assert(WS_NEED <= (size_t)1073741824, "workspace map exceeds 1 GiB");

constexpr int LDS_BYTES = 147456;
constexpr int LDS_TAB = 131072;
constexpr int NPHASE = 15;

struct Params {
    const float* in[34];
    float* out;
    unsigned char* ws;
    int ph_lo, ph_hi;
};

__device__ __forceinline__ unsigned pk2(float lo, float hi) { f32x2 v = {lo, hi}; bf16x2_t b = __builtin_convertvector(v, bf16x2_t); return __builtin_bit_cast(unsigned, b); }
__device__ __forceinline__ bf16_t f2bf(float f) { return (bf16_t)(pk2(f, 0.f) & 0xffffu); }
__device__ __forceinline__ float bf2f(bf16_t h) { return __uint_as_float(((unsigned)h) << 16); }
__device__ __forceinline__ float bflo(unsigned w) { return __uint_as_float(w << 16); }
__device__ __forceinline__ float bfhi(unsigned w) { return __uint_as_float(w & 0xffff0000u); }
__device__ __forceinline__ unsigned pk4_f8(float a, float b, float c, float d) { int w = 0; w = __builtin_amdgcn_cvt_pk_fp8_f32(a, b, w, false); w = __builtin_amdgcn_cvt_pk_fp8_f32(c, d, w, true); return (unsigned)w; }
__device__ __forceinline__ float sigmoidf_(float x) { return 1.f / (1.f + __expf(-x)); }
__device__ __forceinline__ float gelu_tanh(float x) { const float u = 0.7978845608028654f * (x + 0.044715f * x * x * x); const float e = __expf(2.f * u); return 0.5f * x * (2.f - 2.f / (e + 1.f)); }
__device__ __forceinline__ float wave_sum(float v) {
#pragma unroll
    for (int o = 1; o < 64; o <<= 1) v += __shfl_xor(v, o);
    return v;
}
#define WAVE_SYNC() do { __builtin_amdgcn_fence(__ATOMIC_RELEASE, "wavefront"); __builtin_amdgcn_wave_barrier(); __builtin_amdgcn_fence(__ATOMIC_ACQUIRE, "wavefront"); } while (0)

namespace pg8 {
typedef int v8i_t __attribute__((ext_vector_type(8)));
typedef int v4i8_t __attribute__((ext_vector_type(4)));
constexpr int BM = 256, BK = 64, HALF = 128, HTB = HALF * BK * 2, STAGE_BYTES = 8 * HTB;
__device__ __forceinline__ int lds_byte(int r, int c) { const int st = (r >> 4) * 2 + (c >> 5), rr = r & 15, cc = c & 31, ob = rr * 64 + cc * 2; return st * 1024 + (ob ^ (((ob >> 9) & 1) << 5)); }
__device__ __forceinline__ void stage_rc(int b, int& R, int& C) { const int st = b / 1024, sb = b % 1024, swz = sb ^ (((sb >> 9) & 1) << 5); R = (st >> 1) * 16 + swz / 64; C = (st & 1) * 32 + (swz % 64) / 2; }
__device__ __forceinline__ int perm32(int rho) { const int n = rho >> 4, i = rho & 15; return 8 * (i >> 2) + 4 * n + (i & 3); }
struct Unit { const char* A; const char* B; const int* rows; int pm, pn, e, nvalid, rmax; };

template <class Epi, class Sched, bool ALIGN_EPI, bool F8 = false>
__device__ __forceinline__ void gemm_phase(LAS unsigned char* lds, const int K, const int lda, const int ldb, const Sched& S, const Epi& E) {
    const int tid = threadIdx.x, wid = __builtin_amdgcn_readfirstlane(tid >> 6), lane = tid & 63, wr = wid >> 2, wc = wid & 3, fr = lane & 15, fq = lane >> 4;
    const int nt = K / BK;
    unsigned voffB[2]; int Ra[2], Ca[2];
#pragma unroll
    for (int i = 0; i < 2; ++i) { int R, C; stage_rc(tid * 16 + i * 8192, R, C); const int Rb = Epi::PERM ? ((R & ~31) + perm32(R & 31)) : R;
        Ra[i] = R; Ca[i] = C; voffB[i] = (unsigned)(Rb * ldb + C) * 2u; }
    unsigned offC[2][2], offN[2][2];
#define PG8_SETOFF(o, u) do { _Pragma("unroll") for (int h_ = 0; h_ < 2; ++h_) _Pragma("unroll") for (int i_ = 0; i_ < 2; ++i_) { \
        if ((u).rows) { int ix_ = h_ * HALF + Ra[i_]; ix_ = ix_ < (u).rmax ? ix_ : (u).rmax; o[h_][i_] = (unsigned)(u).rows[ix_] * (unsigned)(lda * 2) + (unsigned)Ca[i_] * 2u; } \
        else o[h_][i_] = (unsigned)((h_ * HALF + Ra[i_]) * lda + Ca[i_]) * 2u; } } while (0)
    const size_t kstep = (size_t)(BK * 2);
    const size_t hstepB = (size_t)HALF * ldb * 2;
    const unsigned ldsw = (unsigned)wid * 1024u;
    const int aoff = lds_byte(wr * 64 + fr, fq * 8), boff = lds_byte(wc * 32 + fr, fq * 8);
#define PG8_SA(b, h) (((b) * 2 + (h)) * HTB)
#define PG8_SB(b, h) ((4 + (b) * 2 + (h)) * HTB)
#define PG8_STAGE(bufoff, gbase, voff) do { _Pragma("unroll") for (int _i = 0; _i < 2; ++_i) \
        __builtin_amdgcn_global_load_lds((const unsigned*)((const char*)(gbase) + (voff)[_i]), (LAS unsigned*)(lds + (bufoff) + ldsw + _i * 8192), 16, 0, 0); } while (0)
#define PG8_LDA(dst, b, h) do { _Pragma("unroll") for (int m = 0; m < 4; ++m) { \
        if constexpr (F8) dst##8[m] = __builtin_shufflevector(*(const LAS v4i8_t*)(lds + PG8_SA(b, h) + aoff + m * 2048), *(const LAS v4i8_t*)(lds + PG8_SA(b, h) + aoff + m * 2048 + 1024), 0, 1, 2, 3, 4, 5, 6, 7); \
        else { _Pragma("unroll") for (int k = 0; k < 2; ++k) dst[m][k] = *(const LAS bf16x8*)(lds + PG8_SA(b, h) + aoff + m * 2048 + k * 1024); } } } while (0)
#define PG8_LDB(dst, b, h) do { _Pragma("unroll") for (int n = 0; n < 2; ++n) { \
        if constexpr (F8) dst##8[n] = __builtin_shufflevector(*(const LAS v4i8_t*)(lds + PG8_SB(b, h) + boff + n * 2048), *(const LAS v4i8_t*)(lds + PG8_SB(b, h) + boff + n * 2048 + 1024), 0, 1, 2, 3, 4, 5, 6, 7); \
        else { _Pragma("unroll") for (int k = 0; k < 2; ++k) dst[n][k] = *(const LAS bf16x8*)(lds + PG8_SB(b, h) + boff + n * 2048 + k * 1024); } } } while (0)
#define PG8_MMA(ai, bj, At, Bt) do { __builtin_amdgcn_s_setprio(1); _Pragma("unroll") for (int m = 0; m < 4; ++m) _Pragma("unroll") for (int n = 0; n < 2; ++n) { \
        if constexpr (F8) asm volatile("v_mfma_scale_f32_16x16x128_f8f6f4 %0, %1, %2, %0, %3, %3 op_sel_hi:[0,0,0]" : "+v"(acc[ai][bj][m][n]) : "v"(Bt##8[n]), "v"(At##8[m]), "v"(f8scale_));   \
        else { _Pragma("unroll") for (int k = 0; k < 2; ++k) acc[ai][bj][m][n] = __builtin_amdgcn_mfma_f32_16x16x32_bf16(Bt[n][k], At[m][k], acc[ai][bj][m][n], 0, 0, 0); } } \
        __builtin_amdgcn_s_setprio(0); } while (0)
#define PG8_WAIT_V(n) asm volatile("s_waitcnt vmcnt(" #n ")" ::: "memory")
#define PG8_WAIT_L(n) asm volatile("s_waitcnt lgkmcnt(" #n ")" ::: "memory")
#define PG8_BAR __builtin_amdgcn_s_barrier()
#define PG8_SCHED __builtin_amdgcn_sched_barrier(0)
    Unit cur, nxt; int ui = 0;
    if (!S.next(0, cur)) return;
    f32x4 acc[2][2][4][2];
#pragma unroll
    for (int a = 0; a < 2; ++a)
#pragma unroll
        for (int b = 0; b < 2; ++b)
#pragma unroll
            for (int m = 0; m < 4; ++m)
#pragma unroll
                for (int n = 0; n < 2; ++n) acc[a][b][m][n] = (f32x4){0.f, 0.f, 0.f, 0.f};
    bf16x8 At[4][2], B0[2][2], B1[2][2];
    v8i_t At8[4], B08[2], B18[2];
    const int f8scale_ = 0x7F7F7F7F;
    const char* cA = cur.A; const char* cB = cur.B;
    PG8_SETOFF(offC, cur);
    PG8_STAGE(PG8_SB(0, 0), cB, voffB); PG8_STAGE(PG8_SB(0, 1), cB + hstepB, voffB); PG8_STAGE(PG8_SA(0, 0), cA, offC[0]); PG8_STAGE(PG8_SA(0, 1), cA, offC[1]);
    if (wr == 1) PG8_BAR;
    PG8_WAIT_V(2); PG8_BAR;
    PG8_STAGE(PG8_SB(1, 0), cB + kstep, voffB); PG8_STAGE(PG8_SA(1, 0), cA + kstep, offC[0]); PG8_STAGE(PG8_SB(1, 1), cB + hstepB + kstep, voffB);
    PG8_WAIT_V(6); PG8_BAR;
    for (;;) {
        const bool has_next = S.next(ui + 1, nxt);
        const char* nA = has_next ? nxt.A : cA; const char* nB = has_next ? nxt.B : cB;
        if (has_next) { PG8_SETOFF(offN, nxt); } else { offN[0][0] = offC[0][0]; offN[0][1] = offC[0][1]; offN[1][0] = offC[1][0]; offN[1][1] = offC[1][1]; }
#pragma unroll 1
        for (int t = 0; t < nt; t += 2) {
            const bool last = (t == nt - 2);
            const char* a1 = cA + (size_t)(t + 1) * kstep;
            const char* a2 = last ? nA : cA + (size_t)(t + 2) * kstep; const char* b2 = last ? nB : cB + (size_t)(t + 2) * kstep;
            const char* a3 = a2 + kstep; const char* b3 = b2 + kstep;
            unsigned o2[2][2];
            o2[0][0] = last ? offN[0][0] : offC[0][0]; o2[0][1] = last ? offN[0][1] : offC[0][1]; o2[1][0] = last ? offN[1][0] : offC[1][0]; o2[1][1] = last ? offN[1][1] : offC[1][1];
            PG8_LDB(B0, 0, 0); PG8_LDB(B1, 0, 1); PG8_SCHED; PG8_LDA(At, 0, 0); PG8_STAGE(PG8_SA(1, 1), a1, offC[1]);
            PG8_WAIT_V(8); PG8_WAIT_L(0); PG8_BAR; PG8_MMA(0, 0, At, B0); PG8_MMA(0, 1, At, B1); PG8_BAR; PG8_SCHED;
            PG8_LDA(At, 0, 1); PG8_STAGE(PG8_SB(0, 0), b2, voffB); PG8_STAGE(PG8_SB(0, 1), b2 + hstepB, voffB); PG8_STAGE(PG8_SA(0, 0), a2, o2[0]);
            PG8_WAIT_V(8); PG8_WAIT_L(0); PG8_BAR; PG8_MMA(1, 0, At, B0); PG8_MMA(1, 1, At, B1); PG8_BAR; PG8_SCHED;
            PG8_LDB(B0, 1, 0); PG8_LDB(B1, 1, 1); PG8_SCHED; PG8_LDA(At, 1, 0); PG8_STAGE(PG8_SA(0, 1), a2, o2[1]);
            PG8_WAIT_V(8); PG8_WAIT_L(0); PG8_BAR; PG8_MMA(0, 0, At, B0); PG8_MMA(0, 1, At, B1); PG8_BAR; PG8_SCHED;
            PG8_LDA(At, 1, 1); PG8_STAGE(PG8_SB(1, 0), b3, voffB); PG8_STAGE(PG8_SB(1, 1), b3 + hstepB, voffB); PG8_STAGE(PG8_SA(1, 0), a3, o2[0]);
            PG8_WAIT_V(8); PG8_WAIT_L(0); PG8_BAR; PG8_MMA(1, 0, At, B0); PG8_MMA(1, 1, At, B1); PG8_BAR; PG8_SCHED;
        }
        if constexpr (ALIGN_EPI) { if (wr == 0) PG8_BAR; }
        if constexpr (F8) asm volatile("s_nop 15\n\ts_nop 15" ::: "memory");
        E(acc, cur, wr, wc, fr, fq);
        if (!has_next) break;
#pragma unroll
        for (int a = 0; a < 2; ++a)
#pragma unroll
            for (int b = 0; b < 2; ++b)
#pragma unroll
                for (int m = 0; m < 4; ++m)
#pragma unroll
                    for (int n = 0; n < 2; ++n) acc[a][b][m][n] = (f32x4){0.f, 0.f, 0.f, 0.f};
        cur = nxt; cA = nA; cB = nB; ++ui;
        offC[0][0] = offN[0][0]; offC[0][1] = offN[0][1]; offC[1][0] = offN[1][0]; offC[1][1] = offN[1][1];
        if constexpr (ALIGN_EPI) { if (wr == 1) PG8_BAR; }
    }
    PG8_WAIT_V(0);
    if constexpr (!ALIGN_EPI) { if (wr == 0) PG8_BAR; }
    PG8_BAR;
#undef PG8_SETOFF
#undef PG8_SA
#undef PG8_SB
#undef PG8_STAGE
#undef PG8_LDA
#undef PG8_LDB
#undef PG8_MMA
#undef PG8_WAIT_V
#undef PG8_WAIT_L
#undef PG8_BAR
#undef PG8_SCHED
}

struct DenseOrder {
    const char* A; const char* B; size_t tstepA, tstepB; int nM, nN, nwg, G, c;
    __device__ __forceinline__ void init(const void* A_, const void* B_, int M, int N, int lda, int ldb, int G_, int c_) {
        A = (const char*)A_; B = (const char*)B_; tstepA = (size_t)BM * lda * 2; tstepB = (size_t)BM * ldb * 2; nM = M / BM; nN = N / BM; nwg = nM * nN; G = G_; c = c_; }
    __device__ __forceinline__ bool next(int i, Unit& u) const {
        const long L = (long)i * G + c; if (L >= nwg) return false;
        int wgid = (int)L; { const int q = nwg / 8, r = nwg % 8, xcd = wgid % 8, off = wgid / 8; wgid = (xcd < r ? xcd * (q + 1) : r * (q + 1) + (xcd - r) * q) + off; }
        const int nig = 8 * nN, gid = wgid / nig, fm = gid * 8, gsz = (nM - fm) < 8 ? (nM - fm) : 8;
        u.pm = fm + ((wgid % nig) % gsz); u.pn = (wgid % nig) / gsz; u.e = 0; u.nvalid = 256; u.rows = nullptr; u.rmax = 255;
        u.A = A + (size_t)u.pm * tstepA; u.B = B + (size_t)u.pn * tstepB; return true;
    }
};
}

__device__ __forceinline__ int map_in(int n) { return n < 1792 ? n : (n < 3840 ? n + 24 : (n < 3864 ? 1792 + (n - 3840) : -1)); }
__device__ __forceinline__ int map_il128(int n) { const int b = n >> 7; return (b & 1) * 1024 + (b >> 1) * 128 + (n & 127); }

struct TrJob { const float* W; bf16_t* Wt; int K, Nsrc, map, kt, nt; float f8scale; };
constexpr int TR_IN = 16 * 16, TR_GLU = 8 * 8, TR_NSA = 8 * 4, TR_OUT = 16 * 4, TR_C1 = 2 * 32, TR_GU = 32 * 16 * 8, TR_DN = 32 * 16 * 4;
constexpr int TR_ITEMS = TR_IN + TR_GLU + TR_NSA + TR_OUT + TR_C1 + TR_GU + TR_DN;
__device__ __forceinline__ void tr_job(const Params& p, int r, TrJob& j) {
    unsigned char* ws = p.ws;
    if (r < TR_IN) { j = TrJob{p.in[5], (bf16_t*)(ws + O_WT_IN), 1024, 3864, 1, r / 16, r % 16, 0.f}; return; } r -= TR_IN;
    if (r < TR_GLU) { j = TrJob{p.in[14], (bf16_t*)(ws + O_WT_GLU), 512, 2048, 2, r / 8, r % 8, 0.f}; return; } r -= TR_GLU;
    if (r < TR_NSA) { j = TrJob{p.in[22], (bf16_t*)(ws + O_WT_NSA), 512, 1024, 0, r / 4, r % 4, 0.f}; return; } r -= TR_NSA;
    if (r < TR_OUT) { j = TrJob{p.in[23], (bf16_t*)(ws + O_WT_OUT), 1024, 1024, 0, r / 4, r % 4, 0.f}; return; } r -= TR_OUT;
    if (r < TR_C1) { const int kv = r / 32; j = TrJob{p.in[kv ? 20 : 17], (bf16_t*)(ws + O_WT_C1) + (size_t)kv * 256 * 2048, 2048, 128, 3, r % 32, 0, 0.f}; return; } r -= TR_C1;
    if (r < TR_GU) { const int e = r / 128, q = r % 128; j = TrJob{p.in[28] + (size_t)e * 1024 * 2048, (bf16_t*)(ws + O_WT_GU + (size_t)e * 2048 * 1024), 1024, 2048, 2, q / 8, q % 8, WGU_SCALE}; return; } r -= TR_GU;
    { const int e = r / 64, q = r % 64; j = TrJob{p.in[30] + (size_t)e * 1024 * 1024, (bf16_t*)(ws + O_WT_DN + (size_t)e * 1024 * 1024), 1024, 1024, 0, q / 4, q % 4, WDN_SCALE}; }
}
__device__ __forceinline__ void tr_load(const TrJob& j, f32x4 (&v)[8], int tid) {
    const int n4 = tid & 63, kq = tid >> 6, nd = j.nt * 256 + 4 * n4;
    const int src = j.map == 0 ? nd : (j.map == 1 ? map_in(nd) : (j.map == 2 ? map_il128(nd) : (nd < 128 ? nd : -1)));
    const float* base = j.W + (size_t)(j.kt * 64 + kq) * j.Nsrc + (src >= 0 ? src : 0);
#pragma unroll
    for (int i = 0; i < 8; ++i) v[i] = (src >= 0) ? *(const f32x4*)(base + (size_t)i * 8 * j.Nsrc) : (f32x4){0.f, 0.f, 0.f, 0.f};
}
__device__ __forceinline__ void convert_weights(const Params& p, unsigned char* smem, int lo, int hi, unsigned* queue) {
    float* t = (float*)smem;
    int* nxt_slot = (int*)(smem + 64 * 260 * 4);
    const int tid = threadIdx.x;
    int it;
    if (queue) { if (tid == 0) *nxt_slot = lo + (int)atomicAdd(queue, 1u); __syncthreads(); it = *nxt_slot; __syncthreads(); }
    else it = lo + blockIdx.x;
    if (it >= hi) return;
    TrJob j; tr_job(p, it, j);
    f32x4 v[8];
    tr_load(j, v, tid);
    for (;;) {
        { const int n4 = tid & 63, kq = tid >> 6;
#pragma unroll
          for (int i = 0; i < 8; ++i) *(f32x4*)(t + (i * 8 + kq) * 260 + 4 * n4) = v[i]; }
        if (queue && tid == 0) *nxt_slot = lo + (int)atomicAdd(queue, 1u);
        __syncthreads();
        const TrJob cj = j;
        const int nit = queue ? *nxt_slot : it + (int)gridDim.x;
        const bool more = nit < hi;
        if (more) { tr_job(p, nit, j); tr_load(j, v, tid); }
        if (cj.f8scale != 0.f) {
          const int n = tid & 255, kh = (tid >> 8) * 32; const float sc = cj.f8scale;
          unsigned char* d = (unsigned char*)cj.Wt + (size_t)(cj.nt * 256 + n) * cj.K + cj.kt * 64 + kh;
#pragma unroll
          for (int q = 0; q < 2; ++q) {
              const float* c = t + (kh + 16 * q) * 260 + n;
              u32x4 o;
              o.x = pk4_f8(c[0] * sc, c[260] * sc, c[2 * 260] * sc, c[3 * 260] * sc); o.y = pk4_f8(c[4 * 260] * sc, c[5 * 260] * sc, c[6 * 260] * sc, c[7 * 260] * sc);
              o.z = pk4_f8(c[8 * 260] * sc, c[9 * 260] * sc, c[10 * 260] * sc, c[11 * 260] * sc); o.w = pk4_f8(c[12 * 260] * sc, c[13 * 260] * sc, c[14 * 260] * sc, c[15 * 260] * sc);
              *(u32x4*)(d + 16 * q) = o;
          }
        } else { const int n = tid & 255, kh = (tid >> 8) * 32;
          bf16_t* d = cj.Wt + (size_t)(cj.nt * 256 + n) * cj.K + cj.kt * 64 + kh;
#pragma unroll
          for (int q = 0; q < 4; ++q) {
              const float* c = t + (kh + 8 * q) * 260 + n;
              u32x4 o;
              o.x = pk2(c[0], c[260]); o.y = pk2(c[2 * 260], c[3 * 260]); o.z = pk2(c[4 * 260], c[5 * 260]); o.w = pk2(c[6 * 260], c[7 * 260]);
              *(u32x4*)(d + 8 * q) = o;
          } }
        __syncthreads();
        if (!more) break;
        it = nit;
    }
}

__device__ __forceinline__ void phase0(const Params& p, unsigned char* smem) {
    unsigned char* ws = p.ws;
    const int tid = threadIdx.x;
    convert_weights(p, smem, 0, TR_ITEMS - TR_GU - TR_DN, nullptr);
    constexpr int I_ADA = 96;
    constexpr int I_S5 = 32 * 33;
    constexpr int I_MISC = 17;
    constexpr int NITEM = I_ADA + I_S5 + I_MISC;
    for (int item = blockIdx.x; item < NITEM; item += gridDim.x) {
        int r = item;
        if (r < I_ADA) {
            const float* c = p.in[1]; const float* w = p.in[3]; const float* bb = p.in[4];
            const int wid = tid >> 6, lane = tid & 63, j = r * 64 + lane;
            float a0 = 0.f, a1 = 0.f, a2 = 0.f, a3 = 0.f;
#pragma unroll 4
            for (int k = wid * 128; k < wid * 128 + 128; ++k) {
                const float wv = w[(size_t)k * 6144 + j];
                const float c0 = c[k], c1 = c[1024 + k], c2 = c[2048 + k], c3 = c[3072 + k];
                a0 += c0 * sigmoidf_(c0) * wv; a1 += c1 * sigmoidf_(c1) * wv; a2 += c2 * sigmoidf_(c2) * wv; a3 += c3 * sigmoidf_(c3) * wv;
            }
            float* red = (float*)smem;
            red[(wid * 4 + 0) * 64 + lane] = a0; red[(wid * 4 + 1) * 64 + lane] = a1; red[(wid * 4 + 2) * 64 + lane] = a2; red[(wid * 4 + 3) * 64 + lane] = a3;
            __syncthreads();
            if (tid < 256) { const int b = tid >> 6; float s = 0.f;
#pragma unroll
              for (int w8 = 0; w8 < 8; ++w8) s += red[(w8 * 4 + b) * 64 + lane];
              ((float*)(ws + O_ADA))[b * 6144 + j] = s + bb[j]; }
            __syncthreads();
            continue;
        }
        r -= I_ADA;
        if (r < I_S5) {
            const int g = r / 33, dl = r % 33;
            f32x2* pw = (f32x2*)smem;
            f32x2* bbv = pw + 64;
            f32x2* ccv = bbv + 1024;
            const float dt = expf(p.in[8][g]);
            if (tid < 64) {
                const int n = tid; const double re = p.in[6][g * 64 + n], im = p.in[7][g * 64 + n];
                const double mag = exp(re * (double)dt * dl), ang = im * (double)dt * dl;
                double sn, cs; sincos(ang, &sn, &cs);
                pw[n] = (f32x2){(float)(mag * cs), (float)(mag * sn)};
                if (dl == 32) { ((f32x2*)(ws + O_LAML))[g * 64 + n] = pw[n]; }
            }
            for (int e = tid; e < 1024; e += NT) {
                const int n = e >> 4, q = e & 15;
                const double re = p.in[6][g * 64 + n], im = p.in[7][g * 64 + n];
                const double mag = exp(re * (double)dt), ang = im * (double)dt;
                double sn, cs; sincos(ang, &sn, &cs);
                const double lr = mag * cs - 1.0, li = mag * sn;
                const double den = re * re + im * im;
                const double fr_ = (lr * re + li * im) / den, fi_ = (li * re - lr * im) / den;
                const double br = p.in[9][(g * 64 + n) * 16 + q], bi = p.in[10][(g * 64 + n) * 16 + q];
                bbv[e] = (f32x2){(float)(fr_ * br - fi_ * bi), (float)(fr_ * bi + fi_ * br)};
            }
            for (int e = tid; e < 1024; e += NT) { ccv[e] = (f32x2){p.in[11][g * 1024 + e], p.in[12][g * 1024 + e]}; }
            __syncthreads();
            bf16_t* TW2 = (bf16_t*)(ws + O_TW2) + (size_t)g * 512 * UROW;
            bf16_t* W1T = (bf16_t*)(ws + O_W1T) + (size_t)g * 256 * 512;
            if (dl < 32) {
                if (tid < 256) {
                    const int pp = tid >> 4, q = tid & 15;
                    float acc = 0.f;
                    for (int n = 0; n < 64; ++n) {
                        const f32x2 cv = ccv[pp * 64 + n], pv = pw[n], bv = bbv[n * 16 + q];
                        const float xr = cv.x * pv.x - cv.y * pv.y, xi = cv.x * pv.y + cv.y * pv.x;
                        acc += xr * bv.x - xi * bv.y;
                    }
                    if (dl == 0 && pp == q) acc += p.in[13][g * 16 + pp];
                    const bf16_t kb = f2bf(acc);
                    for (int tau = dl; tau < 32; ++tau) { const int s = tau - dl; TW2[(size_t)(tau * 16 + pp) * UROW + s * 16 + q] = kb; }
                    if (dl >= 1) for (int s = dl; s < 32; ++s) { const int tau = s - dl; TW2[(size_t)(tau * 16 + pp) * UROW + s * 16 + q] = 0; }
                }
                const int s = 31 - dl;
                for (int e = tid; e < 2048; e += NT) {
                    const int c = e >> 4, qq = e & 15, n = c & 63, ri = c >> 6;
                    const f32x2 pv = pw[n], bv = bbv[n * 16 + qq];
                    const float zr = pv.x * bv.x - pv.y * bv.y, zi = pv.x * bv.y + pv.y * bv.x;
                    W1T[(size_t)c * 512 + s * 16 + qq] = f2bf(ri ? zi : zr);
                }
            } else {
                u32x4* z = (u32x4*)(W1T + (size_t)128 * 512);
                for (int e = tid; e < 128 * 512 / 8; e += NT) z[e] = (u32x4){0u, 0u, 0u, 0u};
            }
            if (dl >= 1) {
                const int tau = dl - 1;
                for (int e = tid; e < 2048; e += NT) {
                    const int pp = e >> 7, c = e & 127, n = c & 63, ri = c >> 6;
                    const f32x2 cv = ccv[pp * 64 + n], pv = pw[n];
                    const float xr = cv.x * pv.x - cv.y * pv.y, xi = cv.x * pv.y + cv.y * pv.x;
                    TW2[(size_t)(tau * 16 + pp) * UROW + 512 + c] = f2bf(ri ? -xi : xr);
                }
            }
            __syncthreads();
            continue;
        }
        r -= I_S5;
        if (r < 16) {
            const int kv = r >> 3, part = r & 7, j = tid & 127, qtr = tid >> 7;
            const float* pos = p.in[kv ? 19 : 16]; const float* w1 = p.in[kv ? 20 : 17];
            float a = 0.f;
            const int i0 = part * 256 + qtr * 64;
            for (int i = i0; i < i0 + 64; ++i) a += pos[i] * w1[(size_t)i * 128 + j];
            float* red = (float*)smem;
            red[tid] = a;
            __syncthreads();
            if (tid < 128) ((float*)(ws + O_BIAS1))[(kv * 8 + part) * 128 + tid] = (red[tid] + red[tid + 128]) + (red[tid + 256] + red[tid + 384]);
            __syncthreads();
            continue;
        }
        if (tid < 64) ((unsigned*)(ws + O_CNT))[tid] = 0u;
    }
}

__device__ __forceinline__ void phase1(const Params& p, unsigned char*) {
    const float* x = p.in[0];
    bf16_t* xn = (bf16_t*)(p.ws + O_XN);
    for (size_t i = (size_t)blockIdx.x * NT + threadIdx.x; i < (size_t)NTOK * 128; i += (size_t)gridDim.x * NT) {
        const int token = (int)(i >> 7), k = (int)(i & 127) * 8, b = token >> 13;
        const float* ada = (const float*)(p.ws + O_ADA) + b * 6144;
        const f32x4 x0 = *(const f32x4*)(x + (size_t)token * 1024 + k), x1 = *(const f32x4*)(x + (size_t)token * 1024 + k + 4);
        const f32x4 s0 = *(const f32x4*)(ada + 1024 + k), s1 = *(const f32x4*)(ada + 1024 + k + 4);
        const f32x4 h0 = *(const f32x4*)(ada + k), h1 = *(const f32x4*)(ada + k + 4);
        u32x4 o;
        o.x = pk2(x0[0] * (1.f + s0[0]) + h0[0], x0[1] * (1.f + s0[1]) + h0[1]); o.y = pk2(x0[2] * (1.f + s0[2]) + h0[2], x0[3] * (1.f + s0[3]) + h0[3]);
        o.z = pk2(x1[0] * (1.f + s1[0]) + h1[0], x1[1] * (1.f + s1[1]) + h1[1]); o.w = pk2(x1[2] * (1.f + s1[2]) + h1[2], x1[3] * (1.f + s1[3]) + h1[3]);
        *(u32x4*)(xn + (size_t)token * 1024 + k) = o;
    }
}

typedef const f32x4 (&AccRef)[2][2][4][2];
struct EpiIn {
    static constexpr bool PERM = true;
    unsigned char* ws;
    __device__ __forceinline__ void operator()(AccRef acc, const pg8::Unit& u, int wr, int wc, int fr, int fq) const {
        const int pn = u.pn;
#pragma unroll
        for (int ai = 0; ai < 2; ++ai)
#pragma unroll
            for (int m = 0; m < 4; ++m) {
                const int token = u.pm * 256 + ai * 128 + wr * 64 + m * 16 + fr;
#pragma unroll
                for (int bj = 0; bj < 2; ++bj) {
                    const int col = pn * 256 + bj * 128 + wc * 32 + 8 * fq;
                    const f32x4 v0 = acc[ai][bj][m][0], v1 = acc[ai][bj][m][1];
                    if (pn < 2) {
                        const int g = col >> 4, q = col & 15;
                        bf16_t* d = (bf16_t*)(ws + O_U) + ((size_t)(g * 1024 + (token >> 5)) * UROW + (token & 31) * 16 + q);
                        *(u32x4*)d = (u32x4){pk2(v0[0], v0[1]), pk2(v0[2], v0[3]), pk2(v1[0], v1[1]), pk2(v1[2], v1[3])};
                    } else if (pn < 4) {
                        bf16_t* d = (bf16_t*)(ws + O_Q) + (size_t)token * 512 + (col - 512);
                        *(u32x4*)d = (u32x4){pk2(v0[0] * QSCALE, v0[1] * QSCALE), pk2(v0[2] * QSCALE, v0[3] * QSCALE), pk2(v1[0] * QSCALE, v1[1] * QSCALE), pk2(v1[2] * QSCALE, v1[3] * QSCALE)};
                    } else if (pn < 7) {
                        const int c = col - 1024, j6 = c >> 7, g = (c >> 6) & 1, dd = c & 63, b = token >> 13, s = token & 8191;
                        bf16_t* slab = (bf16_t*)(ws + O_KV) + (size_t)((j6 * 4 + b) * 2 + g) * KV_SLAB;
                        if (j6 == 3 || j6 == 5) {
                            const int p64 = s & 63, p16 = p64 & 15, slot = (p16 & 3) | ((p16 & 4) << 1) | ((p16 & 8) >> 1);
                            bf16_t* blkp = slab + (size_t)(s >> 6) * 4096 + (((p64 >> 5) * 2 + ((p64 >> 4) & 1)) * 64 + (slot >> 3) * 32) * 8 + (slot & 7);
#pragma unroll
                            for (int j = 0; j < 4; ++j) { const int d0 = dd + j, d1 = dd + 4 + j;
                                blkp[((d0 >> 5) * 4 * 64 + (d0 & 31)) * 8] = f2bf(v0[j]); blkp[((d1 >> 5) * 4 * 64 + (d1 & 31)) * 8] = f2bf(v1[j]); }
                        } else if (j6 == 2 || j6 == 4) {
                            bf16_t* d = slab + (size_t)((s >> 5) * 4 + (dd >> 4)) * 512 + (((dd >> 3) & 1) * 32 + (s & 31)) * 8;
                            *(u32x4*)d = (u32x4){pk2(v0[0], v0[1]), pk2(v0[2], v0[3]), pk2(v1[0], v1[1]), pk2(v1[2], v1[3])};
                        } else {
                            *(u32x4*)(slab + (size_t)s * 64 + dd) = (u32x4){pk2(v0[0], v0[1]), pk2(v0[2], v0[3]), pk2(v1[0], v1[1]), pk2(v1[2], v1[3])};
                        }
                    } else if (pn < 15) {
                        bf16_t* d = (pn < 11 ? (bf16_t*)(ws + O_SG5) + (size_t)token * 1024 + (col - 1792) : (bf16_t*)(ws + O_SGN) + (size_t)token * 1024 + (col - 2816));
                        *(u32x4*)d = (u32x4){pk2(sigmoidf_(v0[0]), sigmoidf_(v0[1])), pk2(sigmoidf_(v0[2]), sigmoidf_(v0[3])), pk2(sigmoidf_(v1[0]), sigmoidf_(v1[1])), pk2(sigmoidf_(v1[2]), sigmoidf_(v1[3]))};
                    } else {
                        const int c = col - 3840;
                        if (c < 24) { float* d = (float*)(ws + O_GN) + (size_t)token * 24 + c;
                            *(f32x4*)d = (f32x4){sigmoidf_(v0[0]), sigmoidf_(v0[1]), sigmoidf_(v0[2]), sigmoidf_(v0[3])};
                            *(f32x4*)(d + 4) = (f32x4){sigmoidf_(v1[0]), sigmoidf_(v1[1]), sigmoidf_(v1[2]), sigmoidf_(v1[3])}; }
                    }
                }
            }
    }
};
__device__ __forceinline__ void phase2(const Params& p, LAS unsigned char* lds) {
    pg8::DenseOrder S; S.init(p.ws + O_XN, p.ws + O_WT_IN, NTOK, NIN_PAD, 1024, 1024, gridDim.x, blockIdx.x);
    EpiIn E{p.ws};
    pg8::gemm_phase<EpiIn, pg8::DenseOrder, true>(lds, 1024, 1024, 1024, S, E);
}

struct BatchOrder {
    const char* A; const char* B; size_t bsA, bsB, tstepA, tstepB; int nM, nN, nunits, G, c;
    __device__ __forceinline__ bool next(int i, pg8::Unit& u) const {
        const long L = (long)i * G + c; if (L >= nunits) return false;
        const int per = nM * nN, bt = (int)L / per, rem = (int)L % per;
        u.pm = rem / nN; u.pn = rem % nN; u.e = bt; u.nvalid = 256; u.rows = nullptr; u.rmax = 255;
        u.A = A + (size_t)bt * bsA + (size_t)u.pm * tstepA; u.B = B + (size_t)bt * bsB + (size_t)u.pn * tstepB; return true;
    }
};
struct EpiE { static constexpr bool PERM = false; float* E;
    __device__ __forceinline__ void operator()(AccRef acc, const pg8::Unit& u, int wr, int wc, int fr, int fq) const {
#pragma unroll
        for (int ai = 0; ai < 2; ++ai)
#pragma unroll
            for (int m = 0; m < 4; ++m) {
                const int r = u.pm * 256 + ai * 128 + wr * 64 + m * 16 + fr;
#pragma unroll
                for (int n = 0; n < 2; ++n) *(f32x4*)(E + ((size_t)u.e * 1024 + r) * 128 + wc * 32 + n * 16 + fq * 4) = acc[ai][0][m][n];
            }
    } };
struct EpiCmp { static constexpr bool PERM = true; const float* b1p; bf16_t* HC;
    __device__ __forceinline__ void operator()(AccRef acc, const pg8::Unit& u, int wr, int wc, int fr, int fq) const {
        const int col = wc * 32 + 8 * fq;
        f32x4 b0 = (f32x4){0.f, 0.f, 0.f, 0.f}, b1 = b0;
#pragma unroll
        for (int part = 0; part < 8; ++part) { b0 += *(const f32x4*)(b1p + (u.e * 8 + part) * 128 + col); b1 += *(const f32x4*)(b1p + (u.e * 8 + part) * 128 + col + 4); }
#pragma unroll
        for (int ai = 0; ai < 2; ++ai)
#pragma unroll
            for (int m = 0; m < 4; ++m) {
                const int R = u.pm * 256 + ai * 128 + wr * 64 + m * 16 + fr;
                const f32x4 v0 = acc[ai][0][m][0] + b0, v1 = acc[ai][0][m][1] + b1;
                *(u32x4*)(HC + ((size_t)u.e * 4096 + R) * 128 + col) = (u32x4){pk2(gelu_tanh(v0[0]), gelu_tanh(v0[1])), pk2(gelu_tanh(v0[2]), gelu_tanh(v0[3])), pk2(gelu_tanh(v1[0]), gelu_tanh(v1[1])), pk2(gelu_tanh(v1[2]), gelu_tanh(v1[3]))};
            }
    } };
__device__ __forceinline__ void phase3(const Params& p, LAS unsigned char* lds) {
    const int G = gridDim.x;
    {
        BatchOrder S{(const char*)(p.ws + O_U), (const char*)(p.ws + O_W1T), (size_t)1024 * UROW * 2, (size_t)256 * 512 * 2, (size_t)256 * UROW * 2, 0, 4, 1, 128, G, (int)blockIdx.x};
        EpiE E{(float*)(p.ws + O_E)};
        pg8::gemm_phase<EpiE, BatchOrder, false>(lds, 512, UROW, 512, S, E);
    }
    {
        BatchOrder S{(const char*)(p.ws + O_KV), (const char*)(p.ws + O_WT_C1), (size_t)8 * KV_SLAB * 2, (size_t)256 * 2048 * 2, (size_t)256 * 1024 * 2, 0, 16, 1, 32, G, (int)((blockIdx.x + G - 128 % G) % G)};
        EpiCmp E{(const float*)(p.ws + O_BIAS1), (bf16_t*)(p.ws + O_HC)};
        pg8::gemm_phase<EpiCmp, BatchOrder, false>(lds, 2048, 1024, 2048, S, E);
    }
}
__device__ __forceinline__ void phase4(const Params& p, unsigned char* smem) {
    const int tid = threadIdx.x;
    for (int item = blockIdx.x; item < 16 + 512; item += gridDim.x) {
        if (item < 16) {
            f32x2* seg = (f32x2*)smem;
#pragma unroll 1
            for (int half = 0; half < 8; ++half) {
                const int n = tid & 63, sg = tid >> 6, bg = item * 8 + half, b = bg >> 5, g = bg & 31;
                const f32x2 lm = ((const f32x2*)(p.ws + O_LAML))[g * 64 + n];
                const float* E = (const float*)(p.ws + O_E) + (size_t)(g * 1024 + b * 256 + sg * 32) * 128;
                bf16_t* U = (bf16_t*)(p.ws + O_U) + (size_t)(g * 1024 + b * 256 + sg * 32) * UROW + 512;
                float er[32], ei[32];
#pragma unroll
                for (int c = 0; c < 32; ++c) { er[c] = E[(size_t)c * 128 + n]; ei[c] = E[(size_t)c * 128 + 64 + n]; }
                float hr = 0.f, hi = 0.f;
#pragma unroll
                for (int c = 0; c < 32; ++c) { const float nr = lm.x * hr - lm.y * hi + er[c], ni = lm.x * hi + lm.y * hr + ei[c]; hr = nr; hi = ni; }
                seg[sg * 64 + n] = (f32x2){hr, hi};
                float pr = lm.x, pi = lm.y;
#pragma unroll
                for (int q = 0; q < 5; ++q) { const float nr = pr * pr - pi * pi, ni = 2.f * pr * pi; pr = nr; pi = ni; }
                __syncthreads();
                float sr = 0.f, si = 0.f;
                for (int k = 0; k < sg; ++k) { const f32x2 a = seg[k * 64 + n]; const float nr = pr * sr - pi * si + a.x, ni = pr * si + pi * sr + a.y; sr = nr; si = ni; }
                hr = sr; hi = si;
#pragma unroll
                for (int c = 0; c < 32; ++c) {
                    U[(size_t)c * UROW + n] = f2bf(hr); U[(size_t)c * UROW + 64 + n] = f2bf(hi);
                    const float nr = lm.x * hr - lm.y * hi + er[c], ni = lm.x * hi + lm.y * hr + ei[c]; hr = nr; hi = ni;
                }
                __syncthreads();
            }
        } else {
#pragma unroll 1
            for (int rep = 0; rep < 2; ++rep) {
                const int o = ((item - 16) * 2 + rep) * NT + tid, d = o & 63, R = (o >> 6) & 4095, kv = o >> 18;
                const bf16_t* h = (const bf16_t*)(p.ws + O_HC) + ((size_t)kv * 4096 + R) * 128;
                const float* w2 = p.in[kv ? 21 : 18];
                float a = 0.f;
#pragma unroll 8
                for (int j = 0; j < 128; ++j) a += bf2f(h[j]) * w2[j * 64 + d];
                const int bgi = R >> 9, n = R & 511;
                if (kv == 0) ((bf16_t*)(p.ws + O_KC))[(size_t)bgi * 512 * 64 + (size_t)((n >> 5) * 4 + (d >> 4)) * 512 + (((d >> 3) & 1) * 32 + (n & 31)) * 8 + (d & 7)] = f2bf(a);
                else { const int p64 = n & 63, p16 = p64 & 15, slot = (p16 & 3) | ((p16 & 4) << 1) | ((p16 & 8) >> 1);
                       ((bf16_t*)(p.ws + O_KC))[(size_t)4096 * 64 + (size_t)bgi * 64 * 512 + (size_t)(n >> 6) * 4096 + ((((d >> 5) * 2 + (p64 >> 5)) * 2 + ((p64 >> 4) & 1)) * 64 + (slot >> 3) * 32 + (d & 31)) * 8 + (slot & 7)] = f2bf(a); }
            }
        }
    }
    __syncthreads();
    convert_weights(p, smem, TR_ITEMS - TR_GU - TR_DN, TR_ITEMS, (unsigned*)(p.ws + O_CNT) + 40);
}
struct EpiY { static constexpr bool PERM = true; bf16_t* YS;
    __device__ __forceinline__ void operator()(AccRef acc, const pg8::Unit& u, int wr, int wc, int fr, int fq) const {
#pragma unroll
        for (int ai = 0; ai < 2; ++ai)
#pragma unroll
            for (int m = 0; m < 4; ++m) {
                const int r = u.pm * 256 + ai * 128 + wr * 64 + m * 16 + fr;
                const int tok0 = (r >> 8) * SEQ + (r & 255) * S5L;
#pragma unroll
                for (int bj = 0; bj < 2; ++bj) {
                    const int col = u.pn * 256 + bj * 128 + wc * 32 + 8 * fq, tau = col >> 4, pp = col & 15;
                    const f32x4 v0 = acc[ai][bj][m][0], v1 = acc[ai][bj][m][1];
                    *(u32x4*)(YS + (size_t)(tok0 + tau) * 512 + u.e * 16 + pp) = (u32x4){pk2(gelu_tanh(v0[0]), gelu_tanh(v0[1])), pk2(gelu_tanh(v0[2]), gelu_tanh(v0[3])), pk2(gelu_tanh(v1[0]), gelu_tanh(v1[1])), pk2(gelu_tanh(v1[2]), gelu_tanh(v1[3]))};
                }
            }
    } };
__device__ __forceinline__ void phase5(const Params& p, LAS unsigned char* lds) {
    BatchOrder S{(const char*)(p.ws + O_U), (const char*)(p.ws + O_TW2), (size_t)1024 * UROW * 2, (size_t)512 * UROW * 2, (size_t)256 * UROW * 2, (size_t)256 * UROW * 2, 4, 2, 256, (int)gridDim.x, (int)blockIdx.x};
    EpiY E{(bf16_t*)(p.ws + O_YS)};
    pg8::gemm_phase<EpiY, BatchOrder, false>(lds, UROW, UROW, UROW, S, E);
}
struct EpiGlu { static constexpr bool PERM = true; const float* bglu; const bf16_t* SG5; bf16_t* MS5;
    __device__ __forceinline__ void operator()(AccRef acc, const pg8::Unit& u, int wr, int wc, int fr, int fq) const {
        const int cv = u.pn * 128 + wc * 32 + 8 * fq;
        const f32x4 bv0 = *(const f32x4*)(bglu + cv), bv1 = *(const f32x4*)(bglu + cv + 4), bg0 = *(const f32x4*)(bglu + 1024 + cv), bg1 = *(const f32x4*)(bglu + 1024 + cv + 4);
#pragma unroll
        for (int ai = 0; ai < 2; ++ai)
#pragma unroll
            for (int m = 0; m < 4; ++m) {
                const int token = u.pm * 256 + ai * 128 + wr * 64 + m * 16 + fr;
                const u32x4 sg = *(const u32x4*)(SG5 + (size_t)token * 1024 + cv);
                const f32x4 va0 = acc[ai][0][m][0] + bv0, va1 = acc[ai][0][m][1] + bv1, ga0 = acc[ai][1][m][0] + bg0, ga1 = acc[ai][1][m][1] + bg1;
                u32x4 o;
                o.x = pk2(va0[0] * sigmoidf_(ga0[0]) * bflo(sg.x), va0[1] * sigmoidf_(ga0[1]) * bfhi(sg.x)); o.y = pk2(va0[2] * sigmoidf_(ga0[2]) * bflo(sg.y), va0[3] * sigmoidf_(ga0[3]) * bfhi(sg.y));
                o.z = pk2(va1[0] * sigmoidf_(ga1[0]) * bflo(sg.z), va1[1] * sigmoidf_(ga1[1]) * bfhi(sg.z)); o.w = pk2(va1[2] * sigmoidf_(ga1[2]) * bflo(sg.w), va1[3] * sigmoidf_(ga1[3]) * bfhi(sg.w));
                *(u32x4*)(MS5 + (size_t)token * 1024 + cv) = o;
            }
    } };
__device__ __forceinline__ void phase6(const Params& p, LAS unsigned char* lds) {
    pg8::DenseOrder S; S.init(p.ws + O_YS, p.ws + O_WT_GLU, NTOK, 2048, 512, 512, gridDim.x, blockIdx.x);
    EpiGlu E{p.in[15], (const bf16_t*)(p.ws + O_SG5), (bf16_t*)(p.ws + O_MS5)};
    pg8::gemm_phase<EpiGlu, pg8::DenseOrder, true>(lds, 512, 512, 512, S, E);
}
typedef float f32x16 __attribute__((ext_vector_type(16)));
__device__ __forceinline__ int rel_bucket_dev(int dist) {
    const int n = dist > 0 ? dist : 0;
    if (n < 16) return n;
    const int l = (int)(__log2f((float)n * 0.0625f) * 2.6666667f);
    const int v = 16 + l;
    return v < 31 ? v : 31;
}
__device__ __forceinline__ float xhalf_max(float v) { auto rr = __builtin_amdgcn_permlane32_swap(__float_as_uint(v), __float_as_uint(v), false, false); return fmaxf(__uint_as_float(rr[0]), __uint_as_float(rr[1])); }
__device__ __forceinline__ float xhalf_sum(float v) { auto rr = __builtin_amdgcn_permlane32_swap(__float_as_uint(v), __float_as_uint(v), false, false); return __uint_as_float(rr[0]) + __uint_as_float(rr[1]); }
__device__ __forceinline__ float quad_sum(float v) {
    v += __uint_as_float(__builtin_amdgcn_update_dpp(0u, __float_as_uint(v), 0xB1, 0xF, 0xF, true));
    v += __uint_as_float(__builtin_amdgcn_update_dpp(0u, __float_as_uint(v), 0x4E, 0xF, 0xF, true));
    return v;
}
constexpr int LSW = 1168;
constexpr int LWW = 656;
constexpr float RESC_THR = 6.f;
constexpr int IMPW = 132;
constexpr float NEG_BIG = -1e30f;

typedef int v4i_t __attribute__((ext_vector_type(4)));
typedef __amdgpu_buffer_rsrc_t rsrc_t;
__device__ __forceinline__ bf16x8 bload16(rsrc_t r, unsigned voff, unsigned soff) { return __builtin_bit_cast(bf16x8, __builtin_amdgcn_raw_buffer_load_b128(r, (int)voff, (int)soff, 0)); }
__device__ __forceinline__ void load_k(bf16x8 (&kf)[8], rsrc_t r, unsigned soff, unsigned voff) {
#pragma unroll
    for (int i = 0; i < 8; ++i) kf[i] = bload16(r, voff, soff + i * 1024);
}
__device__ __forceinline__ void load_v(bf16x8 (&vf)[8], rsrc_t r, unsigned soff, unsigned voff) {
#pragma unroll
    for (int i = 0; i < 8; ++i) vf[i] = bload16(r, voff, soff + i * 1024);
}
__device__ __forceinline__ void qk_block(f32x16 (&st)[2], const bf16x8 (&qf)[4], const bf16x8 (&kf)[8], float cinit) {
#pragma unroll
    for (int sub = 0; sub < 2; ++sub) {
        f32x16 acc;
#pragma unroll
        for (int r = 0; r < 16; ++r) acc[r] = cinit;
#pragma unroll
        for (int s = 0; s < 4; ++s) acc = __builtin_amdgcn_mfma_f32_32x32x16_bf16(kf[sub * 4 + s], qf[s], acc, 0, 0, 0);
        st[sub] = acc;
    }
}
__device__ __forceinline__ void bias_lut(f32x16 (&st)[2], const float* p) {
#pragma unroll
    for (int sub = 0; sub < 2; ++sub)
#pragma unroll
        for (int r = 0; r < 16; ++r) st[sub][r] += p[59 - (32 * sub + (r & 3) + 8 * (r >> 2))];
}
__device__ __forceinline__ void bias_mask_cmp(f32x16 (&st)[2], int dist0, const float* lutS) {
#pragma unroll
    for (int sub = 0; sub < 2; ++sub) {
        float bias[16];
#pragma unroll
        for (int r = 0; r < 16; ++r) {
            const int dist = dist0 - 16 * (32 * sub + (r & 3) + 8 * (r >> 2));
            const int idx = dist < 0 ? 0 : (dist > 1024 ? 1024 : dist);
            bias[r] = lutS[64 + idx];
        }
#pragma unroll
        for (int r = 0; r < 16; ++r) {
            const int dist = dist0 - 16 * (32 * sub + (r & 3) + 8 * (r >> 2));
            const float v = st[sub][r] + bias[r];
            st[sub][r] = dist >= 0 ? v : -INFINITY;
        }
    }
}
__device__ __forceinline__ float tile_max(const f32x16 (&st)[2]) {
    float a = __builtin_fmaxf(__builtin_fmaxf(st[0][0], st[0][1]), st[1][0]), b2 = __builtin_fmaxf(__builtin_fmaxf(st[0][2], st[0][3]), st[1][1]);
    a = __builtin_fmaxf(__builtin_fmaxf(a, st[1][2]), st[1][3]);
#pragma unroll
    for (int r = 4; r < 16; r += 4) {
        a = __builtin_fmaxf(__builtin_fmaxf(a, st[0][r]), st[0][r + 1]); b2 = __builtin_fmaxf(__builtin_fmaxf(b2, st[0][r + 2]), st[0][r + 3]);
        a = __builtin_fmaxf(__builtin_fmaxf(a, st[1][r]), st[1][r + 1]); b2 = __builtin_fmaxf(__builtin_fmaxf(b2, st[1][r + 2]), st[1][r + 3]);
    }
    return xhalf_max(__builtin_fmaxf(a, b2));
}
__device__ __forceinline__ void pv_block(f32x16 (&O)[2], const f32x16 (&st)[2], const bf16x8 (&vf)[8]) {
    bf16x8 pf[2][2];
#pragma unroll
    for (int sub = 0; sub < 2; ++sub)
#pragma unroll
        for (int s2 = 0; s2 < 2; ++s2) {
            u32x4 w;
            w.x = pk2(st[sub][8 * s2 + 0], st[sub][8 * s2 + 1]); w.y = pk2(st[sub][8 * s2 + 2], st[sub][8 * s2 + 3]);
            w.z = pk2(st[sub][8 * s2 + 4], st[sub][8 * s2 + 5]); w.w = pk2(st[sub][8 * s2 + 6], st[sub][8 * s2 + 7]);
            pf[sub][s2] = __builtin_bit_cast(bf16x8, w);
        }
#pragma unroll
    for (int dt = 0; dt < 2; ++dt)
#pragma unroll
        for (int sub = 0; sub < 2; ++sub)
#pragma unroll
            for (int s2 = 0; s2 < 2; ++s2) O[dt] = __builtin_amdgcn_mfma_f32_32x32x16_bf16(vf[dt * 4 + sub * 2 + s2], pf[sub][s2], O[dt], 0, 0, 0);
}
__device__ __forceinline__ void softmax_step(f32x16 (&st)[2], f32x16 (&O)[2], float& m, float& l) {
    const float mx = tile_max(st);
    if (__any(mx > RESC_THR)) {
        const float dl = mx > 0.f ? mx : 0.f;
        const float corr = __builtin_amdgcn_exp2f(-dl);
        m += dl; l *= corr;
#pragma unroll
        for (int sub = 0; sub < 2; ++sub)
#pragma unroll
            for (int r = 0; r < 16; ++r) st[sub][r] -= dl;
#pragma unroll
        for (int dt = 0; dt < 2; ++dt)
#pragma unroll
            for (int r = 0; r < 16; ++r) O[dt][r] *= corr;
    }
    float sum = 0.f;
#pragma unroll
    for (int sub = 0; sub < 2; ++sub)
#pragma unroll
        for (int r = 0; r < 16; ++r) { const float pe = __builtin_amdgcn_exp2f(st[sub][r]); st[sub][r] = pe; sum += pe; }
    l += sum;
}

constexpr int FLW = 68;
__device__ __forceinline__ void kv_step(f32x16 (&O)[2], float& m, float& l, const bf16x8 (&qf)[4], const bf16x8 (&kf)[8], bf16x8 (&kn)[8], rsrc_t rv, unsigned ksoff_next, unsigned koff,
                                        unsigned vsoff_blk, unsigned vvoff, const float* lutp, bool selme, float b31) {
    bf16x8 vf[8];
    load_v(vf, rv, vsoff_blk, vvoff);
    f32x16 st[2];
    qk_block(st, qf, kf, selme ? (lutp ? -m : b31 - m) : -INFINITY);
    __builtin_amdgcn_sched_barrier(0);
    load_k(kn, rv, ksoff_next, koff);
    if (lutp) bias_lut(st, lutp);
    softmax_step(st, O, m, l);
    pv_block(O, st, vf);
}

__device__ __forceinline__ void nsa_tile(const Params& p, int bg, int tg, const float* lutSall, const float* lutWall, float* impw, float* fl, int lane) {
    asm volatile("" : "+v"(lane));
    const int q = lane & 31, h2 = lane >> 5, tok = q >> 2, head = q & 3;
    const int b = bg >> 1, g = bg & 1, t0 = tg * 8, t = t0 + tok, token = b * SEQ + t;
    const float* lutS = lutSall + head * LSW;
    const float* lutW = lutWall + head * LWW;
    const float b31 = lutS[64 + 1024];
    bf16x8 qf[4];
    { const bf16_t* qp = (const bf16_t*)(p.ws + O_Q) + (size_t)token * 512 + (g * 4 + head) * 64 + 8 * h2;
#pragma unroll
      for (int s = 0; s < 4; ++s) qf[s] = *(const bf16x8*)(qp + 16 * s); }
    const float* gn = (const float*)(p.ws + O_GN) + (size_t)token * 24 + (g * 4 + head) * 3;
    float* flp = fl + q * FLW + 4 * h2;
    f32x16 O[2];
#pragma unroll
    for (int dt = 0; dt < 2; ++dt)
#pragma unroll
        for (int r = 0; r < 16; ++r) O[dt][r] = 0.f;
    const int cur = t0 >> 6;
    { const int u = head + 4 * h2;
#pragma unroll
      for (int i = 0; i < 16; ++i) impw[tok * IMPW + i * 8 + u] = 0.f; }
    WAVE_SYNC();
    bf16x8 kfA[8], kfB[8];
    const rsrc_t rKV = __builtin_amdgcn_make_buffer_rsrc((void*)(p.ws + O_KV), 0, (int)(6 * 8 * KV_SLAB * 2 + 8192), 0x00020000);
    const rsrc_t rKC = __builtin_amdgcn_make_buffer_rsrc((void*)(p.ws + O_KC), 0, (int)(2 * 4096 * 64 * 2), 0x00020000);
    const unsigned koff = (unsigned)lane * 16u, vsoff = koff;

    {
        const unsigned Kc = (unsigned)bg * 512u * 64u * 2u;
        const unsigned VcT = (4096u * 64u + (unsigned)bg * 64u * 512u) * 2u;
        const int tl = t0 + 7;
        const int ncmax = tl >= 31 ? ((tl - 31) >> 4) + 1 : 0;
        const int nblk = (ncmax + 63) >> 6;
        float m = NEG_BIG, l = 0.f;
        f32x16 st[2];
#define CMP_FAR(BLK) (16 * (64 * (BLK) + 63) + 31 + 1024 <= t0)
#define CMP_P1(KF, KN, BLK, BN) do { const bool far_ = CMP_FAR(BLK); qk_block(st, qf, KF, far_ ? b31 : 0.f); __builtin_amdgcn_sched_barrier(0); load_k(KN, rKC, Kc + (BN) * 8192, koff); \
            if (!far_) bias_mask_cmp(st, t - 31 - 16 * ((BLK) * 64 + 4 * h2), lutS); \
            const float mn = fmaxf(m, tile_max(st)); float sum = 0.f; \
            _Pragma("unroll") for (int sub = 0; sub < 2; ++sub) _Pragma("unroll") for (int r = 0; r < 16; ++r) sum += __builtin_amdgcn_exp2f(st[sub][r] - mn); \
            l = l * __builtin_amdgcn_exp2f(m - mn) + sum; m = mn; } while (0)
        if (nblk > 0) load_k(kfA, rKC, Kc, koff);
#pragma unroll 1
        for (int blk = 0; blk < nblk; blk += 2) {
            const int b1 = blk + 1 < nblk ? blk + 1 : blk;
            CMP_P1(kfA, kfB, blk, b1);
            if (blk + 1 >= nblk) break;
            const int b2 = blk + 2 < nblk ? blk + 2 : blk + 1;
            CMP_P1(kfB, kfA, blk + 1, b2);
        }
#undef CMP_P1
        l = xhalf_sum(l);
        const float invl = l > 0.f ? 1.f / l : 0.f;
#define CMP_P2(KF, KN, BLK, BN) do { const bool far_ = CMP_FAR(BLK); bf16x8 vf[8]; load_v(vf, rKC, VcT + (BLK) * 8192, koff); \
            qk_block(st, qf, KF, (far_ ? b31 : 0.f) - m); __builtin_amdgcn_sched_barrier(0); load_k(KN, rKC, Kc + (BN) * 8192, koff); \
            if (!far_) bias_mask_cmp(st, t - 31 - 16 * ((BLK) * 64 + 4 * h2), lutS); \
            _Pragma("unroll") for (int sub = 0; sub < 2; ++sub) _Pragma("unroll") for (int r = 0; r < 16; ++r) st[sub][r] = __builtin_amdgcn_exp2f(st[sub][r]) * invl; \
            _Pragma("unroll") for (int sub = 0; sub < 2; ++sub) _Pragma("unroll") for (int a = 0; a < 4; ++a) { \
                const float L_ = quad_sum(st[sub][4 * a + 3]); \
                const float G_ = quad_sum((st[sub][4 * a] + st[sub][4 * a + 1]) + (st[sub][4 * a + 2] + st[sub][4 * a + 3])); \
                const int j_ = (BLK) * 16 + 8 * sub + 2 * a + h2; \
                if (head == 0) { atomicAdd(&impw[tok * IMPW + j_], G_); if (j_ + 1 < 128) atomicAdd(&impw[tok * IMPW + j_ + 1], L_); } } \
            pv_block(O, st, vf); } while (0)
        if (nblk > 0) load_k(kfA, rKC, Kc, koff);
#pragma unroll 1
        for (int blk = 0; blk < nblk; blk += 2) {
            const int b1 = blk + 1 < nblk ? blk + 1 : blk;
            CMP_P2(kfA, kfB, blk, b1);
            if (blk + 1 >= nblk) break;
            const int b2 = blk + 2 < nblk ? blk + 2 : blk + 1;
            CMP_P2(kfB, kfA, blk + 1, b2);
        }
#undef CMP_P2
#undef CMP_FAR
        const float g0 = gn[0];
#pragma unroll
        for (int dt = 0; dt < 2; ++dt)
#pragma unroll
            for (int a = 0; a < 4; ++a) {
                *(f32x4*)(flp + dt * 32 + a * 8) = (f32x4){g0 * O[dt][4 * a], g0 * O[dt][4 * a + 1], g0 * O[dt][4 * a + 2], g0 * O[dt][4 * a + 3]};
                O[dt][4 * a] = 0.f; O[dt][4 * a + 1] = 0.f; O[dt][4 * a + 2] = 0.f; O[dt][4 * a + 3] = 0.f;
            }
    }
    WAVE_SYNC();

    unsigned long long mlo, mhi;
    if (cur < 16) { mlo = (1ull << (cur + 1)) - 1ull; mhi = 0ull; }
    else {
        const int u = head + 4 * h2;
        float val[16];
#pragma unroll
        for (int i = 0; i < 16; ++i) { const int j = i * 8 + u; val[i] = (j >= 1 && j <= cur - 2) ? impw[tok * IMPW + j] : -1.f; }
        mlo = 1ull; mhi = 0ull;
        if (cur < 64) mlo |= 1ull << cur; else mhi |= 1ull << (cur - 64);
        if (cur - 1 < 64) mlo |= 1ull << (cur - 1); else mhi |= 1ull << (cur - 1 - 64);
#pragma unroll 1
        for (int round = 0; round < 13; ++round) {
            float bs = val[0]; int bj = u;
#pragma unroll
            for (int i = 1; i < 16; ++i) { if (val[i] > bs) { bs = val[i]; bj = i * 8 + u; } }
            { const float os = __uint_as_float(__builtin_amdgcn_update_dpp(0u, __float_as_uint(bs), 0xB1, 0xF, 0xF, true)); const int oj = __builtin_amdgcn_update_dpp(0, bj, 0xB1, 0xF, 0xF, true);
              if (os > bs || (os == bs && oj < bj)) { bs = os; bj = oj; } }
            { const float os = __uint_as_float(__builtin_amdgcn_update_dpp(0u, __float_as_uint(bs), 0x4E, 0xF, 0xF, true)); const int oj = __builtin_amdgcn_update_dpp(0, bj, 0x4E, 0xF, 0xF, true);
              if (os > bs || (os == bs && oj < bj)) { bs = os; bj = oj; } }
            { const float os = __shfl_xor(bs, 32); const int oj = __shfl_xor(bj, 32);
              if (os > bs || (os == bs && oj < bj)) { bs = os; bj = oj; } }
            if (bj < 64) mlo |= 1ull << bj; else mhi |= 1ull << (bj - 64);
#pragma unroll
            for (int i = 0; i < 16; ++i) if (i * 8 + u == bj) val[i] = -2.f;
        }
    }
    unsigned long long ulo = mlo, uhi = mhi;
#pragma unroll
    for (int o = 4; o < 32; o <<= 1) { ulo |= __shfl_xor(ulo, o); uhi |= __shfl_xor(uhi, o); }
    ulo = ((unsigned long long)__builtin_amdgcn_readfirstlane((unsigned)(ulo >> 32)) << 32) | (unsigned)__builtin_amdgcn_readfirstlane((unsigned)ulo);
    uhi = ((unsigned long long)__builtin_amdgcn_readfirstlane((unsigned)(uhi >> 32)) << 32) | (unsigned)__builtin_amdgcn_readfirstlane((unsigned)uhi);

    {
        const unsigned Ks = (unsigned)((2 * 4 + b) * 2 + g) * (unsigned)(KV_SLAB * 2);
        const unsigned VsT = (unsigned)((3 * 4 + b) * 2 + g) * (unsigned)(KV_SLAB * 2);
        float m = 0.f, l = 0.f;
#define POPJ(J) do { if (ulo) { J = __builtin_ctzll(ulo); ulo &= ulo - 1ull; } else if (uhi) { J = 64 + __builtin_ctzll(uhi); uhi &= uhi - 1ull; } else J = -1; } while (0)
#define SEL_STEP(KF, KN, J, JN) do { const bool selme_ = (J) < 64 ? ((mlo >> (J)) & 1ull) : ((mhi >> ((J) - 64)) & 1ull); \
            const bool near_ = (64 * (J) + 63 + 1024 > t0); \
            kv_step(O, m, l, qf, KF, KN, rKV, Ks + (JN) * 8192, koff, VsT + (J) * 8192, vsoff, near_ ? lutS + (t - 64 * (J) - 4 * h2 + 64 - 59) : nullptr, selme_, b31); } while (0)
        int ja, jb;
        POPJ(ja);
        load_k(kfA, rKV, Ks + ja * 8192, koff);
#pragma unroll 1
        for (;;) {
            POPJ(jb);
            { const int jn = jb >= 0 ? jb : ja; SEL_STEP(kfA, kfB, ja, jn); }
            if (jb < 0) break;
            POPJ(ja);
            { const int jn = ja >= 0 ? ja : jb; SEL_STEP(kfB, kfA, jb, jn); }
            if (ja < 0) break;
        }
#undef SEL_STEP
#undef POPJ
        l = xhalf_sum(l);
        const float sc = l > 0.f ? gn[1] / l : 0.f;
#pragma unroll
        for (int dt = 0; dt < 2; ++dt)
#pragma unroll
            for (int a = 0; a < 4; ++a) {
                f32x4 f = *(const f32x4*)(flp + dt * 32 + a * 8);
                f[0] += sc * O[dt][4 * a]; f[1] += sc * O[dt][4 * a + 1]; f[2] += sc * O[dt][4 * a + 2]; f[3] += sc * O[dt][4 * a + 3];
                *(f32x4*)(flp + dt * 32 + a * 8) = f;
                O[dt][4 * a] = 0.f; O[dt][4 * a + 1] = 0.f; O[dt][4 * a + 2] = 0.f; O[dt][4 * a + 3] = 0.f;
            }
    }
    {
        const unsigned Kw = (unsigned)((4 * 4 + b) * 2 + g) * (unsigned)(KV_SLAB * 2);
        const unsigned VwT = (unsigned)((5 * 4 + b) * 2 + g) * (unsigned)(KV_SLAB * 2);
        float m = 0.f, l = 0.f;
        const int wlo = t0 - 511;
        const int r_begin = (wlo > 0 ? wlo : 0) & ~63;
        const int r_last = t0 + 7;
#define WIN_STEP(KF, KN, R0, RN) kv_step(O, m, l, qf, KF, KN, rKV, Kw + (RN) * 128, koff, VwT + (R0) * 128, vsoff, lutW + (t - (R0) - 4 * h2 + 72 - 59), true, b31)
        load_k(kfA, rKV, Kw + r_begin * 128, koff);
#pragma unroll 1
        for (int row0 = r_begin; row0 <= r_last; row0 += 128) {
            { const int rn = row0 + 64 <= r_last ? row0 + 64 : row0; WIN_STEP(kfA, kfB, row0, rn); }
            if (row0 + 64 > r_last) break;
            { const int rn = row0 + 128 <= r_last ? row0 + 128 : row0 + 64; WIN_STEP(kfB, kfA, row0 + 64, rn); }
        }
#undef WIN_STEP
        l = xhalf_sum(l);
        const float sc = l > 0.f ? gn[2] / l : 0.f;
        bf16_t* op = (bf16_t*)(p.ws + O_ONSA) + (size_t)token * 512 + (g * 4 + head) * 64 + 4 * h2;
#pragma unroll
        for (int dt = 0; dt < 2; ++dt)
#pragma unroll
            for (int a = 0; a < 4; ++a) {
                const f32x4 f = *(const f32x4*)(flp + dt * 32 + a * 8);
                *(u32x2*)(op + dt * 32 + a * 8) = (u32x2){pk2(f[0] + sc * O[dt][4 * a], f[1] + sc * O[dt][4 * a + 1]), pk2(f[2] + sc * O[dt][4 * a + 2], f[3] + sc * O[dt][4 * a + 3])};
            }
    }
    WAVE_SYNC();
}

__device__ __forceinline__ void phase7(const Params& p, unsigned char* smem) {
    const int tid = threadIdx.x, lane = tid & 63, wid = __builtin_amdgcn_readfirstlane(tid >> 6);
    float* lutS = (float*)smem;
    float* lutW = lutS + 4 * LSW;
    float* impw = lutW + 4 * LWW + wid * 8 * IMPW;
    float* fl = lutW + 4 * LWW + NWV * 8 * IMPW + wid * 32 * FLW;
    const int bg = blockIdx.x & 7, g = bg & 1;
    for (int i = tid; i < 4 * LSW; i += NT) { const int head = i / LSW, dist = i % LSW - 64;
        lutS[i] = dist < 0 ? -INFINITY : p.in[2][rel_bucket_dev(dist) * 8 + g * 4 + head] * LOG2E; }
    for (int i = tid; i < 4 * LWW; i += NT) { const int head = i / LWW, dist = i % LWW - 72;
        lutW[i] = (dist < 0 || dist >= 512) ? -INFINITY : p.in[2][rel_bucket_dev(dist) * 8 + g * 4 + head] * LOG2E; }
    __syncthreads();
    const int nblk_bg = (gridDim.x - bg + 7) >> 3;
    const int W = nblk_bg * NWV, w = (blockIdx.x >> 3) * NWV + wid;
#pragma unroll 1
    for (int round = 0; ; ++round) {
        const int idx = round * W + ((round & 1) ? (W - 1 - w) : w);
        if (idx >= 1024) break;
        nsa_tile(p, bg, 1023 - idx, lutS, lutW, impw, fl, lane);
    }
    __syncthreads();
}

struct EpiNsa { static constexpr bool PERM = true; const bf16_t* SGN; bf16_t* MS5;
    __device__ __forceinline__ void operator()(AccRef acc, const pg8::Unit& u, int wr, int wc, int fr, int fq) const {
#pragma unroll
        for (int ai = 0; ai < 2; ++ai)
#pragma unroll
            for (int m = 0; m < 4; ++m) {
                const int token = u.pm * 256 + ai * 128 + wr * 64 + m * 16 + fr;
#pragma unroll
                for (int bj = 0; bj < 2; ++bj) {
                    const int col = u.pn * 256 + bj * 128 + wc * 32 + 8 * fq;
                    const u32x4 sg = *(const u32x4*)(SGN + (size_t)token * 1024 + col);
                    const u32x4 ms = *(const u32x4*)(MS5 + (size_t)token * 1024 + col);
                    const f32x4 v0 = acc[ai][bj][m][0], v1 = acc[ai][bj][m][1];
                    u32x4 o;
                    o.x = pk2(bflo(ms.x) + bflo(sg.x) * v0[0], bfhi(ms.x) + bfhi(sg.x) * v0[1]); o.y = pk2(bflo(ms.y) + bflo(sg.y) * v0[2], bfhi(ms.y) + bfhi(sg.y) * v0[3]);
                    o.z = pk2(bflo(ms.z) + bflo(sg.z) * v1[0], bfhi(ms.z) + bfhi(sg.z) * v1[1]); o.w = pk2(bflo(ms.w) + bflo(sg.w) * v1[2], bfhi(ms.w) + bfhi(sg.w) * v1[3]);
                    *(u32x4*)(MS5 + (size_t)token * 1024 + col) = o;
                }
            }
    } };
__device__ __forceinline__ void phase8(const Params& p, LAS unsigned char* lds) {
    pg8::DenseOrder S; S.init(p.ws + O_ONSA, p.ws + O_WT_NSA, NTOK, 1024, 512, 512, gridDim.x, blockIdx.x);
    EpiNsa E{(const bf16_t*)(p.ws + O_SGN), (bf16_t*)(p.ws + O_MS5)};
    pg8::gemm_phase<EpiNsa, pg8::DenseOrder, true>(lds, 512, 512, 512, S, E);
}
struct EpiOut { static constexpr bool PERM = false; const float* x; const float* ada; float* Z1;
    __device__ __forceinline__ void operator()(AccRef acc, const pg8::Unit& u, int wr, int wc, int fr, int fq) const {
        const float* ga = ada + (u.pm >> 5) * 6144 + 2048;
#pragma unroll
        for (int ai = 0; ai < 2; ++ai)
#pragma unroll
            for (int m = 0; m < 4; ++m) {
                const int token = u.pm * 256 + ai * 128 + wr * 64 + m * 16 + fr;
#pragma unroll
                for (int bj = 0; bj < 2; ++bj)
#pragma unroll
                    for (int n = 0; n < 2; ++n) {
                        const int col = u.pn * 256 + bj * 128 + wc * 32 + n * 16 + fq * 4;
                        const f32x4 xv = *(const f32x4*)(x + (size_t)token * 1024 + col), gv = *(const f32x4*)(ga + col);
                        *(f32x4*)(Z1 + (size_t)token * 1024 + col) = xv * DN_ALPHA + gv * acc[ai][bj][m][n];
                    }
            }
    } };
__device__ __forceinline__ void phase9(const Params& p, LAS unsigned char* lds) {
    pg8::DenseOrder S; S.init(p.ws + O_MS5, p.ws + O_WT_OUT, NTOK, 1024, 1024, 1024, gridDim.x, blockIdx.x);
    EpiOut E{p.in[0], (const float*)(p.ws + O_ADA), (float*)(p.ws + O_Z1)};
    pg8::gemm_phase<EpiOut, pg8::DenseOrder, true>(lds, 1024, 1024, 1024, S, E);
}

__device__ __forceinline__ void phase10(const Params& p, unsigned char* smem) {
    const int tid = threadIdx.x, lane = tid & 63, wid = tid >> 6;
    float* hs = (float*)smem + wid * 1024;
    const float* lg = p.in[24]; const float* lb = p.in[25]; const float* wr_ = p.in[26]; const float* br_ = p.in[27];
    unsigned* cnt = (unsigned*)(p.ws + O_CNT);
    for (int item = blockIdx.x; item < NTOK / NWV; item += gridDim.x) {
        const int token = item * NWV + wid, b = token >> 13;
        float* zr = (float*)(p.ws + O_Z1) + (size_t)token * 1024;
        const float* ada = (const float*)(p.ws + O_ADA) + b * 6144;
        f32x4 v[4]; float s = 0.f;
#pragma unroll
        for (int j = 0; j < 4; ++j) { v[j] = *(const f32x4*)(zr + j * 256 + lane * 4); s += (v[j][0] + v[j][1]) + (v[j][2] + v[j][3]); }
        const float mean = wave_sum(s) * (1.f / 1024.f); float q = 0.f;
#pragma unroll
        for (int j = 0; j < 4; ++j) { v[j] = v[j] - mean; q += (v[j][0] * v[j][0] + v[j][1] * v[j][1]) + (v[j][2] * v[j][2] + v[j][3] * v[j][3]); }
        const float rstd = rsqrtf(wave_sum(q) * (1.f / 1024.f) + LN_EPS);
        unsigned char* h2 = p.ws + O_H2 + (size_t)token * 1024;
#pragma unroll
        for (int j = 0; j < 4; ++j) {
            const int c = j * 256 + lane * 4;
            const f32x4 x1 = v[j] * rstd * *(const f32x4*)(lg + c) + *(const f32x4*)(lb + c);
            *(f32x4*)(zr + c) = x1;
            const f32x4 hv = x1 * (*(const f32x4*)(ada + 4096 + c) + 1.f) + *(const f32x4*)(ada + 3072 + c);
            *(f32x4*)(hs + c) = hv;
            *(unsigned*)(h2 + c) = pk4_f8(hv[0], hv[1], hv[2], hv[3]);
        }
        WAVE_SYNC();
        const int e = lane & 31, kh = lane >> 5;
        float a = 0.f;
#pragma unroll 8
        for (int k = kh * 512; k < kh * 512 + 512; ++k) a += hs[k] * wr_[k * 32 + e];
        a += __shfl_xor(a, 32);
        a += br_[e];
        float val = a; int te[4]; float tv[4];
#pragma unroll
        for (int r = 0; r < 4; ++r) {
            float bs = val; int bj = e;
#pragma unroll
            for (int o = 1; o < 32; o <<= 1) { const float os = __shfl_xor(bs, o); const int oj = __shfl_xor(bj, o); if (os > bs || (os == bs && oj < bj)) { bs = os; bj = oj; } }
            te[r] = bj; tv[r] = bs;
            if (e == bj) val = -INFINITY;
        }
        const float e0 = 1.f, e1 = __expf(tv[1] - tv[0]), e2 = __expf(tv[2] - tv[0]), e3 = __expf(tv[3] - tv[0]);
        const float inv = 1.f / (e0 + e1 + e2 + e3);
        if (lane < 4) {
            const int ee = lane == 0 ? te[0] : (lane == 1 ? te[1] : (lane == 2 ? te[2] : te[3]));
            const float gg = (lane == 0 ? e0 : (lane == 1 ? e1 : (lane == 2 ? e2 : e3))) * inv;
            const unsigned pos = atomicAdd(cnt + ee, 1u);
            ((int*)(p.ws + O_TOPE))[token * 4 + lane] = ee;
            ((unsigned*)(p.ws + O_TOPP))[token * 4 + lane] = pos;
            ((float*)(p.ws + O_TOPG))[token * 4 + lane] = gg;
        }
        WAVE_SYNC();
    }
}

__device__ __forceinline__ void load_offsets(const Params& p, int* offs  , int* toff  ) {
    if (threadIdx.x == 0) {
        const unsigned* cnt = (const unsigned*)(p.ws + O_CNT);
        int a = 0, t = 0;
        for (int e = 0; e < 32; ++e) { offs[e] = a; toff[e] = t; const int c = (int)cnt[e]; a += c; t += (c + 255) >> 8; }
        offs[32] = a; toff[32] = t;
    }
    __syncthreads();
}
__device__ __forceinline__ void phase11(const Params& p, unsigned char* smem) {
    int* offs = (int*)(smem + LDS_TAB); int* toff = offs + 40;
    load_offsets(p, offs, toff);
    const int* tope = (const int*)(p.ws + O_TOPE); const unsigned* topp = (const unsigned*)(p.ws + O_TOPP); const float* topg = (const float*)(p.ws + O_TOPG);
    float* rowgate = (float*)(p.ws + O_ROWGATE); int* tokrow = (int*)(p.ws + O_TOKROW); int* rowtok = (int*)(p.ws + O_ROWTOK);
    for (int i = blockIdx.x * NT + threadIdx.x; i < NROWS; i += gridDim.x * NT) {
        const int R = offs[tope[i]] + (int)topp[i];
        rowgate[R] = topg[i]; tokrow[i] = R; rowtok[R] = i >> 2;
    }
    __syncthreads();
}

struct MoeOrder {
    const int* offs; const int* toff; const char* A; const char* B; const int* rowtok; size_t bsB; int nN, G, c;
    __device__ __forceinline__ bool next(int i, pg8::Unit& u) const {
        const long L = (long)i * G + c; if (L >= (long)toff[32] * nN) return false;
        const int tile = (int)L / nN, pn = (int)L % nN;
        int e = 0;
#pragma unroll 1
        while (toff[e + 1] <= tile) ++e;
        e = __builtin_amdgcn_readfirstlane(e);
        const int r0 = __builtin_amdgcn_readfirstlane(offs[e] + (tile - toff[e]) * 256);
        u.pm = r0; u.pn = pn; u.e = e; u.nvalid = __builtin_amdgcn_readfirstlane(offs[e + 1]) - r0;
        if (rowtok) { u.A = A; u.rows = rowtok + r0; const int rm = NROWS - 1 - r0; u.rmax = rm < 255 ? rm : 255; }
        else { u.A = A + (size_t)r0 * 1024; u.rows = nullptr; u.rmax = 255; }
        u.B = B + (size_t)e * bsB + (size_t)pn * 256 * 1024; return true;
    }
};
struct EpiGU { static constexpr bool PERM = true; const float* bgu; unsigned char* ACT;
    __device__ __forceinline__ void operator()(AccRef acc, const pg8::Unit& u, int wr, int wc, int fr, int fq) const {
        const int cv = u.pn * 128 + wc * 32 + 8 * fq;
        const float* bb = bgu + (size_t)u.e * 2048;
        const float ws_ = 1.f / WGU_SCALE;
        const f32x4 bg0 = *(const f32x4*)(bb + cv), bg1 = *(const f32x4*)(bb + cv + 4), bu0 = *(const f32x4*)(bb + 1024 + cv), bu1 = *(const f32x4*)(bb + 1024 + cv + 4);
#pragma unroll
        for (int ai = 0; ai < 2; ++ai)
#pragma unroll
            for (int m = 0; m < 4; ++m) {
                const int lr = ai * 128 + wr * 64 + m * 16 + fr;
                if (lr < u.nvalid) {
                    const f32x4 ga0 = acc[ai][0][m][0] * ws_ + bg0, ga1 = acc[ai][0][m][1] * ws_ + bg1, ua0 = acc[ai][1][m][0] * ws_ + bu0, ua1 = acc[ai][1][m][1] * ws_ + bu1;
                    float o[8];
#pragma unroll
                    for (int j = 0; j < 4; ++j) {
                        const float gt0 = fminf(ga0[j], 7.f), up0 = fminf(fmaxf(ua0[j], -7.f), 7.f); o[j] = (up0 + 1.f) * gt0 * sigmoidf_(1.702f * gt0);
                        const float gt1 = fminf(ga1[j], 7.f), up1 = fminf(fmaxf(ua1[j], -7.f), 7.f); o[4 + j] = (up1 + 1.f) * gt1 * sigmoidf_(1.702f * gt1);
                    }
                    *(u32x2*)(ACT + (size_t)(u.pm + lr) * 1024 + cv) = (u32x2){pk4_f8(o[0], o[1], o[2], o[3]), pk4_f8(o[4], o[5], o[6], o[7])};
                }
            }
    } };
__device__ __forceinline__ void phase12(const Params& p, unsigned char* smem, LAS unsigned char* lds) {
    int* offs = (int*)(smem + LDS_TAB); int* toff = offs + 40;
    load_offsets(p, offs, toff);
    MoeOrder S{offs, toff, (const char*)(p.ws + O_H2), (const char*)(p.ws + O_WT_GU), (const int*)(p.ws + O_ROWTOK), (size_t)2048 * 1024, 8, (int)gridDim.x, (int)blockIdx.x};
    EpiGU E{p.in[29], p.ws + O_ACT};
    pg8::gemm_phase<EpiGU, MoeOrder, true, true>(lds, 512, 512, 512, S, E);
    __syncthreads();
}
struct EpiDn { static constexpr bool PERM = true; const float* bd; const float* rowgate; bf16_t* YK;
    __device__ __forceinline__ void operator()(AccRef acc, const pg8::Unit& u, int wr, int wc, int fr, int fq) const {
        const float* bb = bd + (size_t)u.e * 1024;
#pragma unroll
        for (int ai = 0; ai < 2; ++ai)
#pragma unroll
            for (int m = 0; m < 4; ++m) {
                const int lr = ai * 128 + wr * 64 + m * 16 + fr;
                if (lr < u.nvalid) {
                    const float gw = rowgate[u.pm + lr];
#pragma unroll
                    for (int bj = 0; bj < 2; ++bj) {
                        const int col = u.pn * 256 + bj * 128 + wc * 32 + 8 * fq;
                        const f32x4 v0 = (acc[ai][bj][m][0] * (1.f / WDN_SCALE) + *(const f32x4*)(bb + col)) * gw, v1 = (acc[ai][bj][m][1] * (1.f / WDN_SCALE) + *(const f32x4*)(bb + col + 4)) * gw;
                        *(u32x4*)(YK + (size_t)(u.pm + lr) * 1024 + col) = (u32x4){pk2(v0[0], v0[1]), pk2(v0[2], v0[3]), pk2(v1[0], v1[1]), pk2(v1[2], v1[3])};
                    }
                }
            }
    } };
__device__ __forceinline__ void phase13(const Params& p, unsigned char* smem, LAS unsigned char* lds) {
    int* offs = (int*)(smem + LDS_TAB); int* toff = offs + 40;
    load_offsets(p, offs, toff);
    MoeOrder S{offs, toff, (const char*)(p.ws + O_ACT), (const char*)(p.ws + O_WT_DN), nullptr, (size_t)1024 * 1024, 4, (int)gridDim.x, (int)blockIdx.x};
    EpiDn E{p.in[31], (const float*)(p.ws + O_ROWGATE), (bf16_t*)(p.ws + O_YK)};
    pg8::gemm_phase<EpiDn, MoeOrder, true, true>(lds, 512, 512, 512, S, E);
    __syncthreads();
}

__device__ __forceinline__ void phase14(const Params& p, unsigned char*) {
    const int tid = threadIdx.x, lane = tid & 63, wid = tid >> 6;
    const float* lg = p.in[32]; const float* lb = p.in[33];
    const int* tokrow = (const int*)(p.ws + O_TOKROW);
    const bf16_t* YK = (const bf16_t*)(p.ws + O_YK);
    for (int item = blockIdx.x; item < NTOK / NWV; item += gridDim.x) {
        const int token = item * NWV + wid, b = token >> 13;
        const float* x1 = (const float*)(p.ws + O_Z1) + (size_t)token * 1024;
        const float* gf = (const float*)(p.ws + O_ADA) + b * 6144 + 5120;
        const int r0 = tokrow[token * 4 + 0], r1 = tokrow[token * 4 + 1], r2 = tokrow[token * 4 + 2], r3 = tokrow[token * 4 + 3];
        f32x4 v[4]; float s = 0.f;
#pragma unroll
        for (int j = 0; j < 4; ++j) {
            const int c = j * 256 + lane * 4;
            const u32x2 a0 = *(const u32x2*)(YK + (size_t)r0 * 1024 + c), a1 = *(const u32x2*)(YK + (size_t)r1 * 1024 + c), a2 = *(const u32x2*)(YK + (size_t)r2 * 1024 + c), a3 = *(const u32x2*)(YK + (size_t)r3 * 1024 + c);
            f32x4 y;
            y[0] = (bflo(a0.x) + bflo(a1.x)) + (bflo(a2.x) + bflo(a3.x)); y[1] = (bfhi(a0.x) + bfhi(a1.x)) + (bfhi(a2.x) + bfhi(a3.x));
            y[2] = (bflo(a0.y) + bflo(a1.y)) + (bflo(a2.y) + bflo(a3.y)); y[3] = (bfhi(a0.y) + bfhi(a1.y)) + (bfhi(a2.y) + bfhi(a3.y));
            v[j] = *(const f32x4*)(x1 + c) * DN_ALPHA + *(const f32x4*)(gf + c) * y;
            s += (v[j][0] + v[j][1]) + (v[j][2] + v[j][3]);
        }
        const float mean = wave_sum(s) * (1.f / 1024.f); float q = 0.f;
#pragma unroll
        for (int j = 0; j < 4; ++j) { v[j] = v[j] - mean; q += (v[j][0] * v[j][0] + v[j][1] * v[j][1]) + (v[j][2] * v[j][2] + v[j][3] * v[j][3]); }
        const float rstd = rsqrtf(wave_sum(q) * (1.f / 1024.f) + LN_EPS);
#pragma unroll
        for (int j = 0; j < 4; ++j) { const int c = j * 256 + lane * 4; *(f32x4*)(p.out + (size_t)token * 1024 + c) = v[j] * rstd * *(const f32x4*)(lg + c) + *(const f32x4*)(lb + c); }
    }
}

template <bool COOP>
__global__ void __launch_bounds__(NT, 2) fwd_kernel(Params p) {
    extern __shared__ __attribute__((aligned(16))) unsigned char smem[];
    LAS unsigned char* lds = (LAS unsigned char*)smem;
    const int lo = p.ph_lo, hi = p.ph_hi;
#define RUN_PHASE(k, call) if (((PH_MASK >> (k)) & 1) && lo <= (k) && (k) < hi) { _Pragma("unroll 1") for (int rep_ = 0; rep_ < 1 + ((REPEAT_MASK >> (k)) & 1); ++rep_) { if (rep_) { if (COOP) cg::this_grid().sync(); } call; } } if (COOP) { if (lo <= (k) && (k) + 1 < hi) cg::this_grid().sync(); }
    RUN_PHASE(0, phase0(p, smem))
    RUN_PHASE(1, phase1(p, smem))
    RUN_PHASE(2, phase2(p, lds))
    RUN_PHASE(3, phase3(p, lds))
    RUN_PHASE(4, phase4(p, smem))
    RUN_PHASE(5, phase5(p, lds))
    RUN_PHASE(6, phase6(p, lds))
    RUN_PHASE(7, phase7(p, smem))
    RUN_PHASE(8, phase8(p, lds))
    RUN_PHASE(9, phase9(p, lds))
    RUN_PHASE(10, phase10(p, smem))
    RUN_PHASE(11, phase11(p, smem))
    RUN_PHASE(12, phase12(p, smem, lds))
    RUN_PHASE(13, phase13(p, smem, lds))
    RUN_PHASE(14, phase14(p, smem))
#undef RUN_PHASE
}

extern "C" void kernel_launch(void* const* d_in, const int* in_sizes, int n_in, void* d_out, int out_size, void* d_ws, size_t ws_size, hipStream_t stream) {
    static int grid = 0;
    if (grid == 0) {
        if (n_in != 34 || out_size != NTOK * DM || ws_size < WS_NEED) { fprintf(stderr, "kernel_launch: unexpected problem (n_in %d, out %d, ws %zu need %zu)\n", n_in, out_size, ws_size, (size_t)WS_NEED); grid = -1; return; }
        int dev = 0, cus = 0, per_cu = 0;
        (void)hipGetDevice(&dev);
        (void)hipDeviceGetAttribute(&cus, hipDeviceAttributeMultiprocessorCount, dev);
#if ONE_LAUNCH
        (void)hipFuncSetAttribute((const void*)fwd_kernel<true>, hipFuncAttributeMaxDynamicSharedMemorySize, LDS_BYTES);
        (void)hipOccupancyMaxActiveBlocksPerMultiprocessor(&per_cu, fwd_kernel<true>, NT, LDS_BYTES);
#else
        (void)hipFuncSetAttribute((const void*)fwd_kernel<false>, hipFuncAttributeMaxDynamicSharedMemorySize, LDS_BYTES);
        (void)hipOccupancyMaxActiveBlocksPerMultiprocessor(&per_cu, fwd_kernel<false>, NT, LDS_BYTES);
#endif
        if (per_cu < 1) { fprintf(stderr, "kernel_launch: occupancy query reports %d blocks per CU\n", per_cu); per_cu = 1; }
        grid = cus * per_cu;
        fprintf(stderr, "kernel_launch: grid %d (%d CUs x %d)\n", grid, cus, per_cu);
    }
    if (grid < 0) return;
    Params p{};
    for (int i = 0; i < 34; ++i) p.in[i] = (const float*)d_in[i];
    p.out = (float*)d_out; p.ws = (unsigned char*)d_ws;
#if ONE_LAUNCH
    p.ph_lo = 0; p.ph_hi = NPHASE;
    void* args[] = {&p};
    hipError_t e = hipLaunchCooperativeKernel((void*)fwd_kernel<true>, dim3(grid), dim3(NT), args, LDS_BYTES, stream);
    if (e != hipSuccess) fprintf(stderr, "cooperative launch failed: %s (grid %d)\n", hipGetErrorString(e), grid);
#else
    for (int ph = 0; ph < NPHASE; ++ph) {
        p.ph_lo = ph; p.ph_hi = ph + 1;
        hipLaunchKernelGGL(fwd_kernel<false>, dim3(grid), dim3(NT), LDS_BYTES, stream, p);
    }
#endif
}
```

```cpp
#include <hip/hip_runtime.h>
#include <hip/hip_cooperative_groups.h>
#include <cstdio>
#include <cstdint>
namespace cg = cooperative_groups;

#ifndef PH_MASK
#define PH_MASK 0xFFFFF
#endif
#ifndef REPEAT_MASK
#define REPEAT_MASK 0
#endif
#ifndef ONE_LAUNCH
#define ONE_LAUNCH 1
#endif

#define LAS __attribute__((address_space(3)))
typedef unsigned short bf16_t;
typedef short bf16x8 __attribute__((ext_vector_type(8)));
typedef float f32x4 __attribute__((ext_vector_type(4)));
typedef float f32x2 __attribute__((ext_vector_type(2)));
typedef unsigned u32x4 __attribute__((ext_vector_type(4)));
typedef unsigned u32x2 __attribute__((ext_vector_type(2)));
typedef __bf16 bf16x2_t __attribute__((ext_vector_type(2)));

constexpr int NB = 4, SEQ = 8192, NTOK = NB * SEQ, DM = 1024;
constexpr int NIN_PAD = 4096;
constexpr int NEXP = 32, TOPK = 4, NROWS = NTOK * TOPK;
constexpr int S5L = 32;
constexpr int NCHUNK = SEQ / S5L;
constexpr int UROW = 640;
constexpr float DN_ALPHA = 1.189207115002721f;
constexpr float LN_EPS = 1e-5f;
constexpr float LOG2E = 1.4426950408889634f;
constexpr float QSCALE = 0.125f * 1.4426950408889634f;
constexpr float WGU_SCALE = 32.f, WDN_SCALE = 64.f;
constexpr int NT = 512;
constexpr int NWV = NT / 64;

constexpr size_t al256(size_t x) { return (x + 255) & ~(size_t)255; }
constexpr size_t O_ADA = 0;
constexpr size_t O_CNT = O_ADA + al256(4 * 6144 * 4);
constexpr size_t O_LAML = O_CNT + 1024;
constexpr size_t O_BIAS1 = O_LAML + al256(32 * 64 * 2 * 4);
constexpr size_t O_WT_IN = O_BIAS1 + al256(2 * 8 * 128 * 4);
constexpr size_t O_WT_GLU = O_WT_IN + al256((size_t)NIN_PAD * 1024 * 2);
constexpr size_t O_WT_NSA = O_WT_GLU + al256((size_t)2048 * 512 * 2);
constexpr size_t O_WT_OUT = O_WT_NSA + al256((size_t)1024 * 512 * 2);
constexpr size_t O_WT_C1 = O_WT_OUT + al256((size_t)1024 * 1024 * 2);
constexpr size_t O_W1T = O_WT_C1 + al256((size_t)2 * 256 * 2048 * 2);
constexpr size_t O_TW2 = O_W1T + al256((size_t)32 * 256 * 512 * 2);
constexpr size_t O_WT_GU = O_TW2 + al256((size_t)32 * 512 * 640 * 2);
constexpr size_t O_WT_DN = O_WT_GU + al256((size_t)32 * 2048 * 1024);
constexpr size_t O_H2 = O_WT_DN + al256((size_t)32 * 1024 * 1024);
constexpr size_t O_Z1 = O_H2 + al256((size_t)NTOK * 1024);
constexpr size_t O_TOPE = O_Z1 + al256((size_t)NTOK * 1024 * 4);
constexpr size_t O_TOPP = O_TOPE + al256((size_t)NROWS * 4);
constexpr size_t O_TOPG = O_TOPP + al256((size_t)NROWS * 4);
constexpr size_t O_ROWTOK = O_TOPG + al256((size_t)NROWS * 4);
constexpr size_t O_ROWGATE = O_ROWTOK + al256((size_t)(NROWS + 256) * 4);
constexpr size_t O_TOKROW = O_ROWGATE + al256((size_t)(NROWS + 256) * 4);
constexpr size_t O_OVL = O_TOKROW + al256((size_t)NROWS * 4);
constexpr size_t O_U = O_OVL;
constexpr size_t O_E = O_U + al256((size_t)32 * 1024 * UROW * 2);
constexpr size_t O_YS = O_E + al256((size_t)32 * 1024 * 128 * 4);
constexpr size_t O_Q = O_YS + al256((size_t)NTOK * 512 * 2);
constexpr size_t O_KV = O_Q + al256((size_t)NTOK * 512 * 2);
constexpr size_t KV_SLAB = (size_t)SEQ * 64;
constexpr size_t O_SG5 = O_KV + al256((size_t)6 * 8 * KV_SLAB * 2 + 8192);
constexpr size_t O_SGN = O_SG5 + al256((size_t)NTOK * 1024 * 2);
constexpr size_t O_GN = O_SGN + al256((size_t)NTOK * 1024 * 2);
constexpr size_t O_MS5 = O_GN + al256((size_t)NTOK * 24 * 4);
constexpr size_t O_ONSA = O_MS5 + al256((size_t)NTOK * 1024 * 2);
constexpr size_t O_HC = O_ONSA + al256((size_t)NTOK * 512 * 2);
constexpr size_t O_KC = O_HC + al256((size_t)2 * 4096 * 128 * 2);
constexpr size_t O_XN = O_KC + al256((size_t)2 * 4096 * 64 * 2);
constexpr size_t O_END1 = O_XN + al256((size_t)NTOK * 1024 * 2);
constexpr size_t O_ACT = O_OVL;
constexpr size_t O_YK = O_ACT + al256((size_t)(NROWS + 256) * 1024);
constexpr size_t O_END2 = O_YK + al256((size_t)(NROWS + 256) * 1024 * 2);
constexpr size_t WS_NEED = O_END1 > O_END2 ? O_END1 : O_END2;
static_assert(WS_NEED <= (size_t)1073741824, "workspace map exceeds 1 GiB");

constexpr int LDS_BYTES = 147456;
constexpr int LDS_TAB = 131072;
constexpr int NPHASE = 15;

struct Params {
    const float* in[34];
    float* out;
    unsigned char* ws;
    int ph_lo, ph_hi;
};

__device__ __forceinline__ unsigned pk2(float lo, float hi) { f32x2 v = {lo, hi}; bf16x2_t b = __builtin_convertvector(v, bf16x2_t); return __builtin_bit_cast(unsigned, b); }
__device__ __forceinline__ bf16_t f2bf(float f) { return (bf16_t)(pk2(f, 0.f) & 0xffffu); }
__device__ __forceinline__ float bf2f(bf16_t h) { return __uint_as_float(((unsigned)h) << 16); }
__device__ __forceinline__ float bflo(unsigned w) { return __uint_as_float(w << 16); }
__device__ __forceinline__ float bfhi(unsigned w) { return __uint_as_float(w & 0xffff0000u); }
__device__ __forceinline__ unsigned pk4_f8(float a, float b, float c, float d) { int w = 0; w = __builtin_amdgcn_cvt_pk_fp8_f32(a, b, w, false); w = __builtin_amdgcn_cvt_pk_fp8_f32(c, d, w, true); return (unsigned)w; }
__device__ __forceinline__ float sigmoidf_(float x) { return 1.f / (1.f + __expf(-x)); }
__device__ __forceinline__ float gelu_tanh(float x) { const float u = 0.7978845608028654f * (x + 0.044715f * x * x * x); const float e = __expf(2.f * u); return 0.5f * x * (2.f - 2.f / (e + 1.f)); }
__device__ __forceinline__ float wave_sum(float v) {
#pragma unroll
    for (int o = 1; o < 64; o <<= 1) v += __shfl_xor(v, o);
    return v;
}
#define WAVE_SYNC() do { __builtin_amdgcn_fence(__ATOMIC_RELEASE, "wavefront"); __builtin_amdgcn_wave_barrier(); __builtin_amdgcn_fence(__ATOMIC_ACQUIRE, "wavefront"); } while (0)

namespace pg8 {
typedef int v8i_t __attribute__((ext_vector_type(8)));
typedef int v4i8_t __attribute__((ext_vector_type(4)));
constexpr int BM = 256, BK = 64, HALF = 128, HTB = HALF * BK * 2, STAGE_BYTES = 8 * HTB;
__device__ __forceinline__ int lds_byte(int r, int c) { const int st = (r >> 4) * 2 + (c >> 5), rr = r & 15, cc = c & 31, ob = rr * 64 + cc * 2; return st * 1024 + (ob ^ (((ob >> 9) & 1) << 5)); }
__device__ __forceinline__ void stage_rc(int b, int& R, int& C) { const int st = b / 1024, sb = b % 1024, swz = sb ^ (((sb >> 9) & 1) << 5); R = (st >> 1) * 16 + swz / 64; C = (st & 1) * 32 + (swz % 64) / 2; }
__device__ __forceinline__ int perm32(int rho) { const int n = rho >> 4, i = rho & 15; return 8 * (i >> 2) + 4 * n + (i & 3); }
struct Unit { const char* A; const char* B; const int* rows; int pm, pn, e, nvalid, rmax; };

template <class Epi, class Sched, bool ALIGN_EPI, bool F8 = false>
__device__ __forceinline__ void gemm_phase(LAS unsigned char* lds, const int K, const int lda, const int ldb, const Sched& S, const Epi& E) {
    const int tid = threadIdx.x, wid = __builtin_amdgcn_readfirstlane(tid >> 6), lane = tid & 63, wr = wid >> 2, wc = wid & 3, fr = lane & 15, fq = lane >> 4;
    const int nt = K / BK;
    unsigned voffB[2]; int Ra[2], Ca[2];
#pragma unroll
    for (int i = 0; i < 2; ++i) { int R, C; stage_rc(tid * 16 + i * 8192, R, C); const int Rb = Epi::PERM ? ((R & ~31) + perm32(R & 31)) : R;
        Ra[i] = R; Ca[i] = C; voffB[i] = (unsigned)(Rb * ldb + C) * 2u; }
    unsigned offC[2][2], offN[2][2];
#define PG8_SETOFF(o, u) do { _Pragma("unroll") for (int h_ = 0; h_ < 2; ++h_) _Pragma("unroll") for (int i_ = 0; i_ < 2; ++i_) { \
        if ((u).rows) { int ix_ = h_ * HALF + Ra[i_]; ix_ = ix_ < (u).rmax ? ix_ : (u).rmax; o[h_][i_] = (unsigned)(u).rows[ix_] * (unsigned)(lda * 2) + (unsigned)Ca[i_] * 2u; } \
        else o[h_][i_] = (unsigned)((h_ * HALF + Ra[i_]) * lda + Ca[i_]) * 2u; } } while (0)
    const size_t kstep = (size_t)(BK * 2);
    const size_t hstepB = (size_t)HALF * ldb * 2;
    const unsigned ldsw = (unsigned)wid * 1024u;
    const int aoff = lds_byte(wr * 64 + fr, fq * 8), boff = lds_byte(wc * 32 + fr, fq * 8);
#define PG8_SA(b, h) (((b) * 2 + (h)) * HTB)
#define PG8_SB(b, h) ((4 + (b) * 2 + (h)) * HTB)
#define PG8_STAGE(bufoff, gbase, voff) do { _Pragma("unroll") for (int _i = 0; _i < 2; ++_i) \
        __builtin_amdgcn_global_load_lds((const unsigned*)((const char*)(gbase) + (voff)[_i]), (LAS unsigned*)(lds + (bufoff) + ldsw + _i * 8192), 16, 0, 0); } while (0)
#define PG8_LDA(dst, b, h) do { _Pragma("unroll") for (int m = 0; m < 4; ++m) { \
        if constexpr (F8) dst##8[m] = __builtin_shufflevector(*(const LAS v4i8_t*)(lds + PG8_SA(b, h) + aoff + m * 2048), *(const LAS v4i8_t*)(lds + PG8_SA(b, h) + aoff + m * 2048 + 1024), 0, 1, 2, 3, 4, 5, 6, 7); \
        else { _Pragma("unroll") for (int k = 0; k < 2; ++k) dst[m][k] = *(const LAS bf16x8*)(lds + PG8_SA(b, h) + aoff + m * 2048 + k * 1024); } } } while (0)
#define PG8_LDB(dst, b, h) do { _Pragma("unroll") for (int n = 0; n < 2; ++n) { \
        if constexpr (F8) dst##8[n] = __builtin_shufflevector(*(const LAS v4i8_t*)(lds + PG8_SB(b, h) + boff + n * 2048), *(const LAS v4i8_t*)(lds + PG8_SB(b, h) + boff + n * 2048 + 1024), 0, 1, 2, 3, 4, 5, 6, 7); \
        else { _Pragma("unroll") for (int k = 0; k < 2; ++k) dst[n][k] = *(const LAS bf16x8*)(lds + PG8_SB(b, h) + boff + n * 2048 + k * 1024); } } } while (0)
#define PG8_MMA(ai, bj, At, Bt) do { __builtin_amdgcn_s_setprio(1); _Pragma("unroll") for (int m = 0; m < 4; ++m) _Pragma("unroll") for (int n = 0; n < 2; ++n) { \
        if constexpr (F8) asm volatile("v_mfma_scale_f32_16x16x128_f8f6f4 %0, %1, %2, %0, %3, %3 op_sel_hi:[0,0,0]" : "+v"(acc[ai][bj][m][n]) : "v"(Bt##8[n]), "v"(At##8[m]), "v"(f8scale_));   \
        else { _Pragma("unroll") for (int k = 0; k < 2; ++k) acc[ai][bj][m][n] = __builtin_amdgcn_mfma_f32_16x16x32_bf16(Bt[n][k], At[m][k], acc[ai][bj][m][n], 0, 0, 0); } } \
        __builtin_amdgcn_s_setprio(0); } while (0)
#define PG8_WAIT_V(n) asm volatile("s_waitcnt vmcnt(" #n ")" ::: "memory")
#define PG8_WAIT_L(n) asm volatile("s_waitcnt lgkmcnt(" #n ")" ::: "memory")
#define PG8_BAR __builtin_amdgcn_s_barrier()
#define PG8_SCHED __builtin_amdgcn_sched_barrier(0)
    Unit cur, nxt; int ui = 0;
    if (!S.next(0, cur)) return;
    f32x4 acc[2][2][4][2];
#pragma unroll
    for (int a = 0; a < 2; ++a)
#pragma unroll
        for (int b = 0; b < 2; ++b)
#pragma unroll
            for (int m = 0; m < 4; ++m)
#pragma unroll
                for (int n = 0; n < 2; ++n) acc[a][b][m][n] = (f32x4){0.f, 0.f, 0.f, 0.f};
    bf16x8 At[4][2], B0[2][2], B1[2][2];
    v8i_t At8[4], B08[2], B18[2];
    const int f8scale_ = 0x7F7F7F7F;
    const char* cA = cur.A; const char* cB = cur.B;
    PG8_SETOFF(offC, cur);
    PG8_STAGE(PG8_SB(0, 0), cB, voffB); PG8_STAGE(PG8_SB(0, 1), cB + hstepB, voffB); PG8_STAGE(PG8_SA(0, 0), cA, offC[0]); PG8_STAGE(PG8_SA(0, 1), cA, offC[1]);
    if (wr == 1) PG8_BAR;
    PG8_WAIT_V(2); PG8_BAR;
    PG8_STAGE(PG8_SB(1, 0), cB + kstep, voffB); PG8_STAGE(PG8_SA(1, 0), cA + kstep, offC[0]); PG8_STAGE(PG8_SB(1, 1), cB + hstepB + kstep, voffB);
    PG8_WAIT_V(6); PG8_BAR;
    for (;;) {
        const bool has_next = S.next(ui + 1, nxt);
        const char* nA = has_next ? nxt.A : cA; const char* nB = has_next ? nxt.B : cB;
        if (has_next) { PG8_SETOFF(offN, nxt); } else { offN[0][0] = offC[0][0]; offN[0][1] = offC[0][1]; offN[1][0] = offC[1][0]; offN[1][1] = offC[1][1]; }
#pragma unroll 1
        for (int t = 0; t < nt; t += 2) {
            const bool last = (t == nt - 2);
            const char* a1 = cA + (size_t)(t + 1) * kstep;
            const char* a2 = last ? nA : cA + (size_t)(t + 2) * kstep; const char* b2 = last ? nB : cB + (size_t)(t + 2) * kstep;
            const char* a3 = a2 + kstep; const char* b3 = b2 + kstep;
            unsigned o2[2][2];
            o2[0][0] = last ? offN[0][0] : offC[0][0]; o2[0][1] = last ? offN[0][1] : offC[0][1]; o2[1][0] = last ? offN[1][0] : offC[1][0]; o2[1][1] = last ? offN[1][1] : offC[1][1];
            PG8_LDB(B0, 0, 0); PG8_LDB(B1, 0, 1); PG8_SCHED; PG8_LDA(At, 0, 0); PG8_STAGE(PG8_SA(1, 1), a1, offC[1]);
            PG8_WAIT_V(8); PG8_WAIT_L(0); PG8_BAR; PG8_MMA(0, 0, At, B0); PG8_MMA(0, 1, At, B1); PG8_BAR; PG8_SCHED;
            PG8_LDA(At, 0, 1); PG8_STAGE(PG8_SB(0, 0), b2, voffB); PG8_STAGE(PG8_SB(0, 1), b2 + hstepB, voffB); PG8_STAGE(PG8_SA(0, 0), a2, o2[0]);
            PG8_WAIT_V(8); PG8_WAIT_L(0); PG8_BAR; PG8_MMA(1, 0, At, B0); PG8_MMA(1, 1, At, B1); PG8_BAR; PG8_SCHED;
            PG8_LDB(B0, 1, 0); PG8_LDB(B1, 1, 1); PG8_SCHED; PG8_LDA(At, 1, 0); PG8_STAGE(PG8_SA(0, 1), a2, o2[1]);
            PG8_WAIT_V(8); PG8_WAIT_L(0); PG8_BAR; PG8_MMA(0, 0, At, B0); PG8_MMA(0, 1, At, B1); PG8_BAR; PG8_SCHED;
            PG8_LDA(At, 1, 1); PG8_STAGE(PG8_SB(1, 0), b3, voffB); PG8_STAGE(PG8_SB(1, 1), b3 + hstepB, voffB); PG8_STAGE(PG8_SA(1, 0), a3, o2[0]);
            PG8_WAIT_V(8); PG8_WAIT_L(0); PG8_BAR; PG8_MMA(1, 0, At, B0); PG8_MMA(1, 1, At, B1); PG8_BAR; PG8_SCHED;
        }
        if constexpr (ALIGN_EPI) { if (wr == 0) PG8_BAR; }
        if constexpr (F8) asm volatile("s_nop 15\n\ts_nop 15" ::: "memory");
        E(acc, cur, wr, wc, fr, fq);
        if (!has_next) break;
#pragma unroll
        for (int a = 0; a < 2; ++a)
#pragma unroll
            for (int b = 0; b < 2; ++b)
#pragma unroll
                for (int m = 0; m < 4; ++m)
#pragma unroll
                    for (int n = 0; n < 2; ++n) acc[a][b][m][n] = (f32x4){0.f, 0.f, 0.f, 0.f};
        cur = nxt; cA = nA; cB = nB; ++ui;
        offC[0][0] = offN[0][0]; offC[0][1] = offN[0][1]; offC[1][0] = offN[1][0]; offC[1][1] = offN[1][1];
        if constexpr (ALIGN_EPI) { if (wr == 1) PG8_BAR; }
    }
    PG8_WAIT_V(0);
    if constexpr (!ALIGN_EPI) { if (wr == 0) PG8_BAR; }
    PG8_BAR;
#undef PG8_SETOFF
#undef PG8_SA
#undef PG8_SB
#undef PG8_STAGE
#undef PG8_LDA
#undef PG8_LDB
#undef PG8_MMA
#undef PG8_WAIT_V
#undef PG8_WAIT_L
#undef PG8_BAR
#undef PG8_SCHED
}

struct DenseOrder {
    const char* A; const char* B; size_t tstepA, tstepB; int nM, nN, nwg, G, c;
    __device__ __forceinline__ void init(const void* A_, const void* B_, int M, int N, int lda, int ldb, int G_, int c_) {
        A = (const char*)A_; B = (const char*)B_; tstepA = (size_t)BM * lda * 2; tstepB = (size_t)BM * ldb * 2; nM = M / BM; nN = N / BM; nwg = nM * nN; G = G_; c = c_; }
    __device__ __forceinline__ bool next(int i, Unit& u) const {
        const long L = (long)i * G + c; if (L >= nwg) return false;
        int wgid = (int)L; { const int q = nwg / 8, r = nwg % 8, xcd = wgid % 8, off = wgid / 8; wgid = (xcd < r ? xcd * (q + 1) : r * (q + 1) + (xcd - r) * q) + off; }
        const int nig = 8 * nN, gid = wgid / nig, fm = gid * 8, gsz = (nM - fm) < 8 ? (nM - fm) : 8;
        u.pm = fm + ((wgid % nig) % gsz); u.pn = (wgid % nig) / gsz; u.e = 0; u.nvalid = 256; u.rows = nullptr; u.rmax = 255;
        u.A = A + (size_t)u.pm * tstepA; u.B = B + (size_t)u.pn * tstepB; return true;
    }
};
}

__device__ __forceinline__ int map_in(int n) { return n < 1792 ? n : (n < 3840 ? n + 24 : (n < 3864 ? 1792 + (n - 3840) : -1)); }
__device__ __forceinline__ int map_il128(int n) { const int b = n >> 7; return (b & 1) * 1024 + (b >> 1) * 128 + (n & 127); }

struct TrJob { const float* W; bf16_t* Wt; int K, Nsrc, map, kt, nt; float f8scale; };
constexpr int TR_IN = 16 * 16, TR_GLU = 8 * 8, TR_NSA = 8 * 4, TR_OUT = 16 * 4, TR_C1 = 2 * 32, TR_GU = 32 * 16 * 8, TR_DN = 32 * 16 * 4;
constexpr int TR_ITEMS = TR_IN + TR_GLU + TR_NSA + TR_OUT + TR_C1 + TR_GU + TR_DN;
__device__ __forceinline__ void tr_job(const Params& p, int r, TrJob& j) {
    unsigned char* ws = p.ws;
    if (r < TR_IN) { j = TrJob{p.in[5], (bf16_t*)(ws + O_WT_IN), 1024, 3864, 1, r / 16, r % 16, 0.f}; return; } r -= TR_IN;
    if (r < TR_GLU) { j = TrJob{p.in[14], (bf16_t*)(ws + O_WT_GLU), 512, 2048, 2, r / 8, r % 8, 0.f}; return; } r -= TR_GLU;
    if (r < TR_NSA) { j = TrJob{p.in[22], (bf16_t*)(ws + O_WT_NSA), 512, 1024, 0, r / 4, r % 4, 0.f}; return; } r -= TR_NSA;
    if (r < TR_OUT) { j = TrJob{p.in[23], (bf16_t*)(ws + O_WT_OUT), 1024, 1024, 0, r / 4, r % 4, 0.f}; return; } r -= TR_OUT;
    if (r < TR_C1) { const int kv = r / 32; j = TrJob{p.in[kv ? 20 : 17], (bf16_t*)(ws + O_WT_C1) + (size_t)kv * 256 * 2048, 2048, 128, 3, r % 32, 0, 0.f}; return; } r -= TR_C1;
    if (r < TR_GU) { const int e = r / 128, q = r % 128; j = TrJob{p.in[28] + (size_t)e * 1024 * 2048, (bf16_t*)(ws + O_WT_GU + (size_t)e * 2048 * 1024), 1024, 2048, 2, q / 8, q % 8, WGU_SCALE}; return; } r -= TR_GU;
    { const int e = r / 64, q = r % 64; j = TrJob{p.in[30] + (size_t)e * 1024 * 1024, (bf16_t*)(ws + O_WT_DN + (size_t)e * 1024 * 1024), 1024, 1024, 0, q / 4, q % 4, WDN_SCALE}; }
}
__device__ __forceinline__ void tr_load(const TrJob& j, f32x4 (&v)[8], int tid) {
    const int n4 = tid & 63, kq = tid >> 6, nd = j.nt * 256 + 4 * n4;
    const int src = j.map == 0 ? nd : (j.map == 1 ? map_in(nd) : (j.map == 2 ? map_il128(nd) : (nd < 128 ? nd : -1)));
    const float* base = j.W + (size_t)(j.kt * 64 + kq) * j.Nsrc + (src >= 0 ? src : 0);
#pragma unroll
    for (int i = 0; i < 8; ++i) v[i] = (src >= 0) ? *(const f32x4*)(base + (size_t)i * 8 * j.Nsrc) : (f32x4){0.f, 0.f, 0.f, 0.f};
}
__device__ __forceinline__ void tr_store(const TrJob& cj, const float* t, int tid) {
    if (cj.f8scale != 0.f) {
        const int n = tid & 255, kh = (tid >> 8) * 32; const float sc = cj.f8scale;
        unsigned char* d = (unsigned char*)cj.Wt + (size_t)(cj.nt * 256 + n) * cj.K + cj.kt * 64 + kh;
#pragma unroll
        for (int q = 0; q < 2; ++q) {
            const float* c = t + (kh + 16 * q) * 260 + n;
            u32x4 o;
            o.x = pk4_f8(c[0] * sc, c[260] * sc, c[2 * 260] * sc, c[3 * 260] * sc); o.y = pk4_f8(c[4 * 260] * sc, c[5 * 260] * sc, c[6 * 260] * sc, c[7 * 260] * sc);
            o.z = pk4_f8(c[8 * 260] * sc, c[9 * 260] * sc, c[10 * 260] * sc, c[11 * 260] * sc); o.w = pk4_f8(c[12 * 260] * sc, c[13 * 260] * sc, c[14 * 260] * sc, c[15 * 260] * sc);
            *(u32x4*)(d + 16 * q) = o;
        }
    } else {
        const int n = tid & 255, kh = (tid >> 8) * 32;
        bf16_t* d = cj.Wt + (size_t)(cj.nt * 256 + n) * cj.K + cj.kt * 64 + kh;
#pragma unroll
        for (int q = 0; q < 4; ++q) {
            const float* c = t + (kh + 8 * q) * 260 + n;
            u32x4 o;
            o.x = pk2(c[0], c[260]); o.y = pk2(c[2 * 260], c[3 * 260]); o.z = pk2(c[4 * 260], c[5 * 260]); o.w = pk2(c[6 * 260], c[7 * 260]);
            *(u32x4*)(d + 8 * q) = o;
        }
    }
}
__device__ __forceinline__ void convert_weights(const Params& p, unsigned char* smem, int lo, int hi, unsigned* queue) {
    float* t = (float*)smem;
    int* slot = (int*)(smem + 64 * 260 * 4);
    const int tid = threadIdx.x, n4 = tid & 63, kq = tid >> 6;
    const int G = gridDim.x;
    int ia, ib;
    if (queue) { if (tid == 0) { slot[0] = lo + (int)atomicAdd(queue, 1u); slot[1] = lo + (int)atomicAdd(queue, 1u); } __syncthreads(); ia = slot[0]; ib = slot[1]; __syncthreads(); }
    else { ia = lo + blockIdx.x; ib = ia + G; }
    if (ia >= hi) return;
    TrJob ja, jb; f32x4 va[8], vb[8];
    tr_job(p, ia, ja); tr_load(ja, va, tid);
    if (ib < hi) { tr_job(p, ib, jb); tr_load(jb, vb, tid); }
#define TR_ROUND(I, J, V) do { \
        _Pragma("unroll") for (int i = 0; i < 8; ++i) *(f32x4*)(t + (i * 8 + kq) * 260 + 4 * n4) = V[i]; \
        if (queue && tid == 0) slot[0] = lo + (int)atomicAdd(queue, 1u); \
        __syncthreads(); \
        const TrJob cj_ = J; \
        I = queue ? slot[0] : I + 2 * G; \
        if (I < hi) { tr_job(p, I, J); tr_load(J, V, tid); } \
        tr_store(cj_, t, tid); \
        __syncthreads(); } while (0)
    for (;;) {
        TR_ROUND(ia, ja, va);
        if (ib >= hi) break;
        TR_ROUND(ib, jb, vb);
        if (ia >= hi) break;
    }
#undef TR_ROUND
}

__device__ __forceinline__ void phase0(const Params& p, unsigned char* smem) {
    unsigned char* ws = p.ws;
    const int tid = threadIdx.x;
    convert_weights(p, smem, 0, TR_ITEMS - TR_GU - TR_DN, nullptr);
    constexpr int I_ADA = 96;
    constexpr int I_S5 = 32 * 33;
    constexpr int I_MISC = 17;
    constexpr int NITEM = I_ADA + I_S5 + I_MISC;
    for (int item = blockIdx.x; item < NITEM; item += gridDim.x) {
        int r = item;
        if (r < I_ADA) {
            const float* c = p.in[1]; const float* w = p.in[3]; const float* bb = p.in[4];
            const int wid = tid >> 6, lane = tid & 63, j = r * 64 + lane;
            float a0 = 0.f, a1 = 0.f, a2 = 0.f, a3 = 0.f;
#pragma unroll 4
            for (int k = wid * 128; k < wid * 128 + 128; ++k) {
                const float wv = w[(size_t)k * 6144 + j];
                const float c0 = c[k], c1 = c[1024 + k], c2 = c[2048 + k], c3 = c[3072 + k];
                a0 += c0 * sigmoidf_(c0) * wv; a1 += c1 * sigmoidf_(c1) * wv; a2 += c2 * sigmoidf_(c2) * wv; a3 += c3 * sigmoidf_(c3) * wv;
            }
            float* red = (float*)smem;
            red[(wid * 4 + 0) * 64 + lane] = a0; red[(wid * 4 + 1) * 64 + lane] = a1; red[(wid * 4 + 2) * 64 + lane] = a2; red[(wid * 4 + 3) * 64 + lane] = a3;
            __syncthreads();
            if (tid < 256) { const int b = tid >> 6; float s = 0.f;
#pragma unroll
              for (int w8 = 0; w8 < 8; ++w8) s += red[(w8 * 4 + b) * 64 + lane];
              ((float*)(ws + O_ADA))[b * 6144 + j] = s + bb[j]; }
            __syncthreads();
            continue;
        }
        r -= I_ADA;
        if (r < I_S5) {
            const int g = r / 33, dl = r % 33;
            f32x2* pw = (f32x2*)smem;
            f32x2* bbv = pw + 64;
            f32x2* ccv = bbv + 1024;
            const float dt = expf(p.in[8][g]);
            if (tid < 64) {
                const int n = tid; const double re = p.in[6][g * 64 + n], im = p.in[7][g * 64 + n];
                const double mag = exp(re * (double)dt * dl), ang = im * (double)dt * dl;
                double sn, cs; sincos(ang, &sn, &cs);
                pw[n] = (f32x2){(float)(mag * cs), (float)(mag * sn)};
                if (dl == 32) { ((f32x2*)(ws + O_LAML))[g * 64 + n] = pw[n]; }
            }
            for (int e = tid; e < 1024; e += NT) {
                const int n = e >> 4, q = e & 15;
                const double re = p.in[6][g * 64 + n], im = p.in[7][g * 64 + n];
                const double mag = exp(re * (double)dt), ang = im * (double)dt;
                double sn, cs; sincos(ang, &sn, &cs);
                const double lr = mag * cs - 1.0, li = mag * sn;
                const double den = re * re + im * im;
                const double fr_ = (lr * re + li * im) / den, fi_ = (li * re - lr * im) / den;
                const double br = p.in[9][(g * 64 + n) * 16 + q], bi = p.in[10][(g * 64 + n) * 16 + q];
                bbv[e] = (f32x2){(float)(fr_ * br - fi_ * bi), (float)(fr_ * bi + fi_ * br)};
            }
            for (int e = tid; e < 1024; e += NT) { ccv[e] = (f32x2){p.in[11][g * 1024 + e], p.in[12][g * 1024 + e]}; }
            __syncthreads();
            bf16_t* TW2 = (bf16_t*)(ws + O_TW2) + (size_t)g * 512 * UROW;
            bf16_t* W1T = (bf16_t*)(ws + O_W1T) + (size_t)g * 256 * 512;
            if (dl < 32) {
                if (tid < 256) {
                    const int pp = tid >> 4, q = tid & 15;
                    float acc = 0.f;
                    for (int n = 0; n < 64; ++n) {
                        const f32x2 cv = ccv[pp * 64 + n], pv = pw[n], bv = bbv[n * 16 + q];
                        const float xr = cv.x * pv.x - cv.y * pv.y, xi = cv.x * pv.y + cv.y * pv.x;
                        acc += xr * bv.x - xi * bv.y;
                    }
                    if (dl == 0 && pp == q) acc += p.in[13][g * 16 + pp];
                    const bf16_t kb = f2bf(acc);
                    for (int tau = dl; tau < 32; ++tau) { const int s = tau - dl; TW2[(size_t)(tau * 16 + pp) * UROW + s * 16 + q] = kb; }
                    if (dl >= 1) for (int s = dl; s < 32; ++s) { const int tau = s - dl; TW2[(size_t)(tau * 16 + pp) * UROW + s * 16 + q] = 0; }
                }
                const int s = 31 - dl;
                for (int e = tid; e < 2048; e += NT) {
                    const int c = e >> 4, qq = e & 15, n = c & 63, ri = c >> 6;
                    const f32x2 pv = pw[n], bv = bbv[n * 16 + qq];
                    const float zr = pv.x * bv.x - pv.y * bv.y, zi = pv.x * bv.y + pv.y * bv.x;
                    W1T[(size_t)c * 512 + s * 16 + qq] = f2bf(ri ? zi : zr);
                }
            } else {
                u32x4* z = (u32x4*)(W1T + (size_t)128 * 512);
                for (int e = tid; e < 128 * 512 / 8; e += NT) z[e] = (u32x4){0u, 0u, 0u, 0u};
            }
            if (dl >= 1) {
                const int tau = dl - 1;
                for (int e = tid; e < 2048; e += NT) {
                    const int pp = e >> 7, c = e & 127, n = c & 63, ri = c >> 6;
                    const f32x2 cv = ccv[pp * 64 + n], pv = pw[n];
                    const float xr = cv.x * pv.x - cv.y * pv.y, xi = cv.x * pv.y + cv.y * pv.x;
                    TW2[(size_t)(tau * 16 + pp) * UROW + 512 + c] = f2bf(ri ? -xi : xr);
                }
            }
            __syncthreads();
            continue;
        }
        r -= I_S5;
        if (r < 16) {
            const int kv = r >> 3, part = r & 7, j = tid & 127, qtr = tid >> 7;
            const float* pos = p.in[kv ? 19 : 16]; const float* w1 = p.in[kv ? 20 : 17];
            float a = 0.f;
            const int i0 = part * 256 + qtr * 64;
            for (int i = i0; i < i0 + 64; ++i) a += pos[i] * w1[(size_t)i * 128 + j];
            float* red = (float*)smem;
            red[tid] = a;
            __syncthreads();
            if (tid < 128) ((float*)(ws + O_BIAS1))[(kv * 8 + part) * 128 + tid] = (red[tid] + red[tid + 128]) + (red[tid + 256] + red[tid + 384]);
            __syncthreads();
            continue;
        }
        if (tid < 64) ((unsigned*)(ws + O_CNT))[tid] = 0u;
    }
}

__device__ __forceinline__ void phase1(const Params& p, unsigned char*) {
    const float* x = p.in[0];
    bf16_t* xn = (bf16_t*)(p.ws + O_XN);
    for (size_t i = (size_t)blockIdx.x * NT + threadIdx.x; i < (size_t)NTOK * 128; i += (size_t)gridDim.x * NT) {
        const int token = (int)(i >> 7), k = (int)(i & 127) * 8, b = token >> 13;
        const float* ada = (const float*)(p.ws + O_ADA) + b * 6144;
        const f32x4 x0 = *(const f32x4*)(x + (size_t)token * 1024 + k), x1 = *(const f32x4*)(x + (size_t)token * 1024 + k + 4);
        const f32x4 s0 = *(const f32x4*)(ada + 1024 + k), s1 = *(const f32x4*)(ada + 1024 + k + 4);
        const f32x4 h0 = *(const f32x4*)(ada + k), h1 = *(const f32x4*)(ada + k + 4);
        u32x4 o;
        o.x = pk2(x0[0] * (1.f + s0[0]) + h0[0], x0[1] * (1.f + s0[1]) + h0[1]); o.y = pk2(x0[2] * (1.f + s0[2]) + h0[2], x0[3] * (1.f + s0[3]) + h0[3]);
        o.z = pk2(x1[0] * (1.f + s1[0]) + h1[0], x1[1] * (1.f + s1[1]) + h1[1]); o.w = pk2(x1[2] * (1.f + s1[2]) + h1[2], x1[3] * (1.f + s1[3]) + h1[3]);
        *(u32x4*)(xn + (size_t)token * 1024 + k) = o;
    }
}

typedef const f32x4 (&AccRef)[2][2][4][2];
struct EpiIn {
    static constexpr bool PERM = true;
    unsigned char* ws;
    __device__ __forceinline__ void operator()(AccRef acc, const pg8::Unit& u, int wr, int wc, int fr, int fq) const {
        const int pn = u.pn;
#pragma unroll
        for (int ai = 0; ai < 2; ++ai)
#pragma unroll
            for (int m = 0; m < 4; ++m) {
                const int token = u.pm * 256 + ai * 128 + wr * 64 + m * 16 + fr;
#pragma unroll
                for (int bj = 0; bj < 2; ++bj) {
                    const int col = pn * 256 + bj * 128 + wc * 32 + 8 * fq;
                    const f32x4 v0 = acc[ai][bj][m][0], v1 = acc[ai][bj][m][1];
                    if (pn < 2) {
                        const int g = col >> 4, q = col & 15;
                        bf16_t* d = (bf16_t*)(ws + O_U) + ((size_t)(g * 1024 + (token >> 5)) * UROW + (token & 31) * 16 + q);
                        *(u32x4*)d = (u32x4){pk2(v0[0], v0[1]), pk2(v0[2], v0[3]), pk2(v1[0], v1[1]), pk2(v1[2], v1[3])};
                    } else if (pn < 4) {
                        bf16_t* d = (bf16_t*)(ws + O_Q) + (size_t)token * 512 + (col - 512);
                        *(u32x4*)d = (u32x4){pk2(v0[0] * QSCALE, v0[1] * QSCALE), pk2(v0[2] * QSCALE, v0[3] * QSCALE), pk2(v1[0] * QSCALE, v1[1] * QSCALE), pk2(v1[2] * QSCALE, v1[3] * QSCALE)};
                    } else if (pn < 7) {
                        const int c = col - 1024, j6 = c >> 7, g = (c >> 6) & 1, dd = c & 63, b = token >> 13, s = token & 8191;
                        bf16_t* slab = (bf16_t*)(ws + O_KV) + (size_t)((j6 * 4 + b) * 2 + g) * KV_SLAB;
                        if (j6 == 3 || j6 == 5) {
                            const int p64 = s & 63, p16 = p64 & 15, slot = (p16 & 3) | ((p16 & 4) << 1) | ((p16 & 8) >> 1);
                            bf16_t* blkp = slab + (size_t)(s >> 6) * 4096 + (((p64 >> 5) * 2 + ((p64 >> 4) & 1)) * 64 + (slot >> 3) * 32) * 8 + (slot & 7);
#pragma unroll
                            for (int j = 0; j < 4; ++j) { const int d0 = dd + j, d1 = dd + 4 + j;
                                blkp[((d0 >> 5) * 4 * 64 + (d0 & 31)) * 8] = f2bf(v0[j]); blkp[((d1 >> 5) * 4 * 64 + (d1 & 31)) * 8] = f2bf(v1[j]); }
                        } else if (j6 == 2 || j6 == 4) {
                            bf16_t* d = slab + (size_t)((s >> 5) * 4 + (dd >> 4)) * 512 + (((dd >> 3) & 1) * 32 + (s & 31)) * 8;
                            *(u32x4*)d = (u32x4){pk2(v0[0], v0[1]), pk2(v0[2], v0[3]), pk2(v1[0], v1[1]), pk2(v1[2], v1[3])};
                        } else {
                            *(u32x4*)(slab + (size_t)s * 64 + dd) = (u32x4){pk2(v0[0], v0[1]), pk2(v0[2], v0[3]), pk2(v1[0], v1[1]), pk2(v1[2], v1[3])};
                        }
                    } else if (pn < 15) {
                        bf16_t* d = (pn < 11 ? (bf16_t*)(ws + O_SG5) + (size_t)token * 1024 + (col - 1792) : (bf16_t*)(ws + O_SGN) + (size_t)token * 1024 + (col - 2816));
                        *(u32x4*)d = (u32x4){pk2(sigmoidf_(v0[0]), sigmoidf_(v0[1])), pk2(sigmoidf_(v0[2]), sigmoidf_(v0[3])), pk2(sigmoidf_(v1[0]), sigmoidf_(v1[1])), pk2(sigmoidf_(v1[2]), sigmoidf_(v1[3]))};
                    } else {
                        const int c = col - 3840;
                        if (c < 24) { float* d = (float*)(ws + O_GN) + (size_t)token * 24 + c;
                            *(f32x4*)d = (f32x4){sigmoidf_(v0[0]), sigmoidf_(v0[1]), sigmoidf_(v0[2]), sigmoidf_(v0[3])};
                            *(f32x4*)(d + 4) = (f32x4){sigmoidf_(v1[0]), sigmoidf_(v1[1]), sigmoidf_(v1[2]), sigmoidf_(v1[3])}; }
                    }
                }
            }
    }
};
__device__ __forceinline__ void phase2(const Params& p, LAS unsigned char* lds) {
    pg8::DenseOrder S; S.init(p.ws + O_XN, p.ws + O_WT_IN, NTOK, NIN_PAD, 1024, 1024, gridDim.x, blockIdx.x);
    EpiIn E{p.ws};
    pg8::gemm_phase<EpiIn, pg8::DenseOrder, true>(lds, 1024, 1024, 1024, S, E);
}

struct BatchOrder {
    const char* A; const char* B; size_t bsA, bsB, tstepA, tstepB; int nM, nN, nunits, G, c;
    __device__ __forceinline__ bool next(int i, pg8::Unit& u) const {
        const long L = (long)i * G + c; if (L >= nunits) return false;
        const int per = nM * nN, bt = (int)L / per, rem = (int)L % per;
        u.pm = rem / nN; u.pn = rem % nN; u.e = bt; u.nvalid = 256; u.rows = nullptr; u.rmax = 255;
        u.A = A + (size_t)bt * bsA + (size_t)u.pm * tstepA; u.B = B + (size_t)bt * bsB + (size_t)u.pn * tstepB; return true;
    }
};
struct EpiE { static constexpr bool PERM = false; float* E;
    __device__ __forceinline__ void operator()(AccRef acc, const pg8::Unit& u, int wr, int wc, int fr, int fq) const {
#pragma unroll
        for (int ai = 0; ai < 2; ++ai)
#pragma unroll
            for (int m = 0; m < 4; ++m) {
                const int r = u.pm * 256 + ai * 128 + wr * 64 + m * 16 + fr;
#pragma unroll
                for (int n = 0; n < 2; ++n) *(f32x4*)(E + ((size_t)u.e * 1024 + r) * 128 + wc * 32 + n * 16 + fq * 4) = acc[ai][0][m][n];
            }
    } };
struct EpiCmp { static constexpr bool PERM = true; const float* b1p; bf16_t* HC;
    __device__ __forceinline__ void operator()(AccRef acc, const pg8::Unit& u, int wr, int wc, int fr, int fq) const {
        const int col = wc * 32 + 8 * fq;
        f32x4 b0 = (f32x4){0.f, 0.f, 0.f, 0.f}, b1 = b0;
#pragma unroll
        for (int part = 0; part < 8; ++part) { b0 += *(const f32x4*)(b1p + (u.e * 8 + part) * 128 + col); b1 += *(const f32x4*)(b1p + (u.e * 8 + part) * 128 + col + 4); }
#pragma unroll
        for (int ai = 0; ai < 2; ++ai)
#pragma unroll
            for (int m = 0; m < 4; ++m) {
                const int R = u.pm * 256 + ai * 128 + wr * 64 + m * 16 + fr;
                const f32x4 v0 = acc[ai][0][m][0] + b0, v1 = acc[ai][0][m][1] + b1;
                *(u32x4*)(HC + ((size_t)u.e * 4096 + R) * 128 + col) = (u32x4){pk2(gelu_tanh(v0[0]), gelu_tanh(v0[1])), pk2(gelu_tanh(v0[2]), gelu_tanh(v0[3])), pk2(gelu_tanh(v1[0]), gelu_tanh(v1[1])), pk2(gelu_tanh(v1[2]), gelu_tanh(v1[3]))};
            }
    } };
__device__ __forceinline__ void phase3(const Params& p, LAS unsigned char* lds) {
    const int G = gridDim.x;
    {
        BatchOrder S{(const char*)(p.ws + O_U), (const char*)(p.ws + O_W1T), (size_t)1024 * UROW * 2, (size_t)256 * 512 * 2, (size_t)256 * UROW * 2, 0, 4, 1, 128, G, (int)blockIdx.x};
        EpiE E{(float*)(p.ws + O_E)};
        pg8::gemm_phase<EpiE, BatchOrder, false>(lds, 512, UROW, 512, S, E);
    }
    {
        BatchOrder S{(const char*)(p.ws + O_KV), (const char*)(p.ws + O_WT_C1), (size_t)8 * KV_SLAB * 2, (size_t)256 * 2048 * 2, (size_t)256 * 1024 * 2, 0, 16, 1, 32, G, (int)((blockIdx.x + G - 128 % G) % G)};
        EpiCmp E{(const float*)(p.ws + O_BIAS1), (bf16_t*)(p.ws + O_HC)};
        pg8::gemm_phase<EpiCmp, BatchOrder, false>(lds, 2048, 1024, 2048, S, E);
    }
}
__device__ __forceinline__ void phase4(const Params& p, unsigned char* smem) {
    const int tid = threadIdx.x;
    for (int item = blockIdx.x; item < 16 + 512; item += gridDim.x) {
        if (item < 16) {
            f32x2* seg = (f32x2*)smem;
#pragma unroll 1
            for (int half = 0; half < 8; ++half) {
                const int n = tid & 63, sg = tid >> 6, bg = item * 8 + half, b = bg >> 5, g = bg & 31;
                const f32x2 lm = ((const f32x2*)(p.ws + O_LAML))[g * 64 + n];
                const float* E = (const float*)(p.ws + O_E) + (size_t)(g * 1024 + b * 256 + sg * 32) * 128;
                bf16_t* U = (bf16_t*)(p.ws + O_U) + (size_t)(g * 1024 + b * 256 + sg * 32) * UROW + 512;
                float er[32], ei[32];
#pragma unroll
                for (int c = 0; c < 32; ++c) { er[c] = E[(size_t)c * 128 + n]; ei[c] = E[(size_t)c * 128 + 64 + n]; }
                float hr = 0.f, hi = 0.f;
#pragma unroll
                for (int c = 0; c < 32; ++c) { const float nr = lm.x * hr - lm.y * hi + er[c], ni = lm.x * hi + lm.y * hr + ei[c]; hr = nr; hi = ni; }
                seg[sg * 64 + n] = (f32x2){hr, hi};
                float pr = lm.x, pi = lm.y;
#pragma unroll
                for (int q = 0; q < 5; ++q) { const float nr = pr * pr - pi * pi, ni = 2.f * pr * pi; pr = nr; pi = ni; }
                __syncthreads();
                float sr = 0.f, si = 0.f;
                for (int k = 0; k < sg; ++k) { const f32x2 a = seg[k * 64 + n]; const float nr = pr * sr - pi * si + a.x, ni = pr * si + pi * sr + a.y; sr = nr; si = ni; }
                hr = sr; hi = si;
#pragma unroll
                for (int c = 0; c < 32; ++c) {
                    U[(size_t)c * UROW + n] = f2bf(hr); U[(size_t)c * UROW + 64 + n] = f2bf(hi);
                    const float nr = lm.x * hr - lm.y * hi + er[c], ni = lm.x * hi + lm.y * hr + ei[c]; hr = nr; hi = ni;
                }
                __syncthreads();
            }
        } else {
#pragma unroll 1
            for (int rep = 0; rep < 2; ++rep) {
                const int o = ((item - 16) * 2 + rep) * NT + tid, d = o & 63, R = (o >> 6) & 4095, kv = o >> 18;
                const bf16_t* h = (const bf16_t*)(p.ws + O_HC) + ((size_t)kv * 4096 + R) * 128;
                const float* w2 = p.in[kv ? 21 : 18];
                float a = 0.f;
#pragma unroll 8
                for (int j = 0; j < 128; ++j) a += bf2f(h[j]) * w2[j * 64 + d];
                const int bgi = R >> 9, n = R & 511;
                if (kv == 0) ((bf16_t*)(p.ws + O_KC))[(size_t)bgi * 512 * 64 + (size_t)((n >> 5) * 4 + (d >> 4)) * 512 + (((d >> 3) & 1) * 32 + (n & 31)) * 8 + (d & 7)] = f2bf(a);
                else { const int p64 = n & 63, p16 = p64 & 15, slot = (p16 & 3) | ((p16 & 4) << 1) | ((p16 & 8) >> 1);
                       ((bf16_t*)(p.ws + O_KC))[(size_t)4096 * 64 + (size_t)bgi * 64 * 512 + (size_t)(n >> 6) * 4096 + ((((d >> 5) * 2 + (p64 >> 5)) * 2 + ((p64 >> 4) & 1)) * 64 + (slot >> 3) * 32 + (d & 31)) * 8 + (slot & 7)] = f2bf(a); }
            }
        }
    }
    __syncthreads();
    convert_weights(p, smem, TR_ITEMS - TR_GU - TR_DN, TR_ITEMS, (unsigned*)(p.ws + O_CNT) + 40);
}
struct EpiY { static constexpr bool PERM = true; bf16_t* YS;
    __device__ __forceinline__ void operator()(AccRef acc, const pg8::Unit& u, int wr, int wc, int fr, int fq) const {
#pragma unroll
        for (int ai = 0; ai < 2; ++ai)
#pragma unroll
            for (int m = 0; m < 4; ++m) {
                const int r = u.pm * 256 + ai * 128 + wr * 64 + m * 16 + fr;
                const int tok0 = (r >> 8) * SEQ + (r & 255) * S5L;
#pragma unroll
                for (int bj = 0; bj < 2; ++bj) {
                    const int col = u.pn * 256 + bj * 128 + wc * 32 + 8 * fq, tau = col >> 4, pp = col & 15;
                    const f32x4 v0 = acc[ai][bj][m][0], v1 = acc[ai][bj][m][1];
                    *(u32x4*)(YS + (size_t)(tok0 + tau) * 512 + u.e * 16 + pp) = (u32x4){pk2(gelu_tanh(v0[0]), gelu_tanh(v0[1])), pk2(gelu_tanh(v0[2]), gelu_tanh(v0[3])), pk2(gelu_tanh(v1[0]), gelu_tanh(v1[1])), pk2(gelu_tanh(v1[2]), gelu_tanh(v1[3]))};
                }
            }
    } };
__device__ __forceinline__ void phase5(const Params& p, LAS unsigned char* lds) {
    BatchOrder S{(const char*)(p.ws + O_U), (const char*)(p.ws + O_TW2), (size_t)1024 * UROW * 2, (size_t)512 * UROW * 2, (size_t)256 * UROW * 2, (size_t)256 * UROW * 2, 4, 2, 256, (int)gridDim.x, (int)blockIdx.x};
    EpiY E{(bf16_t*)(p.ws + O_YS)};
    pg8::gemm_phase<EpiY, BatchOrder, false>(lds, UROW, UROW, UROW, S, E);
}
struct EpiGlu { static constexpr bool PERM = true; const float* bglu; const bf16_t* SG5; bf16_t* MS5;
    __device__ __forceinline__ void operator()(AccRef acc, const pg8::Unit& u, int wr, int wc, int fr, int fq) const {
        const int cv = u.pn * 128 + wc * 32 + 8 * fq;
        const f32x4 bv0 = *(const f32x4*)(bglu + cv), bv1 = *(const f32x4*)(bglu + cv + 4), bg0 = *(const f32x4*)(bglu + 1024 + cv), bg1 = *(const f32x4*)(bglu + 1024 + cv + 4);
#pragma unroll
        for (int ai = 0; ai < 2; ++ai) {
            u32x4 sgv[4];
#pragma unroll
            for (int m = 0; m < 4; ++m) sgv[m] = *(const u32x4*)(SG5 + (size_t)(u.pm * 256 + ai * 128 + wr * 64 + m * 16 + fr) * 1024 + cv);
#pragma unroll
            for (int m = 0; m < 4; ++m) {
                const int token = u.pm * 256 + ai * 128 + wr * 64 + m * 16 + fr;
                const u32x4 sg = sgv[m];
                const f32x4 va0 = acc[ai][0][m][0] + bv0, va1 = acc[ai][0][m][1] + bv1, ga0 = acc[ai][1][m][0] + bg0, ga1 = acc[ai][1][m][1] + bg1;
                u32x4 o;
                o.x = pk2(va0[0] * sigmoidf_(ga0[0]) * bflo(sg.x), va0[1] * sigmoidf_(ga0[1]) * bfhi(sg.x)); o.y = pk2(va0[2] * sigmoidf_(ga0[2]) * bflo(sg.y), va0[3] * sigmoidf_(ga0[3]) * bfhi(sg.y));
                o.z = pk2(va1[0] * sigmoidf_(ga1[0]) * bflo(sg.z), va1[1] * sigmoidf_(ga1[1]) * bfhi(sg.z)); o.w = pk2(va1[2] * sigmoidf_(ga1[2]) * bflo(sg.w), va1[3] * sigmoidf_(ga1[3]) * bfhi(sg.w));
                *(u32x4*)(MS5 + (size_t)token * 1024 + cv) = o;
            }
        }
    } };
__device__ __forceinline__ void phase6(const Params& p, LAS unsigned char* lds) {
    pg8::DenseOrder S; S.init(p.ws + O_YS, p.ws + O_WT_GLU, NTOK, 2048, 512, 512, gridDim.x, blockIdx.x);
    EpiGlu E{p.in[15], (const bf16_t*)(p.ws + O_SG5), (bf16_t*)(p.ws + O_MS5)};
    pg8::gemm_phase<EpiGlu, pg8::DenseOrder, true>(lds, 512, 512, 512, S, E);
}
typedef float f32x16 __attribute__((ext_vector_type(16)));
__device__ __forceinline__ int rel_bucket_dev(int dist) {
    const int n = dist > 0 ? dist : 0;
    if (n < 16) return n;
    const int l = (int)(__log2f((float)n * 0.0625f) * 2.6666667f);
    const int v = 16 + l;
    return v < 31 ? v : 31;
}
__device__ __forceinline__ float xhalf_max(float v) { auto rr = __builtin_amdgcn_permlane32_swap(__float_as_uint(v), __float_as_uint(v), false, false); return fmaxf(__uint_as_float(rr[0]), __uint_as_float(rr[1])); }
__device__ __forceinline__ float xhalf_sum(float v) { auto rr = __builtin_amdgcn_permlane32_swap(__float_as_uint(v), __float_as_uint(v), false, false); return __uint_as_float(rr[0]) + __uint_as_float(rr[1]); }
__device__ __forceinline__ float quad_sum(float v) {
    v += __uint_as_float(__builtin_amdgcn_update_dpp(0u, __float_as_uint(v), 0xB1, 0xF, 0xF, true));
    v += __uint_as_float(__builtin_amdgcn_update_dpp(0u, __float_as_uint(v), 0x4E, 0xF, 0xF, true));
    return v;
}
constexpr int LSW = 1168;
constexpr int LWW = 656;
constexpr float RESC_THR = 6.f;
constexpr int IMPW = 132;
constexpr float NEG_BIG = -1e30f;

typedef int v4i_t __attribute__((ext_vector_type(4)));
typedef __amdgpu_buffer_rsrc_t rsrc_t;
__device__ __forceinline__ bf16x8 bload16(rsrc_t r, unsigned voff, unsigned soff) { return __builtin_bit_cast(bf16x8, __builtin_amdgcn_raw_buffer_load_b128(r, (int)voff, (int)soff, 0)); }
__device__ __forceinline__ void load_k(bf16x8 (&kf)[8], rsrc_t r, unsigned soff, unsigned voff) {
#pragma unroll
    for (int i = 0; i < 8; ++i) kf[i] = bload16(r, voff, soff + i * 1024);
}
__device__ __forceinline__ void load_v(bf16x8 (&vf)[8], rsrc_t r, unsigned soff, unsigned voff) {
#pragma unroll
    for (int i = 0; i < 8; ++i) vf[i] = bload16(r, voff, soff + i * 1024);
}
__device__ __forceinline__ void qk_block(f32x16 (&st)[2], const bf16x8 (&qf)[4], const bf16x8 (&kf)[8], float cinit) {
#pragma unroll
    for (int sub = 0; sub < 2; ++sub) {
        f32x16 acc;
#pragma unroll
        for (int r = 0; r < 16; ++r) acc[r] = cinit;
#pragma unroll
        for (int s = 0; s < 4; ++s) acc = __builtin_amdgcn_mfma_f32_32x32x16_bf16(kf[sub * 4 + s], qf[s], acc, 0, 0, 0);
        st[sub] = acc;
    }
}
__device__ __forceinline__ void bias_lut(f32x16 (&st)[2], const float* p) {
#pragma unroll
    for (int sub = 0; sub < 2; ++sub)
#pragma unroll
        for (int r = 0; r < 16; ++r) st[sub][r] += p[59 - (32 * sub + (r & 3) + 8 * (r >> 2))];
}
__device__ __forceinline__ void bias_mask_cmp(f32x16 (&st)[2], int dist0, const float* lutS) {
#pragma unroll
    for (int sub = 0; sub < 2; ++sub) {
        float bias[16];
#pragma unroll
        for (int r = 0; r < 16; ++r) {
            const int dist = dist0 - 16 * (32 * sub + (r & 3) + 8 * (r >> 2));
            const int idx = dist < 0 ? 0 : (dist > 1024 ? 1024 : dist);
            bias[r] = lutS[64 + idx];
        }
#pragma unroll
        for (int r = 0; r < 16; ++r) {
            const int dist = dist0 - 16 * (32 * sub + (r & 3) + 8 * (r >> 2));
            const float v = st[sub][r] + bias[r];
            st[sub][r] = dist >= 0 ? v : -INFINITY;
        }
    }
}
__device__ __forceinline__ float tile_max(const f32x16 (&st)[2]) {
    float a = __builtin_fmaxf(__builtin_fmaxf(st[0][0], st[0][1]), st[1][0]), b2 = __builtin_fmaxf(__builtin_fmaxf(st[0][2], st[0][3]), st[1][1]);
    a = __builtin_fmaxf(__builtin_fmaxf(a, st[1][2]), st[1][3]);
#pragma unroll
    for (int r = 4; r < 16; r += 4) {
        a = __builtin_fmaxf(__builtin_fmaxf(a, st[0][r]), st[0][r + 1]); b2 = __builtin_fmaxf(__builtin_fmaxf(b2, st[0][r + 2]), st[0][r + 3]);
        a = __builtin_fmaxf(__builtin_fmaxf(a, st[1][r]), st[1][r + 1]); b2 = __builtin_fmaxf(__builtin_fmaxf(b2, st[1][r + 2]), st[1][r + 3]);
    }
    return xhalf_max(__builtin_fmaxf(a, b2));
}
__device__ __forceinline__ void pv_block(f32x16 (&O)[2], const f32x16 (&st)[2], const bf16x8 (&vf)[8]) {
    bf16x8 pf[2][2];
#pragma unroll
    for (int sub = 0; sub < 2; ++sub)
#pragma unroll
        for (int s2 = 0; s2 < 2; ++s2) {
            u32x4 w;
            w.x = pk2(st[sub][8 * s2 + 0], st[sub][8 * s2 + 1]); w.y = pk2(st[sub][8 * s2 + 2], st[sub][8 * s2 + 3]);
            w.z = pk2(st[sub][8 * s2 + 4], st[sub][8 * s2 + 5]); w.w = pk2(st[sub][8 * s2 + 6], st[sub][8 * s2 + 7]);
            pf[sub][s2] = __builtin_bit_cast(bf16x8, w);
        }
#pragma unroll
    for (int dt = 0; dt < 2; ++dt)
#pragma unroll
        for (int sub = 0; sub < 2; ++sub)
#pragma unroll
            for (int s2 = 0; s2 < 2; ++s2) O[dt] = __builtin_amdgcn_mfma_f32_32x32x16_bf16(vf[dt * 4 + sub * 2 + s2], pf[sub][s2], O[dt], 0, 0, 0);
}
__device__ __forceinline__ void softmax_step(f32x16 (&st)[2], f32x16 (&O)[2], float& m, float& l) {
    const float mx = tile_max(st);
    if (__any(mx > RESC_THR)) {
        const float dl = mx > 0.f ? mx : 0.f;
        const float corr = __builtin_amdgcn_exp2f(-dl);
        m += dl; l *= corr;
#pragma unroll
        for (int sub = 0; sub < 2; ++sub)
#pragma unroll
            for (int r = 0; r < 16; ++r) st[sub][r] -= dl;
#pragma unroll
        for (int dt = 0; dt < 2; ++dt)
#pragma unroll
            for (int r = 0; r < 16; ++r) O[dt][r] *= corr;
    }
    float sum = 0.f;
#pragma unroll
    for (int sub = 0; sub < 2; ++sub)
#pragma unroll
        for (int r = 0; r < 16; ++r) { const float pe = __builtin_amdgcn_exp2f(st[sub][r]); st[sub][r] = pe; sum += pe; }
    l += sum;
}

constexpr int FLW = 68;
__device__ __forceinline__ void kv_step(f32x16 (&O)[2], float& m, float& l, const bf16x8 (&qf)[4], const bf16x8 (&kf)[8], bf16x8 (&kn)[8], rsrc_t rv, unsigned ksoff_next, unsigned koff,
                                        unsigned vsoff_blk, unsigned vvoff, const float* lutp, bool selme, float b31) {
    bf16x8 vf[8];
    load_v(vf, rv, vsoff_blk, vvoff);
    f32x16 st[2];
    qk_block(st, qf, kf, selme ? (lutp ? -m : b31 - m) : -INFINITY);
    __builtin_amdgcn_sched_barrier(0);
    load_k(kn, rv, ksoff_next, koff);
    if (lutp) bias_lut(st, lutp);
    softmax_step(st, O, m, l);
    pv_block(O, st, vf);
}

__device__ __forceinline__ void nsa_tile(const Params& p, int bg, int tg, const float* lutSall, const float* lutWall, float* impw, float* fl, int lane) {
    asm volatile("" : "+v"(lane));
    const int q = lane & 31, h2 = lane >> 5, tok = q >> 2, head = q & 3;
    const int b = bg >> 1, g = bg & 1, t0 = tg * 8, t = t0 + tok, token = b * SEQ + t;
    const float* lutS = lutSall + head * LSW;
    const float* lutW = lutWall + head * LWW;
    const float b31 = lutS[64 + 1024];
    bf16x8 qf[4];
    { const bf16_t* qp = (const bf16_t*)(p.ws + O_Q) + (size_t)token * 512 + (g * 4 + head) * 64 + 8 * h2;
#pragma unroll
      for (int s = 0; s < 4; ++s) qf[s] = *(const bf16x8*)(qp + 16 * s); }
    const float* gn = (const float*)(p.ws + O_GN) + (size_t)token * 24 + (g * 4 + head) * 3;
    float* flp = fl + q * FLW + 4 * h2;
    f32x16 O[2];
#pragma unroll
    for (int dt = 0; dt < 2; ++dt)
#pragma unroll
        for (int r = 0; r < 16; ++r) O[dt][r] = 0.f;
    const int cur = t0 >> 6;
    { const int u = head + 4 * h2;
#pragma unroll
      for (int i = 0; i < 16; ++i) impw[tok * IMPW + i * 8 + u] = 0.f; }
    WAVE_SYNC();
    bf16x8 kfA[8], kfB[8];
    const rsrc_t rKV = __builtin_amdgcn_make_buffer_rsrc((void*)(p.ws + O_KV), 0, (int)(6 * 8 * KV_SLAB * 2 + 8192), 0x00020000);
    const rsrc_t rKC = __builtin_amdgcn_make_buffer_rsrc((void*)(p.ws + O_KC), 0, (int)(2 * 4096 * 64 * 2), 0x00020000);
    const unsigned koff = (unsigned)lane * 16u, vsoff = koff;

    {
        const unsigned Kc = (unsigned)bg * 512u * 64u * 2u;
        const unsigned VcT = (4096u * 64u + (unsigned)bg * 64u * 512u) * 2u;
        const int tl = t0 + 7;
        const int ncmax = tl >= 31 ? ((tl - 31) >> 4) + 1 : 0;
        const int nblk = (ncmax + 63) >> 6;
        float m = NEG_BIG, l = 0.f;
        f32x16 st[2];
#define CMP_FAR(BLK) (16 * (64 * (BLK) + 63) + 31 + 1024 <= t0)
#define CMP_P1(KF, KN, BLK, BN) do { const bool far_ = CMP_FAR(BLK); qk_block(st, qf, KF, far_ ? b31 : 0.f); __builtin_amdgcn_sched_barrier(0); load_k(KN, rKC, Kc + (BN) * 8192, koff); \
            if (!far_) bias_mask_cmp(st, t - 31 - 16 * ((BLK) * 64 + 4 * h2), lutS); \
            const float mn = fmaxf(m, tile_max(st)); float sum = 0.f; \
            _Pragma("unroll") for (int sub = 0; sub < 2; ++sub) _Pragma("unroll") for (int r = 0; r < 16; ++r) sum += __builtin_amdgcn_exp2f(st[sub][r] - mn); \
            l = l * __builtin_amdgcn_exp2f(m - mn) + sum; m = mn; } while (0)
        if (nblk > 0) load_k(kfA, rKC, Kc, koff);
#pragma unroll 1
        for (int blk = 0; blk < nblk; blk += 2) {
            const int b1 = blk + 1 < nblk ? blk + 1 : blk;
            CMP_P1(kfA, kfB, blk, b1);
            if (blk + 1 >= nblk) break;
            const int b2 = blk + 2 < nblk ? blk + 2 : blk + 1;
            CMP_P1(kfB, kfA, blk + 1, b2);
        }
#undef CMP_P1
        l = xhalf_sum(l);
        const float invl = l > 0.f ? 1.f / l : 0.f;
#define CMP_P2(KF, KN, BLK, BN) do { const bool far_ = CMP_FAR(BLK); bf16x8 vf[8]; load_v(vf, rKC, VcT + (BLK) * 8192, koff); \
            qk_block(st, qf, KF, (far_ ? b31 : 0.f) - m); __builtin_amdgcn_sched_barrier(0); load_k(KN, rKC, Kc + (BN) * 8192, koff); \
            if (!far_) bias_mask_cmp(st, t - 31 - 16 * ((BLK) * 64 + 4 * h2), lutS); \
            _Pragma("unroll") for (int sub = 0; sub < 2; ++sub) _Pragma("unroll") for (int r = 0; r < 16; ++r) st[sub][r] = __builtin_amdgcn_exp2f(st[sub][r]) * invl; \
            _Pragma("unroll") for (int sub = 0; sub < 2; ++sub) _Pragma("unroll") for (int a = 0; a < 4; ++a) { \
                const float L_ = quad_sum(st[sub][4 * a + 3]); \
                const float G_ = quad_sum((st[sub][4 * a] + st[sub][4 * a + 1]) + (st[sub][4 * a + 2] + st[sub][4 * a + 3])); \
                const int j_ = (BLK) * 16 + 8 * sub + 2 * a + h2; \
                if (head == 0) { atomicAdd(&impw[tok * IMPW + j_], G_); if (j_ + 1 < 128) atomicAdd(&impw[tok * IMPW + j_ + 1], L_); } } \
            pv_block(O, st, vf); } while (0)
        if (nblk > 0) load_k(kfA, rKC, Kc, koff);
#pragma unroll 1
        for (int blk = 0; blk < nblk; blk += 2) {
            const int b1 = blk + 1 < nblk ? blk + 1 : blk;
            CMP_P2(kfA, kfB, blk, b1);
            if (blk + 1 >= nblk) break;
            const int b2 = blk + 2 < nblk ? blk + 2 : blk + 1;
            CMP_P2(kfB, kfA, blk + 1, b2);
        }
#undef CMP_P2
#undef CMP_FAR
        const float g0 = gn[0];
#pragma unroll
        for (int dt = 0; dt < 2; ++dt)
#pragma unroll
            for (int a = 0; a < 4; ++a) {
                *(f32x4*)(flp + dt * 32 + a * 8) = (f32x4){g0 * O[dt][4 * a], g0 * O[dt][4 * a + 1], g0 * O[dt][4 * a + 2], g0 * O[dt][4 * a + 3]};
                O[dt][4 * a] = 0.f; O[dt][4 * a + 1] = 0.f; O[dt][4 * a + 2] = 0.f; O[dt][4 * a + 3] = 0.f;
            }
    }
    WAVE_SYNC();

    unsigned long long mlo, mhi;
    if (cur < 16) { mlo = (1ull << (cur + 1)) - 1ull; mhi = 0ull; }
    else {
        const int u = head + 4 * h2;
        float val[16];
#pragma unroll
        for (int i = 0; i < 16; ++i) { const int j = i * 8 + u; val[i] = (j >= 1 && j <= cur - 2) ? impw[tok * IMPW + j] : -1.f; }
        mlo = 1ull; mhi = 0ull;
        if (cur < 64) mlo |= 1ull << cur; else mhi |= 1ull << (cur - 64);
        if (cur - 1 < 64) mlo |= 1ull << (cur - 1); else mhi |= 1ull << (cur - 1 - 64);
#pragma unroll 1
        for (int round = 0; round < 13; ++round) {
            float bs = val[0]; int bj = u;
#pragma unroll
            for (int i = 1; i < 16; ++i) { if (val[i] > bs) { bs = val[i]; bj = i * 8 + u; } }
            { const float os = __uint_as_float(__builtin_amdgcn_update_dpp(0u, __float_as_uint(bs), 0xB1, 0xF, 0xF, true)); const int oj = __builtin_amdgcn_update_dpp(0, bj, 0xB1, 0xF, 0xF, true);
              if (os > bs || (os == bs && oj < bj)) { bs = os; bj = oj; } }
            { const float os = __uint_as_float(__builtin_amdgcn_update_dpp(0u, __float_as_uint(bs), 0x4E, 0xF, 0xF, true)); const int oj = __builtin_amdgcn_update_dpp(0, bj, 0x4E, 0xF, 0xF, true);
              if (os > bs || (os == bs && oj < bj)) { bs = os; bj = oj; } }
            { const float os = __shfl_xor(bs, 32); const int oj = __shfl_xor(bj, 32);
              if (os > bs || (os == bs && oj < bj)) { bs = os; bj = oj; } }
            if (bj < 64) mlo |= 1ull << bj; else mhi |= 1ull << (bj - 64);
#pragma unroll
            for (int i = 0; i < 16; ++i) if (i * 8 + u == bj) val[i] = -2.f;
        }
    }
    unsigned long long ulo = mlo, uhi = mhi;
#pragma unroll
    for (int o = 4; o < 32; o <<= 1) { ulo |= __shfl_xor(ulo, o); uhi |= __shfl_xor(uhi, o); }
    ulo = ((unsigned long long)__builtin_amdgcn_readfirstlane((unsigned)(ulo >> 32)) << 32) | (unsigned)__builtin_amdgcn_readfirstlane((unsigned)ulo);
    uhi = ((unsigned long long)__builtin_amdgcn_readfirstlane((unsigned)(uhi >> 32)) << 32) | (unsigned)__builtin_amdgcn_readfirstlane((unsigned)uhi);

    {
        const unsigned Ks = (unsigned)((2 * 4 + b) * 2 + g) * (unsigned)(KV_SLAB * 2);
        const unsigned VsT = (unsigned)((3 * 4 + b) * 2 + g) * (unsigned)(KV_SLAB * 2);
        float m = 0.f, l = 0.f;
#define POPJ(J) do { if (ulo) { J = __builtin_ctzll(ulo); ulo &= ulo - 1ull; } else if (uhi) { J = 64 + __builtin_ctzll(uhi); uhi &= uhi - 1ull; } else J = -1; } while (0)
#define SEL_STEP(KF, KN, J, JN) do { const bool selme_ = (J) < 64 ? ((mlo >> (J)) & 1ull) : ((mhi >> ((J) - 64)) & 1ull); \
            const bool near_ = (64 * (J) + 63 + 1024 > t0); \
            kv_step(O, m, l, qf, KF, KN, rKV, Ks + (JN) * 8192, koff, VsT + (J) * 8192, vsoff, near_ ? lutS + (t - 64 * (J) - 4 * h2 + 64 - 59) : nullptr, selme_, b31); } while (0)
        int ja, jb;
        POPJ(ja);
        load_k(kfA, rKV, Ks + ja * 8192, koff);
#pragma unroll 1
        for (;;) {
            POPJ(jb);
            { const int jn = jb >= 0 ? jb : ja; SEL_STEP(kfA, kfB, ja, jn); }
            if (jb < 0) break;
            POPJ(ja);
            { const int jn = ja >= 0 ? ja : jb; SEL_STEP(kfB, kfA, jb, jn); }
            if (ja < 0) break;
        }
#undef SEL_STEP
#undef POPJ
        l = xhalf_sum(l);
        const float sc = l > 0.f ? gn[1] / l : 0.f;
#pragma unroll
        for (int dt = 0; dt < 2; ++dt)
#pragma unroll
            for (int a = 0; a < 4; ++a) {
                f32x4 f = *(const f32x4*)(flp + dt * 32 + a * 8);
                f[0] += sc * O[dt][4 * a]; f[1] += sc * O[dt][4 * a + 1]; f[2] += sc * O[dt][4 * a + 2]; f[3] += sc * O[dt][4 * a + 3];
                *(f32x4*)(flp + dt * 32 + a * 8) = f;
                O[dt][4 * a] = 0.f; O[dt][4 * a + 1] = 0.f; O[dt][4 * a + 2] = 0.f; O[dt][4 * a + 3] = 0.f;
            }
    }
    {
        const unsigned Kw = (unsigned)((4 * 4 + b) * 2 + g) * (unsigned)(KV_SLAB * 2);
        const unsigned VwT = (unsigned)((5 * 4 + b) * 2 + g) * (unsigned)(KV_SLAB * 2);
        float m = 0.f, l = 0.f;
        const int wlo = t0 - 511;
        const int r_begin = (wlo > 0 ? wlo : 0) & ~63;
        const int r_last = t0 + 7;
#define WIN_STEP(KF, KN, R0, RN) kv_step(O, m, l, qf, KF, KN, rKV, Kw + (RN) * 128, koff, VwT + (R0) * 128, vsoff, lutW + (t - (R0) - 4 * h2 + 72 - 59), true, b31)
        load_k(kfA, rKV, Kw + r_begin * 128, koff);
#pragma unroll 1
        for (int row0 = r_begin; row0 <= r_last; row0 += 128) {
            { const int rn = row0 + 64 <= r_last ? row0 + 64 : row0; WIN_STEP(kfA, kfB, row0, rn); }
            if (row0 + 64 > r_last) break;
            { const int rn = row0 + 128 <= r_last ? row0 + 128 : row0 + 64; WIN_STEP(kfB, kfA, row0 + 64, rn); }
        }
#undef WIN_STEP
        l = xhalf_sum(l);
        const float sc = l > 0.f ? gn[2] / l : 0.f;
        bf16_t* op = (bf16_t*)(p.ws + O_ONSA) + (size_t)token * 512 + (g * 4 + head) * 64 + 4 * h2;
#pragma unroll
        for (int dt = 0; dt < 2; ++dt)
#pragma unroll
            for (int a = 0; a < 4; ++a) {
                const f32x4 f = *(const f32x4*)(flp + dt * 32 + a * 8);
                *(u32x2*)(op + dt * 32 + a * 8) = (u32x2){pk2(f[0] + sc * O[dt][4 * a], f[1] + sc * O[dt][4 * a + 1]), pk2(f[2] + sc * O[dt][4 * a + 2], f[3] + sc * O[dt][4 * a + 3])};
            }
    }
    WAVE_SYNC();
}

__device__ __forceinline__ void phase7(const Params& p, unsigned char* smem) {
    const int tid = threadIdx.x, lane = tid & 63, wid = __builtin_amdgcn_readfirstlane(tid >> 6);
    float* lutS = (float*)smem;
    float* lutW = lutS + 4 * LSW;
    float* impw = lutW + 4 * LWW + wid * 8 * IMPW;
    float* fl = lutW + 4 * LWW + NWV * 8 * IMPW + wid * 32 * FLW;
    const int bg = blockIdx.x & 7, g = bg & 1;
    for (int i = tid; i < 4 * LSW; i += NT) { const int head = i / LSW, dist = i % LSW - 64;
        lutS[i] = dist < 0 ? -INFINITY : p.in[2][rel_bucket_dev(dist) * 8 + g * 4 + head] * LOG2E; }
    for (int i = tid; i < 4 * LWW; i += NT) { const int head = i / LWW, dist = i % LWW - 72;
        lutW[i] = (dist < 0 || dist >= 512) ? -INFINITY : p.in[2][rel_bucket_dev(dist) * 8 + g * 4 + head] * LOG2E; }
    __syncthreads();
    const int nblk_bg = (gridDim.x - bg + 7) >> 3;
    const int W = nblk_bg * NWV, w = (blockIdx.x >> 3) * NWV + wid;
#pragma unroll 1
    for (int round = 0; ; ++round) {
        const int idx = round * W + ((round & 1) ? (W - 1 - w) : w);
        if (idx >= 1024) break;
        nsa_tile(p, bg, 1023 - idx, lutS, lutW, impw, fl, lane);
    }
    __syncthreads();
}

struct EpiNsa { static constexpr bool PERM = true; const bf16_t* SGN; bf16_t* MS5;
    __device__ __forceinline__ void operator()(AccRef acc, const pg8::Unit& u, int wr, int wc, int fr, int fq) const {
#pragma unroll
        for (int ai = 0; ai < 2; ++ai)
#pragma unroll
            for (int mh = 0; mh < 4; mh += 2) {
                u32x4 sgv[2][2], msv[2][2];
#pragma unroll
                for (int m = 0; m < 2; ++m)
#pragma unroll
                    for (int bj = 0; bj < 2; ++bj) {
                        const size_t off = (size_t)(u.pm * 256 + ai * 128 + wr * 64 + (mh + m) * 16 + fr) * 1024 + u.pn * 256 + bj * 128 + wc * 32 + 8 * fq;
                        sgv[m][bj] = *(const u32x4*)(SGN + off); msv[m][bj] = *(const u32x4*)(MS5 + off);
                    }
#pragma unroll
                for (int m = 0; m < 2; ++m)
#pragma unroll
                    for (int bj = 0; bj < 2; ++bj) {
                        const size_t off = (size_t)(u.pm * 256 + ai * 128 + wr * 64 + (mh + m) * 16 + fr) * 1024 + u.pn * 256 + bj * 128 + wc * 32 + 8 * fq;
                        const u32x4 sg = sgv[m][bj], ms = msv[m][bj];
                        const f32x4 v0 = acc[ai][bj][mh + m][0], v1 = acc[ai][bj][mh + m][1];
                        u32x4 o;
                        o.x = pk2(bflo(ms.x) + bflo(sg.x) * v0[0], bfhi(ms.x) + bfhi(sg.x) * v0[1]); o.y = pk2(bflo(ms.y) + bflo(sg.y) * v0[2], bfhi(ms.y) + bfhi(sg.y) * v0[3]);
                        o.z = pk2(bflo(ms.z) + bflo(sg.z) * v1[0], bfhi(ms.z) + bfhi(sg.z) * v1[1]); o.w = pk2(bflo(ms.w) + bflo(sg.w) * v1[2], bfhi(ms.w) + bfhi(sg.w) * v1[3]);
                        *(u32x4*)(MS5 + off) = o;
                    }
            }
    } };
__device__ __forceinline__ void phase8(const Params& p, LAS unsigned char* lds) {
    pg8::DenseOrder S; S.init(p.ws + O_ONSA, p.ws + O_WT_NSA, NTOK, 1024, 512, 512, gridDim.x, blockIdx.x);
    EpiNsa E{(const bf16_t*)(p.ws + O_SGN), (bf16_t*)(p.ws + O_MS5)};
    pg8::gemm_phase<EpiNsa, pg8::DenseOrder, true>(lds, 512, 512, 512, S, E);
}
struct EpiOut { static constexpr bool PERM = false; const float* x; const float* ada; float* Z1;
    __device__ __forceinline__ void operator()(AccRef acc, const pg8::Unit& u, int wr, int wc, int fr, int fq) const {
        const float* ga = ada + (u.pm >> 5) * 6144 + 2048;
        f32x4 gv[2][2];
#pragma unroll
        for (int bj = 0; bj < 2; ++bj)
#pragma unroll
            for (int n = 0; n < 2; ++n) gv[bj][n] = *(const f32x4*)(ga + u.pn * 256 + bj * 128 + wc * 32 + n * 16 + fq * 4);
#pragma unroll
        for (int ai = 0; ai < 2; ++ai)
#pragma unroll
            for (int mh = 0; mh < 4; mh += 2) {
                f32x4 xv[2][2][2];
#pragma unroll
                for (int m = 0; m < 2; ++m)
#pragma unroll
                    for (int bj = 0; bj < 2; ++bj)
#pragma unroll
                        for (int n = 0; n < 2; ++n) xv[m][bj][n] = *(const f32x4*)(x + (size_t)(u.pm * 256 + ai * 128 + wr * 64 + (mh + m) * 16 + fr) * 1024 + u.pn * 256 + bj * 128 + wc * 32 + n * 16 + fq * 4);
#pragma unroll
                for (int m = 0; m < 2; ++m)
#pragma unroll
                    for (int bj = 0; bj < 2; ++bj)
#pragma unroll
                        for (int n = 0; n < 2; ++n)
                            *(f32x4*)(Z1 + (size_t)(u.pm * 256 + ai * 128 + wr * 64 + (mh + m) * 16 + fr) * 1024 + u.pn * 256 + bj * 128 + wc * 32 + n * 16 + fq * 4) = xv[m][bj][n] * DN_ALPHA + gv[bj][n] * acc[ai][bj][mh + m][n];
            }
    } };
__device__ __forceinline__ void phase9(const Params& p, LAS unsigned char* lds) {
    pg8::DenseOrder S; S.init(p.ws + O_MS5, p.ws + O_WT_OUT, NTOK, 1024, 1024, 1024, gridDim.x, blockIdx.x);
    EpiOut E{p.in[0], (const float*)(p.ws + O_ADA), (float*)(p.ws + O_Z1)};
    pg8::gemm_phase<EpiOut, pg8::DenseOrder, true>(lds, 1024, 1024, 1024, S, E);
}

__device__ __forceinline__ void phase10(const Params& p, unsigned char* smem) {
    const int tid = threadIdx.x, lane = tid & 63, wid = tid >> 6;
    float* hs = (float*)smem + wid * 1024;
    const float* lg = p.in[24]; const float* lb = p.in[25]; const float* wr_ = p.in[26]; const float* br_ = p.in[27];
    unsigned* cnt = (unsigned*)(p.ws + O_CNT);
    for (int item = blockIdx.x; item < NTOK / NWV; item += gridDim.x) {
        const int token = item * NWV + wid, b = token >> 13;
        float* zr = (float*)(p.ws + O_Z1) + (size_t)token * 1024;
        const float* ada = (const float*)(p.ws + O_ADA) + b * 6144;
        f32x4 v[4]; float s = 0.f;
#pragma unroll
        for (int j = 0; j < 4; ++j) { v[j] = *(const f32x4*)(zr + j * 256 + lane * 4); s += (v[j][0] + v[j][1]) + (v[j][2] + v[j][3]); }
        const float mean = wave_sum(s) * (1.f / 1024.f); float q = 0.f;
#pragma unroll
        for (int j = 0; j < 4; ++j) { v[j] = v[j] - mean; q += (v[j][0] * v[j][0] + v[j][1] * v[j][1]) + (v[j][2] * v[j][2] + v[j][3] * v[j][3]); }
        const float rstd = rsqrtf(wave_sum(q) * (1.f / 1024.f) + LN_EPS);
        unsigned char* h2 = p.ws + O_H2 + (size_t)token * 1024;
#pragma unroll
        for (int j = 0; j < 4; ++j) {
            const int c = j * 256 + lane * 4;
            const f32x4 x1 = v[j] * rstd * *(const f32x4*)(lg + c) + *(const f32x4*)(lb + c);
            *(f32x4*)(zr + c) = x1;
            const f32x4 hv = x1 * (*(const f32x4*)(ada + 4096 + c) + 1.f) + *(const f32x4*)(ada + 3072 + c);
            *(f32x4*)(hs + c) = hv;
            *(unsigned*)(h2 + c) = pk4_f8(hv[0], hv[1], hv[2], hv[3]);
        }
        WAVE_SYNC();
        const int e = lane & 31, kh = lane >> 5;
        float a = 0.f;
#pragma unroll 8
        for (int k = kh * 512; k < kh * 512 + 512; ++k) a += hs[k] * wr_[k * 32 + e];
        a += __shfl_xor(a, 32);
        a += br_[e];
        float val = a; int te[4]; float tv[4];
#pragma unroll
        for (int r = 0; r < 4; ++r) {
            float bs = val; int bj = e;
#pragma unroll
            for (int o = 1; o < 32; o <<= 1) { const float os = __shfl_xor(bs, o); const int oj = __shfl_xor(bj, o); if (os > bs || (os == bs && oj < bj)) { bs = os; bj = oj; } }
            te[r] = bj; tv[r] = bs;
            if (e == bj) val = -INFINITY;
        }
        const float e0 = 1.f, e1 = __expf(tv[1] - tv[0]), e2 = __expf(tv[2] - tv[0]), e3 = __expf(tv[3] - tv[0]);
        const float inv = 1.f / (e0 + e1 + e2 + e3);
        if (lane < 4) {
            const int ee = lane == 0 ? te[0] : (lane == 1 ? te[1] : (lane == 2 ? te[2] : te[3]));
            const float gg = (lane == 0 ? e0 : (lane == 1 ? e1 : (lane == 2 ? e2 : e3))) * inv;
            const unsigned pos = atomicAdd(cnt + ee, 1u);
            ((int*)(p.ws + O_TOPE))[token * 4 + lane] = ee;
            ((unsigned*)(p.ws + O_TOPP))[token * 4 + lane] = pos;
            ((float*)(p.ws + O_TOPG))[token * 4 + lane] = gg;
        }
        WAVE_SYNC();
    }
}

__device__ __forceinline__ void load_offsets(const Params& p, int* offs  , int* toff  ) {
    if (threadIdx.x == 0) {
        const unsigned* cnt = (const unsigned*)(p.ws + O_CNT);
        int a = 0, t = 0;
        for (int e = 0; e < 32; ++e) { offs[e] = a; toff[e] = t; const int c = (int)cnt[e]; a += c; t += (c + 255) >> 8; }
        offs[32] = a; toff[32] = t;
    }
    __syncthreads();
}
__device__ __forceinline__ void phase11(const Params& p, unsigned char* smem) {
    int* offs = (int*)(smem + LDS_TAB); int* toff = offs + 40;
    load_offsets(p, offs, toff);
    const int* tope = (const int*)(p.ws + O_TOPE); const unsigned* topp = (const unsigned*)(p.ws + O_TOPP); const float* topg = (const float*)(p.ws + O_TOPG);
    float* rowgate = (float*)(p.ws + O_ROWGATE); int* tokrow = (int*)(p.ws + O_TOKROW); int* rowtok = (int*)(p.ws + O_ROWTOK);
    for (int i = blockIdx.x * NT + threadIdx.x; i < NROWS; i += gridDim.x * NT) {
        const int R = offs[tope[i]] + (int)topp[i];
        rowgate[R] = topg[i]; tokrow[i] = R; rowtok[R] = i >> 2;
    }
    __syncthreads();
}

struct MoeOrder {
    const int* offs; const int* toff; const char* A; const char* B; const int* rowtok; size_t bsB; int nN, G, c;
    __device__ __forceinline__ bool next(int i, pg8::Unit& u) const {
        const int v = (G % 8 == 0) ? (c % 8) * (G / 8) + c / 8 : c;
        const long L = (long)i * G + v; if (L >= (long)toff[32] * nN) return false;
        const int tile = (int)L / nN, pn = (int)L % nN;
        int e = 0;
#pragma unroll 1
        while (toff[e + 1] <= tile) ++e;
        e = __builtin_amdgcn_readfirstlane(e);
        const int r0 = __builtin_amdgcn_readfirstlane(offs[e] + (tile - toff[e]) * 256);
        u.pm = r0; u.pn = pn; u.e = e; u.nvalid = __builtin_amdgcn_readfirstlane(offs[e + 1]) - r0;
        if (rowtok) { u.A = A; u.rows = rowtok + r0; const int rm = NROWS - 1 - r0; u.rmax = rm < 255 ? rm : 255; }
        else { u.A = A + (size_t)r0 * 1024; u.rows = nullptr; u.rmax = 255; }
        u.B = B + (size_t)e * bsB + (size_t)pn * 256 * 1024; return true;
    }
};
struct EpiGU { static constexpr bool PERM = true; const float* bgu; unsigned char* ACT;
    __device__ __forceinline__ void operator()(AccRef acc, const pg8::Unit& u, int wr, int wc, int fr, int fq) const {
        const int cv = u.pn * 128 + wc * 32 + 8 * fq;
        const float* bb = bgu + (size_t)u.e * 2048;
        const float ws_ = 1.f / WGU_SCALE;
        const f32x4 bg0 = *(const f32x4*)(bb + cv), bg1 = *(const f32x4*)(bb + cv + 4), bu0 = *(const f32x4*)(bb + 1024 + cv), bu1 = *(const f32x4*)(bb + 1024 + cv + 4);
#pragma unroll
        for (int ai = 0; ai < 2; ++ai)
#pragma unroll
            for (int m = 0; m < 4; ++m) {
                const int lr = ai * 128 + wr * 64 + m * 16 + fr;
                const int row = lr < u.nvalid ? u.pm + lr : NROWS + lr;
                const f32x4 ga0 = acc[ai][0][m][0] * ws_ + bg0, ga1 = acc[ai][0][m][1] * ws_ + bg1, ua0 = acc[ai][1][m][0] * ws_ + bu0, ua1 = acc[ai][1][m][1] * ws_ + bu1;
                float o[8];
#pragma unroll
                for (int j = 0; j < 4; ++j) {
                    const float gt0 = fminf(ga0[j], 7.f), up0 = fminf(fmaxf(ua0[j], -7.f), 7.f); o[j] = (up0 + 1.f) * gt0 * sigmoidf_(1.702f * gt0);
                    const float gt1 = fminf(ga1[j], 7.f), up1 = fminf(fmaxf(ua1[j], -7.f), 7.f); o[4 + j] = (up1 + 1.f) * gt1 * sigmoidf_(1.702f * gt1);
                }
                *(u32x2*)(ACT + (size_t)row * 1024 + cv) = (u32x2){pk4_f8(o[0], o[1], o[2], o[3]), pk4_f8(o[4], o[5], o[6], o[7])};
            }
    } };
__device__ __forceinline__ void phase12(const Params& p, unsigned char* smem, LAS unsigned char* lds) {
    int* offs = (int*)(smem + LDS_TAB); int* toff = offs + 40;
    load_offsets(p, offs, toff);
    MoeOrder S{offs, toff, (const char*)(p.ws + O_H2), (const char*)(p.ws + O_WT_GU), (const int*)(p.ws + O_ROWTOK), (size_t)2048 * 1024, 8, (int)gridDim.x, (int)blockIdx.x};
    EpiGU E{p.in[29], p.ws + O_ACT};
    pg8::gemm_phase<EpiGU, MoeOrder, true, true>(lds, 512, 512, 512, S, E);
    __syncthreads();
}
struct EpiDn { static constexpr bool PERM = true; const float* bd; const float* rowgate; bf16_t* YK;
    __device__ __forceinline__ void operator()(AccRef acc, const pg8::Unit& u, int wr, int wc, int fr, int fq) const {
        const float* bb = bd + (size_t)u.e * 1024;
        f32x4 bv[2][2]; float gw[2][4];
#pragma unroll
        for (int bj = 0; bj < 2; ++bj) { const int col = u.pn * 256 + bj * 128 + wc * 32 + 8 * fq; bv[bj][0] = *(const f32x4*)(bb + col); bv[bj][1] = *(const f32x4*)(bb + col + 4); }
#pragma unroll
        for (int ai = 0; ai < 2; ++ai)
#pragma unroll
            for (int m = 0; m < 4; ++m) gw[ai][m] = rowgate[u.pm + ai * 128 + wr * 64 + m * 16 + fr];
#pragma unroll
        for (int ai = 0; ai < 2; ++ai)
#pragma unroll
            for (int m = 0; m < 4; ++m) {
                const int lr = ai * 128 + wr * 64 + m * 16 + fr;
                const int row = lr < u.nvalid ? u.pm + lr : NROWS + lr;
#pragma unroll
                for (int bj = 0; bj < 2; ++bj) {
                    const int col = u.pn * 256 + bj * 128 + wc * 32 + 8 * fq;
                    const f32x4 v0 = (acc[ai][bj][m][0] * (1.f / WDN_SCALE) + bv[bj][0]) * gw[ai][m], v1 = (acc[ai][bj][m][1] * (1.f / WDN_SCALE) + bv[bj][1]) * gw[ai][m];
                    *(u32x4*)(YK + (size_t)row * 1024 + col) = (u32x4){pk2(v0[0], v0[1]), pk2(v0[2], v0[3]), pk2(v1[0], v1[1]), pk2(v1[2], v1[3])};
                }
            }
    } };
__device__ __forceinline__ void phase13(const Params& p, unsigned char* smem, LAS unsigned char* lds) {
    int* offs = (int*)(smem + LDS_TAB); int* toff = offs + 40;
    load_offsets(p, offs, toff);
    MoeOrder S{offs, toff, (const char*)(p.ws + O_ACT), (const char*)(p.ws + O_WT_DN), nullptr, (size_t)1024 * 1024, 4, (int)gridDim.x, (int)blockIdx.x};
    EpiDn E{p.in[31], (const float*)(p.ws + O_ROWGATE), (bf16_t*)(p.ws + O_YK)};
    pg8::gemm_phase<EpiDn, MoeOrder, true, true>(lds, 512, 512, 512, S, E);
    __syncthreads();
}

__device__ __forceinline__ void phase14(const Params& p, unsigned char*) {
    const int tid = threadIdx.x, lane = tid & 63, wid = tid >> 6;
    const float* lg = p.in[32]; const float* lb = p.in[33];
    const int* tokrow = (const int*)(p.ws + O_TOKROW);
    const bf16_t* YK = (const bf16_t*)(p.ws + O_YK);
    for (int item = blockIdx.x; item < NTOK / NWV; item += gridDim.x) {
        const int token = item * NWV + wid, b = token >> 13;
        const float* x1 = (const float*)(p.ws + O_Z1) + (size_t)token * 1024;
        const float* gf = (const float*)(p.ws + O_ADA) + b * 6144 + 5120;
        const int r0 = tokrow[token * 4 + 0], r1 = tokrow[token * 4 + 1], r2 = tokrow[token * 4 + 2], r3 = tokrow[token * 4 + 3];
        f32x4 v[4]; float s = 0.f;
#pragma unroll
        for (int j = 0; j < 4; ++j) {
            const int c = j * 256 + lane * 4;
            const u32x2 a0 = *(const u32x2*)(YK + (size_t)r0 * 1024 + c), a1 = *(const u32x2*)(YK + (size_t)r1 * 1024 + c), a2 = *(const u32x2*)(YK + (size_t)r2 * 1024 + c), a3 = *(const u32x2*)(YK + (size_t)r3 * 1024 + c);
            f32x4 y;
            y[0] = (bflo(a0.x) + bflo(a1.x)) + (bflo(a2.x) + bflo(a3.x)); y[1] = (bfhi(a0.x) + bfhi(a1.x)) + (bfhi(a2.x) + bfhi(a3.x));
            y[2] = (bflo(a0.y) + bflo(a1.y)) + (bflo(a2.y) + bflo(a3.y)); y[3] = (bfhi(a0.y) + bfhi(a1.y)) + (bfhi(a2.y) + bfhi(a3.y));
            v[j] = *(const f32x4*)(x1 + c) * DN_ALPHA + *(const f32x4*)(gf + c) * y;
            s += (v[j][0] + v[j][1]) + (v[j][2] + v[j][3]);
        }
        const float mean = wave_sum(s) * (1.f / 1024.f); float q = 0.f;
#pragma unroll
        for (int j = 0; j < 4; ++j) { v[j] = v[j] - mean; q += (v[j][0] * v[j][0] + v[j][1] * v[j][1]) + (v[j][2] * v[j][2] + v[j][3] * v[j][3]); }
        const float rstd = rsqrtf(wave_sum(q) * (1.f / 1024.f) + LN_EPS);
#pragma unroll
        for (int j = 0; j < 4; ++j) { const int c = j * 256 + lane * 4; *(f32x4*)(p.out + (size_t)token * 1024 + c) = v[j] * rstd * *(const f32x4*)(lg + c) + *(const f32x4*)(lb + c); }
    }
}

#if defined(__HIP_DEVICE_COMPILE__)
typedef const __attribute__((address_space(4))) Params* KernargPtr;
__device__ __forceinline__ KernargPtr opaque_kernarg() { KernargPtr kp = (KernargPtr)__builtin_amdgcn_kernarg_segment_ptr(); asm volatile("" : "+s"(kp)); return kp; }
#define GAS __attribute__((address_space(1)))
__device__ __forceinline__ Params load_params() {
    Params r; const __attribute__((address_space(4))) unsigned long long* s = (const __attribute__((address_space(4))) unsigned long long*)opaque_kernarg();
#pragma unroll
    for (int i = 0; i < 34; ++i) r.in[i] = (const float*)(const GAS float*)s[i];
    r.out = (float*)(GAS float*)s[34]; r.ws = (unsigned char*)(GAS unsigned char*)s[35];
    const unsigned long long pp = s[36]; r.ph_lo = (int)(unsigned)pp; r.ph_hi = (int)(unsigned)(pp >> 32);
    return r; }
#else
#define opaque_kernarg() (&p_unused)
#endif
#if defined(__HIP_DEVICE_COMPILE__)
#define PARAMS_NOW() load_params()
#else
#define PARAMS_NOW() p_unused
#endif
template <bool COOP>
__global__ void __launch_bounds__(NT, 2) fwd_kernel(Params p_unused) {
    extern __shared__ __attribute__((aligned(16))) unsigned char smem[];
    LAS unsigned char* lds = (LAS unsigned char*)smem;
    const int lo = opaque_kernarg()->ph_lo, hi = opaque_kernarg()->ph_hi;
#define RUN_PHASE(k, call) if (((PH_MASK >> (k)) & 1) && lo <= (k) && (k) < hi) { _Pragma("unroll 1") for (int rep_ = 0; rep_ < 1 + ((REPEAT_MASK >> (k)) & 1); ++rep_) { if (rep_) { if (COOP) cg::this_grid().sync(); } const Params p = PARAMS_NOW(); call; } } if (COOP) { if (lo <= (k) && (k) + 1 < hi) cg::this_grid().sync(); }
    RUN_PHASE(0, phase0(p, smem))
    RUN_PHASE(1, phase1(p, smem))
    RUN_PHASE(2, phase2(p, lds))
    RUN_PHASE(3, phase3(p, lds))
    RUN_PHASE(4, phase4(p, smem))
    RUN_PHASE(5, phase5(p, lds))
    RUN_PHASE(6, phase6(p, lds))
    RUN_PHASE(7, phase7(p, smem))
    RUN_PHASE(8, phase8(p, lds))
    RUN_PHASE(9, phase9(p, lds))
    RUN_PHASE(10, phase10(p, smem))
    RUN_PHASE(11, phase11(p, smem))
    RUN_PHASE(12, phase12(p, smem, lds))
    RUN_PHASE(13, phase13(p, smem, lds))
    RUN_PHASE(14, phase14(p, smem))
#undef RUN_PHASE
}

extern "C" void kernel_launch(void* const* d_in, const int* in_sizes, int n_in, void* d_out, int out_size, void* d_ws, size_t ws_size, hipStream_t stream) {
    static int grid = 0;
    if (grid == 0) {
        if (n_in != 34 || out_size != NTOK * DM || ws_size < WS_NEED) { fprintf(stderr, "kernel_launch: unexpected problem (n_in %d, out %d, ws %zu need %zu)\n", n_in, out_size, ws_size, (size_t)WS_NEED); grid = -1; return; }
        int dev = 0, cus = 0, per_cu = 0;
        (void)hipGetDevice(&dev);
        (void)hipDeviceGetAttribute(&cus, hipDeviceAttributeMultiprocessorCount, dev);
#if ONE_LAUNCH
        (void)hipFuncSetAttribute((const void*)fwd_kernel<true>, hipFuncAttributeMaxDynamicSharedMemorySize, LDS_BYTES);
        (void)hipOccupancyMaxActiveBlocksPerMultiprocessor(&per_cu, fwd_kernel<true>, NT, LDS_BYTES);
#else
        (void)hipFuncSetAttribute((const void*)fwd_kernel<false>, hipFuncAttributeMaxDynamicSharedMemorySize, LDS_BYTES);
        (void)hipOccupancyMaxActiveBlocksPerMultiprocessor(&per_cu, fwd_kernel<false>, NT, LDS_BYTES);
#endif
        if (per_cu < 1) { fprintf(stderr, "kernel_launch: occupancy query reports %d blocks per CU\n", per_cu); per_cu = 1; }
        grid = cus * per_cu;
        fprintf(stderr, "kernel_launch: grid %d (%d CUs x %d)\n", grid, cus, per_cu);
    }
    if (grid < 0) return;
    Params p{};
    for (int i = 0; i < 34; ++i) p.in[i] = (const float*)d_in[i];
    p.out = (float*)d_out; p.ws = (unsigned char*)d_ws;
#if ONE_LAUNCH
    p.ph_lo = 0; p.ph_hi = NPHASE;
    void* args[] = {&p};
    hipError_t e = hipLaunchCooperativeKernel((void*)fwd_kernel<true>, dim3(grid), dim3(NT), args, LDS_BYTES, stream);
    if (e != hipSuccess) fprintf(stderr, "cooperative launch failed: %s (grid %d)\n", hipGetErrorString(e), grid);
#else
    for (int ph = 0; ph < NPHASE; ++ph) {
        p.ph_lo = ph; p.ph_hi = ph + 1;
        hipLaunchKernelGGL(fwd_kernel<false>, dim3(grid), dim3(NT), LDS_BYTES, stream, p);
    }
#endif
}
```

```cpp
#include <hip/hip_runtime.h>
#include <hip/hip_cooperative_groups.h>
#include <cstdio>
#include <cstdint>
namespace cg = cooperative_groups;

#ifndef PH_MASK
#define PH_MASK 0xFFFFF
#endif
#ifndef REPEAT_MASK
#define REPEAT_MASK 0
#endif
#ifndef ONE_LAUNCH
#define ONE_LAUNCH 1
#endif

#define LAS __attribute__((address_space(3)))
typedef unsigned short bf16_t;
typedef short bf16x8 __attribute__((ext_vector_type(8)));
typedef float f32x4 __attribute__((ext_vector_type(4)));
typedef float f32x2 __attribute__((ext_vector_type(2)));
typedef unsigned u32x4 __attribute__((ext_vector_type(4)));
typedef unsigned u32x2 __attribute__((ext_vector_type(2)));
typedef __bf16 bf16x2_t __attribute__((ext_vector_type(2)));

constexpr int NB = 4, SEQ = 8192, NTOK = NB * SEQ, DM = 1024;
constexpr int NIN_PAD = 4096;
constexpr int NEXP = 32, TOPK = 4, NROWS = NTOK * TOPK;
constexpr int S5L = 32;
constexpr int NCHUNK = SEQ / S5L;
constexpr int UROW = 640;
constexpr float DN_ALPHA = 1.189207115002721f;
constexpr float LN_EPS = 1e-5f;
constexpr float LOG2E = 1.4426950408889634f;
constexpr float QSCALE = 0.125f * 1.4426950408889634f;
constexpr float WGU_SCALE = 32.f, WDN_SCALE = 64.f;
constexpr int NT = 512;
constexpr int NWV = NT / 64;

constexpr size_t al256(size_t x) { return (x + 255) & ~(size_t)255; }
constexpr size_t O_ADA = 0;
constexpr size_t O_CNT = O_ADA + al256(4 * 6144 * 4);
constexpr size_t O_BAR = O_CNT + 1024;
constexpr size_t BAR_BYTES = 3456 * 4;
constexpr size_t O_LAML = O_BAR + al256(BAR_BYTES);
constexpr size_t O_BIAS1 = O_LAML + al256(32 * 64 * 2 * 4);
constexpr size_t O_WT_IN = O_BIAS1 + al256(2 * 8 * 128 * 4);
constexpr size_t O_WT_GLU = O_WT_IN + al256((size_t)NIN_PAD * 1024 * 2);
constexpr size_t O_WT_NSA = O_WT_GLU + al256((size_t)2048 * 512 * 2);
constexpr size_t O_WT_OUT = O_WT_NSA + al256((size_t)1024 * 512 * 2);
constexpr size_t O_WT_C1 = O_WT_OUT + al256((size_t)1024 * 1024 * 2);
constexpr size_t O_W1T = O_WT_C1 + al256((size_t)2 * 256 * 2048 * 2);
constexpr size_t O_TW2 = O_W1T + al256((size_t)32 * 256 * 512 * 2);
constexpr size_t O_WT_GU = O_TW2 + al256((size_t)32 * 512 * 640 * 2);
constexpr size_t O_WT_DN = O_WT_GU + al256((size_t)32 * 2048 * 1024);
constexpr size_t O_H2 = O_WT_DN + al256((size_t)32 * 1024 * 1024);
constexpr size_t O_Z1 = O_H2 + al256((size_t)NTOK * 1024);
constexpr size_t O_TOPE = O_Z1 + al256((size_t)NTOK * 1024 * 4);
constexpr size_t O_TOPP = O_TOPE + al256((size_t)NROWS * 4);
constexpr size_t O_TOPG = O_TOPP + al256((size_t)NROWS * 4);
constexpr size_t O_ROWTOK = O_TOPG + al256((size_t)NROWS * 4);
constexpr size_t O_ROWGATE = O_ROWTOK + al256((size_t)(NROWS + 256) * 4);
constexpr size_t O_TOKROW = O_ROWGATE + al256((size_t)(NROWS + 256) * 4);
constexpr size_t O_OVL = O_TOKROW + al256((size_t)NROWS * 4);
constexpr size_t O_U = O_OVL;
constexpr size_t O_E = O_U + al256((size_t)32 * 1024 * UROW * 2);
constexpr size_t O_YS = O_E + al256((size_t)32 * 1024 * 128 * 4);
constexpr size_t O_Q = O_YS + al256((size_t)NTOK * 512 * 2);
constexpr size_t O_KV = O_Q + al256((size_t)NTOK * 512 * 2);
constexpr size_t KV_SLAB = (size_t)SEQ * 64;
constexpr size_t O_SG5 = O_KV + al256((size_t)6 * 8 * KV_SLAB * 2 + 8192);
constexpr size_t O_SGN = O_SG5 + al256((size_t)NTOK * 1024 * 2);
constexpr size_t O_GN = O_SGN + al256((size_t)NTOK * 1024 * 2);
constexpr size_t O_MS5 = O_GN + al256((size_t)NTOK * 24 * 4);
constexpr size_t O_ONSA = O_MS5 + al256((size_t)NTOK * 1024 * 2);
constexpr size_t O_HC = O_ONSA + al256((size_t)NTOK * 512 * 2);
constexpr size_t O_KC = O_HC + al256((size_t)2 * 4096 * 128 * 2);
constexpr size_t O_XN = O_KC + al256((size_t)2 * 4096 * 64 * 2);
constexpr size_t O_END1 = O_XN + al256((size_t)NTOK * 1024 * 2);
constexpr size_t O_ACT = O_OVL;
constexpr size_t O_YK = O_ACT + al256((size_t)(NROWS + 256) * 1024);
constexpr size_t O_END2 = O_YK + al256((size_t)(NROWS + 256) * 1024 * 2);
constexpr size_t WS_NEED = O_END1 > O_END2 ? O_END1 : O_END2;
static_assert(WS_NEED <= (size_t)1073741824, "workspace map exceeds 1 GiB");

constexpr int LDS_BYTES = 147456;
constexpr int LDS_TAB = 131072;
constexpr int NPHASE = 15;

struct Params {
    const float* in[34];
    float* out;
    unsigned char* ws;
    int ph_lo, ph_hi;
};

__device__ __forceinline__ unsigned pk2(float lo, float hi) { f32x2 v = {lo, hi}; bf16x2_t b = __builtin_convertvector(v, bf16x2_t); return __builtin_bit_cast(unsigned, b); }
__device__ __forceinline__ bf16_t f2bf(float f) { return (bf16_t)(pk2(f, 0.f) & 0xffffu); }
__device__ __forceinline__ float bf2f(bf16_t h) { return __uint_as_float(((unsigned)h) << 16); }
__device__ __forceinline__ float bflo(unsigned w) { return __uint_as_float(w << 16); }
__device__ __forceinline__ float bfhi(unsigned w) { return __uint_as_float(w & 0xffff0000u); }
__device__ __forceinline__ unsigned pk4_f8(float a, float b, float c, float d) { int w = 0; w = __builtin_amdgcn_cvt_pk_fp8_f32(a, b, w, false); w = __builtin_amdgcn_cvt_pk_fp8_f32(c, d, w, true); return (unsigned)w; }
__device__ __forceinline__ float sigmoidf_(float x) { return 1.f / (1.f + __expf(-x)); }
__device__ __forceinline__ float gelu_tanh(float x) { const float u = 0.7978845608028654f * (x + 0.044715f * x * x * x); const float e = __expf(2.f * u); return 0.5f * x * (2.f - 2.f / (e + 1.f)); }
__device__ __forceinline__ float wave_sum(float v) {
#pragma unroll
    for (int o = 1; o < 64; o <<= 1) v += __shfl_xor(v, o);
    return v;
}
#define WAVE_SYNC() do { __builtin_amdgcn_fence(__ATOMIC_RELEASE, "wavefront"); __builtin_amdgcn_wave_barrier(); __builtin_amdgcn_fence(__ATOMIC_ACQUIRE, "wavefront"); } while (0)

namespace pg8 {
typedef int v8i_t __attribute__((ext_vector_type(8)));
typedef int v4i8_t __attribute__((ext_vector_type(4)));
constexpr int BM = 256, BK = 64, HALF = 128, HTB = HALF * BK * 2, STAGE_BYTES = 8 * HTB;
__device__ __forceinline__ int lds_byte(int r, int c) { const int st = (r >> 4) * 2 + (c >> 5), rr = r & 15, cc = c & 31, ob = rr * 64 + cc * 2; return st * 1024 + (ob ^ (((ob >> 9) & 1) << 5)); }
__device__ __forceinline__ void stage_rc(int b, int& R, int& C) { const int st = b / 1024, sb = b % 1024, swz = sb ^ (((sb >> 9) & 1) << 5); R = (st >> 1) * 16 + swz / 64; C = (st & 1) * 32 + (swz % 64) / 2; }
__device__ __forceinline__ int perm32(int rho) { const int n = rho >> 4, i = rho & 15; return 8 * (i >> 2) + 4 * n + (i & 3); }
struct Unit { const char* A; const char* B; const int* rows; int pm, pn, e, nvalid, rmax; };

template <class Epi, class Sched, bool ALIGN_EPI, bool F8 = false>
__device__ __forceinline__ void gemm_phase(LAS unsigned char* lds, const int K, const int lda, const int ldb, const Sched& S, const Epi& E) {
    const int tid = threadIdx.x, wid = __builtin_amdgcn_readfirstlane(tid >> 6), lane = tid & 63, wr = wid >> 2, wc = wid & 3, fr = lane & 15, fq = lane >> 4;
    const int nt = K / BK;
    unsigned voffB[2]; int Ra[2], Ca[2];
#pragma unroll
    for (int i = 0; i < 2; ++i) { int R, C; stage_rc(tid * 16 + i * 8192, R, C); const int Rb = Epi::PERM ? ((R & ~31) + perm32(R & 31)) : R;
        Ra[i] = R; Ca[i] = C; voffB[i] = (unsigned)(Rb * ldb + C) * 2u; }
    unsigned offC[2][2], offN[2][2];
#define PG8_SETOFF(o, u) do { _Pragma("unroll") for (int h_ = 0; h_ < 2; ++h_) _Pragma("unroll") for (int i_ = 0; i_ < 2; ++i_) { \
        if ((u).rows) { int ix_ = h_ * HALF + Ra[i_]; ix_ = ix_ < (u).rmax ? ix_ : (u).rmax; o[h_][i_] = (unsigned)(u).rows[ix_] * (unsigned)(lda * 2) + (unsigned)Ca[i_] * 2u; } \
        else o[h_][i_] = (unsigned)((h_ * HALF + Ra[i_]) * lda + Ca[i_]) * 2u; } } while (0)
    const size_t kstep = (size_t)(BK * 2);
    const size_t hstepB = (size_t)HALF * ldb * 2;
    const unsigned ldsw = (unsigned)wid * 1024u;
    const int aoff = lds_byte(wr * 64 + fr, fq * 8), boff = lds_byte(wc * 32 + fr, fq * 8);
#define PG8_SA(b, h) (((b) * 2 + (h)) * HTB)
#define PG8_SB(b, h) ((4 + (b) * 2 + (h)) * HTB)
#define PG8_STAGE(bufoff, gbase, voff) do { _Pragma("unroll") for (int _i = 0; _i < 2; ++_i) \
        __builtin_amdgcn_global_load_lds((const unsigned*)((const char*)(gbase) + (voff)[_i]), (LAS unsigned*)(lds + (bufoff) + ldsw + _i * 8192), 16, 0, 0); } while (0)
#define PG8_LDA(dst, b, h) do { _Pragma("unroll") for (int m = 0; m < 4; ++m) { \
        if constexpr (F8) dst##8[m] = __builtin_shufflevector(*(const LAS v4i8_t*)(lds + PG8_SA(b, h) + aoff + m * 2048), *(const LAS v4i8_t*)(lds + PG8_SA(b, h) + aoff + m * 2048 + 1024), 0, 1, 2, 3, 4, 5, 6, 7); \
        else { _Pragma("unroll") for (int k = 0; k < 2; ++k) dst[m][k] = *(const LAS bf16x8*)(lds + PG8_SA(b, h) + aoff + m * 2048 + k * 1024); } } } while (0)
#define PG8_LDB(dst, b, h) do { _Pragma("unroll") for (int n = 0; n < 2; ++n) { \
        if constexpr (F8) dst##8[n] = __builtin_shufflevector(*(const LAS v4i8_t*)(lds + PG8_SB(b, h) + boff + n * 2048), *(const LAS v4i8_t*)(lds + PG8_SB(b, h) + boff + n * 2048 + 1024), 0, 1, 2, 3, 4, 5, 6, 7); \
        else { _Pragma("unroll") for (int k = 0; k < 2; ++k) dst[n][k] = *(const LAS bf16x8*)(lds + PG8_SB(b, h) + boff + n * 2048 + k * 1024); } } } while (0)
#define PG8_MMA(ai, bj, At, Bt) do { __builtin_amdgcn_s_setprio(1); _Pragma("unroll") for (int m = 0; m < 4; ++m) _Pragma("unroll") for (int n = 0; n < 2; ++n) { \
        if constexpr (F8) asm volatile("v_mfma_scale_f32_16x16x128_f8f6f4 %0, %1, %2, %0, %3, %3 op_sel_hi:[0,0,0]" : "+v"(acc[ai][bj][m][n]) : "v"(Bt##8[n]), "v"(At##8[m]), "v"(f8scale_));   \
        else { _Pragma("unroll") for (int k = 0; k < 2; ++k) acc[ai][bj][m][n] = __builtin_amdgcn_mfma_f32_16x16x32_bf16(Bt[n][k], At[m][k], acc[ai][bj][m][n], 0, 0, 0); } } \
        __builtin_amdgcn_s_setprio(0); } while (0)
#define PG8_WAIT_V(n) asm volatile("s_waitcnt vmcnt(" #n ")" ::: "memory")
#define PG8_WAIT_L(n) asm volatile("s_waitcnt lgkmcnt(" #n ")" ::: "memory")
#define PG8_BAR __builtin_amdgcn_s_barrier()
#define PG8_SCHED __builtin_amdgcn_sched_barrier(0)
    Unit cur, nxt; int ui = 0;
    if (!S.next(0, cur)) return;
    f32x4 acc[2][2][4][2];
#pragma unroll
    for (int a = 0; a < 2; ++a)
#pragma unroll
        for (int b = 0; b < 2; ++b)
#pragma unroll
            for (int m = 0; m < 4; ++m)
#pragma unroll
                for (int n = 0; n < 2; ++n) acc[a][b][m][n] = (f32x4){0.f, 0.f, 0.f, 0.f};
    bf16x8 At[4][2], B0[2][2], B1[2][2];
    v8i_t At8[4], B08[2], B18[2];
    const int f8scale_ = 0x7F7F7F7F;
    const char* cA = cur.A; const char* cB = cur.B;
    PG8_SETOFF(offC, cur);
    PG8_STAGE(PG8_SB(0, 0), cB, voffB); PG8_STAGE(PG8_SB(0, 1), cB + hstepB, voffB); PG8_STAGE(PG8_SA(0, 0), cA, offC[0]); PG8_STAGE(PG8_SA(0, 1), cA, offC[1]);
    if (wr == 1) PG8_BAR;
    PG8_WAIT_V(2); PG8_BAR;
    PG8_STAGE(PG8_SB(1, 0), cB + kstep, voffB); PG8_STAGE(PG8_SA(1, 0), cA + kstep, offC[0]); PG8_STAGE(PG8_SB(1, 1), cB + hstepB + kstep, voffB);
    PG8_WAIT_V(6); PG8_BAR;
    for (;;) {
        const bool has_next = S.next(ui + 1, nxt);
        const char* nA = has_next ? nxt.A : cA; const char* nB = has_next ? nxt.B : cB;
        if (has_next) { PG8_SETOFF(offN, nxt); } else { offN[0][0] = offC[0][0]; offN[0][1] = offC[0][1]; offN[1][0] = offC[1][0]; offN[1][1] = offC[1][1]; }
#pragma unroll 1
        for (int t = 0; t < nt; t += 2) {
            const bool last = (t == nt - 2);
            const char* a1 = cA + (size_t)(t + 1) * kstep;
            const char* a2 = last ? nA : cA + (size_t)(t + 2) * kstep; const char* b2 = last ? nB : cB + (size_t)(t + 2) * kstep;
            const char* a3 = a2 + kstep; const char* b3 = b2 + kstep;
            unsigned o2[2][2];
            o2[0][0] = last ? offN[0][0] : offC[0][0]; o2[0][1] = last ? offN[0][1] : offC[0][1]; o2[1][0] = last ? offN[1][0] : offC[1][0]; o2[1][1] = last ? offN[1][1] : offC[1][1];
            PG8_LDB(B0, 0, 0); PG8_LDB(B1, 0, 1); PG8_SCHED; PG8_LDA(At, 0, 0); PG8_STAGE(PG8_SA(1, 1), a1, offC[1]);
            PG8_WAIT_V(8); PG8_WAIT_L(0); PG8_BAR; PG8_MMA(0, 0, At, B0); PG8_MMA(0, 1, At, B1); PG8_BAR; PG8_SCHED;
            PG8_LDA(At, 0, 1); PG8_STAGE(PG8_SB(0, 0), b2, voffB); PG8_STAGE(PG8_SB(0, 1), b2 + hstepB, voffB); PG8_STAGE(PG8_SA(0, 0), a2, o2[0]);
            PG8_WAIT_V(8); PG8_WAIT_L(0); PG8_BAR; PG8_MMA(1, 0, At, B0); PG8_MMA(1, 1, At, B1); PG8_BAR; PG8_SCHED;
            PG8_LDB(B0, 1, 0); PG8_LDB(B1, 1, 1); PG8_SCHED; PG8_LDA(At, 1, 0); PG8_STAGE(PG8_SA(0, 1), a2, o2[1]);
            PG8_WAIT_V(8); PG8_WAIT_L(0); PG8_BAR; PG8_MMA(0, 0, At, B0); PG8_MMA(0, 1, At, B1); PG8_BAR; PG8_SCHED;
            PG8_LDA(At, 1, 1); PG8_STAGE(PG8_SB(1, 0), b3, voffB); PG8_STAGE(PG8_SB(1, 1), b3 + hstepB, voffB); PG8_STAGE(PG8_SA(1, 0), a3, o2[0]);
            PG8_WAIT_V(8); PG8_WAIT_L(0); PG8_BAR; PG8_MMA(1, 0, At, B0); PG8_MMA(1, 1, At, B1); PG8_BAR; PG8_SCHED;
        }
        if constexpr (ALIGN_EPI) { if (wr == 0) PG8_BAR; }
        if constexpr (F8) asm volatile("s_nop 15\n\ts_nop 15" ::: "memory");
        E(acc, cur, wr, wc, fr, fq);
        if (!has_next) break;
#pragma unroll
        for (int a = 0; a < 2; ++a)
#pragma unroll
            for (int b = 0; b < 2; ++b)
#pragma unroll
                for (int m = 0; m < 4; ++m)
#pragma unroll
                    for (int n = 0; n < 2; ++n) acc[a][b][m][n] = (f32x4){0.f, 0.f, 0.f, 0.f};
        cur = nxt; cA = nA; cB = nB; ++ui;
        offC[0][0] = offN[0][0]; offC[0][1] = offN[0][1]; offC[1][0] = offN[1][0]; offC[1][1] = offN[1][1];
        if constexpr (ALIGN_EPI) { if (wr == 1) PG8_BAR; }
    }
    PG8_WAIT_V(0);
    if constexpr (!ALIGN_EPI) { if (wr == 0) PG8_BAR; }
    PG8_BAR;
#undef PG8_SETOFF
#undef PG8_SA
#undef PG8_SB
#undef PG8_STAGE
#undef PG8_LDA
#undef PG8_LDB
#undef PG8_MMA
#undef PG8_WAIT_V
#undef PG8_WAIT_L
#undef PG8_BAR
#undef PG8_SCHED
}

struct DenseOrder {
    const char* A; const char* B; size_t tstepA, tstepB; int nM, nN, nwg, G, c;
    __device__ __forceinline__ void init(const void* A_, const void* B_, int M, int N, int lda, int ldb, int G_, int c_) {
        A = (const char*)A_; B = (const char*)B_; tstepA = (size_t)BM * lda * 2; tstepB = (size_t)BM * ldb * 2; nM = M / BM; nN = N / BM; nwg = nM * nN; G = G_; c = c_; }
    __device__ __forceinline__ bool next(int i, Unit& u) const {
        const long L = (long)i * G + c; if (L >= nwg) return false;
        int wgid = (int)L; { const int q = nwg / 8, r = nwg % 8, xcd = wgid % 8, off = wgid / 8; wgid = (xcd < r ? xcd * (q + 1) : r * (q + 1) + (xcd - r) * q) + off; }
        const int nig = 8 * nN, gid = wgid / nig, fm = gid * 8, gsz = (nM - fm) < 8 ? (nM - fm) : 8;
        u.pm = fm + ((wgid % nig) % gsz); u.pn = (wgid % nig) / gsz; u.e = 0; u.nvalid = 256; u.rows = nullptr; u.rmax = 255;
        u.A = A + (size_t)u.pm * tstepA; u.B = B + (size_t)u.pn * tstepB; return true;
    }
};
}

__device__ __forceinline__ int map_in(int n) { return n < 1792 ? n : (n < 3840 ? n + 24 : (n < 3864 ? 1792 + (n - 3840) : -1)); }
__device__ __forceinline__ int map_il128(int n) { const int b = n >> 7; return (b & 1) * 1024 + (b >> 1) * 128 + (n & 127); }

struct TrJob { const float* W; bf16_t* Wt; int K, Nsrc, map, kt, nt; float f8scale; };
constexpr int TR_IN = 16 * 16, TR_GLU = 8 * 8, TR_NSA = 8 * 4, TR_OUT = 16 * 4, TR_C1 = 2 * 32, TR_GU = 32 * 16 * 8, TR_DN = 32 * 16 * 4;
constexpr int TR_ITEMS = TR_IN + TR_GLU + TR_NSA + TR_OUT + TR_C1 + TR_GU + TR_DN;
__device__ __forceinline__ void tr_job(const Params& p, int r, TrJob& j) {
    unsigned char* ws = p.ws;
    if (r < TR_IN) { j = TrJob{p.in[5], (bf16_t*)(ws + O_WT_IN), 1024, 3864, 1, r / 16, r % 16, 0.f}; return; } r -= TR_IN;
    if (r < TR_GLU) { j = TrJob{p.in[14], (bf16_t*)(ws + O_WT_GLU), 512, 2048, 2, r / 8, r % 8, 0.f}; return; } r -= TR_GLU;
    if (r < TR_NSA) { j = TrJob{p.in[22], (bf16_t*)(ws + O_WT_NSA), 512, 1024, 0, r / 4, r % 4, 0.f}; return; } r -= TR_NSA;
    if (r < TR_OUT) { j = TrJob{p.in[23], (bf16_t*)(ws + O_WT_OUT), 1024, 1024, 0, r / 4, r % 4, 0.f}; return; } r -= TR_OUT;
    if (r < TR_C1) { const int kv = r / 32; j = TrJob{p.in[kv ? 20 : 17], (bf16_t*)(ws + O_WT_C1) + (size_t)kv * 256 * 2048, 2048, 128, 3, r % 32, 0, 0.f}; return; } r -= TR_C1;
    if (r < TR_GU) { const int e = r / 128, q = r % 128; j = TrJob{p.in[28] + (size_t)e * 1024 * 2048, (bf16_t*)(ws + O_WT_GU + (size_t)e * 2048 * 1024), 1024, 2048, 2, q / 8, q % 8, WGU_SCALE}; return; } r -= TR_GU;
    { const int e = r / 64, q = r % 64; j = TrJob{p.in[30] + (size_t)e * 1024 * 1024, (bf16_t*)(ws + O_WT_DN + (size_t)e * 1024 * 1024), 1024, 1024, 0, q / 4, q % 4, WDN_SCALE}; }
}
__device__ __forceinline__ void tr_load(const TrJob& j, f32x4 (&v)[8], int tid) {
    const int n4 = tid & 63, kq = tid >> 6, nd = j.nt * 256 + 4 * n4;
    const int src = j.map == 0 ? nd : (j.map == 1 ? map_in(nd) : (j.map == 2 ? map_il128(nd) : (nd < 128 ? nd : -1)));
    const float* base = j.W + (size_t)(j.kt * 64 + kq) * j.Nsrc + (src >= 0 ? src : 0);
#pragma unroll
    for (int i = 0; i < 8; ++i) v[i] = (src >= 0) ? *(const f32x4*)(base + (size_t)i * 8 * j.Nsrc) : (f32x4){0.f, 0.f, 0.f, 0.f};
}
__device__ __forceinline__ void tr_store(const TrJob& cj, const float* t, int tid) {
    if (cj.f8scale != 0.f) {
        const int n = tid & 255, kh = (tid >> 8) * 32; const float sc = cj.f8scale;
        unsigned char* d = (unsigned char*)cj.Wt + (size_t)(cj.nt * 256 + n) * cj.K + cj.kt * 64 + kh;
#pragma unroll
        for (int q = 0; q < 2; ++q) {
            const float* c = t + (kh + 16 * q) * 260 + n;
            u32x4 o;
            o.x = pk4_f8(c[0] * sc, c[260] * sc, c[2 * 260] * sc, c[3 * 260] * sc); o.y = pk4_f8(c[4 * 260] * sc, c[5 * 260] * sc, c[6 * 260] * sc, c[7 * 260] * sc);
            o.z = pk4_f8(c[8 * 260] * sc, c[9 * 260] * sc, c[10 * 260] * sc, c[11 * 260] * sc); o.w = pk4_f8(c[12 * 260] * sc, c[13 * 260] * sc, c[14 * 260] * sc, c[15 * 260] * sc);
            *(u32x4*)(d + 16 * q) = o;
        }
    } else {
        const int n = tid & 255, kh = (tid >> 8) * 32;
        bf16_t* d = cj.Wt + (size_t)(cj.nt * 256 + n) * cj.K + cj.kt * 64 + kh;
#pragma unroll
        for (int q = 0; q < 4; ++q) {
            const float* c = t + (kh + 8 * q) * 260 + n;
            u32x4 o;
            o.x = pk2(c[0], c[260]); o.y = pk2(c[2 * 260], c[3 * 260]); o.z = pk2(c[4 * 260], c[5 * 260]); o.w = pk2(c[6 * 260], c[7 * 260]);
            *(u32x4*)(d + 8 * q) = o;
        }
    }
}
__device__ __forceinline__ void convert_weights(const Params& p, unsigned char* smem, int lo, int hi, unsigned* queue) {
    float* t = (float*)smem;
    int* slot = (int*)(smem + 64 * 260 * 4);
    const int tid = threadIdx.x, n4 = tid & 63, kq = tid >> 6;
    const int G = gridDim.x;
    int ia, ib;
    if (queue) { if (tid == 0) { slot[0] = lo + (int)atomicAdd(queue, 1u); slot[1] = lo + (int)atomicAdd(queue, 1u); } __syncthreads(); ia = slot[0]; ib = slot[1]; __syncthreads(); }
    else { ia = lo + blockIdx.x; ib = ia + G; }
    if (ia >= hi) return;
    TrJob ja, jb; f32x4 va[8], vb[8];
    tr_job(p, ia, ja); tr_load(ja, va, tid);
    if (ib < hi) { tr_job(p, ib, jb); tr_load(jb, vb, tid); }
#define TR_ROUND(I, J, V) do { \
        _Pragma("unroll") for (int i = 0; i < 8; ++i) *(f32x4*)(t + (i * 8 + kq) * 260 + 4 * n4) = V[i]; \
        if (queue && tid == 0) slot[0] = lo + (int)atomicAdd(queue, 1u); \
        __syncthreads(); \
        const TrJob cj_ = J; \
        I = queue ? slot[0] : I + 2 * G; \
        if (I < hi) { tr_job(p, I, J); tr_load(J, V, tid); } \
        tr_store(cj_, t, tid); \
        __syncthreads(); } while (0)
    for (;;) {
        TR_ROUND(ia, ja, va);
        if (ib >= hi) break;
        TR_ROUND(ib, jb, vb);
        if (ia >= hi) break;
    }
#undef TR_ROUND
}

__device__ __forceinline__ void phase0(const Params& p, unsigned char* smem) {
    unsigned char* ws = p.ws;
    const int tid = threadIdx.x;
    convert_weights(p, smem, 0, TR_ITEMS - TR_GU - TR_DN, nullptr);
    constexpr int I_ADA = 96;
    constexpr int I_S5 = 32 * 33;
    constexpr int I_MISC = 17;
    constexpr int NITEM = I_ADA + I_S5 + I_MISC;
    for (int item = blockIdx.x; item < NITEM; item += gridDim.x) {
        int r = item;
        if (r < I_ADA) {
            const float* c = p.in[1]; const float* w = p.in[3]; const float* bb = p.in[4];
            const int wid = tid >> 6, lane = tid & 63, j = r * 64 + lane;
            float a0 = 0.f, a1 = 0.f, a2 = 0.f, a3 = 0.f;
#pragma unroll 4
            for (int k = wid * 128; k < wid * 128 + 128; ++k) {
                const float wv = w[(size_t)k * 6144 + j];
                const float c0 = c[k], c1 = c[1024 + k], c2 = c[2048 + k], c3 = c[3072 + k];
                a0 += c0 * sigmoidf_(c0) * wv; a1 += c1 * sigmoidf_(c1) * wv; a2 += c2 * sigmoidf_(c2) * wv; a3 += c3 * sigmoidf_(c3) * wv;
            }
            float* red = (float*)smem;
            red[(wid * 4 + 0) * 64 + lane] = a0; red[(wid * 4 + 1) * 64 + lane] = a1; red[(wid * 4 + 2) * 64 + lane] = a2; red[(wid * 4 + 3) * 64 + lane] = a3;
            __syncthreads();
            if (tid < 256) { const int b = tid >> 6; float s = 0.f;
#pragma unroll
              for (int w8 = 0; w8 < 8; ++w8) s += red[(w8 * 4 + b) * 64 + lane];
              ((float*)(ws + O_ADA))[b * 6144 + j] = s + bb[j]; }
            __syncthreads();
            continue;
        }
        r -= I_ADA;
        if (r < I_S5) {
            const int g = r / 33, dl = r % 33;
            f32x2* pw = (f32x2*)smem;
            f32x2* bbv = pw + 64;
            f32x2* ccv = bbv + 1024;
            const float dt = expf(p.in[8][g]);
            if (tid < 64) {
                const int n = tid; const double re = p.in[6][g * 64 + n], im = p.in[7][g * 64 + n];
                const double mag = exp(re * (double)dt * dl), ang = im * (double)dt * dl;
                double sn, cs; sincos(ang, &sn, &cs);
                pw[n] = (f32x2){(float)(mag * cs), (float)(mag * sn)};
                if (dl == 32) { ((f32x2*)(ws + O_LAML))[g * 64 + n] = pw[n]; }
            }
            for (int e = tid; e < 1024; e += NT) {
                const int n = e >> 4, q = e & 15;
                const double re = p.in[6][g * 64 + n], im = p.in[7][g * 64 + n];
                const double mag = exp(re * (double)dt), ang = im * (double)dt;
                double sn, cs; sincos(ang, &sn, &cs);
                const double lr = mag * cs - 1.0, li = mag * sn;
                const double den = re * re + im * im;
                const double fr_ = (lr * re + li * im) / den, fi_ = (li * re - lr * im) / den;
                const double br = p.in[9][(g * 64 + n) * 16 + q], bi = p.in[10][(g * 64 + n) * 16 + q];
                bbv[e] = (f32x2){(float)(fr_ * br - fi_ * bi), (float)(fr_ * bi + fi_ * br)};
            }
            for (int e = tid; e < 1024; e += NT) { ccv[e] = (f32x2){p.in[11][g * 1024 + e], p.in[12][g * 1024 + e]}; }
            __syncthreads();
            bf16_t* TW2 = (bf16_t*)(ws + O_TW2) + (size_t)g * 512 * UROW;
            bf16_t* W1T = (bf16_t*)(ws + O_W1T) + (size_t)g * 256 * 512;
            if (dl < 32) {
                if (tid < 256) {
                    const int pp = tid >> 4, q = tid & 15;
                    float acc = 0.f;
                    for (int n = 0; n < 64; ++n) {
                        const f32x2 cv = ccv[pp * 64 + n], pv = pw[n], bv = bbv[n * 16 + q];
                        const float xr = cv.x * pv.x - cv.y * pv.y, xi = cv.x * pv.y + cv.y * pv.x;
                        acc += xr * bv.x - xi * bv.y;
                    }
                    if (dl == 0 && pp == q) acc += p.in[13][g * 16 + pp];
                    const bf16_t kb = f2bf(acc);
                    for (int tau = dl; tau < 32; ++tau) { const int s = tau - dl; TW2[(size_t)(tau * 16 + pp) * UROW + s * 16 + q] = kb; }
                    if (dl >= 1) for (int s = dl; s < 32; ++s) { const int tau = s - dl; TW2[(size_t)(tau * 16 + pp) * UROW + s * 16 + q] = 0; }
                }
                const int s = 31 - dl;
                for (int e = tid; e < 2048; e += NT) {
                    const int c = e >> 4, qq = e & 15, n = c & 63, ri = c >> 6;
                    const f32x2 pv = pw[n], bv = bbv[n * 16 + qq];
                    const float zr = pv.x * bv.x - pv.y * bv.y, zi = pv.x * bv.y + pv.y * bv.x;
                    W1T[(size_t)c * 512 + s * 16 + qq] = f2bf(ri ? zi : zr);
                }
            } else {
                u32x4* z = (u32x4*)(W1T + (size_t)128 * 512);
                for (int e = tid; e < 128 * 512 / 8; e += NT) z[e] = (u32x4){0u, 0u, 0u, 0u};
            }
            if (dl >= 1) {
                const int tau = dl - 1;
                for (int e = tid; e < 2048; e += NT) {
                    const int pp = e >> 7, c = e & 127, n = c & 63, ri = c >> 6;
                    const f32x2 cv = ccv[pp * 64 + n], pv = pw[n];
                    const float xr = cv.x * pv.x - cv.y * pv.y, xi = cv.x * pv.y + cv.y * pv.x;
                    TW2[(size_t)(tau * 16 + pp) * UROW + 512 + c] = f2bf(ri ? -xi : xr);
                }
            }
            __syncthreads();
            continue;
        }
        r -= I_S5;
        if (r < 16) {
            const int kv = r >> 3, part = r & 7, j = tid & 127, qtr = tid >> 7;
            const float* pos = p.in[kv ? 19 : 16]; const float* w1 = p.in[kv ? 20 : 17];
            float a = 0.f;
            const int i0 = part * 256 + qtr * 64;
            for (int i = i0; i < i0 + 64; ++i) a += pos[i] * w1[(size_t)i * 128 + j];
            float* red = (float*)smem;
            red[tid] = a;
            __syncthreads();
            if (tid < 128) ((float*)(ws + O_BIAS1))[(kv * 8 + part) * 128 + tid] = (red[tid] + red[tid + 128]) + (red[tid + 256] + red[tid + 384]);
            __syncthreads();
            continue;
        }
        if (tid < 64) ((unsigned*)(ws + O_CNT))[tid] = 0u;
    }
}

__device__ __forceinline__ void phase1(const Params& p, unsigned char*) {
    const float* x = p.in[0];
    bf16_t* xn = (bf16_t*)(p.ws + O_XN);
    for (size_t i = (size_t)blockIdx.x * NT + threadIdx.x; i < (size_t)NTOK * 128; i += (size_t)gridDim.x * NT) {
        const int token = (int)(i >> 7), k = (int)(i & 127) * 8, b = token >> 13;
        const float* ada = (const float*)(p.ws + O_ADA) + b * 6144;
        const f32x4 x0 = *(const f32x4*)(x + (size_t)token * 1024 + k), x1 = *(const f32x4*)(x + (size_t)token * 1024 + k + 4);
        const f32x4 s0 = *(const f32x4*)(ada + 1024 + k), s1 = *(const f32x4*)(ada + 1024 + k + 4);
        const f32x4 h0 = *(const f32x4*)(ada + k), h1 = *(const f32x4*)(ada + k + 4);
        u32x4 o;
        o.x = pk2(x0[0] * (1.f + s0[0]) + h0[0], x0[1] * (1.f + s0[1]) + h0[1]); o.y = pk2(x0[2] * (1.f + s0[2]) + h0[2], x0[3] * (1.f + s0[3]) + h0[3]);
        o.z = pk2(x1[0] * (1.f + s1[0]) + h1[0], x1[1] * (1.f + s1[1]) + h1[1]); o.w = pk2(x1[2] * (1.f + s1[2]) + h1[2], x1[3] * (1.f + s1[3]) + h1[3]);
        *(u32x4*)(xn + (size_t)token * 1024 + k) = o;
    }
}

typedef const f32x4 (&AccRef)[2][2][4][2];
struct EpiIn {
    static constexpr bool PERM = true;
    unsigned char* ws;
    __device__ __forceinline__ void operator()(AccRef acc, const pg8::Unit& u, int wr, int wc, int fr, int fq) const {
        const int pn = u.pn;
#pragma unroll
        for (int ai = 0; ai < 2; ++ai)
#pragma unroll
            for (int m = 0; m < 4; ++m) {
                const int token = u.pm * 256 + ai * 128 + wr * 64 + m * 16 + fr;
#pragma unroll
                for (int bj = 0; bj < 2; ++bj) {
                    const int col = pn * 256 + bj * 128 + wc * 32 + 8 * fq;
                    const f32x4 v0 = acc[ai][bj][m][0], v1 = acc[ai][bj][m][1];
                    if (pn < 2) {
                        const int g = col >> 4, q = col & 15;
                        bf16_t* d = (bf16_t*)(ws + O_U) + ((size_t)(g * 1024 + (token >> 5)) * UROW + (token & 31) * 16 + q);
                        *(u32x4*)d = (u32x4){pk2(v0[0], v0[1]), pk2(v0[2], v0[3]), pk2(v1[0], v1[1]), pk2(v1[2], v1[3])};
                    } else if (pn < 4) {
                        bf16_t* d = (bf16_t*)(ws + O_Q) + (size_t)token * 512 + (col - 512);
                        *(u32x4*)d = (u32x4){pk2(v0[0] * QSCALE, v0[1] * QSCALE), pk2(v0[2] * QSCALE, v0[3] * QSCALE), pk2(v1[0] * QSCALE, v1[1] * QSCALE), pk2(v1[2] * QSCALE, v1[3] * QSCALE)};
                    } else if (pn < 7) {
                        const int c = col - 1024, j6 = c >> 7, g = (c >> 6) & 1, dd = c & 63, b = token >> 13, s = token & 8191;
                        bf16_t* slab = (bf16_t*)(ws + O_KV) + (size_t)((j6 * 4 + b) * 2 + g) * KV_SLAB;
                        if (j6 == 3 || j6 == 5) {
                            const int p64 = s & 63, p16 = p64 & 15, slot = (p16 & 3) | ((p16 & 4) << 1) | ((p16 & 8) >> 1);
                            bf16_t* blkp = slab + (size_t)(s >> 6) * 4096 + (((p64 >> 5) * 2 + ((p64 >> 4) & 1)) * 64 + (slot >> 3) * 32) * 8 + (slot & 7);
#pragma unroll
                            for (int j = 0; j < 4; ++j) { const int d0 = dd + j, d1 = dd + 4 + j;
                                blkp[((d0 >> 5) * 4 * 64 + (d0 & 31)) * 8] = f2bf(v0[j]); blkp[((d1 >> 5) * 4 * 64 + (d1 & 31)) * 8] = f2bf(v1[j]); }
                        } else if (j6 == 2 || j6 == 4) {
                            bf16_t* d = slab + (size_t)((s >> 5) * 4 + (dd >> 4)) * 512 + (((dd >> 3) & 1) * 32 + (s & 31)) * 8;
                            *(u32x4*)d = (u32x4){pk2(v0[0], v0[1]), pk2(v0[2], v0[3]), pk2(v1[0], v1[1]), pk2(v1[2], v1[3])};
                        } else {
                            *(u32x4*)(slab + (size_t)s * 64 + dd) = (u32x4){pk2(v0[0], v0[1]), pk2(v0[2], v0[3]), pk2(v1[0], v1[1]), pk2(v1[2], v1[3])};
                        }
                    } else if (pn < 15) {
                        bf16_t* d = (pn < 11 ? (bf16_t*)(ws + O_SG5) + (size_t)token * 1024 + (col - 1792) : (bf16_t*)(ws + O_SGN) + (size_t)token * 1024 + (col - 2816));
                        *(u32x4*)d = (u32x4){pk2(sigmoidf_(v0[0]), sigmoidf_(v0[1])), pk2(sigmoidf_(v0[2]), sigmoidf_(v0[3])), pk2(sigmoidf_(v1[0]), sigmoidf_(v1[1])), pk2(sigmoidf_(v1[2]), sigmoidf_(v1[3]))};
                    } else {
                        const int c = col - 3840;
                        if (c < 24) { float* d = (float*)(ws + O_GN) + (size_t)token * 24 + c;
                            *(f32x4*)d = (f32x4){sigmoidf_(v0[0]), sigmoidf_(v0[1]), sigmoidf_(v0[2]), sigmoidf_(v0[3])};
                            *(f32x4*)(d + 4) = (f32x4){sigmoidf_(v1[0]), sigmoidf_(v1[1]), sigmoidf_(v1[2]), sigmoidf_(v1[3])}; }
                    }
                }
            }
    }
};
__device__ __forceinline__ void phase2(const Params& p, LAS unsigned char* lds) {
    pg8::DenseOrder S; S.init(p.ws + O_XN, p.ws + O_WT_IN, NTOK, NIN_PAD, 1024, 1024, gridDim.x, blockIdx.x);
    EpiIn E{p.ws};
    pg8::gemm_phase<EpiIn, pg8::DenseOrder, true>(lds, 1024, 1024, 1024, S, E);
}

struct BatchOrder {
    const char* A; const char* B; size_t bsA, bsB, tstepA, tstepB; int nM, nN, nunits, G, c;
    __device__ __forceinline__ bool next(int i, pg8::Unit& u) const {
        const long L = (long)i * G + c; if (L >= nunits) return false;
        const int per = nM * nN, bt = (int)L / per, rem = (int)L % per;
        u.pm = rem / nN; u.pn = rem % nN; u.e = bt; u.nvalid = 256; u.rows = nullptr; u.rmax = 255;
        u.A = A + (size_t)bt * bsA + (size_t)u.pm * tstepA; u.B = B + (size_t)bt * bsB + (size_t)u.pn * tstepB; return true;
    }
};
struct EpiE { static constexpr bool PERM = false; float* E;
    __device__ __forceinline__ void operator()(AccRef acc, const pg8::Unit& u, int wr, int wc, int fr, int fq) const {
#pragma unroll
        for (int ai = 0; ai < 2; ++ai)
#pragma unroll
            for (int m = 0; m < 4; ++m) {
                const int r = u.pm * 256 + ai * 128 + wr * 64 + m * 16 + fr;
#pragma unroll
                for (int n = 0; n < 2; ++n) *(f32x4*)(E + ((size_t)u.e * 1024 + r) * 128 + wc * 32 + n * 16 + fq * 4) = acc[ai][0][m][n];
            }
    } };
struct EpiCmp { static constexpr bool PERM = true; const float* b1p; bf16_t* HC;
    __device__ __forceinline__ void operator()(AccRef acc, const pg8::Unit& u, int wr, int wc, int fr, int fq) const {
        const int col = wc * 32 + 8 * fq;
        f32x4 b0 = (f32x4){0.f, 0.f, 0.f, 0.f}, b1 = b0;
#pragma unroll
        for (int part = 0; part < 8; ++part) { b0 += *(const f32x4*)(b1p + (u.e * 8 + part) * 128 + col); b1 += *(const f32x4*)(b1p + (u.e * 8 + part) * 128 + col + 4); }
#pragma unroll
        for (int ai = 0; ai < 2; ++ai)
#pragma unroll
            for (int m = 0; m < 4; ++m) {
                const int R = u.pm * 256 + ai * 128 + wr * 64 + m * 16 + fr;
                const f32x4 v0 = acc[ai][0][m][0] + b0, v1 = acc[ai][0][m][1] + b1;
                *(u32x4*)(HC + ((size_t)u.e * 4096 + R) * 128 + col) = (u32x4){pk2(gelu_tanh(v0[0]), gelu_tanh(v0[1])), pk2(gelu_tanh(v0[2]), gelu_tanh(v0[3])), pk2(gelu_tanh(v1[0]), gelu_tanh(v1[1])), pk2(gelu_tanh(v1[2]), gelu_tanh(v1[3]))};
            }
    } };
__device__ __forceinline__ void phase3(const Params& p, LAS unsigned char* lds) {
    const int G = gridDim.x;
    {
        BatchOrder S{(const char*)(p.ws + O_U), (const char*)(p.ws + O_W1T), (size_t)1024 * UROW * 2, (size_t)256 * 512 * 2, (size_t)256 * UROW * 2, 0, 4, 1, 128, G, (int)blockIdx.x};
        EpiE E{(float*)(p.ws + O_E)};
        pg8::gemm_phase<EpiE, BatchOrder, false>(lds, 512, UROW, 512, S, E);
    }
    {
        BatchOrder S{(const char*)(p.ws + O_KV), (const char*)(p.ws + O_WT_C1), (size_t)8 * KV_SLAB * 2, (size_t)256 * 2048 * 2, (size_t)256 * 1024 * 2, 0, 16, 1, 32, G, (int)((blockIdx.x + G - 128 % G) % G)};
        EpiCmp E{(const float*)(p.ws + O_BIAS1), (bf16_t*)(p.ws + O_HC)};
        pg8::gemm_phase<EpiCmp, BatchOrder, false>(lds, 2048, 1024, 2048, S, E);
    }
}
__device__ __forceinline__ void phase4(const Params& p, unsigned char* smem) {
    const int tid = threadIdx.x;
    for (int item = blockIdx.x; item < 16 + 512; item += gridDim.x) {
        if (item < 16) {
            f32x2* seg = (f32x2*)smem;
#pragma unroll 1
            for (int half = 0; half < 8; ++half) {
                const int n = tid & 63, sg = tid >> 6, bg = item * 8 + half, b = bg >> 5, g = bg & 31;
                const f32x2 lm = ((const f32x2*)(p.ws + O_LAML))[g * 64 + n];
                const float* E = (const float*)(p.ws + O_E) + (size_t)(g * 1024 + b * 256 + sg * 32) * 128;
                bf16_t* U = (bf16_t*)(p.ws + O_U) + (size_t)(g * 1024 + b * 256 + sg * 32) * UROW + 512;
                float er[32], ei[32];
#pragma unroll
                for (int c = 0; c < 32; ++c) { er[c] = E[(size_t)c * 128 + n]; ei[c] = E[(size_t)c * 128 + 64 + n]; }
                float hr = 0.f, hi = 0.f;
#pragma unroll
                for (int c = 0; c < 32; ++c) { const float nr = lm.x * hr - lm.y * hi + er[c], ni = lm.x * hi + lm.y * hr + ei[c]; hr = nr; hi = ni; }
                seg[sg * 64 + n] = (f32x2){hr, hi};
                float pr = lm.x, pi = lm.y;
#pragma unroll
                for (int q = 0; q < 5; ++q) { const float nr = pr * pr - pi * pi, ni = 2.f * pr * pi; pr = nr; pi = ni; }
                __syncthreads();
                float sr = 0.f, si = 0.f;
                for (int k = 0; k < sg; ++k) { const f32x2 a = seg[k * 64 + n]; const float nr = pr * sr - pi * si + a.x, ni = pr * si + pi * sr + a.y; sr = nr; si = ni; }
                hr = sr; hi = si;
#pragma unroll
                for (int c = 0; c < 32; ++c) {
                    U[(size_t)c * UROW + n] = f2bf(hr); U[(size_t)c * UROW + 64 + n] = f2bf(hi);
                    const float nr = lm.x * hr - lm.y * hi + er[c], ni = lm.x * hi + lm.y * hr + ei[c]; hr = nr; hi = ni;
                }
                __syncthreads();
            }
        } else {
#pragma unroll 1
            for (int rep = 0; rep < 2; ++rep) {
                const int o = ((item - 16) * 2 + rep) * NT + tid, d = o & 63, R = (o >> 6) & 4095, kv = o >> 18;
                const bf16_t* h = (const bf16_t*)(p.ws + O_HC) + ((size_t)kv * 4096 + R) * 128;
                const float* w2 = p.in[kv ? 21 : 18];
                float a = 0.f;
#pragma unroll 8
                for (int j = 0; j < 128; ++j) a += bf2f(h[j]) * w2[j * 64 + d];
                const int bgi = R >> 9, n = R & 511;
                if (kv == 0) ((bf16_t*)(p.ws + O_KC))[(size_t)bgi * 512 * 64 + (size_t)((n >> 5) * 4 + (d >> 4)) * 512 + (((d >> 3) & 1) * 32 + (n & 31)) * 8 + (d & 7)] = f2bf(a);
                else { const int p64 = n & 63, p16 = p64 & 15, slot = (p16 & 3) | ((p16 & 4) << 1) | ((p16 & 8) >> 1);
                       ((bf16_t*)(p.ws + O_KC))[(size_t)4096 * 64 + (size_t)bgi * 64 * 512 + (size_t)(n >> 6) * 4096 + ((((d >> 5) * 2 + (p64 >> 5)) * 2 + ((p64 >> 4) & 1)) * 64 + (slot >> 3) * 32 + (d & 31)) * 8 + (slot & 7)] = f2bf(a); }
            }
        }
    }
    __syncthreads();
    convert_weights(p, smem, TR_ITEMS - TR_GU - TR_DN, TR_ITEMS, (unsigned*)(p.ws + O_CNT) + 40);
}
struct EpiY { static constexpr bool PERM = true; bf16_t* YS;
    __device__ __forceinline__ void operator()(AccRef acc, const pg8::Unit& u, int wr, int wc, int fr, int fq) const {
#pragma unroll
        for (int ai = 0; ai < 2; ++ai)
#pragma unroll
            for (int m = 0; m < 4; ++m) {
                const int r = u.pm * 256 + ai * 128 + wr * 64 + m * 16 + fr;
                const int tok0 = (r >> 8) * SEQ + (r & 255) * S5L;
#pragma unroll
                for (int bj = 0; bj < 2; ++bj) {
                    const int col = u.pn * 256 + bj * 128 + wc * 32 + 8 * fq, tau = col >> 4, pp = col & 15;
                    const f32x4 v0 = acc[ai][bj][m][0], v1 = acc[ai][bj][m][1];
                    *(u32x4*)(YS + (size_t)(tok0 + tau) * 512 + u.e * 16 + pp) = (u32x4){pk2(gelu_tanh(v0[0]), gelu_tanh(v0[1])), pk2(gelu_tanh(v0[2]), gelu_tanh(v0[3])), pk2(gelu_tanh(v1[0]), gelu_tanh(v1[1])), pk2(gelu_tanh(v1[2]), gelu_tanh(v1[3]))};
                }
            }
    } };
__device__ __forceinline__ void phase5(const Params& p, LAS unsigned char* lds) {
    BatchOrder S{(const char*)(p.ws + O_U), (const char*)(p.ws + O_TW2), (size_t)1024 * UROW * 2, (size_t)512 * UROW * 2, (size_t)256 * UROW * 2, (size_t)256 * UROW * 2, 4, 2, 256, (int)gridDim.x, (int)blockIdx.x};
    EpiY E{(bf16_t*)(p.ws + O_YS)};
    pg8::gemm_phase<EpiY, BatchOrder, false>(lds, UROW, UROW, UROW, S, E);
}
struct EpiGlu { static constexpr bool PERM = true; const float* bglu; const bf16_t* SG5; bf16_t* MS5;
    __device__ __forceinline__ void operator()(AccRef acc, const pg8::Unit& u, int wr, int wc, int fr, int fq) const {
        const int cv = u.pn * 128 + wc * 32 + 8 * fq;
        const f32x4 bv0 = *(const f32x4*)(bglu + cv), bv1 = *(const f32x4*)(bglu + cv + 4), bg0 = *(const f32x4*)(bglu + 1024 + cv), bg1 = *(const f32x4*)(bglu + 1024 + cv + 4);
#pragma unroll
        for (int ai = 0; ai < 2; ++ai) {
            u32x4 sgv[4];
#pragma unroll
            for (int m = 0; m < 4; ++m) sgv[m] = *(const u32x4*)(SG5 + (size_t)(u.pm * 256 + ai * 128 + wr * 64 + m * 16 + fr) * 1024 + cv);
#pragma unroll
            for (int m = 0; m < 4; ++m) {
                const int token = u.pm * 256 + ai * 128 + wr * 64 + m * 16 + fr;
                const u32x4 sg = sgv[m];
                const f32x4 va0 = acc[ai][0][m][0] + bv0, va1 = acc[ai][0][m][1] + bv1, ga0 = acc[ai][1][m][0] + bg0, ga1 = acc[ai][1][m][1] + bg1;
                u32x4 o;
                o.x = pk2(va0[0] * sigmoidf_(ga0[0]) * bflo(sg.x), va0[1] * sigmoidf_(ga0[1]) * bfhi(sg.x)); o.y = pk2(va0[2] * sigmoidf_(ga0[2]) * bflo(sg.y), va0[3] * sigmoidf_(ga0[3]) * bfhi(sg.y));
                o.z = pk2(va1[0] * sigmoidf_(ga1[0]) * bflo(sg.z), va1[1] * sigmoidf_(ga1[1]) * bfhi(sg.z)); o.w = pk2(va1[2] * sigmoidf_(ga1[2]) * bflo(sg.w), va1[3] * sigmoidf_(ga1[3]) * bfhi(sg.w));
                *(u32x4*)(MS5 + (size_t)token * 1024 + cv) = o;
            }
        }
    } };
__device__ __forceinline__ void phase6(const Params& p, LAS unsigned char* lds) {
    pg8::DenseOrder S; S.init(p.ws + O_YS, p.ws + O_WT_GLU, NTOK, 2048, 512, 512, gridDim.x, blockIdx.x);
    EpiGlu E{p.in[15], (const bf16_t*)(p.ws + O_SG5), (bf16_t*)(p.ws + O_MS5)};
    pg8::gemm_phase<EpiGlu, pg8::DenseOrder, true>(lds, 512, 512, 512, S, E);
}
typedef float f32x16 __attribute__((ext_vector_type(16)));
__device__ __forceinline__ int rel_bucket_dev(int dist) {
    const int n = dist > 0 ? dist : 0;
    if (n < 16) return n;
    const int l = (int)(__log2f((float)n * 0.0625f) * 2.6666667f);
    const int v = 16 + l;
    return v < 31 ? v : 31;
}
__device__ __forceinline__ float xhalf_max(float v) { auto rr = __builtin_amdgcn_permlane32_swap(__float_as_uint(v), __float_as_uint(v), false, false); return fmaxf(__uint_as_float(rr[0]), __uint_as_float(rr[1])); }
__device__ __forceinline__ float xhalf_sum(float v) { auto rr = __builtin_amdgcn_permlane32_swap(__float_as_uint(v), __float_as_uint(v), false, false); return __uint_as_float(rr[0]) + __uint_as_float(rr[1]); }
__device__ __forceinline__ float quad_sum(float v) {
    v += __uint_as_float(__builtin_amdgcn_update_dpp(0u, __float_as_uint(v), 0xB1, 0xF, 0xF, true));
    v += __uint_as_float(__builtin_amdgcn_update_dpp(0u, __float_as_uint(v), 0x4E, 0xF, 0xF, true));
    return v;
}
constexpr int LSW = 1168;
constexpr int LWW = 656;
constexpr float RESC_THR = 6.f;
constexpr int IMPW = 132;
constexpr float NEG_BIG = -1e30f;

typedef int v4i_t __attribute__((ext_vector_type(4)));
typedef __amdgpu_buffer_rsrc_t rsrc_t;
__device__ __forceinline__ bf16x8 bload16(rsrc_t r, unsigned voff, unsigned soff) { return __builtin_bit_cast(bf16x8, __builtin_amdgcn_raw_buffer_load_b128(r, (int)voff, (int)soff, 0)); }
__device__ __forceinline__ void load_k(bf16x8 (&kf)[8], rsrc_t r, unsigned soff, unsigned voff) {
#pragma unroll
    for (int i = 0; i < 8; ++i) kf[i] = bload16(r, voff, soff + i * 1024);
}
__device__ __forceinline__ void load_v(bf16x8 (&vf)[8], rsrc_t r, unsigned soff, unsigned voff) {
#pragma unroll
    for (int i = 0; i < 8; ++i) vf[i] = bload16(r, voff, soff + i * 1024);
}
__device__ __forceinline__ void qk_block(f32x16 (&st)[2], const bf16x8 (&qf)[4], const bf16x8 (&kf)[8], float cinit) {
#pragma unroll
    for (int sub = 0; sub < 2; ++sub) {
        f32x16 acc;
#pragma unroll
        for (int r = 0; r < 16; ++r) acc[r] = cinit;
#pragma unroll
        for (int s = 0; s < 4; ++s) acc = __builtin_amdgcn_mfma_f32_32x32x16_bf16(kf[sub * 4 + s], qf[s], acc, 0, 0, 0);
        st[sub] = acc;
    }
}
__device__ __forceinline__ void bias_lut(f32x16 (&st)[2], const float* p) {
#pragma unroll
    for (int sub = 0; sub < 2; ++sub)
#pragma unroll
        for (int r = 0; r < 16; ++r) st[sub][r] += p[59 - (32 * sub + (r & 3) + 8 * (r >> 2))];
}
__device__ __forceinline__ void bias_mask_cmp(f32x16 (&st)[2], int dist0, const float* lutS) {
#pragma unroll
    for (int sub = 0; sub < 2; ++sub) {
        float bias[16];
#pragma unroll
        for (int r = 0; r < 16; ++r) {
            const int dist = dist0 - 16 * (32 * sub + (r & 3) + 8 * (r >> 2));
            const int idx = dist < 0 ? 0 : (dist > 1024 ? 1024 : dist);
            bias[r] = lutS[64 + idx];
        }
#pragma unroll
        for (int r = 0; r < 16; ++r) {
            const int dist = dist0 - 16 * (32 * sub + (r & 3) + 8 * (r >> 2));
            const float v = st[sub][r] + bias[r];
            st[sub][r] = dist >= 0 ? v : -INFINITY;
        }
    }
}
__device__ __forceinline__ float tile_max(const f32x16 (&st)[2]) {
    float a = __builtin_fmaxf(__builtin_fmaxf(st[0][0], st[0][1]), st[1][0]), b2 = __builtin_fmaxf(__builtin_fmaxf(st[0][2], st[0][3]), st[1][1]);
    a = __builtin_fmaxf(__builtin_fmaxf(a, st[1][2]), st[1][3]);
#pragma unroll
    for (int r = 4; r < 16; r += 4) {
        a = __builtin_fmaxf(__builtin_fmaxf(a, st[0][r]), st[0][r + 1]); b2 = __builtin_fmaxf(__builtin_fmaxf(b2, st[0][r + 2]), st[0][r + 3]);
        a = __builtin_fmaxf(__builtin_fmaxf(a, st[1][r]), st[1][r + 1]); b2 = __builtin_fmaxf(__builtin_fmaxf(b2, st[1][r + 2]), st[1][r + 3]);
    }
    return xhalf_max(__builtin_fmaxf(a, b2));
}
__device__ __forceinline__ void pv_block(f32x16 (&O)[2], const f32x16 (&st)[2], const bf16x8 (&vf)[8]) {
    bf16x8 pf[2][2];
#pragma unroll
    for (int sub = 0; sub < 2; ++sub)
#pragma unroll
        for (int s2 = 0; s2 < 2; ++s2) {
            u32x4 w;
            w.x = pk2(st[sub][8 * s2 + 0], st[sub][8 * s2 + 1]); w.y = pk2(st[sub][8 * s2 + 2], st[sub][8 * s2 + 3]);
            w.z = pk2(st[sub][8 * s2 + 4], st[sub][8 * s2 + 5]); w.w = pk2(st[sub][8 * s2 + 6], st[sub][8 * s2 + 7]);
            pf[sub][s2] = __builtin_bit_cast(bf16x8, w);
        }
#pragma unroll
    for (int dt = 0; dt < 2; ++dt)
#pragma unroll
        for (int sub = 0; sub < 2; ++sub)
#pragma unroll
            for (int s2 = 0; s2 < 2; ++s2) O[dt] = __builtin_amdgcn_mfma_f32_32x32x16_bf16(vf[dt * 4 + sub * 2 + s2], pf[sub][s2], O[dt], 0, 0, 0);
}
__device__ __forceinline__ void softmax_step(f32x16 (&st)[2], f32x16 (&O)[2], float& m, float& l) {
    const float mx = tile_max(st);
    if (__any(mx > RESC_THR)) {
        const float dl = mx > 0.f ? mx : 0.f;
        const float corr = __builtin_amdgcn_exp2f(-dl);
        m += dl; l *= corr;
#pragma unroll
        for (int sub = 0; sub < 2; ++sub)
#pragma unroll
            for (int r = 0; r < 16; ++r) st[sub][r] -= dl;
#pragma unroll
        for (int dt = 0; dt < 2; ++dt)
#pragma unroll
            for (int r = 0; r < 16; ++r) O[dt][r] *= corr;
    }
    float sum = 0.f;
#pragma unroll
    for (int sub = 0; sub < 2; ++sub)
#pragma unroll
        for (int r = 0; r < 16; ++r) { const float pe = __builtin_amdgcn_exp2f(st[sub][r]); st[sub][r] = pe; sum += pe; }
    l += sum;
}

constexpr int FLW = 68;
__device__ __forceinline__ void kv_step(f32x16 (&O)[2], float& m, float& l, const bf16x8 (&qf)[4], const bf16x8 (&kf)[8], bf16x8 (&kn)[8], rsrc_t rv, unsigned ksoff_next, unsigned koff,
                                        unsigned vsoff_blk, unsigned vvoff, const float* lutp, bool selme, float b31) {
    bf16x8 vf[8];
    load_v(vf, rv, vsoff_blk, vvoff);
    f32x16 st[2];
    qk_block(st, qf, kf, selme ? (lutp ? -m : b31 - m) : -INFINITY);
    __builtin_amdgcn_sched_barrier(0);
    load_k(kn, rv, ksoff_next, koff);
    if (lutp) bias_lut(st, lutp);
    softmax_step(st, O, m, l);
    pv_block(O, st, vf);
}

__device__ __forceinline__ void nsa_tile(const Params& p, int bg, int tg, const float* lutSall, const float* lutWall, float* impw, float* fl, int lane) {
    asm volatile("" : "+v"(lane));
    const int q = lane & 31, h2 = lane >> 5, tok = q >> 2, head = q & 3;
    const int b = bg >> 1, g = bg & 1, t0 = tg * 8, t = t0 + tok, token = b * SEQ + t;
    const float* lutS = lutSall + head * LSW;
    const float* lutW = lutWall + head * LWW;
    const float b31 = lutS[64 + 1024];
    bf16x8 qf[4];
    { const bf16_t* qp = (const bf16_t*)(p.ws + O_Q) + (size_t)token * 512 + (g * 4 + head) * 64 + 8 * h2;
#pragma unroll
      for (int s = 0; s < 4; ++s) qf[s] = *(const bf16x8*)(qp + 16 * s); }
    const float* gn = (const float*)(p.ws + O_GN) + (size_t)token * 24 + (g * 4 + head) * 3;
    float* flp = fl + q * FLW + 4 * h2;
    f32x16 O[2];
#pragma unroll
    for (int dt = 0; dt < 2; ++dt)
#pragma unroll
        for (int r = 0; r < 16; ++r) O[dt][r] = 0.f;
    const int cur = t0 >> 6;
    { const int u = head + 4 * h2;
#pragma unroll
      for (int i = 0; i < 16; ++i) impw[tok * IMPW + i * 8 + u] = 0.f; }
    WAVE_SYNC();
    bf16x8 kfA[8], kfB[8];
    const rsrc_t rKV = __builtin_amdgcn_make_buffer_rsrc((void*)(p.ws + O_KV), 0, (int)(6 * 8 * KV_SLAB * 2 + 8192), 0x00020000);
    const rsrc_t rKC = __builtin_amdgcn_make_buffer_rsrc((void*)(p.ws + O_KC), 0, (int)(2 * 4096 * 64 * 2), 0x00020000);
    const unsigned koff = (unsigned)lane * 16u, vsoff = koff;

    {
        const unsigned Kc = (unsigned)bg * 512u * 64u * 2u;
        const unsigned VcT = (4096u * 64u + (unsigned)bg * 64u * 512u) * 2u;
        const int tl = t0 + 7;
        const int ncmax = tl >= 31 ? ((tl - 31) >> 4) + 1 : 0;
        const int nblk = (ncmax + 63) >> 6;
        float m = NEG_BIG, l = 0.f;
        f32x16 st[2];
#define CMP_FAR(BLK) (16 * (64 * (BLK) + 63) + 31 + 1024 <= t0)
#define CMP_P1(KF, KN, BLK, BN) do { const bool far_ = CMP_FAR(BLK); qk_block(st, qf, KF, far_ ? b31 : 0.f); __builtin_amdgcn_sched_barrier(0); load_k(KN, rKC, Kc + (BN) * 8192, koff); \
            if (!far_) bias_mask_cmp(st, t - 31 - 16 * ((BLK) * 64 + 4 * h2), lutS); \
            const float mn = fmaxf(m, tile_max(st)); float sum = 0.f; \
            _Pragma("unroll") for (int sub = 0; sub < 2; ++sub) _Pragma("unroll") for (int r = 0; r < 16; ++r) sum += __builtin_amdgcn_exp2f(st[sub][r] - mn); \
            l = l * __builtin_amdgcn_exp2f(m - mn) + sum; m = mn; } while (0)
        if (nblk > 0) load_k(kfA, rKC, Kc, koff);
#pragma unroll 1
        for (int blk = 0; blk < nblk; blk += 2) {
            const int b1 = blk + 1 < nblk ? blk + 1 : blk;
            CMP_P1(kfA, kfB, blk, b1);
            if (blk + 1 >= nblk) break;
            const int b2 = blk + 2 < nblk ? blk + 2 : blk + 1;
            CMP_P1(kfB, kfA, blk + 1, b2);
        }
#undef CMP_P1
        l = xhalf_sum(l);
        const float invl = l > 0.f ? 1.f / l : 0.f;
#define CMP_P2(KF, KN, BLK, BN) do { const bool far_ = CMP_FAR(BLK); bf16x8 vf[8]; load_v(vf, rKC, VcT + (BLK) * 8192, koff); \
            qk_block(st, qf, KF, (far_ ? b31 : 0.f) - m); __builtin_amdgcn_sched_barrier(0); load_k(KN, rKC, Kc + (BN) * 8192, koff); \
            if (!far_) bias_mask_cmp(st, t - 31 - 16 * ((BLK) * 64 + 4 * h2), lutS); \
            _Pragma("unroll") for (int sub = 0; sub < 2; ++sub) _Pragma("unroll") for (int r = 0; r < 16; ++r) st[sub][r] = __builtin_amdgcn_exp2f(st[sub][r]) * invl; \
            _Pragma("unroll") for (int sub = 0; sub < 2; ++sub) _Pragma("unroll") for (int a = 0; a < 4; ++a) { \
                const float L_ = quad_sum(st[sub][4 * a + 3]); \
                const float G_ = quad_sum((st[sub][4 * a] + st[sub][4 * a + 1]) + (st[sub][4 * a + 2] + st[sub][4 * a + 3])); \
                const int j_ = (BLK) * 16 + 8 * sub + 2 * a + h2; \
                if (head == 0) { atomicAdd(&impw[tok * IMPW + j_], G_); if (j_ + 1 < 128) atomicAdd(&impw[tok * IMPW + j_ + 1], L_); } } \
            pv_block(O, st, vf); } while (0)
        if (nblk > 0) load_k(kfA, rKC, Kc, koff);
#pragma unroll 1
        for (int blk = 0; blk < nblk; blk += 2) {
            const int b1 = blk + 1 < nblk ? blk + 1 : blk;
            CMP_P2(kfA, kfB, blk, b1);
            if (blk + 1 >= nblk) break;
            const int b2 = blk + 2 < nblk ? blk + 2 : blk + 1;
            CMP_P2(kfB, kfA, blk + 1, b2);
        }
#undef CMP_P2
#undef CMP_FAR
        const float g0 = gn[0];
#pragma unroll
        for (int dt = 0; dt < 2; ++dt)
#pragma unroll
            for (int a = 0; a < 4; ++a) {
                *(f32x4*)(flp + dt * 32 + a * 8) = (f32x4){g0 * O[dt][4 * a], g0 * O[dt][4 * a + 1], g0 * O[dt][4 * a + 2], g0 * O[dt][4 * a + 3]};
                O[dt][4 * a] = 0.f; O[dt][4 * a + 1] = 0.f; O[dt][4 * a + 2] = 0.f; O[dt][4 * a + 3] = 0.f;
            }
    }
    WAVE_SYNC();

    unsigned long long mlo, mhi;
    if (cur < 16) { mlo = (1ull << (cur + 1)) - 1ull; mhi = 0ull; }
    else {
        const int u = head + 4 * h2;
        float val[16];
#pragma unroll
        for (int i = 0; i < 16; ++i) { const int j = i * 8 + u; val[i] = (j >= 1 && j <= cur - 2) ? impw[tok * IMPW + j] : -1.f; }
        mlo = 1ull; mhi = 0ull;
        if (cur < 64) mlo |= 1ull << cur; else mhi |= 1ull << (cur - 64);
        if (cur - 1 < 64) mlo |= 1ull << (cur - 1); else mhi |= 1ull << (cur - 1 - 64);
#pragma unroll 1
        for (int round = 0; round < 13; ++round) {
            float bs = val[0]; int bj = u;
#pragma unroll
            for (int i = 1; i < 16; ++i) { if (val[i] > bs) { bs = val[i]; bj = i * 8 + u; } }
            { const float os = __uint_as_float(__builtin_amdgcn_update_dpp(0u, __float_as_uint(bs), 0xB1, 0xF, 0xF, true)); const int oj = __builtin_amdgcn_update_dpp(0, bj, 0xB1, 0xF, 0xF, true);
              if (os > bs || (os == bs && oj < bj)) { bs = os; bj = oj; } }
            { const float os = __uint_as_float(__builtin_amdgcn_update_dpp(0u, __float_as_uint(bs), 0x4E, 0xF, 0xF, true)); const int oj = __builtin_amdgcn_update_dpp(0, bj, 0x4E, 0xF, 0xF, true);
              if (os > bs || (os == bs && oj < bj)) { bs = os; bj = oj; } }
            { const float os = __shfl_xor(bs, 32); const int oj = __shfl_xor(bj, 32);
              if (os > bs || (os == bs && oj < bj)) { bs = os; bj = oj; } }
            if (bj < 64) mlo |= 1ull << bj; else mhi |= 1ull << (bj - 64);
#pragma unroll
            for (int i = 0; i < 16; ++i) if (i * 8 + u == bj) val[i] = -2.f;
        }
    }
    unsigned long long ulo = mlo, uhi = mhi;
#pragma unroll
    for (int o = 4; o < 32; o <<= 1) { ulo |= __shfl_xor(ulo, o); uhi |= __shfl_xor(uhi, o); }
    ulo = ((unsigned long long)__builtin_amdgcn_readfirstlane((unsigned)(ulo >> 32)) << 32) | (unsigned)__builtin_amdgcn_readfirstlane((unsigned)ulo);
    uhi = ((unsigned long long)__builtin_amdgcn_readfirstlane((unsigned)(uhi >> 32)) << 32) | (unsigned)__builtin_amdgcn_readfirstlane((unsigned)uhi);

    {
        const unsigned Ks = (unsigned)((2 * 4 + b) * 2 + g) * (unsigned)(KV_SLAB * 2);
        const unsigned VsT = (unsigned)((3 * 4 + b) * 2 + g) * (unsigned)(KV_SLAB * 2);
        float m = 0.f, l = 0.f;
#define POPJ(J) do { if (ulo) { J = __builtin_ctzll(ulo); ulo &= ulo - 1ull; } else if (uhi) { J = 64 + __builtin_ctzll(uhi); uhi &= uhi - 1ull; } else J = -1; } while (0)
#define SEL_STEP(KF, KN, J, JN) do { const bool selme_ = (J) < 64 ? ((mlo >> (J)) & 1ull) : ((mhi >> ((J) - 64)) & 1ull); \
            const bool near_ = (64 * (J) + 63 + 1024 > t0); \
            kv_step(O, m, l, qf, KF, KN, rKV, Ks + (JN) * 8192, koff, VsT + (J) * 8192, vsoff, near_ ? lutS + (t - 64 * (J) - 4 * h2 + 64 - 59) : nullptr, selme_, b31); } while (0)
        int ja, jb;
        POPJ(ja);
        load_k(kfA, rKV, Ks + ja * 8192, koff);
#pragma unroll 1
        for (;;) {
            POPJ(jb);
            { const int jn = jb >= 0 ? jb : ja; SEL_STEP(kfA, kfB, ja, jn); }
            if (jb < 0) break;
            POPJ(ja);
            { const int jn = ja >= 0 ? ja : jb; SEL_STEP(kfB, kfA, jb, jn); }
            if (ja < 0) break;
        }
#undef SEL_STEP
#undef POPJ
        l = xhalf_sum(l);
        const float sc = l > 0.f ? gn[1] / l : 0.f;
#pragma unroll
        for (int dt = 0; dt < 2; ++dt)
#pragma unroll
            for (int a = 0; a < 4; ++a) {
                f32x4 f = *(const f32x4*)(flp + dt * 32 + a * 8);
                f[0] += sc * O[dt][4 * a]; f[1] += sc * O[dt][4 * a + 1]; f[2] += sc * O[dt][4 * a + 2]; f[3] += sc * O[dt][4 * a + 3];
                *(f32x4*)(flp + dt * 32 + a * 8) = f;
                O[dt][4 * a] = 0.f; O[dt][4 * a + 1] = 0.f; O[dt][4 * a + 2] = 0.f; O[dt][4 * a + 3] = 0.f;
            }
    }
    {
        const unsigned Kw = (unsigned)((4 * 4 + b) * 2 + g) * (unsigned)(KV_SLAB * 2);
        const unsigned VwT = (unsigned)((5 * 4 + b) * 2 + g) * (unsigned)(KV_SLAB * 2);
        float m = 0.f, l = 0.f;
        const int wlo = t0 - 511;
        const int r_begin = (wlo > 0 ? wlo : 0) & ~63;
        const int r_last = t0 + 7;
#define WIN_STEP(KF, KN, R0, RN) kv_step(O, m, l, qf, KF, KN, rKV, Kw + (RN) * 128, koff, VwT + (R0) * 128, vsoff, lutW + (t - (R0) - 4 * h2 + 72 - 59), true, b31)
        load_k(kfA, rKV, Kw + r_begin * 128, koff);
#pragma unroll 1
        for (int row0 = r_begin; row0 <= r_last; row0 += 128) {
            { const int rn = row0 + 64 <= r_last ? row0 + 64 : row0; WIN_STEP(kfA, kfB, row0, rn); }
            if (row0 + 64 > r_last) break;
            { const int rn = row0 + 128 <= r_last ? row0 + 128 : row0 + 64; WIN_STEP(kfB, kfA, row0 + 64, rn); }
        }
#undef WIN_STEP
        l = xhalf_sum(l);
        const float sc = l > 0.f ? gn[2] / l : 0.f;
        bf16_t* op = (bf16_t*)(p.ws + O_ONSA) + (size_t)token * 512 + (g * 4 + head) * 64 + 4 * h2;
#pragma unroll
        for (int dt = 0; dt < 2; ++dt)
#pragma unroll
            for (int a = 0; a < 4; ++a) {
                const f32x4 f = *(const f32x4*)(flp + dt * 32 + a * 8);
                *(u32x2*)(op + dt * 32 + a * 8) = (u32x2){pk2(f[0] + sc * O[dt][4 * a], f[1] + sc * O[dt][4 * a + 1]), pk2(f[2] + sc * O[dt][4 * a + 2], f[3] + sc * O[dt][4 * a + 3])};
            }
    }
    WAVE_SYNC();
}

__device__ __forceinline__ void phase7(const Params& p, unsigned char* smem) {
    const int tid = threadIdx.x, lane = tid & 63, wid = __builtin_amdgcn_readfirstlane(tid >> 6);
    float* lutS = (float*)smem;
    float* lutW = lutS + 4 * LSW;
    float* impw = lutW + 4 * LWW + wid * 8 * IMPW;
    float* fl = lutW + 4 * LWW + NWV * 8 * IMPW + wid * 32 * FLW;
    const int bg = blockIdx.x & 7, g = bg & 1;
    for (int i = tid; i < 4 * LSW; i += NT) { const int head = i / LSW, dist = i % LSW - 64;
        lutS[i] = dist < 0 ? -INFINITY : p.in[2][rel_bucket_dev(dist) * 8 + g * 4 + head] * LOG2E; }
    for (int i = tid; i < 4 * LWW; i += NT) { const int head = i / LWW, dist = i % LWW - 72;
        lutW[i] = (dist < 0 || dist >= 512) ? -INFINITY : p.in[2][rel_bucket_dev(dist) * 8 + g * 4 + head] * LOG2E; }
    __syncthreads();
    const int nblk_bg = (gridDim.x - bg + 7) >> 3;
    const int W = nblk_bg * NWV, w = (blockIdx.x >> 3) * NWV + wid;
#pragma unroll 1
    for (int round = 0; ; ++round) {
        const int idx = round * W + ((round & 1) ? (W - 1 - w) : w);
        if (idx >= 1024) break;
        nsa_tile(p, bg, 1023 - idx, lutS, lutW, impw, fl, lane);
    }
    __syncthreads();
}

struct EpiNsa { static constexpr bool PERM = true; const bf16_t* SGN; bf16_t* MS5;
    __device__ __forceinline__ void operator()(AccRef acc, const pg8::Unit& u, int wr, int wc, int fr, int fq) const {
#pragma unroll
        for (int ai = 0; ai < 2; ++ai)
#pragma unroll
            for (int mh = 0; mh < 4; mh += 2) {
                u32x4 sgv[2][2], msv[2][2];
#pragma unroll
                for (int m = 0; m < 2; ++m)
#pragma unroll
                    for (int bj = 0; bj < 2; ++bj) {
                        const size_t off = (size_t)(u.pm * 256 + ai * 128 + wr * 64 + (mh + m) * 16 + fr) * 1024 + u.pn * 256 + bj * 128 + wc * 32 + 8 * fq;
                        sgv[m][bj] = *(const u32x4*)(SGN + off); msv[m][bj] = *(const u32x4*)(MS5 + off);
                    }
#pragma unroll
                for (int m = 0; m < 2; ++m)
#pragma unroll
                    for (int bj = 0; bj < 2; ++bj) {
                        const size_t off = (size_t)(u.pm * 256 + ai * 128 + wr * 64 + (mh + m) * 16 + fr) * 1024 + u.pn * 256 + bj * 128 + wc * 32 + 8 * fq;
                        const u32x4 sg = sgv[m][bj], ms = msv[m][bj];
                        const f32x4 v0 = acc[ai][bj][mh + m][0], v1 = acc[ai][bj][mh + m][1];
                        u32x4 o;
                        o.x = pk2(bflo(ms.x) + bflo(sg.x) * v0[0], bfhi(ms.x) + bfhi(sg.x) * v0[1]); o.y = pk2(bflo(ms.y) + bflo(sg.y) * v0[2], bfhi(ms.y) + bfhi(sg.y) * v0[3]);
                        o.z = pk2(bflo(ms.z) + bflo(sg.z) * v1[0], bfhi(ms.z) + bfhi(sg.z) * v1[1]); o.w = pk2(bflo(ms.w) + bflo(sg.w) * v1[2], bfhi(ms.w) + bfhi(sg.w) * v1[3]);
                        *(u32x4*)(MS5 + off) = o;
                    }
            }
    } };
__device__ __forceinline__ void phase8(const Params& p, LAS unsigned char* lds) {
    pg8::DenseOrder S; S.init(p.ws + O_ONSA, p.ws + O_WT_NSA, NTOK, 1024, 512, 512, gridDim.x, blockIdx.x);
    EpiNsa E{(const bf16_t*)(p.ws + O_SGN), (bf16_t*)(p.ws + O_MS5)};
    pg8::gemm_phase<EpiNsa, pg8::DenseOrder, true>(lds, 512, 512, 512, S, E);
}
struct EpiOut { static constexpr bool PERM = false; const float* x; const float* ada; float* Z1;
    __device__ __forceinline__ void operator()(AccRef acc, const pg8::Unit& u, int wr, int wc, int fr, int fq) const {
        const float* ga = ada + (u.pm >> 5) * 6144 + 2048;
        f32x4 gv[2][2];
#pragma unroll
        for (int bj = 0; bj < 2; ++bj)
#pragma unroll
            for (int n = 0; n < 2; ++n) gv[bj][n] = *(const f32x4*)(ga + u.pn * 256 + bj * 128 + wc * 32 + n * 16 + fq * 4);
#pragma unroll
        for (int ai = 0; ai < 2; ++ai)
#pragma unroll
            for (int mh = 0; mh < 4; mh += 2) {
                f32x4 xv[2][2][2];
#pragma unroll
                for (int m = 0; m < 2; ++m)
#pragma unroll
                    for (int bj = 0; bj < 2; ++bj)
#pragma unroll
                        for (int n = 0; n < 2; ++n) xv[m][bj][n] = *(const f32x4*)(x + (size_t)(u.pm * 256 + ai * 128 + wr * 64 + (mh + m) * 16 + fr) * 1024 + u.pn * 256 + bj * 128 + wc * 32 + n * 16 + fq * 4);
#pragma unroll
                for (int m = 0; m < 2; ++m)
#pragma unroll
                    for (int bj = 0; bj < 2; ++bj)
#pragma unroll
                        for (int n = 0; n < 2; ++n)
                            *(f32x4*)(Z1 + (size_t)(u.pm * 256 + ai * 128 + wr * 64 + (mh + m) * 16 + fr) * 1024 + u.pn * 256 + bj * 128 + wc * 32 + n * 16 + fq * 4) = xv[m][bj][n] * DN_ALPHA + gv[bj][n] * acc[ai][bj][mh + m][n];
            }
    } };
__device__ __forceinline__ void phase9(const Params& p, LAS unsigned char* lds) {
    pg8::DenseOrder S; S.init(p.ws + O_MS5, p.ws + O_WT_OUT, NTOK, 1024, 1024, 1024, gridDim.x, blockIdx.x);
    EpiOut E{p.in[0], (const float*)(p.ws + O_ADA), (float*)(p.ws + O_Z1)};
    pg8::gemm_phase<EpiOut, pg8::DenseOrder, true>(lds, 1024, 1024, 1024, S, E);
}

__device__ __forceinline__ void phase10(const Params& p, unsigned char* smem) {
    const int tid = threadIdx.x, lane = tid & 63, wid = tid >> 6;
    float* hs = (float*)smem + wid * 1024;
    const float* lg = p.in[24]; const float* lb = p.in[25]; const float* wr_ = p.in[26]; const float* br_ = p.in[27];
    unsigned* cnt = (unsigned*)(p.ws + O_CNT);
    for (int item = blockIdx.x; item < NTOK / NWV; item += gridDim.x) {
        const int token = item * NWV + wid, b = token >> 13;
        float* zr = (float*)(p.ws + O_Z1) + (size_t)token * 1024;
        const float* ada = (const float*)(p.ws + O_ADA) + b * 6144;
        f32x4 v[4]; float s = 0.f;
#pragma unroll
        for (int j = 0; j < 4; ++j) { v[j] = *(const f32x4*)(zr + j * 256 + lane * 4); s += (v[j][0] + v[j][1]) + (v[j][2] + v[j][3]); }
        const float mean = wave_sum(s) * (1.f / 1024.f); float q = 0.f;
#pragma unroll
        for (int j = 0; j < 4; ++j) { v[j] = v[j] - mean; q += (v[j][0] * v[j][0] + v[j][1] * v[j][1]) + (v[j][2] * v[j][2] + v[j][3] * v[j][3]); }
        const float rstd = rsqrtf(wave_sum(q) * (1.f / 1024.f) + LN_EPS);
        unsigned char* h2 = p.ws + O_H2 + (size_t)token * 1024;
#pragma unroll
        for (int j = 0; j < 4; ++j) {
            const int c = j * 256 + lane * 4;
            const f32x4 x1 = v[j] * rstd * *(const f32x4*)(lg + c) + *(const f32x4*)(lb + c);
            *(f32x4*)(zr + c) = x1;
            const f32x4 hv = x1 * (*(const f32x4*)(ada + 4096 + c) + 1.f) + *(const f32x4*)(ada + 3072 + c);
            *(f32x4*)(hs + c) = hv;
            *(unsigned*)(h2 + c) = pk4_f8(hv[0], hv[1], hv[2], hv[3]);
        }
        WAVE_SYNC();
        const int e = lane & 31, kh = lane >> 5;
        float a = 0.f;
#pragma unroll 8
        for (int k = kh * 512; k < kh * 512 + 512; ++k) a += hs[k] * wr_[k * 32 + e];
        a += __shfl_xor(a, 32);
        a += br_[e];
        float val = a; int te[4]; float tv[4];
#pragma unroll
        for (int r = 0; r < 4; ++r) {
            float bs = val; int bj = e;
#pragma unroll
            for (int o = 1; o < 32; o <<= 1) { const float os = __shfl_xor(bs, o); const int oj = __shfl_xor(bj, o); if (os > bs || (os == bs && oj < bj)) { bs = os; bj = oj; } }
            te[r] = bj; tv[r] = bs;
            if (e == bj) val = -INFINITY;
        }
        const float e0 = 1.f, e1 = __expf(tv[1] - tv[0]), e2 = __expf(tv[2] - tv[0]), e3 = __expf(tv[3] - tv[0]);
        const float inv = 1.f / (e0 + e1 + e2 + e3);
        if (lane < 4) {
            const int ee = lane == 0 ? te[0] : (lane == 1 ? te[1] : (lane == 2 ? te[2] : te[3]));
            const float gg = (lane == 0 ? e0 : (lane == 1 ? e1 : (lane == 2 ? e2 : e3))) * inv;
            const unsigned pos = atomicAdd(cnt + ee, 1u);
            ((int*)(p.ws + O_TOPE))[token * 4 + lane] = ee;
            ((unsigned*)(p.ws + O_TOPP))[token * 4 + lane] = pos;
            ((float*)(p.ws + O_TOPG))[token * 4 + lane] = gg;
        }
        WAVE_SYNC();
    }
}

__device__ __forceinline__ void load_offsets(const Params& p, int* offs  , int* toff  ) {
    if (threadIdx.x < 64) {
        const int lane = threadIdx.x;
        const int c = lane < 32 ? (int)((const unsigned*)(p.ws + O_CNT))[lane] : 0;
        int a = c, t = (c + 255) >> 8;
#pragma unroll
        for (int o = 1; o < 32; o <<= 1) { const int ua = __shfl_up(a, o), ut = __shfl_up(t, o); if ((lane & 31) >= o) { a += ua; t += ut; } }
        if (lane < 32) { offs[lane] = a - c; toff[lane] = t - ((c + 255) >> 8); if (lane == 31) { offs[32] = a; toff[32] = t; } }
    }
    __syncthreads();
}
__device__ __forceinline__ void phase11(const Params& p, unsigned char* smem) {
    int* offs = (int*)(smem + LDS_TAB); int* toff = offs + 40;
    load_offsets(p, offs, toff);
    const int* tope = (const int*)(p.ws + O_TOPE); const unsigned* topp = (const unsigned*)(p.ws + O_TOPP); const float* topg = (const float*)(p.ws + O_TOPG);
    float* rowgate = (float*)(p.ws + O_ROWGATE); int* tokrow = (int*)(p.ws + O_TOKROW); int* rowtok = (int*)(p.ws + O_ROWTOK);
    for (int i = blockIdx.x * NT + threadIdx.x; i < NROWS; i += gridDim.x * NT) {
        const int R = offs[tope[i]] + (int)topp[i];
        rowgate[R] = topg[i]; tokrow[i] = R; rowtok[R] = i >> 2;
    }
    __syncthreads();
}

struct MoeOrder {
    const int* offs; const int* toff; const char* A; const char* B; const int* rowtok; size_t bsB; int nN, G, c;
    __device__ __forceinline__ bool next(int i, pg8::Unit& u) const {
        const int v = (G % 8 == 0) ? (c % 8) * (G / 8) + c / 8 : c;
        const long L = (long)i * G + v; if (L >= (long)toff[32] * nN) return false;
        const int tile = (int)L / nN, pn = (int)L % nN;
        int e = 0;
#pragma unroll 1
        while (toff[e + 1] <= tile) ++e;
        e = __builtin_amdgcn_readfirstlane(e);
        const int r0 = __builtin_amdgcn_readfirstlane(offs[e] + (tile - toff[e]) * 256);
        u.pm = r0; u.pn = pn; u.e = e; u.nvalid = __builtin_amdgcn_readfirstlane(offs[e + 1]) - r0;
        if (rowtok) { u.A = A; u.rows = rowtok + r0; const int rm = NROWS - 1 - r0; u.rmax = rm < 255 ? rm : 255; }
        else { u.A = A + (size_t)r0 * 1024; u.rows = nullptr; u.rmax = 255; }
        u.B = B + (size_t)e * bsB + (size_t)pn * 256 * 1024; return true;
    }
};
struct EpiGU { static constexpr bool PERM = true; const float* bgu; unsigned char* ACT;
    __device__ __forceinline__ void operator()(AccRef acc, const pg8::Unit& u, int wr, int wc, int fr, int fq) const {
        const int cv = u.pn * 128 + wc * 32 + 8 * fq;
        const float* bb = bgu + (size_t)u.e * 2048;
        const float ws_ = 1.f / WGU_SCALE;
        const f32x4 bg0 = *(const f32x4*)(bb + cv), bg1 = *(const f32x4*)(bb + cv + 4), bu0 = *(const f32x4*)(bb + 1024 + cv), bu1 = *(const f32x4*)(bb + 1024 + cv + 4);
#pragma unroll
        for (int ai = 0; ai < 2; ++ai)
#pragma unroll
            for (int m = 0; m < 4; ++m) {
                const int lr = ai * 128 + wr * 64 + m * 16 + fr;
                const int row = lr < u.nvalid ? u.pm + lr : NROWS + lr;
                const f32x4 ga0 = acc[ai][0][m][0] * ws_ + bg0, ga1 = acc[ai][0][m][1] * ws_ + bg1, ua0 = acc[ai][1][m][0] * ws_ + bu0, ua1 = acc[ai][1][m][1] * ws_ + bu1;
                float o[8];
#pragma unroll
                for (int j = 0; j < 4; ++j) {
                    const float gt0 = fminf(ga0[j], 7.f), up0 = fminf(fmaxf(ua0[j], -7.f), 7.f); o[j] = (up0 + 1.f) * gt0 * sigmoidf_(1.702f * gt0);
                    const float gt1 = fminf(ga1[j], 7.f), up1 = fminf(fmaxf(ua1[j], -7.f), 7.f); o[4 + j] = (up1 + 1.f) * gt1 * sigmoidf_(1.702f * gt1);
                }
                *(u32x2*)(ACT + (size_t)row * 1024 + cv) = (u32x2){pk4_f8(o[0], o[1], o[2], o[3]), pk4_f8(o[4], o[5], o[6], o[7])};
            }
    } };
__device__ __forceinline__ void phase12(const Params& p, unsigned char* smem, LAS unsigned char* lds) {
    int* offs = (int*)(smem + LDS_TAB); int* toff = offs + 40;
    load_offsets(p, offs, toff);
    MoeOrder S{offs, toff, (const char*)(p.ws + O_H2), (const char*)(p.ws + O_WT_GU), (const int*)(p.ws + O_ROWTOK), (size_t)2048 * 1024, 8, (int)gridDim.x, (int)blockIdx.x};
    EpiGU E{p.in[29], p.ws + O_ACT};
    pg8::gemm_phase<EpiGU, MoeOrder, true, true>(lds, 512, 512, 512, S, E);
    __syncthreads();
}
struct EpiDn { static constexpr bool PERM = true; const float* bd; const float* rowgate; bf16_t* YK;
    __device__ __forceinline__ void operator()(AccRef acc, const pg8::Unit& u, int wr, int wc, int fr, int fq) const {
        const float* bb = bd + (size_t)u.e * 1024;
        f32x4 bv[2][2]; float gw[2][4];
#pragma unroll
        for (int bj = 0; bj < 2; ++bj) { const int col = u.pn * 256 + bj * 128 + wc * 32 + 8 * fq; bv[bj][0] = *(const f32x4*)(bb + col); bv[bj][1] = *(const f32x4*)(bb + col + 4); }
#pragma unroll
        for (int ai = 0; ai < 2; ++ai)
#pragma unroll
            for (int m = 0; m < 4; ++m) gw[ai][m] = rowgate[u.pm + ai * 128 + wr * 64 + m * 16 + fr];
#pragma unroll
        for (int ai = 0; ai < 2; ++ai)
#pragma unroll
            for (int m = 0; m < 4; ++m) {
                const int lr = ai * 128 + wr * 64 + m * 16 + fr;
                const int row = lr < u.nvalid ? u.pm + lr : NROWS + lr;
#pragma unroll
                for (int bj = 0; bj < 2; ++bj) {
                    const int col = u.pn * 256 + bj * 128 + wc * 32 + 8 * fq;
                    const f32x4 v0 = (acc[ai][bj][m][0] * (1.f / WDN_SCALE) + bv[bj][0]) * gw[ai][m], v1 = (acc[ai][bj][m][1] * (1.f / WDN_SCALE) + bv[bj][1]) * gw[ai][m];
                    *(u32x4*)(YK + (size_t)row * 1024 + col) = (u32x4){pk2(v0[0], v0[1]), pk2(v0[2], v0[3]), pk2(v1[0], v1[1]), pk2(v1[2], v1[3])};
                }
            }
    } };
__device__ __forceinline__ void phase13(const Params& p, unsigned char* smem, LAS unsigned char* lds) {
    int* offs = (int*)(smem + LDS_TAB); int* toff = offs + 40;
    load_offsets(p, offs, toff);
    MoeOrder S{offs, toff, (const char*)(p.ws + O_ACT), (const char*)(p.ws + O_WT_DN), nullptr, (size_t)1024 * 1024, 4, (int)gridDim.x, (int)blockIdx.x};
    EpiDn E{p.in[31], (const float*)(p.ws + O_ROWGATE), (bf16_t*)(p.ws + O_YK)};
    pg8::gemm_phase<EpiDn, MoeOrder, true, true>(lds, 512, 512, 512, S, E);
    __syncthreads();
}

__device__ __forceinline__ void phase14(const Params& p, unsigned char*) {
    const int tid = threadIdx.x, lane = tid & 63, wid = tid >> 6;
    const float* lg = p.in[32]; const float* lb = p.in[33];
    const int* tokrow = (const int*)(p.ws + O_TOKROW);
    const bf16_t* YK = (const bf16_t*)(p.ws + O_YK);
    for (int item = blockIdx.x; item < NTOK / NWV; item += gridDim.x) {
        const int token = item * NWV + wid, b = token >> 13;
        const float* x1 = (const float*)(p.ws + O_Z1) + (size_t)token * 1024;
        const float* gf = (const float*)(p.ws + O_ADA) + b * 6144 + 5120;
        const int r0 = tokrow[token * 4 + 0], r1 = tokrow[token * 4 + 1], r2 = tokrow[token * 4 + 2], r3 = tokrow[token * 4 + 3];
        f32x4 v[4]; float s = 0.f;
#pragma unroll
        for (int j = 0; j < 4; ++j) {
            const int c = j * 256 + lane * 4;
            const u32x2 a0 = *(const u32x2*)(YK + (size_t)r0 * 1024 + c), a1 = *(const u32x2*)(YK + (size_t)r1 * 1024 + c), a2 = *(const u32x2*)(YK + (size_t)r2 * 1024 + c), a3 = *(const u32x2*)(YK + (size_t)r3 * 1024 + c);
            f32x4 y;
            y[0] = (bflo(a0.x) + bflo(a1.x)) + (bflo(a2.x) + bflo(a3.x)); y[1] = (bfhi(a0.x) + bfhi(a1.x)) + (bfhi(a2.x) + bfhi(a3.x));
            y[2] = (bflo(a0.y) + bflo(a1.y)) + (bflo(a2.y) + bflo(a3.y)); y[3] = (bfhi(a0.y) + bfhi(a1.y)) + (bfhi(a2.y) + bfhi(a3.y));
            v[j] = *(const f32x4*)(x1 + c) * DN_ALPHA + *(const f32x4*)(gf + c) * y;
            s += (v[j][0] + v[j][1]) + (v[j][2] + v[j][3]);
        }
        const float mean = wave_sum(s) * (1.f / 1024.f); float q = 0.f;
#pragma unroll
        for (int j = 0; j < 4; ++j) { v[j] = v[j] - mean; q += (v[j][0] * v[j][0] + v[j][1] * v[j][1]) + (v[j][2] * v[j][2] + v[j][3] * v[j][3]); }
        const float rstd = rsqrtf(wave_sum(q) * (1.f / 1024.f) + LN_EPS);
#pragma unroll
        for (int j = 0; j < 4; ++j) { const int c = j * 256 + lane * 4; *(f32x4*)(p.out + (size_t)token * 1024 + c) = v[j] * rstd * *(const f32x4*)(lg + c) + *(const f32x4*)(lb + c); }
    }
}


#define XB_TMO      128
#define XB_XCNT(j)  (256  + 64 * (j))
#define XB_XSUB(j)  (1280 + 64 * (j))
#define XB_XGEN(j)  (2304 + 64 * (j))
#define XB_TOP      3328
#define XB_TOPGEN   3392
#define XB_SPIN_CAP (1u << 20)
__device__ __forceinline__ unsigned xb_ld(unsigned* p)              { return __hip_atomic_load(p, __ATOMIC_RELAXED, __HIP_MEMORY_SCOPE_AGENT); }
__device__ __forceinline__ unsigned xb_add(unsigned* p, unsigned v) { return __hip_atomic_fetch_add(p, v, __ATOMIC_RELAXED, __HIP_MEMORY_SCOPE_AGENT); }
__device__ __forceinline__ unsigned xb_xcc_id() { return (unsigned)__builtin_amdgcn_s_getreg((3 << 11) | 20) & 0xFu; }
#define XB_SPIN(cond, bar) do { unsigned _sp = 0; while (cond) { __builtin_amdgcn_s_sleep(1); \
    if ((++_sp & 255u) == 0u) { if (xb_ld(&(bar)[XB_TMO])) break; if (_sp > XB_SPIN_CAP) { atomicAdd(&(bar)[XB_TMO], 1u); break; } } } } while (0)
struct XcdBarrier { unsigned* bar; unsigned x; volatile LAS unsigned* st; };
__device__ __forceinline__ XcdBarrier xcd_barrier_post(unsigned* bar, volatile LAS unsigned* st) {
    XcdBarrier b; b.bar = bar; b.x = xb_xcc_id(); b.st = st;
    if (threadIdx.x == 0) (void)xb_add(&bar[XB_XCNT(b.x)], 1u);
    return b;
}
__device__ __forceinline__ void xcd_barrier_complete(unsigned* bar, unsigned x, unsigned& nloc, unsigned& nx) {
    const unsigned G = gridDim.x * gridDim.y * gridDim.z;
    unsigned sum, cnt, mine, sp = 0u;
    for (;;) {
        sum = 0u; cnt = 0u; mine = 0u;
#pragma unroll
        for (unsigned j = 0; j < 16; ++j) { const unsigned c = xb_ld(&bar[XB_XCNT(j)]); sum += c; cnt += (c > 0u) ? 1u : 0u; mine = (j == x) ? c : mine; }
        if (sum == G) break;
        __builtin_amdgcn_s_sleep(1);
        if ((++sp & 255u) == 0u) { if (xb_ld(&bar[XB_TMO])) break; if (sp > XB_SPIN_CAP) { atomicAdd(&bar[XB_TMO], 1u); break; } }
    }
    nloc = mine > 0u ? mine : 1u; nx = cnt > 0u ? cnt : 1u;
}
__device__ __forceinline__ void xcd_barrier(const XcdBarrier& b) {
    asm volatile("s_waitcnt vmcnt(0)" ::: "memory");
    __syncthreads();
    if (threadIdx.x == 0) {
        unsigned* bar = b.bar;
        __builtin_amdgcn_s_waitcnt(0);
        unsigned nloc = b.st[0], nx = b.st[1];
        if (nloc == 0u) { xcd_barrier_complete(bar, b.x, nloc, nx); b.st[0] = nloc; b.st[1] = nx; }
        const unsigned old = xb_add(&bar[XB_XSUB(b.x)], 1u);
        const unsigned gen = old / nloc;
        if (old + 1u == (gen + 1u) * nloc) {
            __builtin_amdgcn_fence(__ATOMIC_RELEASE, "agent");
            asm volatile("s_waitcnt vmcnt(0)" ::: "memory");
            const unsigned og = xb_add(&bar[XB_TOP], 1u);
            const unsigned tg = og / nx;
            if (og + 1u == (tg + 1u) * nx) xb_add(&bar[XB_TOPGEN], 1u);
            else XB_SPIN(xb_ld(&bar[XB_TOPGEN]) == tg, bar);
            __builtin_amdgcn_fence(__ATOMIC_ACQUIRE, "agent");
            xb_add(&bar[XB_XGEN(b.x)], 1u);
            asm volatile("s_waitcnt vmcnt(0)" ::: "memory");
        } else {
            XB_SPIN(xb_ld(&bar[XB_XGEN(b.x)]) == gen, bar);
            __builtin_amdgcn_fence(__ATOMIC_ACQUIRE, "agent");
            asm volatile("s_waitcnt vmcnt(0)" ::: "memory");
        }
    }
    __syncthreads();
}

#if defined(__HIP_DEVICE_COMPILE__)
typedef const __attribute__((address_space(4))) Params* KernargPtr;
__device__ __forceinline__ KernargPtr opaque_kernarg() { KernargPtr kp = (KernargPtr)__builtin_amdgcn_kernarg_segment_ptr(); asm volatile("" : "+s"(kp)); return kp; }
#define GAS __attribute__((address_space(1)))
__device__ __forceinline__ Params load_params() {
    Params r; const __attribute__((address_space(4))) unsigned long long* s = (const __attribute__((address_space(4))) unsigned long long*)opaque_kernarg();
#pragma unroll
    for (int i = 0; i < 34; ++i) r.in[i] = (const float*)(const GAS float*)s[i];
    r.out = (float*)(GAS float*)s[34]; r.ws = (unsigned char*)(GAS unsigned char*)s[35];
    const unsigned long long pp = s[36]; r.ph_lo = (int)(unsigned)pp; r.ph_hi = (int)(unsigned)(pp >> 32);
    return r; }
#else
#define opaque_kernarg() (&p_unused)
#endif
#if defined(__HIP_DEVICE_COMPILE__)
#define PARAMS_NOW() load_params()
#else
#define PARAMS_NOW() p_unused
#endif
template <bool COOP>
__global__ void __launch_bounds__(NT, 2) fwd_kernel(Params p_unused) {
    extern __shared__ __attribute__((aligned(16))) unsigned char smem[];
    LAS unsigned char* lds = (LAS unsigned char*)smem;
    const int lo = opaque_kernarg()->ph_lo, hi = opaque_kernarg()->ph_hi;
    volatile LAS unsigned* bst = (volatile LAS unsigned*)(lds + LDS_BYTES - 16);
    if (threadIdx.x == 0) { bst[0] = 0u; bst[1] = 0u; }
    __syncthreads();
    XcdBarrier gbar; gbar.bar = nullptr; gbar.x = 0; gbar.st = bst;
    if (COOP) { const Params p0 = PARAMS_NOW(); gbar = xcd_barrier_post((unsigned*)(p0.ws + O_BAR), bst); }
#define SEAM(k) do { if ((k) == 0) cg::this_grid().sync(); else xcd_barrier(gbar); } while (0)
#define RUN_PHASE(k, call) if (((PH_MASK >> (k)) & 1) && lo <= (k) && (k) < hi) { _Pragma("unroll 1") for (int rep_ = 0; rep_ < 1 + ((REPEAT_MASK >> (k)) & 1); ++rep_) { if (rep_) { if (COOP) SEAM(1); } const Params p = PARAMS_NOW(); call; } } if (COOP) { if (lo <= (k) && (k) + 1 < hi) SEAM(k); }
    RUN_PHASE(0, phase0(p, smem))
    RUN_PHASE(1, phase1(p, smem))
    RUN_PHASE(2, phase2(p, lds))
    RUN_PHASE(3, phase3(p, lds))
    RUN_PHASE(4, phase4(p, smem))
    RUN_PHASE(5, phase5(p, lds))
    RUN_PHASE(6, phase6(p, lds))
    RUN_PHASE(7, phase7(p, smem))
    RUN_PHASE(8, phase8(p, lds))
    RUN_PHASE(9, phase9(p, lds))
    RUN_PHASE(10, phase10(p, smem))
    RUN_PHASE(11, phase11(p, smem))
    RUN_PHASE(12, phase12(p, smem, lds))
    RUN_PHASE(13, phase13(p, smem, lds))
    RUN_PHASE(14, phase14(p, smem))
#undef RUN_PHASE
#undef SEAM
}

extern "C" void kernel_launch(void* const* d_in, const int* in_sizes, int n_in, void* d_out, int out_size, void* d_ws, size_t ws_size, hipStream_t stream) {
    static int grid = 0;
    if (grid == 0) {
        if (n_in != 34 || out_size != NTOK * DM || ws_size < WS_NEED) { fprintf(stderr, "kernel_launch: unexpected problem (n_in %d, out %d, ws %zu need %zu)\n", n_in, out_size, ws_size, (size_t)WS_NEED); grid = -1; return; }
        int dev = 0, cus = 0, per_cu = 0;
        (void)hipGetDevice(&dev);
        (void)hipDeviceGetAttribute(&cus, hipDeviceAttributeMultiprocessorCount, dev);
#if ONE_LAUNCH
        (void)hipFuncSetAttribute((const void*)fwd_kernel<true>, hipFuncAttributeMaxDynamicSharedMemorySize, LDS_BYTES);
        (void)hipOccupancyMaxActiveBlocksPerMultiprocessor(&per_cu, fwd_kernel<true>, NT, LDS_BYTES);
#else
        (void)hipFuncSetAttribute((const void*)fwd_kernel<false>, hipFuncAttributeMaxDynamicSharedMemorySize, LDS_BYTES);
        (void)hipOccupancyMaxActiveBlocksPerMultiprocessor(&per_cu, fwd_kernel<false>, NT, LDS_BYTES);
#endif
        if (per_cu < 1) { fprintf(stderr, "kernel_launch: occupancy query reports %d blocks per CU\n", per_cu); per_cu = 1; }
        grid = cus * per_cu;
        fprintf(stderr, "kernel_launch: grid %d (%d CUs x %d)\n", grid, cus, per_cu);
    }
    if (grid < 0) return;
    Params p{};
    for (int i = 0; i < 34; ++i) p.in[i] = (const float*)d_in[i];
    p.out = (float*)d_out; p.ws = (unsigned char*)d_ws;
#if ONE_LAUNCH
    if (hipMemsetAsync((char*)d_ws + O_BAR, 0, BAR_BYTES, stream) != hipSuccess) { fprintf(stderr, "kernel_launch: memset of the barrier words failed\n"); return; }
    p.ph_lo = 0; p.ph_hi = NPHASE;
    void* args[] = {&p};
    hipError_t e = hipLaunchCooperativeKernel((void*)fwd_kernel<true>, dim3(grid), dim3(NT), args, LDS_BYTES, stream);
    if (e != hipSuccess) fprintf(stderr, "cooperative launch failed: %s (grid %d)\n", hipGetErrorString(e), grid);
#else
    for (int ph = 0; ph < NPHASE; ++ph) {
        p.ph_lo = ph; p.ph_hi = ph + 1;
        hipLaunchKernelGGL(fwd_kernel<false>, dim3(grid), dim3(NT), LDS_BYTES, stream, p);
    }
#endif
}
```

```cpp
#include <hip/hip_runtime.h>
#include <hip/hip_cooperative_groups.h>
#include <cstdio>
#include <cstdint>
namespace cg = cooperative_groups;

#ifndef PH_MASK
#define PH_MASK 0xFFFFF
#endif
#ifndef REPEAT_MASK
#define REPEAT_MASK 0
#endif
#ifndef ONE_LAUNCH
#define ONE_LAUNCH 1
#endif

#define LAS __attribute__((address_space(3)))
typedef unsigned short bf16_t;
typedef short bf16x8 __attribute__((ext_vector_type(8)));
typedef float f32x4 __attribute__((ext_vector_type(4)));
typedef float f32x2 __attribute__((ext_vector_type(2)));
typedef unsigned u32x4 __attribute__((ext_vector_type(4)));
typedef unsigned u32x2 __attribute__((ext_vector_type(2)));
typedef __bf16 bf16x2_t __attribute__((ext_vector_type(2)));

constexpr int NB = 4, SEQ = 8192, NTOK = NB * SEQ, DM = 1024;
constexpr int NIN_PAD = 4096;
constexpr int NEXP = 32, TOPK = 4, NROWS = NTOK * TOPK;
constexpr int S5L = 32;
constexpr int NCHUNK = SEQ / S5L;
constexpr int UROW = 640;
constexpr float DN_ALPHA = 1.189207115002721f;
constexpr float LN_EPS = 1e-5f;
constexpr float LOG2E = 1.4426950408889634f;
constexpr float QSCALE = 0.125f * 1.4426950408889634f;
constexpr float WGU_SCALE = 32.f, WDN_SCALE = 64.f;
constexpr int NT = 512;
constexpr int NWV = NT / 64;

constexpr size_t al256(size_t x) { return (x + 255) & ~(size_t)255; }
constexpr size_t O_ADA = 0;
constexpr size_t O_CNT = O_ADA + al256(4 * 6144 * 4);
constexpr size_t O_BAR = O_CNT + 8192;
constexpr size_t BAR_BYTES = 3456 * 4;
constexpr size_t O_LAML = O_BAR + al256(BAR_BYTES);
constexpr size_t O_BIAS1 = O_LAML + al256(32 * 64 * 2 * 4);
constexpr size_t O_WT_IN = O_BIAS1 + al256(2 * 8 * 128 * 4);
constexpr size_t O_WT_GLU = O_WT_IN + al256((size_t)NIN_PAD * 1024);
constexpr size_t O_WT_NSA = O_WT_GLU + al256((size_t)2048 * 512 * 2);
constexpr size_t O_WT_OUT = O_WT_NSA + al256((size_t)1024 * 512 * 2);
constexpr size_t O_WT_C1 = O_WT_OUT + al256((size_t)1024 * 1024 * 2);
constexpr size_t O_W1T = O_WT_C1 + al256((size_t)2 * 256 * 2048 * 2);
constexpr size_t O_TW2 = O_W1T + al256((size_t)32 * 256 * 512 * 2);
constexpr size_t O_WT_GU = O_TW2 + al256((size_t)32 * 512 * 640 * 2);
constexpr size_t O_WT_DN = O_WT_GU + al256((size_t)32 * 2048 * 1024);
constexpr size_t O_H2 = O_WT_DN + al256((size_t)32 * 1024 * 1024);
constexpr size_t O_Z1 = O_H2 + al256((size_t)NTOK * 1024);
constexpr size_t O_TOPE = O_Z1 + al256((size_t)NTOK * 1024 * 4);
constexpr size_t O_TOPP = O_TOPE + al256((size_t)NROWS * 4);
constexpr size_t O_TOPG = O_TOPP + al256((size_t)NROWS * 4);
constexpr size_t O_ROWTOK = O_TOPG + al256((size_t)NROWS * 4);
constexpr size_t O_ROWGATE = O_ROWTOK + al256((size_t)NEXP * NTOK * 4);
constexpr size_t O_OVL = O_ROWGATE + al256((size_t)NEXP * NTOK * 4 + 1024);
constexpr size_t O_U = O_OVL;
constexpr size_t O_E = O_U + al256((size_t)32 * 1024 * UROW * 2);
constexpr size_t O_YS = O_E + al256((size_t)32 * 1024 * 128 * 4);
constexpr size_t O_Q = O_YS + al256((size_t)NTOK * 512 * 2);
constexpr size_t O_KV = O_Q + al256((size_t)NTOK * 512 * 2);
constexpr size_t KV_SLAB = (size_t)SEQ * 64;
constexpr size_t O_SG5 = O_KV + al256((size_t)6 * 8 * KV_SLAB * 2 + 8192);
constexpr size_t O_SGN = O_SG5 + al256((size_t)NTOK * 1024 * 2);
constexpr size_t O_GN = O_SGN + al256((size_t)NTOK * 1024 * 2);
constexpr size_t O_MS5 = O_GN + al256((size_t)NTOK * 24 * 4);
constexpr size_t O_ONSA = O_MS5 + al256((size_t)NTOK * 1024 * 2);
constexpr size_t O_HC = O_ONSA + al256((size_t)NTOK * 512 * 2);
constexpr size_t O_KC = O_HC + al256((size_t)2 * 4096 * 128 * 2);
constexpr size_t O_XN = O_KC + al256((size_t)2 * 4096 * 64 * 2);
constexpr size_t O_END1 = O_XN + al256((size_t)NTOK * 1024);
constexpr size_t O_ACT = O_OVL;
constexpr size_t O_YK = O_ACT + al256((size_t)(NROWS + 256) * 1024);
constexpr size_t O_END2 = O_YK + al256((size_t)(NROWS + 256) * 1024 * 2);
constexpr size_t WS_NEED = O_END1 > O_END2 ? O_END1 : O_END2;
static_assert(WS_NEED <= (size_t)1073741824, "workspace map exceeds 1 GiB");

constexpr int LDS_BYTES = 147456;
constexpr int LDS_TAB = 131072;
constexpr int NPHASE = 15;

struct Params {
    const float* in[34];
    float* out;
    unsigned char* ws;
    int ph_lo, ph_hi;
};

__device__ __forceinline__ unsigned pk2(float lo, float hi) { f32x2 v = {lo, hi}; bf16x2_t b = __builtin_convertvector(v, bf16x2_t); return __builtin_bit_cast(unsigned, b); }
__device__ __forceinline__ bf16_t f2bf(float f) { return (bf16_t)(pk2(f, 0.f) & 0xffffu); }
__device__ __forceinline__ float bf2f(bf16_t h) { return __uint_as_float(((unsigned)h) << 16); }
__device__ __forceinline__ float bflo(unsigned w) { return __uint_as_float(w << 16); }
__device__ __forceinline__ float bfhi(unsigned w) { return __uint_as_float(w & 0xffff0000u); }
#define LOG2E_F 1.4426950408889634f
__device__ __forceinline__ unsigned pk4_f8(float a, float b, float c, float d) { int w = 0; w = __builtin_amdgcn_cvt_pk_fp8_f32(a, b, w, false); w = __builtin_amdgcn_cvt_pk_fp8_f32(c, d, w, true); return (unsigned)w; }
__device__ __forceinline__ float sigmoidf_(float x) { return __builtin_amdgcn_rcpf(1.f + __builtin_amdgcn_exp2f(-LOG2E_F * x)); }
__device__ __forceinline__ float gelu_tanh(float x) { const float u = 0.7978845608028654f * (x + 0.044715f * x * x * x); const float e = __builtin_amdgcn_exp2f((2.f * LOG2E_F) * u); return x * (1.f - __builtin_amdgcn_rcpf(e + 1.f)); }
__device__ __forceinline__ float wave_sum(float v) {
#pragma unroll
    for (int o = 1; o < 64; o <<= 1) v += __shfl_xor(v, o);
    return v;
}
#define WAVE_SYNC() do { __builtin_amdgcn_fence(__ATOMIC_RELEASE, "wavefront"); __builtin_amdgcn_wave_barrier(); __builtin_amdgcn_fence(__ATOMIC_ACQUIRE, "wavefront"); } while (0)

#define XB_TMO      128
#define XB_XCNT(j)  (256  + 64 * (j))
#define XB_XSUB(j)  (1280 + 64 * (j))
#define XB_XGEN(j)  (2304 + 64 * (j))
#define XB_TOP      3328
#define XB_TOPGEN   3392
#define XB_SPIN_CAP (1u << 20)
__device__ __forceinline__ unsigned xb_ld(unsigned* p)              { return __hip_atomic_load(p, __ATOMIC_RELAXED, __HIP_MEMORY_SCOPE_AGENT); }
__device__ __forceinline__ unsigned xb_add(unsigned* p, unsigned v) { return __hip_atomic_fetch_add(p, v, __ATOMIC_RELAXED, __HIP_MEMORY_SCOPE_AGENT); }
__device__ __forceinline__ unsigned xb_xcc_id() { return (unsigned)__builtin_amdgcn_s_getreg((3 << 11) | 20) & 0xFu; }
#define XB_SPIN(cond, bar) do { unsigned _sp = 0; while (cond) { __builtin_amdgcn_s_sleep(1); \
    if ((++_sp & 255u) == 0u) { if (xb_ld(&(bar)[XB_TMO])) break; if (_sp > XB_SPIN_CAP) { atomicAdd(&(bar)[XB_TMO], 1u); break; } } } } while (0)
struct XcdBarrier { unsigned* bar; unsigned x; volatile LAS unsigned* st; };
__device__ __forceinline__ XcdBarrier xcd_barrier_post(unsigned* bar, volatile LAS unsigned* st) {
    XcdBarrier b; b.bar = bar; b.x = xb_xcc_id(); b.st = st;
    if (threadIdx.x == 0) (void)xb_add(&bar[XB_XCNT(b.x)], 1u);
    return b;
}
__device__ __forceinline__ void xcd_barrier_complete(unsigned* bar, unsigned x, unsigned& nloc, unsigned& nx) {
    const unsigned G = gridDim.x * gridDim.y * gridDim.z;
    unsigned sum, cnt, mine, sp = 0u;
    for (;;) {
        sum = 0u; cnt = 0u; mine = 0u;
#pragma unroll
        for (unsigned j = 0; j < 16; ++j) { const unsigned c = xb_ld(&bar[XB_XCNT(j)]); sum += c; cnt += (c > 0u) ? 1u : 0u; mine = (j == x) ? c : mine; }
        if (sum == G) break;
        __builtin_amdgcn_s_sleep(1);
        if ((++sp & 255u) == 0u) { if (xb_ld(&bar[XB_TMO])) break; if (sp > XB_SPIN_CAP) { atomicAdd(&bar[XB_TMO], 1u); break; } }
    }
    nloc = mine > 0u ? mine : 1u; nx = cnt > 0u ? cnt : 1u;
}
__device__ __forceinline__ void xcd_barrier(const XcdBarrier& b) {
    asm volatile("s_waitcnt vmcnt(0)" ::: "memory");
    __syncthreads();
    if (threadIdx.x == 0) {
        unsigned* bar = b.bar;
        __builtin_amdgcn_s_waitcnt(0);
        unsigned nloc = b.st[0], nx = b.st[1];
        if (nloc == 0u) { xcd_barrier_complete(bar, b.x, nloc, nx); b.st[0] = nloc; b.st[1] = nx; }
        const unsigned old = xb_add(&bar[XB_XSUB(b.x)], 1u);
        const unsigned gen = old / nloc;
        if (old + 1u == (gen + 1u) * nloc) {
            __builtin_amdgcn_fence(__ATOMIC_RELEASE, "agent");
            asm volatile("s_waitcnt vmcnt(0)" ::: "memory");
            const unsigned og = xb_add(&bar[XB_TOP], 1u);
            const unsigned tg = og / nx;
            if (og + 1u == (tg + 1u) * nx) xb_add(&bar[XB_TOPGEN], 1u);
            else XB_SPIN(xb_ld(&bar[XB_TOPGEN]) == tg, bar);
            __builtin_amdgcn_fence(__ATOMIC_ACQUIRE, "agent");
            xb_add(&bar[XB_XGEN(b.x)], 1u);
            asm volatile("s_waitcnt vmcnt(0)" ::: "memory");
        } else {
            XB_SPIN(xb_ld(&bar[XB_XGEN(b.x)]) == gen, bar);
            __builtin_amdgcn_fence(__ATOMIC_ACQUIRE, "agent");
            asm volatile("s_waitcnt vmcnt(0)" ::: "memory");
        }
    }
    __syncthreads();
}


namespace pg8 {
typedef int v8i_t __attribute__((ext_vector_type(8)));
typedef int v4i8_t __attribute__((ext_vector_type(4)));
constexpr int BM = 256, BK = 64, HALF = 128, HTB = HALF * BK * 2, STAGE_BYTES = 8 * HTB;
__device__ __forceinline__ int lds_byte(int r, int c) { const int st = (r >> 4) * 2 + (c >> 5), rr = r & 15, cc = c & 31, ob = rr * 64 + cc * 2; return st * 1024 + (ob ^ (((ob >> 9) & 1) << 5)); }
__device__ __forceinline__ void stage_rc(int b, int& R, int& C) { const int st = b / 1024, sb = b % 1024, swz = sb ^ (((sb >> 9) & 1) << 5); R = (st >> 1) * 16 + swz / 64; C = (st & 1) * 32 + (swz % 64) / 2; }
__device__ __forceinline__ int perm32(int rho) { const int n = rho >> 4, i = rho & 15; return 8 * (i >> 2) + 4 * n + (i & 3); }
struct Unit { const char* A; const char* B; const int* rows; int pm, pn, e, nvalid, rmax, gidx; };

template <class Epi, class Sched, bool ALIGN_EPI, bool F8 = false>
__device__ __forceinline__ void gemm_phase(LAS unsigned char* lds, const int K, const int lda, const int ldb, const Sched& S, const Epi& E) {
    const int tid = threadIdx.x, wid = __builtin_amdgcn_readfirstlane(tid >> 6), lane = tid & 63, wr = wid >> 2, wc = wid & 3, fr = lane & 15, fq = lane >> 4;
    const int nt = K / BK;
    unsigned voffB[2]; int Ra[2], Ca[2];
#pragma unroll
    for (int i = 0; i < 2; ++i) { int R, C; stage_rc(tid * 16 + i * 8192, R, C); const int Rb = Epi::PERM ? ((R & ~31) + perm32(R & 31)) : R;
        Ra[i] = R; Ca[i] = C; voffB[i] = (unsigned)(Rb * ldb + C) * 2u; }
    unsigned offC[2][2], offN[2][2];
#define PG8_SETOFF(o, u) do { _Pragma("unroll") for (int h_ = 0; h_ < 2; ++h_) _Pragma("unroll") for (int i_ = 0; i_ < 2; ++i_) { \
        if ((u).rows) { int ix_ = h_ * HALF + Ra[i_]; ix_ = ix_ < (u).rmax ? ix_ : (u).rmax; o[h_][i_] = (unsigned)(u).rows[ix_] * (unsigned)(lda * 2) + (unsigned)Ca[i_] * 2u; } \
        else o[h_][i_] = (unsigned)((h_ * HALF + Ra[i_]) * lda + Ca[i_]) * 2u; } } while (0)
    const size_t kstep = (size_t)(BK * 2);
    const size_t hstepB = (size_t)HALF * ldb * 2;
    const unsigned ldsw = (unsigned)wid * 1024u;
    const int aoff = lds_byte(wr * 64 + fr, fq * 8), boff = lds_byte(wc * 32 + fr, fq * 8);
#define PG8_SA(b, h) (((b) * 2 + (h)) * HTB)
#define PG8_SB(b, h) ((4 + (b) * 2 + (h)) * HTB)
#define PG8_STAGE(bufoff, gbase, voff) do { _Pragma("unroll") for (int _i = 0; _i < 2; ++_i) \
        __builtin_amdgcn_global_load_lds((const unsigned*)((const char*)(gbase) + (voff)[_i]), (LAS unsigned*)(lds + (bufoff) + ldsw + _i * 8192), 16, 0, 0); } while (0)
#define PG8_LDA(dst, b, h) do { _Pragma("unroll") for (int m = 0; m < 4; ++m) { \
        if constexpr (F8) dst##8[m] = __builtin_shufflevector(*(const LAS v4i8_t*)(lds + PG8_SA(b, h) + aoff + m * 2048), *(const LAS v4i8_t*)(lds + PG8_SA(b, h) + aoff + m * 2048 + 1024), 0, 1, 2, 3, 4, 5, 6, 7); \
        else { _Pragma("unroll") for (int k = 0; k < 2; ++k) dst[m][k] = *(const LAS bf16x8*)(lds + PG8_SA(b, h) + aoff + m * 2048 + k * 1024); } } } while (0)
#define PG8_LDB(dst, b, h) do { _Pragma("unroll") for (int n = 0; n < 2; ++n) { \
        if constexpr (F8) dst##8[n] = __builtin_shufflevector(*(const LAS v4i8_t*)(lds + PG8_SB(b, h) + boff + n * 2048), *(const LAS v4i8_t*)(lds + PG8_SB(b, h) + boff + n * 2048 + 1024), 0, 1, 2, 3, 4, 5, 6, 7); \
        else { _Pragma("unroll") for (int k = 0; k < 2; ++k) dst[n][k] = *(const LAS bf16x8*)(lds + PG8_SB(b, h) + boff + n * 2048 + k * 1024); } } } while (0)
#define PG8_MMA(ai, bj, At, Bt) do { __builtin_amdgcn_s_setprio(1); _Pragma("unroll") for (int m = 0; m < 4; ++m) _Pragma("unroll") for (int n = 0; n < 2; ++n) { \
        if constexpr (F8) asm volatile("v_mfma_scale_f32_16x16x128_f8f6f4 %0, %1, %2, %0, %3, %3 op_sel_hi:[0,0,0]" : "+v"(acc[ai][bj][m][n]) : "v"(Bt##8[n]), "v"(At##8[m]), "v"(f8scale_));   \
        else { _Pragma("unroll") for (int k = 0; k < 2; ++k) acc[ai][bj][m][n] = __builtin_amdgcn_mfma_f32_16x16x32_bf16(Bt[n][k], At[m][k], acc[ai][bj][m][n], 0, 0, 0); } } \
        __builtin_amdgcn_s_setprio(0); } while (0)
#define PG8_WAIT_V(n) asm volatile("s_waitcnt vmcnt(" #n ")" ::: "memory")
#define PG8_WAIT_L(n) asm volatile("s_waitcnt lgkmcnt(" #n ")" ::: "memory")
#define PG8_BAR __builtin_amdgcn_s_barrier()
#define PG8_SCHED __builtin_amdgcn_sched_barrier(0)
    Unit cur, nxt; int ui = 0;
    if (!S.next(0, cur)) return;
    f32x4 acc[2][2][4][2];
#pragma unroll
    for (int a = 0; a < 2; ++a)
#pragma unroll
        for (int b = 0; b < 2; ++b)
#pragma unroll
            for (int m = 0; m < 4; ++m)
#pragma unroll
                for (int n = 0; n < 2; ++n) acc[a][b][m][n] = (f32x4){0.f, 0.f, 0.f, 0.f};
    bf16x8 At[4][2], B0[2][2], B1[2][2];
    v8i_t At8[4], B08[2], B18[2];
    const int f8scale_ = 0x7F7F7F7F;
    const char* cA = cur.A; const char* cB = cur.B;
    PG8_SETOFF(offC, cur);
    PG8_STAGE(PG8_SB(0, 0), cB, voffB); PG8_STAGE(PG8_SB(0, 1), cB + hstepB, voffB); PG8_STAGE(PG8_SA(0, 0), cA, offC[0]); PG8_STAGE(PG8_SA(0, 1), cA, offC[1]);
    if (wr == 1) PG8_BAR;
    PG8_WAIT_V(2); PG8_BAR;
    PG8_STAGE(PG8_SB(1, 0), cB + kstep, voffB); PG8_STAGE(PG8_SA(1, 0), cA + kstep, offC[0]); PG8_STAGE(PG8_SB(1, 1), cB + hstepB + kstep, voffB);
    PG8_WAIT_V(6); PG8_BAR;
    for (;;) {
        const bool has_next = S.next(ui + 1, nxt);
        const char* nA = has_next ? nxt.A : cA; const char* nB = has_next ? nxt.B : cB;
        if (has_next) { PG8_SETOFF(offN, nxt); } else { offN[0][0] = offC[0][0]; offN[0][1] = offC[0][1]; offN[1][0] = offC[1][0]; offN[1][1] = offC[1][1]; }
#pragma unroll 1
        for (int t = 0; t < nt; t += 2) {
            const bool last = (t == nt - 2);
            const char* a1 = cA + (size_t)(t + 1) * kstep;
            const char* a2 = last ? nA : cA + (size_t)(t + 2) * kstep; const char* b2 = last ? nB : cB + (size_t)(t + 2) * kstep;
            const char* a3 = a2 + kstep; const char* b3 = b2 + kstep;
            unsigned o2[2][2];
            o2[0][0] = last ? offN[0][0] : offC[0][0]; o2[0][1] = last ? offN[0][1] : offC[0][1]; o2[1][0] = last ? offN[1][0] : offC[1][0]; o2[1][1] = last ? offN[1][1] : offC[1][1];
            PG8_LDB(B0, 0, 0); PG8_LDB(B1, 0, 1); PG8_SCHED; PG8_LDA(At, 0, 0); PG8_STAGE(PG8_SA(1, 1), a1, offC[1]);
            PG8_WAIT_V(8); PG8_WAIT_L(0); PG8_BAR; PG8_MMA(0, 0, At, B0); PG8_MMA(0, 1, At, B1); PG8_BAR; PG8_SCHED;
            PG8_LDA(At, 0, 1); PG8_STAGE(PG8_SB(0, 0), b2, voffB); PG8_STAGE(PG8_SB(0, 1), b2 + hstepB, voffB); PG8_STAGE(PG8_SA(0, 0), a2, o2[0]);
            PG8_WAIT_V(8); PG8_WAIT_L(0); PG8_BAR; PG8_MMA(1, 0, At, B0); PG8_MMA(1, 1, At, B1); PG8_BAR; PG8_SCHED;
            PG8_LDB(B0, 1, 0); PG8_LDB(B1, 1, 1); PG8_SCHED; PG8_LDA(At, 1, 0); PG8_STAGE(PG8_SA(0, 1), a2, o2[1]);
            PG8_WAIT_V(8); PG8_WAIT_L(0); PG8_BAR; PG8_MMA(0, 0, At, B0); PG8_MMA(0, 1, At, B1); PG8_BAR; PG8_SCHED;
            PG8_LDA(At, 1, 1); PG8_STAGE(PG8_SB(1, 0), b3, voffB); PG8_STAGE(PG8_SB(1, 1), b3 + hstepB, voffB); PG8_STAGE(PG8_SA(1, 0), a3, o2[0]);
            PG8_WAIT_V(8); PG8_WAIT_L(0); PG8_BAR; PG8_MMA(1, 0, At, B0); PG8_MMA(1, 1, At, B1); PG8_BAR; PG8_SCHED;
        }
        if constexpr (ALIGN_EPI) { if (wr == 0) PG8_BAR; }
        if constexpr (F8) asm volatile("s_nop 15\n\ts_nop 15" ::: "memory");
        E(acc, cur, wr, wc, fr, fq);
        if (!has_next) break;
#pragma unroll
        for (int a = 0; a < 2; ++a)
#pragma unroll
            for (int b = 0; b < 2; ++b)
#pragma unroll
                for (int m = 0; m < 4; ++m)
#pragma unroll
                    for (int n = 0; n < 2; ++n) acc[a][b][m][n] = (f32x4){0.f, 0.f, 0.f, 0.f};
        cur = nxt; cA = nA; cB = nB; ++ui;
        offC[0][0] = offN[0][0]; offC[0][1] = offN[0][1]; offC[1][0] = offN[1][0]; offC[1][1] = offN[1][1];
        if constexpr (ALIGN_EPI) { if (wr == 1) PG8_BAR; }
    }
    PG8_WAIT_V(0);
    if constexpr (!ALIGN_EPI) { if (wr == 0) PG8_BAR; }
    PG8_BAR;
#undef PG8_SETOFF
#undef PG8_SA
#undef PG8_SB
#undef PG8_STAGE
#undef PG8_LDA
#undef PG8_LDB
#undef PG8_MMA
#undef PG8_WAIT_V
#undef PG8_WAIT_L
#undef PG8_BAR
#undef PG8_SCHED
}

struct DenseOrder {
    const char* A; const char* B; size_t tstepA, tstepB; int nM, nN, nwg, G, c;
    __device__ __forceinline__ void init(const void* A_, const void* B_, int M, int N, int lda, int ldb, int G_, int c_) {
        A = (const char*)A_; B = (const char*)B_; tstepA = (size_t)BM * lda * 2; tstepB = (size_t)BM * ldb * 2; nM = M / BM; nN = N / BM; nwg = nM * nN; G = G_; c = c_; }
    __device__ __forceinline__ bool next(int i, Unit& u) const {
        const long L = (long)i * G + c; if (L >= nwg) return false;
        int wgid = (int)L; { const int q = nwg / 8, r = nwg % 8, xcd = wgid % 8, off = wgid / 8; wgid = (xcd < r ? xcd * (q + 1) : r * (q + 1) + (xcd - r) * q) + off; }
        const int nig = 8 * nN, gid = wgid / nig, fm = gid * 8, gsz = (nM - fm) < 8 ? (nM - fm) : 8;
        u.pm = fm + ((wgid % nig) % gsz); u.pn = (wgid % nig) / gsz; u.e = 0; u.nvalid = 256; u.rows = nullptr; u.rmax = 255;
        u.A = A + (size_t)u.pm * tstepA; u.B = B + (size_t)u.pn * tstepB; return true;
    }
};
}

__device__ __forceinline__ int map_in(int n) { return n < 1792 ? n : (n < 3840 ? n + 24 : (n < 3864 ? 1792 + (n - 3840) : -1)); }
__device__ __forceinline__ int map_il128(int n) { const int b = n >> 7; return (b & 1) * 1024 + (b >> 1) * 128 + (n & 127); }

struct TrJob { const float* W; bf16_t* Wt; int K, Nsrc, map, kt, nt; float f8scale; };
constexpr int TR_IN = 16 * 16, TR_GLU = 8 * 8, TR_NSA = 8 * 4, TR_OUT = 16 * 4, TR_C1 = 2 * 32, TR_GU = 32 * 16 * 8, TR_DN = 32 * 16 * 4;
constexpr int TR_ITEMS = TR_IN + TR_GLU + TR_NSA + TR_OUT + TR_C1 + TR_GU + TR_DN;
__device__ __forceinline__ void tr_job(const Params& p, int r, TrJob& j) {
    unsigned char* ws = p.ws;
    if (r < TR_IN) { j = TrJob{p.in[5], (bf16_t*)(ws + O_WT_IN), 1024, 3864, 1, r / 16, r % 16, WGU_SCALE}; return; } r -= TR_IN;
    if (r < TR_GLU) { j = TrJob{p.in[14], (bf16_t*)(ws + O_WT_GLU), 512, 2048, 2, r / 8, r % 8, 0.f}; return; } r -= TR_GLU;
    if (r < TR_NSA) { j = TrJob{p.in[22], (bf16_t*)(ws + O_WT_NSA), 512, 1024, 0, r / 4, r % 4, 0.f}; return; } r -= TR_NSA;
    if (r < TR_OUT) { j = TrJob{p.in[23], (bf16_t*)(ws + O_WT_OUT), 1024, 1024, 0, r / 4, r % 4, 0.f}; return; } r -= TR_OUT;
    if (r < TR_C1) { const int kv = r / 32; j = TrJob{p.in[kv ? 20 : 17], (bf16_t*)(ws + O_WT_C1) + (size_t)kv * 256 * 2048, 2048, 128, 3, r % 32, 0, 0.f}; return; } r -= TR_C1;
    if (r < TR_GU) { const int e = r / 128, q = r % 128; j = TrJob{p.in[28] + (size_t)e * 1024 * 2048, (bf16_t*)(ws + O_WT_GU + (size_t)e * 2048 * 1024), 1024, 2048, 2, q / 8, q % 8, WGU_SCALE}; return; } r -= TR_GU;
    { const int e = r / 64, q = r % 64; j = TrJob{p.in[30] + (size_t)e * 1024 * 1024, (bf16_t*)(ws + O_WT_DN + (size_t)e * 1024 * 1024), 1024, 1024, 0, q / 4, q % 4, WDN_SCALE}; }
}
__device__ __forceinline__ void tr_load(const TrJob& j, f32x4 (&v)[8], int tid) {
    const int n4 = tid & 63, kq = tid >> 6, nd = j.nt * 256 + 4 * n4;
    const int src = j.map == 0 ? nd : (j.map == 1 ? map_in(nd) : (j.map == 2 ? map_il128(nd) : (nd < 128 ? nd : -1)));
    const float* base = j.W + (size_t)(j.kt * 64 + kq) * j.Nsrc + (src >= 0 ? src : 0);
#pragma unroll
    for (int i = 0; i < 8; ++i) v[i] = (src >= 0) ? *(const f32x4*)(base + (size_t)i * 8 * j.Nsrc) : (f32x4){0.f, 0.f, 0.f, 0.f};
}
__device__ __forceinline__ void tr_store(const TrJob& cj, const float* t, int tid) {
    if (cj.f8scale != 0.f) {
        const int n = tid & 255, kh = (tid >> 8) * 32; const float sc = cj.f8scale;
        unsigned char* d = (unsigned char*)cj.Wt + (size_t)(cj.nt * 256 + n) * cj.K + cj.kt * 64 + kh;
#pragma unroll
        for (int q = 0; q < 2; ++q) {
            const float* c = t + (kh + 16 * q) * 260 + n;
            u32x4 o;
            o.x = pk4_f8(c[0] * sc, c[260] * sc, c[2 * 260] * sc, c[3 * 260] * sc); o.y = pk4_f8(c[4 * 260] * sc, c[5 * 260] * sc, c[6 * 260] * sc, c[7 * 260] * sc);
            o.z = pk4_f8(c[8 * 260] * sc, c[9 * 260] * sc, c[10 * 260] * sc, c[11 * 260] * sc); o.w = pk4_f8(c[12 * 260] * sc, c[13 * 260] * sc, c[14 * 260] * sc, c[15 * 260] * sc);
            *(u32x4*)(d + 16 * q) = o;
        }
    } else {
        const int n = tid & 255, kh = (tid >> 8) * 32;
        bf16_t* d = cj.Wt + (size_t)(cj.nt * 256 + n) * cj.K + cj.kt * 64 + kh;
#pragma unroll
        for (int q = 0; q < 4; ++q) {
            const float* c = t + (kh + 8 * q) * 260 + n;
            u32x4 o;
            o.x = pk2(c[0], c[260]); o.y = pk2(c[2 * 260], c[3 * 260]); o.z = pk2(c[4 * 260], c[5 * 260]); o.w = pk2(c[6 * 260], c[7 * 260]);
            *(u32x4*)(d + 8 * q) = o;
        }
    }
}
__device__ __forceinline__ void convert_weights(const Params& p, unsigned char* smem, int lo, int hi, unsigned* queue) {
    float* t = (float*)smem;
    int* slot = (int*)(smem + 64 * 260 * 4);
    const int tid = threadIdx.x, n4 = tid & 63, kq = tid >> 6;
    const int G = gridDim.x;
    int ia, ib;
    if (queue) { if (tid == 0) { slot[0] = lo + (int)atomicAdd(queue, 1u); slot[1] = lo + (int)atomicAdd(queue, 1u); } __syncthreads(); ia = slot[0]; ib = slot[1]; __syncthreads(); }
    else { ia = lo + blockIdx.x; ib = ia + G; }
    if (ia >= hi) return;
    TrJob ja, jb; f32x4 va[8], vb[8];
    tr_job(p, ia, ja); tr_load(ja, va, tid);
    if (ib < hi) { tr_job(p, ib, jb); tr_load(jb, vb, tid); }
#define TR_ROUND(I, J, V) do { \
        _Pragma("unroll") for (int i = 0; i < 8; ++i) *(f32x4*)(t + (i * 8 + kq) * 260 + 4 * n4) = V[i]; \
        if (queue && tid == 0) slot[0] = lo + (int)atomicAdd(queue, 1u); \
        __syncthreads(); \
        const TrJob cj_ = J; \
        I = queue ? slot[0] : I + 2 * G; \
        if (I < hi) { tr_job(p, I, J); tr_load(J, V, tid); } \
        tr_store(cj_, t, tid); \
        __syncthreads(); } while (0)
    for (;;) {
        TR_ROUND(ia, ja, va);
        if (ib >= hi) break;
        TR_ROUND(ib, jb, vb);
        if (ia >= hi) break;
    }
#undef TR_ROUND
}

__device__ __forceinline__ void phase0(const Params& p, unsigned char* smem) {
    unsigned char* ws = p.ws;
    const int tid = threadIdx.x;
    convert_weights(p, smem, 0, TR_ITEMS - TR_GU - TR_DN, nullptr);
    constexpr int I_ADA = 96;
    constexpr int I_S5 = 32 * 33;
    constexpr int I_MISC = 17;
    constexpr int NITEM = I_ADA + I_S5 + I_MISC;
    for (int item = blockIdx.x; item < NITEM; item += gridDim.x) {
        int r = item;
        if (r < I_ADA) {
            const float* c = p.in[1]; const float* w = p.in[3]; const float* bb = p.in[4];
            const int wid = tid >> 6, lane = tid & 63, j = r * 64 + lane;
            float a0 = 0.f, a1 = 0.f, a2 = 0.f, a3 = 0.f;
#pragma unroll 4
            for (int k = wid * 128; k < wid * 128 + 128; ++k) {
                const float wv = w[(size_t)k * 6144 + j];
                const float c0 = c[k], c1 = c[1024 + k], c2 = c[2048 + k], c3 = c[3072 + k];
                a0 += c0 * sigmoidf_(c0) * wv; a1 += c1 * sigmoidf_(c1) * wv; a2 += c2 * sigmoidf_(c2) * wv; a3 += c3 * sigmoidf_(c3) * wv;
            }
            float* red = (float*)smem;
            red[(wid * 4 + 0) * 64 + lane] = a0; red[(wid * 4 + 1) * 64 + lane] = a1; red[(wid * 4 + 2) * 64 + lane] = a2; red[(wid * 4 + 3) * 64 + lane] = a3;
            __syncthreads();
            if (tid < 256) { const int b = tid >> 6; float s = 0.f;
#pragma unroll
              for (int w8 = 0; w8 < 8; ++w8) s += red[(w8 * 4 + b) * 64 + lane];
              ((float*)(ws + O_ADA))[b * 6144 + j] = s + bb[j]; }
            asm volatile("s_waitcnt vmcnt(0)" ::: "memory");
            __syncthreads();
            if (tid == 0) { __builtin_amdgcn_fence(__ATOMIC_RELEASE, "agent"); asm volatile("s_waitcnt vmcnt(0)" ::: "memory"); (void)xb_add((unsigned*)(ws + O_BAR) + 3400, 1u); }
            continue;
        }
        r -= I_ADA;
        if (r < I_S5) {
            const int g = r / 33, dl = r % 33;
            f32x2* pw = (f32x2*)smem;
            f32x2* bbv = pw + 64;
            f32x2* ccv = bbv + 1024;
            const float dt = expf(p.in[8][g]);
            if (tid < 64) {
                const int n = tid; const double re = p.in[6][g * 64 + n], im = p.in[7][g * 64 + n];
                const double mag = exp(re * (double)dt * dl), ang = im * (double)dt * dl;
                double sn, cs; sincos(ang, &sn, &cs);
                pw[n] = (f32x2){(float)(mag * cs), (float)(mag * sn)};
                if (dl == 32) { ((f32x2*)(ws + O_LAML))[g * 64 + n] = pw[n]; }
            }
            for (int e = tid; e < 1024; e += NT) {
                const int n = e >> 4, q = e & 15;
                const double re = p.in[6][g * 64 + n], im = p.in[7][g * 64 + n];
                const double mag = exp(re * (double)dt), ang = im * (double)dt;
                double sn, cs; sincos(ang, &sn, &cs);
                const double lr = mag * cs - 1.0, li = mag * sn;
                const double den = re * re + im * im;
                const double fr_ = (lr * re + li * im) / den, fi_ = (li * re - lr * im) / den;
                const double br = p.in[9][(g * 64 + n) * 16 + q], bi = p.in[10][(g * 64 + n) * 16 + q];
                bbv[e] = (f32x2){(float)(fr_ * br - fi_ * bi), (float)(fr_ * bi + fi_ * br)};
            }
            for (int e = tid; e < 1024; e += NT) { ccv[e] = (f32x2){p.in[11][g * 1024 + e], p.in[12][g * 1024 + e]}; }
            __syncthreads();
            bf16_t* TW2 = (bf16_t*)(ws + O_TW2) + (size_t)g * 512 * UROW;
            bf16_t* W1T = (bf16_t*)(ws + O_W1T) + (size_t)g * 256 * 512;
            if (dl < 32) {
                if (tid < 256) {
                    const int pp = tid >> 4, q = tid & 15;
                    float acc = 0.f;
                    for (int n = 0; n < 64; ++n) {
                        const f32x2 cv = ccv[pp * 64 + n], pv = pw[n], bv = bbv[n * 16 + q];
                        const float xr = cv.x * pv.x - cv.y * pv.y, xi = cv.x * pv.y + cv.y * pv.x;
                        acc += xr * bv.x - xi * bv.y;
                    }
                    if (dl == 0 && pp == q) acc += p.in[13][g * 16 + pp];
                    const bf16_t kb = f2bf(acc);
                    for (int tau = dl; tau < 32; ++tau) { const int s = tau - dl; TW2[(size_t)(tau * 16 + pp) * UROW + s * 16 + q] = kb; }
                    if (dl >= 1) for (int s = dl; s < 32; ++s) { const int tau = s - dl; TW2[(size_t)(tau * 16 + pp) * UROW + s * 16 + q] = 0; }
                }
                const int s = 31 - dl;
                for (int e = tid; e < 2048; e += NT) {
                    const int c = e >> 4, qq = e & 15, n = c & 63, ri = c >> 6;
                    const f32x2 pv = pw[n], bv = bbv[n * 16 + qq];
                    const float zr = pv.x * bv.x - pv.y * bv.y, zi = pv.x * bv.y + pv.y * bv.x;
                    W1T[(size_t)c * 512 + s * 16 + qq] = f2bf(ri ? zi : zr);
                }
            } else {
                u32x4* z = (u32x4*)(W1T + (size_t)128 * 512);
                for (int e = tid; e < 128 * 512 / 8; e += NT) z[e] = (u32x4){0u, 0u, 0u, 0u};
            }
            if (dl >= 1) {
                const int tau = dl - 1;
                for (int e = tid; e < 2048; e += NT) {
                    const int pp = e >> 7, c = e & 127, n = c & 63, ri = c >> 6;
                    const f32x2 cv = ccv[pp * 64 + n], pv = pw[n];
                    const float xr = cv.x * pv.x - cv.y * pv.y, xi = cv.x * pv.y + cv.y * pv.x;
                    TW2[(size_t)(tau * 16 + pp) * UROW + 512 + c] = f2bf(ri ? -xi : xr);
                }
            }
            __syncthreads();
            continue;
        }
        r -= I_S5;
        if (r < 16) {
            const int kv = r >> 3, part = r & 7, j = tid & 127, qtr = tid >> 7;
            const float* pos = p.in[kv ? 19 : 16]; const float* w1 = p.in[kv ? 20 : 17];
            float a = 0.f;
            const int i0 = part * 256 + qtr * 64;
            for (int i = i0; i < i0 + 64; ++i) a += pos[i] * w1[(size_t)i * 128 + j];
            float* red = (float*)smem;
            red[tid] = a;
            __syncthreads();
            if (tid < 128) ((float*)(ws + O_BIAS1))[(kv * 8 + part) * 128 + tid] = (red[tid] + red[tid + 128]) + (red[tid + 256] + red[tid + 384]);
            __syncthreads();
            continue;
        }
        for (int i = tid; i < 1100; i += NT) ((unsigned*)(ws + O_CNT))[i] = 0u;
    }
}

__device__ __forceinline__ void phase1(const Params& p, unsigned char*) {
    if (threadIdx.x == 0) { unsigned* f = (unsigned*)(p.ws + O_BAR) + 3400; XB_SPIN(xb_ld(f) < 96u, (unsigned*)(p.ws + O_BAR)); __builtin_amdgcn_fence(__ATOMIC_ACQUIRE, "agent"); asm volatile("s_waitcnt vmcnt(0)" ::: "memory"); }
    __syncthreads();
    const float* x = p.in[0];
    unsigned char* xn = p.ws + O_XN;
    for (size_t i = (size_t)blockIdx.x * NT + threadIdx.x; i < (size_t)NTOK * 128; i += (size_t)gridDim.x * NT) {
        const int token = (int)(i >> 7), k = (int)(i & 127) * 8, b = token >> 13;
        const float* ada = (const float*)(p.ws + O_ADA) + b * 6144;
        const f32x4 x0 = *(const f32x4*)(x + (size_t)token * 1024 + k), x1 = *(const f32x4*)(x + (size_t)token * 1024 + k + 4);
        const f32x4 s0 = *(const f32x4*)(ada + 1024 + k), s1 = *(const f32x4*)(ada + 1024 + k + 4);
        const f32x4 h0 = *(const f32x4*)(ada + k), h1 = *(const f32x4*)(ada + k + 4);
        *(u32x2*)(xn + (size_t)token * 1024 + k) = (u32x2){pk4_f8(x0[0] * (1.f + s0[0]) + h0[0], x0[1] * (1.f + s0[1]) + h0[1], x0[2] * (1.f + s0[2]) + h0[2], x0[3] * (1.f + s0[3]) + h0[3]),
                                                           pk4_f8(x1[0] * (1.f + s1[0]) + h1[0], x1[1] * (1.f + s1[1]) + h1[1], x1[2] * (1.f + s1[2]) + h1[2], x1[3] * (1.f + s1[3]) + h1[3])};
    }
}

typedef const f32x4 (&AccRef)[2][2][4][2];
struct EpiIn {
    static constexpr bool PERM = true;
    unsigned char* ws;
    __device__ __forceinline__ void operator()(AccRef acc, const pg8::Unit& u, int wr, int wc, int fr, int fq) const {
        const int pn = u.pn;
#pragma unroll
        for (int ai = 0; ai < 2; ++ai)
#pragma unroll
            for (int m = 0; m < 4; ++m) {
                const int token = u.pm * 256 + ai * 128 + wr * 64 + m * 16 + fr;
#pragma unroll
                for (int bj = 0; bj < 2; ++bj) {
                    const int col = pn * 256 + bj * 128 + wc * 32 + 8 * fq;
                    const f32x4 v0 = acc[ai][bj][m][0] * (1.f / WGU_SCALE), v1 = acc[ai][bj][m][1] * (1.f / WGU_SCALE);
                    if (pn < 2) {
                        const int g = col >> 4, q = col & 15;
                        bf16_t* d = (bf16_t*)(ws + O_U) + ((size_t)(g * 1024 + (token >> 5)) * UROW + (token & 31) * 16 + q);
                        *(u32x4*)d = (u32x4){pk2(v0[0], v0[1]), pk2(v0[2], v0[3]), pk2(v1[0], v1[1]), pk2(v1[2], v1[3])};
                    } else if (pn < 4) {
                        bf16_t* d = (bf16_t*)(ws + O_Q) + (size_t)token * 512 + (col - 512);
                        *(u32x4*)d = (u32x4){pk2(v0[0] * QSCALE, v0[1] * QSCALE), pk2(v0[2] * QSCALE, v0[3] * QSCALE), pk2(v1[0] * QSCALE, v1[1] * QSCALE), pk2(v1[2] * QSCALE, v1[3] * QSCALE)};
                    } else if (pn < 7) {
                        const int c = col - 1024, j6 = c >> 7, g = (c >> 6) & 1, dd = c & 63, b = token >> 13, s = token & 8191;
                        bf16_t* slab = (bf16_t*)(ws + O_KV) + (size_t)((j6 * 4 + b) * 2 + g) * KV_SLAB;
                        if (j6 == 3 || j6 == 5) {
                            const int p64 = s & 63, p16 = p64 & 15, slot = (p16 & 3) | ((p16 & 4) << 1) | ((p16 & 8) >> 1);
                            bf16_t* blkp = slab + (size_t)(s >> 6) * 4096 + (((p64 >> 5) * 2 + ((p64 >> 4) & 1)) * 64 + (slot >> 3) * 32) * 8 + (slot & 7);
#pragma unroll
                            for (int j = 0; j < 4; ++j) { const int d0 = dd + j, d1 = dd + 4 + j;
                                blkp[((d0 >> 5) * 4 * 64 + (d0 & 31)) * 8] = f2bf(v0[j]); blkp[((d1 >> 5) * 4 * 64 + (d1 & 31)) * 8] = f2bf(v1[j]); }
                        } else if (j6 == 2 || j6 == 4) {
                            bf16_t* d = slab + (size_t)((s >> 5) * 4 + (dd >> 4)) * 512 + (((dd >> 3) & 1) * 32 + (s & 31)) * 8;
                            *(u32x4*)d = (u32x4){pk2(v0[0], v0[1]), pk2(v0[2], v0[3]), pk2(v1[0], v1[1]), pk2(v1[2], v1[3])};
                        } else {
                            *(u32x4*)(slab + (size_t)s * 64 + dd) = (u32x4){pk2(v0[0], v0[1]), pk2(v0[2], v0[3]), pk2(v1[0], v1[1]), pk2(v1[2], v1[3])};
                        }
                    } else if (pn < 15) {
                        bf16_t* d = (pn < 11 ? (bf16_t*)(ws + O_SG5) + (size_t)token * 1024 + (col - 1792) : (bf16_t*)(ws + O_SGN) + (size_t)token * 1024 + (col - 2816));
                        *(u32x4*)d = (u32x4){pk2(sigmoidf_(v0[0]), sigmoidf_(v0[1])), pk2(sigmoidf_(v0[2]), sigmoidf_(v0[3])), pk2(sigmoidf_(v1[0]), sigmoidf_(v1[1])), pk2(sigmoidf_(v1[2]), sigmoidf_(v1[3]))};
                    } else {
                        const int c = col - 3840;
                        if (c < 24) { float* d = (float*)(ws + O_GN) + (size_t)token * 24 + c;
                            *(f32x4*)d = (f32x4){sigmoidf_(v0[0]), sigmoidf_(v0[1]), sigmoidf_(v0[2]), sigmoidf_(v0[3])};
                            *(f32x4*)(d + 4) = (f32x4){sigmoidf_(v1[0]), sigmoidf_(v1[1]), sigmoidf_(v1[2]), sigmoidf_(v1[3])}; }
                    }
                }
            }
    }
};
__device__ __forceinline__ void phase2(const Params& p, LAS unsigned char* lds) {
    pg8::DenseOrder S; S.init(p.ws + O_XN, p.ws + O_WT_IN, NTOK, NIN_PAD, 512, 512, gridDim.x, blockIdx.x);
    EpiIn E{p.ws};
    pg8::gemm_phase<EpiIn, pg8::DenseOrder, true, true>(lds, 512, 512, 512, S, E);
}

struct BatchOrder {
    const char* A; const char* B; size_t bsA, bsB, tstepA, tstepB; int nM, nN, nunits, G, c;
    __device__ __forceinline__ bool next(int i, pg8::Unit& u) const {
        const long L = (long)i * G + c; if (L >= nunits) return false;
        const int per = nM * nN, bt = (int)L / per, rem = (int)L % per;
        u.pm = rem / nN; u.pn = rem % nN; u.e = bt; u.nvalid = 256; u.rows = nullptr; u.rmax = 255;
        u.A = A + (size_t)bt * bsA + (size_t)u.pm * tstepA; u.B = B + (size_t)bt * bsB + (size_t)u.pn * tstepB; return true;
    }
};
struct EpiE { static constexpr bool PERM = false; float* E;
    __device__ __forceinline__ void operator()(AccRef acc, const pg8::Unit& u, int wr, int wc, int fr, int fq) const {
#pragma unroll
        for (int ai = 0; ai < 2; ++ai)
#pragma unroll
            for (int m = 0; m < 4; ++m) {
                const int r = u.pm * 256 + ai * 128 + wr * 64 + m * 16 + fr;
#pragma unroll
                for (int n = 0; n < 2; ++n) *(f32x4*)(E + ((size_t)u.e * 1024 + r) * 128 + wc * 32 + n * 16 + fq * 4) = acc[ai][0][m][n];
            }
    } };
struct EpiCmp { static constexpr bool PERM = true; const float* b1p; bf16_t* HC;
    __device__ __forceinline__ void operator()(AccRef acc, const pg8::Unit& u, int wr, int wc, int fr, int fq) const {
        const int col = wc * 32 + 8 * fq;
        f32x4 b0 = (f32x4){0.f, 0.f, 0.f, 0.f}, b1 = b0;
#pragma unroll
        for (int part = 0; part < 8; ++part) { b0 += *(const f32x4*)(b1p + (u.e * 8 + part) * 128 + col); b1 += *(const f32x4*)(b1p + (u.e * 8 + part) * 128 + col + 4); }
#pragma unroll
        for (int ai = 0; ai < 2; ++ai)
#pragma unroll
            for (int m = 0; m < 4; ++m) {
                const int R = u.pm * 256 + ai * 128 + wr * 64 + m * 16 + fr;
                const f32x4 v0 = acc[ai][0][m][0] + b0, v1 = acc[ai][0][m][1] + b1;
                *(u32x4*)(HC + ((size_t)u.e * 4096 + R) * 128 + col) = (u32x4){pk2(gelu_tanh(v0[0]), gelu_tanh(v0[1])), pk2(gelu_tanh(v0[2]), gelu_tanh(v0[3])), pk2(gelu_tanh(v1[0]), gelu_tanh(v1[1])), pk2(gelu_tanh(v1[2]), gelu_tanh(v1[3]))};
            }
    } };
__device__ __forceinline__ void phase3(const Params& p, LAS unsigned char* lds) {
    const int G = gridDim.x;
    {
        BatchOrder S{(const char*)(p.ws + O_U), (const char*)(p.ws + O_W1T), (size_t)1024 * UROW * 2, (size_t)256 * 512 * 2, (size_t)256 * UROW * 2, 0, 4, 1, 128, G, (int)blockIdx.x};
        EpiE E{(float*)(p.ws + O_E)};
        pg8::gemm_phase<EpiE, BatchOrder, false>(lds, 512, UROW, 512, S, E);
    }
    {
        BatchOrder S{(const char*)(p.ws + O_KV), (const char*)(p.ws + O_WT_C1), (size_t)8 * KV_SLAB * 2, (size_t)256 * 2048 * 2, (size_t)256 * 1024 * 2, 0, 16, 1, 32, G, (int)((blockIdx.x + G - 128 % G) % G)};
        EpiCmp E{(const float*)(p.ws + O_BIAS1), (bf16_t*)(p.ws + O_HC)};
        pg8::gemm_phase<EpiCmp, BatchOrder, false>(lds, 2048, 1024, 2048, S, E);
    }
}
__device__ __forceinline__ void phase4(const Params& p, unsigned char* smem) {
    const int tid = threadIdx.x;
    for (int item = blockIdx.x; item < 16 + 512; item += gridDim.x) {
        if (item < 16) {
            f32x2* seg = (f32x2*)smem;
#pragma unroll 1
            for (int half = 0; half < 8; ++half) {
                const int n = tid & 63, sg = tid >> 6, bg = item * 8 + half, b = bg >> 5, g = bg & 31;
                const f32x2 lm = ((const f32x2*)(p.ws + O_LAML))[g * 64 + n];
                const float* E = (const float*)(p.ws + O_E) + (size_t)(g * 1024 + b * 256 + sg * 32) * 128;
                bf16_t* U = (bf16_t*)(p.ws + O_U) + (size_t)(g * 1024 + b * 256 + sg * 32) * UROW + 512;
                float er[32], ei[32];
#pragma unroll
                for (int c = 0; c < 32; ++c) { er[c] = E[(size_t)c * 128 + n]; ei[c] = E[(size_t)c * 128 + 64 + n]; }
                float hr = 0.f, hi = 0.f;
#pragma unroll
                for (int c = 0; c < 32; ++c) { const float nr = lm.x * hr - lm.y * hi + er[c], ni = lm.x * hi + lm.y * hr + ei[c]; hr = nr; hi = ni; }
                seg[sg * 64 + n] = (f32x2){hr, hi};
                float pr = lm.x, pi = lm.y;
#pragma unroll
                for (int q = 0; q < 5; ++q) { const float nr = pr * pr - pi * pi, ni = 2.f * pr * pi; pr = nr; pi = ni; }
                __syncthreads();
                float sr = 0.f, si = 0.f;
                for (int k = 0; k < sg; ++k) { const f32x2 a = seg[k * 64 + n]; const float nr = pr * sr - pi * si + a.x, ni = pr * si + pi * sr + a.y; sr = nr; si = ni; }
                hr = sr; hi = si;
#pragma unroll
                for (int c = 0; c < 32; ++c) {
                    U[(size_t)c * UROW + n] = f2bf(hr); U[(size_t)c * UROW + 64 + n] = f2bf(hi);
                    const float nr = lm.x * hr - lm.y * hi + er[c], ni = lm.x * hi + lm.y * hr + ei[c]; hr = nr; hi = ni;
                }
                __syncthreads();
            }
        } else {
#pragma unroll 1
            for (int rep = 0; rep < 2; ++rep) {
                const int o = ((item - 16) * 2 + rep) * NT + tid, d = o & 63, R = (o >> 6) & 4095, kv = o >> 18;
                const bf16_t* h = (const bf16_t*)(p.ws + O_HC) + ((size_t)kv * 4096 + R) * 128;
                const float* w2 = p.in[kv ? 21 : 18];
                float a = 0.f;
#pragma unroll 8
                for (int j = 0; j < 128; ++j) a += bf2f(h[j]) * w2[j * 64 + d];
                const int bgi = R >> 9, n = R & 511;
                if (kv == 0) ((bf16_t*)(p.ws + O_KC))[(size_t)bgi * 512 * 64 + (size_t)((n >> 5) * 4 + (d >> 4)) * 512 + (((d >> 3) & 1) * 32 + (n & 31)) * 8 + (d & 7)] = f2bf(a);
                else { const int p64 = n & 63, p16 = p64 & 15, slot = (p16 & 3) | ((p16 & 4) << 1) | ((p16 & 8) >> 1);
                       ((bf16_t*)(p.ws + O_KC))[(size_t)4096 * 64 + (size_t)bgi * 64 * 512 + (size_t)(n >> 6) * 4096 + ((((d >> 5) * 2 + (p64 >> 5)) * 2 + ((p64 >> 4) & 1)) * 64 + (slot >> 3) * 32 + (d & 31)) * 8 + (slot & 7)] = f2bf(a); }
            }
        }
    }
    __syncthreads();
    convert_weights(p, smem, TR_ITEMS - TR_GU - TR_DN, TR_ITEMS, (unsigned*)(p.ws + O_CNT) + 1056);
}
struct EpiY { static constexpr bool PERM = true; bf16_t* YS;
    __device__ __forceinline__ void operator()(AccRef acc, const pg8::Unit& u, int wr, int wc, int fr, int fq) const {
#pragma unroll
        for (int ai = 0; ai < 2; ++ai)
#pragma unroll
            for (int m = 0; m < 4; ++m) {
                const int r = u.pm * 256 + ai * 128 + wr * 64 + m * 16 + fr;
                const int tok0 = (r >> 8) * SEQ + (r & 255) * S5L;
#pragma unroll
                for (int bj = 0; bj < 2; ++bj) {
                    const int col = u.pn * 256 + bj * 128 + wc * 32 + 8 * fq, tau = col >> 4, pp = col & 15;
                    const f32x4 v0 = acc[ai][bj][m][0], v1 = acc[ai][bj][m][1];
                    *(u32x4*)(YS + (size_t)(tok0 + tau) * 512 + u.e * 16 + pp) = (u32x4){pk2(gelu_tanh(v0[0]), gelu_tanh(v0[1])), pk2(gelu_tanh(v0[2]), gelu_tanh(v0[3])), pk2(gelu_tanh(v1[0]), gelu_tanh(v1[1])), pk2(gelu_tanh(v1[2]), gelu_tanh(v1[3]))};
                }
            }
    } };
__device__ __forceinline__ void phase5(const Params& p, LAS unsigned char* lds) {
    BatchOrder S{(const char*)(p.ws + O_U), (const char*)(p.ws + O_TW2), (size_t)1024 * UROW * 2, (size_t)512 * UROW * 2, (size_t)256 * UROW * 2, (size_t)256 * UROW * 2, 4, 2, 256, (int)gridDim.x, (int)blockIdx.x};
    EpiY E{(bf16_t*)(p.ws + O_YS)};
    pg8::gemm_phase<EpiY, BatchOrder, false>(lds, UROW, UROW, UROW, S, E);
}
struct EpiGlu { static constexpr bool PERM = true; const float* bglu; const bf16_t* SG5; bf16_t* MS5;
    __device__ __forceinline__ void operator()(AccRef acc, const pg8::Unit& u, int wr, int wc, int fr, int fq) const {
        const int cv = u.pn * 128 + wc * 32 + 8 * fq;
        const f32x4 bv0 = *(const f32x4*)(bglu + cv), bv1 = *(const f32x4*)(bglu + cv + 4), bg0 = *(const f32x4*)(bglu + 1024 + cv), bg1 = *(const f32x4*)(bglu + 1024 + cv + 4);
#pragma unroll
        for (int ai = 0; ai < 2; ++ai) {
            u32x4 sgv[4];
#pragma unroll
            for (int m = 0; m < 4; ++m) sgv[m] = *(const u32x4*)(SG5 + (size_t)(u.pm * 256 + ai * 128 + wr * 64 + m * 16 + fr) * 1024 + cv);
#pragma unroll
            for (int m = 0; m < 4; ++m) {
                const int token = u.pm * 256 + ai * 128 + wr * 64 + m * 16 + fr;
                const u32x4 sg = sgv[m];
                const f32x4 va0 = acc[ai][0][m][0] + bv0, va1 = acc[ai][0][m][1] + bv1, ga0 = acc[ai][1][m][0] + bg0, ga1 = acc[ai][1][m][1] + bg1;
                u32x4 o;
                o.x = pk2(va0[0] * sigmoidf_(ga0[0]) * bflo(sg.x), va0[1] * sigmoidf_(ga0[1]) * bfhi(sg.x)); o.y = pk2(va0[2] * sigmoidf_(ga0[2]) * bflo(sg.y), va0[3] * sigmoidf_(ga0[3]) * bfhi(sg.y));
                o.z = pk2(va1[0] * sigmoidf_(ga1[0]) * bflo(sg.z), va1[1] * sigmoidf_(ga1[1]) * bfhi(sg.z)); o.w = pk2(va1[2] * sigmoidf_(ga1[2]) * bflo(sg.w), va1[3] * sigmoidf_(ga1[3]) * bfhi(sg.w));
                *(u32x4*)(MS5 + (size_t)token * 1024 + cv) = o;
            }
        }
    } };
__device__ __forceinline__ void phase6(const Params& p, LAS unsigned char* lds) {
    pg8::DenseOrder S; S.init(p.ws + O_YS, p.ws + O_WT_GLU, NTOK, 2048, 512, 512, gridDim.x, blockIdx.x);
    EpiGlu E{p.in[15], (const bf16_t*)(p.ws + O_SG5), (bf16_t*)(p.ws + O_MS5)};
    pg8::gemm_phase<EpiGlu, pg8::DenseOrder, true>(lds, 512, 512, 512, S, E);
}
typedef float f32x16 __attribute__((ext_vector_type(16)));
__device__ __forceinline__ int rel_bucket_dev(int dist) {
    const int n = dist > 0 ? dist : 0;
    if (n < 16) return n;
    const int l = (int)(__log2f((float)n * 0.0625f) * 2.6666667f);
    const int v = 16 + l;
    return v < 31 ? v : 31;
}
__device__ __forceinline__ float xhalf_max(float v) { auto rr = __builtin_amdgcn_permlane32_swap(__float_as_uint(v), __float_as_uint(v), false, false); return fmaxf(__uint_as_float(rr[0]), __uint_as_float(rr[1])); }
__device__ __forceinline__ float xhalf_sum(float v) { auto rr = __builtin_amdgcn_permlane32_swap(__float_as_uint(v), __float_as_uint(v), false, false); return __uint_as_float(rr[0]) + __uint_as_float(rr[1]); }
__device__ __forceinline__ float quad_sum(float v) {
    v += __uint_as_float(__builtin_amdgcn_update_dpp(0u, __float_as_uint(v), 0xB1, 0xF, 0xF, true));
    v += __uint_as_float(__builtin_amdgcn_update_dpp(0u, __float_as_uint(v), 0x4E, 0xF, 0xF, true));
    return v;
}
constexpr int LSW = 1168;
constexpr int LWW = 656;
constexpr float RESC_THR = 6.f;
constexpr int IMPW = 132;
constexpr float NEG_BIG = -1e30f;

typedef int v4i_t __attribute__((ext_vector_type(4)));
typedef __amdgpu_buffer_rsrc_t rsrc_t;
__device__ __forceinline__ bf16x8 bload16(rsrc_t r, unsigned voff, unsigned soff) { return __builtin_bit_cast(bf16x8, __builtin_amdgcn_raw_buffer_load_b128(r, (int)voff, (int)soff, 0)); }
__device__ __forceinline__ void load_k(bf16x8 (&kf)[8], rsrc_t r, unsigned soff, unsigned voff) {
#pragma unroll
    for (int i = 0; i < 8; ++i) kf[i] = bload16(r, voff, soff + i * 1024);
}
__device__ __forceinline__ void load_v(bf16x8 (&vf)[8], rsrc_t r, unsigned soff, unsigned voff) {
#pragma unroll
    for (int i = 0; i < 8; ++i) vf[i] = bload16(r, voff, soff + i * 1024);
}
__device__ __forceinline__ void qk_block(f32x16 (&st)[2], const bf16x8 (&qf)[4], const bf16x8 (&kf)[8], float cinit) {
#pragma unroll
    for (int sub = 0; sub < 2; ++sub) {
        f32x16 acc;
#pragma unroll
        for (int r = 0; r < 16; ++r) acc[r] = cinit;
#pragma unroll
        for (int s = 0; s < 4; ++s) acc = __builtin_amdgcn_mfma_f32_32x32x16_bf16(kf[sub * 4 + s], qf[s], acc, 0, 0, 0);
        st[sub] = acc;
    }
}
__device__ __forceinline__ void bias_lut(f32x16 (&st)[2], const float* p) {
#pragma unroll
    for (int sub = 0; sub < 2; ++sub)
#pragma unroll
        for (int r = 0; r < 16; ++r) st[sub][r] += p[59 - (32 * sub + (r & 3) + 8 * (r >> 2))];
}
__device__ __forceinline__ void bias_mask_cmp(f32x16 (&st)[2], int dist0, const float* lutS) {
#pragma unroll
    for (int sub = 0; sub < 2; ++sub) {
        float bias[16];
#pragma unroll
        for (int r = 0; r < 16; ++r) {
            const int dist = dist0 - 16 * (32 * sub + (r & 3) + 8 * (r >> 2));
            const int idx = dist < 0 ? 0 : (dist > 1024 ? 1024 : dist);
            bias[r] = lutS[64 + idx];
        }
#pragma unroll
        for (int r = 0; r < 16; ++r) {
            const int dist = dist0 - 16 * (32 * sub + (r & 3) + 8 * (r >> 2));
            const float v = st[sub][r] + bias[r];
            st[sub][r] = dist >= 0 ? v : -INFINITY;
        }
    }
}
__device__ __forceinline__ float tile_max(const f32x16 (&st)[2]) {
    float a = __builtin_fmaxf(__builtin_fmaxf(st[0][0], st[0][1]), st[1][0]), b2 = __builtin_fmaxf(__builtin_fmaxf(st[0][2], st[0][3]), st[1][1]);
    a = __builtin_fmaxf(__builtin_fmaxf(a, st[1][2]), st[1][3]);
#pragma unroll
    for (int r = 4; r < 16; r += 4) {
        a = __builtin_fmaxf(__builtin_fmaxf(a, st[0][r]), st[0][r + 1]); b2 = __builtin_fmaxf(__builtin_fmaxf(b2, st[0][r + 2]), st[0][r + 3]);
        a = __builtin_fmaxf(__builtin_fmaxf(a, st[1][r]), st[1][r + 1]); b2 = __builtin_fmaxf(__builtin_fmaxf(b2, st[1][r + 2]), st[1][r + 3]);
    }
    return xhalf_max(__builtin_fmaxf(a, b2));
}
__device__ __forceinline__ void pv_block(f32x16 (&O)[2], const f32x16 (&st)[2], const bf16x8 (&vf)[8]) {
    bf16x8 pf[2][2];
#pragma unroll
    for (int sub = 0; sub < 2; ++sub)
#pragma unroll
        for (int s2 = 0; s2 < 2; ++s2) {
            u32x4 w;
            w.x = pk2(st[sub][8 * s2 + 0], st[sub][8 * s2 + 1]); w.y = pk2(st[sub][8 * s2 + 2], st[sub][8 * s2 + 3]);
            w.z = pk2(st[sub][8 * s2 + 4], st[sub][8 * s2 + 5]); w.w = pk2(st[sub][8 * s2 + 6], st[sub][8 * s2 + 7]);
            pf[sub][s2] = __builtin_bit_cast(bf16x8, w);
        }
#pragma unroll
    for (int dt = 0; dt < 2; ++dt)
#pragma unroll
        for (int sub = 0; sub < 2; ++sub)
#pragma unroll
            for (int s2 = 0; s2 < 2; ++s2) O[dt] = __builtin_amdgcn_mfma_f32_32x32x16_bf16(vf[dt * 4 + sub * 2 + s2], pf[sub][s2], O[dt], 0, 0, 0);
}
__device__ __forceinline__ void softmax_step(f32x16 (&st)[2], f32x16 (&O)[2], float& m, float& l) {
    const float mx = tile_max(st);
    if (__any(mx > RESC_THR)) {
        const float dl = mx > 0.f ? mx : 0.f;
        const float corr = __builtin_amdgcn_exp2f(-dl);
        m += dl; l *= corr;
#pragma unroll
        for (int sub = 0; sub < 2; ++sub)
#pragma unroll
            for (int r = 0; r < 16; ++r) st[sub][r] -= dl;
#pragma unroll
        for (int dt = 0; dt < 2; ++dt)
#pragma unroll
            for (int r = 0; r < 16; ++r) O[dt][r] *= corr;
    }
    float sum = 0.f;
#pragma unroll
    for (int sub = 0; sub < 2; ++sub)
#pragma unroll
        for (int r = 0; r < 16; ++r) { const float pe = __builtin_amdgcn_exp2f(st[sub][r]); st[sub][r] = pe; sum += pe; }
    l += sum;
}

constexpr int FLW = 68;
__device__ __forceinline__ void kv_step(f32x16 (&O)[2], float& m, float& l, const bf16x8 (&qf)[4], const bf16x8 (&kf)[8], bf16x8 (&kn)[8], rsrc_t rv, unsigned ksoff_next, unsigned koff,
                                        unsigned vsoff_blk, unsigned vvoff, const float* lutp, bool selme, float b31) {
    bf16x8 vf[8];
    load_v(vf, rv, vsoff_blk, vvoff);
    f32x16 st[2];
    qk_block(st, qf, kf, selme ? (lutp ? -m : b31 - m) : -INFINITY);
    __builtin_amdgcn_sched_barrier(0);
    load_k(kn, rv, ksoff_next, koff);
    if (lutp) bias_lut(st, lutp);
    softmax_step(st, O, m, l);
    pv_block(O, st, vf);
}

__device__ __forceinline__ void nsa_tile(const Params& p, int bg, int tg, const float* lutSall, const float* lutWall, float* impw, float* fl, int lane) {
    asm volatile("" : "+v"(lane));
    const int q = lane & 31, h2 = lane >> 5, tok = q >> 2, head = q & 3;
    const int b = bg >> 1, g = bg & 1, t0 = tg * 8, t = t0 + tok, token = b * SEQ + t;
    const float* lutS = lutSall + head * LSW;
    const float* lutW = lutWall + head * LWW;
    const float b31 = lutS[64 + 1024];
    bf16x8 qf[4];
    { const bf16_t* qp = (const bf16_t*)(p.ws + O_Q) + (size_t)token * 512 + (g * 4 + head) * 64 + 8 * h2;
#pragma unroll
      for (int s = 0; s < 4; ++s) qf[s] = *(const bf16x8*)(qp + 16 * s); }
    const float* gn = (const float*)(p.ws + O_GN) + (size_t)token * 24 + (g * 4 + head) * 3;
    float* flp = fl + q * FLW + 4 * h2;
    f32x16 O[2];
#pragma unroll
    for (int dt = 0; dt < 2; ++dt)
#pragma unroll
        for (int r = 0; r < 16; ++r) O[dt][r] = 0.f;
    const int cur = t0 >> 6;
    { const int u = head + 4 * h2;
#pragma unroll
      for (int i = 0; i < 16; ++i) impw[tok * IMPW + i * 8 + u] = 0.f; }
    WAVE_SYNC();
    bf16x8 kfA[8], kfB[8];
    const rsrc_t rKV = __builtin_amdgcn_make_buffer_rsrc((void*)(p.ws + O_KV), 0, (int)(6 * 8 * KV_SLAB * 2 + 8192), 0x00020000);
    const rsrc_t rKC = __builtin_amdgcn_make_buffer_rsrc((void*)(p.ws + O_KC), 0, (int)(2 * 4096 * 64 * 2), 0x00020000);
    const unsigned koff = (unsigned)lane * 16u, vsoff = koff;

    {
        const unsigned Kc = (unsigned)bg * 512u * 64u * 2u;
        const unsigned VcT = (4096u * 64u + (unsigned)bg * 64u * 512u) * 2u;
        const int tl = t0 + 7;
        const int ncmax = tl >= 31 ? ((tl - 31) >> 4) + 1 : 0;
        const int nblk = (ncmax + 63) >> 6;
        float m = NEG_BIG, l = 0.f;
        f32x16 st[2];
#define CMP_FAR(BLK) (16 * (64 * (BLK) + 63) + 31 + 1024 <= t0)
#define CMP_P1(KF, KN, BLK, BN) do { const bool far_ = CMP_FAR(BLK); qk_block(st, qf, KF, far_ ? b31 : 0.f); __builtin_amdgcn_sched_barrier(0); load_k(KN, rKC, Kc + (BN) * 8192, koff); \
            if (!far_) bias_mask_cmp(st, t - 31 - 16 * ((BLK) * 64 + 4 * h2), lutS); \
            const float mn = fmaxf(m, tile_max(st)); float sum = 0.f; \
            _Pragma("unroll") for (int sub = 0; sub < 2; ++sub) _Pragma("unroll") for (int r = 0; r < 16; ++r) sum += __builtin_amdgcn_exp2f(st[sub][r] - mn); \
            l = l * __builtin_amdgcn_exp2f(m - mn) + sum; m = mn; } while (0)
        if (nblk > 0) load_k(kfA, rKC, Kc, koff);
#pragma unroll 1
        for (int blk = 0; blk < nblk; blk += 2) {
            const int b1 = blk + 1 < nblk ? blk + 1 : blk;
            CMP_P1(kfA, kfB, blk, b1);
            if (blk + 1 >= nblk) break;
            const int b2 = blk + 2 < nblk ? blk + 2 : blk + 1;
            CMP_P1(kfB, kfA, blk + 1, b2);
        }
#undef CMP_P1
        l = xhalf_sum(l);
        const float invl = l > 0.f ? 1.f / l : 0.f;
#define CMP_P2(KF, KN, BLK, BN) do { const bool far_ = CMP_FAR(BLK); bf16x8 vf[8]; load_v(vf, rKC, VcT + (BLK) * 8192, koff); \
            qk_block(st, qf, KF, (far_ ? b31 : 0.f) - m); __builtin_amdgcn_sched_barrier(0); load_k(KN, rKC, Kc + (BN) * 8192, koff); \
            if (!far_) bias_mask_cmp(st, t - 31 - 16 * ((BLK) * 64 + 4 * h2), lutS); \
            _Pragma("unroll") for (int sub = 0; sub < 2; ++sub) _Pragma("unroll") for (int r = 0; r < 16; ++r) st[sub][r] = __builtin_amdgcn_exp2f(st[sub][r]) * invl; \
            _Pragma("unroll") for (int sub = 0; sub < 2; ++sub) _Pragma("unroll") for (int a = 0; a < 4; ++a) { \
                const float L_ = quad_sum(st[sub][4 * a + 3]); \
                const float G_ = quad_sum((st[sub][4 * a] + st[sub][4 * a + 1]) + (st[sub][4 * a + 2] + st[sub][4 * a + 3])); \
                const int j_ = (BLK) * 16 + 8 * sub + 2 * a + h2; \
                if (head == 0) { atomicAdd(&impw[tok * IMPW + j_], G_); if (j_ + 1 < 128) atomicAdd(&impw[tok * IMPW + j_ + 1], L_); } } \
            pv_block(O, st, vf); } while (0)
        if (nblk > 0) load_k(kfA, rKC, Kc, koff);
#pragma unroll 1
        for (int blk = 0; blk < nblk; blk += 2) {
            const int b1 = blk + 1 < nblk ? blk + 1 : blk;
            CMP_P2(kfA, kfB, blk, b1);
            if (blk + 1 >= nblk) break;
            const int b2 = blk + 2 < nblk ? blk + 2 : blk + 1;
            CMP_P2(kfB, kfA, blk + 1, b2);
        }
#undef CMP_P2
#undef CMP_FAR
        const float g0 = gn[0];
#pragma unroll
        for (int dt = 0; dt < 2; ++dt)
#pragma unroll
            for (int a = 0; a < 4; ++a) {
                *(f32x4*)(flp + dt * 32 + a * 8) = (f32x4){g0 * O[dt][4 * a], g0 * O[dt][4 * a + 1], g0 * O[dt][4 * a + 2], g0 * O[dt][4 * a + 3]};
                O[dt][4 * a] = 0.f; O[dt][4 * a + 1] = 0.f; O[dt][4 * a + 2] = 0.f; O[dt][4 * a + 3] = 0.f;
            }
    }
    WAVE_SYNC();

    unsigned long long mlo, mhi;
    if (cur < 16) { mlo = (1ull << (cur + 1)) - 1ull; mhi = 0ull; }
    else {
        const int u = head + 4 * h2;
        float val[16];
#pragma unroll
        for (int i = 0; i < 16; ++i) { const int j = i * 8 + u; val[i] = (j >= 1 && j <= cur - 2) ? impw[tok * IMPW + j] : -1.f; }
        mlo = 1ull; mhi = 0ull;
        if (cur < 64) mlo |= 1ull << cur; else mhi |= 1ull << (cur - 64);
        if (cur - 1 < 64) mlo |= 1ull << (cur - 1); else mhi |= 1ull << (cur - 1 - 64);
#pragma unroll 1
        for (int round = 0; round < 13; ++round) {
            float bs = val[0]; int bj = u;
#pragma unroll
            for (int i = 1; i < 16; ++i) { if (val[i] > bs) { bs = val[i]; bj = i * 8 + u; } }
            { const float os = __uint_as_float(__builtin_amdgcn_update_dpp(0u, __float_as_uint(bs), 0xB1, 0xF, 0xF, true)); const int oj = __builtin_amdgcn_update_dpp(0, bj, 0xB1, 0xF, 0xF, true);
              if (os > bs || (os == bs && oj < bj)) { bs = os; bj = oj; } }
            { const float os = __uint_as_float(__builtin_amdgcn_update_dpp(0u, __float_as_uint(bs), 0x4E, 0xF, 0xF, true)); const int oj = __builtin_amdgcn_update_dpp(0, bj, 0x4E, 0xF, 0xF, true);
              if (os > bs || (os == bs && oj < bj)) { bs = os; bj = oj; } }
            { const float os = __shfl_xor(bs, 32); const int oj = __shfl_xor(bj, 32);
              if (os > bs || (os == bs && oj < bj)) { bs = os; bj = oj; } }
            if (bj < 64) mlo |= 1ull << bj; else mhi |= 1ull << (bj - 64);
#pragma unroll
            for (int i = 0; i < 16; ++i) if (i * 8 + u == bj) val[i] = -2.f;
        }
    }
    unsigned long long ulo = mlo, uhi = mhi;
#pragma unroll
    for (int o = 4; o < 32; o <<= 1) { ulo |= __shfl_xor(ulo, o); uhi |= __shfl_xor(uhi, o); }
    ulo = ((unsigned long long)__builtin_amdgcn_readfirstlane((unsigned)(ulo >> 32)) << 32) | (unsigned)__builtin_amdgcn_readfirstlane((unsigned)ulo);
    uhi = ((unsigned long long)__builtin_amdgcn_readfirstlane((unsigned)(uhi >> 32)) << 32) | (unsigned)__builtin_amdgcn_readfirstlane((unsigned)uhi);

    {
        const unsigned Ks = (unsigned)((2 * 4 + b) * 2 + g) * (unsigned)(KV_SLAB * 2);
        const unsigned VsT = (unsigned)((3 * 4 + b) * 2 + g) * (unsigned)(KV_SLAB * 2);
        float m = 0.f, l = 0.f;
#define POPJ(J) do { if (ulo) { J = __builtin_ctzll(ulo); ulo &= ulo - 1ull; } else if (uhi) { J = 64 + __builtin_ctzll(uhi); uhi &= uhi - 1ull; } else J = -1; } while (0)
#define SEL_STEP(KF, KN, J, JN) do { const bool selme_ = (J) < 64 ? ((mlo >> (J)) & 1ull) : ((mhi >> ((J) - 64)) & 1ull); \
            const bool near_ = (64 * (J) + 63 + 1024 > t0); \
            kv_step(O, m, l, qf, KF, KN, rKV, Ks + (JN) * 8192, koff, VsT + (J) * 8192, vsoff, near_ ? lutS + (t - 64 * (J) - 4 * h2 + 64 - 59) : nullptr, selme_, b31); } while (0)
        int ja, jb;
        POPJ(ja);
        load_k(kfA, rKV, Ks + ja * 8192, koff);
#pragma unroll 1
        for (;;) {
            POPJ(jb);
            { const int jn = jb >= 0 ? jb : ja; SEL_STEP(kfA, kfB, ja, jn); }
            if (jb < 0) break;
            POPJ(ja);
            { const int jn = ja >= 0 ? ja : jb; SEL_STEP(kfB, kfA, jb, jn); }
            if (ja < 0) break;
        }
#undef SEL_STEP
#undef POPJ
        l = xhalf_sum(l);
        const float sc = l > 0.f ? gn[1] / l : 0.f;
#pragma unroll
        for (int dt = 0; dt < 2; ++dt)
#pragma unroll
            for (int a = 0; a < 4; ++a) {
                f32x4 f = *(const f32x4*)(flp + dt * 32 + a * 8);
                f[0] += sc * O[dt][4 * a]; f[1] += sc * O[dt][4 * a + 1]; f[2] += sc * O[dt][4 * a + 2]; f[3] += sc * O[dt][4 * a + 3];
                *(f32x4*)(flp + dt * 32 + a * 8) = f;
                O[dt][4 * a] = 0.f; O[dt][4 * a + 1] = 0.f; O[dt][4 * a + 2] = 0.f; O[dt][4 * a + 3] = 0.f;
            }
    }
    {
        const unsigned Kw = (unsigned)((4 * 4 + b) * 2 + g) * (unsigned)(KV_SLAB * 2);
        const unsigned VwT = (unsigned)((5 * 4 + b) * 2 + g) * (unsigned)(KV_SLAB * 2);
        float m = 0.f, l = 0.f;
        const int wlo = t0 - 511;
        const int r_begin = (wlo > 0 ? wlo : 0) & ~63;
        const int r_last = t0 + 7;
#define WIN_STEP(KF, KN, R0, RN) kv_step(O, m, l, qf, KF, KN, rKV, Kw + (RN) * 128, koff, VwT + (R0) * 128, vsoff, lutW + (t - (R0) - 4 * h2 + 72 - 59), true, b31)
        load_k(kfA, rKV, Kw + r_begin * 128, koff);
#pragma unroll 1
        for (int row0 = r_begin; row0 <= r_last; row0 += 128) {
            { const int rn = row0 + 64 <= r_last ? row0 + 64 : row0; WIN_STEP(kfA, kfB, row0, rn); }
            if (row0 + 64 > r_last) break;
            { const int rn = row0 + 128 <= r_last ? row0 + 128 : row0 + 64; WIN_STEP(kfB, kfA, row0 + 64, rn); }
        }
#undef WIN_STEP
        l = xhalf_sum(l);
        const float sc = l > 0.f ? gn[2] / l : 0.f;
        bf16_t* op = (bf16_t*)(p.ws + O_ONSA) + (size_t)token * 512 + (g * 4 + head) * 64 + 4 * h2;
#pragma unroll
        for (int dt = 0; dt < 2; ++dt)
#pragma unroll
            for (int a = 0; a < 4; ++a) {
                const f32x4 f = *(const f32x4*)(flp + dt * 32 + a * 8);
                *(u32x2*)(op + dt * 32 + a * 8) = (u32x2){pk2(f[0] + sc * O[dt][4 * a], f[1] + sc * O[dt][4 * a + 1]), pk2(f[2] + sc * O[dt][4 * a + 2], f[3] + sc * O[dt][4 * a + 3])};
            }
    }
    WAVE_SYNC();
}

__device__ __forceinline__ void phase7(const Params& p, unsigned char* smem) {
    const int tid = threadIdx.x, lane = tid & 63, wid = __builtin_amdgcn_readfirstlane(tid >> 6);
    float* lutS = (float*)smem;
    float* lutW = lutS + 4 * LSW;
    float* impw = lutW + 4 * LWW + wid * 8 * IMPW;
    float* fl = lutW + 4 * LWW + NWV * 8 * IMPW + wid * 32 * FLW;
    const int bg = blockIdx.x & 7, g = bg & 1;
    for (int i = tid; i < 4 * LSW; i += NT) { const int head = i / LSW, dist = i % LSW - 64;
        lutS[i] = dist < 0 ? -INFINITY : p.in[2][rel_bucket_dev(dist) * 8 + g * 4 + head] * LOG2E; }
    for (int i = tid; i < 4 * LWW; i += NT) { const int head = i / LWW, dist = i % LWW - 72;
        lutW[i] = (dist < 0 || dist >= 512) ? -INFINITY : p.in[2][rel_bucket_dev(dist) * 8 + g * 4 + head] * LOG2E; }
    __syncthreads();
    const int nblk_bg = (gridDim.x - bg + 7) >> 3;
    const int W = nblk_bg * NWV, w = (blockIdx.x >> 3) * NWV + wid;
#pragma unroll 1
    for (int round = 0; ; ++round) {
        const int idx = round * W + ((round & 1) ? (W - 1 - w) : w);
        if (idx >= 1024) break;
        nsa_tile(p, bg, 1023 - idx, lutS, lutW, impw, fl, lane);
    }
    __syncthreads();
}

struct EpiNsa { static constexpr bool PERM = true; const bf16_t* SGN; bf16_t* MS5;
    __device__ __forceinline__ void operator()(AccRef acc, const pg8::Unit& u, int wr, int wc, int fr, int fq) const {
#pragma unroll
        for (int ai = 0; ai < 2; ++ai)
#pragma unroll
            for (int mh = 0; mh < 4; mh += 2) {
                u32x4 sgv[2][2], msv[2][2];
#pragma unroll
                for (int m = 0; m < 2; ++m)
#pragma unroll
                    for (int bj = 0; bj < 2; ++bj) {
                        const size_t off = (size_t)(u.pm * 256 + ai * 128 + wr * 64 + (mh + m) * 16 + fr) * 1024 + u.pn * 256 + bj * 128 + wc * 32 + 8 * fq;
                        sgv[m][bj] = *(const u32x4*)(SGN + off); msv[m][bj] = *(const u32x4*)(MS5 + off);
                    }
#pragma unroll
                for (int m = 0; m < 2; ++m)
#pragma unroll
                    for (int bj = 0; bj < 2; ++bj) {
                        const size_t off = (size_t)(u.pm * 256 + ai * 128 + wr * 64 + (mh + m) * 16 + fr) * 1024 + u.pn * 256 + bj * 128 + wc * 32 + 8 * fq;
                        const u32x4 sg = sgv[m][bj], ms = msv[m][bj];
                        const f32x4 v0 = acc[ai][bj][mh + m][0], v1 = acc[ai][bj][mh + m][1];
                        u32x4 o;
                        o.x = pk2(bflo(ms.x) + bflo(sg.x) * v0[0], bfhi(ms.x) + bfhi(sg.x) * v0[1]); o.y = pk2(bflo(ms.y) + bflo(sg.y) * v0[2], bfhi(ms.y) + bfhi(sg.y) * v0[3]);
                        o.z = pk2(bflo(ms.z) + bflo(sg.z) * v1[0], bfhi(ms.z) + bfhi(sg.z) * v1[1]); o.w = pk2(bflo(ms.w) + bflo(sg.w) * v1[2], bfhi(ms.w) + bfhi(sg.w) * v1[3]);
                        *(u32x4*)(MS5 + off) = o;
                    }
            }
    } };
__device__ __forceinline__ void phase8(const Params& p, LAS unsigned char* lds) {
    pg8::DenseOrder S; S.init(p.ws + O_ONSA, p.ws + O_WT_NSA, NTOK, 1024, 512, 512, gridDim.x, blockIdx.x);
    EpiNsa E{(const bf16_t*)(p.ws + O_SGN), (bf16_t*)(p.ws + O_MS5)};
    pg8::gemm_phase<EpiNsa, pg8::DenseOrder, true>(lds, 512, 512, 512, S, E);
}
struct EpiOut { static constexpr bool PERM = true; const float* ada; bf16_t* Y;
    __device__ __forceinline__ void operator()(AccRef acc, const pg8::Unit& u, int wr, int wc, int fr, int fq) const {
        const float* ga = ada + (u.pm >> 5) * 6144 + 2048;
        f32x4 gv[2][2];
#pragma unroll
        for (int bj = 0; bj < 2; ++bj) { const int col = u.pn * 256 + bj * 128 + wc * 32 + 8 * fq; gv[bj][0] = *(const f32x4*)(ga + col); gv[bj][1] = *(const f32x4*)(ga + col + 4); }
#pragma unroll
        for (int ai = 0; ai < 2; ++ai)
#pragma unroll
            for (int m = 0; m < 4; ++m) {
                const int token = u.pm * 256 + ai * 128 + wr * 64 + m * 16 + fr;
#pragma unroll
                for (int bj = 0; bj < 2; ++bj) {
                    const int col = u.pn * 256 + bj * 128 + wc * 32 + 8 * fq;
                    const f32x4 v0 = acc[ai][bj][m][0] * gv[bj][0], v1 = acc[ai][bj][m][1] * gv[bj][1];
                    *(u32x4*)(Y + (size_t)token * 1024 + col) = (u32x4){pk2(v0[0], v0[1]), pk2(v0[2], v0[3]), pk2(v1[0], v1[1]), pk2(v1[2], v1[3])};
                }
            }
    } };
__device__ __forceinline__ void phase9(const Params& p, LAS unsigned char* lds) {
    pg8::DenseOrder S; S.init(p.ws + O_MS5, p.ws + O_WT_OUT, NTOK, 1024, 1024, 1024, gridDim.x, blockIdx.x);
    EpiOut E{(const float*)(p.ws + O_ADA), (bf16_t*)(p.ws + O_SG5)};
    pg8::gemm_phase<EpiOut, pg8::DenseOrder, true>(lds, 1024, 1024, 1024, S, E);
}

__device__ __forceinline__ void phase10(const Params& p, unsigned char* smem) {
    typedef float f32x16_t __attribute__((ext_vector_type(16)));
    constexpr int HSW = 1025;
    const int tid = threadIdx.x, lane = tid & 63, wid = __builtin_amdgcn_readfirstlane(tid >> 6);
    float* hsb = (float*)smem;
    int* lcnt = (int*)(smem + 32 * HSW * 4);
    int* lbase = lcnt + 32;
    int* lsel = lcnt + 64;
    float* lgate = (float*)(lsel + 4 * 256);
    const float* lg = p.in[24]; const float* lb = p.in[25]; const float* wr_ = p.in[26]; const float* br_ = p.in[27];
    unsigned* cnt = (unsigned*)(p.ws + O_CNT);
    if (tid < 32) lcnt[tid] = 0;
    __syncthreads();
    int nstep = 0;
#pragma unroll 1
    for (int grp = blockIdx.x; grp < NTOK / 32; grp += gridDim.x, ++nstep) {
#pragma unroll 1
        for (int i = 0; i < 4; ++i) {
            const int lt = wid * 4 + i, token = grp * 32 + lt, b = token >> 13;
            float* zr = (float*)(p.ws + O_Z1) + (size_t)token * 1024;
            const float* xr = p.in[0] + (size_t)token * 1024;
            const bf16_t* yr = (const bf16_t*)(p.ws + O_SG5) + (size_t)token * 1024;
            const float* ada = (const float*)(p.ws + O_ADA) + b * 6144;
            f32x4 v[4]; float sm = 0.f;
#pragma unroll
            for (int j = 0; j < 4; ++j) { const u32x2 yv = *(const u32x2*)(yr + j * 256 + lane * 4); const f32x4 xv = *(const f32x4*)(xr + j * 256 + lane * 4);
                v[j] = xv * DN_ALPHA + (f32x4){bflo(yv.x), bfhi(yv.x), bflo(yv.y), bfhi(yv.y)}; sm += (v[j][0] + v[j][1]) + (v[j][2] + v[j][3]); }
            const float mean = wave_sum(sm) * (1.f / 1024.f); float q = 0.f;
#pragma unroll
            for (int j = 0; j < 4; ++j) { v[j] = v[j] - mean; q += (v[j][0] * v[j][0] + v[j][1] * v[j][1]) + (v[j][2] * v[j][2] + v[j][3] * v[j][3]); }
            const float rstd = rsqrtf(wave_sum(q) * (1.f / 1024.f) + LN_EPS);
            unsigned char* h2 = p.ws + O_H2 + (size_t)token * 1024;
#pragma unroll
            for (int j = 0; j < 4; ++j) {
                const int c = j * 256 + lane * 4;
                const f32x4 x1 = v[j] * rstd * *(const f32x4*)(lg + c) + *(const f32x4*)(lb + c);
                *(f32x4*)(zr + c) = x1;
                const f32x4 hv = x1 * (*(const f32x4*)(ada + 4096 + c) + 1.f) + *(const f32x4*)(ada + 3072 + c);
                float* hd = hsb + lt * HSW + c; hd[0] = hv[0]; hd[1] = hv[1]; hd[2] = hv[2]; hd[3] = hv[3];
                *(unsigned*)(h2 + c) = pk4_f8(hv[0], hv[1], hv[2], hv[3]);
            }
        }
        __syncthreads();
        f32x16_t acc;
#pragma unroll
        for (int r = 0; r < 16; ++r) acc[r] = 0.f;
        { const float* ap = hsb + (lane & 31) * HSW + wid * 128 + (lane >> 5);
          const float* bp = wr_ + (size_t)(wid * 128 + (lane >> 5)) * 32 + (lane & 31);
#pragma unroll 8
          for (int j = 0; j < 64; ++j) acc = __builtin_amdgcn_mfma_f32_32x32x2f32(ap[2 * j], bp[(size_t)2 * j * 32], acc, 0, 0, 0); }
        __syncthreads();
        { float* pt = hsb + wid * 1024 + (lane & 31);
#pragma unroll
          for (int r = 0; r < 16; ++r) pt[((r & 3) + 8 * (r >> 2) + 4 * (lane >> 5)) * 32] = acc[r]; }
        __syncthreads();
        { float* lgt = hsb + 8192;
#pragma unroll
          for (int i = 0; i < 2; ++i) { const int o = tid * 2 + i; float sum = 0.f;
#pragma unroll
              for (int w = 0; w < 8; ++w) sum += hsb[w * 1024 + o];
              lgt[o] = sum + br_[o & 31]; } }
        __syncthreads();
#pragma unroll 1
        for (int rr = 0; rr < 2; ++rr) {
            const int e = lane & 31, lt = wid * 4 + rr * 2 + (lane >> 5);
            float val = hsb[8192 + lt * 32 + e]; int te[4]; float tv[4];
#pragma unroll
            for (int r = 0; r < 4; ++r) {
                float bs = val; int bj = e;
#pragma unroll
                for (int o = 1; o < 32; o <<= 1) { const float os = __shfl_xor(bs, o); const int oj = __shfl_xor(bj, o); if (os > bs || (os == bs && oj < bj)) { bs = os; bj = oj; } }
                te[r] = bj; tv[r] = bs;
                if (e == bj) val = -INFINITY;
            }
            const float e0 = 1.f, e1 = __expf(tv[1] - tv[0]), e2 = __expf(tv[2] - tv[0]), e3 = __expf(tv[3] - tv[0]);
            const float inv = 1.f / (e0 + e1 + e2 + e3);
            if (e < 4) {
                const int ee = e == 0 ? te[0] : (e == 1 ? te[1] : (e == 2 ? te[2] : te[3]));
                const float gg = (e == 0 ? e0 : (e == 1 ? e1 : (e == 2 ? e2 : e3))) * inv;
                const int rk = atomicAdd(&lcnt[ee], 1);
                lsel[(nstep * 32 + lt) * 4 + e] = ee | (rk << 8);
                lgate[(nstep * 32 + lt) * 4 + e] = gg;
            }
        }
        __syncthreads();
    }
    if (tid < 32) lbase[tid] = (int)atomicAdd(cnt + tid * 32, (unsigned)lcnt[tid]);
    __syncthreads();
    {
        for (int i = tid; i < nstep * 32 * 4; i += NT) {
            const int li = i >> 2, kk = i & 3, st = li >> 5, lt = li & 31;
            const int token = (blockIdx.x + st * gridDim.x) * 32 + lt;
            const int sv = lsel[i], ee = sv & 255, pos = lbase[ee] + (sv >> 8);
            ((int*)(p.ws + O_TOPE))[token * 4 + kk] = ee;
            ((unsigned*)(p.ws + O_TOPP))[token * 4 + kk] = (unsigned)pos;
            ((int*)(p.ws + O_ROWTOK))[(size_t)ee * NTOK + pos] = token;
            ((float*)(p.ws + O_ROWGATE))[(size_t)ee * NTOK + pos] = lgate[i];
        }
    }
    __syncthreads();
}

__device__ __forceinline__ void load_offsets(const Params& p, int* offs  , int* toff  ) {
    if (threadIdx.x < 64) {
        const int lane = threadIdx.x;
        const int c = lane < 32 ? (int)((const unsigned*)(p.ws + O_CNT))[lane * 32] : 0;
        int a = c, t = (c + 255) >> 8;
#pragma unroll
        for (int o = 1; o < 32; o <<= 1) { const int ua = __shfl_up(a, o), ut = __shfl_up(t, o); if ((lane & 31) >= o) { a += ua; t += ut; } }
        if (lane < 32) { offs[lane] = a - c; toff[lane] = t - ((c + 255) >> 8); if (lane == 31) { offs[32] = a; toff[32] = t; } }
    }
    __syncthreads();
}
struct MoeOrder {
    const int* offs; const int* toff; const char* A; const char* B; const int* rowtok; size_t bsB; int nN, G, c;
    __device__ __forceinline__ bool next(int i, pg8::Unit& u) const {
        const int v = (G % 8 == 0) ? (c % 8) * (G / 8) + c / 8 : c;
        const long L = (long)i * G + v; if (L >= (long)toff[32] * nN) return false;
        const int tile = (int)L / nN, pn = (int)L % nN;
        int e = 0;
#pragma unroll 1
        while (toff[e + 1] <= tile) ++e;
        e = __builtin_amdgcn_readfirstlane(e);
        const int r0 = __builtin_amdgcn_readfirstlane(offs[e] + (tile - toff[e]) * 256);
        u.pm = r0; u.pn = pn; u.e = e; u.nvalid = __builtin_amdgcn_readfirstlane(offs[e + 1]) - r0;
        u.gidx = e * NTOK + (tile - toff[e]) * 256;
        if (rowtok) { u.A = A; u.rows = rowtok + u.gidx; const int rm = u.nvalid - 1; u.rmax = rm < 255 ? rm : 255; }
        else { u.A = A + (size_t)r0 * 1024; u.rows = nullptr; u.rmax = 255; }
        u.B = B + (size_t)e * bsB + (size_t)pn * 256 * 1024; return true;
    }
};
struct EpiGU { static constexpr bool PERM = true; const float* bgu; unsigned char* ACT;
    __device__ __forceinline__ void operator()(AccRef acc, const pg8::Unit& u, int wr, int wc, int fr, int fq) const {
        const int cv = u.pn * 128 + wc * 32 + 8 * fq;
        const float* bb = bgu + (size_t)u.e * 2048;
        const float ws_ = 1.f / WGU_SCALE;
        const f32x4 bg0 = *(const f32x4*)(bb + cv), bg1 = *(const f32x4*)(bb + cv + 4), bu0 = *(const f32x4*)(bb + 1024 + cv), bu1 = *(const f32x4*)(bb + 1024 + cv + 4);
#pragma unroll
        for (int ai = 0; ai < 2; ++ai)
#pragma unroll
            for (int m = 0; m < 4; ++m) {
                const int lr = ai * 128 + wr * 64 + m * 16 + fr;
                const int row = lr < u.nvalid ? u.pm + lr : NROWS + lr;
                const f32x4 ga0 = acc[ai][0][m][0] * ws_ + bg0, ga1 = acc[ai][0][m][1] * ws_ + bg1, ua0 = acc[ai][1][m][0] * ws_ + bu0, ua1 = acc[ai][1][m][1] * ws_ + bu1;
                float o[8];
#pragma unroll
                for (int j = 0; j < 4; ++j) {
                    const float gt0 = __builtin_fminf(ga0[j], 7.f), up0 = __builtin_fminf(__builtin_fmaxf(ua0[j], -7.f), 7.f); o[j] = (up0 + 1.f) * gt0 * sigmoidf_(1.702f * gt0);
                    const float gt1 = __builtin_fminf(ga1[j], 7.f), up1 = __builtin_fminf(__builtin_fmaxf(ua1[j], -7.f), 7.f); o[4 + j] = (up1 + 1.f) * gt1 * sigmoidf_(1.702f * gt1);
                }
                *(u32x2*)(ACT + (size_t)row * 1024 + cv) = (u32x2){pk4_f8(o[0], o[1], o[2], o[3]), pk4_f8(o[4], o[5], o[6], o[7])};
            }
    } };
__device__ __forceinline__ void phase12(const Params& p, unsigned char* smem, LAS unsigned char* lds) {
    int* offs = (int*)(smem + LDS_TAB); int* toff = offs + 40;
    load_offsets(p, offs, toff);
    MoeOrder S{offs, toff, (const char*)(p.ws + O_H2), (const char*)(p.ws + O_WT_GU), (const int*)(p.ws + O_ROWTOK), (size_t)2048 * 1024, 8, (int)gridDim.x, (int)blockIdx.x};
    EpiGU E{p.in[29], p.ws + O_ACT};
    pg8::gemm_phase<EpiGU, MoeOrder, true, true>(lds, 512, 512, 512, S, E);
    __syncthreads();
}
struct EpiDn { static constexpr bool PERM = true; const float* bd; const float* rowgate; bf16_t* YK;
    __device__ __forceinline__ void operator()(AccRef acc, const pg8::Unit& u, int wr, int wc, int fr, int fq) const {
        const float* bb = bd + (size_t)u.e * 1024;
        f32x4 bv[2][2]; float gw[2][4];
#pragma unroll
        for (int bj = 0; bj < 2; ++bj) { const int col = u.pn * 256 + bj * 128 + wc * 32 + 8 * fq; bv[bj][0] = *(const f32x4*)(bb + col); bv[bj][1] = *(const f32x4*)(bb + col + 4); }
#pragma unroll
        for (int ai = 0; ai < 2; ++ai)
#pragma unroll
            for (int m = 0; m < 4; ++m) gw[ai][m] = rowgate[u.gidx + ai * 128 + wr * 64 + m * 16 + fr];
#pragma unroll
        for (int ai = 0; ai < 2; ++ai)
#pragma unroll
            for (int m = 0; m < 4; ++m) {
                const int lr = ai * 128 + wr * 64 + m * 16 + fr;
                const int row = lr < u.nvalid ? u.pm + lr : NROWS + lr;
#pragma unroll
                for (int bj = 0; bj < 2; ++bj) {
                    const int col = u.pn * 256 + bj * 128 + wc * 32 + 8 * fq;
                    const f32x4 v0 = (acc[ai][bj][m][0] * (1.f / WDN_SCALE) + bv[bj][0]) * gw[ai][m], v1 = (acc[ai][bj][m][1] * (1.f / WDN_SCALE) + bv[bj][1]) * gw[ai][m];
                    *(u32x4*)(YK + (size_t)row * 1024 + col) = (u32x4){pk2(v0[0], v0[1]), pk2(v0[2], v0[3]), pk2(v1[0], v1[1]), pk2(v1[2], v1[3])};
                }
            }
    } };
__device__ __forceinline__ void phase13(const Params& p, unsigned char* smem, LAS unsigned char* lds) {
    int* offs = (int*)(smem + LDS_TAB); int* toff = offs + 40;
    load_offsets(p, offs, toff);
    MoeOrder S{offs, toff, (const char*)(p.ws + O_ACT), (const char*)(p.ws + O_WT_DN), nullptr, (size_t)1024 * 1024, 4, (int)gridDim.x, (int)blockIdx.x};
    EpiDn E{p.in[31], (const float*)(p.ws + O_ROWGATE), (bf16_t*)(p.ws + O_YK)};
    pg8::gemm_phase<EpiDn, MoeOrder, true, true>(lds, 512, 512, 512, S, E);
    __syncthreads();
}

__device__ __forceinline__ void phase14(const Params& p, unsigned char* smem) {
    const int tid = threadIdx.x, lane = tid & 63, wid = tid >> 6;
    int* offs = (int*)(smem + LDS_TAB); int* toff = offs + 40;
    load_offsets(p, offs, toff);
    const float* lg = p.in[32]; const float* lb = p.in[33];
    const int* tope = (const int*)(p.ws + O_TOPE); const unsigned* topp = (const unsigned*)(p.ws + O_TOPP);
    const bf16_t* YK = (const bf16_t*)(p.ws + O_YK);
    for (int item = blockIdx.x; item < NTOK / NWV; item += gridDim.x) {
        const int token = item * NWV + wid, b = token >> 13;
        const float* x1 = (const float*)(p.ws + O_Z1) + (size_t)token * 1024;
        const float* gf = (const float*)(p.ws + O_ADA) + b * 6144 + 5120;
        const int r0 = offs[tope[token * 4 + 0]] + (int)topp[token * 4 + 0], r1 = offs[tope[token * 4 + 1]] + (int)topp[token * 4 + 1], r2 = offs[tope[token * 4 + 2]] + (int)topp[token * 4 + 2], r3 = offs[tope[token * 4 + 3]] + (int)topp[token * 4 + 3];
        f32x4 v[4]; float s = 0.f;
#pragma unroll
        for (int j = 0; j < 4; ++j) {
            const int c = j * 256 + lane * 4;
            const u32x2 a0 = *(const u32x2*)(YK + (size_t)r0 * 1024 + c), a1 = *(const u32x2*)(YK + (size_t)r1 * 1024 + c), a2 = *(const u32x2*)(YK + (size_t)r2 * 1024 + c), a3 = *(const u32x2*)(YK + (size_t)r3 * 1024 + c);
            f32x4 y;
            y[0] = (bflo(a0.x) + bflo(a1.x)) + (bflo(a2.x) + bflo(a3.x)); y[1] = (bfhi(a0.x) + bfhi(a1.x)) + (bfhi(a2.x) + bfhi(a3.x));
            y[2] = (bflo(a0.y) + bflo(a1.y)) + (bflo(a2.y) + bflo(a3.y)); y[3] = (bfhi(a0.y) + bfhi(a1.y)) + (bfhi(a2.y) + bfhi(a3.y));
            v[j] = *(const f32x4*)(x1 + c) * DN_ALPHA + *(const f32x4*)(gf + c) * y;
            s += (v[j][0] + v[j][1]) + (v[j][2] + v[j][3]);
        }
        const float mean = wave_sum(s) * (1.f / 1024.f); float q = 0.f;
#pragma unroll
        for (int j = 0; j < 4; ++j) { v[j] = v[j] - mean; q += (v[j][0] * v[j][0] + v[j][1] * v[j][1]) + (v[j][2] * v[j][2] + v[j][3] * v[j][3]); }
        const float rstd = rsqrtf(wave_sum(q) * (1.f / 1024.f) + LN_EPS);
#pragma unroll
        for (int j = 0; j < 4; ++j) { const int c = j * 256 + lane * 4; *(f32x4*)(p.out + (size_t)token * 1024 + c) = v[j] * rstd * *(const f32x4*)(lg + c) + *(const f32x4*)(lb + c); }
    }
}


#if defined(__HIP_DEVICE_COMPILE__)
typedef const __attribute__((address_space(4))) Params* KernargPtr;
__device__ __forceinline__ KernargPtr opaque_kernarg() { KernargPtr kp = (KernargPtr)__builtin_amdgcn_kernarg_segment_ptr(); asm volatile("" : "+s"(kp)); return kp; }
#define GAS __attribute__((address_space(1)))
__device__ __forceinline__ Params load_params() {
    Params r; const __attribute__((address_space(4))) unsigned long long* s = (const __attribute__((address_space(4))) unsigned long long*)opaque_kernarg();
#pragma unroll
    for (int i = 0; i < 34; ++i) r.in[i] = (const float*)(const GAS float*)s[i];
    r.out = (float*)(GAS float*)s[34]; r.ws = (unsigned char*)(GAS unsigned char*)s[35];
    const unsigned long long pp = s[36]; r.ph_lo = (int)(unsigned)pp; r.ph_hi = (int)(unsigned)(pp >> 32);
    return r; }
#else
#define opaque_kernarg() (&p_unused)
#endif
#if defined(__HIP_DEVICE_COMPILE__)
#define PARAMS_NOW() load_params()
#else
#define PARAMS_NOW() p_unused
#endif
template <bool COOP>
__global__ void __launch_bounds__(NT, 2) fwd_kernel(Params p_unused) {
    extern __shared__ __attribute__((aligned(16))) unsigned char smem[];
    LAS unsigned char* lds = (LAS unsigned char*)smem;
    const int lo = opaque_kernarg()->ph_lo, hi = opaque_kernarg()->ph_hi;
    volatile LAS unsigned* bst = (volatile LAS unsigned*)(lds + LDS_BYTES - 16);
    if (threadIdx.x == 0) { bst[0] = 0u; bst[1] = 0u; }
    __syncthreads();
    XcdBarrier gbar; gbar.bar = nullptr; gbar.x = 0; gbar.st = bst;
    if (COOP) { const Params p0 = PARAMS_NOW(); gbar = xcd_barrier_post((unsigned*)(p0.ws + O_BAR), bst); }
#define SEAM(k) do { if ((k) == 1) cg::this_grid().sync(); else xcd_barrier(gbar); } while (0)
#define RUN_PHASE(k, call) if (((PH_MASK >> (k)) & 1) && lo <= (k) && (k) < hi) { _Pragma("unroll 1") for (int rep_ = 0; rep_ < 1 + ((REPEAT_MASK >> (k)) & 1); ++rep_) { if (rep_) { if (COOP) SEAM(1); } const Params p = PARAMS_NOW(); call; } } if (COOP) { if ((k) != 0 && (k) != 6 && lo <= (k) && (k) + 1 < hi) SEAM(k); }
    RUN_PHASE(0, phase0(p, smem))
    RUN_PHASE(1, phase1(p, smem))
    RUN_PHASE(2, phase2(p, lds))
    RUN_PHASE(3, phase3(p, lds))
    RUN_PHASE(4, phase4(p, smem))
    RUN_PHASE(5, phase5(p, lds))
    RUN_PHASE(6, phase6(p, lds))
    RUN_PHASE(7, phase7(p, smem))
    RUN_PHASE(8, phase8(p, lds))
    RUN_PHASE(9, phase9(p, lds))
    RUN_PHASE(10, phase10(p, smem))
    RUN_PHASE(12, phase12(p, smem, lds))
    RUN_PHASE(13, phase13(p, smem, lds))
    RUN_PHASE(14, phase14(p, smem))
#undef RUN_PHASE
#undef SEAM
}

extern "C" void kernel_launch(void* const* d_in, const int* in_sizes, int n_in, void* d_out, int out_size, void* d_ws, size_t ws_size, hipStream_t stream) {
    static int grid = 0;
    if (grid == 0) {
        if (n_in != 34 || out_size != NTOK * DM || ws_size < WS_NEED) { fprintf(stderr, "kernel_launch: unexpected problem (n_in %d, out %d, ws %zu need %zu)\n", n_in, out_size, ws_size, (size_t)WS_NEED); grid = -1; return; }
        int dev = 0, cus = 0, per_cu = 0;
        (void)hipGetDevice(&dev);
        (void)hipDeviceGetAttribute(&cus, hipDeviceAttributeMultiprocessorCount, dev);
#if ONE_LAUNCH
        (void)hipFuncSetAttribute((const void*)fwd_kernel<true>, hipFuncAttributeMaxDynamicSharedMemorySize, LDS_BYTES);
        (void)hipOccupancyMaxActiveBlocksPerMultiprocessor(&per_cu, fwd_kernel<true>, NT, LDS_BYTES);
#else
        (void)hipFuncSetAttribute((const void*)fwd_kernel<false>, hipFuncAttributeMaxDynamicSharedMemorySize, LDS_BYTES);
        (void)hipOccupancyMaxActiveBlocksPerMultiprocessor(&per_cu, fwd_kernel<false>, NT, LDS_BYTES);
#endif
        if (per_cu < 1) { fprintf(stderr, "kernel_launch: occupancy query reports %d blocks per CU\n", per_cu); per_cu = 1; }
        grid = cus * per_cu;
        fprintf(stderr, "kernel_launch: grid %d (%d CUs x %d)\n", grid, cus, per_cu);
    }
    if (grid < 0) return;
    Params p{};
    for (int i = 0; i < 34; ++i) p.in[i] = (const float*)d_in[i];
    p.out = (float*)d_out; p.ws = (unsigned char*)d_ws;
#if ONE_LAUNCH
    if (hipMemsetAsync((char*)d_ws + O_BAR, 0, BAR_BYTES, stream) != hipSuccess) { fprintf(stderr, "kernel_launch: memset of the barrier words failed\n"); return; }
    p.ph_lo = 0; p.ph_hi = NPHASE;
    void* args[] = {&p};
    hipError_t e = hipLaunchCooperativeKernel((void*)fwd_kernel<true>, dim3(grid), dim3(NT), args, LDS_BYTES, stream);
    if (e != hipSuccess) fprintf(stderr, "cooperative launch failed: %s (grid %d)\n", hipGetErrorString(e), grid);
#else
    for (int ph = 0; ph < NPHASE; ++ph) {
        p.ph_lo = ph; p.ph_hi = ph + 1;
        hipLaunchKernelGGL(fwd_kernel<false>, dim3(grid), dim3(NT), LDS_BYTES, stream, p);
    }
#endif
}
```

```cpp
#include <hip/hip_runtime.h>
#include <hip/hip_cooperative_groups.h>
#include <cstdio>
#include <cstdint>
namespace cg = cooperative_groups;

#ifndef PH_MASK
#define PH_MASK 0xFFFFF
#endif
#ifndef REPEAT_MASK
#define REPEAT_MASK 0
#endif
#ifndef ONE_LAUNCH
#define ONE_LAUNCH 1
#endif

#define LAS __attribute__((address_space(3)))
typedef unsigned short bf16_t;
typedef short bf16x8 __attribute__((ext_vector_type(8)));
typedef float f32x4 __attribute__((ext_vector_type(4)));
typedef float f32x2 __attribute__((ext_vector_type(2)));
typedef unsigned u32x4 __attribute__((ext_vector_type(4)));
typedef unsigned u32x2 __attribute__((ext_vector_type(2)));
typedef __bf16 bf16x2_t __attribute__((ext_vector_type(2)));

constexpr int NB = 4, SEQ = 8192, NTOK = NB * SEQ, DM = 1024;
constexpr int NIN_PAD = 4096;
constexpr int NEXP = 32, TOPK = 4, NROWS = NTOK * TOPK;
constexpr int S5L = 32;
constexpr int NCHUNK = SEQ / S5L;
constexpr int UROW = 640;
constexpr float DN_ALPHA = 1.189207115002721f;
constexpr float LN_EPS = 1e-5f;
constexpr float LOG2E = 1.4426950408889634f;
constexpr float QSCALE = 0.125f * 1.4426950408889634f;
constexpr float YS_SCALE = 8.f, ONSA_SCALE = 16.f, MRG_SCALE = 8.f, WGLU_SCALE = 16.f, WNSA_SCALE = 16.f, WOUT_SCALE = 32.f;
constexpr float WGU_SCALE = 32.f, WDN_SCALE = 64.f;
constexpr int NT = 512;
constexpr int NWV = NT / 64;

constexpr size_t al256(size_t x) { return (x + 255) & ~(size_t)255; }
constexpr size_t O_ADA = 0;
constexpr size_t O_CNT = O_ADA + al256(4 * 6144 * 4);
constexpr size_t O_BAR = O_CNT + 8192;
constexpr size_t BAR_BYTES = 3456 * 4;
constexpr size_t O_LAML = O_BAR + al256(BAR_BYTES);
constexpr size_t O_BIAS1 = O_LAML + al256(32 * 64 * 2 * 4);
constexpr size_t O_WT_IN = O_BIAS1 + al256(2 * 8 * 128 * 4);
constexpr size_t O_WT_GLU = O_WT_IN + al256((size_t)NIN_PAD * 1024);
constexpr size_t O_WT_NSA = O_WT_GLU + al256((size_t)2048 * 512 * 2);
constexpr size_t O_WT_OUT = O_WT_NSA + al256((size_t)1024 * 512 * 2);
constexpr size_t O_WT_C1 = O_WT_OUT + al256((size_t)1024 * 1024 * 2);
constexpr size_t O_W1T = O_WT_C1 + al256((size_t)2 * 256 * 2048 * 2);
constexpr size_t O_TW2 = O_W1T + al256((size_t)32 * 256 * 512 * 2);
constexpr size_t O_WT_GU = O_TW2 + al256((size_t)32 * 512 * 640 * 2);
constexpr size_t O_WT_DN = O_WT_GU + al256((size_t)32 * 2048 * 1024);
constexpr size_t O_H2 = O_WT_DN + al256((size_t)32 * 1024 * 1024);
constexpr size_t O_Z1 = O_H2 + al256((size_t)NTOK * 1024);
constexpr size_t O_TOPE = O_Z1 + al256((size_t)NTOK * 1024 * 4);
constexpr size_t O_TOPP = O_TOPE + al256((size_t)NROWS * 4);
constexpr size_t O_TOPG = O_TOPP + al256((size_t)NROWS * 4);
constexpr size_t O_ROWTOK = O_TOPG + al256((size_t)NROWS * 4);
constexpr size_t O_ROWGATE = O_ROWTOK + al256((size_t)NEXP * NTOK * 4);
constexpr size_t O_OVL = O_ROWGATE + al256((size_t)NEXP * NTOK * 4 + 1024);
constexpr size_t O_U = O_OVL;
constexpr size_t O_E = O_U + al256((size_t)32 * 1024 * UROW * 2);
constexpr size_t O_YS = O_E + al256((size_t)32 * 1024 * 128 * 4);
constexpr size_t O_Q = O_YS + al256((size_t)NTOK * 512 * 2);
constexpr size_t O_KV = O_Q + al256((size_t)NTOK * 512 * 2);
constexpr size_t KV_SLAB = (size_t)SEQ * 64;
constexpr size_t O_SG5 = O_KV + al256((size_t)6 * 8 * KV_SLAB * 2 + 8192);
constexpr size_t O_SGN = O_SG5 + al256((size_t)NTOK * 1024 * 2);
constexpr size_t O_GN = O_SGN + al256((size_t)NTOK * 1024 * 2);
constexpr size_t O_MS5 = O_GN + al256((size_t)NTOK * 24 * 4);
constexpr size_t O_ONSA = O_MS5 + al256((size_t)NTOK * 1024 * 2);
constexpr size_t O_HC = O_ONSA + al256((size_t)NTOK * 512 * 2);
constexpr size_t O_KC = O_HC + al256((size_t)2 * 4096 * 128 * 2);
constexpr size_t O_XN = O_KC + al256((size_t)2 * 4096 * 64 * 2);
constexpr size_t O_END1 = O_XN + al256((size_t)NTOK * 1024);
constexpr size_t O_ACT = O_OVL;
constexpr size_t O_YK = O_ACT + al256((size_t)(NROWS + 256) * 1024);
constexpr size_t O_END2 = O_YK + al256((size_t)(NROWS + 256) * 1024 * 2);
constexpr size_t WS_NEED = O_END1 > O_END2 ? O_END1 : O_END2;
static_assert(WS_NEED <= (size_t)1073741824, "workspace map exceeds 1 GiB");

constexpr int LDS_BYTES = 147456;
constexpr int LDS_TAB = 131072;
constexpr int NPHASE = 15;

struct Params {
    const float* in[34];
    float* out;
    unsigned char* ws;
    int ph_lo, ph_hi;
};

__device__ __forceinline__ unsigned pk2(float lo, float hi) { f32x2 v = {lo, hi}; bf16x2_t b = __builtin_convertvector(v, bf16x2_t); return __builtin_bit_cast(unsigned, b); }
__device__ __forceinline__ bf16_t f2bf(float f) { return (bf16_t)(pk2(f, 0.f) & 0xffffu); }
__device__ __forceinline__ float bf2f(bf16_t h) { return __uint_as_float(((unsigned)h) << 16); }
__device__ __forceinline__ float bflo(unsigned w) { return __uint_as_float(w << 16); }
__device__ __forceinline__ float bfhi(unsigned w) { return __uint_as_float(w & 0xffff0000u); }
#define LOG2E_F 1.4426950408889634f
__device__ __forceinline__ unsigned pk4_f8(float a, float b, float c, float d) { int w = 0; w = __builtin_amdgcn_cvt_pk_fp8_f32(a, b, w, false); w = __builtin_amdgcn_cvt_pk_fp8_f32(c, d, w, true); return (unsigned)w; }
__device__ __forceinline__ float sigmoidf_(float x) { return __builtin_amdgcn_rcpf(1.f + __builtin_amdgcn_exp2f(-LOG2E_F * x)); }
__device__ __forceinline__ float gelu_tanh(float x) { const float u = 0.7978845608028654f * (x + 0.044715f * x * x * x); const float e = __builtin_amdgcn_exp2f((2.f * LOG2E_F) * u); return x * (1.f - __builtin_amdgcn_rcpf(e + 1.f)); }
__device__ __forceinline__ float wave_sum(float v) {
#pragma unroll
    for (int o = 1; o < 64; o <<= 1) v += __shfl_xor(v, o);
    return v;
}
#define WAVE_SYNC() do { __builtin_amdgcn_fence(__ATOMIC_RELEASE, "wavefront"); __builtin_amdgcn_wave_barrier(); __builtin_amdgcn_fence(__ATOMIC_ACQUIRE, "wavefront"); } while (0)

#define XB_TMO      128
#define XB_XCNT(j)  (256  + 64 * (j))
#define XB_XSUB(j)  (1280 + 64 * (j))
#define XB_XGEN(j)  (2304 + 64 * (j))
#define XB_TOP      3328
#define XB_TOPGEN   3392
#define XB_SPIN_CAP (1u << 20)
__device__ __forceinline__ unsigned xb_ld(unsigned* p)              { return __hip_atomic_load(p, __ATOMIC_RELAXED, __HIP_MEMORY_SCOPE_AGENT); }
__device__ __forceinline__ unsigned xb_add(unsigned* p, unsigned v) { return __hip_atomic_fetch_add(p, v, __ATOMIC_RELAXED, __HIP_MEMORY_SCOPE_AGENT); }
__device__ __forceinline__ unsigned xb_xcc_id() { return (unsigned)__builtin_amdgcn_s_getreg((3 << 11) | 20) & 0xFu; }
#define XB_SPIN(cond, bar) do { unsigned _sp = 0; while (cond) { __builtin_amdgcn_s_sleep(1); \
    if ((++_sp & 255u) == 0u) { if (xb_ld(&(bar)[XB_TMO])) break; if (_sp > XB_SPIN_CAP) { atomicAdd(&(bar)[XB_TMO], 1u); break; } } } } while (0)
struct XcdBarrier { unsigned* bar; unsigned x; volatile LAS unsigned* st; };
__device__ __forceinline__ XcdBarrier xcd_barrier_post(unsigned* bar, volatile LAS unsigned* st) {
    XcdBarrier b; b.bar = bar; b.x = xb_xcc_id(); b.st = st;
    if (threadIdx.x == 0) (void)xb_add(&bar[XB_XCNT(b.x)], 1u);
    return b;
}
__device__ __forceinline__ void xcd_barrier_complete(unsigned* bar, unsigned x, unsigned& nloc, unsigned& nx) {
    const unsigned G = gridDim.x * gridDim.y * gridDim.z;
    unsigned sum, cnt, mine, sp = 0u;
    for (;;) {
        sum = 0u; cnt = 0u; mine = 0u;
#pragma unroll
        for (unsigned j = 0; j < 16; ++j) { const unsigned c = xb_ld(&bar[XB_XCNT(j)]); sum += c; cnt += (c > 0u) ? 1u : 0u; mine = (j == x) ? c : mine; }
        if (sum == G) break;
        __builtin_amdgcn_s_sleep(1);
        if ((++sp & 255u) == 0u) { if (xb_ld(&bar[XB_TMO])) break; if (sp > XB_SPIN_CAP) { atomicAdd(&bar[XB_TMO], 1u); break; } }
    }
    nloc = mine > 0u ? mine : 1u; nx = cnt > 0u ? cnt : 1u;
}
__device__ __forceinline__ void xcd_barrier(const XcdBarrier& b) {
    asm volatile("s_waitcnt vmcnt(0)" ::: "memory");
    __syncthreads();
    if (threadIdx.x == 0) {
        unsigned* bar = b.bar;
        __builtin_amdgcn_s_waitcnt(0);
        unsigned nloc = b.st[0], nx = b.st[1];
        if (nloc == 0u) { xcd_barrier_complete(bar, b.x, nloc, nx); b.st[0] = nloc; b.st[1] = nx; }
        const unsigned old = xb_add(&bar[XB_XSUB(b.x)], 1u);
        const unsigned gen = old / nloc;
        if (old + 1u == (gen + 1u) * nloc) {
            __builtin_amdgcn_fence(__ATOMIC_RELEASE, "agent");
            asm volatile("s_waitcnt vmcnt(0)" ::: "memory");
            const unsigned og = xb_add(&bar[XB_TOP], 1u);
            const unsigned tg = og / nx;
            if (og + 1u == (tg + 1u) * nx) xb_add(&bar[XB_TOPGEN], 1u);
            else XB_SPIN(xb_ld(&bar[XB_TOPGEN]) == tg, bar);
            __builtin_amdgcn_fence(__ATOMIC_ACQUIRE, "agent");
            xb_add(&bar[XB_XGEN(b.x)], 1u);
            asm volatile("s_waitcnt vmcnt(0)" ::: "memory");
        } else {
            XB_SPIN(xb_ld(&bar[XB_XGEN(b.x)]) == gen, bar);
            __builtin_amdgcn_fence(__ATOMIC_ACQUIRE, "agent");
            asm volatile("s_waitcnt vmcnt(0)" ::: "memory");
        }
    }
    __syncthreads();
}


namespace pg8 {
typedef int v8i_t __attribute__((ext_vector_type(8)));
typedef int v4i8_t __attribute__((ext_vector_type(4)));
constexpr int BM = 256, BK = 64, HALF = 128, HTB = HALF * BK * 2, STAGE_BYTES = 8 * HTB;
__device__ __forceinline__ int lds_byte(int r, int c) { const int st = (r >> 4) * 2 + (c >> 5), rr = r & 15, cc = c & 31, ob = rr * 64 + cc * 2; return st * 1024 + (ob ^ (((ob >> 9) & 1) << 5)); }
__device__ __forceinline__ void stage_rc(int b, int& R, int& C) { const int st = b / 1024, sb = b % 1024, swz = sb ^ (((sb >> 9) & 1) << 5); R = (st >> 1) * 16 + swz / 64; C = (st & 1) * 32 + (swz % 64) / 2; }
__device__ __forceinline__ int perm32(int rho) { const int n = rho >> 4, i = rho & 15; return 8 * (i >> 2) + 4 * n + (i & 3); }
struct Unit { const char* A; const char* B; const int* rows; int pm, pn, e, nvalid, rmax, gidx; };

template <class Epi, class Sched, bool ALIGN_EPI, bool F8 = false>
__device__ __forceinline__ void gemm_phase(LAS unsigned char* lds, const int K, const int lda, const int ldb, const Sched& S, const Epi& E) {
    const int tid = threadIdx.x, wid = __builtin_amdgcn_readfirstlane(tid >> 6), lane = tid & 63, wr = wid >> 2, wc = wid & 3, fr = lane & 15, fq = lane >> 4;
    const int nt = K / BK;
    unsigned voffB[2]; int Ra[2], Ca[2];
#pragma unroll
    for (int i = 0; i < 2; ++i) { int R, C; stage_rc(tid * 16 + i * 8192, R, C); const int Rb = Epi::PERM ? ((R & ~31) + perm32(R & 31)) : R;
        Ra[i] = R; Ca[i] = C; voffB[i] = (unsigned)(Rb * ldb + C) * 2u; }
    unsigned offC[2][2], offN[2][2];
#define PG8_SETOFF(o, u) do { _Pragma("unroll") for (int h_ = 0; h_ < 2; ++h_) _Pragma("unroll") for (int i_ = 0; i_ < 2; ++i_) { \
        if ((u).rows) { int ix_ = h_ * HALF + Ra[i_]; ix_ = ix_ < (u).rmax ? ix_ : (u).rmax; o[h_][i_] = (unsigned)((u).rows[ix_] >> 2) * (unsigned)(lda * 2) + (unsigned)Ca[i_] * 2u; } \
        else o[h_][i_] = (unsigned)((h_ * HALF + Ra[i_]) * lda + Ca[i_]) * 2u; } } while (0)
    const size_t kstep = (size_t)(BK * 2);
    const size_t hstepB = (size_t)HALF * ldb * 2;
    const unsigned ldsw = (unsigned)wid * 1024u;
    const int aoff = lds_byte(wr * 64 + fr, fq * 8), boff = lds_byte(wc * 32 + fr, fq * 8);
#define PG8_SA(b, h) (((b) * 2 + (h)) * HTB)
#define PG8_SB(b, h) ((4 + (b) * 2 + (h)) * HTB)
#define PG8_STAGE(bufoff, gbase, voff) do { _Pragma("unroll") for (int _i = 0; _i < 2; ++_i) \
        __builtin_amdgcn_global_load_lds((const unsigned*)((const char*)(gbase) + (voff)[_i]), (LAS unsigned*)(lds + (bufoff) + ldsw + _i * 8192), 16, 0, 0); } while (0)
#define PG8_LDA(dst, b, h) do { _Pragma("unroll") for (int m = 0; m < 4; ++m) { \
        if constexpr (F8) dst##8[m] = __builtin_shufflevector(*(const LAS v4i8_t*)(lds + PG8_SA(b, h) + aoff + m * 2048), *(const LAS v4i8_t*)(lds + PG8_SA(b, h) + aoff + m * 2048 + 1024), 0, 1, 2, 3, 4, 5, 6, 7); \
        else { _Pragma("unroll") for (int k = 0; k < 2; ++k) dst[m][k] = *(const LAS bf16x8*)(lds + PG8_SA(b, h) + aoff + m * 2048 + k * 1024); } } } while (0)
#define PG8_LDB(dst, b, h) do { _Pragma("unroll") for (int n = 0; n < 2; ++n) { \
        if constexpr (F8) dst##8[n] = __builtin_shufflevector(*(const LAS v4i8_t*)(lds + PG8_SB(b, h) + boff + n * 2048), *(const LAS v4i8_t*)(lds + PG8_SB(b, h) + boff + n * 2048 + 1024), 0, 1, 2, 3, 4, 5, 6, 7); \
        else { _Pragma("unroll") for (int k = 0; k < 2; ++k) dst[n][k] = *(const LAS bf16x8*)(lds + PG8_SB(b, h) + boff + n * 2048 + k * 1024); } } } while (0)
#define PG8_MMA(ai, bj, At, Bt) do { __builtin_amdgcn_s_setprio(1); _Pragma("unroll") for (int m = 0; m < 4; ++m) _Pragma("unroll") for (int n = 0; n < 2; ++n) { \
        if constexpr (F8) asm volatile("v_mfma_scale_f32_16x16x128_f8f6f4 %0, %1, %2, %0, %3, %3 op_sel_hi:[0,0,0]" : "+v"(acc[ai][bj][m][n]) : "v"(Bt##8[n]), "v"(At##8[m]), "v"(f8scale_));   \
        else { _Pragma("unroll") for (int k = 0; k < 2; ++k) acc[ai][bj][m][n] = __builtin_amdgcn_mfma_f32_16x16x32_bf16(Bt[n][k], At[m][k], acc[ai][bj][m][n], 0, 0, 0); } } \
        __builtin_amdgcn_s_setprio(0); } while (0)
#define PG8_WAIT_V(n) asm volatile("s_waitcnt vmcnt(" #n ")" ::: "memory")
#define PG8_WAIT_L(n) asm volatile("s_waitcnt lgkmcnt(" #n ")" ::: "memory")
#define PG8_BAR __builtin_amdgcn_s_barrier()
#define PG8_SCHED __builtin_amdgcn_sched_barrier(0)
    Unit cur, nxt; int ui = 0;
    if (!S.next(0, cur)) return;
    f32x4 acc[2][2][4][2];
#pragma unroll
    for (int a = 0; a < 2; ++a)
#pragma unroll
        for (int b = 0; b < 2; ++b)
#pragma unroll
            for (int m = 0; m < 4; ++m)
#pragma unroll
                for (int n = 0; n < 2; ++n) acc[a][b][m][n] = (f32x4){0.f, 0.f, 0.f, 0.f};
    bf16x8 At[4][2], B0[2][2], B1[2][2];
    v8i_t At8[4], B08[2], B18[2];
    const int f8scale_ = 0x7F7F7F7F;
    const char* cA = cur.A; const char* cB = cur.B;
    PG8_SETOFF(offC, cur);
    PG8_STAGE(PG8_SB(0, 0), cB, voffB); PG8_STAGE(PG8_SB(0, 1), cB + hstepB, voffB); PG8_STAGE(PG8_SA(0, 0), cA, offC[0]); PG8_STAGE(PG8_SA(0, 1), cA, offC[1]);
    if (wr == 1) PG8_BAR;
    PG8_WAIT_V(2); PG8_BAR;
    PG8_STAGE(PG8_SB(1, 0), cB + kstep, voffB); PG8_STAGE(PG8_SA(1, 0), cA + kstep, offC[0]); PG8_STAGE(PG8_SB(1, 1), cB + hstepB + kstep, voffB);
    PG8_WAIT_V(6); PG8_BAR;
    for (;;) {
        const bool has_next = S.next(ui + 1, nxt);
        const char* nA = has_next ? nxt.A : cA; const char* nB = has_next ? nxt.B : cB;
        if (has_next) { PG8_SETOFF(offN, nxt); } else { offN[0][0] = offC[0][0]; offN[0][1] = offC[0][1]; offN[1][0] = offC[1][0]; offN[1][1] = offC[1][1]; }
#pragma unroll 1
        for (int t = 0; t < nt; t += 2) {
            const bool last = (t == nt - 2);
            const char* a1 = cA + (size_t)(t + 1) * kstep;
            const char* a2 = last ? nA : cA + (size_t)(t + 2) * kstep; const char* b2 = last ? nB : cB + (size_t)(t + 2) * kstep;
            const char* a3 = a2 + kstep; const char* b3 = b2 + kstep;
            unsigned o2[2][2];
            o2[0][0] = last ? offN[0][0] : offC[0][0]; o2[0][1] = last ? offN[0][1] : offC[0][1]; o2[1][0] = last ? offN[1][0] : offC[1][0]; o2[1][1] = last ? offN[1][1] : offC[1][1];
            PG8_LDB(B0, 0, 0); PG8_LDB(B1, 0, 1); PG8_SCHED; PG8_LDA(At, 0, 0); PG8_STAGE(PG8_SA(1, 1), a1, offC[1]);
            PG8_WAIT_V(8); PG8_WAIT_L(0); PG8_BAR; PG8_MMA(0, 0, At, B0); PG8_MMA(0, 1, At, B1); PG8_BAR; PG8_SCHED;
            PG8_LDA(At, 0, 1); PG8_STAGE(PG8_SB(0, 0), b2, voffB); PG8_STAGE(PG8_SB(0, 1), b2 + hstepB, voffB); PG8_STAGE(PG8_SA(0, 0), a2, o2[0]);
            PG8_WAIT_V(8); PG8_WAIT_L(0); PG8_BAR; PG8_MMA(1, 0, At, B0); PG8_MMA(1, 1, At, B1); PG8_BAR; PG8_SCHED;
            PG8_LDB(B0, 1, 0); PG8_LDB(B1, 1, 1); PG8_SCHED; PG8_LDA(At, 1, 0); PG8_STAGE(PG8_SA(0, 1), a2, o2[1]);
            PG8_WAIT_V(8); PG8_WAIT_L(0); PG8_BAR; PG8_MMA(0, 0, At, B0); PG8_MMA(0, 1, At, B1); PG8_BAR; PG8_SCHED;
            PG8_LDA(At, 1, 1); PG8_STAGE(PG8_SB(1, 0), b3, voffB); PG8_STAGE(PG8_SB(1, 1), b3 + hstepB, voffB); PG8_STAGE(PG8_SA(1, 0), a3, o2[0]);
            PG8_WAIT_V(8); PG8_WAIT_L(0); PG8_BAR; PG8_MMA(1, 0, At, B0); PG8_MMA(1, 1, At, B1); PG8_BAR; PG8_SCHED;
        }
        if constexpr (ALIGN_EPI) { if (wr == 0) PG8_BAR; }
        if constexpr (F8) asm volatile("s_nop 15\n\ts_nop 15" ::: "memory");
        E(acc, cur, wr, wc, fr, fq);
        if (!has_next) break;
#pragma unroll
        for (int a = 0; a < 2; ++a)
#pragma unroll
            for (int b = 0; b < 2; ++b)
#pragma unroll
                for (int m = 0; m < 4; ++m)
#pragma unroll
                    for (int n = 0; n < 2; ++n) acc[a][b][m][n] = (f32x4){0.f, 0.f, 0.f, 0.f};
        cur = nxt; cA = nA; cB = nB; ++ui;
        offC[0][0] = offN[0][0]; offC[0][1] = offN[0][1]; offC[1][0] = offN[1][0]; offC[1][1] = offN[1][1];
        if constexpr (ALIGN_EPI) { if (wr == 1) PG8_BAR; }
    }
    PG8_WAIT_V(0);
    if constexpr (!ALIGN_EPI) { if (wr == 0) PG8_BAR; }
    PG8_BAR;
#undef PG8_SETOFF
#undef PG8_SA
#undef PG8_SB
#undef PG8_STAGE
#undef PG8_LDA
#undef PG8_LDB
#undef PG8_MMA
#undef PG8_WAIT_V
#undef PG8_WAIT_L
#undef PG8_BAR
#undef PG8_SCHED
}

struct DenseOrder {
    const char* A; const char* B; size_t tstepA, tstepB; int nM, nN, nwg, G, c;
    __device__ __forceinline__ void init(const void* A_, const void* B_, int M, int N, int lda, int ldb, int G_, int c_) {
        A = (const char*)A_; B = (const char*)B_; tstepA = (size_t)BM * lda * 2; tstepB = (size_t)BM * ldb * 2; nM = M / BM; nN = N / BM; nwg = nM * nN; G = G_; c = c_; }
    __device__ __forceinline__ bool next(int i, Unit& u) const {
        const long L = (long)i * G + c; if (L >= nwg) return false;
        int wgid = (int)L; { const int q = nwg / 8, r = nwg % 8, xcd = wgid % 8, off = wgid / 8; wgid = (xcd < r ? xcd * (q + 1) : r * (q + 1) + (xcd - r) * q) + off; }
        const int nig = 8 * nN, gid = wgid / nig, fm = gid * 8, gsz = (nM - fm) < 8 ? (nM - fm) : 8;
        u.pm = fm + ((wgid % nig) % gsz); u.pn = (wgid % nig) / gsz; u.e = 0; u.nvalid = 256; u.rows = nullptr; u.rmax = 255;
        u.A = A + (size_t)u.pm * tstepA; u.B = B + (size_t)u.pn * tstepB; return true;
    }
};
}

__device__ __forceinline__ int map_in(int n) { return n < 1792 ? n : (n < 3840 ? n + 24 : (n < 3864 ? 1792 + (n - 3840) : -1)); }
__device__ __forceinline__ int map_il128(int n) { const int b = n >> 7; return (b & 1) * 1024 + (b >> 1) * 128 + (n & 127); }

struct TrJob { const float* W; bf16_t* Wt; int K, Nsrc, map, kt, nt; float f8scale; };
constexpr int TR_IN = 16 * 16, TR_GLU = 8 * 8, TR_NSA = 8 * 4, TR_OUT = 16 * 4, TR_C1 = 2 * 32, TR_GU = 32 * 16 * 8, TR_DN = 32 * 16 * 4;
constexpr int TR_ITEMS = TR_IN + TR_GLU + TR_NSA + TR_OUT + TR_C1 + TR_GU + TR_DN;
__device__ __forceinline__ void tr_job(const Params& p, int r, TrJob& j) {
    unsigned char* ws = p.ws;
    if (r < TR_IN) { j = TrJob{p.in[5], (bf16_t*)(ws + O_WT_IN), 1024, 3864, 1, r / 16, r % 16, WGU_SCALE}; return; } r -= TR_IN;
    if (r < TR_GLU) { j = TrJob{p.in[14], (bf16_t*)(ws + O_WT_GLU), 512, 2048, 2, r / 8, r % 8, WGLU_SCALE}; return; } r -= TR_GLU;
    if (r < TR_NSA) { j = TrJob{p.in[22], (bf16_t*)(ws + O_WT_NSA), 512, 1024, 0, r / 4, r % 4, WNSA_SCALE}; return; } r -= TR_NSA;
    if (r < TR_OUT) { j = TrJob{p.in[23], (bf16_t*)(ws + O_WT_OUT), 1024, 1024, 0, r / 4, r % 4, WOUT_SCALE}; return; } r -= TR_OUT;
    if (r < TR_C1) { const int kv = r / 32; j = TrJob{p.in[kv ? 20 : 17], (bf16_t*)(ws + O_WT_C1) + (size_t)kv * 256 * 2048, 2048, 128, 3, r % 32, 0, 0.f}; return; } r -= TR_C1;
    if (r < TR_GU) { const int e = r / 128, q = r % 128; j = TrJob{p.in[28] + (size_t)e * 1024 * 2048, (bf16_t*)(ws + O_WT_GU + (size_t)e * 2048 * 1024), 1024, 2048, 2, q / 8, q % 8, WGU_SCALE}; return; } r -= TR_GU;
    { const int e = r / 64, q = r % 64; j = TrJob{p.in[30] + (size_t)e * 1024 * 1024, (bf16_t*)(ws + O_WT_DN + (size_t)e * 1024 * 1024), 1024, 1024, 0, q / 4, q % 4, WDN_SCALE}; }
}
__device__ __forceinline__ void tr_load(const TrJob& j, f32x4 (&v)[8], int tid) {
    const int n4 = tid & 63, kq = tid >> 6, nd = j.nt * 256 + 4 * n4;
    const int src = j.map == 0 ? nd : (j.map == 1 ? map_in(nd) : (j.map == 2 ? map_il128(nd) : (nd < 128 ? nd : -1)));
    const float* base = j.W + (size_t)(j.kt * 64 + kq) * j.Nsrc + (src >= 0 ? src : 0);
#pragma unroll
    for (int i = 0; i < 8; ++i) v[i] = (src >= 0) ? *(const f32x4*)(base + (size_t)i * 8 * j.Nsrc) : (f32x4){0.f, 0.f, 0.f, 0.f};
}
__device__ __forceinline__ void tr_store(const TrJob& cj, const float* t, int tid) {
    if (cj.f8scale != 0.f) {
        const int n = tid & 255, kh = (tid >> 8) * 32; const float sc = cj.f8scale;
        unsigned char* d = (unsigned char*)cj.Wt + (size_t)(cj.nt * 256 + n) * cj.K + cj.kt * 64 + kh;
#pragma unroll
        for (int q = 0; q < 2; ++q) {
            const float* c = t + (kh + 16 * q) * 260 + n;
            u32x4 o;
            o.x = pk4_f8(c[0] * sc, c[260] * sc, c[2 * 260] * sc, c[3 * 260] * sc); o.y = pk4_f8(c[4 * 260] * sc, c[5 * 260] * sc, c[6 * 260] * sc, c[7 * 260] * sc);
            o.z = pk4_f8(c[8 * 260] * sc, c[9 * 260] * sc, c[10 * 260] * sc, c[11 * 260] * sc); o.w = pk4_f8(c[12 * 260] * sc, c[13 * 260] * sc, c[14 * 260] * sc, c[15 * 260] * sc);
            *(u32x4*)(d + 16 * q) = o;
        }
    } else {
        const int n = tid & 255, kh = (tid >> 8) * 32;
        bf16_t* d = cj.Wt + (size_t)(cj.nt * 256 + n) * cj.K + cj.kt * 64 + kh;
#pragma unroll
        for (int q = 0; q < 4; ++q) {
            const float* c = t + (kh + 8 * q) * 260 + n;
            u32x4 o;
            o.x = pk2(c[0], c[260]); o.y = pk2(c[2 * 260], c[3 * 260]); o.z = pk2(c[4 * 260], c[5 * 260]); o.w = pk2(c[6 * 260], c[7 * 260]);
            *(u32x4*)(d + 8 * q) = o;
        }
    }
}
__device__ __forceinline__ void convert_weights(const Params& p, unsigned char* smem, int lo, int hi, unsigned* queue) {
    float* t = (float*)smem;
    int* slot = (int*)(smem + 64 * 260 * 4);
    const int tid = threadIdx.x, n4 = tid & 63, kq = tid >> 6;
    const int G = gridDim.x;
    int ia, ib;
    if (queue) { if (tid == 0) { slot[0] = lo + (int)atomicAdd(queue, 1u); slot[1] = lo + (int)atomicAdd(queue, 1u); } __syncthreads(); ia = slot[0]; ib = slot[1]; __syncthreads(); }
    else { ia = lo + blockIdx.x; ib = ia + G; }
    if (ia >= hi) return;
    TrJob ja, jb; f32x4 va[8], vb[8];
    tr_job(p, ia, ja); tr_load(ja, va, tid);
    if (ib < hi) { tr_job(p, ib, jb); tr_load(jb, vb, tid); }
#define TR_ROUND(I, J, V) do { \
        _Pragma("unroll") for (int i = 0; i < 8; ++i) *(f32x4*)(t + (i * 8 + kq) * 260 + 4 * n4) = V[i]; \
        if (queue && tid == 0) slot[0] = lo + (int)atomicAdd(queue, 1u); \
        __syncthreads(); \
        const TrJob cj_ = J; \
        I = queue ? slot[0] : I + 2 * G; \
        if (I < hi) { tr_job(p, I, J); tr_load(J, V, tid); } \
        tr_store(cj_, t, tid); \
        __syncthreads(); } while (0)
    for (;;) {
        TR_ROUND(ia, ja, va);
        if (ib >= hi) break;
        TR_ROUND(ib, jb, vb);
        if (ia >= hi) break;
    }
#undef TR_ROUND
}

__device__ __forceinline__ void phase0(const Params& p, unsigned char* smem) {
    unsigned char* ws = p.ws;
    const int tid = threadIdx.x;
    convert_weights(p, smem, 0, TR_ITEMS - TR_GU - TR_DN, nullptr);
    constexpr int I_ADA = 96;
    constexpr int I_S5 = 32 * 33;
    constexpr int I_MISC = 17;
    constexpr int NITEM = I_ADA + I_S5 + I_MISC;
    for (int item = blockIdx.x; item < NITEM; item += gridDim.x) {
        int r = item;
        if (r < I_ADA) {
            const float* c = p.in[1]; const float* w = p.in[3]; const float* bb = p.in[4];
            const int wid = tid >> 6, lane = tid & 63, j = r * 64 + lane;
            float a0 = 0.f, a1 = 0.f, a2 = 0.f, a3 = 0.f;
#pragma unroll 4
            for (int k = wid * 128; k < wid * 128 + 128; ++k) {
                const float wv = w[(size_t)k * 6144 + j];
                const float c0 = c[k], c1 = c[1024 + k], c2 = c[2048 + k], c3 = c[3072 + k];
                a0 += c0 * sigmoidf_(c0) * wv; a1 += c1 * sigmoidf_(c1) * wv; a2 += c2 * sigmoidf_(c2) * wv; a3 += c3 * sigmoidf_(c3) * wv;
            }
            float* red = (float*)smem;
            red[(wid * 4 + 0) * 64 + lane] = a0; red[(wid * 4 + 1) * 64 + lane] = a1; red[(wid * 4 + 2) * 64 + lane] = a2; red[(wid * 4 + 3) * 64 + lane] = a3;
            __syncthreads();
            if (tid < 256) { const int b = tid >> 6; float s = 0.f;
#pragma unroll
              for (int w8 = 0; w8 < 8; ++w8) s += red[(w8 * 4 + b) * 64 + lane];
              ((float*)(ws + O_ADA))[b * 6144 + j] = s + bb[j]; }
            asm volatile("s_waitcnt vmcnt(0)" ::: "memory");
            __syncthreads();
            if (tid == 0) { __builtin_amdgcn_fence(__ATOMIC_RELEASE, "agent"); asm volatile("s_waitcnt vmcnt(0)" ::: "memory"); (void)xb_add((unsigned*)(ws + O_BAR) + 3400, 1u); }
            continue;
        }
        r -= I_ADA;
        if (r < I_S5) {
            const int g = r / 33, dl = r % 33;
            f32x2* pw = (f32x2*)smem;
            f32x2* bbv = pw + 64;
            f32x2* ccv = bbv + 1024;
            const float dt = expf(p.in[8][g]);
            if (tid < 64) {
                const int n = tid; const double re = p.in[6][g * 64 + n], im = p.in[7][g * 64 + n];
                const float mag = __expf((float)(re * (double)dt * dl)); const double ang = im * (double)dt * dl;
                const float ar = (float)(ang - 6.283185307179586 * rint(ang * 0.15915494309189535));
                float sn, cs; sincosf(ar, &sn, &cs);
                pw[n] = (f32x2){mag * cs, mag * sn};
                if (dl == 32) { ((f32x2*)(ws + O_LAML))[g * 64 + n] = pw[n]; }
            }
            for (int e = tid; e < 1024; e += NT) {
                const int n = e >> 4, q = e & 15;
                const double re = p.in[6][g * 64 + n], im = p.in[7][g * 64 + n];
                const double ang = im * (double)dt;
                const float ar = (float)(ang - 6.283185307179586 * rint(ang * 0.15915494309189535));
                float snf, csf; sincosf(ar, &snf, &csf);
                const double mag = exp(re * (double)dt), sn = snf, cs = csf;
                const double lr = mag * cs - 1.0, li = mag * sn;
                const double den = re * re + im * im;
                const double fr_ = (lr * re + li * im) / den, fi_ = (li * re - lr * im) / den;
                const double br = p.in[9][(g * 64 + n) * 16 + q], bi = p.in[10][(g * 64 + n) * 16 + q];
                bbv[e] = (f32x2){(float)(fr_ * br - fi_ * bi), (float)(fr_ * bi + fi_ * br)};
            }
            for (int e = tid; e < 1024; e += NT) { ccv[e] = (f32x2){p.in[11][g * 1024 + e], p.in[12][g * 1024 + e]}; }
            __syncthreads();
            bf16_t* TW2 = (bf16_t*)(ws + O_TW2) + (size_t)g * 512 * UROW;
            bf16_t* W1T = (bf16_t*)(ws + O_W1T) + (size_t)g * 256 * 512;
            if (dl < 32) {
                if (tid < 256) {
                    const int pp = tid >> 4, q = tid & 15;
                    float acc = 0.f;
                    for (int n = 0; n < 64; ++n) {
                        const f32x2 cv = ccv[pp * 64 + n], pv = pw[n], bv = bbv[n * 16 + q];
                        const float xr = cv.x * pv.x - cv.y * pv.y, xi = cv.x * pv.y + cv.y * pv.x;
                        acc += xr * bv.x - xi * bv.y;
                    }
                    if (dl == 0 && pp == q) acc += p.in[13][g * 16 + pp];
                    const bf16_t kb = f2bf(acc);
                    for (int tau = dl; tau < 32; ++tau) { const int s = tau - dl; TW2[(size_t)(tau * 16 + pp) * UROW + s * 16 + q] = kb; }
                    if (dl >= 1) for (int s = dl; s < 32; ++s) { const int tau = s - dl; TW2[(size_t)(tau * 16 + pp) * UROW + s * 16 + q] = 0; }
                }
                const int s = 31 - dl;
                for (int e = tid; e < 2048; e += NT) {
                    const int c = e >> 4, qq = e & 15, n = c & 63, ri = c >> 6;
                    const f32x2 pv = pw[n], bv = bbv[n * 16 + qq];
                    const float zr = pv.x * bv.x - pv.y * bv.y, zi = pv.x * bv.y + pv.y * bv.x;
                    W1T[(size_t)c * 512 + s * 16 + qq] = f2bf(ri ? zi : zr);
                }
            } else {
                u32x4* z = (u32x4*)(W1T + (size_t)128 * 512);
                for (int e = tid; e < 128 * 512 / 8; e += NT) z[e] = (u32x4){0u, 0u, 0u, 0u};
            }
            if (dl >= 1) {
                const int tau = dl - 1;
                for (int e = tid; e < 2048; e += NT) {
                    const int pp = e >> 7, c = e & 127, n = c & 63, ri = c >> 6;
                    const f32x2 cv = ccv[pp * 64 + n], pv = pw[n];
                    const float xr = cv.x * pv.x - cv.y * pv.y, xi = cv.x * pv.y + cv.y * pv.x;
                    TW2[(size_t)(tau * 16 + pp) * UROW + 512 + c] = f2bf(ri ? -xi : xr);
                }
            }
            __syncthreads();
            continue;
        }
        r -= I_S5;
        if (r < 16) {
            const int kv = r >> 3, part = r & 7, j = tid & 127, qtr = tid >> 7;
            const float* pos = p.in[kv ? 19 : 16]; const float* w1 = p.in[kv ? 20 : 17];
            float a = 0.f;
            const int i0 = part * 256 + qtr * 64;
            for (int i = i0; i < i0 + 64; ++i) a += pos[i] * w1[(size_t)i * 128 + j];
            float* red = (float*)smem;
            red[tid] = a;
            __syncthreads();
            if (tid < 128) ((float*)(ws + O_BIAS1))[(kv * 8 + part) * 128 + tid] = (red[tid] + red[tid + 128]) + (red[tid + 256] + red[tid + 384]);
            __syncthreads();
            continue;
        }
        for (int i = tid; i < 1100; i += NT) ((unsigned*)(ws + O_CNT))[i] = 0u;
    }
}

__device__ __forceinline__ void phase1(const Params& p, unsigned char*) {
    if (threadIdx.x == 0) { unsigned* f = (unsigned*)(p.ws + O_BAR) + 3400; XB_SPIN(xb_ld(f) < 96u, (unsigned*)(p.ws + O_BAR)); __builtin_amdgcn_fence(__ATOMIC_ACQUIRE, "agent"); asm volatile("s_waitcnt vmcnt(0)" ::: "memory"); }
    __syncthreads();
    const float* x = p.in[0];
    unsigned char* xn = p.ws + O_XN;
    for (size_t i = (size_t)blockIdx.x * NT + threadIdx.x; i < (size_t)NTOK * 128; i += (size_t)gridDim.x * NT) {
        const int token = (int)(i >> 7), k = (int)(i & 127) * 8, b = token >> 13;
        const float* ada = (const float*)(p.ws + O_ADA) + b * 6144;
        const f32x4 x0 = *(const f32x4*)(x + (size_t)token * 1024 + k), x1 = *(const f32x4*)(x + (size_t)token * 1024 + k + 4);
        const f32x4 s0 = *(const f32x4*)(ada + 1024 + k), s1 = *(const f32x4*)(ada + 1024 + k + 4);
        const f32x4 h0 = *(const f32x4*)(ada + k), h1 = *(const f32x4*)(ada + k + 4);
        *(u32x2*)(xn + (size_t)token * 1024 + k) = (u32x2){pk4_f8(x0[0] * (1.f + s0[0]) + h0[0], x0[1] * (1.f + s0[1]) + h0[1], x0[2] * (1.f + s0[2]) + h0[2], x0[3] * (1.f + s0[3]) + h0[3]),
                                                           pk4_f8(x1[0] * (1.f + s1[0]) + h1[0], x1[1] * (1.f + s1[1]) + h1[1], x1[2] * (1.f + s1[2]) + h1[2], x1[3] * (1.f + s1[3]) + h1[3])};
    }
}

typedef const f32x4 (&AccRef)[2][2][4][2];
struct EpiIn {
    static constexpr bool PERM = true;
    unsigned char* ws;
    __device__ __forceinline__ void operator()(AccRef acc, const pg8::Unit& u, int wr, int wc, int fr, int fq) const {
        const int pn = u.pn;
#pragma unroll
        for (int ai = 0; ai < 2; ++ai)
#pragma unroll
            for (int m = 0; m < 4; ++m) {
                const int token = u.pm * 256 + ai * 128 + wr * 64 + m * 16 + fr;
#pragma unroll
                for (int bj = 0; bj < 2; ++bj) {
                    const int col = pn * 256 + bj * 128 + wc * 32 + 8 * fq;
                    const f32x4 v0 = acc[ai][bj][m][0] * (1.f / WGU_SCALE), v1 = acc[ai][bj][m][1] * (1.f / WGU_SCALE);
                    if (pn < 2) {
                        const int g = col >> 4, q = col & 15;
                        bf16_t* d = (bf16_t*)(ws + O_U) + ((size_t)(g * 1024 + (token >> 5)) * UROW + (token & 31) * 16 + q);
                        *(u32x4*)d = (u32x4){pk2(v0[0], v0[1]), pk2(v0[2], v0[3]), pk2(v1[0], v1[1]), pk2(v1[2], v1[3])};
                    } else if (pn < 4) {
                        bf16_t* d = (bf16_t*)(ws + O_Q) + (size_t)token * 512 + (col - 512);
                        *(u32x4*)d = (u32x4){pk2(v0[0] * QSCALE, v0[1] * QSCALE), pk2(v0[2] * QSCALE, v0[3] * QSCALE), pk2(v1[0] * QSCALE, v1[1] * QSCALE), pk2(v1[2] * QSCALE, v1[3] * QSCALE)};
                    } else if (pn < 7) {
                        const int c = col - 1024, j6 = c >> 7, g = (c >> 6) & 1, dd = c & 63, b = token >> 13, s = token & 8191;
                        bf16_t* slab = (bf16_t*)(ws + O_KV) + (size_t)((j6 * 4 + b) * 2 + g) * KV_SLAB;
                        if (j6 == 3 || j6 == 5) {
                            const int p64 = s & 63, p16 = p64 & 15, slot = (p16 & 3) | ((p16 & 4) << 1) | ((p16 & 8) >> 1);
                            bf16_t* blkp = slab + (size_t)(s >> 6) * 4096 + (((p64 >> 5) * 2 + ((p64 >> 4) & 1)) * 64 + (slot >> 3) * 32) * 8 + (slot & 7);
#pragma unroll
                            for (int j = 0; j < 4; ++j) { const int d0 = dd + j, d1 = dd + 4 + j;
                                blkp[((d0 >> 5) * 4 * 64 + (d0 & 31)) * 8] = f2bf(v0[j]); blkp[((d1 >> 5) * 4 * 64 + (d1 & 31)) * 8] = f2bf(v1[j]); }
                        } else if (j6 == 2 || j6 == 4) {
                            bf16_t* d = slab + (size_t)((s >> 5) * 4 + (dd >> 4)) * 512 + (((dd >> 3) & 1) * 32 + (s & 31)) * 8;
                            *(u32x4*)d = (u32x4){pk2(v0[0], v0[1]), pk2(v0[2], v0[3]), pk2(v1[0], v1[1]), pk2(v1[2], v1[3])};
                        } else {
                            *(u32x4*)(slab + (size_t)s * 64 + dd) = (u32x4){pk2(v0[0], v0[1]), pk2(v0[2], v0[3]), pk2(v1[0], v1[1]), pk2(v1[2], v1[3])};
                        }
                    } else if (pn < 15) {
                        bf16_t* d = (pn < 11 ? (bf16_t*)(ws + O_SG5) + (size_t)token * 1024 + (col - 1792) : (bf16_t*)(ws + O_SGN) + (size_t)token * 1024 + (col - 2816));
                        *(u32x4*)d = (u32x4){pk2(sigmoidf_(v0[0]), sigmoidf_(v0[1])), pk2(sigmoidf_(v0[2]), sigmoidf_(v0[3])), pk2(sigmoidf_(v1[0]), sigmoidf_(v1[1])), pk2(sigmoidf_(v1[2]), sigmoidf_(v1[3]))};
                    } else {
                        const int c = col - 3840;
                        if (c < 24) { float* d = (float*)(ws + O_GN) + (size_t)token * 24 + c;
                            *(f32x4*)d = (f32x4){sigmoidf_(v0[0]), sigmoidf_(v0[1]), sigmoidf_(v0[2]), sigmoidf_(v0[3])};
                            *(f32x4*)(d + 4) = (f32x4){sigmoidf_(v1[0]), sigmoidf_(v1[1]), sigmoidf_(v1[2]), sigmoidf_(v1[3])}; }
                    }
                }
            }
    }
};
__device__ __forceinline__ void phase2(const Params& p, LAS unsigned char* lds) {
    pg8::DenseOrder S; S.init(p.ws + O_XN, p.ws + O_WT_IN, NTOK, NIN_PAD, 512, 512, gridDim.x, blockIdx.x);
    EpiIn E{p.ws};
    pg8::gemm_phase<EpiIn, pg8::DenseOrder, true, true>(lds, 512, 512, 512, S, E);
}

struct BatchOrder {
    const char* A; const char* B; size_t bsA, bsB, tstepA, tstepB; int nM, nN, nunits, G, c;
    __device__ __forceinline__ bool next(int i, pg8::Unit& u) const {
        const long L = (long)i * G + c; if (L >= nunits) return false;
        const int per = nM * nN, bt = (int)L / per, rem = (int)L % per;
        u.pm = rem / nN; u.pn = rem % nN; u.e = bt; u.nvalid = 256; u.rows = nullptr; u.rmax = 255;
        u.A = A + (size_t)bt * bsA + (size_t)u.pm * tstepA; u.B = B + (size_t)bt * bsB + (size_t)u.pn * tstepB; return true;
    }
};
struct EpiE { static constexpr bool PERM = false; float* E;
    __device__ __forceinline__ void operator()(AccRef acc, const pg8::Unit& u, int wr, int wc, int fr, int fq) const {
#pragma unroll
        for (int ai = 0; ai < 2; ++ai)
#pragma unroll
            for (int m = 0; m < 4; ++m) {
                const int r = u.pm * 256 + ai * 128 + wr * 64 + m * 16 + fr;
#pragma unroll
                for (int n = 0; n < 2; ++n) *(f32x4*)(E + ((size_t)u.e * 1024 + r) * 128 + wc * 32 + n * 16 + fq * 4) = acc[ai][0][m][n];
            }
    } };
struct EpiCmp { static constexpr bool PERM = true; const float* b1p; bf16_t* HC;
    __device__ __forceinline__ void operator()(AccRef acc, const pg8::Unit& u, int wr, int wc, int fr, int fq) const {
        const int col = wc * 32 + 8 * fq;
        f32x4 b0 = (f32x4){0.f, 0.f, 0.f, 0.f}, b1 = b0;
#pragma unroll
        for (int part = 0; part < 8; ++part) { b0 += *(const f32x4*)(b1p + (u.e * 8 + part) * 128 + col); b1 += *(const f32x4*)(b1p + (u.e * 8 + part) * 128 + col + 4); }
#pragma unroll
        for (int ai = 0; ai < 2; ++ai)
#pragma unroll
            for (int m = 0; m < 4; ++m) {
                const int R = u.pm * 256 + ai * 128 + wr * 64 + m * 16 + fr;
                const f32x4 v0 = acc[ai][0][m][0] + b0, v1 = acc[ai][0][m][1] + b1;
                *(u32x4*)(HC + ((size_t)u.e * 4096 + R) * 128 + col) = (u32x4){pk2(gelu_tanh(v0[0]), gelu_tanh(v0[1])), pk2(gelu_tanh(v0[2]), gelu_tanh(v0[3])), pk2(gelu_tanh(v1[0]), gelu_tanh(v1[1])), pk2(gelu_tanh(v1[2]), gelu_tanh(v1[3]))};
            }
    } };
__device__ __forceinline__ void phase3(const Params& p, LAS unsigned char* lds) {
    const int G = gridDim.x;
    {
        BatchOrder S{(const char*)(p.ws + O_U), (const char*)(p.ws + O_W1T), (size_t)1024 * UROW * 2, (size_t)256 * 512 * 2, (size_t)256 * UROW * 2, 0, 4, 1, 128, G, (int)blockIdx.x};
        EpiE E{(float*)(p.ws + O_E)};
        pg8::gemm_phase<EpiE, BatchOrder, false>(lds, 512, UROW, 512, S, E);
    }
    {
        BatchOrder S{(const char*)(p.ws + O_KV), (const char*)(p.ws + O_WT_C1), (size_t)8 * KV_SLAB * 2, (size_t)256 * 2048 * 2, (size_t)256 * 1024 * 2, 0, 16, 1, 32, G, (int)((blockIdx.x + G - 128 % G) % G)};
        EpiCmp E{(const float*)(p.ws + O_BIAS1), (bf16_t*)(p.ws + O_HC)};
        pg8::gemm_phase<EpiCmp, BatchOrder, false>(lds, 2048, 1024, 2048, S, E);
    }
}
__device__ __forceinline__ void phase4(const Params& p, unsigned char* smem) {
    const int tid = threadIdx.x;
    for (int item = blockIdx.x; item < 16 + 512; item += gridDim.x) {
        if (item < 16) {
            f32x2* seg = (f32x2*)smem;
#pragma unroll 1
            for (int half = 0; half < 8; ++half) {
                const int n = tid & 63, sg = tid >> 6, bg = item * 8 + half, b = bg >> 5, g = bg & 31;
                const f32x2 lm = ((const f32x2*)(p.ws + O_LAML))[g * 64 + n];
                const float* E = (const float*)(p.ws + O_E) + (size_t)(g * 1024 + b * 256 + sg * 32) * 128;
                bf16_t* U = (bf16_t*)(p.ws + O_U) + (size_t)(g * 1024 + b * 256 + sg * 32) * UROW + 512;
                float er[32], ei[32];
#pragma unroll
                for (int c = 0; c < 32; ++c) { er[c] = E[(size_t)c * 128 + n]; ei[c] = E[(size_t)c * 128 + 64 + n]; }
                float hr = 0.f, hi = 0.f;
#pragma unroll
                for (int c = 0; c < 32; ++c) { const float nr = lm.x * hr - lm.y * hi + er[c], ni = lm.x * hi + lm.y * hr + ei[c]; hr = nr; hi = ni; }
                seg[sg * 64 + n] = (f32x2){hr, hi};
                float pr = lm.x, pi = lm.y;
#pragma unroll
                for (int q = 0; q < 5; ++q) { const float nr = pr * pr - pi * pi, ni = 2.f * pr * pi; pr = nr; pi = ni; }
                __syncthreads();
                float sr = 0.f, si = 0.f;
                for (int k = 0; k < sg; ++k) { const f32x2 a = seg[k * 64 + n]; const float nr = pr * sr - pi * si + a.x, ni = pr * si + pi * sr + a.y; sr = nr; si = ni; }
                hr = sr; hi = si;
#pragma unroll
                for (int c = 0; c < 32; ++c) {
                    U[(size_t)c * UROW + n] = f2bf(hr); U[(size_t)c * UROW + 64 + n] = f2bf(hi);
                    const float nr = lm.x * hr - lm.y * hi + er[c], ni = lm.x * hi + lm.y * hr + ei[c]; hr = nr; hi = ni;
                }
                __syncthreads();
            }
        } else {
#pragma unroll 1
            for (int rep = 0; rep < 2; ++rep) {
                const int o = ((item - 16) * 2 + rep) * NT + tid, d = o & 63, R = (o >> 6) & 4095, kv = o >> 18;
                const bf16_t* h = (const bf16_t*)(p.ws + O_HC) + ((size_t)kv * 4096 + R) * 128;
                const float* w2 = p.in[kv ? 21 : 18];
                float a = 0.f;
#pragma unroll 8
                for (int j = 0; j < 128; ++j) a += bf2f(h[j]) * w2[j * 64 + d];
                const int bgi = R >> 9, n = R & 511;
                if (kv == 0) ((bf16_t*)(p.ws + O_KC))[(size_t)bgi * 512 * 64 + (size_t)((n >> 5) * 4 + (d >> 4)) * 512 + (((d >> 3) & 1) * 32 + (n & 31)) * 8 + (d & 7)] = f2bf(a);
                else { const int p64 = n & 63, p16 = p64 & 15, slot = (p16 & 3) | ((p16 & 4) << 1) | ((p16 & 8) >> 1);
                       ((bf16_t*)(p.ws + O_KC))[(size_t)4096 * 64 + (size_t)bgi * 64 * 512 + (size_t)(n >> 6) * 4096 + ((((d >> 5) * 2 + (p64 >> 5)) * 2 + ((p64 >> 4) & 1)) * 64 + (slot >> 3) * 32 + (d & 31)) * 8 + (slot & 7)] = f2bf(a); }
            }
        }
    }
    __syncthreads();
    convert_weights(p, smem, TR_ITEMS - TR_GU - TR_DN, TR_ITEMS, (unsigned*)(p.ws + O_CNT) + 1056);
}
struct EpiY { static constexpr bool PERM = true; unsigned char* YS;
    __device__ __forceinline__ void operator()(AccRef acc, const pg8::Unit& u, int wr, int wc, int fr, int fq) const {
#pragma unroll
        for (int ai = 0; ai < 2; ++ai)
#pragma unroll
            for (int m = 0; m < 4; ++m) {
                const int r = u.pm * 256 + ai * 128 + wr * 64 + m * 16 + fr;
                const int tok0 = (r >> 8) * SEQ + (r & 255) * S5L;
#pragma unroll
                for (int bj = 0; bj < 2; ++bj) {
                    const int col = u.pn * 256 + bj * 128 + wc * 32 + 8 * fq, tau = col >> 4, pp = col & 15;
                    const f32x4 v0 = acc[ai][bj][m][0], v1 = acc[ai][bj][m][1];
                    *(u32x2*)(YS + (size_t)(tok0 + tau) * 512 + u.e * 16 + pp) = (u32x2){pk4_f8(gelu_tanh(v0[0]) * YS_SCALE, gelu_tanh(v0[1]) * YS_SCALE, gelu_tanh(v0[2]) * YS_SCALE, gelu_tanh(v0[3]) * YS_SCALE),
                                                                                                    pk4_f8(gelu_tanh(v1[0]) * YS_SCALE, gelu_tanh(v1[1]) * YS_SCALE, gelu_tanh(v1[2]) * YS_SCALE, gelu_tanh(v1[3]) * YS_SCALE)};
                }
            }
    } };
__device__ __forceinline__ void phase5(const Params& p, LAS unsigned char* lds) {
    BatchOrder S{(const char*)(p.ws + O_U), (const char*)(p.ws + O_TW2), (size_t)1024 * UROW * 2, (size_t)512 * UROW * 2, (size_t)256 * UROW * 2, (size_t)256 * UROW * 2, 4, 2, 256, (int)gridDim.x, (int)blockIdx.x};
    EpiY E{p.ws + O_YS};
    pg8::gemm_phase<EpiY, BatchOrder, false>(lds, UROW, UROW, UROW, S, E);
}
struct EpiGlu { static constexpr bool PERM = true; const float* bglu; const bf16_t* SG5; bf16_t* MS5;
    __device__ __forceinline__ void operator()(AccRef acc, const pg8::Unit& u, int wr, int wc, int fr, int fq) const {
        const int cv = u.pn * 128 + wc * 32 + 8 * fq;
        const f32x4 bv0 = *(const f32x4*)(bglu + cv), bv1 = *(const f32x4*)(bglu + cv + 4), bg0 = *(const f32x4*)(bglu + 1024 + cv), bg1 = *(const f32x4*)(bglu + 1024 + cv + 4);
#pragma unroll
        for (int ai = 0; ai < 2; ++ai) {
            u32x4 sgv[4];
#pragma unroll
            for (int m = 0; m < 4; ++m) sgv[m] = *(const u32x4*)(SG5 + (size_t)(u.pm * 256 + ai * 128 + wr * 64 + m * 16 + fr) * 1024 + cv);
#pragma unroll
            for (int m = 0; m < 4; ++m) {
                const int token = u.pm * 256 + ai * 128 + wr * 64 + m * 16 + fr;
                const u32x4 sg = sgv[m];
                constexpr float us_ = 1.f / (YS_SCALE * WGLU_SCALE);
                const f32x4 va0 = acc[ai][0][m][0] * us_ + bv0, va1 = acc[ai][0][m][1] * us_ + bv1, ga0 = acc[ai][1][m][0] * us_ + bg0, ga1 = acc[ai][1][m][1] * us_ + bg1;
                u32x4 o;
                o.x = pk2(va0[0] * sigmoidf_(ga0[0]) * bflo(sg.x), va0[1] * sigmoidf_(ga0[1]) * bfhi(sg.x)); o.y = pk2(va0[2] * sigmoidf_(ga0[2]) * bflo(sg.y), va0[3] * sigmoidf_(ga0[3]) * bfhi(sg.y));
                o.z = pk2(va1[0] * sigmoidf_(ga1[0]) * bflo(sg.z), va1[1] * sigmoidf_(ga1[1]) * bfhi(sg.z)); o.w = pk2(va1[2] * sigmoidf_(ga1[2]) * bflo(sg.w), va1[3] * sigmoidf_(ga1[3]) * bfhi(sg.w));
                *(u32x4*)(MS5 + (size_t)token * 1024 + cv) = o;
            }
        }
    } };
__device__ __forceinline__ void phase6(const Params& p, LAS unsigned char* lds) {
    pg8::DenseOrder S; S.init(p.ws + O_YS, p.ws + O_WT_GLU, NTOK, 2048, 256, 256, gridDim.x, blockIdx.x);
    EpiGlu E{p.in[15], (const bf16_t*)(p.ws + O_SG5), (bf16_t*)(p.ws + O_MS5)};
    pg8::gemm_phase<EpiGlu, pg8::DenseOrder, true, true>(lds, 256, 256, 256, S, E);
}
typedef float f32x16 __attribute__((ext_vector_type(16)));
__device__ __forceinline__ int rel_bucket_dev(int dist) {
    const int n = dist > 0 ? dist : 0;
    if (n < 16) return n;
    const int l = (int)(__log2f((float)n * 0.0625f) * 2.6666667f);
    const int v = 16 + l;
    return v < 31 ? v : 31;
}
__device__ __forceinline__ float xhalf_max(float v) { auto rr = __builtin_amdgcn_permlane32_swap(__float_as_uint(v), __float_as_uint(v), false, false); return fmaxf(__uint_as_float(rr[0]), __uint_as_float(rr[1])); }
__device__ __forceinline__ float xhalf_sum(float v) { auto rr = __builtin_amdgcn_permlane32_swap(__float_as_uint(v), __float_as_uint(v), false, false); return __uint_as_float(rr[0]) + __uint_as_float(rr[1]); }
__device__ __forceinline__ float quad_sum(float v) {
    v += __uint_as_float(__builtin_amdgcn_update_dpp(0u, __float_as_uint(v), 0xB1, 0xF, 0xF, true));
    v += __uint_as_float(__builtin_amdgcn_update_dpp(0u, __float_as_uint(v), 0x4E, 0xF, 0xF, true));
    return v;
}
constexpr int LSW = 1168;
constexpr int LWW = 656;
constexpr float RESC_THR = 6.f;
constexpr int IMPW = 132;
constexpr float NEG_BIG = -1e30f;

typedef int v4i_t __attribute__((ext_vector_type(4)));
typedef __amdgpu_buffer_rsrc_t rsrc_t;
__device__ __forceinline__ bf16x8 bload16(rsrc_t r, unsigned voff, unsigned soff) { return __builtin_bit_cast(bf16x8, __builtin_amdgcn_raw_buffer_load_b128(r, (int)voff, (int)soff, 0)); }
__device__ __forceinline__ void load_k(bf16x8 (&kf)[8], rsrc_t r, unsigned soff, unsigned voff) {
#pragma unroll
    for (int i = 0; i < 8; ++i) kf[i] = bload16(r, voff, soff + i * 1024);
}
__device__ __forceinline__ void load_v(bf16x8 (&vf)[8], rsrc_t r, unsigned soff, unsigned voff) {
#pragma unroll
    for (int i = 0; i < 8; ++i) vf[i] = bload16(r, voff, soff + i * 1024);
}
__device__ __forceinline__ void qk_block(f32x16 (&st)[2], const bf16x8 (&qf)[4], const bf16x8 (&kf)[8], float cinit) {
#pragma unroll
    for (int sub = 0; sub < 2; ++sub) {
        f32x16 acc;
#pragma unroll
        for (int r = 0; r < 16; ++r) acc[r] = cinit;
#pragma unroll
        for (int s = 0; s < 4; ++s) acc = __builtin_amdgcn_mfma_f32_32x32x16_bf16(kf[sub * 4 + s], qf[s], acc, 0, 0, 0);
        st[sub] = acc;
    }
}
__device__ __forceinline__ void bias_lut(f32x16 (&st)[2], const float* p) {
#pragma unroll
    for (int sub = 0; sub < 2; ++sub)
#pragma unroll
        for (int r = 0; r < 16; ++r) st[sub][r] += p[59 - (32 * sub + (r & 3) + 8 * (r >> 2))];
}
__device__ __forceinline__ void bias_mask_cmp(f32x16 (&st)[2], int dist0, const float* lutS) {
#pragma unroll
    for (int sub = 0; sub < 2; ++sub) {
        float bias[16];
#pragma unroll
        for (int r = 0; r < 16; ++r) {
            const int dist = dist0 - 16 * (32 * sub + (r & 3) + 8 * (r >> 2));
            const int idx = dist < 0 ? 0 : (dist > 1024 ? 1024 : dist);
            bias[r] = lutS[64 + idx];
        }
#pragma unroll
        for (int r = 0; r < 16; ++r) {
            const int dist = dist0 - 16 * (32 * sub + (r & 3) + 8 * (r >> 2));
            const float v = st[sub][r] + bias[r];
            st[sub][r] = dist >= 0 ? v : -INFINITY;
        }
    }
}
__device__ __forceinline__ float tile_max(const f32x16 (&st)[2]) {
    float a = __builtin_fmaxf(__builtin_fmaxf(st[0][0], st[0][1]), st[1][0]), b2 = __builtin_fmaxf(__builtin_fmaxf(st[0][2], st[0][3]), st[1][1]);
    a = __builtin_fmaxf(__builtin_fmaxf(a, st[1][2]), st[1][3]);
#pragma unroll
    for (int r = 4; r < 16; r += 4) {
        a = __builtin_fmaxf(__builtin_fmaxf(a, st[0][r]), st[0][r + 1]); b2 = __builtin_fmaxf(__builtin_fmaxf(b2, st[0][r + 2]), st[0][r + 3]);
        a = __builtin_fmaxf(__builtin_fmaxf(a, st[1][r]), st[1][r + 1]); b2 = __builtin_fmaxf(__builtin_fmaxf(b2, st[1][r + 2]), st[1][r + 3]);
    }
    return xhalf_max(__builtin_fmaxf(a, b2));
}
__device__ __forceinline__ void pv_block(f32x16 (&O)[2], const f32x16 (&st)[2], const bf16x8 (&vf)[8]) {
    bf16x8 pf[2][2];
#pragma unroll
    for (int sub = 0; sub < 2; ++sub)
#pragma unroll
        for (int s2 = 0; s2 < 2; ++s2) {
            u32x4 w;
            w.x = pk2(st[sub][8 * s2 + 0], st[sub][8 * s2 + 1]); w.y = pk2(st[sub][8 * s2 + 2], st[sub][8 * s2 + 3]);
            w.z = pk2(st[sub][8 * s2 + 4], st[sub][8 * s2 + 5]); w.w = pk2(st[sub][8 * s2 + 6], st[sub][8 * s2 + 7]);
            pf[sub][s2] = __builtin_bit_cast(bf16x8, w);
        }
#pragma unroll
    for (int dt = 0; dt < 2; ++dt)
#pragma unroll
        for (int sub = 0; sub < 2; ++sub)
#pragma unroll
            for (int s2 = 0; s2 < 2; ++s2) O[dt] = __builtin_amdgcn_mfma_f32_32x32x16_bf16(vf[dt * 4 + sub * 2 + s2], pf[sub][s2], O[dt], 0, 0, 0);
}
__device__ __forceinline__ void softmax_step(f32x16 (&st)[2], f32x16 (&O)[2], float& m, float& l) {
    const float mx = tile_max(st);
    if (__any(mx > RESC_THR)) {
        const float dl = mx > 0.f ? mx : 0.f;
        const float corr = __builtin_amdgcn_exp2f(-dl);
        m += dl; l *= corr;
#pragma unroll
        for (int sub = 0; sub < 2; ++sub)
#pragma unroll
            for (int r = 0; r < 16; ++r) st[sub][r] -= dl;
#pragma unroll
        for (int dt = 0; dt < 2; ++dt)
#pragma unroll
            for (int r = 0; r < 16; ++r) O[dt][r] *= corr;
    }
    float sum = 0.f;
#pragma unroll
    for (int sub = 0; sub < 2; ++sub)
#pragma unroll
        for (int r = 0; r < 16; ++r) { const float pe = __builtin_amdgcn_exp2f(st[sub][r]); st[sub][r] = pe; sum += pe; }
    l += sum;
}

constexpr int FLW = 68;
__device__ __forceinline__ void kv_step(f32x16 (&O)[2], float& m, float& l, const bf16x8 (&qf)[4], const bf16x8 (&kf)[8], bf16x8 (&kn)[8], rsrc_t rv, unsigned ksoff_next, unsigned koff,
                                        unsigned vsoff_blk, unsigned vvoff, const float* lutp, bool selme, float b31) {
    bf16x8 vf[8];
    load_v(vf, rv, vsoff_blk, vvoff);
    f32x16 st[2];
    qk_block(st, qf, kf, selme ? (lutp ? -m : b31 - m) : -INFINITY);
    __builtin_amdgcn_sched_barrier(0);
    load_k(kn, rv, ksoff_next, koff);
    if (lutp) bias_lut(st, lutp);
    softmax_step(st, O, m, l);
    pv_block(O, st, vf);
}

__device__ __forceinline__ void nsa_tile(const Params& p, int bg, int tg, const float* lutSall, const float* lutWall, float* impw, float* fl, int lane) {
    asm volatile("" : "+v"(lane));
    const int q = lane & 31, h2 = lane >> 5, tok = q >> 2, head = q & 3;
    const int b = bg >> 1, g = bg & 1, t0 = tg * 8, t = t0 + tok, token = b * SEQ + t;
    const float* lutS = lutSall + head * LSW;
    const float* lutW = lutWall + head * LWW;
    const float b31 = lutS[64 + 1024];
    bf16x8 qf[4];
    { const bf16_t* qp = (const bf16_t*)(p.ws + O_Q) + (size_t)token * 512 + (g * 4 + head) * 64 + 8 * h2;
#pragma unroll
      for (int s = 0; s < 4; ++s) qf[s] = *(const bf16x8*)(qp + 16 * s); }
    const float* gn = (const float*)(p.ws + O_GN) + (size_t)token * 24 + (g * 4 + head) * 3;
    float* flp = fl + q * FLW + 4 * h2;
    f32x16 O[2];
#pragma unroll
    for (int dt = 0; dt < 2; ++dt)
#pragma unroll
        for (int r = 0; r < 16; ++r) O[dt][r] = 0.f;
    const int cur = t0 >> 6;
    { const int u = head + 4 * h2;
#pragma unroll
      for (int i = 0; i < 16; ++i) impw[tok * IMPW + i * 8 + u] = 0.f; }
    WAVE_SYNC();
    bf16x8 kfA[8], kfB[8];
    const rsrc_t rKV = __builtin_amdgcn_make_buffer_rsrc((void*)(p.ws + O_KV), 0, (int)(6 * 8 * KV_SLAB * 2 + 8192), 0x00020000);
    const rsrc_t rKC = __builtin_amdgcn_make_buffer_rsrc((void*)(p.ws + O_KC), 0, (int)(2 * 4096 * 64 * 2), 0x00020000);
    const unsigned koff = (unsigned)lane * 16u, vsoff = koff;

    {
        const unsigned Kc = (unsigned)bg * 512u * 64u * 2u;
        const unsigned VcT = (4096u * 64u + (unsigned)bg * 64u * 512u) * 2u;
        const int tl = t0 + 7;
        const int ncmax = tl >= 31 ? ((tl - 31) >> 4) + 1 : 0;
        const int nblk = (ncmax + 63) >> 6;
        float m = NEG_BIG, l = 0.f;
        f32x16 st[2];
#define CMP_FAR(BLK) (16 * (64 * (BLK) + 63) + 31 + 1024 <= t0)
#define CMP_P1(KF, KN, BLK, BN) do { const bool far_ = CMP_FAR(BLK); qk_block(st, qf, KF, far_ ? b31 : 0.f); __builtin_amdgcn_sched_barrier(0); load_k(KN, rKC, Kc + (BN) * 8192, koff); \
            if (!far_) bias_mask_cmp(st, t - 31 - 16 * ((BLK) * 64 + 4 * h2), lutS); \
            const float mn = fmaxf(m, tile_max(st)); float sum = 0.f; \
            _Pragma("unroll") for (int sub = 0; sub < 2; ++sub) _Pragma("unroll") for (int r = 0; r < 16; ++r) sum += __builtin_amdgcn_exp2f(st[sub][r] - mn); \
            l = l * __builtin_amdgcn_exp2f(m - mn) + sum; m = mn; } while (0)
        if (nblk > 0) load_k(kfA, rKC, Kc, koff);
#pragma unroll 1
        for (int blk = 0; blk < nblk; blk += 2) {
            const int b1 = blk + 1 < nblk ? blk + 1 : blk;
            CMP_P1(kfA, kfB, blk, b1);
            if (blk + 1 >= nblk) break;
            const int b2 = blk + 2 < nblk ? blk + 2 : blk + 1;
            CMP_P1(kfB, kfA, blk + 1, b2);
        }
#undef CMP_P1
        l = xhalf_sum(l);
        const float invl = l > 0.f ? 1.f / l : 0.f;
#define CMP_P2(KF, KN, BLK, BN) do { const bool far_ = CMP_FAR(BLK); bf16x8 vf[8]; load_v(vf, rKC, VcT + (BLK) * 8192, koff); \
            qk_block(st, qf, KF, (far_ ? b31 : 0.f) - m); __builtin_amdgcn_sched_barrier(0); load_k(KN, rKC, Kc + (BN) * 8192, koff); \
            if (!far_) bias_mask_cmp(st, t - 31 - 16 * ((BLK) * 64 + 4 * h2), lutS); \
            _Pragma("unroll") for (int sub = 0; sub < 2; ++sub) _Pragma("unroll") for (int r = 0; r < 16; ++r) st[sub][r] = __builtin_amdgcn_exp2f(st[sub][r]) * invl; \
            _Pragma("unroll") for (int sub = 0; sub < 2; ++sub) _Pragma("unroll") for (int a = 0; a < 4; ++a) { \
                const float L_ = quad_sum(st[sub][4 * a + 3]); \
                const float G_ = quad_sum((st[sub][4 * a] + st[sub][4 * a + 1]) + (st[sub][4 * a + 2] + st[sub][4 * a + 3])); \
                const int j_ = (BLK) * 16 + 8 * sub + 2 * a + h2; \
                if (head == 0) { atomicAdd(&impw[tok * IMPW + j_], G_); if (j_ + 1 < 128) atomicAdd(&impw[tok * IMPW + j_ + 1], L_); } } \
            pv_block(O, st, vf); } while (0)
        if (nblk > 0) load_k(kfA, rKC, Kc, koff);
#pragma unroll 1
        for (int blk = 0; blk < nblk; blk += 2) {
            const int b1 = blk + 1 < nblk ? blk + 1 : blk;
            CMP_P2(kfA, kfB, blk, b1);
            if (blk + 1 >= nblk) break;
            const int b2 = blk + 2 < nblk ? blk + 2 : blk + 1;
            CMP_P2(kfB, kfA, blk + 1, b2);
        }
#undef CMP_P2
#undef CMP_FAR
        const float g0 = gn[0];
#pragma unroll
        for (int dt = 0; dt < 2; ++dt)
#pragma unroll
            for (int a = 0; a < 4; ++a) {
                *(f32x4*)(flp + dt * 32 + a * 8) = (f32x4){g0 * O[dt][4 * a], g0 * O[dt][4 * a + 1], g0 * O[dt][4 * a + 2], g0 * O[dt][4 * a + 3]};
                O[dt][4 * a] = 0.f; O[dt][4 * a + 1] = 0.f; O[dt][4 * a + 2] = 0.f; O[dt][4 * a + 3] = 0.f;
            }
    }
    WAVE_SYNC();

    unsigned long long mlo, mhi;
    if (cur < 16) { mlo = (1ull << (cur + 1)) - 1ull; mhi = 0ull; }
    else {
        const int u = head + 4 * h2;
        float val[16];
#pragma unroll
        for (int i = 0; i < 16; ++i) { const int j = i * 8 + u; val[i] = (j >= 1 && j <= cur - 2) ? impw[tok * IMPW + j] : -1.f; }
        mlo = 1ull; mhi = 0ull;
        if (cur < 64) mlo |= 1ull << cur; else mhi |= 1ull << (cur - 64);
        if (cur - 1 < 64) mlo |= 1ull << (cur - 1); else mhi |= 1ull << (cur - 1 - 64);
#pragma unroll 1
        for (int round = 0; round < 13; ++round) {
            float bs = val[0]; int bj = u;
#pragma unroll
            for (int i = 1; i < 16; ++i) { if (val[i] > bs) { bs = val[i]; bj = i * 8 + u; } }
            { const float os = __uint_as_float(__builtin_amdgcn_update_dpp(0u, __float_as_uint(bs), 0xB1, 0xF, 0xF, true)); const int oj = __builtin_amdgcn_update_dpp(0, bj, 0xB1, 0xF, 0xF, true);
              if (os > bs || (os == bs && oj < bj)) { bs = os; bj = oj; } }
            { const float os = __uint_as_float(__builtin_amdgcn_update_dpp(0u, __float_as_uint(bs), 0x4E, 0xF, 0xF, true)); const int oj = __builtin_amdgcn_update_dpp(0, bj, 0x4E, 0xF, 0xF, true);
              if (os > bs || (os == bs && oj < bj)) { bs = os; bj = oj; } }
            { const float os = __shfl_xor(bs, 32); const int oj = __shfl_xor(bj, 32);
              if (os > bs || (os == bs && oj < bj)) { bs = os; bj = oj; } }
            if (bj < 64) mlo |= 1ull << bj; else mhi |= 1ull << (bj - 64);
#pragma unroll
            for (int i = 0; i < 16; ++i) if (i * 8 + u == bj) val[i] = -2.f;
        }
    }
    unsigned long long ulo = mlo, uhi = mhi;
#pragma unroll
    for (int o = 4; o < 32; o <<= 1) { ulo |= __shfl_xor(ulo, o); uhi |= __shfl_xor(uhi, o); }
    ulo = ((unsigned long long)__builtin_amdgcn_readfirstlane((unsigned)(ulo >> 32)) << 32) | (unsigned)__builtin_amdgcn_readfirstlane((unsigned)ulo);
    uhi = ((unsigned long long)__builtin_amdgcn_readfirstlane((unsigned)(uhi >> 32)) << 32) | (unsigned)__builtin_amdgcn_readfirstlane((unsigned)uhi);

    {
        const unsigned Ks = (unsigned)((2 * 4 + b) * 2 + g) * (unsigned)(KV_SLAB * 2);
        const unsigned VsT = (unsigned)((3 * 4 + b) * 2 + g) * (unsigned)(KV_SLAB * 2);
        float m = 0.f, l = 0.f;
#define POPJ(J) do { if (ulo) { J = __builtin_ctzll(ulo); ulo &= ulo - 1ull; } else if (uhi) { J = 64 + __builtin_ctzll(uhi); uhi &= uhi - 1ull; } else J = -1; } while (0)
#define SEL_STEP(KF, KN, J, JN) do { const bool selme_ = (J) < 64 ? ((mlo >> (J)) & 1ull) : ((mhi >> ((J) - 64)) & 1ull); \
            const bool near_ = (64 * (J) + 63 + 1024 > t0); \
            kv_step(O, m, l, qf, KF, KN, rKV, Ks + (JN) * 8192, koff, VsT + (J) * 8192, vsoff, near_ ? lutS + (t - 64 * (J) - 4 * h2 + 64 - 59) : nullptr, selme_, b31); } while (0)
        int ja, jb;
        POPJ(ja);
        load_k(kfA, rKV, Ks + ja * 8192, koff);
#pragma unroll 1
        for (;;) {
            POPJ(jb);
            { const int jn = jb >= 0 ? jb : ja; SEL_STEP(kfA, kfB, ja, jn); }
            if (jb < 0) break;
            POPJ(ja);
            { const int jn = ja >= 0 ? ja : jb; SEL_STEP(kfB, kfA, jb, jn); }
            if (ja < 0) break;
        }
#undef SEL_STEP
#undef POPJ
        l = xhalf_sum(l);
        const float sc = l > 0.f ? gn[1] / l : 0.f;
#pragma unroll
        for (int dt = 0; dt < 2; ++dt)
#pragma unroll
            for (int a = 0; a < 4; ++a) {
                f32x4 f = *(const f32x4*)(flp + dt * 32 + a * 8);
                f[0] += sc * O[dt][4 * a]; f[1] += sc * O[dt][4 * a + 1]; f[2] += sc * O[dt][4 * a + 2]; f[3] += sc * O[dt][4 * a + 3];
                *(f32x4*)(flp + dt * 32 + a * 8) = f;
                O[dt][4 * a] = 0.f; O[dt][4 * a + 1] = 0.f; O[dt][4 * a + 2] = 0.f; O[dt][4 * a + 3] = 0.f;
            }
    }
    {
        const unsigned Kw = (unsigned)((4 * 4 + b) * 2 + g) * (unsigned)(KV_SLAB * 2);
        const unsigned VwT = (unsigned)((5 * 4 + b) * 2 + g) * (unsigned)(KV_SLAB * 2);
        float m = 0.f, l = 0.f;
        const int wlo = t0 - 511;
        const int r_begin = (wlo > 0 ? wlo : 0) & ~63;
        const int r_last = t0 + 7;
#define WIN_STEP(KF, KN, R0, RN) kv_step(O, m, l, qf, KF, KN, rKV, Kw + (RN) * 128, koff, VwT + (R0) * 128, vsoff, lutW + (t - (R0) - 4 * h2 + 72 - 59), true, b31)
        load_k(kfA, rKV, Kw + r_begin * 128, koff);
#pragma unroll 1
        for (int row0 = r_begin; row0 <= r_last; row0 += 128) {
            { const int rn = row0 + 64 <= r_last ? row0 + 64 : row0; WIN_STEP(kfA, kfB, row0, rn); }
            if (row0 + 64 > r_last) break;
            { const int rn = row0 + 128 <= r_last ? row0 + 128 : row0 + 64; WIN_STEP(kfB, kfA, row0 + 64, rn); }
        }
#undef WIN_STEP
        l = xhalf_sum(l);
        const float sc = l > 0.f ? gn[2] / l : 0.f;
        unsigned char* op = p.ws + O_ONSA + (size_t)token * 512 + (g * 4 + head) * 64 + 4 * h2;
#pragma unroll
        for (int dt = 0; dt < 2; ++dt)
#pragma unroll
            for (int a = 0; a < 4; ++a) {
                const f32x4 f = *(const f32x4*)(flp + dt * 32 + a * 8);
                *(unsigned*)(op + dt * 32 + a * 8) = pk4_f8((f[0] + sc * O[dt][4 * a]) * ONSA_SCALE, (f[1] + sc * O[dt][4 * a + 1]) * ONSA_SCALE, (f[2] + sc * O[dt][4 * a + 2]) * ONSA_SCALE, (f[3] + sc * O[dt][4 * a + 3]) * ONSA_SCALE);
            }
    }
    WAVE_SYNC();
}

__device__ __forceinline__ void phase7(const Params& p, unsigned char* smem) {
    const int tid = threadIdx.x, lane = tid & 63, wid = __builtin_amdgcn_readfirstlane(tid >> 6);
    float* lutS = (float*)smem;
    float* lutW = lutS + 4 * LSW;
    float* impw = lutW + 4 * LWW + wid * 8 * IMPW;
    float* fl = lutW + 4 * LWW + NWV * 8 * IMPW + wid * 32 * FLW;
    const int bg = blockIdx.x & 7, g = bg & 1;
    for (int i = tid; i < 4 * LSW; i += NT) { const int head = i / LSW, dist = i % LSW - 64;
        lutS[i] = dist < 0 ? -INFINITY : p.in[2][rel_bucket_dev(dist) * 8 + g * 4 + head] * LOG2E; }
    for (int i = tid; i < 4 * LWW; i += NT) { const int head = i / LWW, dist = i % LWW - 72;
        lutW[i] = (dist < 0 || dist >= 512) ? -INFINITY : p.in[2][rel_bucket_dev(dist) * 8 + g * 4 + head] * LOG2E; }
    __syncthreads();
    const int nblk_bg = (gridDim.x - bg + 7) >> 3;
    const int W = nblk_bg * NWV, w = (blockIdx.x >> 3) * NWV + wid;
#pragma unroll 1
    for (int round = 0; ; ++round) {
        const int idx = round * W + ((round & 1) ? (W - 1 - w) : w);
        if (idx >= 1024) break;
        nsa_tile(p, bg, 1023 - idx, lutS, lutW, impw, fl, lane);
    }
    __syncthreads();
}

struct EpiNsa { static constexpr bool PERM = true; const bf16_t* SGN; const bf16_t* MS5; unsigned char* MRG;
    __device__ __forceinline__ void operator()(AccRef acc, const pg8::Unit& u, int wr, int wc, int fr, int fq) const {
        constexpr float us_ = 1.f / (ONSA_SCALE * WNSA_SCALE);
#pragma unroll
        for (int ai = 0; ai < 2; ++ai)
#pragma unroll
            for (int mh = 0; mh < 4; mh += 2) {
                u32x4 sgv[2][2], msv[2][2];
#pragma unroll
                for (int m = 0; m < 2; ++m)
#pragma unroll
                    for (int bj = 0; bj < 2; ++bj) {
                        const size_t off = (size_t)(u.pm * 256 + ai * 128 + wr * 64 + (mh + m) * 16 + fr) * 1024 + u.pn * 256 + bj * 128 + wc * 32 + 8 * fq;
                        sgv[m][bj] = *(const u32x4*)(SGN + off); msv[m][bj] = *(const u32x4*)(MS5 + off);
                    }
#pragma unroll
                for (int m = 0; m < 2; ++m)
#pragma unroll
                    for (int bj = 0; bj < 2; ++bj) {
                        const size_t off = (size_t)(u.pm * 256 + ai * 128 + wr * 64 + (mh + m) * 16 + fr) * 1024 + u.pn * 256 + bj * 128 + wc * 32 + 8 * fq;
                        const u32x4 sg = sgv[m][bj], ms = msv[m][bj];
                        const f32x4 v0 = acc[ai][bj][mh + m][0] * us_, v1 = acc[ai][bj][mh + m][1] * us_;
                        *(u32x2*)(MRG + off) = (u32x2){pk4_f8((bflo(ms.x) + bflo(sg.x) * v0[0]) * MRG_SCALE, (bfhi(ms.x) + bfhi(sg.x) * v0[1]) * MRG_SCALE, (bflo(ms.y) + bflo(sg.y) * v0[2]) * MRG_SCALE, (bfhi(ms.y) + bfhi(sg.y) * v0[3]) * MRG_SCALE),
                                                       pk4_f8((bflo(ms.z) + bflo(sg.z) * v1[0]) * MRG_SCALE, (bfhi(ms.z) + bfhi(sg.z) * v1[1]) * MRG_SCALE, (bflo(ms.w) + bflo(sg.w) * v1[2]) * MRG_SCALE, (bfhi(ms.w) + bfhi(sg.w) * v1[3]) * MRG_SCALE)};
                    }
            }
    } };
__device__ __forceinline__ void phase8(const Params& p, LAS unsigned char* lds) {
    pg8::DenseOrder S; S.init(p.ws + O_ONSA, p.ws + O_WT_NSA, NTOK, 1024, 256, 256, gridDim.x, blockIdx.x);
    EpiNsa E{(const bf16_t*)(p.ws + O_SGN), (const bf16_t*)(p.ws + O_MS5), p.ws + O_YS};
    pg8::gemm_phase<EpiNsa, pg8::DenseOrder, true, true>(lds, 256, 256, 256, S, E);
}
struct EpiOut { static constexpr bool PERM = true; const float* ada; bf16_t* Y;
    __device__ __forceinline__ void operator()(AccRef acc, const pg8::Unit& u, int wr, int wc, int fr, int fq) const {
        const float* ga = ada + (u.pm >> 5) * 6144 + 2048;
        f32x4 gv[2][2];
#pragma unroll
        for (int bj = 0; bj < 2; ++bj) { const int col = u.pn * 256 + bj * 128 + wc * 32 + 8 * fq; gv[bj][0] = *(const f32x4*)(ga + col); gv[bj][1] = *(const f32x4*)(ga + col + 4); }
#pragma unroll
        for (int ai = 0; ai < 2; ++ai)
#pragma unroll
            for (int m = 0; m < 4; ++m) {
                const int token = u.pm * 256 + ai * 128 + wr * 64 + m * 16 + fr;
#pragma unroll
                for (int bj = 0; bj < 2; ++bj) {
                    const int col = u.pn * 256 + bj * 128 + wc * 32 + 8 * fq;
                    const f32x4 v0 = acc[ai][bj][m][0] * gv[bj][0] * (1.f / (MRG_SCALE * WOUT_SCALE)), v1 = acc[ai][bj][m][1] * gv[bj][1] * (1.f / (MRG_SCALE * WOUT_SCALE));
                    *(u32x4*)(Y + (size_t)token * 1024 + col) = (u32x4){pk2(v0[0], v0[1]), pk2(v0[2], v0[3]), pk2(v1[0], v1[1]), pk2(v1[2], v1[3])};
                }
            }
    } };
__device__ __forceinline__ void phase9(const Params& p, LAS unsigned char* lds) {
    pg8::DenseOrder S; S.init(p.ws + O_YS, p.ws + O_WT_OUT, NTOK, 1024, 512, 512, gridDim.x, blockIdx.x);
    EpiOut E{(const float*)(p.ws + O_ADA), (bf16_t*)(p.ws + O_SG5)};
    pg8::gemm_phase<EpiOut, pg8::DenseOrder, true, true>(lds, 512, 512, 512, S, E);
}

__device__ __forceinline__ void phase10(const Params& p, unsigned char* smem) {
    typedef float f32x16_t __attribute__((ext_vector_type(16)));
    constexpr int HSW = 1025;
    const int tid = threadIdx.x, lane = tid & 63, wid = __builtin_amdgcn_readfirstlane(tid >> 6);
    float* hsb = (float*)smem;
    int* lcnt = (int*)(smem + 32 * HSW * 4);
    int* lbase = lcnt + 32;
    int* lsel = lcnt + 64;
    float* lgate = (float*)(lsel + 4 * 256);
    const float* lg = p.in[24]; const float* lb = p.in[25]; const float* wr_ = p.in[26]; const float* br_ = p.in[27];
    unsigned* cnt = (unsigned*)(p.ws + O_CNT);
    if (tid < 32) lcnt[tid] = 0;
    __syncthreads();
    int nstep = 0;
#pragma unroll 1
    for (int grp = blockIdx.x; grp < NTOK / 32; grp += gridDim.x, ++nstep) {
#pragma unroll 1
        for (int i = 0; i < 4; ++i) {
            const int lt = wid * 4 + i, token = grp * 32 + lt, b = token >> 13;
            float* zr = (float*)(p.ws + O_Z1) + (size_t)token * 1024;
            const float* xr = p.in[0] + (size_t)token * 1024;
            const bf16_t* yr = (const bf16_t*)(p.ws + O_SG5) + (size_t)token * 1024;
            const float* ada = (const float*)(p.ws + O_ADA) + b * 6144;
            f32x4 v[4]; float sm = 0.f;
#pragma unroll
            for (int j = 0; j < 4; ++j) { const u32x2 yv = *(const u32x2*)(yr + j * 256 + lane * 4); const f32x4 xv = *(const f32x4*)(xr + j * 256 + lane * 4);
                v[j] = xv * DN_ALPHA + (f32x4){bflo(yv.x), bfhi(yv.x), bflo(yv.y), bfhi(yv.y)}; sm += (v[j][0] + v[j][1]) + (v[j][2] + v[j][3]); }
            const float mean = wave_sum(sm) * (1.f / 1024.f); float q = 0.f;
#pragma unroll
            for (int j = 0; j < 4; ++j) { v[j] = v[j] - mean; q += (v[j][0] * v[j][0] + v[j][1] * v[j][1]) + (v[j][2] * v[j][2] + v[j][3] * v[j][3]); }
            const float rstd = rsqrtf(wave_sum(q) * (1.f / 1024.f) + LN_EPS);
            unsigned char* h2 = p.ws + O_H2 + (size_t)token * 1024;
#pragma unroll
            for (int j = 0; j < 4; ++j) {
                const int c = j * 256 + lane * 4;
                const f32x4 x1 = v[j] * rstd * *(const f32x4*)(lg + c) + *(const f32x4*)(lb + c);
                *(f32x4*)(zr + c) = x1;
                const f32x4 hv = x1 * (*(const f32x4*)(ada + 4096 + c) + 1.f) + *(const f32x4*)(ada + 3072 + c);
                float* hd = hsb + lt * HSW + c; hd[0] = hv[0]; hd[1] = hv[1]; hd[2] = hv[2]; hd[3] = hv[3];
                *(unsigned*)(h2 + c) = pk4_f8(hv[0], hv[1], hv[2], hv[3]);
            }
        }
        __syncthreads();
        f32x16_t acc;
#pragma unroll
        for (int r = 0; r < 16; ++r) acc[r] = 0.f;
        { const float* ap = hsb + (lane & 31) * HSW + wid * 128 + (lane >> 5);
          const float* bp = wr_ + (size_t)(wid * 128 + (lane >> 5)) * 32 + (lane & 31);
#pragma unroll 8
          for (int j = 0; j < 64; ++j) acc = __builtin_amdgcn_mfma_f32_32x32x2f32(ap[2 * j], bp[(size_t)2 * j * 32], acc, 0, 0, 0); }
        __syncthreads();
        { float* pt = hsb + wid * 1024 + (lane & 31);
#pragma unroll
          for (int r = 0; r < 16; ++r) pt[((r & 3) + 8 * (r >> 2) + 4 * (lane >> 5)) * 32] = acc[r]; }
        __syncthreads();
        { float* lgt = hsb + 8192;
#pragma unroll
          for (int i = 0; i < 2; ++i) { const int o = tid * 2 + i; float sum = 0.f;
#pragma unroll
              for (int w = 0; w < 8; ++w) sum += hsb[w * 1024 + o];
              lgt[o] = sum + br_[o & 31]; } }
        __syncthreads();
#pragma unroll 1
        for (int rr = 0; rr < 2; ++rr) {
            const int e = lane & 31, lt = wid * 4 + rr * 2 + (lane >> 5);
            float val = hsb[8192 + lt * 32 + e]; int te[4]; float tv[4];
#pragma unroll
            for (int r = 0; r < 4; ++r) {
                float bs = val; int bj = e;
#pragma unroll
                for (int o = 1; o < 32; o <<= 1) { const float os = __shfl_xor(bs, o); const int oj = __shfl_xor(bj, o); if (os > bs || (os == bs && oj < bj)) { bs = os; bj = oj; } }
                te[r] = bj; tv[r] = bs;
                if (e == bj) val = -INFINITY;
            }
            const float e0 = 1.f, e1 = __expf(tv[1] - tv[0]), e2 = __expf(tv[2] - tv[0]), e3 = __expf(tv[3] - tv[0]);
            const float inv = 1.f / (e0 + e1 + e2 + e3);
            if (e < 4) {
                const int ee = e == 0 ? te[0] : (e == 1 ? te[1] : (e == 2 ? te[2] : te[3]));
                const float gg = (e == 0 ? e0 : (e == 1 ? e1 : (e == 2 ? e2 : e3))) * inv;
                const int rk = atomicAdd(&lcnt[ee], 1);
                lsel[(nstep * 32 + lt) * 4 + e] = ee | (rk << 8);
                lgate[(nstep * 32 + lt) * 4 + e] = gg;
            }
        }
        __syncthreads();
    }
    if (tid < 32) lbase[tid] = (int)atomicAdd(cnt + tid * 32, (unsigned)lcnt[tid]);
    __syncthreads();
    {
        for (int i = tid; i < nstep * 32 * 4; i += NT) {
            const int li = i >> 2, kk = i & 3, st = li >> 5, lt = li & 31;
            const int token = (blockIdx.x + st * gridDim.x) * 32 + lt;
            const int sv = lsel[i], ee = sv & 255, pos = lbase[ee] + (sv >> 8);
            ((int*)(p.ws + O_TOPE))[token * 4 + kk] = ee;
            ((unsigned*)(p.ws + O_TOPP))[token * 4 + kk] = (unsigned)pos;
            ((int*)(p.ws + O_ROWTOK))[(size_t)ee * NTOK + pos] = token * 4 + kk;
            ((float*)(p.ws + O_ROWGATE))[(size_t)ee * NTOK + pos] = lgate[i];
        }
    }
    __syncthreads();
}

__device__ __forceinline__ void load_offsets(const Params& p, int* offs  , int* toff  ) {
    if (threadIdx.x < 64) {
        const int lane = threadIdx.x;
        const int c = lane < 32 ? (int)((const unsigned*)(p.ws + O_CNT))[lane * 32] : 0;
        int a = c, t = (c + 255) >> 8;
#pragma unroll
        for (int o = 1; o < 32; o <<= 1) { const int ua = __shfl_up(a, o), ut = __shfl_up(t, o); if ((lane & 31) >= o) { a += ua; t += ut; } }
        if (lane < 32) { offs[lane] = a - c; toff[lane] = t - ((c + 255) >> 8); if (lane == 31) { offs[32] = a; toff[32] = t; } }
    }
    __syncthreads();
}
struct MoeOrder {
    const int* offs; const int* toff; const char* A; const char* B; const int* rowtok; size_t bsB; int nN, G, c;
    __device__ __forceinline__ bool next(int i, pg8::Unit& u) const {
        const int v = (G % 8 == 0) ? (c % 8) * (G / 8) + c / 8 : c;
        const long L = (long)i * G + v; if (L >= (long)toff[32] * nN) return false;
        const int tile = (int)L / nN, pn = (int)L % nN;
        int e = 0;
#pragma unroll 1
        while (toff[e + 1] <= tile) ++e;
        e = __builtin_amdgcn_readfirstlane(e);
        const int r0 = __builtin_amdgcn_readfirstlane(offs[e] + (tile - toff[e]) * 256);
        u.pm = r0; u.pn = pn; u.e = e; u.nvalid = __builtin_amdgcn_readfirstlane(offs[e + 1]) - r0;
        u.gidx = e * NTOK + (tile - toff[e]) * 256;
        if (rowtok) { u.A = A; u.rows = rowtok + u.gidx; const int rm = u.nvalid - 1; u.rmax = rm < 255 ? rm : 255; }
        else { u.A = A + (size_t)r0 * 1024; u.rows = nullptr; u.rmax = 255; }
        u.B = B + (size_t)e * bsB + (size_t)pn * 256 * 1024; return true;
    }
};
struct EpiGU { static constexpr bool PERM = true; const float* bgu; unsigned char* ACT;
    __device__ __forceinline__ void operator()(AccRef acc, const pg8::Unit& u, int wr, int wc, int fr, int fq) const {
        const int cv = u.pn * 128 + wc * 32 + 8 * fq;
        const float* bb = bgu + (size_t)u.e * 2048;
        const float ws_ = 1.f / WGU_SCALE;
        const f32x4 bg0 = *(const f32x4*)(bb + cv), bg1 = *(const f32x4*)(bb + cv + 4), bu0 = *(const f32x4*)(bb + 1024 + cv), bu1 = *(const f32x4*)(bb + 1024 + cv + 4);
#pragma unroll
        for (int ai = 0; ai < 2; ++ai)
#pragma unroll
            for (int m = 0; m < 4; ++m) {
                const int lr = ai * 128 + wr * 64 + m * 16 + fr;
                const int row = lr < u.nvalid ? u.pm + lr : NROWS + lr;
                const f32x4 ga0 = acc[ai][0][m][0] * ws_ + bg0, ga1 = acc[ai][0][m][1] * ws_ + bg1, ua0 = acc[ai][1][m][0] * ws_ + bu0, ua1 = acc[ai][1][m][1] * ws_ + bu1;
                float o[8];
#pragma unroll
                for (int j = 0; j < 4; ++j) {
                    const float gt0 = __builtin_fminf(ga0[j], 7.f), up0 = __builtin_fminf(__builtin_fmaxf(ua0[j], -7.f), 7.f); o[j] = (up0 + 1.f) * gt0 * sigmoidf_(1.702f * gt0);
                    const float gt1 = __builtin_fminf(ga1[j], 7.f), up1 = __builtin_fminf(__builtin_fmaxf(ua1[j], -7.f), 7.f); o[4 + j] = (up1 + 1.f) * gt1 * sigmoidf_(1.702f * gt1);
                }
                *(u32x2*)(ACT + (size_t)row * 1024 + cv) = (u32x2){pk4_f8(o[0], o[1], o[2], o[3]), pk4_f8(o[4], o[5], o[6], o[7])};
            }
    } };
__device__ __forceinline__ void phase12(const Params& p, unsigned char* smem, LAS unsigned char* lds) {
    int* offs = (int*)(smem + LDS_TAB); int* toff = offs + 40;
    load_offsets(p, offs, toff);
    MoeOrder S{offs, toff, (const char*)(p.ws + O_H2), (const char*)(p.ws + O_WT_GU), (const int*)(p.ws + O_ROWTOK), (size_t)2048 * 1024, 8, (int)gridDim.x, (int)blockIdx.x};
    EpiGU E{p.in[29], p.ws + O_ACT};
    pg8::gemm_phase<EpiGU, MoeOrder, true, true>(lds, 512, 512, 512, S, E);
    __syncthreads();
}
struct EpiDn { static constexpr bool PERM = true; const float* bd; const float* rowgate; const int* rowtok; bf16_t* YK;
    __device__ __forceinline__ void operator()(AccRef acc, const pg8::Unit& u, int wr, int wc, int fr, int fq) const {
        const float* bb = bd + (size_t)u.e * 1024;
        f32x4 bv[2][2]; float gw[2][4]; int dst[2][4];
#pragma unroll
        for (int bj = 0; bj < 2; ++bj) { const int col = u.pn * 256 + bj * 128 + wc * 32 + 8 * fq; bv[bj][0] = *(const f32x4*)(bb + col); bv[bj][1] = *(const f32x4*)(bb + col + 4); }
#pragma unroll
        for (int ai = 0; ai < 2; ++ai)
#pragma unroll
            for (int m = 0; m < 4; ++m) { const int lr = ai * 128 + wr * 64 + m * 16 + fr, lc = lr < u.nvalid ? lr : u.nvalid - 1;
                gw[ai][m] = rowgate[u.gidx + lc]; dst[ai][m] = rowtok[u.gidx + lc]; }
#pragma unroll
        for (int ai = 0; ai < 2; ++ai)
#pragma unroll
            for (int m = 0; m < 4; ++m) {
                const int lr = ai * 128 + wr * 64 + m * 16 + fr;
                const int row = lr < u.nvalid ? dst[ai][m] : NROWS + lr;
#pragma unroll
                for (int bj = 0; bj < 2; ++bj) {
                    const int col = u.pn * 256 + bj * 128 + wc * 32 + 8 * fq;
                    const f32x4 v0 = (acc[ai][bj][m][0] * (1.f / WDN_SCALE) + bv[bj][0]) * gw[ai][m], v1 = (acc[ai][bj][m][1] * (1.f / WDN_SCALE) + bv[bj][1]) * gw[ai][m];
                    *(u32x4*)(YK + (size_t)row * 1024 + col) = (u32x4){pk2(v0[0], v0[1]), pk2(v0[2], v0[3]), pk2(v1[0], v1[1]), pk2(v1[2], v1[3])};
                }
            }
    } };
__device__ __forceinline__ void phase13(const Params& p, unsigned char* smem, LAS unsigned char* lds) {
    int* offs = (int*)(smem + LDS_TAB); int* toff = offs + 40;
    load_offsets(p, offs, toff);
    MoeOrder S{offs, toff, (const char*)(p.ws + O_ACT), (const char*)(p.ws + O_WT_DN), nullptr, (size_t)1024 * 1024, 4, (int)gridDim.x, (int)blockIdx.x};
    EpiDn E{p.in[31], (const float*)(p.ws + O_ROWGATE), (const int*)(p.ws + O_ROWTOK), (bf16_t*)(p.ws + O_YK)};
    pg8::gemm_phase<EpiDn, MoeOrder, true, true>(lds, 512, 512, 512, S, E);
    __syncthreads();
}

struct P14Raw { u32x2 a[4][4]; f32x4 x[4]; };
__device__ __forceinline__ void p14_load(P14Raw& r, const bf16_t* YK, const float* X1, int token, int lane) {
#pragma unroll
    for (int j = 0; j < 4; ++j) {
        const int c = j * 256 + lane * 4;
#pragma unroll
        for (int k = 0; k < 4; ++k) r.a[j][k] = *(const u32x2*)(YK + (size_t)(token * 4 + k) * 1024 + c);
        r.x[j] = *(const f32x4*)(X1 + (size_t)token * 1024 + c);
    }
}
__device__ __forceinline__ void p14_finish(const P14Raw& r, const float* gf, const float* lg, const float* lb, float* out, int token, int lane) {
    f32x4 v[4]; float s = 0.f;
#pragma unroll
    for (int j = 0; j < 4; ++j) {
        const int c = j * 256 + lane * 4;
        const u32x2 a0 = r.a[j][0], a1 = r.a[j][1], a2 = r.a[j][2], a3 = r.a[j][3];
        f32x4 y;
        y[0] = (bflo(a0.x) + bflo(a1.x)) + (bflo(a2.x) + bflo(a3.x)); y[1] = (bfhi(a0.x) + bfhi(a1.x)) + (bfhi(a2.x) + bfhi(a3.x));
        y[2] = (bflo(a0.y) + bflo(a1.y)) + (bflo(a2.y) + bflo(a3.y)); y[3] = (bfhi(a0.y) + bfhi(a1.y)) + (bfhi(a2.y) + bfhi(a3.y));
        v[j] = r.x[j] * DN_ALPHA + *(const f32x4*)(gf + c) * y;
        s += (v[j][0] + v[j][1]) + (v[j][2] + v[j][3]);
    }
    const float mean = wave_sum(s) * (1.f / 1024.f); float q = 0.f;
#pragma unroll
    for (int j = 0; j < 4; ++j) { v[j] = v[j] - mean; q += (v[j][0] * v[j][0] + v[j][1] * v[j][1]) + (v[j][2] * v[j][2] + v[j][3] * v[j][3]); }
    const float rstd = rsqrtf(wave_sum(q) * (1.f / 1024.f) + LN_EPS);
#pragma unroll
    for (int j = 0; j < 4; ++j) { const int c = j * 256 + lane * 4; *(f32x4*)(out + (size_t)token * 1024 + c) = v[j] * rstd * *(const f32x4*)(lg + c) + *(const f32x4*)(lb + c); }
}
__device__ __forceinline__ void phase14(const Params& p, unsigned char*) {
    const int tid = threadIdx.x, lane = tid & 63, wid = tid >> 6;
    const float* lg = p.in[32]; const float* lb = p.in[33];
    const bf16_t* YK = (const bf16_t*)(p.ws + O_YK);
    const float* X1 = (const float*)(p.ws + O_Z1);
    const float* ada = (const float*)(p.ws + O_ADA) + 5120;
    const int G = gridDim.x, nit = NTOK / NWV;
    int item = blockIdx.x;
    if (item >= nit) return;
    P14Raw ra, rb;
    p14_load(ra, YK, X1, item * NWV + wid, lane);
#pragma unroll 1
    for (;;) {
        const int ta = item * NWV + wid, ib = item + G;
        if (ib < nit) p14_load(rb, YK, X1, ib * NWV + wid, lane);
        p14_finish(ra, ada + (ta >> 13) * 6144, lg, lb, p.out, ta, lane);
        if (ib >= nit) break;
        const int tb = ib * NWV + wid; item = ib + G;
        if (item < nit) p14_load(ra, YK, X1, item * NWV + wid, lane);
        p14_finish(rb, ada + (tb >> 13) * 6144, lg, lb, p.out, tb, lane);
        if (item >= nit) break;
    }
}


#if defined(__HIP_DEVICE_COMPILE__)
typedef const __attribute__((address_space(4))) Params* KernargPtr;
__device__ __forceinline__ KernargPtr opaque_kernarg() { KernargPtr kp = (KernargPtr)__builtin_amdgcn_kernarg_segment_ptr(); asm volatile("" : "+s"(kp)); return kp; }
#define GAS __attribute__((address_space(1)))
__device__ __forceinline__ Params load_params() {
    Params r; const __attribute__((address_space(4))) unsigned long long* s = (const __attribute__((address_space(4))) unsigned long long*)opaque_kernarg();
#pragma unroll
    for (int i = 0; i < 34; ++i) r.in[i] = (const float*)(const GAS float*)s[i];
    r.out = (float*)(GAS float*)s[34]; r.ws = (unsigned char*)(GAS unsigned char*)s[35];
    const unsigned long long pp = s[36]; r.ph_lo = (int)(unsigned)pp; r.ph_hi = (int)(unsigned)(pp >> 32);
    return r; }
#else
#define opaque_kernarg() (&p_unused)
#endif
#if defined(__HIP_DEVICE_COMPILE__)
#define PARAMS_NOW() load_params()
#else
#define PARAMS_NOW() p_unused
#endif
template <bool COOP>
__global__ void __launch_bounds__(NT, 2) fwd_kernel(Params p_unused) {
    extern __shared__ __attribute__((aligned(16))) unsigned char smem[];
    LAS unsigned char* lds = (LAS unsigned char*)smem;
    const int lo = opaque_kernarg()->ph_lo, hi = opaque_kernarg()->ph_hi;
    volatile LAS unsigned* bst = (volatile LAS unsigned*)(lds + LDS_BYTES - 16);
    if (threadIdx.x == 0) { bst[0] = 0u; bst[1] = 0u; }
    __syncthreads();
    XcdBarrier gbar; gbar.bar = nullptr; gbar.x = 0; gbar.st = bst;
    if (COOP) { const Params p0 = PARAMS_NOW(); gbar = xcd_barrier_post((unsigned*)(p0.ws + O_BAR), bst); }
#define SEAM(k) do { if (lo < 0) cg::this_grid().sync(); else xcd_barrier(gbar); } while (0)
#define RUN_PHASE(k, call) if (((PH_MASK >> (k)) & 1) && lo <= (k) && (k) < hi) { _Pragma("unroll 1") for (int rep_ = 0; rep_ < 1 + ((REPEAT_MASK >> (k)) & 1); ++rep_) { if (rep_) { if (COOP) SEAM(1); } const Params p = PARAMS_NOW(); call; } } if (COOP) { if ((k) != 0 && (k) != 6 && lo <= (k) && (k) + 1 < hi) SEAM(k); }
    RUN_PHASE(0, phase0(p, smem))
    RUN_PHASE(1, phase1(p, smem))
    RUN_PHASE(2, phase2(p, lds))
    RUN_PHASE(3, phase3(p, lds))
    RUN_PHASE(4, phase4(p, smem))
    RUN_PHASE(5, phase5(p, lds))
    RUN_PHASE(6, phase6(p, lds))
    RUN_PHASE(7, phase7(p, smem))
    RUN_PHASE(8, phase8(p, lds))
    RUN_PHASE(9, phase9(p, lds))
    RUN_PHASE(10, phase10(p, smem))
    RUN_PHASE(12, phase12(p, smem, lds))
    RUN_PHASE(13, phase13(p, smem, lds))
    RUN_PHASE(14, phase14(p, smem))
#undef RUN_PHASE
#undef SEAM
}

extern "C" void kernel_launch(void* const* d_in, const int* in_sizes, int n_in, void* d_out, int out_size, void* d_ws, size_t ws_size, hipStream_t stream) {
    static int grid = 0;
    if (grid == 0) {
        if (n_in != 34 || out_size != NTOK * DM || ws_size < WS_NEED) { fprintf(stderr, "kernel_launch: unexpected problem (n_in %d, out %d, ws %zu need %zu)\n", n_in, out_size, ws_size, (size_t)WS_NEED); grid = -1; return; }
        int dev = 0, cus = 0, per_cu = 0;
        (void)hipGetDevice(&dev);
        (void)hipDeviceGetAttribute(&cus, hipDeviceAttributeMultiprocessorCount, dev);
#if ONE_LAUNCH
        (void)hipFuncSetAttribute((const void*)fwd_kernel<true>, hipFuncAttributeMaxDynamicSharedMemorySize, LDS_BYTES);
        (void)hipOccupancyMaxActiveBlocksPerMultiprocessor(&per_cu, fwd_kernel<true>, NT, LDS_BYTES);
#else
        (void)hipFuncSetAttribute((const void*)fwd_kernel<false>, hipFuncAttributeMaxDynamicSharedMemorySize, LDS_BYTES);
        (void)hipOccupancyMaxActiveBlocksPerMultiprocessor(&per_cu, fwd_kernel<false>, NT, LDS_BYTES);
#endif
        if (per_cu < 1) { fprintf(stderr, "kernel_launch: occupancy query reports %d blocks per CU\n", per_cu); per_cu = 1; }
        grid = cus * per_cu;
        fprintf(stderr, "kernel_launch: grid %d (%d CUs x %d)\n", grid, cus, per_cu);
    }
    if (grid < 0) return;
    Params p{};
    for (int i = 0; i < 34; ++i) p.in[i] = (const float*)d_in[i];
    p.out = (float*)d_out; p.ws = (unsigned char*)d_ws;
#if ONE_LAUNCH
    if (hipMemsetAsync((char*)d_ws + O_BAR, 0, BAR_BYTES, stream) != hipSuccess) { fprintf(stderr, "kernel_launch: memset of the barrier words failed\n"); return; }
    p.ph_lo = 0; p.ph_hi = NPHASE;
    void* args[] = {&p};
    hipError_t e = hipLaunchCooperativeKernel((void*)fwd_kernel<true>, dim3(grid), dim3(NT), args, LDS_BYTES, stream);
    if (e != hipSuccess) fprintf(stderr, "cooperative launch failed: %s (grid %d)\n", hipGetErrorString(e), grid);
#else
    for (int ph = 0; ph < NPHASE; ++ph) {
        p.ph_lo = ph; p.ph_hi = ph + 1;
        hipLaunchKernelGGL(fwd_kernel<false>, dim3(grid), dim3(NT), LDS_BYTES, stream, p);
    }
#endif
}
```

```cpp
#include <hip/hip_runtime.h>
#include <hip/hip_cooperative_groups.h>
#include <cstdio>
#include <cstdint>
namespace cg = cooperative_groups;

#ifndef PH_MASK
#define PH_MASK 0xFFFFF
#endif
#ifndef REPEAT_MASK
#define REPEAT_MASK 0
#endif
#ifndef ONE_LAUNCH
#define ONE_LAUNCH 1
#endif

#define LAS __attribute__((address_space(3)))
typedef unsigned short bf16_t;
typedef short bf16x8 __attribute__((ext_vector_type(8)));
typedef float f32x4 __attribute__((ext_vector_type(4)));
typedef float f32x2 __attribute__((ext_vector_type(2)));
typedef unsigned u32x4 __attribute__((ext_vector_type(4)));
typedef unsigned u32x2 __attribute__((ext_vector_type(2)));
typedef __bf16 bf16x2_t __attribute__((ext_vector_type(2)));

constexpr int NB = 4, SEQ = 8192, NTOK = NB * SEQ, DM = 1024;
constexpr int NIN_PAD = 4096;
constexpr int NEXP = 32, TOPK = 4, NROWS = NTOK * TOPK;
constexpr int S5L = 32;
constexpr int NCHUNK = SEQ / S5L;
constexpr int UROW = 640;
constexpr float DN_ALPHA = 1.189207115002721f;
constexpr float LN_EPS = 1e-5f;
constexpr float LOG2E = 1.4426950408889634f;
constexpr float QSCALE = 0.125f * 1.4426950408889634f;
constexpr float YS_SCALE = 8.f, ONSA_SCALE = 16.f, MRG_SCALE = 8.f, WGLU_SCALE = 16.f, WNSA_SCALE = 16.f, WOUT_SCALE = 32.f;
constexpr float WGU_SCALE = 32.f, WDN_SCALE = 64.f;
constexpr int NT = 512;
constexpr int NWV = NT / 64;

constexpr size_t al256(size_t x) { return (x + 255) & ~(size_t)255; }
constexpr size_t O_ADA = 0;
constexpr size_t O_CNT = O_ADA + al256(4 * 6144 * 4);
constexpr size_t O_BAR = O_CNT + 8192;
constexpr size_t BAR_BYTES = 3456 * 4;
constexpr size_t O_LAML = O_BAR + al256(BAR_BYTES);
constexpr size_t O_BIAS1 = O_LAML + al256(32 * 64 * 2 * 4);
constexpr size_t O_WT_IN = O_BIAS1 + al256(2 * 8 * 128 * 4);
constexpr size_t O_WT_GLU = O_WT_IN + al256((size_t)NIN_PAD * 1024);
constexpr size_t O_WT_NSA = O_WT_GLU + al256((size_t)2048 * 512 * 2);
constexpr size_t O_WT_OUT = O_WT_NSA + al256((size_t)1024 * 512 * 2);
constexpr size_t O_WT_C1 = O_WT_OUT + al256((size_t)1024 * 1024 * 2);
constexpr size_t O_W1T = O_WT_C1 + al256((size_t)2 * 256 * 2048 * 2);
constexpr size_t O_TW2 = O_W1T + al256((size_t)32 * 256 * 512 * 2);
constexpr size_t O_WT_GU = O_TW2 + al256((size_t)32 * 512 * 640 * 2);
constexpr size_t O_WT_DN = O_WT_GU + al256((size_t)32 * 2048 * 1024);
constexpr size_t O_H2 = O_WT_DN + al256((size_t)32 * 1024 * 1024);
constexpr size_t O_Z1 = O_H2 + al256((size_t)NTOK * 1024);
constexpr size_t O_TOPE = O_Z1 + al256((size_t)NTOK * 1024 * 4);
constexpr size_t O_TOPP = O_TOPE + al256((size_t)NROWS * 4);
constexpr size_t O_TOPG = O_TOPP + al256((size_t)NROWS * 4);
constexpr size_t O_ROWTOK = O_TOPG + al256((size_t)NROWS * 4);
constexpr size_t O_ROWGATE = O_ROWTOK + al256((size_t)NEXP * NTOK * 4);
constexpr size_t O_OVL = O_ROWGATE + al256((size_t)NEXP * NTOK * 4 + 1024);
constexpr size_t O_U = O_OVL;
constexpr size_t O_E = O_U + al256((size_t)32 * 1024 * UROW * 2);
constexpr size_t O_YS = O_E + al256((size_t)32 * 1024 * 128 * 4);
constexpr size_t O_Q = O_YS + al256((size_t)NTOK * 512 * 2);
constexpr size_t O_KV = O_Q + al256((size_t)NTOK * 512 * 2);
constexpr size_t KV_SLAB = (size_t)SEQ * 64;
constexpr size_t O_SG5 = O_KV + al256((size_t)6 * 8 * KV_SLAB * 2 + 8192);
constexpr size_t O_SGN = O_SG5 + al256((size_t)NTOK * 1024 * 2);
constexpr size_t O_GN = O_SGN + al256((size_t)NTOK * 1024 * 2);
constexpr size_t O_MS5 = O_GN + al256((size_t)NTOK * 24 * 4);
constexpr size_t O_ONSA = O_MS5 + al256((size_t)NTOK * 1024 * 2);
constexpr size_t O_HC = O_ONSA + al256((size_t)NTOK * 512 * 2);
constexpr size_t O_KC = O_HC + al256((size_t)2 * 4096 * 128 * 2);
constexpr size_t O_XN = O_KC + al256((size_t)2 * 4096 * 64 * 2);
constexpr size_t O_END1 = O_XN + al256((size_t)NTOK * 1024);
constexpr size_t O_ACT = O_OVL;
constexpr size_t O_YK = O_ACT + al256((size_t)(NROWS + 256) * 1024);
constexpr size_t O_END2 = O_YK + al256((size_t)(NROWS + 256) * 1024 * 2);
constexpr size_t WS_NEED = O_END1 > O_END2 ? O_END1 : O_END2;
static_assert(WS_NEED <= (size_t)1073741824, "workspace map exceeds 1 GiB");

constexpr int LDS_BYTES = 147456;
constexpr int LDS_TAB = 131072;
constexpr int NPHASE = 15;

struct Params {
    const float* in[34];
    float* out;
    unsigned char* ws;
    int ph_lo, ph_hi;
};

__device__ __forceinline__ unsigned pk2(float lo, float hi) { f32x2 v = {lo, hi}; bf16x2_t b = __builtin_convertvector(v, bf16x2_t); return __builtin_bit_cast(unsigned, b); }
__device__ __forceinline__ bf16_t f2bf(float f) { return (bf16_t)(pk2(f, 0.f) & 0xffffu); }
__device__ __forceinline__ float bf2f(bf16_t h) { return __uint_as_float(((unsigned)h) << 16); }
__device__ __forceinline__ float bflo(unsigned w) { return __uint_as_float(w << 16); }
__device__ __forceinline__ float bfhi(unsigned w) { return __uint_as_float(w & 0xffff0000u); }
#define LOG2E_F 1.4426950408889634f
__device__ __forceinline__ unsigned pk4_f8(float a, float b, float c, float d) { int w = 0; w = __builtin_amdgcn_cvt_pk_fp8_f32(a, b, w, false); w = __builtin_amdgcn_cvt_pk_fp8_f32(c, d, w, true); return (unsigned)w; }
__device__ __forceinline__ float sigmoidf_(float x) { return __builtin_amdgcn_rcpf(1.f + __builtin_amdgcn_exp2f(-LOG2E_F * x)); }
__device__ __forceinline__ float gelu_tanh(float x) { const float u = 0.7978845608028654f * (x + 0.044715f * x * x * x); const float e = __builtin_amdgcn_exp2f((2.f * LOG2E_F) * u); return x * (1.f - __builtin_amdgcn_rcpf(e + 1.f)); }
__device__ __forceinline__ float wave_sum(float v) {
#pragma unroll
    for (int o = 1; o < 64; o <<= 1) v += __shfl_xor(v, o);
    return v;
}
#define WAVE_SYNC() do { __builtin_amdgcn_fence(__ATOMIC_RELEASE, "wavefront"); __builtin_amdgcn_wave_barrier(); __builtin_amdgcn_fence(__ATOMIC_ACQUIRE, "wavefront"); } while (0)

#define XB_TMO      128
#define XB_XCNT(j)  (256  + 64 * (j))
#define XB_XSUB(j)  (1280 + 64 * (j))
#define XB_XGEN(j)  (2304 + 64 * (j))
#define XB_TOP      3328
#define XB_TOPGEN   3392
#define XB_SPIN_CAP (1u << 20)
__device__ __forceinline__ unsigned xb_ld(unsigned* p)              { return __hip_atomic_load(p, __ATOMIC_RELAXED, __HIP_MEMORY_SCOPE_AGENT); }
__device__ __forceinline__ unsigned xb_add(unsigned* p, unsigned v) { return __hip_atomic_fetch_add(p, v, __ATOMIC_RELAXED, __HIP_MEMORY_SCOPE_AGENT); }
__device__ __forceinline__ unsigned xb_xcc_id() { return (unsigned)__builtin_amdgcn_s_getreg((3 << 11) | 20) & 0xFu; }
#define XB_SPIN(cond, bar) do { unsigned _sp = 0; while (cond) { __builtin_amdgcn_s_sleep(1); \
    if ((++_sp & 255u) == 0u) { if (xb_ld(&(bar)[XB_TMO])) break; if (_sp > XB_SPIN_CAP) { atomicAdd(&(bar)[XB_TMO], 1u); break; } } } } while (0)
struct XcdBarrier { unsigned* bar; unsigned x; volatile LAS unsigned* st; };
__device__ __forceinline__ XcdBarrier xcd_barrier_post(unsigned* bar, volatile LAS unsigned* st) {
    XcdBarrier b; b.bar = bar; b.x = xb_xcc_id(); b.st = st;
    if (threadIdx.x == 0) (void)xb_add(&bar[XB_XCNT(b.x)], 1u);
    return b;
}
__device__ __forceinline__ void xcd_barrier_complete(unsigned* bar, unsigned x, unsigned& nloc, unsigned& nx) {
    const unsigned G = gridDim.x * gridDim.y * gridDim.z;
    unsigned sum, cnt, mine, sp = 0u;
    for (;;) {
        sum = 0u; cnt = 0u; mine = 0u;
#pragma unroll
        for (unsigned j = 0; j < 16; ++j) { const unsigned c = xb_ld(&bar[XB_XCNT(j)]); sum += c; cnt += (c > 0u) ? 1u : 0u; mine = (j == x) ? c : mine; }
        if (sum == G) break;
        __builtin_amdgcn_s_sleep(1);
        if ((++sp & 255u) == 0u) { if (xb_ld(&bar[XB_TMO])) break; if (sp > XB_SPIN_CAP) { atomicAdd(&bar[XB_TMO], 1u); break; } }
    }
    nloc = mine > 0u ? mine : 1u; nx = cnt > 0u ? cnt : 1u;
}
__device__ __forceinline__ void xcd_barrier(const XcdBarrier& b) {
    asm volatile("s_waitcnt vmcnt(0)" ::: "memory");
    __syncthreads();
    if (threadIdx.x == 0) {
        unsigned* bar = b.bar;
        __builtin_amdgcn_s_waitcnt(0);
        unsigned nloc = b.st[0], nx = b.st[1];
        if (nloc == 0u) { xcd_barrier_complete(bar, b.x, nloc, nx); b.st[0] = nloc; b.st[1] = nx; }
        const unsigned old = xb_add(&bar[XB_XSUB(b.x)], 1u);
        const unsigned gen = old / nloc;
        if (old + 1u == (gen + 1u) * nloc) {
            __builtin_amdgcn_fence(__ATOMIC_RELEASE, "agent");
            asm volatile("s_waitcnt vmcnt(0)" ::: "memory");
            const unsigned og = xb_add(&bar[XB_TOP], 1u);
            const unsigned tg = og / nx;
            if (og + 1u == (tg + 1u) * nx) xb_add(&bar[XB_TOPGEN], 1u);
            else XB_SPIN(xb_ld(&bar[XB_TOPGEN]) == tg, bar);
            __builtin_amdgcn_fence(__ATOMIC_ACQUIRE, "agent");
            xb_add(&bar[XB_XGEN(b.x)], 1u);
            asm volatile("s_waitcnt vmcnt(0)" ::: "memory");
        } else {
            XB_SPIN(xb_ld(&bar[XB_XGEN(b.x)]) == gen, bar);
            __builtin_amdgcn_fence(__ATOMIC_ACQUIRE, "agent");
            asm volatile("s_waitcnt vmcnt(0)" ::: "memory");
        }
    }
    __syncthreads();
}


namespace pg8 {
typedef int v8i_t __attribute__((ext_vector_type(8)));
typedef int v4i8_t __attribute__((ext_vector_type(4)));
constexpr int BM = 256, BK = 64, HALF = 128, HTB = HALF * BK * 2, STAGE_BYTES = 8 * HTB;
__device__ __forceinline__ int lds_byte(int r, int c) { const int st = (r >> 4) * 2 + (c >> 5), rr = r & 15, cc = c & 31, ob = rr * 64 + cc * 2; return st * 1024 + (ob ^ (((ob >> 9) & 1) << 5)); }
__device__ __forceinline__ void stage_rc(int b, int& R, int& C) { const int st = b / 1024, sb = b % 1024, swz = sb ^ (((sb >> 9) & 1) << 5); R = (st >> 1) * 16 + swz / 64; C = (st & 1) * 32 + (swz % 64) / 2; }
__device__ __forceinline__ int perm32(int rho) { const int n = rho >> 4, i = rho & 15; return 8 * (i >> 2) + 4 * n + (i & 3); }
struct Unit { const char* A; const char* B; const int* rows; int pm, pn, e, nvalid, rmax, gidx; };

template <class Epi, class Sched, bool ALIGN_EPI, bool F8 = false>
__device__ __forceinline__ void gemm_phase(LAS unsigned char* lds, const int K, const int lda, const int ldb, const Sched& S, const Epi& E) {
    const int tid = threadIdx.x, wid = __builtin_amdgcn_readfirstlane(tid >> 6), lane = tid & 63, wr = wid >> 2, wc = wid & 3, fr = lane & 15, fq = lane >> 4;
    const int nt = K / BK;
    unsigned voffB[2]; int Ra[2], Ca[2];
#pragma unroll
    for (int i = 0; i < 2; ++i) { int R, C; stage_rc(tid * 16 + i * 8192, R, C); const int Rb = Epi::PERM ? ((R & ~31) + perm32(R & 31)) : R;
        Ra[i] = R; Ca[i] = C; voffB[i] = (unsigned)(Rb * ldb + C) * 2u; }
    unsigned offC[2][2], offN[2][2];
#define PG8_SETOFF(o, u) do { _Pragma("unroll") for (int h_ = 0; h_ < 2; ++h_) _Pragma("unroll") for (int i_ = 0; i_ < 2; ++i_) { \
        if ((u).rows) { int ix_ = h_ * HALF + Ra[i_]; ix_ = ix_ < (u).rmax ? ix_ : (u).rmax; o[h_][i_] = (unsigned)((u).rows[ix_] >> 2) * (unsigned)(lda * 2) + (unsigned)Ca[i_] * 2u; } \
        else o[h_][i_] = (unsigned)((h_ * HALF + Ra[i_]) * lda + Ca[i_]) * 2u; } } while (0)
    const size_t kstep = (size_t)(BK * 2);
    const size_t hstepB = (size_t)HALF * ldb * 2;
    const unsigned ldsw = (unsigned)wid * 1024u;
    const int aoff = lds_byte(wr * 64 + fr, fq * 8), boff = lds_byte(wc * 32 + fr, fq * 8);
#define PG8_SA(b, h) (((b) * 2 + (h)) * HTB)
#define PG8_SB(b, h) ((4 + (b) * 2 + (h)) * HTB)
#define PG8_STAGE(bufoff, gbase, voff) do { _Pragma("unroll") for (int _i = 0; _i < 2; ++_i) \
        __builtin_amdgcn_global_load_lds((const unsigned*)((const char*)(gbase) + (voff)[_i]), (LAS unsigned*)(lds + (bufoff) + ldsw + _i * 8192), 16, 0, 0); } while (0)
#define PG8_LDA(dst, b, h) do { _Pragma("unroll") for (int m = 0; m < 4; ++m) { \
        if constexpr (F8) dst##8[m] = __builtin_shufflevector(*(const LAS v4i8_t*)(lds + PG8_SA(b, h) + aoff + m * 2048), *(const LAS v4i8_t*)(lds + PG8_SA(b, h) + aoff + m * 2048 + 1024), 0, 1, 2, 3, 4, 5, 6, 7); \
        else { _Pragma("unroll") for (int k = 0; k < 2; ++k) dst[m][k] = *(const LAS bf16x8*)(lds + PG8_SA(b, h) + aoff + m * 2048 + k * 1024); } } } while (0)
#define PG8_LDB(dst, b, h) do { _Pragma("unroll") for (int n = 0; n < 2; ++n) { \
        if constexpr (F8) dst##8[n] = __builtin_shufflevector(*(const LAS v4i8_t*)(lds + PG8_SB(b, h) + boff + n * 2048), *(const LAS v4i8_t*)(lds + PG8_SB(b, h) + boff + n * 2048 + 1024), 0, 1, 2, 3, 4, 5, 6, 7); \
        else { _Pragma("unroll") for (int k = 0; k < 2; ++k) dst[n][k] = *(const LAS bf16x8*)(lds + PG8_SB(b, h) + boff + n * 2048 + k * 1024); } } } while (0)
#define PG8_MMA(ai, bj, At, Bt) do { __builtin_amdgcn_s_setprio(1); _Pragma("unroll") for (int m = 0; m < 4; ++m) _Pragma("unroll") for (int n = 0; n < 2; ++n) { \
        if constexpr (F8) asm volatile("v_mfma_scale_f32_16x16x128_f8f6f4 %0, %1, %2, %0, %3, %3 op_sel_hi:[0,0,0]" : "+v"(acc[ai][bj][m][n]) : "v"(Bt##8[n]), "v"(At##8[m]), "v"(f8scale_));   \
        else { _Pragma("unroll") for (int k = 0; k < 2; ++k) acc[ai][bj][m][n] = __builtin_amdgcn_mfma_f32_16x16x32_bf16(Bt[n][k], At[m][k], acc[ai][bj][m][n], 0, 0, 0); } } \
        __builtin_amdgcn_s_setprio(0); } while (0)
#define PG8_WAIT_V(n) asm volatile("s_waitcnt vmcnt(" #n ")" ::: "memory")
#define PG8_WAIT_L(n) asm volatile("s_waitcnt lgkmcnt(" #n ")" ::: "memory")
#define PG8_BAR __builtin_amdgcn_s_barrier()
#define PG8_SCHED __builtin_amdgcn_sched_barrier(0)
    Unit cur, nxt; int ui = 0;
    if (!S.next(0, cur)) return;
    f32x4 acc[2][2][4][2];
#pragma unroll
    for (int a = 0; a < 2; ++a)
#pragma unroll
        for (int b = 0; b < 2; ++b)
#pragma unroll
            for (int m = 0; m < 4; ++m)
#pragma unroll
                for (int n = 0; n < 2; ++n) acc[a][b][m][n] = (f32x4){0.f, 0.f, 0.f, 0.f};
    bf16x8 At[4][2], B0[2][2], B1[2][2];
    v8i_t At8[4], B08[2], B18[2];
    const int f8scale_ = 0x7F7F7F7F;
    const char* cA = cur.A; const char* cB = cur.B;
    PG8_SETOFF(offC, cur);
    PG8_STAGE(PG8_SB(0, 0), cB, voffB); PG8_STAGE(PG8_SB(0, 1), cB + hstepB, voffB); PG8_STAGE(PG8_SA(0, 0), cA, offC[0]); PG8_STAGE(PG8_SA(0, 1), cA, offC[1]);
    if (wr == 1) PG8_BAR;
    PG8_WAIT_V(2); PG8_BAR;
    PG8_STAGE(PG8_SB(1, 0), cB + kstep, voffB); PG8_STAGE(PG8_SA(1, 0), cA + kstep, offC[0]); PG8_STAGE(PG8_SB(1, 1), cB + hstepB + kstep, voffB);
    PG8_WAIT_V(6); PG8_BAR;
    for (;;) {
        const bool has_next = S.next(ui + 1, nxt);
        const char* nA = has_next ? nxt.A : cA; const char* nB = has_next ? nxt.B : cB;
        if (has_next) { PG8_SETOFF(offN, nxt); } else { offN[0][0] = offC[0][0]; offN[0][1] = offC[0][1]; offN[1][0] = offC[1][0]; offN[1][1] = offC[1][1]; }
#pragma unroll 1
        for (int t = 0; t < nt; t += 2) {
            const bool last = (t == nt - 2);
            const char* a1 = cA + (size_t)(t + 1) * kstep;
            const char* a2 = last ? nA : cA + (size_t)(t + 2) * kstep; const char* b2 = last ? nB : cB + (size_t)(t + 2) * kstep;
            const char* a3 = a2 + kstep; const char* b3 = b2 + kstep;
            unsigned o2[2][2];
            o2[0][0] = last ? offN[0][0] : offC[0][0]; o2[0][1] = last ? offN[0][1] : offC[0][1]; o2[1][0] = last ? offN[1][0] : offC[1][0]; o2[1][1] = last ? offN[1][1] : offC[1][1];
            PG8_LDB(B0, 0, 0); PG8_LDB(B1, 0, 1); PG8_SCHED; PG8_LDA(At, 0, 0); PG8_STAGE(PG8_SA(1, 1), a1, offC[1]);
            PG8_WAIT_V(8); PG8_WAIT_L(0); PG8_BAR; PG8_MMA(0, 0, At, B0); PG8_MMA(0, 1, At, B1); PG8_BAR; PG8_SCHED;
            PG8_LDA(At, 0, 1); PG8_STAGE(PG8_SB(0, 0), b2, voffB); PG8_STAGE(PG8_SB(0, 1), b2 + hstepB, voffB); PG8_STAGE(PG8_SA(0, 0), a2, o2[0]);
            PG8_WAIT_V(8); PG8_WAIT_L(0); PG8_BAR; PG8_MMA(1, 0, At, B0); PG8_MMA(1, 1, At, B1); PG8_BAR; PG8_SCHED;
            PG8_LDB(B0, 1, 0); PG8_LDB(B1, 1, 1); PG8_SCHED; PG8_LDA(At, 1, 0); PG8_STAGE(PG8_SA(0, 1), a2, o2[1]);
            PG8_WAIT_V(8); PG8_WAIT_L(0); PG8_BAR; PG8_MMA(0, 0, At, B0); PG8_MMA(0, 1, At, B1); PG8_BAR; PG8_SCHED;
            PG8_LDA(At, 1, 1); PG8_STAGE(PG8_SB(1, 0), b3, voffB); PG8_STAGE(PG8_SB(1, 1), b3 + hstepB, voffB); PG8_STAGE(PG8_SA(1, 0), a3, o2[0]);
            PG8_WAIT_V(8); PG8_WAIT_L(0); PG8_BAR; PG8_MMA(1, 0, At, B0); PG8_MMA(1, 1, At, B1); PG8_BAR; PG8_SCHED;
        }
        if constexpr (ALIGN_EPI) { if (wr == 0) PG8_BAR; }
        if constexpr (F8) asm volatile("s_nop 15\n\ts_nop 15" ::: "memory");
        E(acc, cur, wr, wc, fr, fq);
        if (!has_next) break;
#pragma unroll
        for (int a = 0; a < 2; ++a)
#pragma unroll
            for (int b = 0; b < 2; ++b)
#pragma unroll
                for (int m = 0; m < 4; ++m)
#pragma unroll
                    for (int n = 0; n < 2; ++n) acc[a][b][m][n] = (f32x4){0.f, 0.f, 0.f, 0.f};
        cur = nxt; cA = nA; cB = nB; ++ui;
        offC[0][0] = offN[0][0]; offC[0][1] = offN[0][1]; offC[1][0] = offN[1][0]; offC[1][1] = offN[1][1];
        if constexpr (ALIGN_EPI) { if (wr == 1) PG8_BAR; }
    }
    PG8_WAIT_V(0);
    if constexpr (!ALIGN_EPI) { if (wr == 0) PG8_BAR; }
    PG8_BAR;
#undef PG8_SETOFF
#undef PG8_SA
#undef PG8_SB
#undef PG8_STAGE
#undef PG8_LDA
#undef PG8_LDB
#undef PG8_MMA
#undef PG8_WAIT_V
#undef PG8_WAIT_L
#undef PG8_BAR
#undef PG8_SCHED
}

struct DenseOrder {
    const char* A; const char* B; size_t tstepA, tstepB; int nM, nN, nwg, G, c;
    __device__ __forceinline__ void init(const void* A_, const void* B_, int M, int N, int lda, int ldb, int G_, int c_) {
        A = (const char*)A_; B = (const char*)B_; tstepA = (size_t)BM * lda * 2; tstepB = (size_t)BM * ldb * 2; nM = M / BM; nN = N / BM; nwg = nM * nN; G = G_; c = c_; }
    __device__ __forceinline__ bool next(int i, Unit& u) const {
        const long L = (long)i * G + c; if (L >= nwg) return false;
        int wgid = (int)L; { const int q = nwg / 8, r = nwg % 8, xcd = wgid % 8, off = wgid / 8; wgid = (xcd < r ? xcd * (q + 1) : r * (q + 1) + (xcd - r) * q) + off; }
        const int nig = 8 * nN, gid = wgid / nig, fm = gid * 8, gsz = (nM - fm) < 8 ? (nM - fm) : 8;
        u.pm = fm + ((wgid % nig) % gsz); u.pn = (wgid % nig) / gsz; u.e = 0; u.nvalid = 256; u.rows = nullptr; u.rmax = 255;
        u.A = A + (size_t)u.pm * tstepA; u.B = B + (size_t)u.pn * tstepB; return true;
    }
};
}

__device__ __forceinline__ int map_in(int n) { return n < 1792 ? n : (n < 3840 ? n + 24 : (n < 3864 ? 1792 + (n - 3840) : -1)); }
__device__ __forceinline__ int map_il128(int n) { const int b = n >> 7; return (b & 1) * 1024 + (b >> 1) * 128 + (n & 127); }

struct TrJob { const float* W; bf16_t* Wt; int K, Nsrc, map, kt, nt; float f8scale; };
constexpr int TR_IN = 16 * 16, TR_GLU = 8 * 8, TR_NSA = 8 * 4, TR_OUT = 16 * 4, TR_C1 = 2 * 32, TR_GU = 32 * 16 * 8, TR_DN = 32 * 16 * 4;
constexpr int TR_ITEMS = TR_IN + TR_GLU + TR_NSA + TR_OUT + TR_C1 + TR_GU + TR_DN;
__device__ __forceinline__ void tr_job(const Params& p, int r, TrJob& j) {
    unsigned char* ws = p.ws;
    if (r < TR_IN) { j = TrJob{p.in[5], (bf16_t*)(ws + O_WT_IN), 1024, 3864, 1, r / 16, r % 16, WGU_SCALE}; return; } r -= TR_IN;
    if (r < TR_GLU) { j = TrJob{p.in[14], (bf16_t*)(ws + O_WT_GLU), 512, 2048, 2, r / 8, r % 8, WGLU_SCALE}; return; } r -= TR_GLU;
    if (r < TR_NSA) { j = TrJob{p.in[22], (bf16_t*)(ws + O_WT_NSA), 512, 1024, 0, r / 4, r % 4, WNSA_SCALE}; return; } r -= TR_NSA;
    if (r < TR_OUT) { j = TrJob{p.in[23], (bf16_t*)(ws + O_WT_OUT), 1024, 1024, 0, r / 4, r % 4, WOUT_SCALE}; return; } r -= TR_OUT;
    if (r < TR_C1) { const int kv = r / 32; j = TrJob{p.in[kv ? 20 : 17], (bf16_t*)(ws + O_WT_C1) + (size_t)kv * 256 * 2048, 2048, 128, 3, r % 32, 0, 0.f}; return; } r -= TR_C1;
    if (r < TR_GU) { const int e = r / 128, q = r % 128; j = TrJob{p.in[28] + (size_t)e * 1024 * 2048, (bf16_t*)(ws + O_WT_GU + (size_t)e * 2048 * 1024), 1024, 2048, 2, q / 8, q % 8, WGU_SCALE}; return; } r -= TR_GU;
    { const int e = r / 64, q = r % 64; j = TrJob{p.in[30] + (size_t)e * 1024 * 1024, (bf16_t*)(ws + O_WT_DN + (size_t)e * 1024 * 1024), 1024, 1024, 0, q / 4, q % 4, WDN_SCALE}; }
}
__device__ __forceinline__ void tr_load(const TrJob& j, f32x4 (&v)[8], int tid) {
    const int n4 = tid & 63, kq = tid >> 6, nd = j.nt * 256 + 4 * n4;
    const int src = j.map == 0 ? nd : (j.map == 1 ? map_in(nd) : (j.map == 2 ? map_il128(nd) : (nd < 128 ? nd : -1)));
    const float* base = j.W + (size_t)(j.kt * 64 + kq) * j.Nsrc + (src >= 0 ? src : 0);
#pragma unroll
    for (int i = 0; i < 8; ++i) v[i] = (src >= 0) ? *(const f32x4*)(base + (size_t)i * 8 * j.Nsrc) : (f32x4){0.f, 0.f, 0.f, 0.f};
}
__device__ __forceinline__ void tr_store(const TrJob& cj, const float* t, int tid) {
    if (cj.f8scale != 0.f) {
        const int n = tid & 255, kh = (tid >> 8) * 32; const float sc = cj.f8scale;
        unsigned char* d = (unsigned char*)cj.Wt + (size_t)(cj.nt * 256 + n) * cj.K + cj.kt * 64 + kh;
#pragma unroll
        for (int q = 0; q < 2; ++q) {
            const float* c = t + (kh + 16 * q) * 260 + n;
            u32x4 o;
            o.x = pk4_f8(c[0] * sc, c[260] * sc, c[2 * 260] * sc, c[3 * 260] * sc); o.y = pk4_f8(c[4 * 260] * sc, c[5 * 260] * sc, c[6 * 260] * sc, c[7 * 260] * sc);
            o.z = pk4_f8(c[8 * 260] * sc, c[9 * 260] * sc, c[10 * 260] * sc, c[11 * 260] * sc); o.w = pk4_f8(c[12 * 260] * sc, c[13 * 260] * sc, c[14 * 260] * sc, c[15 * 260] * sc);
            *(u32x4*)(d + 16 * q) = o;
        }
    } else {
        const int n = tid & 255, kh = (tid >> 8) * 32;
        bf16_t* d = cj.Wt + (size_t)(cj.nt * 256 + n) * cj.K + cj.kt * 64 + kh;
#pragma unroll
        for (int q = 0; q < 4; ++q) {
            const float* c = t + (kh + 8 * q) * 260 + n;
            u32x4 o;
            o.x = pk2(c[0], c[260]); o.y = pk2(c[2 * 260], c[3 * 260]); o.z = pk2(c[4 * 260], c[5 * 260]); o.w = pk2(c[6 * 260], c[7 * 260]);
            *(u32x4*)(d + 8 * q) = o;
        }
    }
}
__device__ __forceinline__ void convert_weights(const Params& p, unsigned char* smem, int lo, int hi, unsigned* queue) {
    float* t = (float*)smem;
    int* slot = (int*)(smem + 64 * 260 * 4);
    const int tid = threadIdx.x, n4 = tid & 63, kq = tid >> 6;
    const int G = gridDim.x;
    int ia, ib;
    if (queue) { if (tid == 0) { slot[0] = lo + (int)atomicAdd(queue, 1u); slot[1] = lo + (int)atomicAdd(queue, 1u); } __syncthreads(); ia = slot[0]; ib = slot[1]; __syncthreads(); }
    else { ia = lo + blockIdx.x; ib = ia + G; }
    if (ia >= hi) return;
    TrJob ja, jb; f32x4 va[8], vb[8];
    tr_job(p, ia, ja); tr_load(ja, va, tid);
    if (ib < hi) { tr_job(p, ib, jb); tr_load(jb, vb, tid); }
#define TR_ROUND(I, J, V) do { \
        _Pragma("unroll") for (int i = 0; i < 8; ++i) *(f32x4*)(t + (i * 8 + kq) * 260 + 4 * n4) = V[i]; \
        if (queue && tid == 0) slot[0] = lo + (int)atomicAdd(queue, 1u); \
        __syncthreads(); \
        const TrJob cj_ = J; \
        I = queue ? slot[0] : I + 2 * G; \
        if (I < hi) { tr_job(p, I, J); tr_load(J, V, tid); } \
        tr_store(cj_, t, tid); \
        __syncthreads(); } while (0)
    for (;;) {
        TR_ROUND(ia, ja, va);
        if (ib >= hi) break;
        TR_ROUND(ib, jb, vb);
        if (ia >= hi) break;
    }
#undef TR_ROUND
}

__device__ __forceinline__ bool convert_one(const Params& p, unsigned char* smem, unsigned* queue) {
    float* t = (float*)smem; int* slot = (int*)(smem + 64 * 260 * 4);
    const int tid = threadIdx.x, lo = TR_ITEMS - TR_GU - TR_DN;
    if (tid == 0) *slot = lo + (int)atomicAdd(queue, 1u);
    __syncthreads();
    const int it = *slot;
    __syncthreads();
    if (it >= TR_ITEMS) return false;
    TrJob j; tr_job(p, it, j);
    f32x4 v[8]; tr_load(j, v, tid);
    { const int n4 = tid & 63, kq = tid >> 6;
#pragma unroll
      for (int i = 0; i < 8; ++i) *(f32x4*)(t + (i * 8 + kq) * 260 + 4 * n4) = v[i]; }
    __syncthreads();
    tr_store(j, t, tid);
    __syncthreads();
    return true;
}
__device__ __forceinline__ void xcd_barrier_work(const XcdBarrier& b, const Params& p, unsigned char* smem, bool allow_work) {
    asm volatile("s_waitcnt vmcnt(0)" ::: "memory");
    __syncthreads();
    volatile LAS unsigned* fl = b.st + 2;
    if (threadIdx.x == 0) {
        unsigned* bar = b.bar;
        __builtin_amdgcn_s_waitcnt(0);
        unsigned nloc = b.st[0], nx = b.st[1];
        if (nloc == 0u) { xcd_barrier_complete(bar, b.x, nloc, nx); b.st[0] = nloc; b.st[1] = nx; }
        const unsigned old = xb_add(&bar[XB_XSUB(b.x)], 1u);
        const unsigned gen = old / nloc;
        const bool leader = (old + 1u == (gen + 1u) * nloc);
        fl[0] = leader ? 1u : 0u; fl[1] = gen;
        if (leader) {
            __builtin_amdgcn_fence(__ATOMIC_RELEASE, "agent");
            asm volatile("s_waitcnt vmcnt(0)" ::: "memory");
            const unsigned og = xb_add(&bar[XB_TOP], 1u);
            const unsigned tg = og / nx;
            if (og + 1u == (tg + 1u) * nx) xb_add(&bar[XB_TOPGEN], 1u);
            else XB_SPIN(xb_ld(&bar[XB_TOPGEN]) == tg, bar);
            __builtin_amdgcn_fence(__ATOMIC_ACQUIRE, "agent");
            xb_add(&bar[XB_XGEN(b.x)], 1u);
            asm volatile("s_waitcnt vmcnt(0)" ::: "memory");
        }
    }
    __syncthreads();
    if (fl[0] == 0u) {
        const unsigned gen = fl[1];
        unsigned* bar = b.bar;
        bool more = allow_work;
        for (;;) {
            __syncthreads();
            if (threadIdx.x == 0) fl[0] = (xb_ld(&bar[XB_XGEN(b.x)]) != gen) ? 2u : 0u;
            __syncthreads();
            if (fl[0] == 2u) break;
            if (more) more = convert_one(p, smem, bar + 3410);
            else { if (threadIdx.x == 0) XB_SPIN(xb_ld(&bar[XB_XGEN(b.x)]) == gen, bar); }
        }
        if (threadIdx.x == 0) { __builtin_amdgcn_fence(__ATOMIC_ACQUIRE, "agent"); asm volatile("s_waitcnt vmcnt(0)" ::: "memory"); }
        __syncthreads();
    }
}

__device__ __forceinline__ void phase0(const Params& p, unsigned char* smem) {
    unsigned char* ws = p.ws;
    const int tid = threadIdx.x;
    convert_weights(p, smem, 0, TR_ITEMS - TR_GU - TR_DN, nullptr);
    constexpr int I_ADA = 96;
    constexpr int I_S5 = 32 * 33;
    constexpr int I_MISC = 17;
    constexpr int NITEM = I_ADA + I_S5 + I_MISC;
    for (int item = blockIdx.x; item < NITEM; item += gridDim.x) {
        int r = item;
        if (r < I_ADA) {
            const float* c = p.in[1]; const float* w = p.in[3]; const float* bb = p.in[4];
            const int wid = tid >> 6, lane = tid & 63, j = r * 64 + lane;
            float a0 = 0.f, a1 = 0.f, a2 = 0.f, a3 = 0.f;
#pragma unroll 4
            for (int k = wid * 128; k < wid * 128 + 128; ++k) {
                const float wv = w[(size_t)k * 6144 + j];
                const float c0 = c[k], c1 = c[1024 + k], c2 = c[2048 + k], c3 = c[3072 + k];
                a0 += c0 * sigmoidf_(c0) * wv; a1 += c1 * sigmoidf_(c1) * wv; a2 += c2 * sigmoidf_(c2) * wv; a3 += c3 * sigmoidf_(c3) * wv;
            }
            float* red = (float*)smem;
            red[(wid * 4 + 0) * 64 + lane] = a0; red[(wid * 4 + 1) * 64 + lane] = a1; red[(wid * 4 + 2) * 64 + lane] = a2; red[(wid * 4 + 3) * 64 + lane] = a3;
            __syncthreads();
            if (tid < 256) { const int b = tid >> 6; float s = 0.f;
#pragma unroll
              for (int w8 = 0; w8 < 8; ++w8) s += red[(w8 * 4 + b) * 64 + lane];
              ((float*)(ws + O_ADA))[b * 6144 + j] = s + bb[j]; }
            asm volatile("s_waitcnt vmcnt(0)" ::: "memory");
            __syncthreads();
            if (tid == 0) { __builtin_amdgcn_fence(__ATOMIC_RELEASE, "agent"); asm volatile("s_waitcnt vmcnt(0)" ::: "memory"); (void)xb_add((unsigned*)(ws + O_BAR) + 3400, 1u); }
            continue;
        }
        r -= I_ADA;
        if (r < I_S5) {
            const int g = r / 33, dl = r % 33;
            f32x2* pw = (f32x2*)smem;
            f32x2* bbv = pw + 64;
            f32x2* ccv = bbv + 1024;
            const float dt = expf(p.in[8][g]);
            if (tid < 64) {
                const int n = tid; const double re = p.in[6][g * 64 + n], im = p.in[7][g * 64 + n];
                const float mag = __expf((float)(re * (double)dt * dl)); const double ang = im * (double)dt * dl;
                const float ar = (float)(ang - 6.283185307179586 * rint(ang * 0.15915494309189535));
                float sn, cs; sincosf(ar, &sn, &cs);
                pw[n] = (f32x2){mag * cs, mag * sn};
                if (dl == 32) { ((f32x2*)(ws + O_LAML))[g * 64 + n] = pw[n]; }
            }
            for (int e = tid; e < 1024; e += NT) {
                const int n = e >> 4, q = e & 15;
                const double re = p.in[6][g * 64 + n], im = p.in[7][g * 64 + n];
                const double ang = im * (double)dt;
                const float ar = (float)(ang - 6.283185307179586 * rint(ang * 0.15915494309189535));
                float snf, csf; sincosf(ar, &snf, &csf);
                const double mag = exp(re * (double)dt), sn = snf, cs = csf;
                const double lr = mag * cs - 1.0, li = mag * sn;
                const double den = re * re + im * im;
                const double fr_ = (lr * re + li * im) / den, fi_ = (li * re - lr * im) / den;
                const double br = p.in[9][(g * 64 + n) * 16 + q], bi = p.in[10][(g * 64 + n) * 16 + q];
                bbv[e] = (f32x2){(float)(fr_ * br - fi_ * bi), (float)(fr_ * bi + fi_ * br)};
            }
            for (int e = tid; e < 1024; e += NT) { ccv[e] = (f32x2){p.in[11][g * 1024 + e], p.in[12][g * 1024 + e]}; }
            __syncthreads();
            bf16_t* TW2 = (bf16_t*)(ws + O_TW2) + (size_t)g * 512 * UROW;
            bf16_t* W1T = (bf16_t*)(ws + O_W1T) + (size_t)g * 256 * 512;
            if (dl < 32) {
                if (tid < 256) {
                    const int pp = tid >> 4, q = tid & 15;
                    float acc = 0.f;
                    for (int n = 0; n < 64; ++n) {
                        const f32x2 cv = ccv[pp * 64 + n], pv = pw[n], bv = bbv[n * 16 + q];
                        const float xr = cv.x * pv.x - cv.y * pv.y, xi = cv.x * pv.y + cv.y * pv.x;
                        acc += xr * bv.x - xi * bv.y;
                    }
                    if (dl == 0 && pp == q) acc += p.in[13][g * 16 + pp];
                    const bf16_t kb = f2bf(acc);
                    for (int tau = dl; tau < 32; ++tau) { const int s = tau - dl; TW2[(size_t)(tau * 16 + pp) * UROW + s * 16 + q] = kb; }
                    if (dl >= 1) for (int s = dl; s < 32; ++s) { const int tau = s - dl; TW2[(size_t)(tau * 16 + pp) * UROW + s * 16 + q] = 0; }
                }
                const int s = 31 - dl;
                for (int e = tid; e < 2048; e += NT) {
                    const int c = e >> 4, qq = e & 15, n = c & 63, ri = c >> 6;
                    const f32x2 pv = pw[n], bv = bbv[n * 16 + qq];
                    const float zr = pv.x * bv.x - pv.y * bv.y, zi = pv.x * bv.y + pv.y * bv.x;
                    W1T[(size_t)c * 512 + s * 16 + qq] = f2bf(ri ? zi : zr);
                }
            } else {
                u32x4* z = (u32x4*)(W1T + (size_t)128 * 512);
                for (int e = tid; e < 128 * 512 / 8; e += NT) z[e] = (u32x4){0u, 0u, 0u, 0u};
            }
            if (dl >= 1) {
                const int tau = dl - 1;
                for (int e = tid; e < 2048; e += NT) {
                    const int pp = e >> 7, c = e & 127, n = c & 63, ri = c >> 6;
                    const f32x2 cv = ccv[pp * 64 + n], pv = pw[n];
                    const float xr = cv.x * pv.x - cv.y * pv.y, xi = cv.x * pv.y + cv.y * pv.x;
                    TW2[(size_t)(tau * 16 + pp) * UROW + 512 + c] = f2bf(ri ? -xi : xr);
                }
            }
            __syncthreads();
            continue;
        }
        r -= I_S5;
        if (r < 16) {
            const int kv = r >> 3, part = r & 7, j = tid & 127, qtr = tid >> 7;
            const float* pos = p.in[kv ? 19 : 16]; const float* w1 = p.in[kv ? 20 : 17];
            float a = 0.f;
            const int i0 = part * 256 + qtr * 64;
            for (int i = i0; i < i0 + 64; ++i) a += pos[i] * w1[(size_t)i * 128 + j];
            float* red = (float*)smem;
            red[tid] = a;
            __syncthreads();
            if (tid < 128) ((float*)(ws + O_BIAS1))[(kv * 8 + part) * 128 + tid] = (red[tid] + red[tid + 128]) + (red[tid + 256] + red[tid + 384]);
            __syncthreads();
            continue;
        }
        for (int i = tid; i < 1100; i += NT) ((unsigned*)(ws + O_CNT))[i] = 0u;
    }
}

__device__ __forceinline__ void phase1(const Params& p, unsigned char*) {
    if (threadIdx.x == 0) { unsigned* f = (unsigned*)(p.ws + O_BAR) + 3400; XB_SPIN(xb_ld(f) < 96u, (unsigned*)(p.ws + O_BAR)); __builtin_amdgcn_fence(__ATOMIC_ACQUIRE, "agent"); asm volatile("s_waitcnt vmcnt(0)" ::: "memory"); }
    __syncthreads();
    const float* x = p.in[0];
    unsigned char* xn = p.ws + O_XN;
    for (size_t i = (size_t)blockIdx.x * NT + threadIdx.x; i < (size_t)NTOK * 128; i += (size_t)gridDim.x * NT) {
        const int token = (int)(i >> 7), k = (int)(i & 127) * 8, b = token >> 13;
        const float* ada = (const float*)(p.ws + O_ADA) + b * 6144;
        const f32x4 x0 = *(const f32x4*)(x + (size_t)token * 1024 + k), x1 = *(const f32x4*)(x + (size_t)token * 1024 + k + 4);
        const f32x4 s0 = *(const f32x4*)(ada + 1024 + k), s1 = *(const f32x4*)(ada + 1024 + k + 4);
        const f32x4 h0 = *(const f32x4*)(ada + k), h1 = *(const f32x4*)(ada + k + 4);
        *(u32x2*)(xn + (size_t)token * 1024 + k) = (u32x2){pk4_f8(x0[0] * (1.f + s0[0]) + h0[0], x0[1] * (1.f + s0[1]) + h0[1], x0[2] * (1.f + s0[2]) + h0[2], x0[3] * (1.f + s0[3]) + h0[3]),
                                                           pk4_f8(x1[0] * (1.f + s1[0]) + h1[0], x1[1] * (1.f + s1[1]) + h1[1], x1[2] * (1.f + s1[2]) + h1[2], x1[3] * (1.f + s1[3]) + h1[3])};
    }
}

typedef const f32x4 (&AccRef)[2][2][4][2];
struct EpiIn {
    static constexpr bool PERM = true;
    unsigned char* ws;
    __device__ __forceinline__ void operator()(AccRef acc, const pg8::Unit& u, int wr, int wc, int fr, int fq) const {
        const int pn = u.pn;
#pragma unroll
        for (int ai = 0; ai < 2; ++ai)
#pragma unroll
            for (int m = 0; m < 4; ++m) {
                const int token = u.pm * 256 + ai * 128 + wr * 64 + m * 16 + fr;
#pragma unroll
                for (int bj = 0; bj < 2; ++bj) {
                    const int col = pn * 256 + bj * 128 + wc * 32 + 8 * fq;
                    const f32x4 v0 = acc[ai][bj][m][0] * (1.f / WGU_SCALE), v1 = acc[ai][bj][m][1] * (1.f / WGU_SCALE);
                    if (pn < 2) {
                        const int g = col >> 4, q = col & 15;
                        bf16_t* d = (bf16_t*)(ws + O_U) + ((size_t)(g * 1024 + (token >> 5)) * UROW + (token & 31) * 16 + q);
                        *(u32x4*)d = (u32x4){pk2(v0[0], v0[1]), pk2(v0[2], v0[3]), pk2(v1[0], v1[1]), pk2(v1[2], v1[3])};
                    } else if (pn < 4) {
                        bf16_t* d = (bf16_t*)(ws + O_Q) + (size_t)token * 512 + (col - 512);
                        *(u32x4*)d = (u32x4){pk2(v0[0] * QSCALE, v0[1] * QSCALE), pk2(v0[2] * QSCALE, v0[3] * QSCALE), pk2(v1[0] * QSCALE, v1[1] * QSCALE), pk2(v1[2] * QSCALE, v1[3] * QSCALE)};
                    } else if (pn < 7) {
                        const int c = col - 1024, j6 = c >> 7, g = (c >> 6) & 1, dd = c & 63, b = token >> 13, s = token & 8191;
                        bf16_t* slab = (bf16_t*)(ws + O_KV) + (size_t)((j6 * 4 + b) * 2 + g) * KV_SLAB;
                        if (j6 == 3 || j6 == 5) {
                            const int p64 = s & 63, p16 = p64 & 15, slot = (p16 & 3) | ((p16 & 4) << 1) | ((p16 & 8) >> 1);
                            bf16_t* blkp = slab + (size_t)(s >> 6) * 4096 + (((p64 >> 5) * 2 + ((p64 >> 4) & 1)) * 64 + (slot >> 3) * 32) * 8 + (slot & 7);
#pragma unroll
                            for (int j = 0; j < 4; ++j) { const int d0 = dd + j, d1 = dd + 4 + j;
                                blkp[((d0 >> 5) * 4 * 64 + (d0 & 31)) * 8] = f2bf(v0[j]); blkp[((d1 >> 5) * 4 * 64 + (d1 & 31)) * 8] = f2bf(v1[j]); }
                        } else if (j6 == 2 || j6 == 4) {
                            bf16_t* d = slab + (size_t)((s >> 5) * 4 + (dd >> 4)) * 512 + (((dd >> 3) & 1) * 32 + (s & 31)) * 8;
                            *(u32x4*)d = (u32x4){pk2(v0[0], v0[1]), pk2(v0[2], v0[3]), pk2(v1[0], v1[1]), pk2(v1[2], v1[3])};
                        } else {
                            *(u32x4*)(slab + (size_t)s * 64 + dd) = (u32x4){pk2(v0[0], v0[1]), pk2(v0[2], v0[3]), pk2(v1[0], v1[1]), pk2(v1[2], v1[3])};
                        }
                    } else if (pn < 15) {
                        bf16_t* d = (pn < 11 ? (bf16_t*)(ws + O_SG5) + (size_t)token * 1024 + (col - 1792) : (bf16_t*)(ws + O_SGN) + (size_t)token * 1024 + (col - 2816));
                        *(u32x4*)d = (u32x4){pk2(sigmoidf_(v0[0]), sigmoidf_(v0[1])), pk2(sigmoidf_(v0[2]), sigmoidf_(v0[3])), pk2(sigmoidf_(v1[0]), sigmoidf_(v1[1])), pk2(sigmoidf_(v1[2]), sigmoidf_(v1[3]))};
                    } else {
                        const int c = col - 3840;
                        if (c < 24) { float* d = (float*)(ws + O_GN) + (size_t)token * 24 + c;
                            *(f32x4*)d = (f32x4){sigmoidf_(v0[0]), sigmoidf_(v0[1]), sigmoidf_(v0[2]), sigmoidf_(v0[3])};
                            *(f32x4*)(d + 4) = (f32x4){sigmoidf_(v1[0]), sigmoidf_(v1[1]), sigmoidf_(v1[2]), sigmoidf_(v1[3])}; }
                    }
                }
            }
    }
};
__device__ __forceinline__ void phase2(const Params& p, LAS unsigned char* lds) {
    pg8::DenseOrder S; S.init(p.ws + O_XN, p.ws + O_WT_IN, NTOK, NIN_PAD, 512, 512, gridDim.x, blockIdx.x);
    EpiIn E{p.ws};
    pg8::gemm_phase<EpiIn, pg8::DenseOrder, true, true>(lds, 512, 512, 512, S, E);
}

struct BatchOrder {
    const char* A; const char* B; size_t bsA, bsB, tstepA, tstepB; int nM, nN, nunits, G, c;
    __device__ __forceinline__ bool next(int i, pg8::Unit& u) const {
        const long L = (long)i * G + c; if (L >= nunits) return false;
        const int per = nM * nN, bt = (int)L / per, rem = (int)L % per;
        u.pm = rem / nN; u.pn = rem % nN; u.e = bt; u.nvalid = 256; u.rows = nullptr; u.rmax = 255;
        u.A = A + (size_t)bt * bsA + (size_t)u.pm * tstepA; u.B = B + (size_t)bt * bsB + (size_t)u.pn * tstepB; return true;
    }
};
struct EpiE { static constexpr bool PERM = false; float* E;
    __device__ __forceinline__ void operator()(AccRef acc, const pg8::Unit& u, int wr, int wc, int fr, int fq) const {
#pragma unroll
        for (int ai = 0; ai < 2; ++ai)
#pragma unroll
            for (int m = 0; m < 4; ++m) {
                const int r = u.pm * 256 + ai * 128 + wr * 64 + m * 16 + fr;
#pragma unroll
                for (int n = 0; n < 2; ++n) *(f32x4*)(E + ((size_t)u.e * 1024 + r) * 128 + wc * 32 + n * 16 + fq * 4) = acc[ai][0][m][n];
            }
    } };
struct EpiCmp { static constexpr bool PERM = true; const float* b1p; bf16_t* HC;
    __device__ __forceinline__ void operator()(AccRef acc, const pg8::Unit& u, int wr, int wc, int fr, int fq) const {
        const int col = wc * 32 + 8 * fq;
        f32x4 b0 = (f32x4){0.f, 0.f, 0.f, 0.f}, b1 = b0;
#pragma unroll
        for (int part = 0; part < 8; ++part) { b0 += *(const f32x4*)(b1p + (u.e * 8 + part) * 128 + col); b1 += *(const f32x4*)(b1p + (u.e * 8 + part) * 128 + col + 4); }
#pragma unroll
        for (int ai = 0; ai < 2; ++ai)
#pragma unroll
            for (int m = 0; m < 4; ++m) {
                const int R = u.pm * 256 + ai * 128 + wr * 64 + m * 16 + fr;
                const f32x4 v0 = acc[ai][0][m][0] + b0, v1 = acc[ai][0][m][1] + b1;
                *(u32x4*)(HC + ((size_t)u.e * 4096 + R) * 128 + col) = (u32x4){pk2(gelu_tanh(v0[0]), gelu_tanh(v0[1])), pk2(gelu_tanh(v0[2]), gelu_tanh(v0[3])), pk2(gelu_tanh(v1[0]), gelu_tanh(v1[1])), pk2(gelu_tanh(v1[2]), gelu_tanh(v1[3]))};
            }
    } };
__device__ __forceinline__ void phase3(const Params& p, LAS unsigned char* lds) {
    const int G = gridDim.x;
    {
        BatchOrder S{(const char*)(p.ws + O_U), (const char*)(p.ws + O_W1T), (size_t)1024 * UROW * 2, (size_t)256 * 512 * 2, (size_t)256 * UROW * 2, 0, 4, 1, 128, G, (int)blockIdx.x};
        EpiE E{(float*)(p.ws + O_E)};
        pg8::gemm_phase<EpiE, BatchOrder, false>(lds, 512, UROW, 512, S, E);
    }
    {
        BatchOrder S{(const char*)(p.ws + O_KV), (const char*)(p.ws + O_WT_C1), (size_t)8 * KV_SLAB * 2, (size_t)256 * 2048 * 2, (size_t)256 * 1024 * 2, 0, 16, 1, 32, G, (int)((blockIdx.x + G - 128 % G) % G)};
        EpiCmp E{(const float*)(p.ws + O_BIAS1), (bf16_t*)(p.ws + O_HC)};
        pg8::gemm_phase<EpiCmp, BatchOrder, false>(lds, 2048, 1024, 2048, S, E);
    }
}
__device__ __forceinline__ void phase4(const Params& p, unsigned char* smem) {
    const int tid = threadIdx.x;
    for (int item = blockIdx.x; item < 16 + 512; item += gridDim.x) {
        if (item < 16) {
            f32x2* seg = (f32x2*)smem;
#pragma unroll 1
            for (int half = 0; half < 8; ++half) {
                const int n = tid & 63, sg = tid >> 6, bg = item * 8 + half, b = bg >> 5, g = bg & 31;
                const f32x2 lm = ((const f32x2*)(p.ws + O_LAML))[g * 64 + n];
                const float* E = (const float*)(p.ws + O_E) + (size_t)(g * 1024 + b * 256 + sg * 32) * 128;
                bf16_t* U = (bf16_t*)(p.ws + O_U) + (size_t)(g * 1024 + b * 256 + sg * 32) * UROW + 512;
                float er[32], ei[32];
#pragma unroll
                for (int c = 0; c < 32; ++c) { er[c] = E[(size_t)c * 128 + n]; ei[c] = E[(size_t)c * 128 + 64 + n]; }
                float hr = 0.f, hi = 0.f;
#pragma unroll
                for (int c = 0; c < 32; ++c) { const float nr = lm.x * hr - lm.y * hi + er[c], ni = lm.x * hi + lm.y * hr + ei[c]; hr = nr; hi = ni; }
                seg[sg * 64 + n] = (f32x2){hr, hi};
                float pr = lm.x, pi = lm.y;
#pragma unroll
                for (int q = 0; q < 5; ++q) { const float nr = pr * pr - pi * pi, ni = 2.f * pr * pi; pr = nr; pi = ni; }
                __syncthreads();
                float sr = 0.f, si = 0.f;
                for (int k = 0; k < sg; ++k) { const f32x2 a = seg[k * 64 + n]; const float nr = pr * sr - pi * si + a.x, ni = pr * si + pi * sr + a.y; sr = nr; si = ni; }
                hr = sr; hi = si;
#pragma unroll
                for (int c = 0; c < 32; ++c) {
                    U[(size_t)c * UROW + n] = f2bf(hr); U[(size_t)c * UROW + 64 + n] = f2bf(hi);
                    const float nr = lm.x * hr - lm.y * hi + er[c], ni = lm.x * hi + lm.y * hr + ei[c]; hr = nr; hi = ni;
                }
                __syncthreads();
            }
        } else {
#pragma unroll 1
            for (int rep = 0; rep < 2; ++rep) {
                const int o = ((item - 16) * 2 + rep) * NT + tid, d = o & 63, R = (o >> 6) & 4095, kv = o >> 18;
                const bf16_t* h = (const bf16_t*)(p.ws + O_HC) + ((size_t)kv * 4096 + R) * 128;
                const float* w2 = p.in[kv ? 21 : 18];
                float a = 0.f;
#pragma unroll 8
                for (int j = 0; j < 128; ++j) a += bf2f(h[j]) * w2[j * 64 + d];
                const int bgi = R >> 9, n = R & 511;
                if (kv == 0) ((bf16_t*)(p.ws + O_KC))[(size_t)bgi * 512 * 64 + (size_t)((n >> 5) * 4 + (d >> 4)) * 512 + (((d >> 3) & 1) * 32 + (n & 31)) * 8 + (d & 7)] = f2bf(a);
                else { const int p64 = n & 63, p16 = p64 & 15, slot = (p16 & 3) | ((p16 & 4) << 1) | ((p16 & 8) >> 1);
                       ((bf16_t*)(p.ws + O_KC))[(size_t)4096 * 64 + (size_t)bgi * 64 * 512 + (size_t)(n >> 6) * 4096 + ((((d >> 5) * 2 + (p64 >> 5)) * 2 + ((p64 >> 4) & 1)) * 64 + (slot >> 3) * 32 + (d & 31)) * 8 + (slot & 7)] = f2bf(a); }
            }
        }
    }
}
struct EpiY { static constexpr bool PERM = true; unsigned char* YS;
    __device__ __forceinline__ void operator()(AccRef acc, const pg8::Unit& u, int wr, int wc, int fr, int fq) const {
#pragma unroll
        for (int ai = 0; ai < 2; ++ai)
#pragma unroll
            for (int m = 0; m < 4; ++m) {
                const int r = u.pm * 256 + ai * 128 + wr * 64 + m * 16 + fr;
                const int tok0 = (r >> 8) * SEQ + (r & 255) * S5L;
#pragma unroll
                for (int bj = 0; bj < 2; ++bj) {
                    const int col = u.pn * 256 + bj * 128 + wc * 32 + 8 * fq, tau = col >> 4, pp = col & 15;
                    const f32x4 v0 = acc[ai][bj][m][0], v1 = acc[ai][bj][m][1];
                    *(u32x2*)(YS + (size_t)(tok0 + tau) * 512 + u.e * 16 + pp) = (u32x2){pk4_f8(gelu_tanh(v0[0]) * YS_SCALE, gelu_tanh(v0[1]) * YS_SCALE, gelu_tanh(v0[2]) * YS_SCALE, gelu_tanh(v0[3]) * YS_SCALE),
                                                                                                    pk4_f8(gelu_tanh(v1[0]) * YS_SCALE, gelu_tanh(v1[1]) * YS_SCALE, gelu_tanh(v1[2]) * YS_SCALE, gelu_tanh(v1[3]) * YS_SCALE)};
                }
            }
    } };
__device__ __forceinline__ void phase5(const Params& p, LAS unsigned char* lds) {
    BatchOrder S{(const char*)(p.ws + O_U), (const char*)(p.ws + O_TW2), (size_t)1024 * UROW * 2, (size_t)512 * UROW * 2, (size_t)256 * UROW * 2, (size_t)256 * UROW * 2, 4, 2, 256, (int)gridDim.x, (int)blockIdx.x};
    EpiY E{p.ws + O_YS};
    pg8::gemm_phase<EpiY, BatchOrder, false>(lds, UROW, UROW, UROW, S, E);
}
struct EpiGlu { static constexpr bool PERM = true; const float* bglu; const bf16_t* SG5; bf16_t* MS5;
    __device__ __forceinline__ void operator()(AccRef acc, const pg8::Unit& u, int wr, int wc, int fr, int fq) const {
        const int cv = u.pn * 128 + wc * 32 + 8 * fq;
        const f32x4 bv0 = *(const f32x4*)(bglu + cv), bv1 = *(const f32x4*)(bglu + cv + 4), bg0 = *(const f32x4*)(bglu + 1024 + cv), bg1 = *(const f32x4*)(bglu + 1024 + cv + 4);
#pragma unroll
        for (int ai = 0; ai < 2; ++ai) {
            u32x4 sgv[4];
#pragma unroll
            for (int m = 0; m < 4; ++m) sgv[m] = *(const u32x4*)(SG5 + (size_t)(u.pm * 256 + ai * 128 + wr * 64 + m * 16 + fr) * 1024 + cv);
#pragma unroll
            for (int m = 0; m < 4; ++m) {
                const int token = u.pm * 256 + ai * 128 + wr * 64 + m * 16 + fr;
                const u32x4 sg = sgv[m];
                constexpr float us_ = 1.f / (YS_SCALE * WGLU_SCALE);
                const f32x4 va0 = acc[ai][0][m][0] * us_ + bv0, va1 = acc[ai][0][m][1] * us_ + bv1, ga0 = acc[ai][1][m][0] * us_ + bg0, ga1 = acc[ai][1][m][1] * us_ + bg1;
                u32x4 o;
                o.x = pk2(va0[0] * sigmoidf_(ga0[0]) * bflo(sg.x), va0[1] * sigmoidf_(ga0[1]) * bfhi(sg.x)); o.y = pk2(va0[2] * sigmoidf_(ga0[2]) * bflo(sg.y), va0[3] * sigmoidf_(ga0[3]) * bfhi(sg.y));
                o.z = pk2(va1[0] * sigmoidf_(ga1[0]) * bflo(sg.z), va1[1] * sigmoidf_(ga1[1]) * bfhi(sg.z)); o.w = pk2(va1[2] * sigmoidf_(ga1[2]) * bflo(sg.w), va1[3] * sigmoidf_(ga1[3]) * bfhi(sg.w));
                *(u32x4*)(MS5 + (size_t)token * 1024 + cv) = o;
            }
        }
    } };
__device__ __forceinline__ void phase6(const Params& p, LAS unsigned char* lds) {
    pg8::DenseOrder S; S.init(p.ws + O_YS, p.ws + O_WT_GLU, NTOK, 2048, 256, 256, gridDim.x, blockIdx.x);
    EpiGlu E{p.in[15], (const bf16_t*)(p.ws + O_SG5), (bf16_t*)(p.ws + O_MS5)};
    pg8::gemm_phase<EpiGlu, pg8::DenseOrder, true, true>(lds, 256, 256, 256, S, E);
}
typedef float f32x16 __attribute__((ext_vector_type(16)));
__device__ __forceinline__ int rel_bucket_dev(int dist) {
    const int n = dist > 0 ? dist : 0;
    if (n < 16) return n;
    const int l = (int)(__log2f((float)n * 0.0625f) * 2.6666667f);
    const int v = 16 + l;
    return v < 31 ? v : 31;
}
__device__ __forceinline__ float xhalf_max(float v) { auto rr = __builtin_amdgcn_permlane32_swap(__float_as_uint(v), __float_as_uint(v), false, false); return fmaxf(__uint_as_float(rr[0]), __uint_as_float(rr[1])); }
__device__ __forceinline__ float xhalf_sum(float v) { auto rr = __builtin_amdgcn_permlane32_swap(__float_as_uint(v), __float_as_uint(v), false, false); return __uint_as_float(rr[0]) + __uint_as_float(rr[1]); }
__device__ __forceinline__ float quad_sum(float v) {
    v += __uint_as_float(__builtin_amdgcn_update_dpp(0u, __float_as_uint(v), 0xB1, 0xF, 0xF, true));
    v += __uint_as_float(__builtin_amdgcn_update_dpp(0u, __float_as_uint(v), 0x4E, 0xF, 0xF, true));
    return v;
}
constexpr int LSW = 1168;
constexpr int LWW = 656;
constexpr float RESC_THR = 6.f;
constexpr int IMPW = 132;
constexpr float NEG_BIG = -1e30f;

typedef int v4i_t __attribute__((ext_vector_type(4)));
typedef __amdgpu_buffer_rsrc_t rsrc_t;
__device__ __forceinline__ bf16x8 bload16(rsrc_t r, unsigned voff, unsigned soff) { return __builtin_bit_cast(bf16x8, __builtin_amdgcn_raw_buffer_load_b128(r, (int)voff, (int)soff, 0)); }
__device__ __forceinline__ void load_k(bf16x8 (&kf)[8], rsrc_t r, unsigned soff, unsigned voff) {
#pragma unroll
    for (int i = 0; i < 8; ++i) kf[i] = bload16(r, voff, soff + i * 1024);
}
__device__ __forceinline__ void load_v(bf16x8 (&vf)[8], rsrc_t r, unsigned soff, unsigned voff) {
#pragma unroll
    for (int i = 0; i < 8; ++i) vf[i] = bload16(r, voff, soff + i * 1024);
}
__device__ __forceinline__ void qk_block(f32x16 (&st)[2], const bf16x8 (&qf)[4], const bf16x8 (&kf)[8], float cinit) {
#pragma unroll
    for (int sub = 0; sub < 2; ++sub) {
        f32x16 acc;
#pragma unroll
        for (int r = 0; r < 16; ++r) acc[r] = cinit;
#pragma unroll
        for (int s = 0; s < 4; ++s) acc = __builtin_amdgcn_mfma_f32_32x32x16_bf16(kf[sub * 4 + s], qf[s], acc, 0, 0, 0);
        st[sub] = acc;
    }
}
__device__ __forceinline__ void bias_lut(f32x16 (&st)[2], const float* p) {
#pragma unroll
    for (int sub = 0; sub < 2; ++sub)
#pragma unroll
        for (int r = 0; r < 16; ++r) st[sub][r] += p[59 - (32 * sub + (r & 3) + 8 * (r >> 2))];
}
__device__ __forceinline__ void bias_mask_cmp(f32x16 (&st)[2], int dist0, const float* lutS) {
#pragma unroll
    for (int sub = 0; sub < 2; ++sub) {
        float bias[16];
#pragma unroll
        for (int r = 0; r < 16; ++r) {
            const int dist = dist0 - 16 * (32 * sub + (r & 3) + 8 * (r >> 2));
            const int idx = dist < 0 ? 0 : (dist > 1024 ? 1024 : dist);
            bias[r] = lutS[64 + idx];
        }
#pragma unroll
        for (int r = 0; r < 16; ++r) {
            const int dist = dist0 - 16 * (32 * sub + (r & 3) + 8 * (r >> 2));
            const float v = st[sub][r] + bias[r];
            st[sub][r] = dist >= 0 ? v : -INFINITY;
        }
    }
}
__device__ __forceinline__ float tile_max(const f32x16 (&st)[2]) {
    float a = __builtin_fmaxf(__builtin_fmaxf(st[0][0], st[0][1]), st[1][0]), b2 = __builtin_fmaxf(__builtin_fmaxf(st[0][2], st[0][3]), st[1][1]);
    a = __builtin_fmaxf(__builtin_fmaxf(a, st[1][2]), st[1][3]);
#pragma unroll
    for (int r = 4; r < 16; r += 4) {
        a = __builtin_fmaxf(__builtin_fmaxf(a, st[0][r]), st[0][r + 1]); b2 = __builtin_fmaxf(__builtin_fmaxf(b2, st[0][r + 2]), st[0][r + 3]);
        a = __builtin_fmaxf(__builtin_fmaxf(a, st[1][r]), st[1][r + 1]); b2 = __builtin_fmaxf(__builtin_fmaxf(b2, st[1][r + 2]), st[1][r + 3]);
    }
    return xhalf_max(__builtin_fmaxf(a, b2));
}
__device__ __forceinline__ void pv_block(f32x16 (&O)[2], const f32x16 (&st)[2], const bf16x8 (&vf)[8]) {
    bf16x8 pf[2][2];
#pragma unroll
    for (int sub = 0; sub < 2; ++sub)
#pragma unroll
        for (int s2 = 0; s2 < 2; ++s2) {
            u32x4 w;
            w.x = pk2(st[sub][8 * s2 + 0], st[sub][8 * s2 + 1]); w.y = pk2(st[sub][8 * s2 + 2], st[sub][8 * s2 + 3]);
            w.z = pk2(st[sub][8 * s2 + 4], st[sub][8 * s2 + 5]); w.w = pk2(st[sub][8 * s2 + 6], st[sub][8 * s2 + 7]);
            pf[sub][s2] = __builtin_bit_cast(bf16x8, w);
        }
#pragma unroll
    for (int dt = 0; dt < 2; ++dt)
#pragma unroll
        for (int sub = 0; sub < 2; ++sub)
#pragma unroll
            for (int s2 = 0; s2 < 2; ++s2) O[dt] = __builtin_amdgcn_mfma_f32_32x32x16_bf16(vf[dt * 4 + sub * 2 + s2], pf[sub][s2], O[dt], 0, 0, 0);
}
__device__ __forceinline__ void softmax_step(f32x16 (&st)[2], f32x16 (&O)[2], float& m, float& l) {
    const float mx = tile_max(st);
    if (__any(mx > RESC_THR)) {
        const float dl = mx > 0.f ? mx : 0.f;
        const float corr = __builtin_amdgcn_exp2f(-dl);
        m += dl; l *= corr;
#pragma unroll
        for (int sub = 0; sub < 2; ++sub)
#pragma unroll
            for (int r = 0; r < 16; ++r) st[sub][r] -= dl;
#pragma unroll
        for (int dt = 0; dt < 2; ++dt)
#pragma unroll
            for (int r = 0; r < 16; ++r) O[dt][r] *= corr;
    }
    float sum = 0.f;
#pragma unroll
    for (int sub = 0; sub < 2; ++sub)
#pragma unroll
        for (int r = 0; r < 16; ++r) { const float pe = __builtin_amdgcn_exp2f(st[sub][r]); st[sub][r] = pe; sum += pe; }
    l += sum;
}

constexpr int FLW = 68;
__device__ __forceinline__ void kv_step(f32x16 (&O)[2], float& m, float& l, const bf16x8 (&qf)[4], const bf16x8 (&kf)[8], bf16x8 (&kn)[8], rsrc_t rv, unsigned ksoff_next, unsigned koff,
                                        unsigned vsoff_blk, unsigned vvoff, const float* lutp, bool selme, float b31) {
    bf16x8 vf[8];
    load_v(vf, rv, vsoff_blk, vvoff);
    f32x16 st[2];
    qk_block(st, qf, kf, selme ? (lutp ? -m : b31 - m) : -INFINITY);
    __builtin_amdgcn_sched_barrier(0);
    load_k(kn, rv, ksoff_next, koff);
    if (lutp) bias_lut(st, lutp);
    softmax_step(st, O, m, l);
    pv_block(O, st, vf);
}

__device__ __forceinline__ void nsa_tile(const Params& p, int bg, int tg, const float* lutSall, const float* lutWall, float* impw, float* fl, int lane) {
    asm volatile("" : "+v"(lane));
    const int q = lane & 31, h2 = lane >> 5, tok = q >> 2, head = q & 3;
    const int b = bg >> 1, g = bg & 1, t0 = tg * 8, t = t0 + tok, token = b * SEQ + t;
    const float* lutS = lutSall + head * LSW;
    const float* lutW = lutWall + head * LWW;
    const float b31 = lutS[64 + 1024];
    bf16x8 qf[4];
    { const bf16_t* qp = (const bf16_t*)(p.ws + O_Q) + (size_t)token * 512 + (g * 4 + head) * 64 + 8 * h2;
#pragma unroll
      for (int s = 0; s < 4; ++s) qf[s] = *(const bf16x8*)(qp + 16 * s); }
    const float* gn = (const float*)(p.ws + O_GN) + (size_t)token * 24 + (g * 4 + head) * 3;
    float* flp = fl + q * FLW + 4 * h2;
    f32x16 O[2];
#pragma unroll
    for (int dt = 0; dt < 2; ++dt)
#pragma unroll
        for (int r = 0; r < 16; ++r) O[dt][r] = 0.f;
    const int cur = t0 >> 6;
    { const int u = head + 4 * h2;
#pragma unroll
      for (int i = 0; i < 16; ++i) impw[tok * IMPW + i * 8 + u] = 0.f; }
    WAVE_SYNC();
    bf16x8 kfA[8], kfB[8];
    const rsrc_t rKV = __builtin_amdgcn_make_buffer_rsrc((void*)(p.ws + O_KV), 0, (int)(6 * 8 * KV_SLAB * 2 + 8192), 0x00020000);
    const rsrc_t rKC = __builtin_amdgcn_make_buffer_rsrc((void*)(p.ws + O_KC), 0, (int)(2 * 4096 * 64 * 2), 0x00020000);
    const unsigned koff = (unsigned)lane * 16u, vsoff = koff;

    {
        const unsigned Kc = (unsigned)bg * 512u * 64u * 2u;
        const unsigned VcT = (4096u * 64u + (unsigned)bg * 64u * 512u) * 2u;
        const int tl = t0 + 7;
        const int ncmax = tl >= 31 ? ((tl - 31) >> 4) + 1 : 0;
        const int nblk = (ncmax + 63) >> 6;
        float m = NEG_BIG, l = 0.f;
        f32x16 st[2];
#define CMP_FAR(BLK) (16 * (64 * (BLK) + 63) + 31 + 1024 <= t0)
#define CMP_P1(KF, KN, BLK, BN) do { const bool far_ = CMP_FAR(BLK); qk_block(st, qf, KF, far_ ? b31 : 0.f); __builtin_amdgcn_sched_barrier(0); load_k(KN, rKC, Kc + (BN) * 8192, koff); \
            if (!far_) bias_mask_cmp(st, t - 31 - 16 * ((BLK) * 64 + 4 * h2), lutS); \
            const float mn = fmaxf(m, tile_max(st)); float sum = 0.f; \
            _Pragma("unroll") for (int sub = 0; sub < 2; ++sub) _Pragma("unroll") for (int r = 0; r < 16; ++r) sum += __builtin_amdgcn_exp2f(st[sub][r] - mn); \
            l = l * __builtin_amdgcn_exp2f(m - mn) + sum; m = mn; } while (0)
        if (nblk > 0) load_k(kfA, rKC, Kc, koff);
#pragma unroll 1
        for (int blk = 0; blk < nblk; blk += 2) {
            const int b1 = blk + 1 < nblk ? blk + 1 : blk;
            CMP_P1(kfA, kfB, blk, b1);
            if (blk + 1 >= nblk) break;
            const int b2 = blk + 2 < nblk ? blk + 2 : blk + 1;
            CMP_P1(kfB, kfA, blk + 1, b2);
        }
#undef CMP_P1
        l = xhalf_sum(l);
        const float invl = l > 0.f ? 1.f / l : 0.f;
#define CMP_P2(KF, KN, BLK, BN) do { const bool far_ = CMP_FAR(BLK); bf16x8 vf[8]; load_v(vf, rKC, VcT + (BLK) * 8192, koff); \
            qk_block(st, qf, KF, (far_ ? b31 : 0.f) - m); __builtin_amdgcn_sched_barrier(0); load_k(KN, rKC, Kc + (BN) * 8192, koff); \
            if (!far_) bias_mask_cmp(st, t - 31 - 16 * ((BLK) * 64 + 4 * h2), lutS); \
            _Pragma("unroll") for (int sub = 0; sub < 2; ++sub) _Pragma("unroll") for (int r = 0; r < 16; ++r) st[sub][r] = __builtin_amdgcn_exp2f(st[sub][r]) * invl; \
            _Pragma("unroll") for (int sub = 0; sub < 2; ++sub) _Pragma("unroll") for (int a = 0; a < 4; ++a) { \
                const float L_ = quad_sum(st[sub][4 * a + 3]); \
                const float G_ = quad_sum((st[sub][4 * a] + st[sub][4 * a + 1]) + (st[sub][4 * a + 2] + st[sub][4 * a + 3])); \
                const int j_ = (BLK) * 16 + 8 * sub + 2 * a + h2; \
                if (head == 0) { atomicAdd(&impw[tok * IMPW + j_], G_); if (j_ + 1 < 128) atomicAdd(&impw[tok * IMPW + j_ + 1], L_); } } \
            pv_block(O, st, vf); } while (0)
        if (nblk > 0) load_k(kfA, rKC, Kc, koff);
#pragma unroll 1
        for (int blk = 0; blk < nblk; blk += 2) {
            const int b1 = blk + 1 < nblk ? blk + 1 : blk;
            CMP_P2(kfA, kfB, blk, b1);
            if (blk + 1 >= nblk) break;
            const int b2 = blk + 2 < nblk ? blk + 2 : blk + 1;
            CMP_P2(kfB, kfA, blk + 1, b2);
        }
#undef CMP_P2
#undef CMP_FAR
        const float g0 = gn[0];
#pragma unroll
        for (int dt = 0; dt < 2; ++dt)
#pragma unroll
            for (int a = 0; a < 4; ++a) {
                *(f32x4*)(flp + dt * 32 + a * 8) = (f32x4){g0 * O[dt][4 * a], g0 * O[dt][4 * a + 1], g0 * O[dt][4 * a + 2], g0 * O[dt][4 * a + 3]};
                O[dt][4 * a] = 0.f; O[dt][4 * a + 1] = 0.f; O[dt][4 * a + 2] = 0.f; O[dt][4 * a + 3] = 0.f;
            }
    }
    WAVE_SYNC();

    unsigned long long mlo, mhi;
    if (cur < 16) { mlo = (1ull << (cur + 1)) - 1ull; mhi = 0ull; }
    else {
        const int u = head + 4 * h2;
        float val[16];
#pragma unroll
        for (int i = 0; i < 16; ++i) { const int j = i * 8 + u; val[i] = (j >= 1 && j <= cur - 2) ? impw[tok * IMPW + j] : -1.f; }
        mlo = 1ull; mhi = 0ull;
        if (cur < 64) mlo |= 1ull << cur; else mhi |= 1ull << (cur - 64);
        if (cur - 1 < 64) mlo |= 1ull << (cur - 1); else mhi |= 1ull << (cur - 1 - 64);
#pragma unroll 1
        for (int round = 0; round < 13; ++round) {
            float bs = val[0]; int bj = u;
#pragma unroll
            for (int i = 1; i < 16; ++i) { if (val[i] > bs) { bs = val[i]; bj = i * 8 + u; } }
            { const float os = __uint_as_float(__builtin_amdgcn_update_dpp(0u, __float_as_uint(bs), 0xB1, 0xF, 0xF, true)); const int oj = __builtin_amdgcn_update_dpp(0, bj, 0xB1, 0xF, 0xF, true);
              if (os > bs || (os == bs && oj < bj)) { bs = os; bj = oj; } }
            { const float os = __uint_as_float(__builtin_amdgcn_update_dpp(0u, __float_as_uint(bs), 0x4E, 0xF, 0xF, true)); const int oj = __builtin_amdgcn_update_dpp(0, bj, 0x4E, 0xF, 0xF, true);
              if (os > bs || (os == bs && oj < bj)) { bs = os; bj = oj; } }
            { const float os = __shfl_xor(bs, 32); const int oj = __shfl_xor(bj, 32);
              if (os > bs || (os == bs && oj < bj)) { bs = os; bj = oj; } }
            if (bj < 64) mlo |= 1ull << bj; else mhi |= 1ull << (bj - 64);
#pragma unroll
            for (int i = 0; i < 16; ++i) if (i * 8 + u == bj) val[i] = -2.f;
        }
    }
    unsigned long long ulo = mlo, uhi = mhi;
#pragma unroll
    for (int o = 4; o < 32; o <<= 1) { ulo |= __shfl_xor(ulo, o); uhi |= __shfl_xor(uhi, o); }
    ulo = ((unsigned long long)__builtin_amdgcn_readfirstlane((unsigned)(ulo >> 32)) << 32) | (unsigned)__builtin_amdgcn_readfirstlane((unsigned)ulo);
    uhi = ((unsigned long long)__builtin_amdgcn_readfirstlane((unsigned)(uhi >> 32)) << 32) | (unsigned)__builtin_amdgcn_readfirstlane((unsigned)uhi);

    {
        const unsigned Ks = (unsigned)((2 * 4 + b) * 2 + g) * (unsigned)(KV_SLAB * 2);
        const unsigned VsT = (unsigned)((3 * 4 + b) * 2 + g) * (unsigned)(KV_SLAB * 2);
        float m = 0.f, l = 0.f;
#define POPJ(J) do { if (ulo) { J = __builtin_ctzll(ulo); ulo &= ulo - 1ull; } else if (uhi) { J = 64 + __builtin_ctzll(uhi); uhi &= uhi - 1ull; } else J = -1; } while (0)
#define SEL_STEP(KF, KN, J, JN) do { const bool selme_ = (J) < 64 ? ((mlo >> (J)) & 1ull) : ((mhi >> ((J) - 64)) & 1ull); \
            const bool near_ = (64 * (J) + 63 + 1024 > t0); \
            kv_step(O, m, l, qf, KF, KN, rKV, Ks + (JN) * 8192, koff, VsT + (J) * 8192, vsoff, near_ ? lutS + (t - 64 * (J) - 4 * h2 + 64 - 59) : nullptr, selme_, b31); } while (0)
        int ja, jb;
        POPJ(ja);
        load_k(kfA, rKV, Ks + ja * 8192, koff);
#pragma unroll 1
        for (;;) {
            POPJ(jb);
            { const int jn = jb >= 0 ? jb : ja; SEL_STEP(kfA, kfB, ja, jn); }
            if (jb < 0) break;
            POPJ(ja);
            { const int jn = ja >= 0 ? ja : jb; SEL_STEP(kfB, kfA, jb, jn); }
            if (ja < 0) break;
        }
#undef SEL_STEP
#undef POPJ
        l = xhalf_sum(l);
        const float sc = l > 0.f ? gn[1] / l : 0.f;
#pragma unroll
        for (int dt = 0; dt < 2; ++dt)
#pragma unroll
            for (int a = 0; a < 4; ++a) {
                f32x4 f = *(const f32x4*)(flp + dt * 32 + a * 8);
                f[0] += sc * O[dt][4 * a]; f[1] += sc * O[dt][4 * a + 1]; f[2] += sc * O[dt][4 * a + 2]; f[3] += sc * O[dt][4 * a + 3];
                *(f32x4*)(flp + dt * 32 + a * 8) = f;
                O[dt][4 * a] = 0.f; O[dt][4 * a + 1] = 0.f; O[dt][4 * a + 2] = 0.f; O[dt][4 * a + 3] = 0.f;
            }
    }
    {
        const unsigned Kw = (unsigned)((4 * 4 + b) * 2 + g) * (unsigned)(KV_SLAB * 2);
        const unsigned VwT = (unsigned)((5 * 4 + b) * 2 + g) * (unsigned)(KV_SLAB * 2);
        float m = 0.f, l = 0.f;
        const int wlo = t0 - 511;
        const int r_begin = (wlo > 0 ? wlo : 0) & ~63;
        const int r_last = t0 + 7;
#define WIN_STEP(KF, KN, R0, RN) kv_step(O, m, l, qf, KF, KN, rKV, Kw + (RN) * 128, koff, VwT + (R0) * 128, vsoff, lutW + (t - (R0) - 4 * h2 + 72 - 59), true, b31)
        load_k(kfA, rKV, Kw + r_begin * 128, koff);
#pragma unroll 1
        for (int row0 = r_begin; row0 <= r_last; row0 += 128) {
            { const int rn = row0 + 64 <= r_last ? row0 + 64 : row0; WIN_STEP(kfA, kfB, row0, rn); }
            if (row0 + 64 > r_last) break;
            { const int rn = row0 + 128 <= r_last ? row0 + 128 : row0 + 64; WIN_STEP(kfB, kfA, row0 + 64, rn); }
        }
#undef WIN_STEP
        l = xhalf_sum(l);
        const float sc = l > 0.f ? gn[2] / l : 0.f;
        unsigned char* op = p.ws + O_ONSA + (size_t)token * 512 + (g * 4 + head) * 64 + 4 * h2;
#pragma unroll
        for (int dt = 0; dt < 2; ++dt)
#pragma unroll
            for (int a = 0; a < 4; ++a) {
                const f32x4 f = *(const f32x4*)(flp + dt * 32 + a * 8);
                *(unsigned*)(op + dt * 32 + a * 8) = pk4_f8((f[0] + sc * O[dt][4 * a]) * ONSA_SCALE, (f[1] + sc * O[dt][4 * a + 1]) * ONSA_SCALE, (f[2] + sc * O[dt][4 * a + 2]) * ONSA_SCALE, (f[3] + sc * O[dt][4 * a + 3]) * ONSA_SCALE);
            }
    }
    WAVE_SYNC();
}

__device__ __forceinline__ void phase7(const Params& p, unsigned char* smem) {
    const int tid = threadIdx.x, lane = tid & 63, wid = __builtin_amdgcn_readfirstlane(tid >> 6);
    float* lutS = (float*)smem;
    float* lutW = lutS + 4 * LSW;
    float* impw = lutW + 4 * LWW + wid * 8 * IMPW;
    float* fl = lutW + 4 * LWW + NWV * 8 * IMPW + wid * 32 * FLW;
    const int bg = blockIdx.x & 7, g = bg & 1;
    for (int i = tid; i < 4 * LSW; i += NT) { const int head = i / LSW, dist = i % LSW - 64;
        lutS[i] = dist < 0 ? -INFINITY : p.in[2][rel_bucket_dev(dist) * 8 + g * 4 + head] * LOG2E; }
    for (int i = tid; i < 4 * LWW; i += NT) { const int head = i / LWW, dist = i % LWW - 72;
        lutW[i] = (dist < 0 || dist >= 512) ? -INFINITY : p.in[2][rel_bucket_dev(dist) * 8 + g * 4 + head] * LOG2E; }
    __syncthreads();
    const int nblk_bg = (gridDim.x - bg + 7) >> 3;
    const int W = nblk_bg * NWV, w = (blockIdx.x >> 3) * NWV + wid;
#pragma unroll 1
    for (int round = 0; ; ++round) {
        const int idx = round * W + ((round & 1) ? (W - 1 - w) : w);
        if (idx >= 1024) break;
        nsa_tile(p, bg, 1023 - idx, lutS, lutW, impw, fl, lane);
    }
    __syncthreads();
}

struct EpiNsa { static constexpr bool PERM = true; const bf16_t* SGN; const bf16_t* MS5; unsigned char* MRG;
    __device__ __forceinline__ void operator()(AccRef acc, const pg8::Unit& u, int wr, int wc, int fr, int fq) const {
        constexpr float us_ = 1.f / (ONSA_SCALE * WNSA_SCALE);
#pragma unroll
        for (int ai = 0; ai < 2; ++ai)
#pragma unroll
            for (int mh = 0; mh < 4; mh += 2) {
                u32x4 sgv[2][2], msv[2][2];
#pragma unroll
                for (int m = 0; m < 2; ++m)
#pragma unroll
                    for (int bj = 0; bj < 2; ++bj) {
                        const size_t off = (size_t)(u.pm * 256 + ai * 128 + wr * 64 + (mh + m) * 16 + fr) * 1024 + u.pn * 256 + bj * 128 + wc * 32 + 8 * fq;
                        sgv[m][bj] = *(const u32x4*)(SGN + off); msv[m][bj] = *(const u32x4*)(MS5 + off);
                    }
#pragma unroll
                for (int m = 0; m < 2; ++m)
#pragma unroll
                    for (int bj = 0; bj < 2; ++bj) {
                        const size_t off = (size_t)(u.pm * 256 + ai * 128 + wr * 64 + (mh + m) * 16 + fr) * 1024 + u.pn * 256 + bj * 128 + wc * 32 + 8 * fq;
                        const u32x4 sg = sgv[m][bj], ms = msv[m][bj];
                        const f32x4 v0 = acc[ai][bj][mh + m][0] * us_, v1 = acc[ai][bj][mh + m][1] * us_;
                        *(u32x2*)(MRG + off) = (u32x2){pk4_f8((bflo(ms.x) + bflo(sg.x) * v0[0]) * MRG_SCALE, (bfhi(ms.x) + bfhi(sg.x) * v0[1]) * MRG_SCALE, (bflo(ms.y) + bflo(sg.y) * v0[2]) * MRG_SCALE, (bfhi(ms.y) + bfhi(sg.y) * v0[3]) * MRG_SCALE),
                                                       pk4_f8((bflo(ms.z) + bflo(sg.z) * v1[0]) * MRG_SCALE, (bfhi(ms.z) + bfhi(sg.z) * v1[1]) * MRG_SCALE, (bflo(ms.w) + bflo(sg.w) * v1[2]) * MRG_SCALE, (bfhi(ms.w) + bfhi(sg.w) * v1[3]) * MRG_SCALE)};
                    }
            }
    } };
__device__ __forceinline__ void phase8(const Params& p, LAS unsigned char* lds) {
    pg8::DenseOrder S; S.init(p.ws + O_ONSA, p.ws + O_WT_NSA, NTOK, 1024, 256, 256, gridDim.x, blockIdx.x);
    EpiNsa E{(const bf16_t*)(p.ws + O_SGN), (const bf16_t*)(p.ws + O_MS5), p.ws + O_YS};
    pg8::gemm_phase<EpiNsa, pg8::DenseOrder, true, true>(lds, 256, 256, 256, S, E);
}
struct EpiOut { static constexpr bool PERM = true; const float* ada; bf16_t* Y;
    __device__ __forceinline__ void operator()(AccRef acc, const pg8::Unit& u, int wr, int wc, int fr, int fq) const {
        const float* ga = ada + (u.pm >> 5) * 6144 + 2048;
        f32x4 gv[2][2];
#pragma unroll
        for (int bj = 0; bj < 2; ++bj) { const int col = u.pn * 256 + bj * 128 + wc * 32 + 8 * fq; gv[bj][0] = *(const f32x4*)(ga + col); gv[bj][1] = *(const f32x4*)(ga + col + 4); }
#pragma unroll
        for (int ai = 0; ai < 2; ++ai)
#pragma unroll
            for (int m = 0; m < 4; ++m) {
                const int token = u.pm * 256 + ai * 128 + wr * 64 + m * 16 + fr;
#pragma unroll
                for (int bj = 0; bj < 2; ++bj) {
                    const int col = u.pn * 256 + bj * 128 + wc * 32 + 8 * fq;
                    const f32x4 v0 = acc[ai][bj][m][0] * gv[bj][0] * (1.f / (MRG_SCALE * WOUT_SCALE)), v1 = acc[ai][bj][m][1] * gv[bj][1] * (1.f / (MRG_SCALE * WOUT_SCALE));
                    *(u32x4*)(Y + (size_t)token * 1024 + col) = (u32x4){pk2(v0[0], v0[1]), pk2(v0[2], v0[3]), pk2(v1[0], v1[1]), pk2(v1[2], v1[3])};
                }
            }
    } };
__device__ __forceinline__ void phase9(const Params& p, LAS unsigned char* lds) {
    pg8::DenseOrder S; S.init(p.ws + O_YS, p.ws + O_WT_OUT, NTOK, 1024, 512, 512, gridDim.x, blockIdx.x);
    EpiOut E{(const float*)(p.ws + O_ADA), (bf16_t*)(p.ws + O_SG5)};
    pg8::gemm_phase<EpiOut, pg8::DenseOrder, true, true>(lds, 512, 512, 512, S, E);
}

__device__ __forceinline__ void phase10(const Params& p, unsigned char* smem) {
    typedef float f32x16_t __attribute__((ext_vector_type(16)));
    constexpr int HSW = 1025;
    const int tid = threadIdx.x, lane = tid & 63, wid = __builtin_amdgcn_readfirstlane(tid >> 6);
    float* hsb = (float*)smem;
    int* lcnt = (int*)(smem + 32 * HSW * 4);
    int* lbase = lcnt + 32;
    int* lsel = lcnt + 64;
    float* lgate = (float*)(lsel + 4 * 256);
    const float* lg = p.in[24]; const float* lb = p.in[25]; const float* wr_ = p.in[26]; const float* br_ = p.in[27];
    unsigned* cnt = (unsigned*)(p.ws + O_CNT);
    if (tid < 32) lcnt[tid] = 0;
    __syncthreads();
    int nstep = 0;
#pragma unroll 1
    for (int grp = blockIdx.x; grp < NTOK / 32; grp += gridDim.x, ++nstep) {
#pragma unroll 1
        for (int i = 0; i < 4; ++i) {
            const int lt = wid * 4 + i, token = grp * 32 + lt, b = token >> 13;
            float* zr = (float*)(p.ws + O_Z1) + (size_t)token * 1024;
            const float* xr = p.in[0] + (size_t)token * 1024;
            const bf16_t* yr = (const bf16_t*)(p.ws + O_SG5) + (size_t)token * 1024;
            const float* ada = (const float*)(p.ws + O_ADA) + b * 6144;
            f32x4 v[4]; float sm = 0.f;
#pragma unroll
            for (int j = 0; j < 4; ++j) { const u32x2 yv = *(const u32x2*)(yr + j * 256 + lane * 4); const f32x4 xv = *(const f32x4*)(xr + j * 256 + lane * 4);
                v[j] = xv * DN_ALPHA + (f32x4){bflo(yv.x), bfhi(yv.x), bflo(yv.y), bfhi(yv.y)}; sm += (v[j][0] + v[j][1]) + (v[j][2] + v[j][3]); }
            const float mean = wave_sum(sm) * (1.f / 1024.f); float q = 0.f;
#pragma unroll
            for (int j = 0; j < 4; ++j) { v[j] = v[j] - mean; q += (v[j][0] * v[j][0] + v[j][1] * v[j][1]) + (v[j][2] * v[j][2] + v[j][3] * v[j][3]); }
            const float rstd = rsqrtf(wave_sum(q) * (1.f / 1024.f) + LN_EPS);
            unsigned char* h2 = p.ws + O_H2 + (size_t)token * 1024;
#pragma unroll
            for (int j = 0; j < 4; ++j) {
                const int c = j * 256 + lane * 4;
                const f32x4 x1 = v[j] * rstd * *(const f32x4*)(lg + c) + *(const f32x4*)(lb + c);
                *(f32x4*)(zr + c) = x1;
                const f32x4 hv = x1 * (*(const f32x4*)(ada + 4096 + c) + 1.f) + *(const f32x4*)(ada + 3072 + c);
                float* hd = hsb + lt * HSW + c; hd[0] = hv[0]; hd[1] = hv[1]; hd[2] = hv[2]; hd[3] = hv[3];
                *(unsigned*)(h2 + c) = pk4_f8(hv[0], hv[1], hv[2], hv[3]);
            }
        }
        __syncthreads();
        f32x16_t acc;
#pragma unroll
        for (int r = 0; r < 16; ++r) acc[r] = 0.f;
        { const float* ap = hsb + (lane & 31) * HSW + wid * 128 + (lane >> 5);
          const float* bp = wr_ + (size_t)(wid * 128 + (lane >> 5)) * 32 + (lane & 31);
#pragma unroll 8
          for (int j = 0; j < 64; ++j) acc = __builtin_amdgcn_mfma_f32_32x32x2f32(ap[2 * j], bp[(size_t)2 * j * 32], acc, 0, 0, 0); }
        __syncthreads();
        { float* pt = hsb + wid * 1024 + (lane & 31);
#pragma unroll
          for (int r = 0; r < 16; ++r) pt[((r & 3) + 8 * (r >> 2) + 4 * (lane >> 5)) * 32] = acc[r]; }
        __syncthreads();
        { float* lgt = hsb + 8192;
#pragma unroll
          for (int i = 0; i < 2; ++i) { const int o = tid * 2 + i; float sum = 0.f;
#pragma unroll
              for (int w = 0; w < 8; ++w) sum += hsb[w * 1024 + o];
              lgt[o] = sum + br_[o & 31]; } }
        __syncthreads();
#pragma unroll 1
        for (int rr = 0; rr < 2; ++rr) {
            const int e = lane & 31, lt = wid * 4 + rr * 2 + (lane >> 5);
            float val = hsb[8192 + lt * 32 + e]; int te[4]; float tv[4];
#pragma unroll
            for (int r = 0; r < 4; ++r) {
                float bs = val; int bj = e;
#pragma unroll
                for (int o = 1; o < 32; o <<= 1) { const float os = __shfl_xor(bs, o); const int oj = __shfl_xor(bj, o); if (os > bs || (os == bs && oj < bj)) { bs = os; bj = oj; } }
                te[r] = bj; tv[r] = bs;
                if (e == bj) val = -INFINITY;
            }
            const float e0 = 1.f, e1 = __expf(tv[1] - tv[0]), e2 = __expf(tv[2] - tv[0]), e3 = __expf(tv[3] - tv[0]);
            const float inv = 1.f / (e0 + e1 + e2 + e3);
            if (e < 4) {
                const int ee = e == 0 ? te[0] : (e == 1 ? te[1] : (e == 2 ? te[2] : te[3]));
                const float gg = (e == 0 ? e0 : (e == 1 ? e1 : (e == 2 ? e2 : e3))) * inv;
                const int rk = atomicAdd(&lcnt[ee], 1);
                lsel[(nstep * 32 + lt) * 4 + e] = ee | (rk << 8);
                lgate[(nstep * 32 + lt) * 4 + e] = gg;
            }
        }
        __syncthreads();
    }
    if (tid < 32) lbase[tid] = (int)atomicAdd(cnt + tid * 32, (unsigned)lcnt[tid]);
    __syncthreads();
    {
        for (int i = tid; i < nstep * 32 * 4; i += NT) {
            const int li = i >> 2, kk = i & 3, st = li >> 5, lt = li & 31;
            const int token = (blockIdx.x + st * gridDim.x) * 32 + lt;
            const int sv = lsel[i], ee = sv & 255, pos = lbase[ee] + (sv >> 8);
            ((int*)(p.ws + O_TOPE))[token * 4 + kk] = ee;
            ((unsigned*)(p.ws + O_TOPP))[token * 4 + kk] = (unsigned)pos;
            ((int*)(p.ws + O_ROWTOK))[(size_t)ee * NTOK + pos] = token * 4 + kk;
            ((float*)(p.ws + O_ROWGATE))[(size_t)ee * NTOK + pos] = lgate[i];
        }
    }
    __syncthreads();
    convert_weights(p, smem, TR_ITEMS - TR_GU - TR_DN, TR_ITEMS, (unsigned*)(p.ws + O_BAR) + 3410);
}

__device__ __forceinline__ void load_offsets(const Params& p, int* offs  , int* toff  ) {
    if (threadIdx.x < 64) {
        const int lane = threadIdx.x;
        const int c = lane < 32 ? (int)((const unsigned*)(p.ws + O_CNT))[lane * 32] : 0;
        int a = c, t = (c + 255) >> 8;
#pragma unroll
        for (int o = 1; o < 32; o <<= 1) { const int ua = __shfl_up(a, o), ut = __shfl_up(t, o); if ((lane & 31) >= o) { a += ua; t += ut; } }
        if (lane < 32) { offs[lane] = a - c; toff[lane] = t - ((c + 255) >> 8); if (lane == 31) { offs[32] = a; toff[32] = t; } }
    }
    __syncthreads();
}
struct MoeOrder {
    const int* offs; const int* toff; const char* A; const char* B; const int* rowtok; size_t bsB; int nN, G, c;
    __device__ __forceinline__ bool next(int i, pg8::Unit& u) const {
        const int v = (G % 8 == 0) ? (c % 8) * (G / 8) + c / 8 : c;
        const long L = (long)i * G + v; if (L >= (long)toff[32] * nN) return false;
        const int tile = (int)L / nN, pn = (int)L % nN;
        int e = 0;
#pragma unroll 1
        while (toff[e + 1] <= tile) ++e;
        e = __builtin_amdgcn_readfirstlane(e);
        const int r0 = __builtin_amdgcn_readfirstlane(offs[e] + (tile - toff[e]) * 256);
        u.pm = r0; u.pn = pn; u.e = e; u.nvalid = __builtin_amdgcn_readfirstlane(offs[e + 1]) - r0;
        u.gidx = e * NTOK + (tile - toff[e]) * 256;
        if (rowtok) { u.A = A; u.rows = rowtok + u.gidx; const int rm = u.nvalid - 1; u.rmax = rm < 255 ? rm : 255; }
        else { u.A = A + (size_t)r0 * 1024; u.rows = nullptr; u.rmax = 255; }
        u.B = B + (size_t)e * bsB + (size_t)pn * 256 * 1024; return true;
    }
};
struct EpiGU { static constexpr bool PERM = true; const float* bgu; unsigned char* ACT;
    __device__ __forceinline__ void operator()(AccRef acc, const pg8::Unit& u, int wr, int wc, int fr, int fq) const {
        const int cv = u.pn * 128 + wc * 32 + 8 * fq;
        const float* bb = bgu + (size_t)u.e * 2048;
        const float ws_ = 1.f / WGU_SCALE;
        const f32x4 bg0 = *(const f32x4*)(bb + cv), bg1 = *(const f32x4*)(bb + cv + 4), bu0 = *(const f32x4*)(bb + 1024 + cv), bu1 = *(const f32x4*)(bb + 1024 + cv + 4);
#pragma unroll
        for (int ai = 0; ai < 2; ++ai)
#pragma unroll
            for (int m = 0; m < 4; ++m) {
                const int lr = ai * 128 + wr * 64 + m * 16 + fr;
                const int row = lr < u.nvalid ? u.pm + lr : NROWS + lr;
                const f32x4 ga0 = acc[ai][0][m][0] * ws_ + bg0, ga1 = acc[ai][0][m][1] * ws_ + bg1, ua0 = acc[ai][1][m][0] * ws_ + bu0, ua1 = acc[ai][1][m][1] * ws_ + bu1;
                float o[8];
#pragma unroll
                for (int j = 0; j < 4; ++j) {
                    const float gt0 = __builtin_fminf(ga0[j], 7.f), up0 = __builtin_fminf(__builtin_fmaxf(ua0[j], -7.f), 7.f); o[j] = (up0 + 1.f) * gt0 * sigmoidf_(1.702f * gt0);
                    const float gt1 = __builtin_fminf(ga1[j], 7.f), up1 = __builtin_fminf(__builtin_fmaxf(ua1[j], -7.f), 7.f); o[4 + j] = (up1 + 1.f) * gt1 * sigmoidf_(1.702f * gt1);
                }
                *(u32x2*)(ACT + (size_t)row * 1024 + cv) = (u32x2){pk4_f8(o[0], o[1], o[2], o[3]), pk4_f8(o[4], o[5], o[6], o[7])};
            }
    } };
__device__ __forceinline__ void phase12(const Params& p, unsigned char* smem, LAS unsigned char* lds) {
    int* offs = (int*)(smem + LDS_TAB); int* toff = offs + 40;
    load_offsets(p, offs, toff);
    MoeOrder S{offs, toff, (const char*)(p.ws + O_H2), (const char*)(p.ws + O_WT_GU), (const int*)(p.ws + O_ROWTOK), (size_t)2048 * 1024, 8, (int)gridDim.x, (int)blockIdx.x};
    EpiGU E{p.in[29], p.ws + O_ACT};
    pg8::gemm_phase<EpiGU, MoeOrder, true, true>(lds, 512, 512, 512, S, E);
    __syncthreads();
}
struct EpiDn { static constexpr bool PERM = true; const float* bd; const float* rowgate; const int* rowtok; bf16_t* YK;
    __device__ __forceinline__ void operator()(AccRef acc, const pg8::Unit& u, int wr, int wc, int fr, int fq) const {
        const float* bb = bd + (size_t)u.e * 1024;
        f32x4 bv[2][2]; float gw[2][4]; int dst[2][4];
#pragma unroll
        for (int bj = 0; bj < 2; ++bj) { const int col = u.pn * 256 + bj * 128 + wc * 32 + 8 * fq; bv[bj][0] = *(const f32x4*)(bb + col); bv[bj][1] = *(const f32x4*)(bb + col + 4); }
#pragma unroll
        for (int ai = 0; ai < 2; ++ai)
#pragma unroll
            for (int m = 0; m < 4; ++m) { const int lr = ai * 128 + wr * 64 + m * 16 + fr, lc = lr < u.nvalid ? lr : u.nvalid - 1;
                gw[ai][m] = rowgate[u.gidx + lc]; dst[ai][m] = rowtok[u.gidx + lc]; }
#pragma unroll
        for (int ai = 0; ai < 2; ++ai)
#pragma unroll
            for (int m = 0; m < 4; ++m) {
                const int lr = ai * 128 + wr * 64 + m * 16 + fr;
                const int row = lr < u.nvalid ? dst[ai][m] : NROWS + lr;
#pragma unroll
                for (int bj = 0; bj < 2; ++bj) {
                    const int col = u.pn * 256 + bj * 128 + wc * 32 + 8 * fq;
                    const f32x4 v0 = (acc[ai][bj][m][0] * (1.f / WDN_SCALE) + bv[bj][0]) * gw[ai][m], v1 = (acc[ai][bj][m][1] * (1.f / WDN_SCALE) + bv[bj][1]) * gw[ai][m];
                    *(u32x4*)(YK + (size_t)row * 1024 + col) = (u32x4){pk2(v0[0], v0[1]), pk2(v0[2], v0[3]), pk2(v1[0], v1[1]), pk2(v1[2], v1[3])};
                }
            }
    } };
__device__ __forceinline__ void phase13(const Params& p, unsigned char* smem, LAS unsigned char* lds) {
    int* offs = (int*)(smem + LDS_TAB); int* toff = offs + 40;
    load_offsets(p, offs, toff);
    MoeOrder S{offs, toff, (const char*)(p.ws + O_ACT), (const char*)(p.ws + O_WT_DN), nullptr, (size_t)1024 * 1024, 4, (int)gridDim.x, (int)blockIdx.x};
    EpiDn E{p.in[31], (const float*)(p.ws + O_ROWGATE), (const int*)(p.ws + O_ROWTOK), (bf16_t*)(p.ws + O_YK)};
    pg8::gemm_phase<EpiDn, MoeOrder, true, true>(lds, 512, 512, 512, S, E);
    __syncthreads();
}

struct P14Raw { u32x2 a[4][4]; f32x4 x[4]; };
__device__ __forceinline__ void p14_load(P14Raw& r, const bf16_t* YK, const float* X1, int token, int lane) {
#pragma unroll
    for (int j = 0; j < 4; ++j) {
        const int c = j * 256 + lane * 4;
#pragma unroll
        for (int k = 0; k < 4; ++k) r.a[j][k] = *(const u32x2*)(YK + (size_t)(token * 4 + k) * 1024 + c);
        r.x[j] = *(const f32x4*)(X1 + (size_t)token * 1024 + c);
    }
}
__device__ __forceinline__ void p14_finish(const P14Raw& r, const float* gf, const float* lg, const float* lb, float* out, int token, int lane) {
    f32x4 v[4]; float s = 0.f;
#pragma unroll
    for (int j = 0; j < 4; ++j) {
        const int c = j * 256 + lane * 4;
        const u32x2 a0 = r.a[j][0], a1 = r.a[j][1], a2 = r.a[j][2], a3 = r.a[j][3];
        f32x4 y;
        y[0] = (bflo(a0.x) + bflo(a1.x)) + (bflo(a2.x) + bflo(a3.x)); y[1] = (bfhi(a0.x) + bfhi(a1.x)) + (bfhi(a2.x) + bfhi(a3.x));
        y[2] = (bflo(a0.y) + bflo(a1.y)) + (bflo(a2.y) + bflo(a3.y)); y[3] = (bfhi(a0.y) + bfhi(a1.y)) + (bfhi(a2.y) + bfhi(a3.y));
        v[j] = r.x[j] * DN_ALPHA + *(const f32x4*)(gf + c) * y;
        s += (v[j][0] + v[j][1]) + (v[j][2] + v[j][3]);
    }
    const float mean = wave_sum(s) * (1.f / 1024.f); float q = 0.f;
#pragma unroll
    for (int j = 0; j < 4; ++j) { v[j] = v[j] - mean; q += (v[j][0] * v[j][0] + v[j][1] * v[j][1]) + (v[j][2] * v[j][2] + v[j][3] * v[j][3]); }
    const float rstd = rsqrtf(wave_sum(q) * (1.f / 1024.f) + LN_EPS);
#pragma unroll
    for (int j = 0; j < 4; ++j) { const int c = j * 256 + lane * 4; *(f32x4*)(out + (size_t)token * 1024 + c) = v[j] * rstd * *(const f32x4*)(lg + c) + *(const f32x4*)(lb + c); }
}
__device__ __forceinline__ void phase14(const Params& p, unsigned char*) {
    const int tid = threadIdx.x, lane = tid & 63, wid = tid >> 6;
    const float* lg = p.in[32]; const float* lb = p.in[33];
    const bf16_t* YK = (const bf16_t*)(p.ws + O_YK);
    const float* X1 = (const float*)(p.ws + O_Z1);
    const float* ada = (const float*)(p.ws + O_ADA) + 5120;
    const int G = gridDim.x, nit = NTOK / NWV;
    int item = blockIdx.x;
    if (item >= nit) return;
    P14Raw ra, rb;
    p14_load(ra, YK, X1, item * NWV + wid, lane);
#pragma unroll 1
    for (;;) {
        const int ta = item * NWV + wid, ib = item + G;
        if (ib < nit) p14_load(rb, YK, X1, ib * NWV + wid, lane);
        p14_finish(ra, ada + (ta >> 13) * 6144, lg, lb, p.out, ta, lane);
        if (ib >= nit) break;
        const int tb = ib * NWV + wid; item = ib + G;
        if (item < nit) p14_load(ra, YK, X1, item * NWV + wid, lane);
        p14_finish(rb, ada + (tb >> 13) * 6144, lg, lb, p.out, tb, lane);
        if (item >= nit) break;
    }
}


#if defined(__HIP_DEVICE_COMPILE__)
typedef const __attribute__((address_space(4))) Params* KernargPtr;
__device__ __forceinline__ KernargPtr opaque_kernarg() { KernargPtr kp = (KernargPtr)__builtin_amdgcn_kernarg_segment_ptr(); asm volatile("" : "+s"(kp)); return kp; }
#define GAS __attribute__((address_space(1)))
__device__ __forceinline__ Params load_params() {
    Params r; const __attribute__((address_space(4))) unsigned long long* s = (const __attribute__((address_space(4))) unsigned long long*)opaque_kernarg();
#pragma unroll
    for (int i = 0; i < 34; ++i) r.in[i] = (const float*)(const GAS float*)s[i];
    r.out = (float*)(GAS float*)s[34]; r.ws = (unsigned char*)(GAS unsigned char*)s[35];
    const unsigned long long pp = s[36]; r.ph_lo = (int)(unsigned)pp; r.ph_hi = (int)(unsigned)(pp >> 32);
    return r; }
#else
#define opaque_kernarg() (&p_unused)
#endif
#if defined(__HIP_DEVICE_COMPILE__)
#define PARAMS_NOW() load_params()
#else
#define PARAMS_NOW() p_unused
#endif
template <bool COOP>
__global__ void __launch_bounds__(NT, 2) fwd_kernel(Params p_unused) {
    extern __shared__ __attribute__((aligned(16))) unsigned char smem[];
    LAS unsigned char* lds = (LAS unsigned char*)smem;
    const int lo = opaque_kernarg()->ph_lo, hi = opaque_kernarg()->ph_hi;
    volatile LAS unsigned* bst = (volatile LAS unsigned*)(lds + LDS_BYTES - 16);
    if (threadIdx.x == 0) { bst[0] = 0u; bst[1] = 0u; bst[2] = 0u; bst[3] = 0u; }
    __syncthreads();
    XcdBarrier gbar; gbar.bar = nullptr; gbar.x = 0; gbar.st = bst;
    if (COOP) { const Params p0 = PARAMS_NOW(); gbar = xcd_barrier_post((unsigned*)(p0.ws + O_BAR), bst); }
#define SEAM(k) do { if (lo < 0) cg::this_grid().sync(); else { const Params pw_ = PARAMS_NOW(); xcd_barrier_work(gbar, pw_, smem, (k) >= 1 && (k) <= 9); } } while (0)
#define RUN_PHASE(k, call) if (((PH_MASK >> (k)) & 1) && lo <= (k) && (k) < hi) { _Pragma("unroll 1") for (int rep_ = 0; rep_ < 1 + ((REPEAT_MASK >> (k)) & 1); ++rep_) { if (rep_) { if (COOP) SEAM(1); } const Params p = PARAMS_NOW(); call; } } if (COOP) { if ((k) != 0 && (k) != 6 && lo <= (k) && (k) + 1 < hi) SEAM(k); }
    RUN_PHASE(0, phase0(p, smem))
    RUN_PHASE(1, phase1(p, smem))
    RUN_PHASE(2, phase2(p, lds))
    RUN_PHASE(3, phase3(p, lds))
    RUN_PHASE(4, phase4(p, smem))
    RUN_PHASE(5, phase5(p, lds))
    RUN_PHASE(6, phase6(p, lds))
    RUN_PHASE(7, phase7(p, smem))
    RUN_PHASE(8, phase8(p, lds))
    RUN_PHASE(9, phase9(p, lds))
    RUN_PHASE(10, phase10(p, smem))
    RUN_PHASE(12, phase12(p, smem, lds))
    RUN_PHASE(13, phase13(p, smem, lds))
    RUN_PHASE(14, phase14(p, smem))
#undef RUN_PHASE
#undef SEAM
}

extern "C" void kernel_launch(void* const* d_in, const int* in_sizes, int n_in, void* d_out, int out_size, void* d_ws, size_t ws_size, hipStream_t stream) {
    static int grid = 0;
    if (grid == 0) {
        if (n_in != 34 || out_size != NTOK * DM || ws_size < WS_NEED) { fprintf(stderr, "kernel_launch: unexpected problem (n_in %d, out %d, ws %zu need %zu)\n", n_in, out_size, ws_size, (size_t)WS_NEED); grid = -1; return; }
        int dev = 0, cus = 0, per_cu = 0;
        (void)hipGetDevice(&dev);
        (void)hipDeviceGetAttribute(&cus, hipDeviceAttributeMultiprocessorCount, dev);
#if ONE_LAUNCH
        (void)hipFuncSetAttribute((const void*)fwd_kernel<true>, hipFuncAttributeMaxDynamicSharedMemorySize, LDS_BYTES);
        (void)hipOccupancyMaxActiveBlocksPerMultiprocessor(&per_cu, fwd_kernel<true>, NT, LDS_BYTES);
#else
        (void)hipFuncSetAttribute((const void*)fwd_kernel<false>, hipFuncAttributeMaxDynamicSharedMemorySize, LDS_BYTES);
        (void)hipOccupancyMaxActiveBlocksPerMultiprocessor(&per_cu, fwd_kernel<false>, NT, LDS_BYTES);
#endif
        if (per_cu < 1) { fprintf(stderr, "kernel_launch: occupancy query reports %d blocks per CU\n", per_cu); per_cu = 1; }
        grid = cus * per_cu;
        fprintf(stderr, "kernel_launch: grid %d (%d CUs x %d)\n", grid, cus, per_cu);
    }
    if (grid < 0) return;
    Params p{};
    for (int i = 0; i < 34; ++i) p.in[i] = (const float*)d_in[i];
    p.out = (float*)d_out; p.ws = (unsigned char*)d_ws;
#if ONE_LAUNCH
    if (hipMemsetAsync((char*)d_ws + O_BAR, 0, BAR_BYTES, stream) != hipSuccess) { fprintf(stderr, "kernel_launch: memset of the barrier words failed\n"); return; }
    p.ph_lo = 0; p.ph_hi = NPHASE;
    void* args[] = {&p};
    hipError_t e = hipLaunchCooperativeKernel((void*)fwd_kernel<true>, dim3(grid), dim3(NT), args, LDS_BYTES, stream);
    if (e != hipSuccess) fprintf(stderr, "cooperative launch failed: %s (grid %d)\n", hipGetErrorString(e), grid);
#else
    for (int ph = 0; ph < NPHASE; ++ph) {
        p.ph_lo = ph; p.ph_hi = ph + 1;
        hipLaunchKernelGGL(fwd_kernel<false>, dim3(grid), dim3(NT), LDS_BYTES, stream, p);
    }
#endif
}
```

```cpp
#include <hip/hip_runtime.h>
#include <hip/hip_cooperative_groups.h>
#include <cstdio>
#include <cstdint>
namespace cg = cooperative_groups;

#ifndef PH_MASK
#define PH_MASK 0xFFFFF
#endif
#ifndef REPEAT_MASK
#define REPEAT_MASK 0
#endif
#ifndef ONE_LAUNCH
#define ONE_LAUNCH 1
#endif

#define LAS __attribute__((address_space(3)))
typedef unsigned short bf16_t;
typedef short bf16x8 __attribute__((ext_vector_type(8)));
typedef float f32x4 __attribute__((ext_vector_type(4)));
typedef float f32x2 __attribute__((ext_vector_type(2)));
typedef unsigned u32x4 __attribute__((ext_vector_type(4)));
typedef unsigned u32x2 __attribute__((ext_vector_type(2)));
typedef __bf16 bf16x2_t __attribute__((ext_vector_type(2)));

constexpr int NB = 4, SEQ = 8192, NTOK = NB * SEQ, DM = 1024;
constexpr int NIN_PAD = 4096;
constexpr int NEXP = 32, TOPK = 4, NROWS = NTOK * TOPK;
constexpr int S5L = 32;
constexpr int NCHUNK = SEQ / S5L;
constexpr int UROW = 640;
constexpr float DN_ALPHA = 1.189207115002721f;
constexpr float LN_EPS = 1e-5f;
constexpr float LOG2E = 1.4426950408889634f;
constexpr float QSCALE = 0.125f * 1.4426950408889634f;
constexpr float YS_SCALE = 8.f, ONSA_SCALE = 16.f, MRG_SCALE = 8.f, WGLU_SCALE = 16.f, WNSA_SCALE = 16.f, WOUT_SCALE = 32.f;
constexpr float WGU_SCALE = 32.f, WDN_SCALE = 64.f, YK_SCALE = 32.f, Y_SCALE = 64.f;
constexpr int NT = 512;
constexpr int NWV = NT / 64;

constexpr size_t al256(size_t x) { return (x + 255) & ~(size_t)255; }
constexpr size_t O_ADA = 0;
constexpr size_t O_CNT = O_ADA + al256(4 * 6144 * 4);
constexpr size_t O_BAR = O_CNT + 8192;
constexpr int XF_BASE = 3456;
constexpr size_t BAR_BYTES = (3456 + 168 * 32) * 4;
constexpr size_t O_LAML = O_BAR + al256(BAR_BYTES);
constexpr size_t O_BIAS1 = O_LAML + al256(32 * 64 * 2 * 4);
constexpr size_t O_WT_IN = O_BIAS1 + al256(2 * 8 * 128 * 4);
constexpr size_t O_WT_GLU = O_WT_IN + al256((size_t)NIN_PAD * 1024);
constexpr size_t O_WT_NSA = O_WT_GLU + al256((size_t)2048 * 512 * 2);
constexpr size_t O_WT_OUT = O_WT_NSA + al256((size_t)1024 * 512 * 2);
constexpr size_t O_WT_C1 = O_WT_OUT + al256((size_t)1024 * 1024 * 2);
constexpr size_t O_W1T = O_WT_C1 + al256((size_t)2 * 256 * 2048 * 2);
constexpr size_t O_TW2 = O_W1T + al256((size_t)32 * 256 * 512 * 2);
constexpr size_t O_WT_GU = O_TW2 + al256((size_t)32 * 512 * 640 * 2);
constexpr size_t O_WT_DN = O_WT_GU + al256((size_t)32 * 2048 * 1024);
constexpr size_t O_H2 = O_WT_DN + al256((size_t)32 * 1024 * 1024);
constexpr size_t O_Z1 = O_H2 + al256((size_t)NTOK * 1024);
constexpr size_t O_TOPE = O_Z1 + al256((size_t)NTOK * 1024 * 4);
constexpr size_t O_TOPP = O_TOPE + al256((size_t)NROWS * 4);
constexpr size_t O_TOPG = O_TOPP + al256((size_t)NROWS * 4);
constexpr size_t O_ROWTOK = O_TOPG + al256((size_t)NROWS * 4);
constexpr size_t O_ROWGATE = O_ROWTOK + al256((size_t)NEXP * NTOK * 4);
constexpr size_t O_OVL = O_ROWGATE + al256((size_t)NEXP * NTOK * 4 + 1024);
constexpr size_t O_U = O_OVL;
constexpr size_t O_E = O_U + al256((size_t)32 * 1024 * UROW * 2);
constexpr size_t O_YS = O_E + al256((size_t)32 * 1024 * 128 * 4);
constexpr size_t O_Q = O_YS + al256((size_t)NTOK * 512 * 2);
constexpr size_t O_KV = O_Q + al256((size_t)NTOK * 512 * 2);
constexpr size_t KV_SLAB = (size_t)SEQ * 64;
constexpr size_t O_SG5 = O_KV + al256((size_t)6 * 8 * KV_SLAB * 2 + 8192);
constexpr size_t O_SGN = O_SG5 + al256((size_t)NTOK * 1024 * 2);
constexpr size_t O_GN = O_SGN + al256((size_t)NTOK * 1024 * 2);
constexpr size_t O_MS5 = O_GN + al256((size_t)NTOK * 24 * 4);
constexpr size_t O_ONSA = O_MS5 + al256((size_t)NTOK * 1024 * 2);
constexpr size_t O_HC = O_ONSA + al256((size_t)NTOK * 512 * 2);
constexpr size_t O_KC = O_HC + al256((size_t)8 * 4096 * 128 * 4);
constexpr size_t O_XN = O_KC + al256((size_t)2 * 4096 * 64 * 2);
constexpr size_t O_END1 = O_XN + al256((size_t)NTOK * 1024);
constexpr size_t O_ACT = O_OVL;
constexpr size_t O_YK = O_ACT + al256((size_t)(NROWS + 256) * 1024);
constexpr size_t O_END2 = O_YK + al256((size_t)(NROWS + 256) * 1024);
constexpr size_t WS_NEED = O_END1 > O_END2 ? O_END1 : O_END2;
static_assert(WS_NEED <= (size_t)1073741824, "workspace map exceeds 1 GiB");

constexpr int LDS_BYTES = 147456;
constexpr int LDS_TAB = 131072;
constexpr int LDS_ROWS = LDS_TAB + 1024;
constexpr int NPHASE = 15;

struct Params {
    const float* in[34];
    float* out;
    unsigned char* ws;
    int ph_lo, ph_hi;
};

__device__ __forceinline__ unsigned pk2(float lo, float hi) { f32x2 v = {lo, hi}; bf16x2_t b = __builtin_convertvector(v, bf16x2_t); return __builtin_bit_cast(unsigned, b); }
__device__ __forceinline__ bf16_t f2bf(float f) { return (bf16_t)(pk2(f, 0.f) & 0xffffu); }
__device__ __forceinline__ float bf2f(bf16_t h) { return __uint_as_float(((unsigned)h) << 16); }
__device__ __forceinline__ float bflo(unsigned w) { return __uint_as_float(w << 16); }
__device__ __forceinline__ float bfhi(unsigned w) { return __uint_as_float(w & 0xffff0000u); }
#define LOG2E_F 1.4426950408889634f
__device__ __forceinline__ unsigned pk4_f8(float a, float b, float c, float d) { unsigned w; asm("v_cvt_pk_fp8_f32 %0, %1, %2" : "=v"(w) : "v"(a), "v"(b)); asm("v_cvt_pk_fp8_f32 %0, %1, %2 op_sel:[0,0,1]" : "+v"(w) : "v"(c), "v"(d)); return w; }
__device__ __forceinline__ f32x4 sigmoid4(f32x4 x) {
    const f32x4 a = x * (-LOG2E_F); f32x4 e, r;
#pragma unroll
    for (int j = 0; j < 4; ++j) e[j] = __builtin_amdgcn_exp2f(a[j]);
    const f32x4 d = e + 1.f;
#pragma unroll
    for (int j = 0; j < 4; ++j) r[j] = __builtin_amdgcn_rcpf(d[j]);
    return r;
}
__device__ __forceinline__ float sigmoidf_(float x) { return __builtin_amdgcn_rcpf(1.f + __builtin_amdgcn_exp2f(-LOG2E_F * x)); }
__device__ __forceinline__ f32x4 gelu4s(f32x4 x, float s) {
    constexpr float c0 = 2.f * LOG2E_F * 0.7978845608028654f, c1 = c0 * 0.044715f;
    const f32x4 a = x * (x * x * c1 + c0); f32x4 e, r;
#pragma unroll
    for (int j = 0; j < 4; ++j) e[j] = __builtin_amdgcn_exp2f(a[j]);
    const f32x4 d = e + 1.f;
#pragma unroll
    for (int j = 0; j < 4; ++j) r[j] = __builtin_amdgcn_rcpf(d[j]);
    const f32x4 xs = x * s;
    return xs - xs * r;
}
__device__ __forceinline__ float gelu_tanh(float x) { const float u = 0.7978845608028654f * (x + 0.044715f * x * x * x); const float e = __builtin_amdgcn_exp2f((2.f * LOG2E_F) * u); return x * (1.f - __builtin_amdgcn_rcpf(e + 1.f)); }
__device__ __forceinline__ float wave_sum(float v) {
#pragma unroll
    for (int o = 1; o < 64; o <<= 1) v += __shfl_xor(v, o);
    return v;
}
#define WAVE_SYNC() do { __builtin_amdgcn_fence(__ATOMIC_RELEASE, "wavefront"); __builtin_amdgcn_wave_barrier(); __builtin_amdgcn_fence(__ATOMIC_ACQUIRE, "wavefront"); } while (0)

#define XB_TMO      128
#define XB_XCNT(j)  (256  + 64 * (j))
#define XB_XSUB(j)  (1280 + 64 * (j))
#define XB_XGEN(j)  (2304 + 64 * (j))
#define XB_TOP      3328
#define XB_TOPGEN   3392
#define XB_SPIN_CAP (1u << 20)
__device__ __forceinline__ unsigned xb_ld(unsigned* p)              { return __hip_atomic_load(p, __ATOMIC_RELAXED, __HIP_MEMORY_SCOPE_AGENT); }
__device__ __forceinline__ unsigned xb_add(unsigned* p, unsigned v) { return __hip_atomic_fetch_add(p, v, __ATOMIC_RELAXED, __HIP_MEMORY_SCOPE_AGENT); }
__device__ __forceinline__ unsigned xb_xcc_id() { return (unsigned)__builtin_amdgcn_s_getreg((3 << 11) | 20) & 0xFu; }
#define XB_SPIN(cond, bar) do { unsigned _sp = 0; while (cond) { __builtin_amdgcn_s_sleep(1); \
    if ((++_sp & 255u) == 0u) { if (xb_ld(&(bar)[XB_TMO])) break; if (_sp > XB_SPIN_CAP) { atomicAdd(&(bar)[XB_TMO], 1u); break; } } } } while (0)
struct XcdBarrier { unsigned* bar; unsigned x; volatile LAS unsigned* st; };
__device__ __forceinline__ XcdBarrier xcd_barrier_post(unsigned* bar, volatile LAS unsigned* st) {
    XcdBarrier b; b.bar = bar; b.x = xb_xcc_id(); b.st = st;
    if (threadIdx.x == 0) (void)xb_add(&bar[XB_XCNT(b.x)], 1u);
    return b;
}
__device__ __forceinline__ void xcd_barrier_complete(unsigned* bar, unsigned x, unsigned& nloc, unsigned& nx) {
    const unsigned G = gridDim.x * gridDim.y * gridDim.z;
    unsigned sum, cnt, mine, sp = 0u;
    for (;;) {
        sum = 0u; cnt = 0u; mine = 0u;
#pragma unroll
        for (unsigned j = 0; j < 16; ++j) { const unsigned c = xb_ld(&bar[XB_XCNT(j)]); sum += c; cnt += (c > 0u) ? 1u : 0u; mine = (j == x) ? c : mine; }
        if (sum == G) break;
        __builtin_amdgcn_s_sleep(1);
        if ((++sp & 255u) == 0u) { if (xb_ld(&bar[XB_TMO])) break; if (sp > XB_SPIN_CAP) { atomicAdd(&bar[XB_TMO], 1u); break; } }
    }
    nloc = mine > 0u ? mine : 1u; nx = cnt > 0u ? cnt : 1u;
}
__device__ __forceinline__ void xcd_barrier(const XcdBarrier& b) {
    asm volatile("s_waitcnt vmcnt(0)" ::: "memory");
    __syncthreads();
    if (threadIdx.x == 0) {
        unsigned* bar = b.bar;
        __builtin_amdgcn_s_waitcnt(0);
        unsigned nloc = b.st[0], nx = b.st[1];
        if (nloc == 0u) { xcd_barrier_complete(bar, b.x, nloc, nx); b.st[0] = nloc; b.st[1] = nx; }
        const unsigned old = xb_add(&bar[XB_XSUB(b.x)], 1u);
        const unsigned gen = old / nloc;
        if (old + 1u == (gen + 1u) * nloc) {
            __builtin_amdgcn_fence(__ATOMIC_RELEASE, "agent");
            asm volatile("s_waitcnt vmcnt(0)" ::: "memory");
            const unsigned og = xb_add(&bar[XB_TOP], 1u);
            const unsigned tg = og / nx;
            if (og + 1u == (tg + 1u) * nx) xb_add(&bar[XB_TOPGEN], 1u);
            else XB_SPIN(xb_ld(&bar[XB_TOPGEN]) == tg, bar);
            __builtin_amdgcn_fence(__ATOMIC_ACQUIRE, "agent");
            xb_add(&bar[XB_XGEN(b.x)], 1u);
            asm volatile("s_waitcnt vmcnt(0)" ::: "memory");
        } else {
            XB_SPIN(xb_ld(&bar[XB_XGEN(b.x)]) == gen, bar);
            __builtin_amdgcn_fence(__ATOMIC_ACQUIRE, "agent");
            asm volatile("s_waitcnt vmcnt(0)" ::: "memory");
        }
    }
    __syncthreads();
}


namespace pg8 {
typedef int v8i_t __attribute__((ext_vector_type(8)));
typedef int v4i8_t __attribute__((ext_vector_type(4)));
constexpr int BM = 256, BK = 64, HALF = 128, HTB = HALF * BK * 2, STAGE_BYTES = 8 * HTB;
__device__ __forceinline__ int lds_byte(int r, int c) { const int st = (r >> 4) * 2 + (c >> 5), rr = r & 15, cc = c & 31, ob = rr * 64 + cc * 2; return st * 1024 + (ob ^ (((ob >> 9) & 1) << 5)); }
__device__ __forceinline__ void stage_rc(int b, int& R, int& C) { const int st = b / 1024, sb = b % 1024, swz = sb ^ (((sb >> 9) & 1) << 5); R = (st >> 1) * 16 + swz / 64; C = (st & 1) * 32 + (swz % 64) / 2; }
__device__ __forceinline__ int perm32(int rho) { const int n = rho >> 4, i = rho & 15; return 8 * (i >> 2) + 4 * n + (i & 3); }
struct Unit { const char* A; const char* B; const int* rows; int pm, pn, e, nvalid, rmax, gidx; };

template <class Epi, class Sched, bool ALIGN_EPI, bool F8 = false, bool GATHER = false>
__device__ __forceinline__ void gemm_phase(LAS unsigned char* lds, const int K, const int lda, const int ldb, const Sched& S, const Epi& E) {
    const int tid = threadIdx.x, wid = __builtin_amdgcn_readfirstlane(tid >> 6), lane = tid & 63, wr = wid >> 2, wc = wid & 3, fr = lane & 15, fq = lane >> 4;
    const int nt = K / BK;
    unsigned voffB[2]; int Ra[2], Ca[2];
#pragma unroll
    for (int i = 0; i < 2; ++i) { int R, C; stage_rc(tid * 16 + i * 8192, R, C); const int Rb = Epi::PERM ? ((R & ~31) + perm32(R & 31)) : R;
        Ra[i] = R; Ca[i] = C; voffB[i] = (unsigned)(Rb * ldb + C) * 2u; }
    unsigned offC[2][2];
    const size_t kstep = (size_t)(BK * 2);
    const size_t hstepB = (size_t)HALF * ldb * 2;
    const unsigned ldsw = (unsigned)wid * 1024u;
    const int aoff = lds_byte(wr * 64 + fr, fq * 8), boff = lds_byte(wc * 32 + fr, fq * 8);
#define PG8_SA(b, h) (((b) * 2 + (h)) * HTB)
#define PG8_SB(b, h) ((4 + (b) * 2 + (h)) * HTB)
#define PG8_STAGE(bufoff, gbase, voff) do { _Pragma("unroll") for (int _i = 0; _i < 2; ++_i) \
        __builtin_amdgcn_global_load_lds((const unsigned*)((const char*)(gbase) + (voff)[_i]), (LAS unsigned*)(lds + (bufoff) + ldsw + _i * 8192), 16, 0, 0); } while (0)
#define PG8_LDA(dst, b, h) do { _Pragma("unroll") for (int m = 0; m < 4; ++m) { \
        if constexpr (F8) dst##8[m] = __builtin_shufflevector(*(const LAS v4i8_t*)(lds + PG8_SA(b, h) + aoff + m * 2048), *(const LAS v4i8_t*)(lds + PG8_SA(b, h) + aoff + m * 2048 + 1024), 0, 1, 2, 3, 4, 5, 6, 7); \
        else { _Pragma("unroll") for (int k = 0; k < 2; ++k) dst[m][k] = *(const LAS bf16x8*)(lds + PG8_SA(b, h) + aoff + m * 2048 + k * 1024); } } } while (0)
#define PG8_LDB(dst, b, h) do { _Pragma("unroll") for (int n = 0; n < 2; ++n) { \
        if constexpr (F8) dst##8[n] = __builtin_shufflevector(*(const LAS v4i8_t*)(lds + PG8_SB(b, h) + boff + n * 2048), *(const LAS v4i8_t*)(lds + PG8_SB(b, h) + boff + n * 2048 + 1024), 0, 1, 2, 3, 4, 5, 6, 7); \
        else { _Pragma("unroll") for (int k = 0; k < 2; ++k) dst[n][k] = *(const LAS bf16x8*)(lds + PG8_SB(b, h) + boff + n * 2048 + k * 1024); } } } while (0)
#define PG8_MMA(ai, bj, At, Bt) do { __builtin_amdgcn_s_setprio(1); _Pragma("unroll") for (int m = 0; m < 4; ++m) _Pragma("unroll") for (int n = 0; n < 2; ++n) { \
        if constexpr (F8) asm volatile("v_mfma_scale_f32_16x16x128_f8f6f4 %0, %1, %2, %0, %3, %3 op_sel_hi:[0,0,0]" : "+v"(acc[ai][bj][m][n]) : "v"(Bt##8[n]), "v"(At##8[m]), "v"(f8scale_));   \
        else { _Pragma("unroll") for (int k = 0; k < 2; ++k) acc[ai][bj][m][n] = __builtin_amdgcn_mfma_f32_16x16x32_bf16(Bt[n][k], At[m][k], acc[ai][bj][m][n], 0, 0, 0); } } \
        __builtin_amdgcn_s_setprio(0); } while (0)
#define PG8_MMA0(ai, bj, At, Bt) do { __builtin_amdgcn_s_setprio(1); _Pragma("unroll") for (int m = 0; m < 4; ++m) _Pragma("unroll") for (int n = 0; n < 2; ++n) { \
        if constexpr (F8) asm volatile("v_mfma_scale_f32_16x16x128_f8f6f4 %0, %1, %2, 0, %3, %3 op_sel_hi:[0,0,0]" : "=&v"(acc[ai][bj][m][n]) : "v"(Bt##8[n]), "v"(At##8[m]), "v"(f8scale_)); \
        else { acc[ai][bj][m][n] = __builtin_amdgcn_mfma_f32_16x16x32_bf16(Bt[n][0], At[m][0], (f32x4){0.f, 0.f, 0.f, 0.f}, 0, 0, 0); acc[ai][bj][m][n] = __builtin_amdgcn_mfma_f32_16x16x32_bf16(Bt[n][1], At[m][1], acc[ai][bj][m][n], 0, 0, 0); } } \
        __builtin_amdgcn_s_setprio(0); } while (0)
#define PG8_WAIT_V(n) asm volatile("s_waitcnt vmcnt(" #n ")" ::: "memory")
#define PG8_WAIT_L(n) asm volatile("s_waitcnt lgkmcnt(" #n ")" ::: "memory")
#define PG8_BAR __builtin_amdgcn_s_barrier()
#define PG8_SCHED __builtin_amdgcn_sched_barrier(0)
    Unit cur, nxt; int ui = 0;
    if (!S.next(0, cur)) return;
    f32x4 acc[2][2][4][2];
#define PG8_ZERO_ACC() do { _Pragma("unroll") for (int a = 0; a < 2; ++a) _Pragma("unroll") for (int b = 0; b < 2; ++b) _Pragma("unroll") for (int m = 0; m < 4; ++m) _Pragma("unroll") for (int n = 0; n < 2; ++n) acc[a][b][m][n] = (f32x4){0.f, 0.f, 0.f, 0.f}; } while (0)
    if constexpr (!F8) PG8_ZERO_ACC();
    bf16x8 At[4][2], B0[2][2], B1[2][2];
    v8i_t At8[4], B08[2], B18[2];
    const int f8scale_ = 0x7F7F7F7F;
    const char* cA = cur.A; const char* cB = cur.B;
    if constexpr (GATHER) {
        int rv_[2][2];
#pragma unroll
        for (int h_ = 0; h_ < 2; ++h_)
#pragma unroll
            for (int i_ = 0; i_ < 2; ++i_) { int ix_ = h_ * HALF + Ra[i_]; ix_ = ix_ < cur.rmax ? ix_ : cur.rmax; rv_[h_][i_] = cur.rows[ix_]; }
#pragma unroll
        for (int h_ = 0; h_ < 2; ++h_)
#pragma unroll
            for (int i_ = 0; i_ < 2; ++i_) offC[h_][i_] = (unsigned)(rv_[h_][i_] >> 2) * (unsigned)(lda * 2) + (unsigned)Ca[i_] * 2u;
    } else {
#pragma unroll
        for (int h_ = 0; h_ < 2; ++h_)
#pragma unroll
            for (int i_ = 0; i_ < 2; ++i_) offC[h_][i_] = (unsigned)((h_ * HALF + Ra[i_]) * lda + Ca[i_]) * 2u;
    }
    PG8_STAGE(PG8_SB(0, 0), cB, voffB); PG8_STAGE(PG8_SB(0, 1), cB + hstepB, voffB); PG8_STAGE(PG8_SA(0, 0), cA, offC[0]); PG8_STAGE(PG8_SA(0, 1), cA, offC[1]);
    if (wr == 1) PG8_BAR;
    PG8_WAIT_V(2); PG8_BAR;
    PG8_STAGE(PG8_SB(1, 0), cB + kstep, voffB); PG8_STAGE(PG8_SA(1, 0), cA + kstep, offC[0]); PG8_STAGE(PG8_SB(1, 1), cB + hstepB + kstep, voffB);
    PG8_WAIT_V(6); PG8_BAR;
    for (;;) {
        const bool has_next = S.next(ui + 1, nxt);
        const char* nA = has_next ? nxt.A : cA; const char* nB = has_next ? nxt.B : cB;
        if constexpr (GATHER) { if (has_next) __builtin_amdgcn_global_load_lds((const unsigned*)(nxt.rows + (tid & 255)), (LAS unsigned*)(lds + LDS_ROWS + (wid & 3) * 256), 4, 0, 0); }
        unsigned o2[2][2];
        o2[0][0] = offC[0][0]; o2[0][1] = offC[0][1]; o2[1][0] = offC[1][0]; o2[1][1] = offC[1][1];
        if constexpr (F8) {
            const int t = 0;
#define MMZ PG8_MMA0
            const bool last = (t == nt - 2);
            const char* a1 = cA + (size_t)(t + 1) * kstep;
            const char* a2 = last ? nA : cA + (size_t)(t + 2) * kstep; const char* b2 = last ? nB : cB + (size_t)(t + 2) * kstep;
            const char* a3 = a2 + kstep; const char* b3 = b2 + kstep;
            if constexpr (GATHER) {
                if (last && has_next) {
#pragma unroll
                    for (int h_ = 0; h_ < 2; ++h_)
#pragma unroll
                        for (int i_ = 0; i_ < 2; ++i_) { int ix_ = h_ * HALF + Ra[i_]; ix_ = ix_ < nxt.rmax ? ix_ : nxt.rmax;
                            o2[h_][i_] = (unsigned)(((const LAS int*)(lds + LDS_ROWS))[ix_] >> 2) * (unsigned)(lda * 2) + (unsigned)Ca[i_] * 2u; }
                }
            }
            PG8_LDB(B0, 0, 0); PG8_LDB(B1, 0, 1); PG8_SCHED; PG8_LDA(At, 0, 0); PG8_STAGE(PG8_SA(1, 1), a1, offC[1]);
            PG8_WAIT_V(8); PG8_WAIT_L(0); PG8_BAR; MMZ(0, 0, At, B0); MMZ(0, 1, At, B1); PG8_BAR; PG8_SCHED;
            PG8_LDA(At, 0, 1); PG8_STAGE(PG8_SB(0, 0), b2, voffB); PG8_STAGE(PG8_SB(0, 1), b2 + hstepB, voffB); PG8_STAGE(PG8_SA(0, 0), a2, o2[0]);
            PG8_WAIT_V(8); PG8_WAIT_L(0); PG8_BAR; MMZ(1, 0, At, B0); MMZ(1, 1, At, B1); PG8_BAR; PG8_SCHED;
            PG8_LDB(B0, 1, 0); PG8_LDB(B1, 1, 1); PG8_SCHED; PG8_LDA(At, 1, 0); PG8_STAGE(PG8_SA(0, 1), a2, o2[1]);
            PG8_WAIT_V(8); PG8_WAIT_L(0); PG8_BAR; PG8_MMA(0, 0, At, B0); PG8_MMA(0, 1, At, B1); PG8_BAR; PG8_SCHED;
            PG8_LDA(At, 1, 1); PG8_STAGE(PG8_SB(1, 0), b3, voffB); PG8_STAGE(PG8_SB(1, 1), b3 + hstepB, voffB); PG8_STAGE(PG8_SA(1, 0), a3, o2[0]);
            PG8_WAIT_V(8); PG8_WAIT_L(0); PG8_BAR; PG8_MMA(1, 0, At, B0); PG8_MMA(1, 1, At, B1); PG8_BAR; PG8_SCHED;
#undef MMZ
        }
#pragma unroll 1
        for (int t = F8 ? 2 : 0; t < nt; t += 2) {
#define MMZ PG8_MMA
            const bool last = (t == nt - 2);
            const char* a1 = cA + (size_t)(t + 1) * kstep;
            const char* a2 = last ? nA : cA + (size_t)(t + 2) * kstep; const char* b2 = last ? nB : cB + (size_t)(t + 2) * kstep;
            const char* a3 = a2 + kstep; const char* b3 = b2 + kstep;
            if constexpr (GATHER) {
                if (last && has_next) {
#pragma unroll
                    for (int h_ = 0; h_ < 2; ++h_)
#pragma unroll
                        for (int i_ = 0; i_ < 2; ++i_) { int ix_ = h_ * HALF + Ra[i_]; ix_ = ix_ < nxt.rmax ? ix_ : nxt.rmax;
                            o2[h_][i_] = (unsigned)(((const LAS int*)(lds + LDS_ROWS))[ix_] >> 2) * (unsigned)(lda * 2) + (unsigned)Ca[i_] * 2u; }
                }
            }
            PG8_LDB(B0, 0, 0); PG8_LDB(B1, 0, 1); PG8_SCHED; PG8_LDA(At, 0, 0); PG8_STAGE(PG8_SA(1, 1), a1, offC[1]);
            PG8_WAIT_V(8); PG8_WAIT_L(0); PG8_BAR; MMZ(0, 0, At, B0); MMZ(0, 1, At, B1); PG8_BAR; PG8_SCHED;
            PG8_LDA(At, 0, 1); PG8_STAGE(PG8_SB(0, 0), b2, voffB); PG8_STAGE(PG8_SB(0, 1), b2 + hstepB, voffB); PG8_STAGE(PG8_SA(0, 0), a2, o2[0]);
            PG8_WAIT_V(8); PG8_WAIT_L(0); PG8_BAR; MMZ(1, 0, At, B0); MMZ(1, 1, At, B1); PG8_BAR; PG8_SCHED;
            PG8_LDB(B0, 1, 0); PG8_LDB(B1, 1, 1); PG8_SCHED; PG8_LDA(At, 1, 0); PG8_STAGE(PG8_SA(0, 1), a2, o2[1]);
            PG8_WAIT_V(8); PG8_WAIT_L(0); PG8_BAR; PG8_MMA(0, 0, At, B0); PG8_MMA(0, 1, At, B1); PG8_BAR; PG8_SCHED;
            PG8_LDA(At, 1, 1); PG8_STAGE(PG8_SB(1, 0), b3, voffB); PG8_STAGE(PG8_SB(1, 1), b3 + hstepB, voffB); PG8_STAGE(PG8_SA(1, 0), a3, o2[0]);
            PG8_WAIT_V(8); PG8_WAIT_L(0); PG8_BAR; PG8_MMA(1, 0, At, B0); PG8_MMA(1, 1, At, B1); PG8_BAR; PG8_SCHED;
#undef MMZ
        }
        if constexpr (ALIGN_EPI) { if (wr == 0) PG8_BAR; }
        if constexpr (F8) asm volatile("s_nop 15\n\ts_nop 15" ::: "memory");
        E(acc, cur, wr, wc, fr, fq);
        if (!has_next) break;
        if constexpr (!F8) PG8_ZERO_ACC();
        cur = nxt; cA = nA; cB = nB; ++ui;
        if constexpr (GATHER) { offC[0][0] = o2[0][0]; offC[0][1] = o2[0][1]; offC[1][0] = o2[1][0]; offC[1][1] = o2[1][1]; }
        if constexpr (ALIGN_EPI) { if (wr == 1) PG8_BAR; }
    }
    PG8_WAIT_V(0);
    if constexpr (!ALIGN_EPI) { if (wr == 0) PG8_BAR; }
    PG8_BAR;
#undef PG8_SA
#undef PG8_SB
#undef PG8_STAGE
#undef PG8_LDA
#undef PG8_LDB
#undef PG8_MMA
#undef PG8_MMA0
#undef PG8_ZERO_ACC
#undef PG8_WAIT_V
#undef PG8_WAIT_L
#undef PG8_BAR
#undef PG8_SCHED
}

struct DenseOrder {
    const char* A; const char* B; size_t tstepA, tstepB; int nM, nN, nwg, G, c;
    __device__ __forceinline__ void init(const void* A_, const void* B_, int M, int N, int lda, int ldb, int G_, int c_) {
        A = (const char*)A_; B = (const char*)B_; tstepA = (size_t)BM * lda * 2; tstepB = (size_t)BM * ldb * 2; nM = M / BM; nN = N / BM; nwg = nM * nN; G = G_; c = c_; }
    __device__ __forceinline__ bool next(int i, Unit& u) const {
        const long L = (long)i * G + c; if (L >= nwg) return false;
        int wgid = (int)L; { const int q = nwg / 8, r = nwg % 8, xcd = wgid % 8, off = wgid / 8; wgid = (xcd < r ? xcd * (q + 1) : r * (q + 1) + (xcd - r) * q) + off; }
        if ((nN & (nN - 1)) == 0 && (nM & 7) == 0) {
            const int lg = 31 - __builtin_clz(nN), idx = wgid & (8 * nN - 1);
            u.pm = ((wgid >> (3 + lg)) << 3) + (idx & 7); u.pn = idx >> 3;
        } else {
            const int nig = 8 * nN, gid = wgid / nig, fm = gid * 8, gsz = (nM - fm) < 8 ? (nM - fm) : 8;
            u.pm = fm + ((wgid % nig) % gsz); u.pn = (wgid % nig) / gsz;
        }
        u.e = 0; u.nvalid = 256; u.rows = nullptr; u.rmax = 255;
        u.A = A + (size_t)u.pm * tstepA; u.B = B + (size_t)u.pn * tstepB; return true;
    }
};
}

__device__ __forceinline__ int map_in(int n) { return n < 1792 ? n : (n < 3840 ? n + 24 : (n < 3864 ? 1792 + (n - 3840) : -1)); }
__device__ __forceinline__ int map_il128(int n) { const int b = n >> 7; return (b & 1) * 1024 + (b >> 1) * 128 + (n & 127); }

struct TrJob { const float* W; bf16_t* Wt; int K, Nsrc, map, kt, nt; float f8scale; };
constexpr int TR_IN = 16 * 16, TR_GLU = 8 * 8, TR_NSA = 8 * 4, TR_OUT = 16 * 4, TR_C1 = 2 * 32, TR_GU = 32 * 16 * 8, TR_DN = 32 * 16 * 4;
constexpr int TR_ITEMS = TR_IN + TR_GLU + TR_NSA + TR_OUT + TR_C1 + TR_GU + TR_DN;
__device__ __forceinline__ void tr_job(const Params& p, int r, TrJob& j) {
    unsigned char* ws = p.ws;
    if (r < TR_IN) { j = TrJob{p.in[5], (bf16_t*)(ws + O_WT_IN), 1024, 3864, 1, r / 16, r % 16, WGU_SCALE}; return; } r -= TR_IN;
    if (r < TR_GLU) { j = TrJob{p.in[14], (bf16_t*)(ws + O_WT_GLU), 512, 2048, 2, r / 8, r % 8, WGLU_SCALE}; return; } r -= TR_GLU;
    if (r < TR_NSA) { j = TrJob{p.in[22], (bf16_t*)(ws + O_WT_NSA), 512, 1024, 0, r / 4, r % 4, WNSA_SCALE}; return; } r -= TR_NSA;
    if (r < TR_OUT) { j = TrJob{p.in[23], (bf16_t*)(ws + O_WT_OUT), 1024, 1024, 0, r / 4, r % 4, WOUT_SCALE}; return; } r -= TR_OUT;
    if (r < TR_C1) { const int kv = r / 32; j = TrJob{p.in[kv ? 20 : 17], (bf16_t*)(ws + O_WT_C1) + (size_t)kv * 256 * 2048, 2048, 128, 3, r % 32, 0, 0.f}; return; } r -= TR_C1;
    if (r < TR_GU) { const int e = r / 128, q = r % 128; j = TrJob{p.in[28] + (size_t)e * 1024 * 2048, (bf16_t*)(ws + O_WT_GU + (size_t)e * 2048 * 1024), 1024, 2048, 2, q / 8, q % 8, WGU_SCALE}; return; } r -= TR_GU;
    { const int e = r / 64, q = r % 64; j = TrJob{p.in[30] + (size_t)e * 1024 * 1024, (bf16_t*)(ws + O_WT_DN + (size_t)e * 1024 * 1024), 1024, 1024, 0, q / 4, q % 4, WDN_SCALE}; }
}
__device__ __forceinline__ void tr_load(const TrJob& j, f32x4 (&v)[8], int tid) {
    const int n4 = tid & 63, kq = tid >> 6, nd = j.nt * 256 + 4 * n4;
    const int src = j.map == 0 ? nd : (j.map == 1 ? map_in(nd) : (j.map == 2 ? map_il128(nd) : (nd < 128 ? nd : -1)));
    const float* base = j.W + (size_t)(j.kt * 64 + kq) * j.Nsrc + (src >= 0 ? src : 0);
#pragma unroll
    for (int i = 0; i < 8; ++i) v[i] = (src >= 0) ? __builtin_nontemporal_load((const f32x4*)(base + (size_t)i * 8 * j.Nsrc)) : (f32x4){0.f, 0.f, 0.f, 0.f};
}
__device__ __forceinline__ void tr_store(const TrJob& cj, const float* t, int tid) {
    if (cj.f8scale != 0.f) {
        const int n = tid & 255, kh = (tid >> 8) * 32; const float sc = cj.f8scale;
        unsigned char* d = (unsigned char*)cj.Wt + (size_t)(cj.nt * 256 + n) * cj.K + cj.kt * 64 + kh;
#pragma unroll
        for (int q = 0; q < 2; ++q) {
            const float* c = t + (kh + 16 * q) * 260 + n;
            u32x4 o;
            o.x = pk4_f8(c[0] * sc, c[260] * sc, c[2 * 260] * sc, c[3 * 260] * sc); o.y = pk4_f8(c[4 * 260] * sc, c[5 * 260] * sc, c[6 * 260] * sc, c[7 * 260] * sc);
            o.z = pk4_f8(c[8 * 260] * sc, c[9 * 260] * sc, c[10 * 260] * sc, c[11 * 260] * sc); o.w = pk4_f8(c[12 * 260] * sc, c[13 * 260] * sc, c[14 * 260] * sc, c[15 * 260] * sc);
            *(u32x4*)(d + 16 * q) = o;
        }
    } else {
        const int n = tid & 255, kh = (tid >> 8) * 32;
        bf16_t* d = cj.Wt + (size_t)(cj.nt * 256 + n) * cj.K + cj.kt * 64 + kh;
#pragma unroll
        for (int q = 0; q < 4; ++q) {
            const float* c = t + (kh + 8 * q) * 260 + n;
            u32x4 o;
            o.x = pk2(c[0], c[260]); o.y = pk2(c[2 * 260], c[3 * 260]); o.z = pk2(c[4 * 260], c[5 * 260]); o.w = pk2(c[6 * 260], c[7 * 260]);
            *(u32x4*)(d + 8 * q) = o;
        }
    }
}
__device__ __forceinline__ void convert_weights(const Params& p, unsigned char* smem, int lo, int hi, unsigned* queue) {
    float* t = (float*)smem;
    int* slot = (int*)(smem + 64 * 260 * 4);
    const int tid = threadIdx.x, n4 = tid & 63, kq = tid >> 6;
    const int G = gridDim.x;
    int ia, ib;
    if (queue) { if (tid == 0) { slot[0] = lo + (int)atomicAdd(queue, 1u); slot[1] = lo + (int)atomicAdd(queue, 1u); } __syncthreads(); ia = slot[0]; ib = slot[1]; __syncthreads(); }
    else { ia = lo + blockIdx.x; ib = ia + G; }
    if (ia >= hi) return;
    TrJob ja, jb; f32x4 va[8], vb[8];
    tr_job(p, ia, ja); tr_load(ja, va, tid);
    if (ib < hi) { tr_job(p, ib, jb); tr_load(jb, vb, tid); }
#define TR_ROUND(I, J, V) do { \
        _Pragma("unroll") for (int i = 0; i < 8; ++i) *(f32x4*)(t + (i * 8 + kq) * 260 + 4 * n4) = V[i]; \
        if (queue && tid == 0) slot[0] = lo + (int)atomicAdd(queue, 1u); \
        __syncthreads(); \
        const TrJob cj_ = J; \
        I = queue ? slot[0] : I + 2 * G; \
        if (I < hi) { tr_job(p, I, J); tr_load(J, V, tid); } \
        tr_store(cj_, t, tid); \
        __syncthreads(); } while (0)
    for (;;) {
        TR_ROUND(ia, ja, va);
        if (ib >= hi) break;
        TR_ROUND(ib, jb, vb);
        if (ia >= hi) break;
    }
#undef TR_ROUND
}

constexpr int TRQ_GU_LO = TR_ITEMS - TR_GU - TR_DN, TRQ_DN_LO = TR_ITEMS - TR_DN;
__device__ __forceinline__ int convert_one(const Params& p, unsigned char* smem, unsigned* queue, int lo, int hi, unsigned* relword, unsigned gen) {
    float* t = (float*)smem; int* slot = (int*)(smem + 64 * 260 * 4);
    const int tid = threadIdx.x;
    if (tid == 0) *slot = lo + (int)atomicAdd(queue, 1u);
    __syncthreads();
    const int it = *slot;
    __syncthreads();
    if (it >= hi) return 0;
    TrJob j; tr_job(p, it, j);
    f32x4 v[8]; tr_load(j, v, tid);
    { const int n4 = tid & 63, kq = tid >> 6;
#pragma unroll
      for (int i = 0; i < 8; ++i) *(f32x4*)(t + (i * 8 + kq) * 260 + 4 * n4) = v[i]; }
    __syncthreads();
    unsigned rw = gen;
    if (tid == 0) rw = xb_ld(relword);
    tr_store(j, t, tid);
    if (tid == 0) slot[1] = (rw != gen) ? 1 : 0;
    __syncthreads();
    return slot[1] ? 2 : 1;
}
__device__ __forceinline__ void xcd_barrier_work(const XcdBarrier& b, const Params& p, unsigned char* smem, bool allow_work) {
    asm volatile("s_waitcnt vmcnt(0)" ::: "memory");
    __syncthreads();
    volatile LAS unsigned* fl = b.st + 2;
    if (threadIdx.x == 0) {
        unsigned* bar = b.bar;
        __builtin_amdgcn_s_waitcnt(0);
        unsigned nloc = b.st[0], nx = b.st[1];
        if (nloc == 0u) { xcd_barrier_complete(bar, b.x, nloc, nx); b.st[0] = nloc; b.st[1] = nx; }
        const unsigned old = xb_add(&bar[XB_XSUB(b.x)], 1u);
        const unsigned gen = old / nloc;
        const bool leader = (old + 1u == (gen + 1u) * nloc);
        fl[0] = leader ? 1u : 0u; fl[1] = gen;
        if (leader) {
            __builtin_amdgcn_fence(__ATOMIC_RELEASE, "agent");
            asm volatile("s_waitcnt vmcnt(0)" ::: "memory");
            const unsigned og = xb_add(&bar[XB_TOP], 1u);
            const unsigned tg = og / nx;
            if (og + 1u == (tg + 1u) * nx) xb_add(&bar[XB_TOPGEN], 1u);
            else XB_SPIN(xb_ld(&bar[XB_TOPGEN]) == tg, bar);
            __builtin_amdgcn_fence(__ATOMIC_ACQUIRE, "agent");
            xb_add(&bar[XB_XGEN(b.x)], 1u);
            asm volatile("s_waitcnt vmcnt(0)" ::: "memory");
        }
    }
    __syncthreads();
    if (fl[0] == 0u) {
        const unsigned gen = fl[1];
        unsigned* bar = b.bar;
        bool more = allow_work, moreA = true;
        bool polled = false;
        for (;;) {
            if (!polled) {
                __syncthreads();
                if (threadIdx.x == 0) fl[0] = (xb_ld(&bar[XB_XGEN(b.x)]) != gen) ? 2u : 0u;
                __syncthreads();
                if (fl[0] == 2u) break;
            }
            polled = false;
            if (more) {
                int r;
                if (moreA) { r = convert_one(p, smem, bar + 3410, TRQ_GU_LO, TRQ_DN_LO, &bar[XB_XGEN(b.x)], gen); if (r == 0) moreA = false; }
                else { r = convert_one(p, smem, bar + 3440, TRQ_DN_LO, TR_ITEMS, &bar[XB_XGEN(b.x)], gen); if (r == 0) more = false; }
                if (r == 2) break;
                polled = (r == 1);
            }
            else { if (threadIdx.x == 0) XB_SPIN(xb_ld(&bar[XB_XGEN(b.x)]) == gen, bar); }
        }
        if (threadIdx.x == 0) { __builtin_amdgcn_fence(__ATOMIC_ACQUIRE, "agent"); asm volatile("s_waitcnt vmcnt(0)" ::: "memory"); }
        __syncthreads();
    }
}

__device__ __forceinline__ void phase0(const Params& p, unsigned char* smem) {
    unsigned char* ws = p.ws;
    const int tid = threadIdx.x;
    convert_weights(p, smem, 0, TR_ITEMS - TR_GU - TR_DN, nullptr);
    constexpr int I_ADA = 96;
    constexpr int I_S5 = 32 * 33;
    constexpr int I_MISC = 17;
    constexpr int NITEM = I_ADA + I_S5 + I_MISC;
    for (int item = blockIdx.x; item < NITEM; item += gridDim.x) {
        int r = item;
        if (r < I_ADA) {
            const float* c = p.in[1]; const float* w = p.in[3]; const float* bb = p.in[4];
            const int wid = tid >> 6, lane = tid & 63, j = r * 64 + lane;
            float a0 = 0.f, a1 = 0.f, a2 = 0.f, a3 = 0.f;
#pragma unroll 4
            for (int k = wid * 128; k < wid * 128 + 128; ++k) {
                const float wv = w[(size_t)k * 6144 + j];
                const float c0 = c[k], c1 = c[1024 + k], c2 = c[2048 + k], c3 = c[3072 + k];
                a0 += c0 * sigmoidf_(c0) * wv; a1 += c1 * sigmoidf_(c1) * wv; a2 += c2 * sigmoidf_(c2) * wv; a3 += c3 * sigmoidf_(c3) * wv;
            }
            float* red = (float*)smem;
            red[(wid * 4 + 0) * 64 + lane] = a0; red[(wid * 4 + 1) * 64 + lane] = a1; red[(wid * 4 + 2) * 64 + lane] = a2; red[(wid * 4 + 3) * 64 + lane] = a3;
            __syncthreads();
            if (tid < 256) { const int b = tid >> 6; float s = 0.f;
#pragma unroll
              for (int w8 = 0; w8 < 8; ++w8) s += red[(w8 * 4 + b) * 64 + lane];
              ((float*)(ws + O_ADA))[b * 6144 + j] = s + bb[j]; }
            asm volatile("s_waitcnt vmcnt(0)" ::: "memory");
            __syncthreads();
            if (tid == 0) { __builtin_amdgcn_fence(__ATOMIC_RELEASE, "agent"); asm volatile("s_waitcnt vmcnt(0)" ::: "memory"); (void)xb_add((unsigned*)(ws + O_BAR) + 3400, 1u); }
            continue;
        }
        r -= I_ADA;
        if (r < I_S5) {
            const int g = r / 33, dl = r % 33;
            f32x2* pw = (f32x2*)smem;
            f32x2* bbv = pw + 64;
            f32x2* ccv = bbv + 1024;
            const float dt = expf(p.in[8][g]);
            if (tid < 64) {
                const int n = tid; const double re = p.in[6][g * 64 + n], im = p.in[7][g * 64 + n];
                const float mag = __expf((float)(re * (double)dt * dl)); const double ang = im * (double)dt * dl;
                const float ar = (float)(ang - 6.283185307179586 * rint(ang * 0.15915494309189535));
                float sn, cs; sincosf(ar, &sn, &cs);
                pw[n] = (f32x2){mag * cs, mag * sn};
                if (dl == 32) { ((f32x2*)(ws + O_LAML))[g * 64 + n] = pw[n]; }
            }
            for (int e = tid; e < 1024; e += NT) {
                const int n = e >> 4, q = e & 15;
                const double re = p.in[6][g * 64 + n], im = p.in[7][g * 64 + n];
                const double ang = im * (double)dt;
                const float ar = (float)(ang - 6.283185307179586 * rint(ang * 0.15915494309189535));
                float snf, csf; sincosf(ar, &snf, &csf);
                const double mag = exp(re * (double)dt), sn = snf, cs = csf;
                const double lr = mag * cs - 1.0, li = mag * sn;
                const double den = re * re + im * im;
                const double fr_ = (lr * re + li * im) / den, fi_ = (li * re - lr * im) / den;
                const double br = p.in[9][(g * 64 + n) * 16 + q], bi = p.in[10][(g * 64 + n) * 16 + q];
                bbv[e] = (f32x2){(float)(fr_ * br - fi_ * bi), (float)(fr_ * bi + fi_ * br)};
            }
            for (int e = tid; e < 1024; e += NT) { ccv[e] = (f32x2){p.in[11][g * 1024 + e], p.in[12][g * 1024 + e]}; }
            __syncthreads();
            bf16_t* TW2 = (bf16_t*)(ws + O_TW2) + (size_t)g * 512 * UROW;
            bf16_t* W1T = (bf16_t*)(ws + O_W1T) + (size_t)g * 256 * 512;
            if (dl < 32) {
                if (tid < 256) {
                    const int pp = tid >> 4, q = tid & 15;
                    float acc = 0.f;
                    for (int n = 0; n < 64; ++n) {
                        const f32x2 cv = ccv[pp * 64 + n], pv = pw[n], bv = bbv[n * 16 + q];
                        const float xr = cv.x * pv.x - cv.y * pv.y, xi = cv.x * pv.y + cv.y * pv.x;
                        acc += xr * bv.x - xi * bv.y;
                    }
                    if (dl == 0 && pp == q) acc += p.in[13][g * 16 + pp];
                    const bf16_t kb = f2bf(acc);
                    for (int tau = dl; tau < 32; ++tau) { const int s = tau - dl; TW2[(size_t)(tau * 16 + pp) * UROW + s * 16 + q] = kb; }
                    if (dl >= 1) for (int s = dl; s < 32; ++s) { const int tau = s - dl; TW2[(size_t)(tau * 16 + pp) * UROW + s * 16 + q] = 0; }
                }
                const int s = 31 - dl;
                for (int e = tid; e < 2048; e += NT) {
                    const int c = e >> 4, qq = e & 15, n = c & 63, ri = c >> 6;
                    const f32x2 pv = pw[n], bv = bbv[n * 16 + qq];
                    const float zr = pv.x * bv.x - pv.y * bv.y, zi = pv.x * bv.y + pv.y * bv.x;
                    W1T[(size_t)c * 512 + s * 16 + qq] = f2bf(ri ? zi : zr);
                }
            } else {
                u32x4* z = (u32x4*)(W1T + (size_t)128 * 512);
                for (int e = tid; e < 128 * 512 / 8; e += NT) z[e] = (u32x4){0u, 0u, 0u, 0u};
            }
            if (dl >= 1) {
                const int tau = dl - 1;
                for (int e = tid; e < 2048; e += NT) {
                    const int pp = e >> 7, c = e & 127, n = c & 63, ri = c >> 6;
                    const f32x2 cv = ccv[pp * 64 + n], pv = pw[n];
                    const float xr = cv.x * pv.x - cv.y * pv.y, xi = cv.x * pv.y + cv.y * pv.x;
                    TW2[(size_t)(tau * 16 + pp) * UROW + 512 + c] = f2bf(ri ? -xi : xr);
                }
            }
            __syncthreads();
            continue;
        }
        r -= I_S5;
        if (r < 16) {
            const int kv = r >> 3, part = r & 7, j = tid & 127, qtr = tid >> 7;
            const float* pos = p.in[kv ? 19 : 16]; const float* w1 = p.in[kv ? 20 : 17];
            float a = 0.f;
            const int i0 = part * 256 + qtr * 64;
            for (int i = i0; i < i0 + 64; ++i) a += pos[i] * w1[(size_t)i * 128 + j];
            float* red = (float*)smem;
            red[tid] = a;
            __syncthreads();
            if (tid < 128) ((float*)(ws + O_BIAS1))[(kv * 8 + part) * 128 + tid] = (red[tid] + red[tid + 128]) + (red[tid + 256] + red[tid + 384]);
            __syncthreads();
            continue;
        }
        for (int i = tid; i < 1100; i += NT) ((unsigned*)(ws + O_CNT))[i] = 0u;
    }
}

__device__ __forceinline__ void phase1(const Params& p, unsigned char*) {
    if (threadIdx.x == 0) { unsigned* f = (unsigned*)(p.ws + O_BAR) + 3400; XB_SPIN(xb_ld(f) < 96u, (unsigned*)(p.ws + O_BAR)); __builtin_amdgcn_fence(__ATOMIC_ACQUIRE, "agent"); asm volatile("s_waitcnt vmcnt(0)" ::: "memory"); }
    __syncthreads();
    const float* x = p.in[0];
    unsigned char* xn = p.ws + O_XN;
    const int lane = threadIdx.x & 63, wid = threadIdx.x >> 6, G = gridDim.x, nit = NTOK / NWV;
    int item = blockIdx.x;
    if (item >= nit) return;
    f32x4 sc[2][2], sh[2][2]; int curb = -1;
#define P1_ADA(TOK) do { const int b_ = (TOK) >> 13; if (b_ != curb) { curb = b_; const float* ada_ = (const float*)(p.ws + O_ADA) + b_ * 6144; \
        _Pragma("unroll") for (int j = 0; j < 2; ++j) { const int c = j * 512 + lane * 8; sc[j][0] = *(const f32x4*)(ada_ + 1024 + c) + 1.f; sc[j][1] = *(const f32x4*)(ada_ + 1024 + c + 4) + 1.f; \
            sh[j][0] = *(const f32x4*)(ada_ + c); sh[j][1] = *(const f32x4*)(ada_ + c + 4); } } } while (0)
#define P1_LOAD(R, TOK) do { _Pragma("unroll") for (int j = 0; j < 2; ++j) { const float* xp_ = x + (size_t)(TOK) * 1024 + j * 512 + lane * 8; R[j][0] = *(const f32x4*)xp_; R[j][1] = *(const f32x4*)(xp_ + 4); } } while (0)
#define P1_STORE(R, TOK) do { _Pragma("unroll") for (int j = 0; j < 2; ++j) { const f32x4 y0 = R[j][0] * sc[j][0] + sh[j][0], y1 = R[j][1] * sc[j][1] + sh[j][1]; \
        *(u32x2*)(xn + (size_t)(TOK) * 1024 + j * 512 + lane * 8) = (u32x2){pk4_f8(y0[0], y0[1], y0[2], y0[3]), pk4_f8(y1[0], y1[1], y1[2], y1[3])}; } } while (0)
    f32x4 ra[2][2], rb[2][2];
    P1_ADA(item * NWV + wid);
    P1_LOAD(ra, item * NWV + wid);
#pragma unroll 1
    for (;;) {
        const int ta = item * NWV + wid, ib = item + G;
        if (ib < nit) P1_LOAD(rb, ib * NWV + wid);
        P1_STORE(ra, ta);
        if (ib >= nit) break;
        const int tb = ib * NWV + wid; item = ib + G;
        P1_ADA(tb);
        if (item < nit) P1_LOAD(ra, item * NWV + wid);
        P1_STORE(rb, tb);
        if (item >= nit) break;
        P1_ADA(item * NWV + wid);
    }
#undef P1_ADA
#undef P1_LOAD
#undef P1_STORE
}

typedef const f32x4 (&AccRef)[2][2][4][2];
struct EpiIn {
    static constexpr bool PERM = true;
    unsigned char* ws;
    __device__ __forceinline__ void operator()(AccRef acc, const pg8::Unit& u, int wr, int wc, int fr, int fq) const {
        const int pn = u.pn;
#pragma unroll
        for (int ai = 0; ai < 2; ++ai)
#pragma unroll
            for (int m = 0; m < 4; ++m) {
                const int token = u.pm * 256 + ai * 128 + wr * 64 + m * 16 + fr;
#pragma unroll
                for (int bj = 0; bj < 2; ++bj) {
                    const int col = pn * 256 + bj * 128 + wc * 32 + 8 * fq;
                    const f32x4 v0 = acc[ai][bj][m][0] * (1.f / WGU_SCALE), v1 = acc[ai][bj][m][1] * (1.f / WGU_SCALE);
                    if (pn < 2) {
                        const int g = col >> 4, q = col & 15;
                        bf16_t* d = (bf16_t*)(ws + O_U) + ((size_t)(g * 1024 + (token >> 5)) * UROW + (token & 31) * 16 + q);
                        *(u32x4*)d = (u32x4){pk2(v0[0], v0[1]), pk2(v0[2], v0[3]), pk2(v1[0], v1[1]), pk2(v1[2], v1[3])};
                    } else if (pn < 4) {
                        bf16_t* d = (bf16_t*)(ws + O_Q) + (size_t)token * 512 + (col - 512);
                        *(u32x4*)d = (u32x4){pk2(v0[0] * QSCALE, v0[1] * QSCALE), pk2(v0[2] * QSCALE, v0[3] * QSCALE), pk2(v1[0] * QSCALE, v1[1] * QSCALE), pk2(v1[2] * QSCALE, v1[3] * QSCALE)};
                    } else if (pn < 7) {
                        const int c = col - 1024, j6 = c >> 7, g = (c >> 6) & 1, dd = c & 63, b = token >> 13, s = token & 8191;
                        bf16_t* slab = (bf16_t*)(ws + O_KV) + (size_t)((j6 * 4 + b) * 2 + g) * KV_SLAB;
                        unsigned char* kvb = ws + O_KV;
                        const unsigned slabo = (unsigned)((j6 * 4 + b) * 2 + g) * (unsigned)(KV_SLAB * 2);
                        if (j6 == 3 || j6 == 5) {
                            const int p64 = s & 63, w5 = p64 & 31, rr = (w5 & 3) + 4 * (w5 >> 3);
                            const unsigned bo = slabo + (unsigned)(s >> 6) * 4096u + (unsigned)(((p64 >> 5) * 64 + ((w5 >> 2) & 1) * 32) * 16 + rr);
#pragma unroll
                            for (int j = 0; j < 4; ++j) { const int d0 = dd + j, d1 = dd + 4 + j;
                                kvb[bo + (unsigned)(((d0 >> 5) * 128 + (d0 & 31)) * 16)] = (unsigned char)__builtin_amdgcn_cvt_pk_fp8_f32(v0[j], v0[j], 0, false);
                                kvb[bo + (unsigned)(((d1 >> 5) * 128 + (d1 & 31)) * 16)] = (unsigned char)__builtin_amdgcn_cvt_pk_fp8_f32(v1[j], v1[j], 0, false); }
                        } else if (j6 == 2 || j6 == 4) {
                            const unsigned bo = slabo + (unsigned)(s >> 6) * 4096u + (unsigned)(((((s >> 5) & 1) * 2 + ((dd >> 4) & 1)) * 64 + (dd >> 5) * 32 + (s & 31)) * 16 + (dd & 15));
                            *(u32x2*)(kvb + bo) = (u32x2){pk4_f8(v0[0], v0[1], v0[2], v0[3]), pk4_f8(v1[0], v1[1], v1[2], v1[3])};
                        } else {
                            *(u32x4*)(slab + (size_t)s * 64 + dd) = (u32x4){pk2(v0[0], v0[1]), pk2(v0[2], v0[3]), pk2(v1[0], v1[1]), pk2(v1[2], v1[3])};
                        }
                    } else if (pn < 15) {
                        bf16_t* d = (pn < 11 ? (bf16_t*)(ws + O_SG5) + (size_t)token * 1024 + (col - 1792) : (bf16_t*)(ws + O_SGN) + (size_t)token * 1024 + (col - 2816));
                        const f32x4 g0 = sigmoid4(v0), g1 = sigmoid4(v1);
                        *(u32x4*)d = (u32x4){pk2(g0[0], g0[1]), pk2(g0[2], g0[3]), pk2(g1[0], g1[1]), pk2(g1[2], g1[3])};
                    } else {
                        const int c = col - 3840;
                        if (c < 24) { float* d = (float*)(ws + O_GN) + (size_t)token * 24 + c;
                            *(f32x4*)d = (f32x4){sigmoidf_(v0[0]), sigmoidf_(v0[1]), sigmoidf_(v0[2]), sigmoidf_(v0[3])};
                            *(f32x4*)(d + 4) = (f32x4){sigmoidf_(v1[0]), sigmoidf_(v1[1]), sigmoidf_(v1[2]), sigmoidf_(v1[3])}; }
                    }
                }
            }
    }
};
__device__ __forceinline__ void phase2(const Params& p, LAS unsigned char* lds) {
    pg8::DenseOrder S; S.init(p.ws + O_XN, p.ws + O_WT_IN, NTOK, NIN_PAD, 512, 512, gridDim.x, blockIdx.x);
    EpiIn E{p.ws};
    pg8::gemm_phase<EpiIn, pg8::DenseOrder, true, true>(lds, 512, 512, 512, S, E);
}

struct BatchOrder {
    const char* A; const char* B; size_t bsA, bsB, tstepA, tstepB; int nM, nN, nunits, G, c;
    __device__ __forceinline__ bool next(int i, pg8::Unit& u) const {
        const long L = (long)i * G + c; if (L >= nunits) return false;
        const int per = nM * nN, bt = (int)L / per, rem = (int)L % per;
        u.pm = rem / nN; u.pn = rem % nN; u.e = bt; u.nvalid = 256; u.rows = nullptr; u.rmax = 255;
        u.A = A + (size_t)bt * bsA + (size_t)u.pm * tstepA; u.B = B + (size_t)bt * bsB + (size_t)u.pn * tstepB; return true;
    }
};
struct EpiE { static constexpr bool PERM = false; float* E;
    __device__ __forceinline__ void operator()(AccRef acc, const pg8::Unit& u, int wr, int wc, int fr, int fq) const {
#pragma unroll
        for (int ai = 0; ai < 2; ++ai)
#pragma unroll
            for (int m = 0; m < 4; ++m) {
                const int r = u.pm * 256 + ai * 128 + wr * 64 + m * 16 + fr;
#pragma unroll
                for (int n = 0; n < 2; ++n) *(f32x4*)(E + ((size_t)u.e * 1024 + r) * 128 + wc * 32 + n * 16 + fq * 4) = acc[ai][0][m][n];
            }
    } };
struct EpiCmp { static constexpr bool PERM = false; float* HCP;
    __device__ __forceinline__ void operator()(AccRef acc, const pg8::Unit& u, int wr, int wc, int fr, int fq) const {
#pragma unroll
        for (int ai = 0; ai < 2; ++ai)
#pragma unroll
            for (int m = 0; m < 4; ++m) {
                const int R = u.pm * 256 + ai * 128 + wr * 64 + m * 16 + fr;
#pragma unroll
                for (int n = 0; n < 2; ++n) *(f32x4*)(HCP + ((size_t)u.e * 4096 + R) * 128 + wc * 32 + n * 16 + fq * 4) = acc[ai][0][m][n];
            }
    } };
struct CmpOrder {
    const char* A; const char* B; int G, c;
    __device__ __forceinline__ bool next(int i, pg8::Unit& u) const {
        const long L = (long)i * G + c; if (L >= 128) return false;
        const int bt = (int)L >> 4, pm = (int)L & 15, kv = bt >> 2, sp = bt & 3;
        u.pm = pm; u.pn = 0; u.e = bt; u.nvalid = 256; u.rows = nullptr; u.rmax = 255; u.gidx = 0;
        u.A = A + (size_t)kv * (8 * KV_SLAB * 2) + (size_t)sp * 1024 + (size_t)pm * (256 * 1024 * 2);
        u.B = B + (size_t)kv * (256 * 2048 * 2) + (size_t)sp * 1024; return true;
    }
};
__device__ __forceinline__ void phase3(const Params& p, LAS unsigned char* lds) {
    const int G = gridDim.x;
    {
        BatchOrder S{(const char*)(p.ws + O_U), (const char*)(p.ws + O_W1T), (size_t)1024 * UROW * 2, (size_t)256 * 512 * 2, (size_t)256 * UROW * 2, 0, 4, 1, 128, G, (int)blockIdx.x};
        EpiE E{(float*)(p.ws + O_E)};
        pg8::gemm_phase<EpiE, BatchOrder, false>(lds, 512, UROW, 512, S, E);
    }
    {
        CmpOrder S{(const char*)(p.ws + O_KV), (const char*)(p.ws + O_WT_C1), G, (int)((blockIdx.x + G - 128 % G) % G)};
        EpiCmp E{(float*)(p.ws + O_HC)};
        pg8::gemm_phase<EpiCmp, CmpOrder, false>(lds, 512, 1024, 2048, S, E);
    }
}
__device__ __forceinline__ void scan_item(const Params& p, unsigned char* smem, int b, int g) {
    const int tid = threadIdx.x;
    f32x2* seg = (f32x2*)smem;
    const int n = tid & 63, sg = tid >> 6;
    const f32x2 lm = ((const f32x2*)(p.ws + O_LAML))[g * 64 + n];
    const float* E = (const float*)(p.ws + O_E) + (size_t)(g * 1024 + b * 256 + sg * 32) * 128;
    bf16_t* U = (bf16_t*)(p.ws + O_U) + (size_t)(g * 1024 + b * 256 + sg * 32) * UROW + 512;
    float er[32], ei[32];
#pragma unroll
    for (int c = 0; c < 32; ++c) { er[c] = E[(size_t)c * 128 + n]; ei[c] = E[(size_t)c * 128 + 64 + n]; }
    float hr = 0.f, hi = 0.f;
#pragma unroll
    for (int c = 0; c < 32; ++c) { const float nr = lm.x * hr - lm.y * hi + er[c], ni = lm.x * hi + lm.y * hr + ei[c]; hr = nr; hi = ni; }
    seg[sg * 64 + n] = (f32x2){hr, hi};
    float pr = lm.x, pi = lm.y;
#pragma unroll
    for (int q = 0; q < 5; ++q) { const float nr = pr * pr - pi * pi, ni = 2.f * pr * pi; pr = nr; pi = ni; }
    __syncthreads();
    float sr = 0.f, si = 0.f;
    for (int k = 0; k < sg; ++k) { const f32x2 a = seg[k * 64 + n]; const float nr = pr * sr - pi * si + a.x, ni = pr * si + pi * sr + a.y; sr = nr; si = ni; }
    hr = sr; hi = si;
#pragma unroll
    for (int c = 0; c < 32; ++c) {
        U[(size_t)c * UROW + n] = f2bf(hr); U[(size_t)c * UROW + 64 + n] = f2bf(hi);
        const float nr = lm.x * hr - lm.y * hi + er[c], ni = lm.x * hi + lm.y * hr + ei[c]; hr = nr; hi = ni;
    }
    __syncthreads();
}
__device__ __forceinline__ void w2_item(const Params& p, unsigned char* smem, int it) {
    const int tid = threadIdx.x;
    float* hb = (float*)smem;
    float* w2s = hb + 16 * 128;
    const int kv = it >> 8, R0 = (it & 255) * 16;
    __syncthreads();
    { const f32x4* w2g = (const f32x4*)p.in[kv ? 21 : 18];
#pragma unroll
      for (int q = 0; q < 4; ++q) ((f32x4*)w2s)[q * NT + tid] = w2g[q * NT + tid]; }
    { const float* hp = (const float*)(p.ws + O_HC); const float* b1p = (const float*)(p.ws + O_BIAS1) + kv * 8 * 128;
#pragma unroll
      for (int q = 0; q < 4; ++q) { const int e = q * NT + tid, r = e >> 7, j = e & 127; float a = 0.f;
#pragma unroll
          for (int sp = 0; sp < 4; ++sp) a += hp[((size_t)(kv * 4 + sp) * 4096 + R0 + r) * 128 + j];
#pragma unroll
          for (int part = 0; part < 8; ++part) a += b1p[part * 128 + j];
          hb[e] = gelu_tanh(a); } }
    __syncthreads();
#pragma unroll 1
    for (int rep = 0; rep < 2; ++rep) {
        const int o = rep * NT + tid, d = o & 63, r = o >> 6, R = R0 + r;
        float a0 = 0.f, a1 = 0.f;
#pragma unroll 16
        for (int j = 0; j < 128; j += 2) { a0 += hb[r * 128 + j] * w2s[j * 64 + d]; a1 += hb[r * 128 + j + 1] * w2s[(j + 1) * 64 + d]; }
        const float a = a0 + a1;
        const int bgi = R >> 9, n = R & 511;
        if (kv == 0) ((bf16_t*)(p.ws + O_KC))[(size_t)bgi * 512 * 64 + (size_t)((n >> 5) * 4 + (d >> 4)) * 512 + (((d >> 3) & 1) * 32 + (n & 31)) * 8 + (d & 7)] = f2bf(a);
        else { const int p64 = n & 63, p16 = p64 & 15, slot = (p16 & 3) | ((p16 & 4) << 1) | ((p16 & 8) >> 1);
               ((bf16_t*)(p.ws + O_KC))[(size_t)4096 * 64 + (size_t)bgi * 64 * 512 + (size_t)(n >> 6) * 4096 + ((((d >> 5) * 2 + (p64 >> 5)) * 2 + ((p64 >> 4) & 1)) * 64 + (slot >> 3) * 32 + (d & 31)) * 8 + (slot & 7)] = f2bf(a); }
    }
}
__device__ __forceinline__ void phase4(const Params& p, unsigned char* smem) {
    for (int item = blockIdx.x; item < 768; item += gridDim.x) {
        if (item < 128) scan_item(p, smem, item >> 5, item & 31);
        else if (item < 512 || item >= 640) w2_item(p, smem, item < 512 ? item - 128 : item - 256);
    }
}
struct EpiY { static constexpr bool PERM = true; static constexpr bool STAGED = false; unsigned char* YS;
    __device__ __forceinline__ void operator()(AccRef acc, const pg8::Unit& u, int wr, int wc, int fr, int fq) const {
        const bool odd = (fq & 1) != 0;
#pragma unroll
        for (int ai = 0; ai < 2; ++ai)
#pragma unroll
            for (int mp = 0; mp < 2; ++mp) {
                const int r = u.pm * 256 + ai * 128 + wr * 64 + (2 * mp + (odd ? 1 : 0)) * 16 + fr;
                const int tok0 = (r >> 8) * SEQ + (r & 255) * S5L;
#pragma unroll
                for (int bj = 0; bj < 2; ++bj) {
                    const int col = u.pn * 256 + bj * 128 + wc * 32 + 8 * fq, tau = col >> 4;
                    unsigned w[2][2];
#pragma unroll
                    for (int mm = 0; mm < 2; ++mm) {
                        const int m = 2 * mp + mm;
                        const f32x4 g0 = gelu4s(acc[ai][bj][m][0], YS_SCALE), g1 = gelu4s(acc[ai][bj][m][1], YS_SCALE);
                        w[mm][0] = pk4_f8(g0[0], g0[1], g0[2], g0[3]); w[mm][1] = pk4_f8(g1[0], g1[1], g1[2], g1[3]);
                    }
                    const unsigned s0 = odd ? w[0][0] : w[1][0], s1 = odd ? w[0][1] : w[1][1];
                    const unsigned r0 = (unsigned)__shfl_xor((int)s0, 16), r1 = (unsigned)__shfl_xor((int)s1, 16);
                    const u32x4 ov = odd ? (u32x4){r0, r1, w[1][0], w[1][1]} : (u32x4){w[0][0], w[0][1], r0, r1};
                    *(u32x4*)(YS + (size_t)(tok0 + tau) * 512 + u.e * 16) = ov;
                }
            }
    } };
__device__ __forceinline__ void phase5(const Params& p, LAS unsigned char* lds) {
    BatchOrder S{(const char*)(p.ws + O_U), (const char*)(p.ws + O_TW2), (size_t)1024 * UROW * 2, (size_t)512 * UROW * 2, (size_t)256 * UROW * 2, (size_t)256 * UROW * 2, 4, 2, 256, (int)gridDim.x, (int)blockIdx.x};
    EpiY E{p.ws + O_YS};
    pg8::gemm_phase<EpiY, BatchOrder, false>(lds, UROW, UROW, UROW, S, E);
}
__device__ __forceinline__ void xf_publish(const Params& p, int flag) {
    asm volatile("s_waitcnt vmcnt(0)" ::: "memory");
    __syncthreads();
    if (threadIdx.x == 0) { __builtin_amdgcn_fence(__ATOMIC_RELEASE, "agent"); asm volatile("s_waitcnt vmcnt(0)" ::: "memory"); (void)xb_add((unsigned*)(p.ws + O_BAR) + XF_BASE + 32 * flag, 1u); }
}
__device__ __forceinline__ void xf_wait(const Params& p, int flag, unsigned need) {
    if (threadIdx.x == 0) { unsigned* f = (unsigned*)(p.ws + O_BAR) + XF_BASE + 32 * flag; XB_SPIN(xb_ld(f) < need, (unsigned*)(p.ws + O_BAR)); __builtin_amdgcn_fence(__ATOMIC_ACQUIRE, "agent"); asm volatile("s_waitcnt vmcnt(0)" ::: "memory"); }
    __syncthreads();
}
__device__ __forceinline__ void phase345(const Params& p, unsigned char* smem, LAS unsigned char* lds) {
    const int L = blockIdx.x, BIG = 1 << 20;
    if (L < 128) {
        {
            BatchOrder S{(const char*)(p.ws + O_U), (const char*)(p.ws + O_W1T), (size_t)1024 * UROW * 2, (size_t)256 * 512 * 2, (size_t)256 * UROW * 2, 0, 4, 1, 128, BIG, L};
            EpiE E{(float*)(p.ws + O_E)};
            pg8::gemm_phase<EpiE, BatchOrder, false>(lds, 512, UROW, 512, S, E);
        }
        scan_item(p, smem, L & 3, L >> 2);
        xf_publish(p, L);
        {
            BatchOrder S{(const char*)(p.ws + O_U), (const char*)(p.ws + O_TW2), (size_t)1024 * UROW * 2, (size_t)512 * UROW * 2, (size_t)256 * UROW * 2, (size_t)256 * UROW * 2, 4, 2, 256, BIG, 2 * L};
            EpiY E{p.ws + O_YS};
            pg8::gemm_phase<EpiY, BatchOrder, false>(lds, UROW, UROW, UROW, S, E);
        }
        {
            const int it = 384 + L;
            xf_wait(p, 128 + (it >> 8) * 16 + ((it & 255) >> 4), 4u);
            w2_item(p, smem, it);
        }
    } else {
        const int c = L - 128;
        {
            CmpOrder S{(const char*)(p.ws + O_KV), (const char*)(p.ws + O_WT_C1), BIG, c};
            EpiCmp E{(float*)(p.ws + O_HC)};
            pg8::gemm_phase<EpiCmp, CmpOrder, false>(lds, 512, 1024, 2048, S, E);
        }
        xf_publish(p, 128 + (c >> 6) * 16 + (c & 15));
        for (int q = 0; q < 3; ++q) {
            const int it = c * 3 + q;
            xf_wait(p, 128 + (it >> 8) * 16 + ((it & 255) >> 4), 4u);
            w2_item(p, smem, it);
        }
        xf_wait(p, c, 1u);
        {
            BatchOrder S{(const char*)(p.ws + O_U), (const char*)(p.ws + O_TW2), (size_t)1024 * UROW * 2, (size_t)512 * UROW * 2, (size_t)256 * UROW * 2, (size_t)256 * UROW * 2, 4, 2, 256, BIG, 2 * c + 1};
            EpiY E{p.ws + O_YS};
            pg8::gemm_phase<EpiY, BatchOrder, false>(lds, UROW, UROW, UROW, S, E);
        }
    }
}
struct EpiGlu { static constexpr bool PERM = true; const float* bglu; const bf16_t* SG5; bf16_t* MS5;
    __device__ __forceinline__ void operator()(AccRef acc, const pg8::Unit& u, int wr, int wc, int fr, int fq) const {
        const int cv = u.pn * 128 + wc * 32 + 8 * fq;
        const f32x4 bv0 = *(const f32x4*)(bglu + cv), bv1 = *(const f32x4*)(bglu + cv + 4), bg0 = *(const f32x4*)(bglu + 1024 + cv), bg1 = *(const f32x4*)(bglu + 1024 + cv + 4);
        u32x4 sgv[2][4];
#pragma unroll
        for (int ai = 0; ai < 2; ++ai)
#pragma unroll
            for (int m = 0; m < 4; ++m) sgv[ai][m] = *(const u32x4*)(SG5 + (size_t)(u.pm * 256 + ai * 128 + wr * 64 + m * 16 + fr) * 1024 + cv);
#pragma unroll
        for (int ai = 0; ai < 2; ++ai) {
#pragma unroll
            for (int m = 0; m < 4; ++m) {
                const int token = u.pm * 256 + ai * 128 + wr * 64 + m * 16 + fr;
                const u32x4 sg = sgv[ai][m];
                constexpr float us_ = 1.f / (YS_SCALE * WGLU_SCALE);
                const f32x4 va0 = acc[ai][0][m][0] * us_ + bv0, va1 = acc[ai][0][m][1] * us_ + bv1, ga0 = acc[ai][1][m][0] * us_ + bg0, ga1 = acc[ai][1][m][1] * us_ + bg1;
                const f32x4 s0 = sigmoid4(ga0), s1 = sigmoid4(ga1);
                u32x4 o;
                o.x = pk2(va0[0] * s0[0] * bflo(sg.x), va0[1] * s0[1] * bfhi(sg.x)); o.y = pk2(va0[2] * s0[2] * bflo(sg.y), va0[3] * s0[3] * bfhi(sg.y));
                o.z = pk2(va1[0] * s1[0] * bflo(sg.z), va1[1] * s1[1] * bfhi(sg.z)); o.w = pk2(va1[2] * s1[2] * bflo(sg.w), va1[3] * s1[3] * bfhi(sg.w));
                *(u32x4*)(MS5 + (size_t)token * 1024 + cv) = o;
            }
        }
    } };
__device__ __forceinline__ void phase6(const Params& p, LAS unsigned char* lds) {
    pg8::DenseOrder S; S.init(p.ws + O_YS, p.ws + O_WT_GLU, NTOK, 2048, 256, 256, gridDim.x, blockIdx.x);
    EpiGlu E{p.in[15], (const bf16_t*)(p.ws + O_SG5), (bf16_t*)(p.ws + O_MS5)};
    pg8::gemm_phase<EpiGlu, pg8::DenseOrder, true, true>(lds, 256, 256, 256, S, E);
}
typedef float f32x16 __attribute__((ext_vector_type(16)));
__device__ __forceinline__ int rel_bucket_dev(int dist) {
    const int n = dist > 0 ? dist : 0;
    if (n < 16) return n;
    const int l = (int)(__log2f((float)n * 0.0625f) * 2.6666667f);
    const int v = 16 + l;
    return v < 31 ? v : 31;
}
__device__ __forceinline__ float xhalf_max(float v) { auto rr = __builtin_amdgcn_permlane32_swap(__float_as_uint(v), __float_as_uint(v), false, false); return fmaxf(__uint_as_float(rr[0]), __uint_as_float(rr[1])); }
__device__ __forceinline__ float xhalf_sum(float v) { auto rr = __builtin_amdgcn_permlane32_swap(__float_as_uint(v), __float_as_uint(v), false, false); return __uint_as_float(rr[0]) + __uint_as_float(rr[1]); }
__device__ __forceinline__ float quad_sum(float v) {
    v += __uint_as_float(__builtin_amdgcn_update_dpp(0u, __float_as_uint(v), 0xB1, 0xF, 0xF, true));
    v += __uint_as_float(__builtin_amdgcn_update_dpp(0u, __float_as_uint(v), 0x4E, 0xF, 0xF, true));
    return v;
}
constexpr int LSW = 1168;
constexpr int LWW = 656;
constexpr float RESC_THR = 6.f;
constexpr int IMPW = 132;
constexpr float NEG_BIG = -1e30f;

typedef int v4i_t __attribute__((ext_vector_type(4)));
typedef __amdgpu_buffer_rsrc_t rsrc_t;
__device__ __forceinline__ bf16x8 bload16(rsrc_t r, unsigned voff, unsigned soff) { return __builtin_bit_cast(bf16x8, __builtin_amdgcn_raw_buffer_load_b128(r, (int)voff, (int)soff, 0)); }
__device__ __forceinline__ void load_k(bf16x8 (&kf)[8], rsrc_t r, unsigned soff, unsigned voff) {
#pragma unroll
    for (int i = 0; i < 8; ++i) kf[i] = bload16(r, voff, soff + i * 1024);
}
__device__ __forceinline__ void load_v(bf16x8 (&vf)[8], rsrc_t r, unsigned soff, unsigned voff) {
#pragma unroll
    for (int i = 0; i < 8; ++i) vf[i] = bload16(r, voff, soff + i * 1024);
}
typedef unsigned long long u64x8 __attribute__((ext_vector_type(8)));
__device__ __forceinline__ f32x16 splat16(float c) {
    const unsigned cb = __float_as_uint(c);
    const unsigned long long c2 = ((unsigned long long)cb << 32) | cb;
    u64x8 t;
#pragma unroll
    for (int i = 0; i < 7; ++i) { unsigned long long o; asm volatile("v_mov_b64 %0, %1" : "=v"(o) : "v"(c2)); t[i] = o; }
    { unsigned long long o; asm volatile("v_mov_b64 %0, %1\n\ts_nop 1" : "=v"(o) : "v"(c2)); t[7] = o; }
    return __builtin_bit_cast(f32x16, t);
}
__device__ __forceinline__ void qk_block(f32x16 (&st)[2], const bf16x8 (&qf)[4], const bf16x8 (&kf)[8], float cinit) {
    const f32x16 cin = splat16(cinit);
#pragma unroll
    for (int sub = 0; sub < 2; ++sub) {
        f32x16 acc = cin;
#pragma unroll
        for (int s = 0; s < 4; ++s) acc = __builtin_amdgcn_mfma_f32_32x32x16_bf16(kf[sub * 4 + s], qf[s], acc, 0, 0, 0);
        st[sub] = acc;
    }
}
__device__ __forceinline__ void bias_lut(f32x16 (&st)[2], const float* p) {
    float lv[2][16];
#pragma unroll
    for (int sub = 0; sub < 2; ++sub)
#pragma unroll
        for (int r = 0; r < 16; ++r) lv[sub][r] = p[59 - (32 * sub + (r & 3) + 8 * (r >> 2))];
    __builtin_amdgcn_sched_barrier(0);
#pragma unroll
    for (int sub = 0; sub < 2; ++sub)
#pragma unroll
        for (int r = 0; r < 16; ++r) st[sub][r] += lv[sub][r];
}
__device__ __forceinline__ void bias_mask_cmp(f32x16 (&st)[2], int dist0, const float* lutS) {
#pragma unroll
    for (int sub = 0; sub < 2; ++sub) {
        float bias[16];
#pragma unroll
        for (int r = 0; r < 16; ++r) {
            const int dist = dist0 - 16 * (32 * sub + (r & 3) + 8 * (r >> 2));
            const int idx = dist < 0 ? 0 : (dist > 1024 ? 1024 : dist);
            bias[r] = lutS[64 + idx];
        }
#pragma unroll
        for (int r = 0; r < 16; ++r) {
            const int dist = dist0 - 16 * (32 * sub + (r & 3) + 8 * (r >> 2));
            const float v = st[sub][r] + bias[r];
            st[sub][r] = dist >= 0 ? v : -INFINITY;
        }
    }
}
__device__ __forceinline__ float tile_max(const f32x16 (&st)[2]) {
    float a = __builtin_fmaxf(__builtin_fmaxf(st[0][0], st[0][1]), st[1][0]), b2 = __builtin_fmaxf(__builtin_fmaxf(st[0][2], st[0][3]), st[1][1]);
    a = __builtin_fmaxf(__builtin_fmaxf(a, st[1][2]), st[1][3]);
#pragma unroll
    for (int r = 4; r < 16; r += 4) {
        a = __builtin_fmaxf(__builtin_fmaxf(a, st[0][r]), st[0][r + 1]); b2 = __builtin_fmaxf(__builtin_fmaxf(b2, st[0][r + 2]), st[0][r + 3]);
        a = __builtin_fmaxf(__builtin_fmaxf(a, st[1][r]), st[1][r + 1]); b2 = __builtin_fmaxf(__builtin_fmaxf(b2, st[1][r + 2]), st[1][r + 3]);
    }
    return xhalf_max(__builtin_fmaxf(a, b2));
}
__device__ __forceinline__ void pv_block(f32x16 (&O)[2], const f32x16 (&st)[2], const bf16x8 (&vf)[8]) {
    bf16x8 pf[2][2];
#pragma unroll
    for (int sub = 0; sub < 2; ++sub)
#pragma unroll
        for (int s2 = 0; s2 < 2; ++s2) {
            u32x4 w;
            w.x = pk2(st[sub][8 * s2 + 0], st[sub][8 * s2 + 1]); w.y = pk2(st[sub][8 * s2 + 2], st[sub][8 * s2 + 3]);
            w.z = pk2(st[sub][8 * s2 + 4], st[sub][8 * s2 + 5]); w.w = pk2(st[sub][8 * s2 + 6], st[sub][8 * s2 + 7]);
            pf[sub][s2] = __builtin_bit_cast(bf16x8, w);
        }
#pragma unroll
    for (int dt = 0; dt < 2; ++dt)
#pragma unroll
        for (int sub = 0; sub < 2; ++sub)
#pragma unroll
            for (int s2 = 0; s2 < 2; ++s2) O[dt] = __builtin_amdgcn_mfma_f32_32x32x16_bf16(vf[dt * 4 + sub * 2 + s2], pf[sub][s2], O[dt], 0, 0, 0);
}
template <bool ADJ> __device__ __forceinline__ void softmax_step_t(f32x16 (&st)[2], f32x16 (&sn)[2], f32x16 (&O)[2], float& m, float& l) {
    const float mx = tile_max(st);
    float dl = 0.f;
    if (__any(mx > RESC_THR)) {
        dl = mx > 0.f ? mx : 0.f;
        const float corr = __builtin_amdgcn_exp2f(-dl);
        m += dl; l *= corr;
#pragma unroll
        for (int sub = 0; sub < 2; ++sub)
#pragma unroll
            for (int r = 0; r < 16; ++r) st[sub][r] -= dl;
#pragma unroll
        for (int dt = 0; dt < 2; ++dt)
#pragma unroll
            for (int r = 0; r < 16; ++r) O[dt][r] *= corr;
        if constexpr (ADJ) {
#pragma unroll
            for (int sub = 0; sub < 2; ++sub)
#pragma unroll
                for (int r = 0; r < 16; ++r) sn[sub][r] -= dl;
        }
    }
    f32x2 sum2 = (f32x2){0.f, 0.f};
#pragma unroll
    for (int sub = 0; sub < 2; ++sub)
#pragma unroll
        for (int r = 0; r < 16; r += 2) { const float pe0 = __builtin_amdgcn_exp2f(st[sub][r]), pe1 = __builtin_amdgcn_exp2f(st[sub][r + 1]); st[sub][r] = pe0; st[sub][r + 1] = pe1; sum2 += (f32x2){pe0, pe1}; }
    l += sum2.x + sum2.y;
}
__device__ __forceinline__ void softmax_step(f32x16 (&st)[2], f32x16 (&O)[2], float& m, float& l) { softmax_step_t<false>(st, st, O, m, l); }

constexpr int FLW = 68;
__device__ __forceinline__ void kv_step(f32x16 (&O)[2], float& m, float& l, const bf16x8 (&qf)[4], const bf16x8 (&kf)[8], bf16x8 (&kn)[8], rsrc_t rv, unsigned ksoff_next, unsigned koff,
                                        unsigned vsoff_blk, unsigned vvoff, const float* lutp, bool selme, float b31) {
    bf16x8 vf[8];
    load_v(vf, rv, vsoff_blk, vvoff);
    f32x16 st[2];
    qk_block(st, qf, kf, selme ? (lutp ? -m : b31 - m) : -INFINITY);
    __builtin_amdgcn_sched_barrier(0);
    load_k(kn, rv, ksoff_next, koff);
    if (lutp) bias_lut(st, lutp);
    softmax_step(st, O, m, l);
    pv_block(O, st, vf);
}

typedef int a8_t __attribute__((ext_vector_type(8)));
__device__ __forceinline__ void load_f8x4(u32x4 (&f)[4], rsrc_t r, unsigned soff, unsigned voff) {
#pragma unroll
    for (int i = 0; i < 4; ++i) f[i] = __builtin_bit_cast(u32x4, __builtin_amdgcn_raw_buffer_load_b128(r, (int)voff, (int)soff + i * 1024, 0));
}
__device__ __forceinline__ a8_t join8(u32x4 a, u32x4 b) { a8_t o; o[0] = (int)a.x; o[1] = (int)a.y; o[2] = (int)a.z; o[3] = (int)a.w; o[4] = (int)b.x; o[5] = (int)b.y; o[6] = (int)b.z; o[7] = (int)b.w; return o; }
__device__ __forceinline__ void qk_block8(f32x16 (&st)[2], const a8_t& q8, const u32x4 (&kf)[4], float cinit) {
    const f32x16 cin = splat16(cinit);
#pragma unroll
    for (int sub = 0; sub < 2; ++sub)
        st[sub] = __builtin_amdgcn_mfma_scale_f32_32x32x64_f8f6f4(join8(kf[sub * 2], kf[sub * 2 + 1]), q8, cin, 0, 0, 0, 0x7F7F7F7F, 0, 0x7C7C7C7C);
}
__device__ __forceinline__ void pv_block8(f32x16 (&O)[2], const f32x16 (&st)[2], const u32x4 (&vf)[4]) {
    a8_t pf;
#pragma unroll
    for (int i = 0; i < 8; ++i) { const int sub = i >> 2, r0 = 4 * (i & 3); pf[i] = (int)pk4_f8(st[sub][r0], st[sub][r0 + 1], st[sub][r0 + 2], st[sub][r0 + 3]); }
#pragma unroll
    for (int dt = 0; dt < 2; ++dt)
        O[dt] = __builtin_amdgcn_mfma_scale_f32_32x32x64_f8f6f4(join8(vf[dt * 2], vf[dt * 2 + 1]), pf, O[dt], 0, 0, 0, 0x7F7F7F7F, 0, 0x7F7F7F7F);
}
__device__ __forceinline__ void kv_step8p(f32x16 (&O)[2], float& m, float& l, const a8_t& q8, f32x16 (&sc)[2], f32x16 (&sn)[2], const u32x4 (&kx)[4], u32x4 (&kf)[4], rsrc_t rv, unsigned ksoff_nn, unsigned koff,
                                          unsigned vsoff_cur, unsigned vvoff, const float* lutp_cur, float cinit_next) {
    u32x4 vf[4];
    load_f8x4(vf, rv, vsoff_cur, vvoff);
    qk_block8(sn, q8, kx, cinit_next);
    __builtin_amdgcn_sched_barrier(0);
    load_f8x4(kf, rv, ksoff_nn, koff);
    if (lutp_cur) bias_lut(sc, lutp_cur);
    softmax_step_t<true>(sc, sn, O, m, l);
    pv_block8(O, sc, vf);
}

__device__ __forceinline__ void nsa_tile(const Params& p, int bg, int tg, const float* lutSall, const float* lutWall, float* impw, float* fl, int lane) {
    asm volatile("" : "+v"(lane));
    const int q = lane & 31, h2 = lane >> 5, tok = q >> 2, head = q & 3;
    const int b = bg >> 1, g = bg & 1, t0 = tg * 8, t = t0 + tok, token = b * SEQ + t;
    const float* lutS = lutSall + head * LSW;
    const float* lutW = lutWall + head * LWW;
    const float b31 = lutS[64 + 1024];
    bf16x8 qf[4];
    { const bf16_t* qp = (const bf16_t*)(p.ws + O_Q) + (size_t)token * 512 + (g * 4 + head) * 64 + 8 * h2;
#pragma unroll
      for (int s = 0; s < 4; ++s) qf[s] = *(const bf16x8*)(qp + 16 * s); }
    const float* gn = (const float*)(p.ws + O_GN) + (size_t)token * 24 + (g * 4 + head) * 3;
    const float gn0 = gn[0], gn1 = gn[1], gn2 = gn[2];
    float* flp = fl + q * FLW + 4 * h2;
    f32x16 O[2];
#pragma unroll
    for (int dt = 0; dt < 2; ++dt)
#pragma unroll
        for (int r = 0; r < 16; ++r) O[dt][r] = 0.f;
    const int cur = t0 >> 6;
    { const int u = head + 4 * h2;
#pragma unroll
      for (int i = 0; i < 16; ++i) { impw[tok * IMPW + i * 8 + u] = 0.f; fl[tok * IMPW + i * 8 + u] = 0.f; } }
    WAVE_SYNC();
    bf16x8 kfA[8], kfB[8];
    const rsrc_t rKV = __builtin_amdgcn_make_buffer_rsrc((void*)(p.ws + O_KV), 0, (int)(6 * 8 * KV_SLAB * 2 + 8192), 0x00020000);
    const rsrc_t rKC = __builtin_amdgcn_make_buffer_rsrc((void*)(p.ws + O_KC), 0, (int)(2 * 4096 * 64 * 2), 0x00020000);
    const unsigned koff = (unsigned)lane * 16u, vsoff = koff;

    {
        const unsigned Kc = (unsigned)bg * 512u * 64u * 2u;
        const unsigned VcT = (4096u * 64u + (unsigned)bg * 64u * 512u) * 2u;
        const int tl = t0 + 7;
        const int ncmax = tl >= 31 ? ((tl - 31) >> 4) + 1 : 0;
        const int nblk = (ncmax + 63) >> 6;
        float m = 0.f, l = 0.f;
        f32x16 st[2];
#define CMP_FAR(BLK) (16 * (64 * (BLK) + 63) + 31 + 1024 <= t0)
#define CMP_P1(KF, KN, BLK, BN) do { const bool far_ = CMP_FAR(BLK); qk_block(st, qf, KF, (far_ ? b31 : 0.f) - m); __builtin_amdgcn_sched_barrier(0); load_k(KN, rKC, Kc + (BN) * 8192, koff); \
            if (!far_) bias_mask_cmp(st, t - 31 - 16 * ((BLK) * 64 + 4 * h2), lutS); \
            const float mx_ = tile_max(st); \
            if (__any(mx_ > RESC_THR)) { const float dl_ = mx_ > 0.f ? mx_ : 0.f; m += dl_; l *= __builtin_amdgcn_exp2f(-dl_); \
                _Pragma("unroll") for (int sub = 0; sub < 2; ++sub) _Pragma("unroll") for (int r = 0; r < 16; ++r) st[sub][r] -= dl_; } \
            f32x2 s2_ = (f32x2){0.f, 0.f}; \
            _Pragma("unroll") for (int sub = 0; sub < 2; ++sub) _Pragma("unroll") for (int r = 0; r < 16; r += 2) s2_ += (f32x2){__builtin_amdgcn_exp2f(st[sub][r]), __builtin_amdgcn_exp2f(st[sub][r + 1])}; \
            l += s2_.x + s2_.y; } while (0)
        if (nblk > 0) load_k(kfA, rKC, Kc, koff);
#pragma unroll 1
        for (int blk = 0; blk < nblk; blk += 2) {
            const int b1 = blk + 1 < nblk ? blk + 1 : blk;
            CMP_P1(kfA, kfB, blk, b1);
            if (blk + 1 >= nblk) break;
            const int b2 = blk + 2 < nblk ? blk + 2 : blk + 1;
            CMP_P1(kfB, kfA, blk + 1, b2);
        }
#undef CMP_P1
        l = xhalf_sum(l);
        const float invl = l > 0.f ? 1.f / l : 0.f;
#define CMP_P2(KF, KN, BLK, BN) do { const bool far_ = CMP_FAR(BLK); bf16x8 vf[8]; load_v(vf, rKC, VcT + (BLK) * 8192, koff); \
            qk_block(st, qf, KF, (far_ ? b31 : 0.f) - m); __builtin_amdgcn_sched_barrier(0); load_k(KN, rKC, Kc + (BN) * 8192, koff); \
            if (!far_) bias_mask_cmp(st, t - 31 - 16 * ((BLK) * 64 + 4 * h2), lutS); \
            _Pragma("unroll") for (int sub = 0; sub < 2; ++sub) _Pragma("unroll") for (int r = 0; r < 16; ++r) st[sub][r] = __builtin_amdgcn_exp2f(st[sub][r]) * invl; \
            _Pragma("unroll") for (int sub = 0; sub < 2; ++sub) _Pragma("unroll") for (int a = 0; a < 4; ++a) { \
                const float L_ = quad_sum(st[sub][4 * a + 3]); \
                const float G_ = quad_sum((st[sub][4 * a] + st[sub][4 * a + 1]) + (st[sub][4 * a + 2] + st[sub][4 * a + 3])); \
                const int j_ = (BLK) * 16 + 8 * sub + 2 * a + h2; \
                if (head == 0) { impw[tok * IMPW + j_] = G_; fl[tok * IMPW + j_] = L_; } } \
            pv_block(O, st, vf); } while (0)
        if (nblk > 0) load_k(kfA, rKC, Kc, koff);
#pragma unroll 1
        for (int blk = 0; blk < nblk; blk += 2) {
            const int b1 = blk + 1 < nblk ? blk + 1 : blk;
            CMP_P2(kfA, kfB, blk, b1);
            if (blk + 1 >= nblk) break;
            const int b2 = blk + 2 < nblk ? blk + 2 : blk + 1;
            CMP_P2(kfB, kfA, blk + 1, b2);
        }
#undef CMP_P2
#undef CMP_FAR
    }
    WAVE_SYNC();

    unsigned long long mlo, mhi;
    unsigned key[16];
    { const int u = head + 4 * h2;
#pragma unroll
      for (int i = 0; i < 16; ++i) { const int j = i * 8 + u; const float iv = impw[tok * IMPW + j] + fl[tok * IMPW + (j >= 1 ? j - 1 : 0)];
          key[i] = (cur >= 16 && j >= 1 && j <= cur - 2) ? ((__float_as_uint(iv) & ~127u) | (unsigned)(127 - j)) : 0u; } }
    WAVE_SYNC();
    {
        const float g0 = gn0;
#pragma unroll
        for (int dt = 0; dt < 2; ++dt)
#pragma unroll
            for (int a = 0; a < 4; ++a) {
                *(f32x4*)(flp + dt * 32 + a * 8) = (f32x4){g0 * O[dt][4 * a], g0 * O[dt][4 * a + 1], g0 * O[dt][4 * a + 2], g0 * O[dt][4 * a + 3]};
                O[dt][4 * a] = 0.f; O[dt][4 * a + 1] = 0.f; O[dt][4 * a + 2] = 0.f; O[dt][4 * a + 3] = 0.f;
            }
    }
    if (cur < 16) { mlo = (1ull << (cur + 1)) - 1ull; mhi = 0ull; }
    else {
        const int u = head + 4 * h2;
        mlo = 1ull; mhi = 0ull;
        if (cur < 64) mlo |= 1ull << cur; else mhi |= 1ull << (cur - 64);
        if (cur - 1 < 64) mlo |= 1ull << (cur - 1); else mhi |= 1ull << (cur - 1 - 64);
        (void)u;
#pragma unroll 1
        for (int round = 0; round < 13; ++round) {
            unsigned best = key[0];
#pragma unroll
            for (int i = 1; i < 16; ++i) best = best > key[i] ? best : key[i];
            { const unsigned o = (unsigned)__builtin_amdgcn_update_dpp(0, (int)best, 0xB1, 0xF, 0xF, true); best = best > o ? best : o; }
            { const unsigned o = (unsigned)__builtin_amdgcn_update_dpp(0, (int)best, 0x4E, 0xF, 0xF, true); best = best > o ? best : o; }
            { const unsigned o = (unsigned)__shfl_xor((int)best, 32); best = best > o ? best : o; }
            const int bj = 127 - (int)(best & 127u);
            if (bj < 64) mlo |= 1ull << bj; else mhi |= 1ull << (bj - 64);
#pragma unroll
            for (int i = 0; i < 16; ++i) key[i] = key[i] == best ? 0u : key[i];
        }
    }
    unsigned long long ulo = mlo, uhi = mhi;
#pragma unroll
    for (int o = 4; o < 32; o <<= 1) { ulo |= __shfl_xor(ulo, o); uhi |= __shfl_xor(uhi, o); }
    ulo = ((unsigned long long)__builtin_amdgcn_readfirstlane((unsigned)(ulo >> 32)) << 32) | (unsigned)__builtin_amdgcn_readfirstlane((unsigned)ulo);
    uhi = ((unsigned long long)__builtin_amdgcn_readfirstlane((unsigned)(uhi >> 32)) << 32) | (unsigned)__builtin_amdgcn_readfirstlane((unsigned)uhi);

    a8_t q8;
    { const bf16_t* qp8 = (const bf16_t*)(p.ws + O_Q) + (size_t)token * 512 + (g * 4 + head) * 64 + 32 * h2;
#pragma unroll
      for (int i = 0; i < 4; ++i) { const u32x4 w = *(const u32x4*)(qp8 + 8 * i);
          q8[2 * i] = (int)pk4_f8(bflo(w.x) * 8.f, bfhi(w.x) * 8.f, bflo(w.y) * 8.f, bfhi(w.y) * 8.f); q8[2 * i + 1] = (int)pk4_f8(bflo(w.z) * 8.f, bfhi(w.z) * 8.f, bflo(w.w) * 8.f, bfhi(w.w) * 8.f); } }
    u32x4 k8A[4], k8B[4];
    {
        const unsigned Ks = (unsigned)((2 * 4 + b) * 2 + g) * (unsigned)(KV_SLAB * 2);
        const unsigned VsT = (unsigned)((3 * 4 + b) * 2 + g) * (unsigned)(KV_SLAB * 2);
        float m = 0.f, l = 0.f;
#define POPJ(J) do { if (ulo) { J = __builtin_ctzll(ulo); ulo &= ulo - 1ull; } else if (uhi) { J = 64 + __builtin_ctzll(uhi); uhi &= uhi - 1ull; } else J = -1; } while (0)
#define SEL_INIT(J) ((((J) < 64 ? ((mlo >> (J)) & 1ull) : ((mhi >> ((J) - 64)) & 1ull)) != 0ull) ? ((64 * (J) + 63 + 1024 > t0) ? -m : b31 - m) : -INFINITY)
#define SEL_STEP(SC, SN, KX, KF, J, JN, JNN) kv_step8p(O, m, l, q8, SC, SN, KX, KF, rKV, Ks + (JNN) * 4096, koff, VsT + (J) * 4096, vsoff, \
            (64 * (J) + 63 + 1024 > t0) ? lutS + (t - 64 * (J) - 4 * h2 + 64 - 59) : nullptr, SEL_INIT(JN))
        f32x16 stA[2], stB[2];
        int j0, j1, j2, j3;
        POPJ(j0); POPJ(j1);
        load_f8x4(k8A, rKV, Ks + j0 * 4096, koff);
        load_f8x4(k8B, rKV, Ks + (j1 >= 0 ? j1 : j0) * 4096, koff);
        qk_block8(stA, q8, k8A, SEL_INIT(j0));
#pragma unroll 1
        for (;;) {
            POPJ(j2);
            { const int jn = j1 >= 0 ? j1 : j0, jnn = j2 >= 0 ? j2 : jn; SEL_STEP(stA, stB, k8B, k8A, j0, jn, jnn); }
            if (j1 < 0) break;
            POPJ(j3);
            { const int jn = j2 >= 0 ? j2 : j1, jnn = j3 >= 0 ? j3 : jn; SEL_STEP(stB, stA, k8A, k8B, j1, jn, jnn); }
            if (j2 < 0) break;
            j0 = j2; j1 = j3;
        }
#undef SEL_INIT
#undef SEL_STEP
#undef POPJ
        asm volatile("s_nop 15\n\ts_nop 3" ::: "memory");
        l = xhalf_sum(l);
        const float sc = l > 0.f ? gn1 / l : 0.f;
#pragma unroll
        for (int dt = 0; dt < 2; ++dt)
#pragma unroll
            for (int a = 0; a < 4; ++a) {
                f32x4 f = *(const f32x4*)(flp + dt * 32 + a * 8);
                f[0] += sc * O[dt][4 * a]; f[1] += sc * O[dt][4 * a + 1]; f[2] += sc * O[dt][4 * a + 2]; f[3] += sc * O[dt][4 * a + 3];
                *(f32x4*)(flp + dt * 32 + a * 8) = f;
                O[dt][4 * a] = 0.f; O[dt][4 * a + 1] = 0.f; O[dt][4 * a + 2] = 0.f; O[dt][4 * a + 3] = 0.f;
            }
    }
    {
        const unsigned Kw = (unsigned)((4 * 4 + b) * 2 + g) * (unsigned)(KV_SLAB * 2);
        const unsigned VwT = (unsigned)((5 * 4 + b) * 2 + g) * (unsigned)(KV_SLAB * 2);
        float m = 0.f, l = 0.f;
        const int wlo = t0 - 511;
        const int r_begin = (wlo > 0 ? wlo : 0) & ~63;
        const int r_last = t0 + 7;
#define WIN_STEP(SC, SN, KX, KF, R0, RNN) kv_step8p(O, m, l, q8, SC, SN, KX, KF, rKV, Kw + (RNN) * 64, koff, VwT + (R0) * 64, vsoff, lutW + (t - (R0) - 4 * h2 + 72 - 59), -m)
        f32x16 stA[2], stB[2];
        { const int r1 = r_begin + 64 <= r_last ? r_begin + 64 : r_begin;
          load_f8x4(k8A, rKV, Kw + r_begin * 64, koff);
          load_f8x4(k8B, rKV, Kw + r1 * 64, koff);
          qk_block8(stA, q8, k8A, -m); }
#pragma unroll 1
        for (int row0 = r_begin; ; row0 += 128) {
            { const int rnn = row0 + 128 <= r_last ? row0 + 128 : (row0 + 64 <= r_last ? row0 + 64 : row0); WIN_STEP(stA, stB, k8B, k8A, row0, rnn); }
            if (row0 + 64 > r_last) break;
            { const int rnn = row0 + 192 <= r_last ? row0 + 192 : (row0 + 128 <= r_last ? row0 + 128 : row0 + 64); WIN_STEP(stB, stA, k8A, k8B, row0 + 64, rnn); }
            if (row0 + 128 > r_last) break;
        }
#undef WIN_STEP
        asm volatile("s_nop 15\n\ts_nop 3" ::: "memory");
        l = xhalf_sum(l);
        const float sc = l > 0.f ? gn2 / l : 0.f;
        unsigned char* op = p.ws + O_ONSA + (size_t)token * 512 + (g * 4 + head) * 64 + 4 * h2;
#pragma unroll
        for (int dt = 0; dt < 2; ++dt)
#pragma unroll
            for (int a = 0; a < 4; ++a) {
                const f32x4 f = *(const f32x4*)(flp + dt * 32 + a * 8);
                *(unsigned*)(op + dt * 32 + a * 8) = pk4_f8((f[0] + sc * O[dt][4 * a]) * ONSA_SCALE, (f[1] + sc * O[dt][4 * a + 1]) * ONSA_SCALE, (f[2] + sc * O[dt][4 * a + 2]) * ONSA_SCALE, (f[3] + sc * O[dt][4 * a + 3]) * ONSA_SCALE);
            }
    }
    WAVE_SYNC();
}

__device__ __forceinline__ void phase7(const Params& p, unsigned char* smem) {
    const int tid = threadIdx.x, lane = tid & 63, wid = __builtin_amdgcn_readfirstlane(tid >> 6);
    float* lutS = (float*)smem;
    float* lutW = lutS + 4 * LSW;
    float* impw = lutW + 4 * LWW + wid * 8 * IMPW;
    float* fl = lutW + 4 * LWW + NWV * 8 * IMPW + wid * 32 * FLW;
    const int bg = blockIdx.x & 7, g = bg & 1;
    for (int i = tid; i < 4 * LSW; i += NT) { const int head = i / LSW, dist = i % LSW - 64;
        lutS[i] = dist < 0 ? -INFINITY : p.in[2][rel_bucket_dev(dist) * 8 + g * 4 + head] * LOG2E; }
    for (int i = tid; i < 4 * LWW; i += NT) { const int head = i / LWW, dist = i % LWW - 72;
        lutW[i] = (dist < 0 || dist >= 512) ? -INFINITY : p.in[2][rel_bucket_dev(dist) * 8 + g * 4 + head] * LOG2E; }
    __syncthreads();
    unsigned* tq = (unsigned*)(p.ws + O_BAR) + XF_BASE + 32 * (160 + bg);
#pragma unroll 1
    for (;;) {
        int idx = 0;
        if (lane == 0) idx = (int)atomicAdd(tq, 1u);
        idx = __builtin_amdgcn_readfirstlane(idx);
        if (idx >= 1024) break;
        nsa_tile(p, bg, 1023 - idx, lutS, lutW, impw, fl, lane);
    }
    __syncthreads();
}

struct EpiNsa { static constexpr bool PERM = true; const bf16_t* SGN; const bf16_t* MS5; unsigned char* MRG;
    __device__ __forceinline__ void operator()(AccRef acc, const pg8::Unit& u, int wr, int wc, int fr, int fq) const {
        constexpr float us_ = 1.f / (ONSA_SCALE * WNSA_SCALE);
        u32x4 sgv[2][2][2], msv[2][2][2];
#define NSA_LOAD(BUF, AI, MH) do { _Pragma("unroll") for (int m = 0; m < 2; ++m) _Pragma("unroll") for (int bj = 0; bj < 2; ++bj) { \
            const size_t off = (size_t)(u.pm * 256 + (AI) * 128 + wr * 64 + ((MH) + m) * 16 + fr) * 1024 + u.pn * 256 + bj * 128 + wc * 32 + 8 * fq; \
            sgv[BUF][m][bj] = *(const u32x4*)(SGN + off); msv[BUF][m][bj] = *(const u32x4*)(MS5 + off); } } while (0)
#define NSA_STORE(BUF, AI, MH) do { _Pragma("unroll") for (int m = 0; m < 2; ++m) _Pragma("unroll") for (int bj = 0; bj < 2; ++bj) { \
            const size_t off = (size_t)(u.pm * 256 + (AI) * 128 + wr * 64 + ((MH) + m) * 16 + fr) * 1024 + u.pn * 256 + bj * 128 + wc * 32 + 8 * fq; \
            const u32x4 sg = sgv[BUF][m][bj], ms = msv[BUF][m][bj]; \
            const f32x4 v0 = acc[AI][bj][(MH) + m][0] * us_, v1 = acc[AI][bj][(MH) + m][1] * us_; \
            *(u32x2*)(MRG + off) = (u32x2){pk4_f8((bflo(ms.x) + bflo(sg.x) * v0[0]) * MRG_SCALE, (bfhi(ms.x) + bfhi(sg.x) * v0[1]) * MRG_SCALE, (bflo(ms.y) + bflo(sg.y) * v0[2]) * MRG_SCALE, (bfhi(ms.y) + bfhi(sg.y) * v0[3]) * MRG_SCALE), \
                                           pk4_f8((bflo(ms.z) + bflo(sg.z) * v1[0]) * MRG_SCALE, (bfhi(ms.z) + bfhi(sg.z) * v1[1]) * MRG_SCALE, (bflo(ms.w) + bflo(sg.w) * v1[2]) * MRG_SCALE, (bfhi(ms.w) + bfhi(sg.w) * v1[3]) * MRG_SCALE)}; } } while (0)
        NSA_LOAD(0, 0, 0);
        NSA_LOAD(1, 0, 2); NSA_STORE(0, 0, 0);
        NSA_LOAD(0, 1, 0); NSA_STORE(1, 0, 2);
        NSA_LOAD(1, 1, 2); NSA_STORE(0, 1, 0);
        NSA_STORE(1, 1, 2);
#undef NSA_LOAD
#undef NSA_STORE
    } };
__device__ __forceinline__ void phase8(const Params& p, LAS unsigned char* lds) {
    pg8::DenseOrder S; S.init(p.ws + O_ONSA, p.ws + O_WT_NSA, NTOK, 1024, 256, 256, gridDim.x, blockIdx.x);
    EpiNsa E{(const bf16_t*)(p.ws + O_SGN), (const bf16_t*)(p.ws + O_MS5), p.ws + O_YS};
    pg8::gemm_phase<EpiNsa, pg8::DenseOrder, true, true>(lds, 256, 256, 256, S, E);
}
struct EpiOut { static constexpr bool PERM = true; static constexpr bool STAGED = false; const float* ada; unsigned char* Y;
    __device__ __forceinline__ void operator()(AccRef acc, const pg8::Unit& u, int wr, int wc, int fr, int fq) const {
        const float* ga = ada + (u.pm >> 5) * 6144 + 2048;
        f32x4 gv[2][2];
#pragma unroll
        for (int bj = 0; bj < 2; ++bj) { const int col = u.pn * 256 + bj * 128 + wc * 32 + 8 * fq; gv[bj][0] = *(const f32x4*)(ga + col) * (Y_SCALE / (MRG_SCALE * WOUT_SCALE)); gv[bj][1] = *(const f32x4*)(ga + col + 4) * (Y_SCALE / (MRG_SCALE * WOUT_SCALE)); }
        const bool odd = (fq & 1) != 0;
#pragma unroll
        for (int ai = 0; ai < 2; ++ai)
#pragma unroll
            for (int mp = 0; mp < 2; ++mp) {
                const int token = u.pm * 256 + ai * 128 + wr * 64 + (2 * mp + (odd ? 1 : 0)) * 16 + fr;
#pragma unroll
                for (int bj = 0; bj < 2; ++bj) {
                    const int col = u.pn * 256 + bj * 128 + wc * 32 + 8 * fq;
                    unsigned w[2][2];
#pragma unroll
                    for (int mm = 0; mm < 2; ++mm) {
                        const int m = 2 * mp + mm;
                        const f32x4 v0 = acc[ai][bj][m][0] * gv[bj][0], v1 = acc[ai][bj][m][1] * gv[bj][1];
                        w[mm][0] = pk4_f8(v0[0], v0[1], v0[2], v0[3]); w[mm][1] = pk4_f8(v1[0], v1[1], v1[2], v1[3]);
                    }
                    const unsigned s0 = odd ? w[0][0] : w[1][0], s1 = odd ? w[0][1] : w[1][1];
                    const unsigned r0 = (unsigned)__shfl_xor((int)s0, 16), r1 = (unsigned)__shfl_xor((int)s1, 16);
                    const u32x4 ov = odd ? (u32x4){r0, r1, w[1][0], w[1][1]} : (u32x4){w[0][0], w[0][1], r0, r1};
                    *(u32x4*)(Y + (size_t)token * 1024 + (col & ~15)) = ov;
                }
            }
    } };
__device__ __forceinline__ void phase9(const Params& p, LAS unsigned char* lds) {
    pg8::DenseOrder S; S.init(p.ws + O_YS, p.ws + O_WT_OUT, NTOK, 1024, 512, 512, gridDim.x, blockIdx.x);
    EpiOut E{(const float*)(p.ws + O_ADA), p.ws + O_SG5};
    pg8::gemm_phase<EpiOut, pg8::DenseOrder, true, true>(lds, 512, 512, 512, S, E);
}

__device__ __forceinline__ void phase10(const Params& p, unsigned char* smem) {
    typedef float f32x16_t __attribute__((ext_vector_type(16)));
    constexpr int HSW = 1025;
    const int tid = threadIdx.x, lane = tid & 63, wid = __builtin_amdgcn_readfirstlane(tid >> 6);
    float* hsb = (float*)smem;
    int* lcnt = (int*)(smem + 32 * HSW * 4);
    int* lbase = lcnt + 32;
    int* lsel = lcnt + 64;
    float* lgate = (float*)(lsel + 4 * 256);
    const float* lg = p.in[24]; const float* lb = p.in[25]; const float* wr_ = p.in[26]; const float* br_ = p.in[27];
    unsigned* cnt = (unsigned*)(p.ws + O_CNT);
    if (tid < 32) lcnt[tid] = 0;
    __syncthreads();
    int nstep = 0;
    float bfr[64];
    { const float* bp = wr_ + (size_t)(wid * 128 + (lane >> 5)) * 32 + (lane & 31);
#pragma unroll
      for (int j = 0; j < 64; ++j) bfr[j] = bp[(size_t)2 * j * 32]; }
    const float brv0 = br_[(tid * 2) & 31], brv1 = br_[(tid * 2 + 1) & 31];
    const float* xin = p.in[0]; const unsigned char* Yin = p.ws + O_SG5;
    const int G = (int)gridDim.x, NG = NTOK / 32;
    f32x4 rx[4][4]; unsigned ry[4][4];
    if ((int)blockIdx.x < NG) {
#pragma unroll
        for (int i = 0; i < 4; ++i) { const size_t tb = (size_t)((int)blockIdx.x * 32 + wid * 4 + i) * 1024 + lane * 4;
#pragma unroll
            for (int j = 0; j < 4; ++j) { ry[i][j] = *(const unsigned*)(Yin + tb + j * 256); rx[i][j] = *(const f32x4*)(xin + tb + j * 256); } }
    }
#pragma unroll 1
    for (int grp = blockIdx.x; grp < NG; grp += G, ++nstep) {
        const int tok0 = grp * 32 + wid * 4, b = tok0 >> 13;
        const float* ada = (const float*)(p.ws + O_ADA) + b * 6144;
        f32x4 gv[4], bv[4], scv[4], shv[4];
#pragma unroll
        for (int j = 0; j < 4; ++j) { const int c = j * 256 + lane * 4; gv[j] = *(const f32x4*)(lg + c); bv[j] = *(const f32x4*)(lb + c); scv[j] = *(const f32x4*)(ada + 4096 + c) + 1.f; shv[j] = *(const f32x4*)(ada + 3072 + c); }
        float rstd[4];
#pragma unroll
        for (int i = 0; i < 4; ++i) {
            float sm = 0.f;
#pragma unroll
            for (int j = 0; j < 4; ++j) { const f32x2 ylo = __builtin_amdgcn_cvt_pk_f32_fp8((int)ry[i][j], false), yhi = __builtin_amdgcn_cvt_pk_f32_fp8((int)ry[i][j], true);
                rx[i][j] = rx[i][j] * DN_ALPHA + (f32x4){ylo.x, ylo.y, yhi.x, yhi.y} * (1.f / Y_SCALE); sm += (rx[i][j][0] + rx[i][j][1]) + (rx[i][j][2] + rx[i][j][3]); }
            const float mean = wave_sum(sm) * (1.f / 1024.f); float q = 0.f;
#pragma unroll
            for (int j = 0; j < 4; ++j) { rx[i][j] = rx[i][j] - mean; q += (rx[i][j][0] * rx[i][j][0] + rx[i][j][1] * rx[i][j][1]) + (rx[i][j][2] * rx[i][j][2] + rx[i][j][3] * rx[i][j][3]); }
            rstd[i] = rsqrtf(wave_sum(q) * (1.f / 1024.f) + LN_EPS);
        }
#pragma unroll
        for (int j = 0; j < 4; ++j) {
            const int c = j * 256 + lane * 4;
#pragma unroll
            for (int i = 0; i < 4; ++i) {
                const int lt = wid * 4 + i; const size_t token = (size_t)(tok0 + i);
                const f32x4 x1 = rx[i][j] * rstd[i] * gv[j] + bv[j];
                *(u32x2*)((bf16_t*)(p.ws + O_Z1) + token * 1024 + c) = (u32x2){pk2(x1[0], x1[1]), pk2(x1[2], x1[3])};
                const f32x4 hv = x1 * scv[j] + shv[j];
                float* hd = hsb + lt * HSW + c; hd[0] = hv[0]; hd[1] = hv[1]; hd[2] = hv[2]; hd[3] = hv[3];
                *(unsigned*)(p.ws + O_H2 + token * 1024 + c) = pk4_f8(hv[0], hv[1], hv[2], hv[3]);
            }
        }
        { const int gn = grp + G < NG ? grp + G : grp;
#pragma unroll
          for (int i = 0; i < 4; ++i) { const size_t tb = (size_t)(gn * 32 + wid * 4 + i) * 1024 + lane * 4;
#pragma unroll
              for (int j = 0; j < 4; ++j) { ry[i][j] = *(const unsigned*)(Yin + tb + j * 256); rx[i][j] = *(const f32x4*)(xin + tb + j * 256); } } }
        __syncthreads();
        f32x16_t acc;
#pragma unroll
        for (int r = 0; r < 16; ++r) acc[r] = 0.f;
        { const float* ap = hsb + (lane & 31) * HSW + wid * 128 + (lane >> 5);
#pragma unroll
          for (int j = 0; j < 64; ++j) acc = __builtin_amdgcn_mfma_f32_32x32x2f32(ap[2 * j], bfr[j], acc, 0, 0, 0); }
        __syncthreads();
        { float* pt = hsb + wid * 1024 + (lane & 31);
#pragma unroll
          for (int r = 0; r < 16; ++r) pt[((r & 3) + 8 * (r >> 2) + 4 * (lane >> 5)) * 32] = acc[r]; }
        __syncthreads();
        { float* lgt = hsb + 8192;
#pragma unroll
          for (int i = 0; i < 2; ++i) { const int o = tid * 2 + i; float sum = 0.f;
#pragma unroll
              for (int w = 0; w < 8; ++w) sum += hsb[w * 1024 + o];
              lgt[(o & 31) * 33 + (o >> 5)] = sum + (i ? brv1 : brv0); } }
        __syncthreads();
        {
            const int lt = wid * 4 + (lane >> 4), sx = lane & 15;
            float v0 = hsb[8192 + sx * 33 + lt], v1 = hsb[8192 + (sx + 16) * 33 + lt];
            int te[4]; float tv[4];
#pragma unroll
            for (int r = 0; r < 4; ++r) {
                float bs; int bj;
                if (v1 > v0) { bs = v1; bj = sx + 16; } else { bs = v0; bj = sx; }
#define ARGMAX_DPP(CTRL) { const float os = __uint_as_float(__builtin_amdgcn_update_dpp(0u, __float_as_uint(bs), CTRL, 0xF, 0xF, true)); const int oj = __builtin_amdgcn_update_dpp(0, bj, CTRL, 0xF, 0xF, true); \
                           if (os > bs || (os == bs && oj < bj)) { bs = os; bj = oj; } }
                ARGMAX_DPP(0xB1) ARGMAX_DPP(0x4E) ARGMAX_DPP(0x141) ARGMAX_DPP(0x140)
#undef ARGMAX_DPP
                te[r] = bj; tv[r] = bs;
                if (bj == sx) v0 = -INFINITY;
                if (bj == sx + 16) v1 = -INFINITY;
            }
            if (sx == 0) {
                const float e1 = __expf(tv[1] - tv[0]), e2 = __expf(tv[2] - tv[0]), e3 = __expf(tv[3] - tv[0]);
                const float inv = 1.f / (1.f + e1 + e2 + e3);
                const float gg[4] = {inv, e1 * inv, e2 * inv, e3 * inv};
#pragma unroll
                for (int r = 0; r < 4; ++r) {
                    const int rk = atomicAdd(&lcnt[te[r]], 1);
                    lsel[(nstep * 32 + lt) * 4 + r] = te[r] | (rk << 8);
                    lgate[(nstep * 32 + lt) * 4 + r] = gg[r];
                }
            }
        }
        __syncthreads();
    }
    if (tid < 32) lbase[tid] = (int)atomicAdd(cnt + tid * 32, (unsigned)lcnt[tid]);
    __syncthreads();
    {
        for (int i = tid; i < nstep * 32 * 4; i += NT) {
            const int li = i >> 2, kk = i & 3, st = li >> 5, lt = li & 31;
            const int token = (blockIdx.x + st * gridDim.x) * 32 + lt;
            const int sv = lsel[i], ee = sv & 255, pos = lbase[ee] + (sv >> 8);
            ((int*)(p.ws + O_TOPE))[token * 4 + kk] = ee;
            ((unsigned*)(p.ws + O_TOPP))[token * 4 + kk] = (unsigned)pos;
            ((int*)(p.ws + O_ROWTOK))[(size_t)ee * NTOK + pos] = token * 4 + kk;
            ((float*)(p.ws + O_ROWGATE))[(size_t)ee * NTOK + pos] = lgate[i];
        }
    }
    __syncthreads();
    convert_weights(p, smem, TRQ_GU_LO, TRQ_DN_LO, (unsigned*)(p.ws + O_BAR) + 3410);
}

__device__ __forceinline__ void load_offsets(const Params& p, int* offs  , int* toff  ) {
    if (threadIdx.x < 64) {
        const int lane = threadIdx.x;
        const int c = lane < 32 ? (int)((const unsigned*)(p.ws + O_CNT))[lane * 32] : 0;
        int a = c, t = (c + 255) >> 8;
#pragma unroll
        for (int o = 1; o < 32; o <<= 1) { const int ua = __shfl_up(a, o), ut = __shfl_up(t, o); if ((lane & 31) >= o) { a += ua; t += ut; } }
        if (lane < 32) { offs[lane] = a - c; toff[lane] = t - ((c + 255) >> 8); if (lane == 31) { offs[32] = a; toff[32] = t; } }
    }
    __syncthreads();
}
struct MoeOrder {
    const int* offs; const int* toff; const char* A; const char* B; const int* rowtok; size_t bsB; int nN, G, c;
    __device__ __forceinline__ bool next(int i, pg8::Unit& u) const {
        const int v = (G % 8 == 0) ? (c % 8) * (G / 8) + c / 8 : c;
        const int lgN = nN == 8 ? 3 : 2;
        const long L = (long)i * G + v; if (L >= ((long)toff[32] << lgN)) return false;
        const int tile = (int)L >> lgN, pn = (int)L & (nN - 1);
        const unsigned long long bal_ = __ballot(toff[(threadIdx.x & 31) + 1] <= tile);
        const int e = __builtin_amdgcn_readfirstlane(__builtin_popcount((unsigned)bal_));
        const int r0 = __builtin_amdgcn_readfirstlane(offs[e] + (tile - toff[e]) * 256);
        u.pm = r0; u.pn = pn; u.e = e; u.nvalid = __builtin_amdgcn_readfirstlane(offs[e + 1]) - r0;
        u.gidx = e * NTOK + (tile - toff[e]) * 256;
        if (rowtok) { u.A = A; u.rows = rowtok + u.gidx; const int rm = u.nvalid - 1; u.rmax = rm < 255 ? rm : 255; }
        else { u.A = A + (size_t)r0 * 1024; u.rows = nullptr; u.rmax = 255; }
        u.B = B + (size_t)e * bsB + (size_t)pn * 256 * 1024; return true;
    }
};
__device__ __forceinline__ f32x4 swiglu4(f32x4 ga, f32x4 ua) {
    f32x4 gt, up, e, r;
#pragma unroll
    for (int j = 0; j < 4; ++j) { gt[j] = __builtin_fminf(ga[j], 7.f); up[j] = __builtin_amdgcn_fmed3f(ua[j], -7.f, 7.f); }
    const f32x4 arg = gt * (-1.702f * LOG2E_F);
#pragma unroll
    for (int j = 0; j < 4; ++j) e[j] = __builtin_amdgcn_exp2f(arg[j]);
    const f32x4 d = e + 1.f;
#pragma unroll
    for (int j = 0; j < 4; ++j) r[j] = __builtin_amdgcn_rcpf(d[j]);
    return (up + 1.f) * gt * r;
}
struct EpiGU { static constexpr bool PERM = true; const float* bgu; unsigned char* ACT;
    __device__ __forceinline__ void operator()(AccRef acc, const pg8::Unit& u, int wr, int wc, int fr, int fq) const {
        const int cv = u.pn * 128 + wc * 32 + 8 * fq;
        const float* bb = bgu + (size_t)u.e * 2048;
        const float ws_ = 1.f / WGU_SCALE;
        const f32x4 bg0 = *(const f32x4*)(bb + cv), bg1 = *(const f32x4*)(bb + cv + 4), bu0 = *(const f32x4*)(bb + 1024 + cv), bu1 = *(const f32x4*)(bb + 1024 + cv + 4);
        const bool odd = (fq & 1) != 0;
#pragma unroll
        for (int ai = 0; ai < 2; ++ai)
#pragma unroll
            for (int mp = 0; mp < 2; ++mp) {
                unsigned w[2][2];
#pragma unroll
                for (int mm = 0; mm < 2; ++mm) {
                    const int m = 2 * mp + mm;
                    const f32x4 ga0 = acc[ai][0][m][0] * ws_ + bg0, ga1 = acc[ai][0][m][1] * ws_ + bg1, ua0 = acc[ai][1][m][0] * ws_ + bu0, ua1 = acc[ai][1][m][1] * ws_ + bu1;
                    const f32x4 o0 = swiglu4(ga0, ua0), o1 = swiglu4(ga1, ua1);
                    w[mm][0] = pk4_f8(o0[0], o0[1], o0[2], o0[3]); w[mm][1] = pk4_f8(o1[0], o1[1], o1[2], o1[3]);
                }
                const unsigned s0 = odd ? w[0][0] : w[1][0], s1 = odd ? w[0][1] : w[1][1];
                const unsigned r0 = (unsigned)__shfl_xor((int)s0, 16), r1 = (unsigned)__shfl_xor((int)s1, 16);
                const int m = 2 * mp + (odd ? 1 : 0);
                const int lr = ai * 128 + wr * 64 + m * 16 + fr;
                const int row = lr < u.nvalid ? u.pm + lr : NROWS + lr;
                const u32x4 ov = odd ? (u32x4){r0, r1, w[1][0], w[1][1]} : (u32x4){w[0][0], w[0][1], r0, r1};
                *(u32x4*)(ACT + (size_t)row * 1024 + (cv & ~15)) = ov;
            }
    } };
__device__ __forceinline__ void phase12(const Params& p, unsigned char* smem, LAS unsigned char* lds) {
    int* offs = (int*)(smem + LDS_TAB); int* toff = offs + 40;
    load_offsets(p, offs, toff);
    MoeOrder S{offs, toff, (const char*)(p.ws + O_H2), (const char*)(p.ws + O_WT_GU), (const int*)(p.ws + O_ROWTOK), (size_t)2048 * 1024, 8, (int)gridDim.x, (int)blockIdx.x};
    EpiGU E{p.in[29], p.ws + O_ACT};
    pg8::gemm_phase<EpiGU, MoeOrder, true, true, true>(lds, 512, 512, 512, S, E);
    __syncthreads();
    convert_weights(p, smem, TRQ_DN_LO, TR_ITEMS, (unsigned*)(p.ws + O_BAR) + 3440);
}
struct EpiDn { static constexpr bool PERM = true; const float* bd; const float* rowgate; const int* rowtok; unsigned char* YK;
    __device__ __forceinline__ void operator()(AccRef acc, const pg8::Unit& u, int wr, int wc, int fr, int fq) const {
        const float* bb = bd + (size_t)u.e * 1024;
        f32x4 bv[2][2]; float gw[2][4]; int dst[2][2];
        const bool odd = (fq & 1) != 0;
#pragma unroll
        for (int bj = 0; bj < 2; ++bj) { const int col = u.pn * 256 + bj * 128 + wc * 32 + 8 * fq; bv[bj][0] = *(const f32x4*)(bb + col); bv[bj][1] = *(const f32x4*)(bb + col + 4); }
#pragma unroll
        for (int ai = 0; ai < 2; ++ai) {
#pragma unroll
            for (int m = 0; m < 4; ++m) { const int lr = ai * 128 + wr * 64 + m * 16 + fr, lc = lr < u.nvalid ? lr : u.nvalid - 1; gw[ai][m] = rowgate[u.gidx + lc] * YK_SCALE; }
#pragma unroll
            for (int mp = 0; mp < 2; ++mp) { const int lr = ai * 128 + wr * 64 + (2 * mp + (odd ? 1 : 0)) * 16 + fr, lc = lr < u.nvalid ? lr : u.nvalid - 1; dst[ai][mp] = rowtok[u.gidx + lc]; }
        }
#pragma unroll
        for (int ai = 0; ai < 2; ++ai)
#pragma unroll
            for (int mp = 0; mp < 2; ++mp) {
                const int lr = ai * 128 + wr * 64 + (2 * mp + (odd ? 1 : 0)) * 16 + fr;
                const int row = lr < u.nvalid ? dst[ai][mp] : NROWS + lr;
#pragma unroll
                for (int bj = 0; bj < 2; ++bj) {
                    const int col = u.pn * 256 + bj * 128 + wc * 32 + 8 * fq;
                    unsigned w[2][2];
#pragma unroll
                    for (int mm = 0; mm < 2; ++mm) {
                        const int m = 2 * mp + mm;
                        const f32x4 v0 = (acc[ai][bj][m][0] * (1.f / WDN_SCALE) + bv[bj][0]) * gw[ai][m], v1 = (acc[ai][bj][m][1] * (1.f / WDN_SCALE) + bv[bj][1]) * gw[ai][m];
                        w[mm][0] = pk4_f8(v0[0], v0[1], v0[2], v0[3]);
                        w[mm][1] = pk4_f8(v1[0], v1[1], v1[2], v1[3]);
                    }
                    const unsigned s0 = odd ? w[0][0] : w[1][0], s1 = odd ? w[0][1] : w[1][1];
                    const unsigned r0 = (unsigned)__shfl_xor((int)s0, 16), r1 = (unsigned)__shfl_xor((int)s1, 16);
                    const u32x4 ov = odd ? (u32x4){r0, r1, w[1][0], w[1][1]} : (u32x4){w[0][0], w[0][1], r0, r1};
                    *(u32x4*)(YK + (size_t)row * 1024 + (col & ~15)) = ov;
                }
            }
    } };
__device__ __forceinline__ void phase13(const Params& p, unsigned char* smem, LAS unsigned char* lds) {
    int* offs = (int*)(smem + LDS_TAB); int* toff = offs + 40;
    load_offsets(p, offs, toff);
    MoeOrder S{offs, toff, (const char*)(p.ws + O_ACT), (const char*)(p.ws + O_WT_DN), nullptr, (size_t)1024 * 1024, 4, (int)gridDim.x, (int)blockIdx.x};
    EpiDn E{p.in[31], (const float*)(p.ws + O_ROWGATE), (const int*)(p.ws + O_ROWTOK), p.ws + O_YK};
    pg8::gemm_phase<EpiDn, MoeOrder, true, true>(lds, 512, 512, 512, S, E);
    __syncthreads();
}

struct P14Raw { unsigned a[4][4]; u32x2 x[4]; };
__device__ __forceinline__ void p14_load(P14Raw& r, const unsigned char* YK, const bf16_t* X1, int token, int lane) {
#pragma unroll
    for (int j = 0; j < 4; ++j) {
        const int c = j * 256 + lane * 4;
#pragma unroll
        for (int k = 0; k < 4; ++k) r.a[j][k] = *(const unsigned*)(YK + (size_t)(token * 4 + k) * 1024 + c);
        r.x[j] = *(const u32x2*)(X1 + (size_t)token * 1024 + c);
    }
}
struct P14Par { f32x4 lg[4], lb[4], gf[4]; };
__device__ __forceinline__ void p14_finish(const P14Raw& r, const P14Par& q, float* out, int token, int lane) {
    f32x4 v[4]; float s = 0.f;
#pragma unroll
    for (int j = 0; j < 4; ++j) {
        f32x2 lo = __builtin_amdgcn_cvt_pk_f32_fp8((int)r.a[j][0], false) + __builtin_amdgcn_cvt_pk_f32_fp8((int)r.a[j][1], false);
        f32x2 hi = __builtin_amdgcn_cvt_pk_f32_fp8((int)r.a[j][0], true) + __builtin_amdgcn_cvt_pk_f32_fp8((int)r.a[j][1], true);
        lo += __builtin_amdgcn_cvt_pk_f32_fp8((int)r.a[j][2], false) + __builtin_amdgcn_cvt_pk_f32_fp8((int)r.a[j][3], false);
        hi += __builtin_amdgcn_cvt_pk_f32_fp8((int)r.a[j][2], true) + __builtin_amdgcn_cvt_pk_f32_fp8((int)r.a[j][3], true);
        const f32x4 y = (f32x4){lo.x, lo.y, hi.x, hi.y} * (1.f / YK_SCALE);
        v[j] = (f32x4){bflo(r.x[j].x), bfhi(r.x[j].x), bflo(r.x[j].y), bfhi(r.x[j].y)} * DN_ALPHA + q.gf[j] * y;
        s += (v[j][0] + v[j][1]) + (v[j][2] + v[j][3]);
    }
    const float mean = wave_sum(s) * (1.f / 1024.f); float qq = 0.f;
#pragma unroll
    for (int j = 0; j < 4; ++j) { v[j] = v[j] - mean; qq += (v[j][0] * v[j][0] + v[j][1] * v[j][1]) + (v[j][2] * v[j][2] + v[j][3] * v[j][3]); }
    const float rstd = rsqrtf(wave_sum(qq) * (1.f / 1024.f) + LN_EPS);
#pragma unroll
    for (int j = 0; j < 4; ++j) { const int c = j * 256 + lane * 4; *(f32x4*)(out + (size_t)token * 1024 + c) = v[j] * rstd * q.lg[j] + q.lb[j]; }
}
__device__ __forceinline__ void p14_gate(P14Par& q, const float* ada, int token, int& curb, int lane) {
    const int b = token >> 13;
    if (b != curb) { curb = b;
#pragma unroll
        for (int j = 0; j < 4; ++j) q.gf[j] = *(const f32x4*)(ada + b * 6144 + j * 256 + lane * 4); }
}
__device__ __forceinline__ void phase14(const Params& p, unsigned char*) {
    const int tid = threadIdx.x, lane = tid & 63, wid = tid >> 6;
    const unsigned char* YK = p.ws + O_YK;
    const bf16_t* X1 = (const bf16_t*)(p.ws + O_Z1);
    const float* ada = (const float*)(p.ws + O_ADA) + 5120;
    const int G = gridDim.x, nit = NTOK / NWV;
    int item = blockIdx.x;
    if (item >= nit) return;
    P14Par q; int curb = -1;
#pragma unroll
    for (int j = 0; j < 4; ++j) { q.lg[j] = *(const f32x4*)(p.in[32] + j * 256 + lane * 4); q.lb[j] = *(const f32x4*)(p.in[33] + j * 256 + lane * 4); }
    P14Raw ra, rb;
    p14_load(ra, YK, X1, item * NWV + wid, lane);
#pragma unroll 1
    for (;;) {
        const int ta = item * NWV + wid, ib = item + G;
        p14_gate(q, ada, ta, curb, lane);
        if (ib < nit) p14_load(rb, YK, X1, ib * NWV + wid, lane);
        p14_finish(ra, q, p.out, ta, lane);
        if (ib >= nit) break;
        const int tb = ib * NWV + wid; item = ib + G;
        p14_gate(q, ada, tb, curb, lane);
        if (item < nit) p14_load(ra, YK, X1, item * NWV + wid, lane);
        p14_finish(rb, q, p.out, tb, lane);
        if (item >= nit) break;
    }
}


#if defined(__HIP_DEVICE_COMPILE__)
typedef const __attribute__((address_space(4))) Params* KernargPtr;
__device__ __forceinline__ KernargPtr opaque_kernarg() { KernargPtr kp = (KernargPtr)__builtin_amdgcn_kernarg_segment_ptr(); asm volatile("" : "+s"(kp)); return kp; }
#define GAS __attribute__((address_space(1)))
__device__ __forceinline__ Params load_params() {
    Params r; const __attribute__((address_space(4))) unsigned long long* s = (const __attribute__((address_space(4))) unsigned long long*)opaque_kernarg();
#pragma unroll
    for (int i = 0; i < 34; ++i) r.in[i] = (const float*)(const GAS float*)s[i];
    r.out = (float*)(GAS float*)s[34]; r.ws = (unsigned char*)(GAS unsigned char*)s[35];
    const unsigned long long pp = s[36]; r.ph_lo = (int)(unsigned)pp; r.ph_hi = (int)(unsigned)(pp >> 32);
    return r; }
#else
#define opaque_kernarg() (&p_unused)
#endif
#if defined(__HIP_DEVICE_COMPILE__)
#define PARAMS_NOW() load_params()
#else
#define PARAMS_NOW() p_unused
#endif
template <bool COOP>
__global__ void __launch_bounds__(NT, 2) fwd_kernel(Params p_unused) {
    extern __shared__ __attribute__((aligned(16))) unsigned char smem[];
    LAS unsigned char* lds = (LAS unsigned char*)smem;
    const int lo = opaque_kernarg()->ph_lo, hi = opaque_kernarg()->ph_hi;
    volatile LAS unsigned* bst = (volatile LAS unsigned*)(lds + LDS_BYTES - 16);
    if (threadIdx.x == 0) { bst[0] = 0u; bst[1] = 0u; bst[2] = 0u; bst[3] = 0u; }
    __syncthreads();
    XcdBarrier gbar; gbar.bar = nullptr; gbar.x = 0; gbar.st = bst;
    if (COOP) { const Params p0 = PARAMS_NOW(); gbar = xcd_barrier_post((unsigned*)(p0.ws + O_BAR), bst); }
#define SEAM(k) do { if (lo < 0) cg::this_grid().sync(); else { const Params pw_ = PARAMS_NOW(); xcd_barrier_work(gbar, pw_, smem, (k) >= 1 && (k) <= 12); } } while (0)
#define RUN_PHASE(k, call) if (((PH_MASK >> (k)) & 1) && lo <= (k) && (k) < hi) { _Pragma("unroll 1") for (int rep_ = 0; rep_ < 1 + ((REPEAT_MASK >> (k)) & 1); ++rep_) { if (rep_) { if (COOP) SEAM(1); } const Params p = PARAMS_NOW(); call; } } if (COOP) { if ((k) != 0 && (k) != 6 && lo <= (k) && (k) + 1 < hi) SEAM(k); }
    RUN_PHASE(0, phase0(p, smem))
    RUN_PHASE(1, phase1(p, smem))
    RUN_PHASE(2, phase2(p, lds))
    if (COOP && gridDim.x == 256 && lo <= 3 && 5 < hi && ((PH_MASK >> 3) & 7) == 7 && ((REPEAT_MASK >> 3) & 7) == 0) {
        { const Params p = PARAMS_NOW(); phase345(p, smem, lds); }
        SEAM(5);
    } else {
    RUN_PHASE(3, phase3(p, lds))
    RUN_PHASE(4, phase4(p, smem))
    RUN_PHASE(5, phase5(p, lds))
    }
    RUN_PHASE(6, phase6(p, lds))
    RUN_PHASE(7, phase7(p, smem))
    RUN_PHASE(8, phase8(p, lds))
    RUN_PHASE(9, phase9(p, lds))
    RUN_PHASE(10, phase10(p, smem))
    RUN_PHASE(12, phase12(p, smem, lds))
    RUN_PHASE(13, phase13(p, smem, lds))
    RUN_PHASE(14, phase14(p, smem))
#undef RUN_PHASE
#undef SEAM
}

extern "C" void kernel_launch(void* const* d_in, const int* in_sizes, int n_in, void* d_out, int out_size, void* d_ws, size_t ws_size, hipStream_t stream) {
    static int grid = 0;
    if (grid == 0) {
        if (n_in != 34 || out_size != NTOK * DM || ws_size < WS_NEED) { fprintf(stderr, "kernel_launch: unexpected problem (n_in %d, out %d, ws %zu need %zu)\n", n_in, out_size, ws_size, (size_t)WS_NEED); grid = -1; return; }
        int dev = 0, cus = 0, per_cu = 0;
        (void)hipGetDevice(&dev);
        (void)hipDeviceGetAttribute(&cus, hipDeviceAttributeMultiprocessorCount, dev);
#if ONE_LAUNCH
        (void)hipFuncSetAttribute((const void*)fwd_kernel<true>, hipFuncAttributeMaxDynamicSharedMemorySize, LDS_BYTES);
        (void)hipOccupancyMaxActiveBlocksPerMultiprocessor(&per_cu, fwd_kernel<true>, NT, LDS_BYTES);
#else
        (void)hipFuncSetAttribute((const void*)fwd_kernel<false>, hipFuncAttributeMaxDynamicSharedMemorySize, LDS_BYTES);
        (void)hipOccupancyMaxActiveBlocksPerMultiprocessor(&per_cu, fwd_kernel<false>, NT, LDS_BYTES);
#endif
        if (per_cu < 1) { fprintf(stderr, "kernel_launch: occupancy query reports %d blocks per CU\n", per_cu); per_cu = 1; }
        grid = cus * per_cu;
        fprintf(stderr, "kernel_launch: grid %d (%d CUs x %d)\n", grid, cus, per_cu);
    }
    if (grid < 0) return;
    Params p{};
    for (int i = 0; i < 34; ++i) p.in[i] = (const float*)d_in[i];
    p.out = (float*)d_out; p.ws = (unsigned char*)d_ws;
#if ONE_LAUNCH
    if (hipMemsetAsync((char*)d_ws + O_BAR, 0, BAR_BYTES, stream) != hipSuccess) { fprintf(stderr, "kernel_launch: memset of the barrier words failed\n"); return; }
    p.ph_lo = 0; p.ph_hi = NPHASE;
    void* args[] = {&p};
    hipError_t e = hipLaunchCooperativeKernel((void*)fwd_kernel<true>, dim3(grid), dim3(NT), args, LDS_BYTES, stream);
    if (e != hipSuccess) fprintf(stderr, "cooperative launch failed: %s (grid %d)\n", hipGetErrorString(e), grid);
#else
    for (int ph = 0; ph < NPHASE; ++ph) {
        p.ph_lo = ph; p.ph_hi = ph + 1;
        hipLaunchKernelGGL(fwd_kernel<false>, dim3(grid), dim3(NT), LDS_BYTES, stream, p);
    }
#endif
}
```
